# Optimizing an MI355X kernel written in HIP

```python
import math
import jax, jax.numpy as jnp
from jax import lax
import numpy as np

D_MODEL = 2048
BATCH = 1
SEQ = 8192
DEPTH = 4

N_META = 16
CHUNK = 128
PAD = CHUNK - N_META
D_FF = 5632
EPS = 1e-6
ROPE_THETA = 10000.0
NEG_INF = -1e30

MLA_HEADS = 4
MLA_NOPE = 128
MLA_ROPE = 64
MLA_QK = MLA_NOPE + MLA_ROPE
MLA_V = 128
MLA_Q_LORA = 384
MLA_KV_LORA = 128
MLA_WIDTH = MLA_HEADS * MLA_V

SSD_HEADS = 8
SSD_HEAD_DIM = 64
SSD_WIDTH = SSD_HEADS * SSD_HEAD_DIM
SSD_GROUPS = 2
SSD_STATE = 128
SSD_CONV = 4
SSD_CONV_CH = SSD_WIDTH + 2 * SSD_GROUPS * SSD_STATE

RET_HEADS = 4
RET_DK = 64
RET_DV = 128
RET_WIDTH = RET_HEADS * RET_DV

RWKV_HEADS = 8
RWKV_HEAD_DIM = 64
RWKV_WIDTH = RWKV_HEADS * RWKV_HEAD_DIM
RWKV_DECAY_LORA = 32
RWKV_A_LORA = 32
RWKV_GATE_LORA = 64
RWKV_LN_EPS = 64e-5

MIX_WIDTH = MLA_WIDTH + SSD_WIDTH + RET_WIDTH + RWKV_WIDTH
MLA_IN = MLA_Q_LORA + MLA_KV_LORA + MLA_ROPE
SSD_IN = SSD_WIDTH + SSD_CONV_CH + SSD_HEADS
RET_IN = 2 * RET_HEADS * RET_DK + 2 * RET_WIDTH
RWKV_IN = 3 * RWKV_WIDTH + RWKV_DECAY_LORA + RWKV_A_LORA + RWKV_GATE_LORA
IN_WIDTH = MLA_IN + SSD_IN + RET_IN + RWKV_IN

kernel_name = 'hybrid_parallel_heads_mla_ssd_ret_rwkv7'


def rms_norm(x, g, eps=EPS):
    xf = x.astype(jnp.float32)
    y = xf * lax.rsqrt(jnp.mean(xf * xf, axis=-1, keepdims=True) + eps)
    return (y * g.astype(jnp.float32)).astype(x.dtype)


def layer_norm_heads(x, g, eps):
    xf = x.astype(jnp.float32)
    mu = jnp.mean(xf, axis=-1, keepdims=True)
    var = jnp.mean(jnp.square(xf - mu), axis=-1, keepdims=True)
    return ((xf - mu) * lax.rsqrt(var + eps) * g.astype(jnp.float32)).astype(x.dtype)


def swiglu(h, w_gate, w_up, w_down):
    return (jax.nn.silu(h @ w_gate) * (h @ w_up)) @ w_down


def rope(x, pos):
    half = x.shape[-1] // 2
    inv = ROPE_THETA ** (-jnp.arange(half, dtype=jnp.float32) / half)
    ang = pos[:, None] * inv[None, :]
    cos = jnp.cos(ang)[None, :, None, :]
    sin = jnp.sin(ang)[None, :, None, :]
    xf = x.astype(jnp.float32)
    x1, x2 = xf[..., :half], xf[..., half:]
    return jnp.concatenate([x1 * cos - x2 * sin, x1 * sin + x2 * cos], axis=-1).astype(x.dtype)


def causal_tri():
    return jnp.arange(CHUNK)[:, None] >= jnp.arange(CHUNK)[None, :]


def chunk_state_scan(decay, states):
    def step(s, inp):
        dcy, st = inp
        return dcy[:, :, None, None] * s + st, s
    s0 = jnp.zeros_like(states[:, 0])
    _, prev = lax.scan(step, s0, (jnp.moveaxis(decay, 1, 0), jnp.moveaxis(states, 1, 0)))
    return jnp.moveaxis(prev, 0, 1)


def mla_mixer(u, pos, valid, q_norm, w_q_up, kv_norm, w_kv_up, qk_norm_q, qk_norm_k):
    b, lp, _ = u.shape
    cq, ckv, k_pe = jnp.split(u, [MLA_Q_LORA, MLA_Q_LORA + MLA_KV_LORA], axis=-1)
    q = (rms_norm(cq, q_norm) @ w_q_up).reshape(b, lp, MLA_HEADS, MLA_QK)
    kv = (rms_norm(ckv, kv_norm) @ w_kv_up).reshape(b, lp, MLA_HEADS, MLA_NOPE + MLA_V)
    k_nope, v = kv[..., :MLA_NOPE], kv[..., MLA_NOPE:]
    k_pe = jnp.broadcast_to(k_pe[:, :, None, :], (b, lp, MLA_HEADS, MLA_ROPE))
    k = jnp.concatenate([k_nope, k_pe], axis=-1)
    q = rms_norm(q, qk_norm_q)
    k = rms_norm(k, qk_norm_k)
    q = jnp.concatenate([q[..., :MLA_NOPE], rope(q[..., MLA_NOPE:], pos)], axis=-1)
    k = jnp.concatenate([k[..., :MLA_NOPE], rope(k[..., MLA_NOPE:], pos)], axis=-1)
    nb = lp // CHUNK
    qb = jnp.moveaxis(q.reshape(b, nb, CHUNK, MLA_HEADS, MLA_QK), 1, 0)
    kpos = jnp.arange(lp)
    scale = MLA_QK ** -0.5

    def block(args):
        qi, i = args
        s = jnp.einsum('bqhd,bkhd->bhqk', qi, k, preferred_element_type=jnp.float32) * scale
        qpos = i * CHUNK + jnp.arange(CHUNK)
        mask = (kpos[None, :] <= qpos[:, None]) & valid[None, :]
        p = jax.nn.softmax(jnp.where(mask, s, NEG_INF), axis=-1).astype(v.dtype)
        return jnp.einsum('bhqk,bkhd->bqhd', p, v)

    o = lax.map(block, (qb, jnp.arange(nb)))
    return jnp.moveaxis(o, 0, 1).reshape(b, lp, MLA_WIDTH)


def ssd_chunked(x, log_a, bm, cm):
    b, lp, h, p = x.shape
    c = lp // CHUNK
    xf = x.astype(jnp.float32).reshape(b, c, CHUNK, h, p)
    bf = bm.astype(jnp.float32).reshape(b, c, CHUNK, h, -1)
    cf = cm.astype(jnp.float32).reshape(b, c, CHUNK, h, -1)
    cs = jnp.cumsum(log_a.astype(jnp.float32).reshape(b, c, CHUNK, h), axis=2)
    seg = cs[:, :, :, None, :] - cs[:, :, None, :, :]
    lmat = jnp.exp(jnp.where(causal_tri()[None, None, :, :, None], seg, -jnp.inf))
    scores = jnp.einsum('bcihn,bcjhn->bcijh', cf, bf) * lmat
    y_diag = jnp.einsum('bcijh,bcjhp->bcihp', scores, xf)
    decay_to_end = jnp.exp(cs[:, :, -1:, :] - cs)
    states = jnp.einsum('bcjhn,bcjh,bcjhp->bchpn', bf, decay_to_end, xf)
    s_prev = chunk_state_scan(jnp.exp(cs[:, :, -1, :]), states)
    y_off = jnp.einsum('bcihn,bchpn,bcih->bcihp', cf, s_prev, jnp.exp(cs))
    return (y_diag + y_off).reshape(b, lp, h, p).astype(x.dtype)


def ssd_mixer(u, valid, conv_w, conv_b, dt_bias, a_log, d_skip, norm_g):
    b, lp, _ = u.shape
    z, xbc, dt = jnp.split(u, [SSD_WIDTH, SSD_WIDTH + SSD_CONV_CH], axis=-1)
    xbc = lax.conv_general_dilated(xbc, conv_w[:, None, :], window_strides=(1,),
                                   padding=[(SSD_CONV - 1, 0)],
                                   dimension_numbers=('NWC', 'WIO', 'NWC'),
                                   feature_group_count=SSD_CONV_CH)
    xbc = jax.nn.silu(xbc + conv_b)
    xs, bm, cm = jnp.split(xbc, [SSD_WIDTH, SSD_WIDTH + SSD_GROUPS * SSD_STATE], axis=-1)
    xs = xs.reshape(b, lp, SSD_HEADS, SSD_HEAD_DIM)
    rep = SSD_HEADS // SSD_GROUPS
    bm = jnp.repeat(bm.reshape(b, lp, SSD_GROUPS, SSD_STATE), rep, axis=2)
    cm = jnp.repeat(cm.reshape(b, lp, SSD_GROUPS, SSD_STATE), rep, axis=2)
    dt = jax.nn.softplus(dt.astype(jnp.float32) + dt_bias.astype(jnp.float32))
    dt = dt * valid.astype(jnp.float32)[None, :, None]
    a = -jnp.exp(a_log.astype(jnp.float32))
    y = ssd_chunked(xs * dt[..., None].astype(xs.dtype), dt * a, bm, cm)
    y = y + d_skip[:, None] * xs
    y = y.reshape(b, lp, SSD_WIDTH) * jax.nn.silu(z)
    return rms_norm(y, norm_g)


def retention_mixer(u, pos, norm_g):
    b, lp, _ = u.shape
    qkw = RET_HEADS * RET_DK
    q, k, v, g = jnp.split(u, [qkw, 2 * qkw, 2 * qkw + RET_WIDTH], axis=-1)
    q = rope(q.reshape(b, lp, RET_HEADS, RET_DK), pos)
    k = rope(k.reshape(b, lp, RET_HEADS, RET_DK), pos) * (RET_DK ** -0.5)
    c = lp // CHUNK
    qf = q.astype(jnp.float32).reshape(b, c, CHUNK, RET_HEADS, RET_DK)
    kf = k.astype(jnp.float32).reshape(b, c, CHUNK, RET_HEADS, RET_DK)
    vf = v.astype(jnp.float32).reshape(b, c, CHUNK, RET_HEADS, RET_DV)
    log_g = jnp.log(1.0 - 2.0 ** (-5.0 - jnp.arange(RET_HEADS, dtype=jnp.float32)))
    idx = jnp.arange(CHUNK, dtype=jnp.float32)
    diff = idx[:, None] - idx[None, :]
    dmat = jnp.exp(jnp.where(causal_tri()[..., None], diff[..., None] * log_g, -jnp.inf))
    y_in = jnp.einsum('bcijh,bcjhv->bcihv', jnp.einsum('bcihk,bcjhk->bcijh', qf, kf) * dmat, vf)
    k_dec = jnp.exp((CHUNK - 1 - idx)[:, None] * log_g)
    states = jnp.einsum('bcjhk,jh,bcjhv->bchvk', kf, k_dec, vf)
    chunk_dec = jnp.broadcast_to(jnp.exp(CHUNK * log_g), (b, c, RET_HEADS))
    s_prev = chunk_state_scan(chunk_dec, states)
    q_dec = jnp.exp((idx + 1.0)[:, None] * log_g)
    y_cross = jnp.einsum('bcihk,bchvk,ih->bcihv', qf, s_prev, q_dec)
    y = (y_in + y_cross).reshape(b, lp, RET_HEADS, RET_DV)
    y = layer_norm_heads(y, norm_g, EPS).astype(u.dtype).reshape(b, lp, RET_WIDTH)
    return jax.nn.silu(g) * y


def rwkv7_mixer(u, mu, w0, w2, a0, a2, g2, k_k, k_a, r_k, ln_g):
    b, lp, _ = u.shape
    u_prev = jnp.pad(u, ((0, 0), (1, 0), (0, 0)))[:, :-1]
    u = u + (u_prev - u) * mu
    r, k, v, wd, ad, gd = jnp.split(
        u, [RWKV_WIDTH, 2 * RWKV_WIDTH, 3 * RWKV_WIDTH, 3 * RWKV_WIDTH + RWKV_DECAY_LORA,
            3 * RWKV_WIDTH + RWKV_DECAY_LORA + RWKV_A_LORA], axis=-1)
    w = (w0 + jnp.tanh(wd) @ w2).astype(jnp.float32)
    w = -jax.nn.softplus(-w) - 0.5
    decay = jnp.exp(-jnp.exp(w))
    a = jax.nn.sigmoid(a0 + ad @ a2)
    g = jax.nn.sigmoid(gd) @ g2
    kk = k * k_k
    k = k * (1.0 + (a - 1.0) * k_a)

    def heads(t):
        return t.astype(jnp.float32).reshape(b, lp, RWKV_HEADS, RWKV_HEAD_DIM)

    rh, kh, vh, ah, dh, kkh = heads(r), heads(k), heads(v), heads(a), heads(decay), heads(kk)
    kkh = kkh / jnp.maximum(jnp.linalg.norm(kkh, axis=-1, keepdims=True), 1e-12)

    def step(s, inp):
        r_t, w_t, k_t, v_t, kk_t, b_t = inp
        sa = jnp.einsum('bhvk,bhk->bhv', s, -kk_t)
        s = s * w_t[:, :, None, :] + sa[..., None] * b_t[:, :, None, :] + v_t[..., None] * k_t[:, :, None, :]
        return s, jnp.einsum('bhvk,bhk->bhv', s, r_t)

    s0 = jnp.zeros((b, RWKV_HEADS, RWKV_HEAD_DIM, RWKV_HEAD_DIM), jnp.float32)
    xs = tuple(jnp.moveaxis(t, 1, 0) for t in (rh, dh, kh, vh, kkh, kkh * ah))
    _, out = lax.scan(step, s0, xs)
    out = jnp.moveaxis(out, 0, 1)
    out = layer_norm_heads(out, ln_g, RWKV_LN_EPS)
    bonus = jnp.sum(rh * kh * r_k.astype(jnp.float32), axis=-1, keepdims=True) * vh
    out = (out + bonus).astype(u.dtype).reshape(b, lp, RWKV_WIDTH)
    return out * g


def setup_inputs(seed: int = 0) -> dict:
    key = jax.random.key(seed)
    ks = iter(jax.random.split(key, 48))
    L = DEPTH

    def nrm(shape, scale):
        return jax.random.normal(next(ks), shape, jnp.float32) * scale

    def gain(shape):
        return 1.0 + nrm(shape, 0.02)

    def unif(shape, lo, hi):
        return jax.random.uniform(next(ks), shape, jnp.float32, minval=lo, maxval=hi)

    dt0 = jnp.exp(unif((L, SSD_HEADS), math.log(1e-3), math.log(1e-1)))
    return {
        'x': nrm((BATCH, SEQ, D_MODEL), 1.0),
        'meta_tokens': nrm((N_META, D_MODEL), 1.0),
        'ffn1_norm': gain((L, D_MODEL)),
        'ffn1_w_gate': nrm((L, D_MODEL, D_FF), D_MODEL ** -0.5),
        'ffn1_w_up': nrm((L, D_MODEL, D_FF), D_MODEL ** -0.5),
        'ffn1_w_down': nrm((L, D_FF, D_MODEL), D_FF ** -0.5),
        'mix_norm': gain((L, D_MODEL)),
        'w_in': nrm((L, D_MODEL, IN_WIDTH), D_MODEL ** -0.5),
        'w_out': nrm((L, MIX_WIDTH, D_MODEL), MIX_WIDTH ** -0.5),
        'mla_q_norm': gain((L, MLA_Q_LORA)),
        'mla_w_q_up': nrm((L, MLA_Q_LORA, MLA_HEADS * MLA_QK), MLA_Q_LORA ** -0.5),
        'mla_kv_norm': gain((L, MLA_KV_LORA)),
        'mla_w_kv_up': nrm((L, MLA_KV_LORA, MLA_HEADS * (MLA_NOPE + MLA_V)), MLA_KV_LORA ** -0.5),
        'mla_qk_norm_q': gain((L, MLA_QK)),
        'mla_qk_norm_k': gain((L, MLA_QK)),
        'ssd_conv_w': nrm((L, SSD_CONV, SSD_CONV_CH), SSD_CONV ** -0.5),
        'ssd_conv_b': nrm((L, SSD_CONV_CH), 0.01),
        'ssd_dt_bias': dt0 + jnp.log(-jnp.expm1(-dt0)),
        'ssd_a_log': jnp.log(unif((L, SSD_HEADS), 1.0, 16.0)),
        'ssd_d': gain((L, SSD_HEADS)),
        'ssd_norm': gain((L, SSD_WIDTH)),
        'ret_norm': gain((L, RET_HEADS, RET_DV)),
        'rwkv_mu': unif((L, RWKV_IN), 0.0, 1.0),
        'rwkv_w0': unif((L, RWKV_WIDTH), -6.0, 0.0),
        'rwkv_w2': nrm((L, RWKV_DECAY_LORA, RWKV_WIDTH), RWKV_DECAY_LORA ** -0.5),
        'rwkv_a0': nrm((L, RWKV_WIDTH), 0.1),
        'rwkv_a2': nrm((L, RWKV_A_LORA, RWKV_WIDTH), RWKV_A_LORA ** -0.5),
        'rwkv_g2': nrm((L, RWKV_GATE_LORA, RWKV_WIDTH), RWKV_GATE_LORA ** -0.5),
        'rwkv_k_k': 0.85 + nrm((L, RWKV_WIDTH), 0.02),
        'rwkv_k_a': gain((L, RWKV_WIDTH)),
        'rwkv_r_k': nrm((L, RWKV_HEADS, RWKV_HEAD_DIM), 0.1),
        'rwkv_ln': gain((L, RWKV_HEADS, RWKV_HEAD_DIM)),
        'ffn2_norm': gain((L, D_MODEL)),
        'ffn2_w_gate': nrm((L, D_MODEL, D_FF), D_MODEL ** -0.5),
        'ffn2_w_up': nrm((L, D_MODEL, D_FF), D_MODEL ** -0.5),
        'ffn2_w_down': nrm((L, D_FF, D_MODEL), D_FF ** -0.5),
    }


def reference(x, meta_tokens, ffn1_norm, ffn1_w_gate, ffn1_w_up, ffn1_w_down, mix_norm, w_in, w_out,
              mla_q_norm, mla_w_q_up, mla_kv_norm, mla_w_kv_up, mla_qk_norm_q, mla_qk_norm_k,
              ssd_conv_w, ssd_conv_b, ssd_dt_bias, ssd_a_log, ssd_d, ssd_norm, ret_norm,
              rwkv_mu, rwkv_w0, rwkv_w2, rwkv_a0, rwkv_a2, rwkv_g2, rwkv_k_k, rwkv_k_a, rwkv_r_k, rwkv_ln,
              ffn2_norm, ffn2_w_gate, ffn2_w_up, ffn2_w_down):
    b, seq, _ = x.shape
    meta = jnp.broadcast_to(meta_tokens.astype(x.dtype)[None], (b, N_META, D_MODEL))
    h = jnp.concatenate([meta, x], axis=1)
    lp = seq + CHUNK
    pos = jnp.arange(lp, dtype=jnp.float32) - PAD
    valid = jnp.arange(lp) >= PAD
    for l in range(DEPTH):
        h = h + 0.5 * swiglu(rms_norm(h, ffn1_norm[l]), ffn1_w_gate[l], ffn1_w_up[l], ffn1_w_down[l])
        u = rms_norm(h, mix_norm[l]) @ w_in[l]
        u = jnp.pad(u, ((0, 0), (PAD, 0), (0, 0)))
        u_mla, u_ssd, u_ret, u_rwkv = jnp.split(
            u, [MLA_IN, MLA_IN + SSD_IN, MLA_IN + SSD_IN + RET_IN], axis=-1)
        y = jnp.concatenate([
            mla_mixer(u_mla, pos, valid, mla_q_norm[l], mla_w_q_up[l], mla_kv_norm[l], mla_w_kv_up[l],
                      mla_qk_norm_q[l], mla_qk_norm_k[l]),
            ssd_mixer(u_ssd, valid, ssd_conv_w[l], ssd_conv_b[l], ssd_dt_bias[l], ssd_a_log[l],
                      ssd_d[l], ssd_norm[l]),
            retention_mixer(u_ret, pos, ret_norm[l]),
            rwkv7_mixer(u_rwkv, rwkv_mu[l], rwkv_w0[l], rwkv_w2[l], rwkv_a0[l], rwkv_a2[l], rwkv_g2[l],
                        rwkv_k_k[l], rwkv_k_a[l], rwkv_r_k[l], rwkv_ln[l]),
        ], axis=-1)[:, PAD:]
        h = h + y @ w_out[l]
        h = h + 0.5 * swiglu(rms_norm(h, ffn2_norm[l]), ffn2_w_gate[l], ffn2_w_up[l], ffn2_w_down[l])
    return h[:, N_META:]
```

```cpp
#include <hip/hip_runtime.h>
#include <cstdio>
#include <cstdint>

#define GAS __attribute__((address_space(1)))
#define LAS __attribute__((address_space(3)))
typedef unsigned short bf16;
typedef unsigned v4u __attribute__((ext_vector_type(4)));
typedef unsigned v2u __attribute__((ext_vector_type(2)));
typedef float f32x4 __attribute__((ext_vector_type(4)));
typedef float f32x2 __attribute__((ext_vector_type(2)));
typedef float f32x16 __attribute__((ext_vector_type(16)));
typedef short bf16x8 __attribute__((ext_vector_type(8)));

constexpr int D = 2048, SEQ = 8192, NMETA = 16, T = SEQ + NMETA, MP = 8448, DFF = 5632, DEPTH = 4;
constexpr int NIN = 5320, NINP = 5376, NCH = 65, TSEQ = 8320, MLAN = 1792;
constexpr int U_MLA = 0, U_SSD = 576, U_RET = 2120, U_RWKV = 3656;
constexpr float EPS = 1e-6f;
constexpr int NWAVES = 8, NTHR = 512;
#ifndef EN_MLA
#define EN_MLA 1
#endif
#ifndef EN_SSD
#define EN_SSD 1
#endif
#ifndef EN_RET
#define EN_RET 1
#endif
#ifndef EN_RWKV
#define EN_RWKV 1
#endif
#ifndef PROBE_NOSCAN
#define PROBE_NOSCAN 0
#endif
#ifndef PROBE_ATTCOPY
#define PROBE_ATTCOPY 0
#endif
#ifndef PROBE_COPY_META
#define PROBE_COPY_META 0
#endif
#ifndef DUP_VAR
#define DUP_VAR 0
#endif
#ifndef PER_PHASE_LAUNCH
#define PER_PHASE_LAUNCH 0
#endif
constexpr int NPHASE = 1 + 8 * 2 + 4 * 7;

constexpr size_t O_CTL = 0, SZ_CTL = 13107200;
constexpr int CW_BAR = 4096;
constexpr size_t O_SS = 65536;
constexpr size_t O_WGU = O_CTL + SZ_CTL,                 SZ_WGU = (size_t)8 * 2 * DFF * D * 2;
constexpr size_t O_WD = O_WGU + SZ_WGU,                  SZ_WD = (size_t)8 * D * DFF * 2;
constexpr size_t O_WIN = O_WD + SZ_WD,                   SZ_WIN = (size_t)4 * NINP * D * 2;
constexpr size_t O_WOUT = O_WIN + SZ_WIN,                SZ_WOUT = (size_t)4 * D * D * 2;
constexpr size_t O_WMLA = O_WOUT + SZ_WOUT,              SZ_WMLA = (size_t)4 * MLAN * 512 * 2;
constexpr size_t O_H = O_WMLA + SZ_WMLA,                 SZ_H = (size_t)MP * D * 4;
constexpr size_t O_HB = O_H + SZ_H,                      SZ_HB = (size_t)MP * D * 2;
constexpr size_t O_U = O_HB + SZ_HB,                     SZ_U = (size_t)MP * NINP * 4;
constexpr size_t O_ACT = O_U;
constexpr size_t O_AMLA = O_U + SZ_U,                    SZ_AMLA = (size_t)MP * 512 * 2;
constexpr size_t O_QKV = O_AMLA + SZ_AMLA,               SZ_QKV = (size_t)MP * MLAN * 4;
constexpr size_t O_Q = O_QKV + SZ_QKV,                   SZ_Q = (size_t)TSEQ * 768 * 2;
constexpr size_t O_K = O_Q + SZ_Q;
constexpr size_t O_VT = O_K + SZ_Q,                      SZ_VT = (size_t)4 * 128 * TSEQ * 2;
constexpr size_t O_Y = O_VT + SZ_VT,                     SZ_Y = (size_t)MP * D * 2;
constexpr size_t O_XBC = O_Y + SZ_Y,                     SZ_XBC = (size_t)MP * 1024 * 4;
constexpr size_t O_DT = O_XBC + SZ_XBC,                  SZ_DT = (size_t)MP * 8 * 4;
constexpr size_t O_LA = O_DT + SZ_DT;
constexpr size_t O_SST = O_LA + SZ_DT,                   SZ_SST = (size_t)NCH * 8 * 64 * 128 * 4;
constexpr size_t O_SDEC = O_SST + SZ_SST,                SZ_SDEC = (size_t)NCH * 8 * 128;
constexpr size_t O_YZ = O_SDEC + SZ_SDEC,                SZ_YZ = (size_t)MP * 512 * 4;
constexpr size_t O_RQK = O_YZ + SZ_YZ,                   SZ_RQK = (size_t)MP * 512 * 4;
constexpr size_t O_RST = O_RQK + SZ_RQK,                 SZ_RST = (size_t)NCH * 4 * 128 * 64 * 4;
constexpr size_t O_RW = O_RST + SZ_RST,                  SZ_RW1 = (size_t)MP * 512 * 4;
constexpr size_t O_RBON = O_RW + 8 * SZ_RW1,             SZ_RBON = (size_t)MP * 8 * 4;
constexpr size_t O_ROPE = O_RBON + SZ_RBON,              SZ_ROPE = (size_t)MP * 32 * 8;
constexpr size_t O_MATS = O_ROPE + SZ_ROPE,             SZ_MATS = (size_t)129 * 8 * 16384 * 4;
constexpr size_t O_SSTATE = O_RW + 7 * SZ_RW1;
constexpr size_t WS_END = O_MATS + SZ_MATS;
static_assert((size_t)129 * 8 * 4096 * 4 <= SZ_RW1, "sstate");
static_assert(WS_END <= 1424122240ull, "d_ws map too large");
static_assert(O_SS + (size_t)12 * MP * 32 * 4 <= SZ_CTL, "ctl map");
static_assert((size_t)MP * DFF * 2 <= SZ_U, "act overlays u");

constexpr int RING_BYTES = 131072;
constexpr int LDSCTL_OFF = 143360;
constexpr int LDS_BYTES = 147456;

#define LDS_WAIT() asm volatile("s_waitcnt lgkmcnt(0)" ::: "memory")
#define LBAR() do { asm volatile("s_waitcnt lgkmcnt(0)" ::: "memory"); __builtin_amdgcn_s_barrier(); asm volatile("" ::: "memory"); } while (0)
constexpr int CW_QUEUE = 8192;
#define VM_WAIT() asm volatile("s_waitcnt vmcnt(0)" ::: "memory")
__device__ __forceinline__ unsigned f2bf(float f) { unsigned u = __builtin_bit_cast(unsigned, f); return (u + 0x7fffu + ((u >> 16) & 1u)) >> 16; }
__device__ __forceinline__ unsigned pk2(float lo, float hi) { return f2bf(lo) | (f2bf(hi) << 16); }
typedef __bf16 bf16x2_t __attribute__((ext_vector_type(2)));
__device__ __forceinline__ unsigned cvtpk(float lo, float hi) { const f32x2 v = {lo, hi}; return __builtin_bit_cast(unsigned, __builtin_convertvector(v, bf16x2_t)); }
__device__ __forceinline__ int lane_id() { unsigned ones = ~0u; asm volatile("" : "+s"(ones)); return (int)__builtin_amdgcn_mbcnt_hi(ones, __builtin_amdgcn_mbcnt_lo(ones, 0u)); }
__device__ __forceinline__ float wave_sum(float v) {
#pragma unroll
    for (int o = 1; o < 64; o <<= 1) v += __shfl_xor(v, o);
    return v;
}
__device__ __forceinline__ float sigmoidf_(float x) { return 1.0f / (1.0f + __expf(-x)); }
__device__ __forceinline__ float siluf_(float x) { return x / (1.0f + __expf(-x)); }
__device__ __forceinline__ float softplusf_(float x) { return x > 20.f ? x : log1pf(expf(x)); }
struct UB { const bf16* p;
    __device__ __forceinline__ float operator[](size_t i) const { return __builtin_bit_cast(float, (unsigned)p[i] << 16); }
    __device__ __forceinline__ UB operator+(size_t o) const { return UB{p + o}; } };
__device__ __forceinline__ f32x4 ldu4(const UB u) { const v2u w = *(const v2u*)u.p;
    return (f32x4){__builtin_bit_cast(float, w.x << 16), __builtin_bit_cast(float, w.x & 0xffff0000u), __builtin_bit_cast(float, w.y << 16), __builtin_bit_cast(float, w.y & 0xffff0000u)}; }
__device__ __forceinline__ int row_of_seq(int s) { return s < NMETA ? SEQ + s : s - NMETA; }
__device__ __forceinline__ int seq_of_row(int r) { return r >= SEQ ? r - SEQ : r + NMETA; }
__device__ __forceinline__ int prev_row(int r) { return r == SEQ ? -1 : (r == 0 ? T - 1 : r - 1); }
__device__ __forceinline__ int crow(int c, int p) { return c == 0 ? (p >= 112 ? SEQ + p - 112 : -1) : 128 * (c - 1) + p; }
namespace pg8 {
#define PG8_LAS __attribute__((address_space(3)))
typedef unsigned short bf16_t;
typedef short bf16x8 __attribute__((ext_vector_type(8)));
typedef float f32x4 __attribute__((ext_vector_type(4)));
typedef unsigned u32x4 __attribute__((ext_vector_type(4)));
constexpr int BM = 256, BK = 64, HALF = 128, HTB = HALF * BK * 2  , STAGE_BYTES = 8 * HTB, NXCD = 8, WGM = 8;

__host__ __device__ __forceinline__ int lds_byte(int r, int c) { const int st = (r >> 4) * 2 + (c >> 5), rr = r & 15, cc = c & 31, ob = rr * 64 + cc * 2; return st * 1024 + (ob ^ (((ob >> 9) & 1) << 5)); }
__host__ __device__ __forceinline__ void stage_rc(int b, int& R, int& C) { const int st = b / 1024, sb = b % 1024, swz = sb ^ (((sb >> 9) & 1) << 5); R = (st >> 1) * 16 + swz / 64; C = (st & 1) * 32 + (swz % 64) / 2; }
__host__ __device__ __forceinline__ int perm32(int rho) { const int n = rho >> 4, i = rho & 15; return 8 * (i >> 2) + 4 * n + (i & 3); }

struct Unit { int pm, pn, ah; };
struct Gemm { const bf16_t* A; const bf16_t* Bt; int M, N, K, lda, ldb, wv; };

struct StaticOrder {
    int nM, nN, nwg, G, c, lim, hmbase;
    __host__ __device__ void init(int M, int N, int G_, int c_) { nM = M / BM; nN = N / BM; nwg = nM * nN; G = G_; c = c_; lim = nwg; hmbase = -1; }
    __host__ __device__ bool next(int i, Unit& u) const {
        long L; u.ah = 0;
        if (hmbase >= 0) { if (i > 0) return false; L = hmbase + (c >> 1); u.ah = c & 1; if (L >= nwg) return false; }
        else { L = (long)i * G + c; if (L >= lim) return false; }
        int wgid = (int)L; { const int q = nwg / NXCD, r = nwg % NXCD, xcd = wgid % NXCD, off = wgid / NXCD; wgid = (xcd < r ? xcd * (q + 1) : r * (q + 1) + (xcd - r) * q) + off; }
        const int nig = WGM * nN, gid = wgid / nig, fm = gid * WGM, gsz = (nM - fm) < WGM ? (nM - fm) : WGM;
        u.pm = fm + ((wgid % nig) % gsz); u.pn = (wgid % nig) / gsz; return true;
    }
    __device__ __forceinline__ void a_ready(const Unit&) const {}
    __device__ __forceinline__ void done(const Unit&) const {}
};

__device__ __forceinline__ unsigned cvt_pk_bf16(float lo, float hi) { unsigned r; asm volatile("v_cvt_pk_bf16_f32 %0, %1, %2" : "=v"(r) : "v"(lo), "v"(hi)); return r; }

template <class Epi, class Sched, bool ALIGN_EPI = false, bool SP2 = false, bool HM = false>
__device__ __forceinline__ void gemm_phase(PG8_LAS unsigned char* lds, const Gemm g, const Sched& S, const Epi& E) {
    int tid = g.wv * 64 + lane_id(); asm volatile("" : "+v"(tid)); const int wid = g.wv, lane = tid & 63, wr = wid >> 2, wc = wid & 3, fr = lane & 15, fq = lane >> 4;
    const int K = g.K, nt = K / BK;
    unsigned voffA[2], voffB[2];
#pragma unroll
    for (int i = 0; i < 2; ++i) { int R, C; stage_rc(tid * 16 + i * 8192, R, C); const int Rb = Epi::PERM ? ((R & ~31) + perm32(R & 31)) : R;
        voffA[i] = (unsigned)(R * g.lda + C) * 2u; voffB[i] = (unsigned)(Rb * g.ldb + C) * 2u; }
    const size_t kstep = (size_t)(BK * 2);
    const size_t hA = (size_t)HALF * g.lda * 2, hB = (size_t)HALF * g.ldb * 2;
    const size_t tA = 2 * hA, tB = 2 * hB;
    const unsigned ldsw = (unsigned)wid * 1024u;
    const int aoff = lds_byte(wr * 64 + fr, fq * 8), boff = lds_byte(wc * 32 + fr, fq * 8);
#define PG8_SA(b, h) (((b) * 2 + (h)) * HTB)
#define PG8_SB(b, h) ((4 + (b) * 2 + (h)) * HTB)
#define PG8_STAGE(bufoff, gbase, voff) do { _Pragma("unroll") for (int _i = 0; _i < 2; ++_i) \
        __builtin_amdgcn_global_load_lds((const unsigned*)((const char*)(gbase) + (voff)[_i]), (PG8_LAS unsigned*)(lds + (bufoff) + ldsw + _i * 8192), 16, 0, 0); } while (0)
#define PG8_LDA(dst, b, h) do { _Pragma("unroll") for (int m = 0; m < 4; ++m) _Pragma("unroll") for (int k = 0; k < 2; ++k) dst[m][k] = *(const PG8_LAS bf16x8*)(lds + PG8_SA(b, h) + aoff + m * 2048 + k * 1024); } while (0)
#define PG8_LDB(dst, b, h) do { _Pragma("unroll") for (int n = 0; n < 2; ++n) _Pragma("unroll") for (int k = 0; k < 2; ++k) dst[n][k] = *(const PG8_LAS bf16x8*)(lds + PG8_SB(b, h) + boff + n * 2048 + k * 1024); } while (0)
#define PG8_MMA(ai, bj, At, Bt) do { __builtin_amdgcn_s_setprio(1); _Pragma("unroll") for (int m = 0; m < 4; ++m) _Pragma("unroll") for (int n = 0; n < 2; ++n) _Pragma("unroll") for (int k = 0; k < 2; ++k) \
        acc[ai][bj][m][n] = __builtin_amdgcn_mfma_f32_16x16x32_bf16(Bt[n][k], At[m][k], acc[ai][bj][m][n], 0, 0, 0); __builtin_amdgcn_s_setprio(0); } while (0)
#define PG8_WAIT_V(n) asm volatile("s_waitcnt vmcnt(" #n ")" ::: "memory")
#define PG8_WAIT_L(n) asm volatile("s_waitcnt lgkmcnt(" #n ")" ::: "memory")
#define PG8_BAR __builtin_amdgcn_s_barrier()
#define PG8_SCHED __builtin_amdgcn_sched_barrier(0)
    Unit cur, nxt; int ui = 0;
    if (!S.next(0, cur)) return;
    f32x4 acc[2][2][4][2];
#pragma unroll
    for (int a = 0; a < 2; ++a)
#pragma unroll
        for (int b = 0; b < 2; ++b)
#pragma unroll
            for (int m = 0; m < 4; ++m)
#pragma unroll
                for (int n = 0; n < 2; ++n) acc[a][b][m][n] = (f32x4){0.f, 0.f, 0.f, 0.f};
    bf16x8 At[4][2], B0[2][2], B1[2][2];
    const char* cA = (const char*)g.A + (size_t)cur.pm * tA + (size_t)cur.ah * hA; const char* cB = (const char*)g.Bt + (size_t)cur.pn * tB;
    S.a_ready(cur);
    if constexpr (SP2) {
        PG8_STAGE(PG8_SB(0, 0), cB, voffB); PG8_STAGE(PG8_SB(0, 1), cB + hB, voffB); PG8_STAGE(PG8_SA(0, 0), cA, voffA); PG8_STAGE(PG8_SA(0, 1), cA + hA, voffA);
        if (wr == 1) PG8_BAR;
        PG8_WAIT_V(2); PG8_BAR;
        PG8_STAGE(PG8_SB(1, 0), cB + kstep, voffB); PG8_STAGE(PG8_SA(1, 0), cA + kstep, voffA); PG8_STAGE(PG8_SB(1, 1), cB + hB + kstep, voffB);
        PG8_WAIT_V(6); PG8_BAR;
    } else {
        PG8_STAGE(PG8_SB(0, 0), cB, voffB); PG8_STAGE(PG8_SA(0, 0), cA, voffA); PG8_STAGE(PG8_SB(0, 1), cB + hB, voffB); PG8_STAGE(PG8_SA(0, 1), cA + hA, voffA);
        if (wr == 1) PG8_BAR;
        PG8_WAIT_V(4); PG8_BAR;
        PG8_STAGE(PG8_SB(1, 0), cB + kstep, voffB); PG8_STAGE(PG8_SA(1, 0), cA + kstep, voffA); PG8_STAGE(PG8_SB(1, 1), cB + hB + kstep, voffB);
        PG8_WAIT_V(6); PG8_BAR;
    }
    for (;;) {
        const bool has_next = S.next(ui + 1, nxt);
        const char* nA = has_next ? (const char*)g.A + (size_t)nxt.pm * tA + (size_t)nxt.ah * hA : cA; const char* nB = has_next ? (const char*)g.Bt + (size_t)nxt.pn * tB : cB;
        for (int t = 0; t < nt; t += 2) {
            const bool last = (t == nt - 2);
            const char* a1 = cA + (size_t)(t + 1) * kstep;
            const char* a2 = last ? nA : cA + (size_t)(t + 2) * kstep; const char* b2 = last ? nB : cB + (size_t)(t + 2) * kstep;
            const char* a3 = a2 + kstep; const char* b3 = b2 + kstep;
            if (last && has_next) S.a_ready(nxt);
            if constexpr (SP2) {
            PG8_LDB(B0, 0, 0); PG8_LDB(B1, 0, 1); PG8_SCHED; PG8_LDA(At, 0, 0); PG8_STAGE(PG8_SA(1, 1), a1 + hA, voffA);
            PG8_WAIT_V(8); PG8_WAIT_L(0); PG8_BAR; PG8_MMA(0, 0, At, B0); PG8_MMA(0, 1, At, B1); PG8_BAR; PG8_SCHED;
            if constexpr (!HM) PG8_LDA(At, 0, 1); PG8_STAGE(PG8_SB(0, 0), b2, voffB); PG8_STAGE(PG8_SB(0, 1), b2 + hB, voffB); PG8_STAGE(PG8_SA(0, 0), a2, voffA);
            PG8_WAIT_V(8); PG8_WAIT_L(0); PG8_BAR; if constexpr (!HM) { PG8_MMA(1, 0, At, B0); PG8_MMA(1, 1, At, B1); } PG8_BAR; PG8_SCHED;
            PG8_LDB(B0, 1, 0); PG8_LDB(B1, 1, 1); PG8_SCHED; PG8_LDA(At, 1, 0); PG8_STAGE(PG8_SA(0, 1), a2 + hA, voffA);
            PG8_WAIT_V(8); PG8_WAIT_L(0); PG8_BAR; PG8_MMA(0, 0, At, B0); PG8_MMA(0, 1, At, B1); PG8_BAR; PG8_SCHED;
            if constexpr (!HM) PG8_LDA(At, 1, 1); PG8_STAGE(PG8_SB(1, 0), b3, voffB); PG8_STAGE(PG8_SB(1, 1), b3 + hB, voffB); PG8_STAGE(PG8_SA(1, 0), a3, voffA);
            PG8_WAIT_V(8); PG8_WAIT_L(0); PG8_BAR; if constexpr (!HM) { PG8_MMA(1, 0, At, B0); PG8_MMA(1, 1, At, B1); } PG8_BAR; PG8_SCHED;
            } else {
            PG8_LDB(B0, 0, 0); PG8_SCHED; PG8_LDA(At, 0, 0); PG8_STAGE(PG8_SA(1, 1), a1 + hA, voffA);
            PG8_WAIT_L(8); PG8_BAR; PG8_WAIT_L(0); PG8_MMA(0, 0, At, B0); PG8_BAR; PG8_SCHED;
            PG8_LDB(B1, 0, 1); PG8_STAGE(PG8_SB(0, 0), b2, voffB);
            PG8_BAR; PG8_WAIT_L(0); PG8_MMA(0, 1, At, B1); PG8_BAR;
            PG8_LDA(At, 0, 1); PG8_STAGE(PG8_SA(0, 0), a2, voffA);
            PG8_BAR; PG8_WAIT_L(0); PG8_MMA(1, 0, At, B0); PG8_BAR; PG8_SCHED;
            PG8_STAGE(PG8_SB(0, 1), b2 + hB, voffB);
            PG8_WAIT_V(6); PG8_BAR; PG8_MMA(1, 1, At, B1); PG8_BAR;
            PG8_LDB(B0, 1, 0); PG8_SCHED; PG8_LDA(At, 1, 0); PG8_STAGE(PG8_SA(0, 1), a2 + hA, voffA);
            PG8_WAIT_L(8); PG8_BAR; PG8_WAIT_L(0); PG8_MMA(0, 0, At, B0); PG8_BAR; PG8_SCHED;
            PG8_LDB(B1, 1, 1); PG8_STAGE(PG8_SB(1, 0), b3, voffB);
            PG8_BAR; PG8_WAIT_L(0); PG8_MMA(0, 1, At, B1); PG8_BAR;
            PG8_LDA(At, 1, 1); PG8_STAGE(PG8_SA(1, 0), a3, voffA);
            PG8_BAR; PG8_WAIT_L(0); PG8_MMA(1, 0, At, B0); PG8_BAR; PG8_SCHED;
            PG8_STAGE(PG8_SB(1, 1), b3 + hB, voffB);
            PG8_WAIT_V(6); PG8_BAR; PG8_MMA(1, 1, At, B1); PG8_BAR;
            }
        }
        if constexpr (ALIGN_EPI) { if (wr == 0) PG8_BAR; }
        if constexpr (!Epi::AFTER_DRAIN) { E(acc, cur, wr, wc, fr, fq); S.done(cur); }
        if (!has_next) break;
#pragma unroll
        for (int a = 0; a < 2; ++a)
#pragma unroll
            for (int b = 0; b < 2; ++b)
#pragma unroll
                for (int m = 0; m < 4; ++m)
#pragma unroll
                    for (int n = 0; n < 2; ++n) acc[a][b][m][n] = (f32x4){0.f, 0.f, 0.f, 0.f};
        cur = nxt; cA = nA; cB = nB; ++ui;
        if constexpr (ALIGN_EPI) { if (wr == 1) PG8_BAR; }
    }
    PG8_WAIT_V(0);
    if constexpr (!ALIGN_EPI) { if (wr == 0) PG8_BAR; }
    PG8_BAR;
    if constexpr (Epi::AFTER_DRAIN) { E.fused(acc, cur, wr, wc, fr, fq, lds, wid, lane); S.done(cur); }
#undef PG8_SA
#undef PG8_SB
#undef PG8_STAGE
#undef PG8_LDA
#undef PG8_LDB
#undef PG8_MMA
#undef PG8_WAIT_V
#undef PG8_WAIT_L
#undef PG8_BAR
#undef PG8_SCHED
}

__device__ __forceinline__ float row_ss(const float* ss, int row, int fq) {
    const f32x4 a = *(const f32x4*)(ss + (size_t)row * 32 + 8 * fq), b = *(const f32x4*)(ss + (size_t)row * 32 + 8 * fq + 4);
    float s = ((a[0] + a[1]) + (a[2] + a[3])) + ((b[0] + b[1]) + (b[2] + b[3]));
    s += __shfl_xor(s, 16); s += __shfl_xor(s, 32); return s;
}
struct EpiScaleF32 {
    static constexpr bool PERM = false, AFTER_DRAIN = false;
    float* C; int ldc; const float* ss; float inv_d, eps;
    __device__ __forceinline__ void operator()(const f32x4 (&acc)[2][2][4][2], const Unit& u, int wr, int wc, int fr, int fq) const {
        const int row0 = u.pm * BM + wr * 64 + fr, col0 = u.pn * BM + wc * 32 + 4 * fq;
#pragma unroll
        for (int ai = 0; ai < 2; ++ai)
#pragma unroll
            for (int m = 0; m < 4; ++m) { const int row = row0 + ai * HALF + m * 16; float* rowp = C + (size_t)row * ldc + col0;
                const float rs = ss ? __builtin_amdgcn_rsqf(row_ss(ss, row, fq) * inv_d + eps) : 1.0f;
#pragma unroll
                for (int bj = 0; bj < 2; ++bj)
#pragma unroll
                    for (int n = 0; n < 2; ++n) *(f32x4*)(rowp + bj * HALF + n * 16) = acc[ai][bj][m][n] * rs; }
    }
};
struct EpiScaleBf16 {
    static constexpr bool PERM = true, AFTER_DRAIN = false;
    bf16_t* O; int ldo; const float* ss; float inv_d, eps;
    __device__ __forceinline__ void operator()(const f32x4 (&acc)[2][2][4][2], const Unit& u, int wr, int wc, int fr, int fq) const {
        const int row0 = u.pm * BM + wr * 64 + fr, col0 = u.pn * BM + wc * 32 + 8 * fq;
#pragma unroll
        for (int ai = 0; ai < 2; ++ai)
#pragma unroll
            for (int m = 0; m < 4; ++m) { const int row = row0 + ai * HALF + m * 16; const float rs = __builtin_amdgcn_rsqf(row_ss(ss, row, fq) * inv_d + eps);
#pragma unroll
                for (int bj = 0; bj < 2; ++bj) { const f32x4 v0 = acc[ai][bj][m][0] * rs, v1 = acc[ai][bj][m][1] * rs;
                    u32x4 w; w.x = cvt_pk_bf16(v0[0], v0[1]); w.y = cvt_pk_bf16(v0[2], v0[3]); w.z = cvt_pk_bf16(v1[0], v1[1]); w.w = cvt_pk_bf16(v1[2], v1[3]);
                    *(u32x4*)(O + (size_t)row * ldo + col0 + bj * HALF) = w; } }
    }
};
struct EpiSwiGLU {
    static constexpr bool PERM = true, AFTER_DRAIN = false;
    bf16_t* O; int ldo; const float* ss; float inv_d, eps; int nai;
    __device__ __forceinline__ void operator()(const f32x4 (&acc)[2][2][4][2], const Unit& u, int wr, int wc, int fr, int fq) const {
        const int row0 = u.pm * BM + u.ah * HALF + wr * 64 + fr, col0 = u.pn * HALF + wc * 32 + 8 * fq;
#pragma unroll
        for (int ai = 0; ai < 2; ++ai) { if (ai >= nai) break;
#pragma unroll
            for (int m = 0; m < 4; ++m) { const int row = row0 + ai * HALF + m * 16;
                const float rs = __builtin_amdgcn_rsqf(row_ss(ss, row, fq) * inv_d + eps);
                float o[8];
#pragma unroll
                for (int n = 0; n < 2; ++n)
#pragma unroll
                    for (int j = 0; j < 4; ++j) { const float gv = acc[ai][0][m][n][j] * rs, uv = acc[ai][1][m][n][j] * rs; o[n * 4 + j] = gv * uv * __builtin_amdgcn_rcpf(1.0f + __expf(-gv)); }
                u32x4 w; w.x = cvt_pk_bf16(o[0], o[1]); w.y = cvt_pk_bf16(o[2], o[3]); w.z = cvt_pk_bf16(o[4], o[5]); w.w = cvt_pk_bf16(o[6], o[7]);
                *(u32x4*)(O + (size_t)row * ldo + col0) = w; } }
    }
};
struct EpiResidual {
    static constexpr bool PERM = true, AFTER_DRAIN = false;
    float* H; bf16_t* HB; float* ss_out; float* out; int out_rows; float scale;
    __device__ __forceinline__ void operator()(const f32x4 (&acc)[2][2][4][2], const Unit& u, int wr, int wc, int fr, int fq) const {
        const int row0 = u.pm * BM + wr * 64 + fr, col0 = u.pn * BM + wc * 32 + 8 * fq;
#pragma unroll
        for (int ai = 0; ai < 2; ++ai)
#pragma unroll
            for (int m = 0; m < 4; ++m) { const int row = row0 + ai * HALF + m * 16; float sq = 0.f;
#pragma unroll
                for (int bj = 0; bj < 2; ++bj) { const size_t off = (size_t)row * 2048 + col0 + bj * HALF;
                    f32x4 h0 = *(const f32x4*)(H + off), h1 = *(const f32x4*)(H + off + 4);
                    h0 = h0 + acc[ai][bj][m][0] * scale; h1 = h1 + acc[ai][bj][m][1] * scale;
                    *(f32x4*)(H + off) = h0; *(f32x4*)(H + off + 4) = h1;
                    if (out && row < out_rows) { *(f32x4*)(out + off) = h0; *(f32x4*)(out + off + 4) = h1; }
                    u32x4 w; w.x = cvt_pk_bf16(h0[0], h0[1]); w.y = cvt_pk_bf16(h0[2], h0[3]); w.z = cvt_pk_bf16(h1[0], h1[1]); w.w = cvt_pk_bf16(h1[2], h1[3]);
                    *(u32x4*)(HB + off) = w;
                    sq += (h0[0] * h0[0] + h0[1] * h0[1]) + (h0[2] * h0[2] + h0[3] * h0[3]) + (h1[0] * h1[0] + h1[1] * h1[1]) + (h1[2] * h1[2] + h1[3] * h1[3]); }
                sq += __shfl_xor(sq, 16); sq += __shfl_xor(sq, 32);
                if (fq == 0 && ss_out) __hip_atomic_fetch_add(ss_out + (size_t)row * 32 + u.pn * 4 + wc, sq, __ATOMIC_RELAXED, __HIP_MEMORY_SCOPE_AGENT); }
    }
};
}
#define XB_TMO      128
#define XB_XCNT(j)  (256  + 64 * (j))
#define XB_XSUB(j)  (1280 + 64 * (j))
#define XB_XGEN(j)  (2304 + 64 * (j))
#define XB_TOP      3328
#define XB_TOPGEN   3392
#define XCD_BAR_WORDS 3456
#define XB_SPIN_CAP (1u << 18)

__device__ __forceinline__ unsigned xb_ld(unsigned* p)              { return __hip_atomic_load(p, __ATOMIC_RELAXED, __HIP_MEMORY_SCOPE_AGENT); }
__device__ __forceinline__ unsigned xb_add(unsigned* p, unsigned v) { return __hip_atomic_fetch_add(p, v, __ATOMIC_RELAXED, __HIP_MEMORY_SCOPE_AGENT); }
__device__ __forceinline__ unsigned xb_xcc_id() { return (unsigned)__builtin_amdgcn_s_getreg((3 << 11) | 20) & 0xFu; }
#define XB_SPIN(cond, bar) do { unsigned _sp = 0; while (cond) { __builtin_amdgcn_s_sleep(1); \
    if ((++_sp & 255u) == 0u) { if (xb_ld(&(bar)[XB_TMO])) break; if (_sp > XB_SPIN_CAP) { atomicAdd(&(bar)[XB_TMO], 1u); break; } } } } while (0)

struct XcdBarrier {
    unsigned* bar; unsigned x;
    volatile LAS unsigned* st;
};

__device__ __forceinline__ XcdBarrier xcd_barrier_post(unsigned* bar, volatile LAS unsigned* st, int wv) {
    XcdBarrier b; b.bar = bar; b.x = xb_xcc_id(); b.st = st;
    if ((wv == 0 && lane_id() == 0)) (void)xb_add(&bar[XB_XCNT(b.x)], 1u);
    return b;
}
__device__ __forceinline__ void xcd_barrier_complete(unsigned* bar, unsigned x, unsigned& nloc, unsigned& nx) {
    const unsigned G = gridDim.x * gridDim.y * gridDim.z;
    unsigned sum, cnt, mine, sp = 0u;
    for (;;) {
        sum = 0u; cnt = 0u; mine = 0u;
#pragma unroll
        for (unsigned j = 0; j < 16; ++j) { const unsigned c = xb_ld(&bar[XB_XCNT(j)]); sum += c; cnt += (c > 0u) ? 1u : 0u; mine = (j == x) ? c : mine; }
        if (sum == G) break;
        __builtin_amdgcn_s_sleep(1);
        if ((++sp & 255u) == 0u) { if (xb_ld(&bar[XB_TMO])) break; if (sp > XB_SPIN_CAP) { atomicAdd(&bar[XB_TMO], 1u); break; } }
    }
    nloc = mine > 0u ? mine : 1u; nx = cnt > 0u ? cnt : 1u;
}

__device__ __forceinline__ void xcd_barrier(const XcdBarrier& b, int wv) {
    asm volatile("s_waitcnt vmcnt(0)" ::: "memory");
    __syncthreads();
    if ((wv == 0 && lane_id() == 0)) {
        unsigned* bar = b.bar;
        __builtin_amdgcn_s_waitcnt(0);
        unsigned nloc = b.st[0], nx = b.st[1];
        if (nloc == 0u) { xcd_barrier_complete(bar, b.x, nloc, nx); b.st[0] = nloc; b.st[1] = nx; }
        const unsigned old = xb_add(&bar[XB_XSUB(b.x)], 1u);
        const unsigned gen = old / nloc;
        if (old + 1u == (gen + 1u) * nloc) {
            __builtin_amdgcn_fence(__ATOMIC_RELEASE, "agent");
            asm volatile("s_waitcnt vmcnt(0)" ::: "memory");
            const unsigned og = xb_add(&bar[XB_TOP], 1u);
            const unsigned tg = og / nx;
            if (og + 1u == (tg + 1u) * nx) xb_add(&bar[XB_TOPGEN], 1u);
            else XB_SPIN(xb_ld(&bar[XB_TOPGEN]) == tg, bar);
            __builtin_amdgcn_fence(__ATOMIC_ACQUIRE, "agent");
            xb_add(&bar[XB_XGEN(b.x)], 1u);
            asm volatile("s_waitcnt vmcnt(0)" ::: "memory");
        } else {
            XB_SPIN(xb_ld(&bar[XB_XGEN(b.x)]) == gen, bar);
            __builtin_amdgcn_fence(__ATOMIC_ACQUIRE, "agent");
            asm volatile("s_waitcnt vmcnt(0)" ::: "memory");
        }
    }
    __syncthreads();
}

struct P { const float* in[36]; float* out; unsigned char* ws; int ph_lo, ph_hi; };
enum { I_X = 0, I_META, I_F1N, I_F1G, I_F1U, I_F1D, I_MIXN, I_WIN, I_WOUT, I_QN, I_WQ, I_KVN, I_WKV, I_QKNQ, I_QKNK, I_CONVW, I_CONVB, I_DTB, I_ALOG, I_SSDD, I_SSDN, I_RETN,
       I_MU, I_W0, I_W2, I_A0, I_A2, I_G2, I_KK, I_KA, I_RK, I_LN, I_F2N, I_F2G, I_F2U, I_F2D };
#define CAS __attribute__((address_space(4)))
typedef const CAS P* KPtr;
struct Ctx { LAS unsigned char* lds; unsigned char* ws; KPtr kp; int tid, lane, wave, G, bid; };
__device__ __forceinline__ Ctx ctx_make(LAS unsigned char* lds, int wv) {
    Ctx F; KPtr kp = (KPtr)__builtin_amdgcn_kernarg_segment_ptr(); asm volatile("" : "+s"(kp)); int t = wv * 64 + lane_id(); asm volatile("" : "+v"(t));
    F.lds = lds; F.kp = kp; F.ws = kp->ws; F.tid = t; F.lane = t & 63; F.wave = __builtin_amdgcn_readfirstlane(t >> 6); F.G = gridDim.x; F.bid = blockIdx.x; return F;
}


__device__ __forceinline__ int queue_next(const Ctx& F, unsigned* ctr) {
    volatile LAS unsigned* slot = (volatile LAS unsigned*)(F.lds + LDSCTL_OFF + 64);
    __syncthreads();
    if (F.tid == 0) *slot = __hip_atomic_fetch_add(ctr, 1u, __ATOMIC_RELAXED, __HIP_MEMORY_SCOPE_AGENT);
    __syncthreads();
    return (int)*slot;
}
__device__ __forceinline__ f32x16 zero16() { f32x16 z;
#pragma unroll
    for (int i = 0; i < 16; ++i) z[i] = 0.f; return z; }
__device__ __forceinline__ void mma32(f32x16& acc, const LAS float* Ap, int sAi, int sAk, const LAS float* Bp, int sBk, int sBj, int K, int lane) {
    const int r = lane & 31, hh = lane >> 5;
    const LAS float* a = Ap + r * sAi + hh * sAk; const LAS float* b = Bp + hh * sBk + r * sBj;
#pragma unroll 4
    for (int k = 0; k < K; k += 2) acc = __builtin_amdgcn_mfma_f32_32x32x2f32(a[k * sAk], b[k * sBk], acc, 0, 0, 0);
}
__device__ __forceinline__ int rreg(int reg, int lane) { return (reg & 3) + 8 * (reg >> 2) + 4 * (lane >> 5); }

__device__ __forceinline__ void cvt_tile(const float* src, int srcN, const float* gain, int valid, bf16* dst, int ldd, LAS float* scr, int lane) {
    const int c4 = lane & 15, r0 = lane >> 4;
    f32x4 v[16];
#pragma unroll
    for (int i = 0; i < 16; ++i) v[i] = (4 * c4 < valid) ? *(const f32x4*)(src + (size_t)(r0 + 4 * i) * srcN + 4 * c4) : (f32x4){0.f, 0.f, 0.f, 0.f};
#pragma unroll
    for (int i = 0; i < 16; ++i) { const int kk = r0 + 4 * i; const float gk = gain ? gain[kk] : 1.0f; LAS float* d = scr + kk * 65 + 4 * c4; d[0] = v[i][0] * gk; d[1] = v[i][1] * gk; d[2] = v[i][2] * gk; d[3] = v[i][3] * gk; }
    LDS_WAIT(); asm volatile("" ::: "memory");
    const int c8 = lane & 7;
#pragma unroll
    for (int j = 0; j < 8; ++j) { const int n = (lane >> 3) + 8 * j; const LAS float* s = scr + (8 * c8) * 65 + n;
        v4u o; o.x = pk2(s[0], s[65]); o.y = pk2(s[130], s[195]); o.z = pk2(s[260], s[325]); o.w = pk2(s[390], s[455]);
        *(v4u*)(dst + (size_t)n * ldd + 8 * c8) = o; }
    LDS_WAIT(); asm volatile("" ::: "memory");
}
__device__ __forceinline__ void convert_layer(const Ctx& F, int L, int gw, int NGW) {
    LAS float* scr = (LAS float*)(F.lds + F.wave * 17408);
    const int lane = F.lane;
    constexpr int IT_GU = 2 * 32 * 176, IT_D = 2 * 88 * 32, IT_IN = 32 * 84, IT_OUT = 32 * 32, IT_MLA = 8 * 28;
    bf16* WGU = (bf16*)(F.ws + O_WGU); bf16* WD = (bf16*)(F.ws + O_WD); bf16* WIN = (bf16*)(F.ws + O_WIN); bf16* WOUT = (bf16*)(F.ws + O_WOUT); bf16* WMLA = (bf16*)(F.ws + O_WMLA);
    const int l = L;
    for (int it = gw; it < IT_GU + IT_D + IT_IN + IT_OUT + IT_MLA; it += NGW) {
        int r = it;
        if (r < IT_GU) { const int which = r / 5632, f = 2 * l + which, q = r % 5632, kb = q / 176, nb = q % 176, n0 = 64 * nb, pn = n0 >> 8, within = n0 & 255, isup = within >= 128, f0 = 128 * pn + (within & 127);
            const float* src = (which ? (isup ? F.kp->in[I_F2U] : F.kp->in[I_F2G]) : (isup ? F.kp->in[I_F1U] : F.kp->in[I_F1G])) + (size_t)l * D * DFF + (size_t)(64 * kb) * DFF + f0;
            const float* gain = (which ? F.kp->in[I_F2N] : F.kp->in[I_F1N]) + l * D + 64 * kb;
            cvt_tile(src, DFF, gain, 64, WGU + (size_t)f * 11264 * 2048 + (size_t)n0 * 2048 + 64 * kb, 2048, scr, lane); continue; }
        r -= IT_GU;
        if (r < IT_D) { const int which = r / 2816, f = 2 * l + which, q = r % 2816, kb = q / 32, nb = q % 32;
            const float* src = (which ? F.kp->in[I_F2D] : F.kp->in[I_F1D]) + (size_t)l * DFF * D + (size_t)(64 * kb) * D + 64 * nb;
            cvt_tile(src, D, nullptr, 64, WD + (size_t)f * 2048 * 5632 + (size_t)(64 * nb) * 5632 + 64 * kb, 5632, scr, lane); continue; }
        r -= IT_D;
        if (r < IT_IN) { const int q = r, kb = q / 84, nb = q % 84, n0 = 64 * nb; int valid = NIN - n0; valid = valid < 0 ? 0 : (valid > 64 ? 64 : valid);
            const float* src = F.kp->in[I_WIN] + (size_t)l * D * NIN + (size_t)(64 * kb) * NIN + n0;
            cvt_tile(src, NIN, F.kp->in[I_MIXN] + l * D + 64 * kb, valid, WIN + (size_t)l * NINP * D + (size_t)n0 * D + 64 * kb, D, scr, lane); continue; }
        r -= IT_IN;
        if (r < IT_OUT) { const int q = r, kb = q / 32, nb = q % 32;
            const float* src = F.kp->in[I_WOUT] + (size_t)l * D * D + (size_t)(64 * kb) * D + 64 * nb;
            cvt_tile(src, D, nullptr, 64, WOUT + (size_t)l * D * D + (size_t)(64 * nb) * D + 64 * kb, D, scr, lane); continue; }
        r -= IT_OUT;
        { const int q = r, kb = q / 28, nb = q % 28, n0 = 64 * nb, k0 = 64 * kb;
            const float* src; int srcN, valid;
            if (n0 < 768) { valid = k0 < 384 ? 64 : 0; src = F.kp->in[I_WQ] + (size_t)l * 384 * 768 + (size_t)k0 * 768 + n0; srcN = 768; }
            else { valid = k0 >= 384 ? 64 : 0; src = F.kp->in[I_WKV] + (size_t)l * 128 * 1024 + (size_t)(k0 - 384) * 1024 + (n0 - 768); srcN = 1024; }
            cvt_tile(src, srcN, nullptr, valid, WMLA + (size_t)l * MLAN * 512 + (size_t)n0 * 512 + k0, 512, scr, lane); }
    }
}
__device__ __forceinline__ void p0_prologue(const Ctx& F, int cvt_only) {
    const int gw = F.bid * NWAVES + F.wave, NGW = F.G * NWAVES, lane = F.lane;
    convert_layer(F, 0, gw, NGW);
    if (cvt_only) return;
    float* H = (float*)(F.ws + O_H); bf16* HB = (bf16*)(F.ws + O_HB); float* SS = (float*)(F.ws + O_SS); bf16* Y = (bf16*)(F.ws + O_Y); f32x2* ROPE = (f32x2*)(F.ws + O_ROPE);
    for (int row = gw; row < MP; row += NGW) {
        const float* src = row < SEQ ? F.kp->in[I_X] + (size_t)row * D : F.kp->in[I_META] + (size_t)(row - SEQ) * D;
        float sq = 0.f;
#pragma unroll
        for (int j = 0; j < 8; ++j) { f32x4 v = (f32x4){0.f, 0.f, 0.f, 0.f}; if (row < T) v = *(const f32x4*)(src + 256 * j + 4 * lane);
            *(f32x4*)(H + (size_t)row * D + 256 * j + 4 * lane) = v; v2u w; w.x = pk2(v[0], v[1]); w.y = pk2(v[2], v[3]); *(v2u*)(HB + (size_t)row * D + 256 * j + 4 * lane) = w;
            sq += (v[0] * v[0] + v[1] * v[1]) + (v[2] * v[2] + v[3] * v[3]); }
        sq = wave_sum(sq); if (lane == 0) __hip_atomic_fetch_add(SS + (size_t)row * 32, sq, __ATOMIC_RELAXED, __HIP_MEMORY_SCOPE_AGENT);
#ifdef PROBE_ZERO_Y
        if (true) {
#else
        if (row >= T) {
#endif
#pragma unroll
            for (int j = 0; j < 4; ++j) *(v4u*)(Y + (size_t)row * D + 512 * j + 8 * lane) = (v4u){0u, 0u, 0u, 0u}; }
#ifdef PROBE_ZERO_Y
        if (row < T && lane < 32) { const float inv = powf(10000.0f, -(float)lane / 32.0f); const float ang = (float)seq_of_row(row) * inv; float sn, cs; sincosf(ang, &sn, &cs); ROPE[row * 32 + lane] = (f32x2){cs, sn}; }
#else
        else if (lane < 32) { const float inv = powf(10000.0f, -(float)lane / 32.0f); const float ang = (float)seq_of_row(row) * inv; float sn, cs; sincosf(ang, &sn, &cs); ROPE[row * 32 + lane] = (f32x2){cs, sn}; }
#endif
    }
}

__device__ __forceinline__ void m1_unit(const Ctx& F, int l, int r0, int r1, int grp) {
    const int lane = F.lane, tid = F.tid;
    const float* U = (const float*)(F.ws + O_U);
    if (r0 < r1) { bf16* AM = (bf16*)(F.ws + O_AMLA); const float* qn = F.kp->in[I_QN] + l * 384; const float* kvn = F.kp->in[I_KVN] + l * 128;
      for (int row = r0 + F.wave; row < r1; row += NWAVES) { const float* ur = U + (size_t)row * NINP + 8 * lane; const f32x4 a = *(const f32x4*)ur, b = *(const f32x4*)(ur + 4);
        const float sq = (a[0] * a[0] + a[1] * a[1]) + (a[2] * a[2] + a[3] * a[3]) + (b[0] * b[0] + b[1] * b[1]) + (b[2] * b[2] + b[3] * b[3]);
        const float sq_q = wave_sum(lane < 48 ? sq : 0.f), sq_kv = wave_sum(lane >= 48 ? sq : 0.f);
        const float rs = lane < 48 ? 1.0f / sqrtf(sq_q * (1.0f / 384.0f) + EPS) : 1.0f / sqrtf(sq_kv * (1.0f / 128.0f) + EPS);
        const float* gp = lane < 48 ? qn + 8 * lane : kvn + 8 * (lane - 48); const f32x4 g0 = *(const f32x4*)gp, g1 = *(const f32x4*)(gp + 4);
        v4u w; w.x = pk2(a[0] * rs * g0[0], a[1] * rs * g0[1]); w.y = pk2(a[2] * rs * g0[2], a[3] * rs * g0[3]); w.z = pk2(b[0] * rs * g1[0], b[1] * rs * g1[1]); w.w = pk2(b[2] * rs * g1[2], b[3] * rs * g1[3]);
        *(v4u*)(AM + (size_t)row * 512 + 8 * lane) = w; } }
    if (r0 < r1) { float* XBC = (float*)(F.ws + O_XBC); float* DT = (float*)(F.ws + O_DT); float* LA = (float*)(F.ws + O_LA);
      const float* cw = F.kp->in[I_CONVW] + l * 4096; const float* cb = F.kp->in[I_CONVB] + l * 1024;
      for (int row = r0 + F.wave; row < r1; row += NWAVES) { const int p1 = prev_row(row), p2 = p1 >= 0 ? prev_row(p1) : -1, p3 = p2 >= 0 ? prev_row(p2) : -1;
#pragma unroll
        for (int j = 0; j < 4; ++j) { const int ch = 256 * j + 4 * lane; const size_t uo = U_SSD + 512 + ch; const f32x4 z4 = (f32x4){0.f, 0.f, 0.f, 0.f};
            const f32x4 x3 = *(const f32x4*)(U + (size_t)row * NINP + uo), x2 = p1 >= 0 ? *(const f32x4*)(U + (size_t)p1 * NINP + uo) : z4, x1 = p2 >= 0 ? *(const f32x4*)(U + (size_t)p2 * NINP + uo) : z4, x0 = p3 >= 0 ? *(const f32x4*)(U + (size_t)p3 * NINP + uo) : z4;
            f32x4 o = *(const f32x4*)(cb + ch) + *(const f32x4*)(cw + ch) * x0 + *(const f32x4*)(cw + 1024 + ch) * x1 + *(const f32x4*)(cw + 2048 + ch) * x2 + *(const f32x4*)(cw + 3072 + ch) * x3;
            o[0] = siluf_(o[0]); o[1] = siluf_(o[1]); o[2] = siluf_(o[2]); o[3] = siluf_(o[3]);
            *(f32x4*)(XBC + (size_t)row * 1024 + ch) = o; }
        if (lane < 8) { const float dt = softplusf_(U[(size_t)row * NINP + U_SSD + 1536 + lane] + F.kp->in[I_DTB][l * 8 + lane]); DT[row * 8 + lane] = dt; LA[row * 8 + lane] = -expf(F.kp->in[I_ALOG][l * 8 + lane]) * dt; } } }
    if (r0 < r1) { float* RQK = (float*)(F.ws + O_RQK); const f32x2* ROPE = (const f32x2*)(F.ws + O_ROPE);
      for (int row = r0 + F.wave; row < r1; row += NWAVES) {
#pragma unroll
        for (int j = 0; j < 4; ++j) { const int idx = lane + 64 * j, qk = idx >> 7, hh = (idx >> 5) & 3, i = idx & 31; const f32x2 cs = ROPE[row * 32 + i];
            const float x1 = U[(size_t)row * NINP + U_RET + qk * 256 + hh * 64 + i], x2 = U[(size_t)row * NINP + U_RET + qk * 256 + hh * 64 + 32 + i]; const float sc = qk ? 0.125f : 1.0f;
            RQK[(size_t)row * 512 + qk * 256 + hh * 64 + i] = (x1 * cs.x - x2 * cs.y) * sc; RQK[(size_t)row * 512 + qk * 256 + hh * 64 + 32 + i] = (x1 * cs.y + x2 * cs.x) * sc; } } }
    if (grp >= 0) { LAS float* xl = (LAS float*)F.lds; const int hd = F.wave, col = lane & 31;
      float* RW = (float*)(F.ws + O_RW); const size_t AS = (size_t)MP * 512; float* RBON = (float*)(F.ws + O_RBON);
      const float* MU = F.kp->in[I_MU] + l * 1664; const float* W2 = F.kp->in[I_W2] + l * 32 * 512; const float* A2 = F.kp->in[I_A2] + l * 32 * 512; const float* G2 = F.kp->in[I_G2] + l * 64 * 512;
      const int r0 = 64 * grp;
      __syncthreads();
#pragma unroll 4
      for (int j = 0; j < 16; ++j) { const int idx = tid + 512 * j, tk = idx >> 7, cl = idx & 127, row = r0 + tk; float xs = 0.f;
          if (row < T) { const int pr = prev_row(row); const size_t uc = U_RWKV + 1536 + cl; const float x = U[(size_t)row * NINP + uc], xp = pr >= 0 ? U[(size_t)pr * NINP + uc] : 0.f; xs = x + (xp - x) * MU[1536 + cl];
              if (cl < 32) xs = tanhf(xs); else if (cl >= 64) xs = sigmoidf_(xs); }
          xl[tk * 132 + cl] = xs; }
      __syncthreads();
      float w0c[2], a0c[2], kkc[2], kac[2], rkc[2], muR[2], muK[2], muV[2];
#pragma unroll
      for (int ct = 0; ct < 2; ++ct) { const int ch = 64 * hd + 32 * ct + col; w0c[ct] = F.kp->in[I_W0][l * 512 + ch]; a0c[ct] = F.kp->in[I_A0][l * 512 + ch]; kkc[ct] = F.kp->in[I_KK][l * 512 + ch]; kac[ct] = F.kp->in[I_KA][l * 512 + ch]; rkc[ct] = F.kp->in[I_RK][l * 512 + ch];
          muR[ct] = MU[ch]; muK[ct] = MU[512 + ch]; muV[ct] = MU[1024 + ch]; }
      for (int tb = 0; tb < 2; ++tb) { if (r0 + 32 * tb >= T) break;
          f32x16 aw[2], aa[2], ag[2];
#pragma unroll
          for (int ct = 0; ct < 2; ++ct) { aw[ct] = zero16(); aa[ct] = zero16(); ag[ct] = zero16(); }
          const LAS float* xa = xl + (32 * tb + col) * 132 + (lane >> 5); const int chb = 64 * hd + col, kh = lane >> 5;
#pragma unroll 8
          for (int t = 0; t < 16; ++t) { const int j = 2 * t + kh; const float x = xa[2 * t]; aw[0] = __builtin_amdgcn_mfma_f32_32x32x2f32(x, W2[j * 512 + chb], aw[0], 0, 0, 0); aw[1] = __builtin_amdgcn_mfma_f32_32x32x2f32(x, W2[j * 512 + chb + 32], aw[1], 0, 0, 0); }
#pragma unroll 8
          for (int t = 0; t < 16; ++t) { const int j = 2 * t + kh; const float x = xa[32 + 2 * t]; aa[0] = __builtin_amdgcn_mfma_f32_32x32x2f32(x, A2[j * 512 + chb], aa[0], 0, 0, 0); aa[1] = __builtin_amdgcn_mfma_f32_32x32x2f32(x, A2[j * 512 + chb + 32], aa[1], 0, 0, 0); }
#pragma unroll 8
          for (int t = 0; t < 32; ++t) { const int j = 2 * t + kh; const float x = xa[64 + 2 * t]; ag[0] = __builtin_amdgcn_mfma_f32_32x32x2f32(x, G2[j * 512 + chb], ag[0], 0, 0, 0); ag[1] = __builtin_amdgcn_mfma_f32_32x32x2f32(x, G2[j * 512 + chb + 32], ag[1], 0, 0, 0); }
#pragma unroll 4
          for (int reg = 0; reg < 16; ++reg) { const int row = r0 + 32 * tb + rreg(reg, lane); if (row >= T) continue;
              const int pr = prev_row(row); float rr[2], k2[2], vv[2], kk[2], av[2], dec[2]; float nq = 0.f, bq = 0.f;
#pragma unroll
              for (int ct = 0; ct < 2; ++ct) { const float* ur = U + (size_t)row * NINP + U_RWKV + chb + 32 * ct; const float* up = U + (size_t)(pr >= 0 ? pr : 0) * NINP + U_RWKV + chb + 32 * ct;
                  float r = ur[0], k = ur[512], v = ur[1024]; const float rp = pr >= 0 ? up[0] : 0.f, kp = pr >= 0 ? up[512] : 0.f, vp = pr >= 0 ? up[1024] : 0.f;
                  r += (rp - r) * muR[ct]; k += (kp - k) * muK[ct]; v += (vp - v) * muV[ct];
                  float wr = w0c[ct] + aw[ct][reg]; wr = -softplusf_(-wr) - 0.5f; dec[ct] = expf(-expf(wr));
                  av[ct] = sigmoidf_(a0c[ct] + aa[ct][reg]);
                  kk[ct] = k * kkc[ct]; k2[ct] = k * (1.0f + (av[ct] - 1.0f) * kac[ct]); rr[ct] = r; vv[ct] = v;
                  nq += kk[ct] * kk[ct]; bq += r * k2[ct] * rkc[ct]; }
#pragma unroll
              for (int o = 1; o < 32; o <<= 1) { nq += __shfl_xor(nq, o); bq += __shfl_xor(bq, o); }
              const float inrm = 1.0f / fmaxf(sqrtf(nq), 1e-12f);
#pragma unroll
              for (int ct = 0; ct < 2; ++ct) { const size_t o = (size_t)row * 512 + chb + 32 * ct; const float kn = kk[ct] * inrm;
                  RW[o] = rr[ct]; RW[AS + o] = dec[ct]; RW[2 * AS + o] = k2[ct]; RW[3 * AS + o] = vv[ct]; RW[4 * AS + o] = -kn; RW[5 * AS + o] = kn * av[ct]; RW[6 * AS + o] = ag[ct][reg]; }
              if (col == 0) RBON[row * 8 + hd] = bq; }
      } }
}
__device__ __forceinline__ void m1_phase(const Ctx& F, int l, int qi = 1) {
    unsigned* ctr = (unsigned*)(F.ws + O_CTL) + CW_QUEUE + 64 * (4 * l + qi);
    constexpr int NG = (T + 63) / 64, NR = (T + 31) / 32;
    for (;;) { const int u = queue_next(F, ctr); if (u >= NG + NR) break;
        if (u < NG) m1_unit(F, l, 0, 0, u); else { const int r0 = 32 * (u - NG); m1_unit(F, l, r0, r0 + 32 < T ? r0 + 32 : T, -1); } }
}
constexpr int RWC = 64, NRC = (T + RWC - 1) / RWC;
__device__ __forceinline__ void rwkv_chunk_unit(const Ctx& F, int c, int h) {
    LAS float* BH = (LAS float*)F.lds; LAS float* KH = BH + 4160; LAS float* NX = KH + 4160; LAS float* RTT = NX + 4160;
    LAS float* AP = RTT + 4160; LAS float* BZ = AP + 4352; LAS float* Pm = BZ + 4160; LAS float* Qm = Pm + 4160; LAS float* Ge = Qm + 4160; LAS float* segt = Ge + 64;
    const float* RW = (const float*)(F.ws + O_RW); const size_t AS = (size_t)MP * 512; float* MATS = (float*)(F.ws + O_MATS) + (size_t)(c * 8 + h) * 16384;
    int tid = F.tid, w = F.wave; asm volatile("" : "+v"(tid), "+s"(w));
    const int lane = tid & 63, seg = tid >> 6, k = tid & 63;
    __syncthreads();
    { float p[8];
#pragma unroll
      for (int i = 0; i < 8; ++i) { const int s = RWC * c + 8 * seg + i; const float wv = s < T ? RW[AS + (size_t)row_of_seq(s) * 512 + 64 * h + k] : 1.0f; p[i] = i ? p[i - 1] * wv : wv; }
      segt[seg * 64 + k] = p[7];
      __syncthreads();
      float pre = 1.0f, tot = 1.0f;
#pragma unroll
      for (int q = 0; q < 8; ++q) { const float t = segt[q * 64 + k]; if (q < seg) pre *= t; tot *= t; }
      if (seg == 0) Ge[k] = tot;
#pragma unroll
      for (int i = 0; i < 8; ++i) { const int il = 8 * seg + i, s = RWC * c + il; const float G = pre * p[i], Gm1 = i ? pre * p[i - 1] : pre;
          float nk = 0.f, r = 0.f, b = 0.f, kk = 0.f;
          if (s < T) { const size_t o = (size_t)row_of_seq(s) * 512 + 64 * h + k; r = RW[o]; kk = RW[2 * AS + o]; nk = RW[4 * AS + o]; b = RW[5 * AS + o]; }
          const float ig = 1.0f / G;
          NX[k * 65 + il] = nk * Gm1; RTT[k * 65 + il] = r * G; BH[il * 65 + k] = b * ig; KH[il * 65 + k] = kk * ig; } }
    __syncthreads();
    { const int prod = w >> 1; const LAS float* Lm = (prod & 1) ? KH : BH; const LAS float* Rm = (prod < 2) ? NX : RTT;
#pragma unroll
      for (int t = 0; t < 2; ++t) { const int tr = w & 1, tc = t; f32x16 acc = zero16();
          mma32(acc, Lm + 32 * tr * 65, 65, 1, Rm + 32 * tc, 65, 1, 64, lane);
#pragma unroll
          for (int r = 0; r < 16; ++r) { const int j = 32 * tr + rreg(r, lane), i = 32 * tc + (lane & 31); const float v = acc[r];
              if (prod == 0) AP[j * 68 + i] = j < i ? v : 0.f; else if (prod == 1) BZ[j * 65 + i] = j < i ? v : 0.f; else if (prod == 2) Pm[j * 65 + i] = j <= i ? v : 0.f; else Qm[j * 65 + i] = j <= i ? v : 0.f; } } }
    __syncthreads();
    if (w < 2) { LAS float* Yr = (w == 0 ? NX : BZ) + lane * 65;
        for (int ib = 0; ib < 4; ++ib) { float a[16];
#pragma unroll
            for (int ii = 0; ii < 16; ++ii) a[ii] = Yr[16 * ib + ii];
            for (int j = 0; j < 16 * ib; ++j) { const float y = Yr[j]; const LAS float* ap = AP + j * 68 + 16 * ib;
                const f32x4 a0 = *(const LAS f32x4*)ap, a1 = *(const LAS f32x4*)(ap + 4), a2 = *(const LAS f32x4*)(ap + 8), a3 = *(const LAS f32x4*)(ap + 12);
#pragma unroll
                for (int q = 0; q < 4; ++q) { a[q] += y * a0[q]; a[4 + q] += y * a1[q]; a[8 + q] += y * a2[q]; a[12 + q] += y * a3[q]; } }
#pragma unroll
            for (int ii = 1; ii < 16; ++ii)
#pragma unroll
                for (int jj = 0; jj < ii; ++jj) a[ii] += a[jj] * AP[(16 * ib + jj) * 68 + 16 * ib + ii];
#pragma unroll
            for (int ii = 0; ii < 16; ++ii) Yr[16 * ib + ii] = a[ii]; } }
    __syncthreads();
    { const int rb = w >> 1;
#pragma unroll
      for (int t = 0; t < 2; ++t) { const int cb = 2 * (w & 1) + t; f32x16 acc = zero16();
          mma32(acc, (rb < 2 ? NX : BZ) + 32 * (rb & 1) * 65, 65, 1, (cb < 2 ? BH : Pm) + 32 * (cb & 1), 65, 1, 64, lane);
          float* dst = MATS + (rb < 2 ? (cb < 2 ? 0 : 8192) : (cb < 2 ? 4096 : 12288));
#pragma unroll
          for (int r = 0; r < 16; ++r) { const int row = 32 * (rb & 1) + rreg(r, lane), col = 32 * (cb & 1) + (lane & 31); float v = acc[r];
              if (rb < 2 && cb < 2) v = (v + (row == col ? 1.0f : 0.0f)) * Ge[col]; else if (rb < 2) v += RTT[row * 65 + col]; else if (cb < 2) v = (v + KH[row * 65 + col]) * Ge[col]; else v += Qm[row * 65 + col];
              dst[row * 64 + col] = v; } } }
}
template <int SV = 0>
__device__ __forceinline__ void rwkv_state_scan(const Ctx& F, int h, int rg) {
    LAS float* Sx = (LAS float*)F.lds; LAS float* tmp = Sx + 1056; LAS float* ring = tmp + 1024;
    const float* RW = (const float*)(F.ws + O_RW); const size_t AS = (size_t)MP * 512; const float* MATS = (const float*)(F.ws + O_MATS); float* SST8 = (float*)(F.ws + (SV ? O_QKV : O_SSTATE));
    const float* ZERO = (const float*)(F.ws + O_H) + (size_t)8300 * D;
    const int tid = F.tid, lane = F.lane, w = F.wave, fr = lane & 15, kq = lane >> 4, role = w >> 2, cbk = w & 3;
#define RW_DMA(cn) do { const int cc_ = (cn) < NRC ? (cn) : NRC - 1; const float* mp_ = MATS + (size_t)(cc_ * 8 + h) * 16384; LAS float* sl_ = ring + ((cn) % 3) * 9216; \
        _Pragma("unroll") for (int q_ = 0; q_ < 2; ++q_) { const int ch_ = w + 8 * q_; \
            __builtin_amdgcn_global_load_lds((const unsigned*)(mp_ + ch_ * 256 + lane * 4), (LAS unsigned*)(sl_ + ch_ * 256), 16, 0, 0); \
            __builtin_amdgcn_global_load_lds((const unsigned*)(mp_ + 4096 + ch_ * 256 + lane * 4), (LAS unsigned*)(sl_ + 4096 + ch_ * 256), 16, 0, 0); \
            const int j_ = 4 * ch_ + kq, s_ = RWC * cc_ + j_; const float* vp_ = s_ < T ? RW + 3 * AS + (size_t)row_of_seq(s_) * 512 + 64 * h + 16 * rg + fr : ZERO + fr; \
            __builtin_amdgcn_global_load_lds((const unsigned*)vp_, (LAS unsigned*)(sl_ + 8192 + ch_ * 64), 4, 0, 0); } } while (0)
    __syncthreads();
    for (int i = tid; i < 1056; i += NTHR) Sx[i] = 0.f;
    RW_DMA(0); RW_DMA(1);
    asm volatile("s_waitcnt vmcnt(0)" ::: "memory");
    __syncthreads();
    for (int c = 0; c < NRC; ++c) {
        if (SV != 1) RW_DMA(c + 2);
        { const int idx = 2 * tid, v = idx >> 6, kk = idx & 63; const f32x2 sv = (f32x2){Sx[v * 66 + kk], Sx[v * 66 + kk + 1]}; *(f32x2*)(SST8 + ((size_t)(c * 8 + h) * 64 + 16 * rg + v) * 64 + kk) = sv; }
        const LAS float* sl = ring + (c % 3) * 9216;
        float av[16], bv[16]; f32x4 acc = (f32x4){0.f, 0.f, 0.f, 0.f}, acc2 = acc;
        if (role == 0) { const LAS float* mb = sl + 16 * cbk + fr;
#pragma unroll
            for (int t = 0; t < 16; ++t) { av[t] = Sx[fr * 66 + 4 * t + kq]; bv[t] = mb[(4 * t + kq) * 64]; }
        } else { const LAS float* wb = sl + 4096 + 16 * cbk + fr; const LAS float* vt = sl + 8192 + fr;
#pragma unroll
            for (int t = 0; t < 16; ++t) { av[t] = vt[(4 * t + kq) * 16]; bv[t] = wb[(4 * t + kq) * 64]; } }
#pragma unroll
        for (int t = 0; t < (SV == 2 ? 2 : 16); t += 2) { acc = __builtin_amdgcn_mfma_f32_16x16x4f32(av[t], bv[t], acc, 0, 0, 0); acc2 = __builtin_amdgcn_mfma_f32_16x16x4f32(av[t + 1], bv[t + 1], acc2, 0, 0, 0); }
        acc = acc + acc2;
        if (role != 0) *(LAS f32x4*)(tmp + (cbk * 64 + lane) * 4) = acc;
        LBAR();
        if (role == 0) { acc = acc + *(const LAS f32x4*)(tmp + (cbk * 64 + lane) * 4);
#pragma unroll
            for (int r = 0; r < 4; ++r) Sx[(4 * kq + r) * 66 + 16 * cbk + fr] = acc[r]; }
        if (SV != 1) asm volatile("s_waitcnt vmcnt(8)" ::: "memory");
        LBAR();
    }
    asm volatile("s_waitcnt vmcnt(0)" ::: "memory");
#undef RW_DMA
}
__device__ __forceinline__ void rwkv_out_unit(const Ctx& F, int l, int c, int h) {
    LAS float* S_ = (LAS float*)F.lds; LAS float* E_ = S_ + 4160; LAS float* VT_ = E_ + 4096; LAS float* F_ = VT_ + 4096; LAS float* O_ = F_ + 4096;
    const float* RW = (const float*)(F.ws + O_RW); const size_t AS = (size_t)MP * 512; const float* MATS = (const float*)(F.ws + O_MATS) + (size_t)(c * 8 + h) * 16384;
    const float* SST8 = (const float*)(F.ws + O_SSTATE) + (size_t)(c * 8 + h) * 4096; const float* RBON = (const float*)(F.ws + O_RBON); bf16* Y = (bf16*)(F.ws + O_Y);
    int tid = F.tid, w = F.wave; asm volatile("" : "+v"(tid), "+s"(w)); const int lane = tid & 63;
    const f32x4 z4 = (f32x4){0.f, 0.f, 0.f, 0.f};
    f32x4 sv[2], ev[2], fv[2], tv[2];
#pragma unroll
    for (int q = 0; q < 2; ++q) { const int idx = tid + 512 * q, r = idx >> 4, c4 = idx & 15, s = RWC * c + r;
        sv[q] = *(const f32x4*)(SST8 + r * 64 + 4 * c4); ev[q] = *(const f32x4*)(MATS + 8192 + 4 * idx); fv[q] = *(const f32x4*)(MATS + 12288 + 4 * idx);
        tv[q] = s < T ? *(const f32x4*)(RW + 3 * AS + (size_t)row_of_seq(s) * 512 + 64 * h + 4 * c4) : z4; }
    const int li = tid >> 3, part = tid & 7, ls = RWC * c + li, lrow = ls < T ? row_of_seq(ls) : 0; const size_t lo = (size_t)lrow * 512 + 64 * h + 8 * part;
    f32x4 v0 = z4, v1 = z4, g0 = z4, g1 = z4; float bon = 0.f;
    if (ls < T) { v0 = *(const f32x4*)(RW + 3 * AS + lo); v1 = *(const f32x4*)(RW + 3 * AS + lo + 4); g0 = *(const f32x4*)(RW + 6 * AS + lo); g1 = *(const f32x4*)(RW + 6 * AS + lo + 4); bon = RBON[lrow * 8 + h]; }
    __syncthreads();
#pragma unroll
    for (int q = 0; q < 2; ++q) { const int idx = tid + 512 * q, r = idx >> 4, c4 = idx & 15;
        LAS float* d = S_ + r * 65 + 4 * c4; d[0] = sv[q][0]; d[1] = sv[q][1]; d[2] = sv[q][2]; d[3] = sv[q][3];
        *(LAS f32x4*)(E_ + 4 * idx) = ev[q]; *(LAS f32x4*)(F_ + 4 * idx) = fv[q]; *(LAS f32x4*)(VT_ + r * 64 + 4 * c4) = tv[q]; }
    LBAR();
    const int tr = (w >> 1) & 1, tc = w & 1; f32x16 acc = zero16();
    if (w < 4) mma32(acc, S_ + 32 * tr * 65, 65, 1, E_ + 32 * tc, 64, 1, 64, lane);
    else { mma32(acc, VT_ + 32 * tr, 1, 64, F_ + 32 * tc, 64, 1, 64, lane);
#pragma unroll
        for (int r = 0; r < 16; ++r) O_[(32 * tr + rreg(r, lane)) * 65 + 32 * tc + (lane & 31)] = acc[r]; }
    LBAR();
    if (w < 4) {
#pragma unroll
        for (int r = 0; r < 16; ++r) O_[(32 * tr + rreg(r, lane)) * 65 + 32 * tc + (lane & 31)] += acc[r]; }
    LBAR();
    { float x[8]; float sm = 0.f;
#pragma unroll
      for (int q = 0; q < 8; ++q) { x[q] = O_[(8 * part + q) * 65 + li]; sm += x[q]; }
      sm += __shfl_xor(sm, 1); sm += __shfl_xor(sm, 2); sm += __shfl_xor(sm, 4);
      const float mu = sm * (1.0f / 64.0f); float vq = 0.f;
#pragma unroll
      for (int q = 0; q < 8; ++q) { const float d = x[q] - mu; vq += d * d; }
      vq += __shfl_xor(vq, 1); vq += __shfl_xor(vq, 2); vq += __shfl_xor(vq, 4);
      const float rstd = 1.0f / sqrtf(vq * (1.0f / 64.0f) + 64e-5f);
      if (ls < T) { const float* lng = F.kp->in[I_LN] + l * 512 + 64 * h + 8 * part;
          float ov[8];
#pragma unroll
          for (int q = 0; q < 4; ++q) { ov[q] = ((x[q] - mu) * rstd * lng[q] + bon * v0[q]) * g0[q]; ov[4 + q] = ((x[4 + q] - mu) * rstd * lng[4 + q] + bon * v1[q]) * g1[q]; }
          v4u wv; wv.x = cvtpk(ov[0], ov[1]); wv.y = cvtpk(ov[2], ov[3]); wv.z = cvtpk(ov[4], ov[5]); wv.w = cvtpk(ov[6], ov[7]);
          *(v4u*)(Y + (size_t)lrow * D + 1536 + 64 * h + 8 * part) = wv; } }
}
__device__ __forceinline__ void ssd_states_unit(const Ctx& F, int c, int h) {
    LAS float* Bm = (LAS float*)F.lds; LAS float* XD = Bm + 16384; LAS float* csl = XD + 8192; LAS float* lal = csl + 128; LAS float* dtl = lal + 128;
    const float* XBC = (const float*)(F.ws + O_XBC); const float* DT = (const float*)(F.ws + O_DT); const float* LA = (const float*)(F.ws + O_LA);
    float* SST = (float*)(F.ws + O_SST); float* SDEC = (float*)(F.ws + O_SDEC);
    const int tid = F.tid, lane = F.lane, w = F.wave, g = h >> 2;
    __syncthreads();
    if (tid < 128) { const int row = crow(c, tid); lal[tid] = row >= 0 ? LA[row * 8 + h] : 0.f; dtl[tid] = row >= 0 ? DT[row * 8 + h] : 0.f; }
    __syncthreads();
    if (tid < 64) { const float e0 = lal[2 * tid], e1 = lal[2 * tid + 1]; float s = e0 + e1;
#pragma unroll
        for (int o = 1; o < 64; o <<= 1) { const float t = __shfl_up(s, o); if (tid >= o) s += t; }
        csl[2 * tid + 1] = s; csl[2 * tid] = s - e1; }
    __syncthreads();
    const float cs_end = csl[127];
#pragma unroll
    for (int k = 0; k < 8; ++k) { const int idx = tid + 512 * k, j = idx >> 5, c4 = idx & 31, row = crow(c, j);
        const f32x4 v = row >= 0 ? *(const f32x4*)(XBC + (size_t)row * 1024 + 512 + 128 * g + 4 * c4) : (f32x4){0.f, 0.f, 0.f, 0.f};
        *(LAS f32x4*)(Bm + j * 128 + 4 * c4) = v; }
#pragma unroll
    for (int k = 0; k < 4; ++k) { const int idx = tid + 512 * k, j = idx >> 4, c4 = idx & 15, row = crow(c, j);
        f32x4 v = row >= 0 ? *(const f32x4*)(XBC + (size_t)row * 1024 + 64 * h + 4 * c4) : (f32x4){0.f, 0.f, 0.f, 0.f};
        v = v * (dtl[j] * expf(cs_end - csl[j]));
        *(LAS f32x4*)(XD + j * 64 + 4 * c4) = v; }
    __syncthreads();
    const int tr = w >> 2, tc = w & 3;
    f32x16 acc = zero16();
    mma32(acc, XD + 32 * tr, 1, 64, Bm + 32 * tc, 128, 1, 128, lane);
    float* dst = SST + ((size_t)(c * 8 + h) * 64 + 32 * tr) * 128 + 32 * tc + (lane & 31);
#pragma unroll
    for (int r = 0; r < 16; ++r) dst[(size_t)rreg(r, lane) * 128] = acc[r];
    if (tid == 0) SDEC[(c * 8 + h) * 32] = expf(cs_end);
}
__device__ __forceinline__ float ret_logg(int h) { return logf(1.0f - exp2f(-5.0f - (float)h)); }
__device__ __forceinline__ void ret_states_unit(const Ctx& F, int c, int h) {
    LAS float* V = (LAS float*)F.lds; LAS float* KD = V + 16384;
    const float* U = (const float*)(F.ws + O_U); const float* RQK = (const float*)(F.ws + O_RQK); float* RST = (float*)(F.ws + O_RST);
    const int tid = F.tid, lane = F.lane, w = F.wave; const float lg = ret_logg(h);
    __syncthreads();
#pragma unroll
    for (int k = 0; k < 8; ++k) { const int idx = tid + 512 * k, j = idx >> 5, c4 = idx & 31, row = crow(c, j);
        const f32x4 v = row >= 0 ? *(const f32x4*)(U + (size_t)row * NINP + U_RET + 512 + 128 * h + 4 * c4) : (f32x4){0.f, 0.f, 0.f, 0.f};
        *(LAS f32x4*)(V + j * 128 + 4 * c4) = v; }
#pragma unroll
    for (int k = 0; k < 4; ++k) { const int idx = tid + 512 * k, j = idx >> 4, c4 = idx & 15, row = crow(c, j);
        f32x4 v = row >= 0 ? *(const f32x4*)(RQK + (size_t)row * 512 + 256 + 64 * h + 4 * c4) : (f32x4){0.f, 0.f, 0.f, 0.f};
        v = v * expf((float)(127 - j) * lg);
        *(LAS f32x4*)(KD + j * 64 + 4 * c4) = v; }
    __syncthreads();
    const int tr = w >> 1, tc = w & 1;
    f32x16 acc = zero16();
    mma32(acc, V + 32 * tr, 1, 128, KD + 32 * tc, 64, 1, 128, lane);
    float* dst = RST + ((size_t)(c * 4 + h) * 128 + 32 * tr) * 64 + 32 * tc + (lane & 31);
#pragma unroll
    for (int r = 0; r < 16; ++r) dst[(size_t)rreg(r, lane) * 64] = acc[r];
}

__device__ __forceinline__ void scan_job(float* base, size_t cstride, const float* dec, int decstride, float constdec) {
    float s = 0.f;
    for (int c0 = 0; c0 < NCH; c0 += 13) { float t[13];
#pragma unroll
        for (int i = 0; i < 13; ++i) t[i] = base[(size_t)(c0 + i) * cstride];
#pragma unroll
        for (int i = 0; i < 13; ++i) { const float d = dec ? dec[(c0 + i) * decstride] : constdec; base[(size_t)(c0 + i) * cstride] = s; s = d * s + t[i]; } }
}
__device__ __forceinline__ void rwkv_scan(const Ctx& F, int hb) {
    LAS float* st = (LAS float*)F.lds;
    float* RW = (float*)(F.ws + O_RW); const size_t AS = (size_t)MP * 512; float* OUT = RW + 7 * AS;
    const int tid = F.tid, lane = F.lane, rl = lane >> 3, ks = lane & 7, myrow = 8 * F.wave + rl;
    float S[8];
#pragma unroll
    for (int j = 0; j < 8; ++j) S[j] = 0.f;
    for (int s0 = 0; s0 < T; s0 += 32) {
        __syncthreads();
#pragma unroll
        for (int j = 0; j < 6; ++j) { const int idx = tid + 512 * j, stp = idx / 96, rem = idx % 96, arr = rem >> 4, c4 = rem & 15, s = s0 + stp;
            if (s < T) { const int row = row_of_seq(s); const int asel = arr == 0 ? 0 : (arr == 1 ? 1 : (arr == 2 ? 2 : (arr == 3 ? 4 : (arr == 4 ? 5 : 3))));
                *(LAS f32x4*)(st + stp * 384 + arr * 64 + 4 * c4) = *(const f32x4*)(RW + asel * AS + (size_t)row * 512 + 64 * hb + 4 * c4); } }
        __syncthreads();
        const int nst = (T - s0) < 32 ? (T - s0) : 32;
        for (int stp = 0; stp < nst; ++stp) { const LAS float* b = st + stp * 384 + 8 * ks;
            const f32x4 r0 = *(const LAS f32x4*)(b), r1 = *(const LAS f32x4*)(b + 4), w0 = *(const LAS f32x4*)(b + 64), w1 = *(const LAS f32x4*)(b + 68), k0 = *(const LAS f32x4*)(b + 128), k1 = *(const LAS f32x4*)(b + 132),
                        n0 = *(const LAS f32x4*)(b + 192), n1 = *(const LAS f32x4*)(b + 196), b0 = *(const LAS f32x4*)(b + 256), b1 = *(const LAS f32x4*)(b + 260);
            const float vv = st[stp * 384 + 320 + myrow];
            float sa = (S[0] * n0[0] + S[1] * n0[1]) + (S[2] * n0[2] + S[3] * n0[3]) + (S[4] * n1[0] + S[5] * n1[1]) + (S[6] * n1[2] + S[7] * n1[3]);
            sa += __shfl_xor(sa, 1); sa += __shfl_xor(sa, 2); sa += __shfl_xor(sa, 4);
            float o = 0.f;
#pragma unroll
            for (int j = 0; j < 4; ++j) { S[j] = S[j] * w0[j] + sa * b0[j] + vv * k0[j]; o += S[j] * r0[j]; S[4 + j] = S[4 + j] * w1[j] + sa * b1[j] + vv * k1[j]; o += S[4 + j] * r1[j]; }
            o += __shfl_xor(o, 1); o += __shfl_xor(o, 2); o += __shfl_xor(o, 4);
            if (ks == 0) OUT[(size_t)row_of_seq(s0 + stp) * 512 + 64 * hb + myrow] = o; }
    }
}
__device__ __forceinline__ void mla_prep2_unit(const Ctx& F, int l, int un) {
    const float* QKVb = (const float*)(F.ws + O_QKV); const float* U = (const float*)(F.ws + O_U);
    bf16* Q = (bf16*)(F.ws + O_Q); bf16* K = (bf16*)(F.ws + O_K); bf16* VT = (bf16*)(F.ws + O_VT);
    LAS bf16* Vl = (LAS bf16*)F.lds;
    const int lane = F.lane, tid = F.tid;
    const float* gq = F.kp->in[I_QKNQ] + l * 192; const float* gk = F.kp->in[I_QKNK] + l * 192;
    const float gq0 = gq[lane], gq1 = gq[64 + lane], gq2 = gq[128 + lane], gk0 = gk[lane], gk1 = gk[64 + lane], gk2 = gk[128 + lane];
    const float qs = 0.07216878364870322f * 1.4426950408889634f;
    __syncthreads();
    for (int i = 0; i < 8; ++i) { const int sl = 8 * F.wave + i, s = 64 * un + sl;
        if (s < T) { const int row = row_of_seq(s); const float* qk = QKVb + (size_t)row * MLAN; const f32x2 cs = ((const f32x2*)(F.ws + O_ROPE))[row * 32 + (lane & 31)];
            const float kpe = U[(size_t)row * NINP + 512 + lane];
#pragma unroll
            for (int h = 0; h < 4; ++h) {
                { float x0 = qk[192 * h + lane], x1 = qk[192 * h + 64 + lane], x2 = qk[192 * h + 128 + lane];
                  const float rs = 1.0f / sqrtf(wave_sum(x0 * x0 + x1 * x1 + x2 * x2) * (1.0f / 192.0f) + EPS);
                  x0 *= rs * gq0; x1 *= rs * gq1; x2 *= rs * gq2;
                  const float ot = __shfl_xor(x2, 32); const float rr = lane < 32 ? x2 * cs.x - ot * cs.y : ot * cs.y + x2 * cs.x;
                  bf16* qd = Q + ((size_t)s * 4 + h) * 192; qd[lane] = (bf16)f2bf(x0 * qs); qd[64 + lane] = (bf16)f2bf(x1 * qs); qd[128 + lane] = (bf16)f2bf(rr * qs); }
                { float x0 = qk[768 + 256 * h + lane], x1 = qk[768 + 256 * h + 64 + lane], x2 = kpe;
                  const float rs = 1.0f / sqrtf(wave_sum(x0 * x0 + x1 * x1 + x2 * x2) * (1.0f / 192.0f) + EPS);
                  x0 *= rs * gk0; x1 *= rs * gk1; x2 *= rs * gk2;
                  const float ot = __shfl_xor(x2, 32); const float rr = lane < 32 ? x2 * cs.x - ot * cs.y : ot * cs.y + x2 * cs.x;
                  bf16* kd = K + ((size_t)s * 4 + h) * 192; kd[lane] = (bf16)f2bf(x0); kd[64 + lane] = (bf16)f2bf(x1); kd[128 + lane] = (bf16)f2bf(rr); }
                Vl[(h * 128 + lane) * 66 + sl] = (bf16)f2bf(qk[768 + 256 * h + 128 + lane]); Vl[(h * 128 + 64 + lane) * 66 + sl] = (bf16)f2bf(qk[768 + 256 * h + 192 + lane]);
            } }
        else {
#pragma unroll
            for (int h = 0; h < 4; ++h) { Vl[(h * 128 + lane) * 66 + sl] = 0; Vl[(h * 128 + 64 + lane) * 66 + sl] = 0; } }
    }
    __syncthreads();
#pragma unroll
    for (int k = 0; k < 8; ++k) { const int idx = tid + 512 * k, r = idx >> 3, j = idx & 7; const LAS unsigned* src = (const LAS unsigned*)(Vl + r * 66 + 8 * j);
        v4u w; w.x = src[0]; w.y = src[1]; w.z = src[2]; w.w = src[3];
        *(v4u*)(VT + (size_t)r * TSEQ + 64 * un + 8 * j) = w; }
}
__device__ __forceinline__ void m3_phase(const Ctx& F, int l) {
    const int b2 = F.bid, NB = F.G;
    for (int job = b2; job < 192; job += NB) {
        if (job < 128) { if (!EN_SSD) continue; const int e = job * 512 + F.tid, h = e >> 13, rest = e & 8191; scan_job((float*)(F.ws + O_SST) + (size_t)h * 8192 + rest, (size_t)8 * 8192, (const float*)(F.ws + O_SDEC) + h * 32, 8 * 32, 0.f); }
        else { if (!EN_RET) continue; const int e = (job - 128) * 512 + F.tid, h = e >> 13, rest = e & 8191; scan_job((float*)(F.ws + O_RST) + (size_t)h * 8192 + rest, (size_t)4 * 8192, nullptr, 0, expf(128.0f * ret_logg(h))); }
    }
    if (EN_MLA) for (int un = b2; un < (T + 63) / 64; un += NB) mla_prep2_unit(F, l, un);
}
template <int VAR = 0>
__device__ __forceinline__ void attn_unit(const Ctx& F, int hh, int qb, size_t yoff = O_Y) {
    LAS bf16* L0 = (LAS bf16*)F.lds;
    const bf16* Q = (const bf16*)(F.ws + O_Q); const bf16* K = (const bf16*)(F.ws + O_K); const bf16* VT = (const bf16*)(F.ws + O_VT); bf16* Y = (bf16*)(F.ws + yoff);
    int tid = F.tid, w = F.wave; asm volatile("" : "+v"(tid), "+s"(w));
    const int lane = tid & 63, h = lane >> 5, c = lane & 31, half = w >> 2, wq = w & 3;
    const int sq = 128 * qb + 32 * wq + c;
    bf16x8 qf[12];
#pragma unroll
    for (int ks = 0; ks < 12; ++ks) qf[ks] = *(const bf16x8*)(Q + ((size_t)sq * 4 + hh) * 192 + 16 * ks + 8 * h);
    f32x16 o[4];
#pragma unroll
    for (int t = 0; t < 4; ++t) o[t] = zero16();
    float m = -1e30f, lsum = 0.f;
    const int nst = qb + 1;
    v4u kr[6], vr[4];
    const unsigned kgo = (unsigned)(((tid >> 3) * 4 + hh) * 192 + 8 * (tid & 7)), klo = (unsigned)((tid >> 3) * 200 + 8 * (tid & 7));
    const unsigned vgo = (unsigned)((hh * 128 + (tid >> 2)) * TSEQ + 8 * (tid & 3)), vlo = (unsigned)(12800 + (tid >> 2) * 72 + 8 * (tid & 3));
#define AT_LOADK(st_) do { const bf16* kb_ = K + (size_t)(128 * (st_)) * 768; _Pragma("unroll") for (int j = 0; j < 6; ++j) kr[j] = *(const v4u*)(kb_ + kgo + (j / 3) * 49152 + 64 * (j % 3)); } while (0)
#define AT_LOADV(st_) do { const bf16* vb_ = VT + 128 * (st_); _Pragma("unroll") for (int j = 0; j < 4; ++j) vr[j] = *(const v4u*)(vb_ + vgo + (j >> 1) * 64 + 32 * (j & 1)); } while (0)
#define AT_STOREK() do { _Pragma("unroll") for (int j = 0; j < 6; ++j) *(LAS v4u*)(L0 + klo + (j / 3) * 22016 + 64 * (j % 3)) = kr[j]; } while (0)
#define AT_STOREV() do { _Pragma("unroll") for (int j = 0; j < 4; ++j) *(LAS v4u*)(L0 + vlo + (j >> 1) * 22016 + 32 * (j & 1)) = vr[j]; } while (0)
    __syncthreads();
    AT_LOADK(0); AT_LOADV(0); AT_STOREK(); AT_STOREV(); if (nst > 1) AT_LOADK(1);
    LBAR();
    const LAS bf16* Ks = L0 + half * 22016; const LAS bf16* Vs = Ks + 12800;
    for (int st = 0; st < nst; ++st) {
        const int kt = 2 * st + half;
        f32x16 sa[2];
#pragma unroll
        for (int t2 = 0; t2 < 2; ++t2) { sa[t2] = zero16();
#pragma unroll
            for (int ks = 0; ks < 12; ++ks) { const bf16x8 a = *(const LAS bf16x8*)(Ks + (32 * t2 + c) * 200 + 16 * ks + 8 * h); sa[t2] = __builtin_amdgcn_mfma_f32_32x32x16_bf16(a, qf[ks], sa[t2], 0, 0, 0); } }
        if (st == nst - 1) {
#pragma unroll
            for (int t2 = 0; t2 < 2; ++t2)
#pragma unroll
                for (int r = 0; r < 16; ++r) { const int key = 64 * kt + 32 * t2 + (r & 3) + 8 * (r >> 2) + 4 * h; if (key > sq) sa[t2][r] = -1e30f; } }
        float mx = -1e30f;
#pragma unroll
        for (int t2 = 0; t2 < 2; ++t2)
#pragma unroll
            for (int r = 0; r < 16; ++r) mx = fmaxf(mx, sa[t2][r]);
        mx = fmaxf(mx, __shfl_xor(mx, 32));
        if (__builtin_amdgcn_ballot_w64(mx > m) != 0ull) { const float mn = fmaxf(m, mx), alpha = __builtin_amdgcn_exp2f(m - mn); m = mn; lsum *= alpha;
#pragma unroll
            for (int t = 0; t < 4; ++t) o[t] = o[t] * alpha; }
        float rs = 0.f;
#pragma unroll
        for (int t2 = 0; t2 < 2; ++t2)
#pragma unroll
            for (int r = 0; r < 16; ++r) { const float pv = __builtin_amdgcn_exp2f(sa[t2][r] - m); sa[t2][r] = pv; rs += pv; }
        rs += __shfl_xor(rs, 32);
        lsum += rs;
        LBAR();
        if (st + 1 < nst) { AT_STOREK(); AT_LOADV(st + 1); }
#pragma unroll
        for (int t2 = 0; t2 < 2; ++t2)
#pragma unroll
            for (int s = 0; s < 2; ++s) { v4u pw; pw.x = cvtpk(sa[t2][8 * s], sa[t2][8 * s + 1]); pw.y = cvtpk(sa[t2][8 * s + 2], sa[t2][8 * s + 3]); pw.z = cvtpk(sa[t2][8 * s + 4], sa[t2][8 * s + 5]); pw.w = cvtpk(sa[t2][8 * s + 6], sa[t2][8 * s + 7]);
                const bf16x8 pf = __builtin_bit_cast(bf16x8, pw);
#pragma unroll
                for (int t = 0; t < 4; ++t) { const LAS bf16* vp = Vs + (32 * t + c) * 72 + 32 * t2 + 16 * s + 4 * h; const v2u lo = *(const LAS v2u*)vp, hi = *(const LAS v2u*)(vp + 8);
                    v4u vw; vw.x = lo.x; vw.y = lo.y; vw.z = hi.x; vw.w = hi.y;
                    o[t] = __builtin_amdgcn_mfma_f32_32x32x16_bf16(__builtin_bit_cast(bf16x8, vw), pf, o[t], 0, 0, 0); } }
        LBAR();
        if (st + 1 < nst) { AT_STOREV(); if (st + 2 < nst) AT_LOADK(st + 2); }
    }
#undef AT_LOADK
#undef AT_LOADV
#undef AT_STOREK
#undef AT_STOREV
    LAS float* MB = (LAS float*)F.lds + (wq * 64 + lane) * 67;
    if (half == 1) { MB[0] = m; MB[1] = lsum;
#pragma unroll
        for (int t = 0; t < 4; ++t)
#pragma unroll
            for (int r = 0; r < 16; ++r) MB[2 + 16 * t + r] = o[t][r]; }
    LBAR();
    if (half == 0) { const float m2 = MB[0], l2 = MB[1], mn = fmaxf(m, m2), a1 = __builtin_amdgcn_exp2f(m - mn), a2 = __builtin_amdgcn_exp2f(m2 - mn);
        const float inv = 1.0f / (lsum * a1 + l2 * a2);
        if (sq < T) { bf16* yr = Y + (size_t)row_of_seq(sq) * D + 128 * hh + 4 * h;
#pragma unroll
            for (int t = 0; t < 4; ++t)
#pragma unroll
                for (int rq = 0; rq < 4; ++rq) { float ov[4];
#pragma unroll
                    for (int i = 0; i < 4; ++i) ov[i] = (o[t][4 * rq + i] * a1 + MB[2 + 16 * t + 4 * rq + i] * a2) * inv;
                    v2u wv; wv.x = cvtpk(ov[0], ov[1]); wv.y = cvtpk(ov[2], ov[3]); *(v2u*)(yr + 32 * t + 8 * rq) = wv; } } }
}
__device__ __forceinline__ void ssd_out_unit(const Ctx& F, int l, int c, int h, int ih) {
    LAS float* CS_ = (LAS float*)F.lds; LAS float* BS_ = CS_ + 4160; LAS float* PS_ = BS_ + 8320; LAS float* SC_ = PS_ + 4160; LAS float* XD_ = SC_ + 8256; LAS float* csl = XD_ + 8192; LAS float* lal = csl + 128; LAS float* dtl = lal + 128;
    LAS float* Y_ = CS_;
    const float* XBC = (const float*)(F.ws + O_XBC); const float* DT = (const float*)(F.ws + O_DT); const float* LA = (const float*)(F.ws + O_LA); const float* U = (const float*)(F.ws + O_U);
    const float* SST = (const float*)(F.ws + O_SST); float* YZ = (float*)(F.ws + O_YZ);
    int tid = F.tid, w = F.wave; asm volatile("" : "+v"(tid), "+s"(w));
    const int lane = tid & 63, g = h >> 2;
    const f32x4 z4 = (f32x4){0.f, 0.f, 0.f, 0.f};
    float lav = 0.f, dtv = 0.f;
    if (tid < 128) { const int row = crow(c, tid); if (row >= 0) { lav = LA[row * 8 + h]; dtv = DT[row * 8 + h]; } }
    f32x4 xdv[4], csv[2][2], bsv[2][4], psv[2][2]; float xsv[8], zv[8];
#pragma unroll
    for (int k = 0; k < 4; ++k) { const int idx = tid + 512 * k, j = idx >> 4, c4 = idx & 15, row = crow(c, j); xdv[k] = row >= 0 ? *(const f32x4*)(XBC + (size_t)row * 1024 + 64 * h + 4 * c4) : z4; }
#pragma unroll
    for (int nh = 0; nh < 2; ++nh) {
#pragma unroll
        for (int k = 0; k < 2; ++k) { const int idx = tid + 512 * k, i = idx >> 4, c4 = idx & 15, row = crow(c, 64 * ih + i); csv[nh][k] = row >= 0 ? *(const f32x4*)(XBC + (size_t)row * 1024 + 768 + 128 * g + 64 * nh + 4 * c4) : z4; }
#pragma unroll
        for (int k = 0; k < 4; ++k) { const int idx = tid + 512 * k, j = idx >> 4, c4 = idx & 15, row = crow(c, j); bsv[nh][k] = row >= 0 ? *(const f32x4*)(XBC + (size_t)row * 1024 + 512 + 128 * g + 64 * nh + 4 * c4) : z4; }
#pragma unroll
        for (int k = 0; k < 2; ++k) { const int idx = tid + 512 * k, pp = idx >> 4, c4 = idx & 15; psv[nh][k] = *(const f32x4*)(SST + ((size_t)(c * 8 + h) * 64 + pp) * 128 + 64 * nh + 4 * c4); } }
#pragma unroll
    for (int k = 0; k < 8; ++k) { const int idx = tid + 512 * k, i = idx >> 6, pp = idx & 63, row = crow(c, 64 * ih + i); xsv[k] = 0.f; zv[k] = 0.f;
        if (row >= 0) { xsv[k] = XBC[(size_t)row * 1024 + 64 * h + pp]; zv[k] = U[(size_t)row * NINP + U_SSD + 64 * h + pp]; } }
    __syncthreads();
    if (tid < 128) { lal[tid] = lav; dtl[tid] = dtv; }
    LBAR();
    if (tid < 64) { const float e0 = lal[2 * tid], e1 = lal[2 * tid + 1]; float s = e0 + e1;
#pragma unroll
        for (int o = 1; o < 64; o <<= 1) { const float t = __shfl_up(s, o); if (tid >= o) s += t; }
        csl[2 * tid + 1] = s; csl[2 * tid] = s - e1; }
#pragma unroll
    for (int k = 0; k < 4; ++k) { const int idx = tid + 512 * k, j = idx >> 4, c4 = idx & 15; *(LAS f32x4*)(XD_ + j * 64 + 4 * c4) = xdv[k] * dtl[j]; }
    f32x16 acc_s = zero16(), acc_y = zero16();
    const int tr = w >> 2, tc = w & 3, tr2 = (w >> 1) & 1, tc2 = w & 1;
#pragma unroll
    for (int nh = 0; nh < 2; ++nh) {
        if (nh) LBAR();
#pragma unroll
        for (int k = 0; k < 2; ++k) { const int idx = tid + 512 * k, i = idx >> 4, c4 = idx & 15; const f32x4 v = csv[nh][k]; LAS float* d = CS_ + i * 65 + 4 * c4; d[0] = v[0]; d[1] = v[1]; d[2] = v[2]; d[3] = v[3]; }
#pragma unroll
        for (int k = 0; k < 4; ++k) { const int idx = tid + 512 * k, j = idx >> 4, c4 = idx & 15; const f32x4 v = bsv[nh][k]; LAS float* d = BS_ + j * 65 + 4 * c4; d[0] = v[0]; d[1] = v[1]; d[2] = v[2]; d[3] = v[3]; }
#pragma unroll
        for (int k = 0; k < 2; ++k) { const int idx = tid + 512 * k, pp = idx >> 4, c4 = idx & 15; const f32x4 v = psv[nh][k]; LAS float* d = PS_ + pp * 65 + 4 * c4; d[0] = v[0]; d[1] = v[1]; d[2] = v[2]; d[3] = v[3]; }
        LBAR();
        mma32(acc_s, CS_ + 32 * tr * 65, 65, 1, BS_ + 32 * tc * 65, 1, 65, 64, lane);
        if (w < 4) mma32(acc_y, CS_ + 32 * tr2 * 65, 65, 1, PS_ + 32 * tc2 * 65, 1, 65, 64, lane);
    }
    if (w < 4) {
#pragma unroll
        for (int r = 0; r < 16; ++r) acc_y[r] *= expf(csl[64 * ih + 32 * tr2 + rreg(r, lane)]); }
#pragma unroll
    for (int r = 0; r < 16; ++r) { const int i = 32 * tr + rreg(r, lane), j = 32 * tc + (lane & 31), il = 64 * ih + i;
        SC_[i * 129 + j] = j <= il ? acc_s[r] * expf(csl[il] - csl[j]) : 0.f; }
    LBAR();
    if (w < 4) { mma32(acc_y, SC_ + 32 * tr2 * 129, 129, 1, XD_ + 32 * tc2, 64, 1, 128, lane);
#pragma unroll
        for (int r = 0; r < 16; ++r) Y_[(32 * tr2 + rreg(r, lane)) * 65 + 32 * tc2 + (lane & 31)] = acc_y[r]; }
    LBAR();
    const float Dh = F.kp->in[I_SSDD][l * 8 + h];
#pragma unroll
    for (int k = 0; k < 8; ++k) { const int idx = tid + 512 * k, i = idx >> 6, pp = idx & 63, row = crow(c, 64 * ih + i);
        if (row >= 0) YZ[(size_t)row * 512 + 64 * h + pp] = (Y_[i * 65 + pp] + Dh * xsv[k]) * siluf_(zv[k]); }
}
__device__ __forceinline__ void ret_out_unit(const Ctx& F, int l, int c, int h, int ih) {
    LAS float* Q_ = (LAS float*)F.lds; LAS float* KM_ = Q_ + 4160; LAS float* SC_ = KM_ + 8320; LAS float* VH_ = SC_ + 8256; LAS float* SP_ = KM_; LAS float* Y_ = SC_;
    const float* U = (const float*)(F.ws + O_U); const float* RQK = (const float*)(F.ws + O_RQK); const float* RST = (const float*)(F.ws + O_RST); bf16* Y = (bf16*)(F.ws + O_Y);
    int tid = F.tid, w = F.wave; asm volatile("" : "+v"(tid), "+s"(w));
    const int lane = tid & 63; const float lg = ret_logg(h);
    const f32x4 z4 = (f32x4){0.f, 0.f, 0.f, 0.f};
    f32x4 qv[2], kv[4], spv[4], vv[2][4], gv[4];
#pragma unroll
    for (int k = 0; k < 2; ++k) { const int idx = tid + 512 * k, i = idx >> 4, c4 = idx & 15, row = crow(c, 64 * ih + i); qv[k] = row >= 0 ? *(const f32x4*)(RQK + (size_t)row * 512 + 64 * h + 4 * c4) : z4; }
#pragma unroll
    for (int k = 0; k < 4; ++k) { const int idx = tid + 512 * k, j = idx >> 4, c4 = idx & 15, row = crow(c, j); kv[k] = row >= 0 ? *(const f32x4*)(RQK + (size_t)row * 512 + 256 + 64 * h + 4 * c4) : z4; }
#pragma unroll
    for (int k = 0; k < 4; ++k) { const int idx = tid + 512 * k, vx = idx >> 4, c4 = idx & 15; spv[k] = *(const f32x4*)(RST + ((size_t)(c * 4 + h) * 128 + vx) * 64 + 4 * c4); }
#pragma unroll
    for (int jh = 0; jh < 2; ++jh)
#pragma unroll
        for (int k = 0; k < 4; ++k) { const int idx = tid + 512 * k, j = idx >> 5, c4 = idx & 31, row = crow(c, 64 * jh + j); vv[jh][k] = (jh <= ih && row >= 0) ? *(const f32x4*)(U + (size_t)row * NINP + U_RET + 512 + 128 * h + 4 * c4) : z4; }
    const int li = tid >> 3, part = tid & 7, lrow = crow(c, 64 * ih + li);
#pragma unroll
    for (int k = 0; k < 4; ++k) gv[k] = lrow >= 0 ? *(const f32x4*)(U + (size_t)lrow * NINP + U_RET + 1024 + 128 * h + 16 * part + 4 * k) : z4;
    __syncthreads();
#pragma unroll
    for (int k = 0; k < 2; ++k) { const int idx = tid + 512 * k, i = idx >> 4, c4 = idx & 15; const f32x4 v = qv[k]; LAS float* d = Q_ + i * 65 + 4 * c4; d[0] = v[0]; d[1] = v[1]; d[2] = v[2]; d[3] = v[3]; }
#pragma unroll
    for (int k = 0; k < 4; ++k) { const int idx = tid + 512 * k, j = idx >> 4, c4 = idx & 15; const f32x4 v = kv[k]; LAS float* d = KM_ + j * 65 + 4 * c4; d[0] = v[0]; d[1] = v[1]; d[2] = v[2]; d[3] = v[3]; }
    LBAR();
    const int tr = w >> 2, tc = w & 3;
    f32x16 acc_s = zero16();
    mma32(acc_s, Q_ + 32 * tr * 65, 65, 1, KM_ + 32 * tc * 65, 1, 65, 64, lane);
    LBAR();
#pragma unroll
    for (int k = 0; k < 4; ++k) { const int idx = tid + 512 * k, vx = idx >> 4, c4 = idx & 15; const f32x4 v = spv[k]; LAS float* d = SP_ + vx * 65 + 4 * c4; d[0] = v[0]; d[1] = v[1]; d[2] = v[2]; d[3] = v[3]; }
#pragma unroll
    for (int r = 0; r < 16; ++r) { const int i = 32 * tr + rreg(r, lane), j = 32 * tc + (lane & 31), il = 64 * ih + i;
        SC_[i * 129 + j] = j <= il ? acc_s[r] * expf((float)(il - j) * lg) : 0.f; }
#pragma unroll
    for (int k = 0; k < 4; ++k) { const int idx = tid + 512 * k, j = idx >> 5, c4 = idx & 31; *(LAS f32x4*)(VH_ + j * 128 + 4 * c4) = vv[0][k]; }
    LBAR();
    f32x16 acc_y = zero16();
    mma32(acc_y, Q_ + 32 * tr * 65, 65, 1, SP_ + 32 * tc * 65, 1, 65, 64, lane);
#pragma unroll
    for (int r = 0; r < 16; ++r) acc_y[r] *= expf((float)(64 * ih + 32 * tr + rreg(r, lane) + 1) * lg);
    mma32(acc_y, SC_ + 32 * tr * 129, 129, 1, VH_ + 32 * tc, 128, 1, 64, lane);
    if (ih) { LBAR();
#pragma unroll
        for (int k = 0; k < 4; ++k) { const int idx = tid + 512 * k, j = idx >> 5, c4 = idx & 31; *(LAS f32x4*)(VH_ + j * 128 + 4 * c4) = vv[1][k]; }
        LBAR();
        mma32(acc_y, SC_ + 32 * tr * 129 + 64, 129, 1, VH_ + 32 * tc, 128, 1, 64, lane); }
    LBAR();
#pragma unroll
    for (int r = 0; r < 16; ++r) Y_[(32 * tr + rreg(r, lane)) * 129 + 32 * tc + (lane & 31)] = acc_y[r];
    LBAR();
    { const LAS float* yr = Y_ + li * 129 + 16 * part;
      float s = 0.f;
#pragma unroll
      for (int k = 0; k < 16; ++k) s += yr[k];
      s += __shfl_xor(s, 1); s += __shfl_xor(s, 2); s += __shfl_xor(s, 4);
      const float mu = s * (1.0f / 128.0f); float q = 0.f;
#pragma unroll
      for (int k = 0; k < 16; ++k) { const float d = yr[k] - mu; q += d * d; }
      q += __shfl_xor(q, 1); q += __shfl_xor(q, 2); q += __shfl_xor(q, 4);
      const float rstd = 1.0f / sqrtf(q * (1.0f / 128.0f) + EPS);
      if (lrow >= 0) { const float* ng = F.kp->in[I_RETN] + l * 512 + 128 * h + 16 * part; float ov[16];
#pragma unroll
          for (int k = 0; k < 16; ++k) ov[k] = (yr[k] - mu) * rstd * ng[k] * siluf_(gv[k >> 2][k & 3]);
          bf16* yd = Y + (size_t)lrow * D + 1024 + 128 * h + 16 * part;
          v4u w0, w1; w0.x = cvtpk(ov[0], ov[1]); w0.y = cvtpk(ov[2], ov[3]); w0.z = cvtpk(ov[4], ov[5]); w0.w = cvtpk(ov[6], ov[7]); w1.x = cvtpk(ov[8], ov[9]); w1.y = cvtpk(ov[10], ov[11]); w1.z = cvtpk(ov[12], ov[13]); w1.w = cvtpk(ov[14], ov[15]);
          *(v4u*)yd = w0; *(v4u*)(yd + 8) = w1; } }
}
__device__ __forceinline__ void m4_phase(const Ctx& F, int l, int qi = 0, int only = -1) {
    unsigned* ctr = (unsigned*)(F.ws + O_CTL) + CW_QUEUE + 64 * (4 * l + qi);
    constexpr int N_AT = 4 * NCH, N_SO = NCH * 16, N_RO = NCH * 8, N_WO = NRC * 8, N_ALL = N_AT + N_SO + N_RO + N_WO;
    int u = queue_next(F, ctr);
    while (u < N_AT) { if (only < 0) attn_unit<0>(F, u & 3, (NCH - 1) - (u >> 2)); else if (only == 0) attn_unit<DUP_VAR>(F, u & 3, (NCH - 1) - (u >> 2), O_QKV); u = queue_next(F, ctr); }
    while (u < N_AT + N_SO + N_RO) { int v = u - N_AT;
        if (v < N_RO) { const int c = v >> 3, h = (v >> 1) & 3, ih = v & 1; if (!(c == 0 && ih == 0) && (only < 0 || only == 2)) ret_out_unit(F, l, c, h, ih); }
        else { v -= N_RO; const int c = v >> 4, h = (v >> 1) & 7, ih = v & 1; if (!(c == 0 && ih == 0) && (only < 0 || only == 1)) ssd_out_unit(F, l, c, h, ih); }
        u = queue_next(F, ctr); }
    if (u < N_ALL && only < 0) {
        if (F.tid == 0) { unsigned* sflag = (unsigned*)(F.ws + O_CTL) + CW_QUEUE + 64 * (16 + l); const unsigned nscan = F.G >= 64 ? 32u : (unsigned)F.G; unsigned sp = 0;
            while (__hip_atomic_load(sflag, __ATOMIC_RELAXED, __HIP_MEMORY_SCOPE_AGENT) < nscan) { __builtin_amdgcn_s_sleep(8); if (++sp > (1u << 22)) break; }
            __builtin_amdgcn_fence(__ATOMIC_ACQUIRE, "agent"); asm volatile("s_waitcnt vmcnt(0)" ::: "memory"); }
        __syncthreads(); }
    while (u < N_ALL) { const int v = u - (N_AT + N_SO + N_RO); if (only < 0 || only == 3) rwkv_out_unit(F, l, v >> 3, v & 7); u = queue_next(F, ctr); }
}
__device__ __forceinline__ void m5_phase(const Ctx& F, int l) {
#ifdef PROBE_DUP
    { const bf16* Y = (const bf16*)(F.ws + O_Y); const bf16* Y2 = (const bf16*)(F.ws + O_YZ); unsigned cnt = 0;
      for (int row = F.bid * NWAVES + F.wave; row < T; row += F.G * NWAVES) for (int j = 0; j < 8; ++j) cnt += Y[(size_t)row * D + 64 * j + F.lane] != Y2[(size_t)row * D + 64 * j + F.lane];
      if (cnt) atomicAdd((unsigned*)(F.ws + O_CTL) + 8, cnt); }
#endif
#ifdef PROBE_COPY_U
    { const float* U = (const float*)(F.ws + O_U); bf16* Y = (bf16*)(F.ws + O_Y);
      for (int row = F.bid * NWAVES + F.wave; row < T; row += F.G * NWAVES)
        for (int j = 0; j < 4; ++j) { const float* ur = U + (size_t)(PROBE_COPY_META ? SEQ + (row & 15) : row) * NINP + PROBE_COPY_U + 512 * j + 8 * F.lane; const f32x4 a = *(const f32x4*)ur, b = *(const f32x4*)(ur + 4);
          v4u w; w.x = pk2(a[0], a[1]); w.y = pk2(a[2], a[3]); w.z = pk2(b[0], b[1]); w.w = pk2(b[2], b[3]); *(v4u*)(Y + (size_t)row * D + 512 * j + 8 * F.lane) = w; } }
#endif
    if (!EN_SSD) return;
    const float* YZ = (const float*)(F.ws + O_YZ); bf16* Y = (bf16*)(F.ws + O_Y); const float* ng = F.kp->in[I_SSDN] + l * 512 + 8 * F.lane;
    for (int row = F.bid * NWAVES + F.wave; row < T; row += F.G * NWAVES) { const float* yr = YZ + (size_t)row * 512 + 8 * F.lane; const f32x4 a = *(const f32x4*)yr, b = *(const f32x4*)(yr + 4);
        const float sq = wave_sum((a[0] * a[0] + a[1] * a[1]) + (a[2] * a[2] + a[3] * a[3]) + (b[0] * b[0] + b[1] * b[1]) + (b[2] * b[2] + b[3] * b[3]));
        const float rs = 1.0f / sqrtf(sq * (1.0f / 512.0f) + EPS); const f32x4 g0 = *(const f32x4*)ng, g1 = *(const f32x4*)(ng + 4);
        v4u w; w.x = pk2(a[0] * rs * g0[0], a[1] * rs * g0[1]); w.y = pk2(a[2] * rs * g0[2], a[3] * rs * g0[3]); w.z = pk2(b[0] * rs * g1[0], b[1] * rs * g1[1]); w.w = pk2(b[2] * rs * g1[2], b[3] * rs * g1[3]);
        *(v4u*)(Y + (size_t)row * D + 512 + 8 * F.lane) = w; }
}
template <int MODE  , int NT>
__device__ __forceinline__ void meta_gemm(const Ctx& F, const bf16* A16, int lda, const bf16* Bt, int ldb, int ntasks, int K, float* Cf, int ldc, const float* ss_in, float* ss_out, bf16* Ob, float* H, float scale) {
    constexpr int NACC = MODE == 1 ? 2 * NT : NT;
    LAS float* red = (LAS float*)F.lds;
    int tid = F.tid, w = F.wave; asm volatile("" : "+v"(tid), "+s"(w));
    const int lane = tid & 63, g = lane >> 4, c = lane & 15, kper = K >> 3;
    for (int task = F.G - 1 - F.bid; task < ntasks; task += F.G) {
        const int n0 = MODE == 1 ? 256 * ((64 * task) >> 7) + ((64 * task) & 127) : 16 * NT * task;
        f32x4 acc[NACC];
#pragma unroll
        for (int q = 0; q < NACC; ++q) acc[q] = (f32x4){0.f, 0.f, 0.f, 0.f};
        const bf16* ap = A16 + (size_t)c * lda + w * kper + 8 * g; const bf16* bp = Bt + (size_t)(n0 + c) * ldb + w * kper + 8 * g;
#pragma unroll 4
        for (int kk = 0; kk < kper; kk += 32) { const bf16x8 a = *(const bf16x8*)(ap + kk);
#pragma unroll
            for (int t = 0; t < NT; ++t) { acc[t] = __builtin_amdgcn_mfma_f32_16x16x32_bf16(*(const bf16x8*)(bp + (size_t)(16 * t) * ldb + kk), a, acc[t], 0, 0, 0);
                if (MODE == 1) acc[NT + t] = __builtin_amdgcn_mfma_f32_16x16x32_bf16(*(const bf16x8*)(bp + (size_t)(128 + 16 * t) * ldb + kk), a, acc[NT + t], 0, 0, 0); } }
        __syncthreads();
#pragma unroll
        for (int q = 0; q < NACC; ++q) *(LAS f32x4*)(red + ((w * NACC + q) * 64 + lane) * 4) = acc[q];
        __syncthreads();
        if (w == 0) { const int row = SEQ + c; float rs = 1.0f;
            if (ss_in) { float s = 0.f;
#pragma unroll
                for (int q = 0; q < 8; ++q) { const f32x4 x = *(const f32x4*)(ss_in + (size_t)row * 32 + 4 * q); s += (x[0] + x[1]) + (x[2] + x[3]); }
                rs = __builtin_amdgcn_rsqf(s * (1.0f / 2048.0f) + EPS); }
            float sq = 0.f;
#pragma unroll
            for (int t = 0; t < NT; ++t) { f32x4 v = (f32x4){0.f, 0.f, 0.f, 0.f}, v2 = v;
#pragma unroll
                for (int ww = 0; ww < 8; ++ww) { v = v + *(const LAS f32x4*)(red + ((ww * NACC + t) * 64 + lane) * 4); if (MODE == 1) v2 = v2 + *(const LAS f32x4*)(red + ((ww * NACC + NT + t) * 64 + lane) * 4); }
                if (MODE == 0) *(f32x4*)(Cf + (size_t)row * ldc + 16 * NT * task + 16 * t + 4 * g) = v * rs;
                if (MODE == 3) { v2u wv; wv.x = pk2(v[0] * rs, v[1] * rs); wv.y = pk2(v[2] * rs, v[3] * rs); *(v2u*)(Ob + (size_t)row * ldc + 16 * NT * task + 16 * t + 4 * g) = wv; }
                if (MODE == 1) { float o[4];
#pragma unroll
                    for (int i = 0; i < 4; ++i) { const float gv = v[i] * rs, uv = v2[i] * rs; o[i] = gv * uv * __builtin_amdgcn_rcpf(1.0f + __expf(-gv)); }
                    v2u wv; wv.x = pk2(o[0], o[1]); wv.y = pk2(o[2], o[3]); *(v2u*)(Ob + (size_t)row * DFF + 64 * task + 16 * t + 4 * g) = wv; }
                if (MODE == 2) { const size_t off = (size_t)row * D + 64 * task + 16 * t + 4 * g; f32x4 h4 = *(const f32x4*)(H + off); h4 = h4 + v * scale; *(f32x4*)(H + off) = h4;
                    v2u wv; wv.x = pk2(h4[0], h4[1]); wv.y = pk2(h4[2], h4[3]); *(v2u*)(Ob + off) = wv; sq += (h4[0] * h4[0] + h4[1] * h4[1]) + (h4[2] * h4[2] + h4[3] * h4[3]); } }
            if (MODE == 2 && ss_out) { sq += __shfl_xor(sq, 16); sq += __shfl_xor(sq, 32); if (g == 0) __hip_atomic_fetch_add(ss_out + (size_t)row * 32 + task, sq, __ATOMIC_RELAXED, __HIP_MEMORY_SCOPE_AGENT); } }
    }
}
__device__ __forceinline__ void gemm_swiglu(const Ctx& F, int hl, int ssidx) {
    const bf16* A = (const bf16*)(F.ws + O_HB); const bf16* Bt = (const bf16*)(F.ws + O_WGU) + (size_t)hl * 11264 * 2048; const float* ss = (const float*)(F.ws + O_SS) + (size_t)ssidx * MP * 32;
    { pg8::Gemm g{A, Bt, SEQ, 11264, 2048, 2048, 2048, F.wave}; pg8::StaticOrder S; S.init(SEQ, 11264, F.G, F.bid);
      const int full = (S.nwg / F.G) * F.G, rem = S.nwg - full;
      const bool split = false && (2 * rem == F.G);
      if (split) S.lim = full;
      pg8::EpiSwiGLU E{(bf16*)(F.ws + O_ACT), DFF, ss, 1.0f / 2048.0f, EPS, 2};
      pg8::gemm_phase<pg8::EpiSwiGLU, pg8::StaticOrder, true, true, false>(F.lds, g, S, E);
      if (split) { pg8::StaticOrder S2; S2.init(SEQ, 11264, F.G, F.bid); S2.hmbase = full;
          pg8::EpiSwiGLU E2{(bf16*)(F.ws + O_ACT), DFF, ss, 1.0f / 2048.0f, EPS, 1};
          pg8::gemm_phase<pg8::EpiSwiGLU, pg8::StaticOrder, true, true, true>(F.lds, g, S2, E2); } }
    meta_gemm<1, 4>(F, A + (size_t)SEQ * 2048, 2048, Bt, 2048, DFF / 64, 2048, nullptr, 0, ss, nullptr, (bf16*)(F.ws + O_ACT), nullptr, 0.f);
}
__device__ __forceinline__ void gemm_residual(const Ctx& F, const bf16* A, const bf16* Bt, int K, int ssidx, bool to_out, float scale) {
    float* sso = ssidx >= 0 ? (float*)(F.ws + O_SS) + (size_t)ssidx * MP * 32 : nullptr;
    { pg8::Gemm g{A, Bt, SEQ, 2048, K, K, K, F.wave}; pg8::StaticOrder S; S.init(SEQ, 2048, F.G, F.bid);
      pg8::EpiResidual E{(float*)(F.ws + O_H), (bf16*)(F.ws + O_HB), sso, to_out ? F.kp->out : nullptr, SEQ, scale};
      pg8::gemm_phase<pg8::EpiResidual, pg8::StaticOrder, true, true>(F.lds, g, S, E); }
    meta_gemm<2, 4>(F, A + (size_t)SEQ * K, K, Bt, K, 32, K, nullptr, 0, nullptr, sso, (bf16*)(F.ws + O_HB), (float*)(F.ws + O_H), scale);
}
__device__ __forceinline__ void gemm_scalef32(const Ctx& F, const bf16* A, const bf16* Bt, int N, int K, float* C, int ssidx) {
    const float* ss = ssidx >= 0 ? (const float*)(F.ws + O_SS) + (size_t)ssidx * MP * 32 : nullptr;
    { pg8::Gemm g{A, Bt, SEQ, N, K, K, K, F.wave}; pg8::StaticOrder S; S.init(SEQ, N, F.G, F.bid);
      pg8::EpiScaleF32 E{C, N, ss, 1.0f / 2048.0f, EPS};
      pg8::gemm_phase<pg8::EpiScaleF32, pg8::StaticOrder, true, true>(F.lds, g, S, E); }
    meta_gemm<0, 4>(F, A + (size_t)SEQ * K, K, Bt, K, N / 64, K, C, N, ss, nullptr, nullptr, nullptr, 0.f);
}
__global__ void __launch_bounds__(NTHR, 2) hybrid_fwd(P p) {
    extern __shared__ __attribute__((aligned(16))) unsigned char lds_raw[];
    LAS unsigned char* lds = (LAS unsigned char*)lds_raw;
    const int wv = __builtin_amdgcn_readfirstlane((int)threadIdx.x >> 6);
    for (int u = threadIdx.x; u < (LDS_BYTES - LDSCTL_OFF) / 4; u += NTHR) ((LAS unsigned*)(lds + LDSCTL_OFF))[u] = 0u;
    __syncthreads();
    XcdBarrier bar = xcd_barrier_post((unsigned*)(p.ws + O_CTL) + CW_BAR, (volatile LAS unsigned*)(lds + LDSCTL_OFF), wv);
    const int lo = p.ph_lo, hi = p.ph_hi;
#define IN(k) (lo <= (k) && (k) < hi)
#define SEAM(k) do { if (IN(k) && IN((k) + 1)) xcd_barrier(bar, wv); } while (0)
#ifndef NO_P0
    if (IN(0)) { const Ctx F = ctx_make(lds, wv); p0_prologue(F, 0); }
#ifdef DUP_CVT
    if (IN(0)) { const Ctx F = ctx_make(lds, wv); p0_prologue(F, 1); }
#endif
#endif
    SEAM(0);
    for (int hl = 0; hl < 8; ++hl) {
        const int l = hl >> 1, second = hl & 1, base = 1 + 11 * l + (second ? 9 : 0);
        if (IN(base)) { const Ctx F = ctx_make(lds, wv); gemm_swiglu(F, hl, 3 * l + (second ? 2 : 0)); }
#ifdef DUP_GU
        if (IN(base)) { const Ctx F = ctx_make(lds, wv); gemm_swiglu(F, hl, 3 * l + (second ? 2 : 0)); }
#endif
        SEAM(base);
        if (IN(base + 1)) { const Ctx F = ctx_make(lds, wv);
            gemm_residual(F, (const bf16*)(F.ws + O_ACT), (const bf16*)(F.ws + O_WD) + (size_t)hl * 2048 * 5632, 5632, second ? (l < 3 ? 3 * (l + 1) : -1) : 3 * l + 1, hl == 7, 0.5f); }
        if (hl < 7) SEAM(base + 1);
        if (!second) {
            const int mb = base + 2;
            if (IN(mb)) { const Ctx F = ctx_make(lds, wv); gemm_scalef32(F, (const bf16*)(F.ws + O_HB), (const bf16*)(F.ws + O_WIN) + (size_t)l * NINP * D, NINP, 2048, (float*)(F.ws + O_U), 3 * l + 1); }
#ifdef DUP_WIN
            if (IN(mb)) { const Ctx F = ctx_make(lds, wv); gemm_scalef32(F, (const bf16*)(F.ws + O_HB), (const bf16*)(F.ws + O_WIN) + (size_t)l * NINP * D, NINP, 2048, (float*)(F.ws + O_U), 3 * l + 1); }
#endif
            SEAM(mb);
#ifndef NO_M1
            if (IN(mb + 1)) { const Ctx F = ctx_make(lds, wv); m1_phase(F, l); }
#ifdef DUP_M1
            if (IN(mb + 1)) { const Ctx F = ctx_make(lds, wv); m1_phase(F, l, 3); }
#endif
#endif
            SEAM(mb + 1);
            if (IN(mb + 2)) {
                if (EN_MLA) { const Ctx F = ctx_make(lds, wv); gemm_scalef32(F, (const bf16*)(F.ws + O_AMLA), (const bf16*)(F.ws + O_WMLA) + (size_t)l * MLAN * 512, MLAN, 512, (float*)(F.ws + O_QKV), -1); }
#ifndef NO_M2
                { const Ctx F = ctx_make(lds, wv); unsigned* ctr = (unsigned*)(F.ws + O_CTL) + CW_QUEUE + 64 * (4 * l + 2);
                  for (;;) { int u = queue_next(F, ctr); if (u >= NRC * 8 + NCH * 8 + NCH * 4) break;
                      if (u < NRC * 8) { rwkv_chunk_unit(F, u >> 3, u & 7); continue; } u -= NRC * 8;
                      if (u < NCH * 8) { ssd_states_unit(F, u >> 3, u & 7); continue; } u -= NCH * 8;
                      ret_states_unit(F, u >> 2, u & 3); } }
#ifdef DUP_M2Q
                { const Ctx F = ctx_make(lds, wv); unsigned* ctr = (unsigned*)(F.ws + O_CTL) + CW_QUEUE + 64 * (4 * l + 3);
                  for (;;) { int u = queue_next(F, ctr); if (u >= NRC * 8 + NCH * 8 + NCH * 4) break;
                      if (u < NRC * 8) { rwkv_chunk_unit(F, u >> 3, u & 7); continue; } u -= NRC * 8;
                      if (u < NCH * 8) { ssd_states_unit(F, u >> 3, u & 7); continue; } u -= NCH * 8;
                      ret_states_unit(F, u >> 2, u & 3); } }
#endif
#endif
            }
            SEAM(mb + 2);
#ifndef NO_M3
            if (IN(mb + 3)) { const Ctx F = ctx_make(lds, wv); m3_phase(F, l); }
            if (IN(mb + 3) && l + 1 < DEPTH) { const Ctx F = ctx_make(lds, wv); { __syncthreads(); convert_layer(F, l + 1, F.bid * NWAVES + F.wave, F.G * NWAVES); } }
#ifdef DUP_SCAN
            if (IN(mb + 3)) { const Ctx F = ctx_make(lds, wv); if (F.bid < 32) rwkv_state_scan<DUP_SCAN>(F, F.bid >> 2, F.bid & 3); }
#endif
#endif
            SEAM(mb + 3);
#ifndef NO_M4
            if (IN(mb + 4)) { const Ctx F = ctx_make(lds, wv); const int nscan = F.G >= 64 ? 32 : F.G;
                if (F.bid < nscan) { for (int s = F.bid; s < 32; s += nscan) rwkv_state_scan<0>(F, s >> 2, s & 3);
                    asm volatile("s_waitcnt vmcnt(0)" ::: "memory"); __syncthreads();
                    if (F.tid == 0) { __builtin_amdgcn_fence(__ATOMIC_RELEASE, "agent"); asm volatile("s_waitcnt vmcnt(0)" ::: "memory"); __hip_atomic_fetch_add((unsigned*)(F.ws + O_CTL) + CW_QUEUE + 64 * (16 + l), 1u, __ATOMIC_RELAXED, __HIP_MEMORY_SCOPE_AGENT); } } }
            if (IN(mb + 4)) { const Ctx F = ctx_make(lds, wv); m4_phase(F, l); }
#ifdef DUP_M4
            if (IN(mb + 4)) { const Ctx F = ctx_make(lds, wv); m4_phase(F, l, 3, DUP_M4 - 1); }
#endif
#endif
            SEAM(mb + 4);
#ifndef NO_M5
            if (IN(mb + 5)) { const Ctx F = ctx_make(lds, wv); m5_phase(F, l); }
#ifdef DUP_M5
            if (IN(mb + 5)) { const Ctx F = ctx_make(lds, wv); m5_phase(F, l); }
#endif
#endif
            SEAM(mb + 5);
#ifdef DUP_BAR
            for (int q = 0; q < 8; ++q) xcd_barrier(bar, wv);
#endif
            if (IN(mb + 6)) { const Ctx F = ctx_make(lds, wv); gemm_residual(F, (const bf16*)(F.ws + O_Y), (const bf16*)(F.ws + O_WOUT) + (size_t)l * D * D, 2048, 3 * l + 2, false, 1.0f); }
            SEAM(mb + 6);
        }
    }
#ifdef PROBE_DUP
    xcd_barrier(bar, wv);
    { const Ctx F = ctx_make(lds, wv); const float v = (float)__hip_atomic_load((unsigned*)(F.ws + O_CTL) + 8, __ATOMIC_RELAXED, __HIP_MEMORY_SCOPE_AGENT); float* out = F.kp->out;
      for (size_t i = (size_t)F.bid * NTHR + F.tid; i < (size_t)SEQ * D; i += (size_t)F.G * NTHR) out[i] = v; }
#endif
#ifdef PROBE_ADD_META
    xcd_barrier(bar, wv);
    { const Ctx F = ctx_make(lds, wv); const float* H = (const float*)(F.ws + O_H); float* out = F.kp->out;
      for (int row = F.bid * NWAVES + F.wave; row < SEQ; row += F.G * NWAVES)
        for (int j = 0; j < 8; ++j) { const int c = 256 * j + 4 * F.lane; f32x4 v = *(f32x4*)(out + (size_t)row * D + c); v = v + *(const f32x4*)(H + (size_t)(SEQ + (row & 15)) * D + c); *(f32x4*)(out + (size_t)row * D + c) = v; } }
#endif
#undef IN
#undef SEAM
}

extern "C" void kernel_launch(void* const* d_in, const int* in_sizes, int n_in, void* d_out, int out_size, void* d_ws, size_t ws_size, hipStream_t stream) {
    static int grid = 0;
    if (grid == 0) {
        if (n_in != 36 || out_size != SEQ * D || ws_size < WS_END) { fprintf(stderr, "kernel_launch: expected 36 inputs, out %d, ws >= %zu; got n_in %d out %d ws %zu\n", SEQ * D, (size_t)WS_END, n_in, out_size, ws_size); grid = -1; return; }
        int dev = 0, cus = 0, per_cu = 0;
        if (hipGetDevice(&dev) != hipSuccess || hipDeviceGetAttribute(&cus, hipDeviceAttributeMultiprocessorCount, dev) != hipSuccess) { grid = -1; return; }
        if (hipFuncSetAttribute((const void*)hybrid_fwd, hipFuncAttributeMaxDynamicSharedMemorySize, LDS_BYTES) != hipSuccess) { fprintf(stderr, "kernel_launch: hipFuncSetAttribute failed\n"); grid = -1; return; }
        if (hipOccupancyMaxActiveBlocksPerMultiprocessor(&per_cu, (const void*)hybrid_fwd, NTHR, LDS_BYTES) != hipSuccess || per_cu < 1) fprintf(stderr, "kernel_launch: occupancy query reports %d\n", per_cu);
        (void)hipGetLastError();
        grid = cus;
    }
    if (grid < 0) return;
    if (hipMemsetAsync((char*)d_ws + O_CTL, 0, SZ_CTL, stream) != hipSuccess) { fprintf(stderr, "kernel_launch: memset failed\n"); return; }
    P a{};
    for (int i = 0; i < 36; ++i) a.in[i] = (const float*)d_in[i];
    a.out = (float*)d_out; a.ws = (unsigned char*)d_ws;
#if PER_PHASE_LAUNCH
    for (int ph = 0; ph < NPHASE; ++ph) { a.ph_lo = ph; a.ph_hi = ph + 1; hipLaunchKernelGGL(hybrid_fwd, dim3(grid), dim3(NTHR), LDS_BYTES, stream, a); }
#else
    a.ph_lo = 0; a.ph_hi = NPHASE;
    hipLaunchKernelGGL(hybrid_fwd, dim3(grid), dim3(NTHR), LDS_BYTES, stream, a);
#endif
    const hipError_t le = hipPeekAtLastError();
    if (le != hipSuccess) fprintf(stderr, "kernel_launch: launch failed: %s\n", hipGetErrorName(le));
}
```

```cpp
#include <hip/hip_runtime.h>
#include <cstdio>
#include <cstdint>

#define GAS __attribute__((address_space(1)))
#define LAS __attribute__((address_space(3)))
typedef unsigned short bf16;
typedef unsigned v4u __attribute__((ext_vector_type(4)));
typedef unsigned v2u __attribute__((ext_vector_type(2)));
typedef float f32x4 __attribute__((ext_vector_type(4)));
typedef float f32x2 __attribute__((ext_vector_type(2)));
typedef float f32x16 __attribute__((ext_vector_type(16)));
typedef short bf16x8 __attribute__((ext_vector_type(8)));

constexpr int D = 2048, SEQ = 8192, NMETA = 16, T = SEQ + NMETA, MP = 8448, DFF = 5632, DEPTH = 4;
constexpr int NIN = 5320, NINP = 5376, NCH = 65, TSEQ = 8320, MLAN = 1792;
constexpr int U_MLA = 0, U_SSD = 576, U_RET = 2120, U_RWKV = 3656;
constexpr float EPS = 1e-6f;
constexpr int NWAVES = 8, NTHR = 512;
#ifndef EN_MLA
#define EN_MLA 1
#endif
#ifndef EN_SSD
#define EN_SSD 1
#endif
#ifndef EN_RET
#define EN_RET 1
#endif
#ifndef EN_RWKV
#define EN_RWKV 1
#endif
#ifndef PROBE_NOSCAN
#define PROBE_NOSCAN 0
#endif
#ifndef PROBE_ATTCOPY
#define PROBE_ATTCOPY 0
#endif
#ifndef PROBE_COPY_META
#define PROBE_COPY_META 0
#endif
#ifndef DUP_VAR
#define DUP_VAR 0
#endif
#ifndef PER_PHASE_LAUNCH
#define PER_PHASE_LAUNCH 0
#endif
constexpr int NPHASE = 1 + 8 * 2 + 4 * 7;

constexpr size_t O_CTL = 0, SZ_CTL = 13107200;
constexpr int CW_BAR = 4096;
constexpr size_t O_SS = 65536;
constexpr size_t O_WGU = O_CTL + SZ_CTL,                 SZ_WGU = (size_t)8 * 2 * DFF * D * 2;
constexpr size_t O_WD = O_WGU + SZ_WGU,                  SZ_WD = (size_t)8 * D * DFF * 2;
constexpr size_t O_WIN = O_WD + SZ_WD,                   SZ_WIN = (size_t)4 * NINP * D * 2;
constexpr size_t O_WOUT = O_WIN + SZ_WIN,                SZ_WOUT = (size_t)4 * D * D * 2;
constexpr size_t O_WMLA = O_WOUT + SZ_WOUT,              SZ_WMLA = (size_t)4 * MLAN * 512 * 2;
constexpr size_t O_H = O_WMLA + SZ_WMLA,                 SZ_H = (size_t)MP * D * 4;
constexpr size_t O_HB = O_H + SZ_H,                      SZ_HB = (size_t)MP * D * 2;
constexpr size_t O_U = O_HB + SZ_HB,                     SZ_U = (size_t)MP * NINP * 4;
constexpr size_t O_ACT = O_U;
constexpr size_t O_AMLA = O_U + SZ_U,                    SZ_AMLA = (size_t)MP * 512 * 2;
constexpr size_t O_QKV = O_AMLA + SZ_AMLA,               SZ_QKV = (size_t)MP * MLAN * 4;
constexpr size_t O_Q = O_QKV + SZ_QKV,                   SZ_Q = (size_t)TSEQ * 768 * 2;
constexpr size_t O_K = O_Q + SZ_Q;
constexpr size_t O_VT = O_K + SZ_Q,                      SZ_VT = (size_t)4 * 128 * TSEQ * 2;
constexpr size_t O_Y = O_VT + SZ_VT,                     SZ_Y = (size_t)MP * D * 2;
constexpr size_t O_XBC = O_Y + SZ_Y,                     SZ_XBC = (size_t)MP * 1024 * 4;
constexpr size_t O_DT = O_XBC + SZ_XBC,                  SZ_DT = (size_t)MP * 8 * 4;
constexpr size_t O_LA = O_DT + SZ_DT;
constexpr size_t O_SST = O_LA + SZ_DT,                   SZ_SST = (size_t)NCH * 8 * 64 * 128 * 4;
constexpr size_t O_SDEC = O_SST + SZ_SST,                SZ_SDEC = (size_t)NCH * 8 * 128;
constexpr size_t O_YZ = O_SDEC + SZ_SDEC,                SZ_YZ = (size_t)MP * 512 * 4;
constexpr size_t O_RQK = O_YZ + SZ_YZ,                   SZ_RQK = (size_t)MP * 512 * 4;
constexpr size_t O_RST = O_RQK + SZ_RQK,                 SZ_RST = (size_t)NCH * 4 * 128 * 64 * 4;
constexpr size_t O_RW = O_RST + SZ_RST,                  SZ_RW1 = (size_t)MP * 512 * 4;
constexpr size_t O_RBON = O_RW + 8 * SZ_RW1,             SZ_RBON = (size_t)MP * 8 * 4;
constexpr size_t O_ROPE = O_RBON + SZ_RBON,              SZ_ROPE = (size_t)MP * 32 * 8;
constexpr size_t O_MATS = O_ROPE + SZ_ROPE,             SZ_MATS = (size_t)129 * 8 * 16384 * 4;
constexpr size_t O_SSTATE = O_RW + 7 * SZ_RW1;
constexpr size_t WS_END = O_MATS + SZ_MATS;
static_assert((size_t)129 * 8 * 4096 * 4 <= SZ_RW1, "sstate");
static_assert(WS_END <= 1424122240ull, "d_ws map too large");
static_assert(O_SS + (size_t)12 * MP * 32 * 4 <= SZ_CTL, "ctl map");
static_assert((size_t)MP * DFF * 2 <= SZ_U, "act overlays u");

constexpr int RING_BYTES = 131072;
constexpr int LDSCTL_OFF = 143360;
constexpr int LDS_BYTES = 147456;

#define LDS_WAIT() asm volatile("s_waitcnt lgkmcnt(0)" ::: "memory")
#define LBAR() do { asm volatile("s_waitcnt lgkmcnt(0)" ::: "memory"); __builtin_amdgcn_s_barrier(); asm volatile("" ::: "memory"); } while (0)
constexpr int CW_QUEUE = 8192;
#define VM_WAIT() asm volatile("s_waitcnt vmcnt(0)" ::: "memory")
__device__ __forceinline__ unsigned f2bf(float f) { unsigned u = __builtin_bit_cast(unsigned, f); return (u + 0x7fffu + ((u >> 16) & 1u)) >> 16; }
__device__ __forceinline__ unsigned pk2(float lo, float hi) { return f2bf(lo) | (f2bf(hi) << 16); }
typedef __bf16 bf16x2_t __attribute__((ext_vector_type(2)));
__device__ __forceinline__ unsigned cvtpk(float lo, float hi) { const f32x2 v = {lo, hi}; return __builtin_bit_cast(unsigned, __builtin_convertvector(v, bf16x2_t)); }
__device__ __forceinline__ int lane_id() { unsigned ones = ~0u; asm volatile("" : "+s"(ones)); return (int)__builtin_amdgcn_mbcnt_hi(ones, __builtin_amdgcn_mbcnt_lo(ones, 0u)); }
__device__ __forceinline__ float wave_sum(float v) {
#pragma unroll
    for (int o = 1; o < 64; o <<= 1) v += __shfl_xor(v, o);
    return v;
}
__device__ __forceinline__ float sigmoidf_(float x) { return 1.0f / (1.0f + __expf(-x)); }
__device__ __forceinline__ float siluf_(float x) { return x / (1.0f + __expf(-x)); }
__device__ __forceinline__ float softplusf_(float x) { return x > 20.f ? x : log1pf(expf(x)); }
struct UB { const bf16* p;
    __device__ __forceinline__ float operator[](size_t i) const { return __builtin_bit_cast(float, (unsigned)p[i] << 16); }
    __device__ __forceinline__ UB operator+(size_t o) const { return UB{p + o}; } };
__device__ __forceinline__ f32x4 ldu4(const UB u) { const v2u w = *(const v2u*)u.p;
    return (f32x4){__builtin_bit_cast(float, w.x << 16), __builtin_bit_cast(float, w.x & 0xffff0000u), __builtin_bit_cast(float, w.y << 16), __builtin_bit_cast(float, w.y & 0xffff0000u)}; }
__device__ __forceinline__ int row_of_seq(int s) { return s < NMETA ? SEQ + s : s - NMETA; }
__device__ __forceinline__ int seq_of_row(int r) { return r >= SEQ ? r - SEQ : r + NMETA; }
__device__ __forceinline__ int prev_row(int r) { return r == SEQ ? -1 : (r == 0 ? T - 1 : r - 1); }
__device__ __forceinline__ int crow(int c, int p) { return c == 0 ? (p >= 112 ? SEQ + p - 112 : -1) : 128 * (c - 1) + p; }
namespace pg8 {
#define PG8_LAS __attribute__((address_space(3)))
typedef unsigned short bf16_t;
typedef short bf16x8 __attribute__((ext_vector_type(8)));
typedef float f32x4 __attribute__((ext_vector_type(4)));
typedef unsigned u32x4 __attribute__((ext_vector_type(4)));
constexpr int BM = 256, BK = 64, HALF = 128, HTB = HALF * BK * 2  , STAGE_BYTES = 8 * HTB, NXCD = 8, WGM = 8;

__host__ __device__ __forceinline__ int lds_byte(int r, int c) { const int st = (r >> 4) * 2 + (c >> 5), rr = r & 15, cc = c & 31, ob = rr * 64 + cc * 2; return st * 1024 + (ob ^ (((ob >> 9) & 1) << 5)); }
__host__ __device__ __forceinline__ void stage_rc(int b, int& R, int& C) { const int st = b / 1024, sb = b % 1024, swz = sb ^ (((sb >> 9) & 1) << 5); R = (st >> 1) * 16 + swz / 64; C = (st & 1) * 32 + (swz % 64) / 2; }
__host__ __device__ __forceinline__ int perm32(int rho) { const int n = rho >> 4, i = rho & 15; return 8 * (i >> 2) + 4 * n + (i & 3); }

struct Unit { int pm, pn, ah; };
struct Gemm { const bf16_t* A; const bf16_t* Bt; int M, N, K, lda, ldb, wv; };

struct StaticOrder {
    int nM, nN, nwg, G, c, lim, hmbase;
    __host__ __device__ void init(int M, int N, int G_, int c_) { nM = M / BM; nN = N / BM; nwg = nM * nN; G = G_; c = c_; lim = nwg; hmbase = -1; }
    __host__ __device__ bool next(int i, Unit& u) const {
        long L; u.ah = 0;
        if (hmbase >= 0) { if (i > 0) return false; L = hmbase + (c >> 1); u.ah = c & 1; if (L >= nwg) return false; }
        else { L = (long)i * G + c; if (L >= lim) return false; }
        int wgid = (int)L; { const int q = nwg / NXCD, r = nwg % NXCD, xcd = wgid % NXCD, off = wgid / NXCD; wgid = (xcd < r ? xcd * (q + 1) : r * (q + 1) + (xcd - r) * q) + off; }
        const int nig = WGM * nN, gid = wgid / nig, fm = gid * WGM, gsz = (nM - fm) < WGM ? (nM - fm) : WGM;
        u.pm = fm + ((wgid % nig) % gsz); u.pn = (wgid % nig) / gsz; return true;
    }
    __device__ __forceinline__ void a_ready(const Unit&) const {}
    __device__ __forceinline__ void done(const Unit&) const {}
};

__device__ __forceinline__ unsigned cvt_pk_bf16(float lo, float hi) { unsigned r; asm volatile("v_cvt_pk_bf16_f32 %0, %1, %2" : "=v"(r) : "v"(lo), "v"(hi)); return r; }

template <class Epi, class Sched, bool ALIGN_EPI = false, bool SP2 = false, bool HM = false>
__device__ __forceinline__ void gemm_phase(PG8_LAS unsigned char* lds, const Gemm g, const Sched& S, const Epi& E) {
    int tid = g.wv * 64 + lane_id(); asm volatile("" : "+v"(tid)); const int wid = g.wv, lane = tid & 63, wr = wid >> 2, wc = wid & 3, fr = lane & 15, fq = lane >> 4;
    const int K = g.K, nt = K / BK;
    unsigned voffA[2], voffB[2];
#pragma unroll
    for (int i = 0; i < 2; ++i) { int R, C; stage_rc(tid * 16 + i * 8192, R, C); const int Rb = Epi::PERM ? ((R & ~31) + perm32(R & 31)) : R;
        voffA[i] = (unsigned)(R * g.lda + C) * 2u; voffB[i] = (unsigned)(Rb * g.ldb + C) * 2u; }
    const size_t kstep = (size_t)(BK * 2);
    const size_t hA = (size_t)HALF * g.lda * 2, hB = (size_t)HALF * g.ldb * 2;
    const size_t tA = 2 * hA, tB = 2 * hB;
    const unsigned ldsw = (unsigned)wid * 1024u;
    const int aoff = lds_byte(wr * 64 + fr, fq * 8), boff = lds_byte(wc * 32 + fr, fq * 8);
#define PG8_SA(b, h) (((b) * 2 + (h)) * HTB)
#define PG8_SB(b, h) ((4 + (b) * 2 + (h)) * HTB)
#define PG8_STAGE(bufoff, gbase, voff) do { _Pragma("unroll") for (int _i = 0; _i < 2; ++_i) \
        __builtin_amdgcn_global_load_lds((const unsigned*)((const char*)(gbase) + (voff)[_i]), (PG8_LAS unsigned*)(lds + (bufoff) + ldsw + _i * 8192), 16, 0, 0); } while (0)
#define PG8_LDA(dst, b, h) do { _Pragma("unroll") for (int m = 0; m < 4; ++m) _Pragma("unroll") for (int k = 0; k < 2; ++k) dst[m][k] = *(const PG8_LAS bf16x8*)(lds + PG8_SA(b, h) + aoff + m * 2048 + k * 1024); } while (0)
#define PG8_LDB(dst, b, h) do { _Pragma("unroll") for (int n = 0; n < 2; ++n) _Pragma("unroll") for (int k = 0; k < 2; ++k) dst[n][k] = *(const PG8_LAS bf16x8*)(lds + PG8_SB(b, h) + boff + n * 2048 + k * 1024); } while (0)
#define PG8_MMA(ai, bj, At, Bt) do { __builtin_amdgcn_s_setprio(1); _Pragma("unroll") for (int m = 0; m < 4; ++m) _Pragma("unroll") for (int n = 0; n < 2; ++n) _Pragma("unroll") for (int k = 0; k < 2; ++k) \
        acc[ai][bj][m][n] = __builtin_amdgcn_mfma_f32_16x16x32_bf16(Bt[n][k], At[m][k], acc[ai][bj][m][n], 0, 0, 0); __builtin_amdgcn_s_setprio(0); } while (0)
#define PG8_WAIT_V(n) asm volatile("s_waitcnt vmcnt(" #n ")" ::: "memory")
#define PG8_WAIT_L(n) asm volatile("s_waitcnt lgkmcnt(" #n ")" ::: "memory")
#define PG8_BAR __builtin_amdgcn_s_barrier()
#define PG8_SCHED __builtin_amdgcn_sched_barrier(0)
    Unit cur, nxt; int ui = 0;
    if (!S.next(0, cur)) return;
    f32x4 acc[2][2][4][2];
#pragma unroll
    for (int a = 0; a < 2; ++a)
#pragma unroll
        for (int b = 0; b < 2; ++b)
#pragma unroll
            for (int m = 0; m < 4; ++m)
#pragma unroll
                for (int n = 0; n < 2; ++n) acc[a][b][m][n] = (f32x4){0.f, 0.f, 0.f, 0.f};
    bf16x8 At[4][2], B0[2][2], B1[2][2];
    const char* cA = (const char*)g.A + (size_t)cur.pm * tA + (size_t)cur.ah * hA; const char* cB = (const char*)g.Bt + (size_t)cur.pn * tB;
    S.a_ready(cur);
    if constexpr (SP2) {
        PG8_STAGE(PG8_SB(0, 0), cB, voffB); PG8_STAGE(PG8_SB(0, 1), cB + hB, voffB); PG8_STAGE(PG8_SA(0, 0), cA, voffA); PG8_STAGE(PG8_SA(0, 1), cA + hA, voffA);
        if (wr == 1) PG8_BAR;
        PG8_WAIT_V(2); PG8_BAR;
        PG8_STAGE(PG8_SB(1, 0), cB + kstep, voffB); PG8_STAGE(PG8_SA(1, 0), cA + kstep, voffA); PG8_STAGE(PG8_SB(1, 1), cB + hB + kstep, voffB);
        PG8_WAIT_V(6); PG8_BAR;
    } else {
        PG8_STAGE(PG8_SB(0, 0), cB, voffB); PG8_STAGE(PG8_SA(0, 0), cA, voffA); PG8_STAGE(PG8_SB(0, 1), cB + hB, voffB); PG8_STAGE(PG8_SA(0, 1), cA + hA, voffA);
        if (wr == 1) PG8_BAR;
        PG8_WAIT_V(4); PG8_BAR;
        PG8_STAGE(PG8_SB(1, 0), cB + kstep, voffB); PG8_STAGE(PG8_SA(1, 0), cA + kstep, voffA); PG8_STAGE(PG8_SB(1, 1), cB + hB + kstep, voffB);
        PG8_WAIT_V(6); PG8_BAR;
    }
    for (;;) {
        const bool has_next = S.next(ui + 1, nxt);
        const char* nA = has_next ? (const char*)g.A + (size_t)nxt.pm * tA + (size_t)nxt.ah * hA : cA; const char* nB = has_next ? (const char*)g.Bt + (size_t)nxt.pn * tB : cB;
        for (int t = 0; t < nt; t += 2) {
            const bool last = (t == nt - 2);
            const char* a1 = cA + (size_t)(t + 1) * kstep;
            const char* a2 = last ? nA : cA + (size_t)(t + 2) * kstep; const char* b2 = last ? nB : cB + (size_t)(t + 2) * kstep;
            const char* a3 = a2 + kstep; const char* b3 = b2 + kstep;
            if (last && has_next) S.a_ready(nxt);
            if constexpr (SP2) {
            PG8_LDB(B0, 0, 0); PG8_LDB(B1, 0, 1); PG8_SCHED; PG8_LDA(At, 0, 0); PG8_STAGE(PG8_SA(1, 1), a1 + hA, voffA);
            PG8_WAIT_V(8); PG8_WAIT_L(0); PG8_BAR; PG8_MMA(0, 0, At, B0); PG8_MMA(0, 1, At, B1); PG8_BAR; PG8_SCHED;
            if constexpr (!HM) PG8_LDA(At, 0, 1); PG8_STAGE(PG8_SB(0, 0), b2, voffB); PG8_STAGE(PG8_SB(0, 1), b2 + hB, voffB); PG8_STAGE(PG8_SA(0, 0), a2, voffA);
            PG8_WAIT_V(8); PG8_WAIT_L(0); PG8_BAR; if constexpr (!HM) { PG8_MMA(1, 0, At, B0); PG8_MMA(1, 1, At, B1); } PG8_BAR; PG8_SCHED;
            PG8_LDB(B0, 1, 0); PG8_LDB(B1, 1, 1); PG8_SCHED; PG8_LDA(At, 1, 0); PG8_STAGE(PG8_SA(0, 1), a2 + hA, voffA);
            PG8_WAIT_V(8); PG8_WAIT_L(0); PG8_BAR; PG8_MMA(0, 0, At, B0); PG8_MMA(0, 1, At, B1); PG8_BAR; PG8_SCHED;
            if constexpr (!HM) PG8_LDA(At, 1, 1); PG8_STAGE(PG8_SB(1, 0), b3, voffB); PG8_STAGE(PG8_SB(1, 1), b3 + hB, voffB); PG8_STAGE(PG8_SA(1, 0), a3, voffA);
            PG8_WAIT_V(8); PG8_WAIT_L(0); PG8_BAR; if constexpr (!HM) { PG8_MMA(1, 0, At, B0); PG8_MMA(1, 1, At, B1); } PG8_BAR; PG8_SCHED;
            } else {
            PG8_LDB(B0, 0, 0); PG8_SCHED; PG8_LDA(At, 0, 0); PG8_STAGE(PG8_SA(1, 1), a1 + hA, voffA);
            PG8_WAIT_L(8); PG8_BAR; PG8_WAIT_L(0); PG8_MMA(0, 0, At, B0); PG8_BAR; PG8_SCHED;
            PG8_LDB(B1, 0, 1); PG8_STAGE(PG8_SB(0, 0), b2, voffB);
            PG8_BAR; PG8_WAIT_L(0); PG8_MMA(0, 1, At, B1); PG8_BAR;
            PG8_LDA(At, 0, 1); PG8_STAGE(PG8_SA(0, 0), a2, voffA);
            PG8_BAR; PG8_WAIT_L(0); PG8_MMA(1, 0, At, B0); PG8_BAR; PG8_SCHED;
            PG8_STAGE(PG8_SB(0, 1), b2 + hB, voffB);
            PG8_WAIT_V(6); PG8_BAR; PG8_MMA(1, 1, At, B1); PG8_BAR;
            PG8_LDB(B0, 1, 0); PG8_SCHED; PG8_LDA(At, 1, 0); PG8_STAGE(PG8_SA(0, 1), a2 + hA, voffA);
            PG8_WAIT_L(8); PG8_BAR; PG8_WAIT_L(0); PG8_MMA(0, 0, At, B0); PG8_BAR; PG8_SCHED;
            PG8_LDB(B1, 1, 1); PG8_STAGE(PG8_SB(1, 0), b3, voffB);
            PG8_BAR; PG8_WAIT_L(0); PG8_MMA(0, 1, At, B1); PG8_BAR;
            PG8_LDA(At, 1, 1); PG8_STAGE(PG8_SA(1, 0), a3, voffA);
            PG8_BAR; PG8_WAIT_L(0); PG8_MMA(1, 0, At, B0); PG8_BAR; PG8_SCHED;
            PG8_STAGE(PG8_SB(1, 1), b3 + hB, voffB);
            PG8_WAIT_V(6); PG8_BAR; PG8_MMA(1, 1, At, B1); PG8_BAR;
            }
        }
        if constexpr (ALIGN_EPI) { if (wr == 0) PG8_BAR; }
        if constexpr (!Epi::AFTER_DRAIN) { E(acc, cur, wr, wc, fr, fq); S.done(cur); }
        if (!has_next) break;
#pragma unroll
        for (int a = 0; a < 2; ++a)
#pragma unroll
            for (int b = 0; b < 2; ++b)
#pragma unroll
                for (int m = 0; m < 4; ++m)
#pragma unroll
                    for (int n = 0; n < 2; ++n) acc[a][b][m][n] = (f32x4){0.f, 0.f, 0.f, 0.f};
        cur = nxt; cA = nA; cB = nB; ++ui;
        if constexpr (ALIGN_EPI) { if (wr == 1) PG8_BAR; }
    }
    PG8_WAIT_V(0);
    if constexpr (!ALIGN_EPI) { if (wr == 0) PG8_BAR; }
    PG8_BAR;
    if constexpr (Epi::AFTER_DRAIN) { E.fused(acc, cur, wr, wc, fr, fq, lds, wid, lane); S.done(cur); }
#undef PG8_SA
#undef PG8_SB
#undef PG8_STAGE
#undef PG8_LDA
#undef PG8_LDB
#undef PG8_MMA
#undef PG8_WAIT_V
#undef PG8_WAIT_L
#undef PG8_BAR
#undef PG8_SCHED
}

__device__ __forceinline__ float row_ss(const float* ss, int row, int fq) {
    const f32x4 a = *(const f32x4*)(ss + (size_t)row * 32 + 8 * fq), b = *(const f32x4*)(ss + (size_t)row * 32 + 8 * fq + 4);
    float s = ((a[0] + a[1]) + (a[2] + a[3])) + ((b[0] + b[1]) + (b[2] + b[3]));
    s += __shfl_xor(s, 16); s += __shfl_xor(s, 32); return s;
}
struct EpiScaleF32 {
    static constexpr bool PERM = false, AFTER_DRAIN = false;
    float* C; int ldc; const float* ss; float inv_d, eps;
    __device__ __forceinline__ void operator()(const f32x4 (&acc)[2][2][4][2], const Unit& u, int wr, int wc, int fr, int fq) const {
        const int row0 = u.pm * BM + wr * 64 + fr, col0 = u.pn * BM + wc * 32 + 4 * fq;
#pragma unroll
        for (int ai = 0; ai < 2; ++ai)
#pragma unroll
            for (int m = 0; m < 4; ++m) { const int row = row0 + ai * HALF + m * 16; float* rowp = C + (size_t)row * ldc + col0;
                const float rs = ss ? __builtin_amdgcn_rsqf(row_ss(ss, row, fq) * inv_d + eps) : 1.0f;
#pragma unroll
                for (int bj = 0; bj < 2; ++bj)
#pragma unroll
                    for (int n = 0; n < 2; ++n) *(f32x4*)(rowp + bj * HALF + n * 16) = acc[ai][bj][m][n] * rs; }
    }
};
struct EpiScaleBf16 {
    static constexpr bool PERM = true, AFTER_DRAIN = false;
    bf16_t* O; int ldo; const float* ss; float inv_d, eps;
    __device__ __forceinline__ void operator()(const f32x4 (&acc)[2][2][4][2], const Unit& u, int wr, int wc, int fr, int fq) const {
        const int row0 = u.pm * BM + wr * 64 + fr, col0 = u.pn * BM + wc * 32 + 8 * fq;
#pragma unroll
        for (int ai = 0; ai < 2; ++ai)
#pragma unroll
            for (int m = 0; m < 4; ++m) { const int row = row0 + ai * HALF + m * 16; const float rs = __builtin_amdgcn_rsqf(row_ss(ss, row, fq) * inv_d + eps);
#pragma unroll
                for (int bj = 0; bj < 2; ++bj) { const f32x4 v0 = acc[ai][bj][m][0] * rs, v1 = acc[ai][bj][m][1] * rs;
                    u32x4 w; w.x = cvt_pk_bf16(v0[0], v0[1]); w.y = cvt_pk_bf16(v0[2], v0[3]); w.z = cvt_pk_bf16(v1[0], v1[1]); w.w = cvt_pk_bf16(v1[2], v1[3]);
                    *(u32x4*)(O + (size_t)row * ldo + col0 + bj * HALF) = w; } }
    }
};
struct EpiSwiGLU {
    static constexpr bool PERM = true, AFTER_DRAIN = false;
    bf16_t* O; int ldo; const float* ss; float inv_d, eps; int nai;
    __device__ __forceinline__ void operator()(const f32x4 (&acc)[2][2][4][2], const Unit& u, int wr, int wc, int fr, int fq) const {
        const int row0 = u.pm * BM + u.ah * HALF + wr * 64 + fr, col0 = u.pn * HALF + wc * 32 + 8 * fq;
#pragma unroll
        for (int ai = 0; ai < 2; ++ai) { if (ai >= nai) break;
#pragma unroll
            for (int m = 0; m < 4; ++m) { const int row = row0 + ai * HALF + m * 16;
                const float rs = __builtin_amdgcn_rsqf(row_ss(ss, row, fq) * inv_d + eps);
                float o[8];
#pragma unroll
                for (int n = 0; n < 2; ++n)
#pragma unroll
                    for (int j = 0; j < 4; ++j) { const float gv = acc[ai][0][m][n][j] * rs, uv = acc[ai][1][m][n][j] * rs; o[n * 4 + j] = gv * uv * __builtin_amdgcn_rcpf(1.0f + __expf(-gv)); }
                u32x4 w; w.x = cvt_pk_bf16(o[0], o[1]); w.y = cvt_pk_bf16(o[2], o[3]); w.z = cvt_pk_bf16(o[4], o[5]); w.w = cvt_pk_bf16(o[6], o[7]);
                *(u32x4*)(O + (size_t)row * ldo + col0) = w; } }
    }
};
struct EpiResidual {
    static constexpr bool PERM = true, AFTER_DRAIN = false;
    float* H; bf16_t* HB; float* ss_out; float* out; int out_rows; float scale;
    __device__ __forceinline__ void operator()(const f32x4 (&acc)[2][2][4][2], const Unit& u, int wr, int wc, int fr, int fq) const {
        const int row0 = u.pm * BM + wr * 64 + fr, col0 = u.pn * BM + wc * 32 + 8 * fq;
#pragma unroll
        for (int ai = 0; ai < 2; ++ai)
#pragma unroll
            for (int m = 0; m < 4; ++m) { const int row = row0 + ai * HALF + m * 16; float sq = 0.f;
#pragma unroll
                for (int bj = 0; bj < 2; ++bj) { const size_t off = (size_t)row * 2048 + col0 + bj * HALF;
                    f32x4 h0 = *(const f32x4*)(H + off), h1 = *(const f32x4*)(H + off + 4);
                    h0 = h0 + acc[ai][bj][m][0] * scale; h1 = h1 + acc[ai][bj][m][1] * scale;
                    *(f32x4*)(H + off) = h0; *(f32x4*)(H + off + 4) = h1;
                    if (out && row < out_rows) { *(f32x4*)(out + off) = h0; *(f32x4*)(out + off + 4) = h1; }
                    u32x4 w; w.x = cvt_pk_bf16(h0[0], h0[1]); w.y = cvt_pk_bf16(h0[2], h0[3]); w.z = cvt_pk_bf16(h1[0], h1[1]); w.w = cvt_pk_bf16(h1[2], h1[3]);
                    *(u32x4*)(HB + off) = w;
                    sq += (h0[0] * h0[0] + h0[1] * h0[1]) + (h0[2] * h0[2] + h0[3] * h0[3]) + (h1[0] * h1[0] + h1[1] * h1[1]) + (h1[2] * h1[2] + h1[3] * h1[3]); }
                sq += __shfl_xor(sq, 16); sq += __shfl_xor(sq, 32);
                if (fq == 0 && ss_out) __hip_atomic_fetch_add(ss_out + (size_t)row * 32 + u.pn * 4 + wc, sq, __ATOMIC_RELAXED, __HIP_MEMORY_SCOPE_AGENT); }
    }
};
}
#define XB_TMO      128
#define XB_XCNT(j)  (256  + 64 * (j))
#define XB_XSUB(j)  (1280 + 64 * (j))
#define XB_XGEN(j)  (2304 + 64 * (j))
#define XB_TOP      3328
#define XB_TOPGEN   3392
#define XCD_BAR_WORDS 3456
#define XB_SPIN_CAP (1u << 18)

__device__ __forceinline__ unsigned xb_ld(unsigned* p)              { return __hip_atomic_load(p, __ATOMIC_RELAXED, __HIP_MEMORY_SCOPE_AGENT); }
__device__ __forceinline__ unsigned xb_add(unsigned* p, unsigned v) { return __hip_atomic_fetch_add(p, v, __ATOMIC_RELAXED, __HIP_MEMORY_SCOPE_AGENT); }
__device__ __forceinline__ unsigned xb_xcc_id() { return (unsigned)__builtin_amdgcn_s_getreg((3 << 11) | 20) & 0xFu; }
#define XB_SPIN(cond, bar) do { unsigned _sp = 0; while (cond) { __builtin_amdgcn_s_sleep(1); \
    if ((++_sp & 255u) == 0u) { if (xb_ld(&(bar)[XB_TMO])) break; if (_sp > XB_SPIN_CAP) { atomicAdd(&(bar)[XB_TMO], 1u); break; } } } } while (0)

struct XcdBarrier {
    unsigned* bar; unsigned x;
    volatile LAS unsigned* st;
};

__device__ __forceinline__ XcdBarrier xcd_barrier_post(unsigned* bar, volatile LAS unsigned* st, int wv) {
    XcdBarrier b; b.bar = bar; b.x = xb_xcc_id(); b.st = st;
    if ((wv == 0 && lane_id() == 0)) (void)xb_add(&bar[XB_XCNT(b.x)], 1u);
    return b;
}
__device__ __forceinline__ void xcd_barrier_complete(unsigned* bar, unsigned x, unsigned& nloc, unsigned& nx) {
    const unsigned G = gridDim.x * gridDim.y * gridDim.z;
    unsigned sum, cnt, mine, sp = 0u;
    for (;;) {
        sum = 0u; cnt = 0u; mine = 0u;
#pragma unroll
        for (unsigned j = 0; j < 16; ++j) { const unsigned c = xb_ld(&bar[XB_XCNT(j)]); sum += c; cnt += (c > 0u) ? 1u : 0u; mine = (j == x) ? c : mine; }
        if (sum == G) break;
        __builtin_amdgcn_s_sleep(1);
        if ((++sp & 255u) == 0u) { if (xb_ld(&bar[XB_TMO])) break; if (sp > XB_SPIN_CAP) { atomicAdd(&bar[XB_TMO], 1u); break; } }
    }
    nloc = mine > 0u ? mine : 1u; nx = cnt > 0u ? cnt : 1u;
}

__device__ __forceinline__ void xcd_barrier(const XcdBarrier& b, int wv) {
    asm volatile("s_waitcnt vmcnt(0)" ::: "memory");
    __syncthreads();
    if ((wv == 0 && lane_id() == 0)) {
        unsigned* bar = b.bar;
        __builtin_amdgcn_s_waitcnt(0);
        unsigned nloc = b.st[0], nx = b.st[1];
        if (nloc == 0u) { xcd_barrier_complete(bar, b.x, nloc, nx); b.st[0] = nloc; b.st[1] = nx; }
        const unsigned old = xb_add(&bar[XB_XSUB(b.x)], 1u);
        const unsigned gen = old / nloc;
        if (old + 1u == (gen + 1u) * nloc) {
            __builtin_amdgcn_fence(__ATOMIC_RELEASE, "agent");
            asm volatile("s_waitcnt vmcnt(0)" ::: "memory");
            const unsigned og = xb_add(&bar[XB_TOP], 1u);
            const unsigned tg = og / nx;
            if (og + 1u == (tg + 1u) * nx) xb_add(&bar[XB_TOPGEN], 1u);
            else XB_SPIN(xb_ld(&bar[XB_TOPGEN]) == tg, bar);
            __builtin_amdgcn_fence(__ATOMIC_ACQUIRE, "agent");
            xb_add(&bar[XB_XGEN(b.x)], 1u);
            asm volatile("s_waitcnt vmcnt(0)" ::: "memory");
        } else {
            XB_SPIN(xb_ld(&bar[XB_XGEN(b.x)]) == gen, bar);
            __builtin_amdgcn_fence(__ATOMIC_ACQUIRE, "agent");
            asm volatile("s_waitcnt vmcnt(0)" ::: "memory");
        }
    }
    __syncthreads();
}

struct P { const float* in[36]; float* out; unsigned char* ws; int ph_lo, ph_hi; };
enum { I_X = 0, I_META, I_F1N, I_F1G, I_F1U, I_F1D, I_MIXN, I_WIN, I_WOUT, I_QN, I_WQ, I_KVN, I_WKV, I_QKNQ, I_QKNK, I_CONVW, I_CONVB, I_DTB, I_ALOG, I_SSDD, I_SSDN, I_RETN,
       I_MU, I_W0, I_W2, I_A0, I_A2, I_G2, I_KK, I_KA, I_RK, I_LN, I_F2N, I_F2G, I_F2U, I_F2D };
#define CAS __attribute__((address_space(4)))
typedef const CAS P* KPtr;
struct Ctx { LAS unsigned char* lds; unsigned char* ws; KPtr kp; int tid, lane, wave, G, bid; };
__device__ __forceinline__ Ctx ctx_make(LAS unsigned char* lds, int wv) {
    Ctx F; KPtr kp = (KPtr)__builtin_amdgcn_kernarg_segment_ptr(); asm volatile("" : "+s"(kp)); int t = wv * 64 + lane_id(); asm volatile("" : "+v"(t));
    F.lds = lds; F.kp = kp; F.ws = kp->ws; F.tid = t; F.lane = t & 63; F.wave = __builtin_amdgcn_readfirstlane(t >> 6); F.G = gridDim.x; F.bid = blockIdx.x; return F;
}


__device__ __forceinline__ int queue_next(const Ctx& F, unsigned* ctr) {
    volatile LAS unsigned* slot = (volatile LAS unsigned*)(F.lds + LDSCTL_OFF + 64);
    __syncthreads();
    if (F.tid == 0) *slot = __hip_atomic_fetch_add(ctr, 1u, __ATOMIC_RELAXED, __HIP_MEMORY_SCOPE_AGENT);
    __syncthreads();
    return (int)*slot;
}
__device__ __forceinline__ f32x16 zero16() { f32x16 z;
#pragma unroll
    for (int i = 0; i < 16; ++i) z[i] = 0.f; return z; }
__device__ __forceinline__ void mma32(f32x16& acc, const LAS float* Ap, int sAi, int sAk, const LAS float* Bp, int sBk, int sBj, int K, int lane) {
    const int r = lane & 31, hh = lane >> 5;
    const LAS float* a = Ap + r * sAi + hh * sAk; const LAS float* b = Bp + hh * sBk + r * sBj;
#pragma unroll 4
    for (int k = 0; k < K; k += 2) acc = __builtin_amdgcn_mfma_f32_32x32x2f32(a[k * sAk], b[k * sBk], acc, 0, 0, 0);
}
__device__ __forceinline__ void mma32bf(f32x16& acc, const LAS float* Ap, int sAi, const LAS float* Bp, int sBj, int K, int lane) {
    const int r = lane & 31, hh = lane >> 5; const LAS float* a = Ap + r * sAi + 8 * hh; const LAS float* b = Bp + r * sBj + 8 * hh;
#pragma unroll 2
    for (int k = 0; k < K; k += 16) { const f32x4 a0 = *(const LAS f32x4*)(a + k), a1 = *(const LAS f32x4*)(a + k + 4), b0 = *(const LAS f32x4*)(b + k), b1 = *(const LAS f32x4*)(b + k + 4);
        v4u aw, bw; aw.x = cvtpk(a0[0], a0[1]); aw.y = cvtpk(a0[2], a0[3]); aw.z = cvtpk(a1[0], a1[1]); aw.w = cvtpk(a1[2], a1[3]); bw.x = cvtpk(b0[0], b0[1]); bw.y = cvtpk(b0[2], b0[3]); bw.z = cvtpk(b1[0], b1[1]); bw.w = cvtpk(b1[2], b1[3]);
        acc = __builtin_amdgcn_mfma_f32_32x32x16_bf16(__builtin_bit_cast(bf16x8, aw), __builtin_bit_cast(bf16x8, bw), acc, 0, 0, 0); }
}
__device__ __forceinline__ int rreg(int reg, int lane) { return (reg & 3) + 8 * (reg >> 2) + 4 * (lane >> 5); }

__device__ __forceinline__ void cvt_tile(const float* src, int srcN, const float* gain, int valid, bf16* dst, int ldd, LAS float* scr, int lane) {
    const int c4 = lane & 15, r0 = lane >> 4;
    f32x4 v[16];
#pragma unroll
    for (int i = 0; i < 16; ++i) v[i] = (4 * c4 < valid) ? *(const f32x4*)(src + (size_t)(r0 + 4 * i) * srcN + 4 * c4) : (f32x4){0.f, 0.f, 0.f, 0.f};
#pragma unroll
    for (int i = 0; i < 16; ++i) { const int kk = r0 + 4 * i; const float gk = gain ? gain[kk] : 1.0f; LAS float* d = scr + kk * 65 + 4 * c4; d[0] = v[i][0] * gk; d[1] = v[i][1] * gk; d[2] = v[i][2] * gk; d[3] = v[i][3] * gk; }
    LDS_WAIT(); asm volatile("" ::: "memory");
    const int c8 = lane & 7;
#pragma unroll
    for (int j = 0; j < 8; ++j) { const int n = (lane >> 3) + 8 * j; const LAS float* s = scr + (8 * c8) * 65 + n;
        v4u o; o.x = pk2(s[0], s[65]); o.y = pk2(s[130], s[195]); o.z = pk2(s[260], s[325]); o.w = pk2(s[390], s[455]);
        *(v4u*)(dst + (size_t)n * ldd + 8 * c8) = o; }
    LDS_WAIT(); asm volatile("" ::: "memory");
}
__device__ __forceinline__ void convert_layer(const Ctx& F, int L, int gw, int NGW) {
    LAS float* scr = (LAS float*)(F.lds + F.wave * 17408);
    const int lane = F.lane;
    constexpr int IT_GU = 2 * 32 * 176, IT_D = 2 * 88 * 32, IT_IN = 32 * 84, IT_OUT = 32 * 32, IT_MLA = 8 * 28;
    bf16* WGU = (bf16*)(F.ws + O_WGU); bf16* WD = (bf16*)(F.ws + O_WD); bf16* WIN = (bf16*)(F.ws + O_WIN); bf16* WOUT = (bf16*)(F.ws + O_WOUT); bf16* WMLA = (bf16*)(F.ws + O_WMLA);
    const int l = L;
    for (int it = gw; it < IT_GU + IT_D + IT_IN + IT_OUT + IT_MLA; it += NGW) {
        int r = it;
        if (r < IT_GU) { const int which = r / 5632, f = 2 * l + which, q = r % 5632, kb = q / 176, nb = q % 176, n0 = 64 * nb, pn = n0 >> 8, within = n0 & 255, isup = within >= 128, f0 = 128 * pn + (within & 127);
            const float* src = (which ? (isup ? F.kp->in[I_F2U] : F.kp->in[I_F2G]) : (isup ? F.kp->in[I_F1U] : F.kp->in[I_F1G])) + (size_t)l * D * DFF + (size_t)(64 * kb) * DFF + f0;
            const float* gain = (which ? F.kp->in[I_F2N] : F.kp->in[I_F1N]) + l * D + 64 * kb;
            cvt_tile(src, DFF, gain, 64, WGU + (size_t)f * 11264 * 2048 + (size_t)n0 * 2048 + 64 * kb, 2048, scr, lane); continue; }
        r -= IT_GU;
        if (r < IT_D) { const int which = r / 2816, f = 2 * l + which, q = r % 2816, kb = q / 32, nb = q % 32;
            const float* src = (which ? F.kp->in[I_F2D] : F.kp->in[I_F1D]) + (size_t)l * DFF * D + (size_t)(64 * kb) * D + 64 * nb;
            cvt_tile(src, D, nullptr, 64, WD + (size_t)f * 2048 * 5632 + (size_t)(64 * nb) * 5632 + 64 * kb, 5632, scr, lane); continue; }
        r -= IT_D;
        if (r < IT_IN) { const int q = r, kb = q / 84, nb = q % 84, n0 = 64 * nb; int valid = NIN - n0; valid = valid < 0 ? 0 : (valid > 64 ? 64 : valid);
            const float* src = F.kp->in[I_WIN] + (size_t)l * D * NIN + (size_t)(64 * kb) * NIN + n0;
            cvt_tile(src, NIN, F.kp->in[I_MIXN] + l * D + 64 * kb, valid, WIN + (size_t)l * NINP * D + (size_t)n0 * D + 64 * kb, D, scr, lane); continue; }
        r -= IT_IN;
        if (r < IT_OUT) { const int q = r, kb = q / 32, nb = q % 32;
            const float* src = F.kp->in[I_WOUT] + (size_t)l * D * D + (size_t)(64 * kb) * D + 64 * nb;
            cvt_tile(src, D, nullptr, 64, WOUT + (size_t)l * D * D + (size_t)(64 * nb) * D + 64 * kb, D, scr, lane); continue; }
        r -= IT_OUT;
        { const int q = r, kb = q / 28, nb = q % 28, n0 = 64 * nb, k0 = 64 * kb;
            const float* src; int srcN, valid;
            if (n0 < 768) { valid = k0 < 384 ? 64 : 0; src = F.kp->in[I_WQ] + (size_t)l * 384 * 768 + (size_t)k0 * 768 + n0; srcN = 768; }
            else { valid = k0 >= 384 ? 64 : 0; src = F.kp->in[I_WKV] + (size_t)l * 128 * 1024 + (size_t)(k0 - 384) * 1024 + (n0 - 768); srcN = 1024; }
            cvt_tile(src, srcN, nullptr, valid, WMLA + (size_t)l * MLAN * 512 + (size_t)n0 * 512 + k0, 512, scr, lane); }
    }
}
__device__ __forceinline__ void p0_prologue(const Ctx& F, int cvt_only) {
    const int gw = F.bid * NWAVES + F.wave, NGW = F.G * NWAVES, lane = F.lane;
    convert_layer(F, 0, gw, NGW);
    if (cvt_only) return;
    float* H = (float*)(F.ws + O_H); bf16* HB = (bf16*)(F.ws + O_HB); float* SS = (float*)(F.ws + O_SS); bf16* Y = (bf16*)(F.ws + O_Y); f32x2* ROPE = (f32x2*)(F.ws + O_ROPE);
    for (int row = gw; row < MP; row += NGW) {
        const float* src = row < SEQ ? F.kp->in[I_X] + (size_t)row * D : F.kp->in[I_META] + (size_t)(row - SEQ) * D;
        float sq = 0.f;
#pragma unroll
        for (int j = 0; j < 8; ++j) { f32x4 v = (f32x4){0.f, 0.f, 0.f, 0.f}; if (row < T) v = *(const f32x4*)(src + 256 * j + 4 * lane);
            *(f32x4*)(H + (size_t)row * D + 256 * j + 4 * lane) = v; v2u w; w.x = pk2(v[0], v[1]); w.y = pk2(v[2], v[3]); *(v2u*)(HB + (size_t)row * D + 256 * j + 4 * lane) = w;
            sq += (v[0] * v[0] + v[1] * v[1]) + (v[2] * v[2] + v[3] * v[3]); }
        sq = wave_sum(sq); if (lane == 0) __hip_atomic_fetch_add(SS + (size_t)row * 32, sq, __ATOMIC_RELAXED, __HIP_MEMORY_SCOPE_AGENT);
#ifdef PROBE_ZERO_Y
        if (true) {
#else
        if (row >= T) {
#endif
#pragma unroll
            for (int j = 0; j < 4; ++j) *(v4u*)(Y + (size_t)row * D + 512 * j + 8 * lane) = (v4u){0u, 0u, 0u, 0u}; }
#ifdef PROBE_ZERO_Y
        if (row < T && lane < 32) { const float inv = powf(10000.0f, -(float)lane / 32.0f); const float ang = (float)seq_of_row(row) * inv; float sn, cs; sincosf(ang, &sn, &cs); ROPE[row * 32 + lane] = (f32x2){cs, sn}; }
#else
        else if (lane < 32) { const float inv = powf(10000.0f, -(float)lane / 32.0f); const float ang = (float)seq_of_row(row) * inv; float sn, cs; sincosf(ang, &sn, &cs); ROPE[row * 32 + lane] = (f32x2){cs, sn}; }
#endif
    }
}

__device__ __forceinline__ void m1_unit(const Ctx& F, int l, int r0, int r1, int grp) {
    const int lane = F.lane, tid = F.tid;
    const float* U = (const float*)(F.ws + O_U);
    if (r0 < r1) { bf16* AM = (bf16*)(F.ws + O_AMLA); const float* qn = F.kp->in[I_QN] + l * 384; const float* kvn = F.kp->in[I_KVN] + l * 128;
#pragma unroll 4
      for (int row = r0 + F.wave; row < r1; row += NWAVES) { const float* ur = U + (size_t)row * NINP + 8 * lane; const f32x4 a = *(const f32x4*)ur, b = *(const f32x4*)(ur + 4);
        const float sq = (a[0] * a[0] + a[1] * a[1]) + (a[2] * a[2] + a[3] * a[3]) + (b[0] * b[0] + b[1] * b[1]) + (b[2] * b[2] + b[3] * b[3]);
        const float sq_q = wave_sum(lane < 48 ? sq : 0.f), sq_kv = wave_sum(lane >= 48 ? sq : 0.f);
        const float rs = lane < 48 ? 1.0f / sqrtf(sq_q * (1.0f / 384.0f) + EPS) : 1.0f / sqrtf(sq_kv * (1.0f / 128.0f) + EPS);
        const float* gp = lane < 48 ? qn + 8 * lane : kvn + 8 * (lane - 48); const f32x4 g0 = *(const f32x4*)gp, g1 = *(const f32x4*)(gp + 4);
        v4u w; w.x = pk2(a[0] * rs * g0[0], a[1] * rs * g0[1]); w.y = pk2(a[2] * rs * g0[2], a[3] * rs * g0[3]); w.z = pk2(b[0] * rs * g1[0], b[1] * rs * g1[1]); w.w = pk2(b[2] * rs * g1[2], b[3] * rs * g1[3]);
        *(v4u*)(AM + (size_t)row * 512 + 8 * lane) = w; } }
    if (r0 < r1) { float* XBC = (float*)(F.ws + O_XBC); float* DT = (float*)(F.ws + O_DT); float* LA = (float*)(F.ws + O_LA);
      const float* cw = F.kp->in[I_CONVW] + l * 4096; const float* cb = F.kp->in[I_CONVB] + l * 1024;
#pragma unroll 4
      for (int row = r0 + F.wave; row < r1; row += NWAVES) { const int p1 = prev_row(row), p2 = p1 >= 0 ? prev_row(p1) : -1, p3 = p2 >= 0 ? prev_row(p2) : -1;
#pragma unroll
        for (int j = 0; j < 4; ++j) { const int ch = 256 * j + 4 * lane; const size_t uo = U_SSD + 512 + ch; const f32x4 z4 = (f32x4){0.f, 0.f, 0.f, 0.f};
            const f32x4 x3 = *(const f32x4*)(U + (size_t)row * NINP + uo), x2 = p1 >= 0 ? *(const f32x4*)(U + (size_t)p1 * NINP + uo) : z4, x1 = p2 >= 0 ? *(const f32x4*)(U + (size_t)p2 * NINP + uo) : z4, x0 = p3 >= 0 ? *(const f32x4*)(U + (size_t)p3 * NINP + uo) : z4;
            f32x4 o = *(const f32x4*)(cb + ch) + *(const f32x4*)(cw + ch) * x0 + *(const f32x4*)(cw + 1024 + ch) * x1 + *(const f32x4*)(cw + 2048 + ch) * x2 + *(const f32x4*)(cw + 3072 + ch) * x3;
            o[0] = siluf_(o[0]); o[1] = siluf_(o[1]); o[2] = siluf_(o[2]); o[3] = siluf_(o[3]);
            *(f32x4*)(XBC + (size_t)row * 1024 + ch) = o; }
        if (lane < 8) { const float dt = softplusf_(U[(size_t)row * NINP + U_SSD + 1536 + lane] + F.kp->in[I_DTB][l * 8 + lane]); DT[row * 8 + lane] = dt; LA[row * 8 + lane] = -expf(F.kp->in[I_ALOG][l * 8 + lane]) * dt; } } }
    if (r0 < r1) { float* RQK = (float*)(F.ws + O_RQK); const f32x2* ROPE = (const f32x2*)(F.ws + O_ROPE);
#pragma unroll 4
      for (int row = r0 + F.wave; row < r1; row += NWAVES) {
#pragma unroll
        for (int j = 0; j < 4; ++j) { const int idx = lane + 64 * j, qk = idx >> 7, hh = (idx >> 5) & 3, i = idx & 31; const f32x2 cs = ROPE[row * 32 + i];
            const float x1 = U[(size_t)row * NINP + U_RET + qk * 256 + hh * 64 + i], x2 = U[(size_t)row * NINP + U_RET + qk * 256 + hh * 64 + 32 + i]; const float sc = qk ? 0.125f : 1.0f;
            RQK[(size_t)row * 512 + qk * 256 + hh * 64 + i] = (x1 * cs.x - x2 * cs.y) * sc; RQK[(size_t)row * 512 + qk * 256 + hh * 64 + 32 + i] = (x1 * cs.y + x2 * cs.x) * sc; } } }
    if (grp >= 0) { LAS float* xl = (LAS float*)F.lds; const int hd = F.wave, col = lane & 31;
      float* RW = (float*)(F.ws + O_RW); const size_t AS = (size_t)MP * 512; float* RBON = (float*)(F.ws + O_RBON);
      const float* MU = F.kp->in[I_MU] + l * 1664; const float* W2 = F.kp->in[I_W2] + l * 32 * 512; const float* A2 = F.kp->in[I_A2] + l * 32 * 512; const float* G2 = F.kp->in[I_G2] + l * 64 * 512;
      const int r0 = 32 * grp;
      __syncthreads();
#pragma unroll
      for (int j = 0; j < 8; ++j) { const int idx = tid + 512 * j, tk = idx >> 7, cl = idx & 127, row = r0 + tk; float xs = 0.f;
          if (row < T) { const int pr = prev_row(row); const size_t uc = U_RWKV + 1536 + cl; const float x = U[(size_t)row * NINP + uc], xp = pr >= 0 ? U[(size_t)pr * NINP + uc] : 0.f; xs = x + (xp - x) * MU[1536 + cl];
              if (cl < 32) xs = tanhf(xs); else if (cl >= 64) xs = sigmoidf_(xs); }
          xl[tk * 132 + cl] = xs; }
      __syncthreads();
      float w0c[2], a0c[2], kkc[2], kac[2], rkc[2], muR[2], muK[2], muV[2];
#pragma unroll
      for (int ct = 0; ct < 2; ++ct) { const int ch = 64 * hd + 32 * ct + col; w0c[ct] = F.kp->in[I_W0][l * 512 + ch]; a0c[ct] = F.kp->in[I_A0][l * 512 + ch]; kkc[ct] = F.kp->in[I_KK][l * 512 + ch]; kac[ct] = F.kp->in[I_KA][l * 512 + ch]; rkc[ct] = F.kp->in[I_RK][l * 512 + ch];
          muR[ct] = MU[ch]; muK[ct] = MU[512 + ch]; muV[ct] = MU[1024 + ch]; }
      { constexpr int tb = 0;
          f32x16 aw[2], aa[2], ag[2];
#pragma unroll
          for (int ct = 0; ct < 2; ++ct) { aw[ct] = zero16(); aa[ct] = zero16(); ag[ct] = zero16(); }
          const LAS float* xa = xl + (32 * tb + col) * 132 + (lane >> 5); const int chb = 64 * hd + col, kh = lane >> 5;
#define M1_LORA(ACC, WM, XO, NB) do { _Pragma("unroll") for (int hb_ = 0; hb_ < (NB); ++hb_) { float bq_[16][2], xq_[16]; \
              _Pragma("unroll") for (int t_ = 0; t_ < 16; ++t_) { const float* wb_ = (WM) + 1024 * (16 * hb_ + t_); bq_[t_][0] = wb_[wvo]; bq_[t_][1] = wb_[wvo + 32]; xq_[t_] = xa[(XO) + 2 * (16 * hb_ + t_)]; } \
              _Pragma("unroll") for (int t_ = 0; t_ < 16; ++t_) { ACC[0] = __builtin_amdgcn_mfma_f32_32x32x2f32(xq_[t_], bq_[t_][0], ACC[0], 0, 0, 0); ACC[1] = __builtin_amdgcn_mfma_f32_32x32x2f32(xq_[t_], bq_[t_][1], ACC[1], 0, 0, 0); } } } while (0)
          const unsigned wvo = (unsigned)(kh * 512 + chb);
          M1_LORA(aw, W2, 0, 1); M1_LORA(aa, A2, 32, 1); M1_LORA(ag, G2, 64, 2);
#undef M1_LORA
#pragma unroll 4
          for (int reg = 0; reg < 16; ++reg) { const int row = r0 + 32 * tb + rreg(reg, lane); if (row >= T) continue;
              const int pr = prev_row(row); float rr[2], k2[2], vv[2], kk[2], av[2], dec[2]; float nq = 0.f, bq = 0.f;
#pragma unroll
              for (int ct = 0; ct < 2; ++ct) { const float* ur = U + (size_t)row * NINP + U_RWKV + chb + 32 * ct; const float* up = U + (size_t)(pr >= 0 ? pr : 0) * NINP + U_RWKV + chb + 32 * ct;
                  float r = ur[0], k = ur[512], v = ur[1024]; const float rp = pr >= 0 ? up[0] : 0.f, kp = pr >= 0 ? up[512] : 0.f, vp = pr >= 0 ? up[1024] : 0.f;
                  r += (rp - r) * muR[ct]; k += (kp - k) * muK[ct]; v += (vp - v) * muV[ct];
                  float wr = w0c[ct] + aw[ct][reg]; wr = -softplusf_(-wr) - 0.5f; dec[ct] = expf(-expf(wr));
                  av[ct] = sigmoidf_(a0c[ct] + aa[ct][reg]);
                  kk[ct] = k * kkc[ct]; k2[ct] = k * (1.0f + (av[ct] - 1.0f) * kac[ct]); rr[ct] = r; vv[ct] = v;
                  nq += kk[ct] * kk[ct]; bq += r * k2[ct] * rkc[ct]; }
#pragma unroll
              for (int o = 1; o < 32; o <<= 1) { nq += __shfl_xor(nq, o); bq += __shfl_xor(bq, o); }
              const float inrm = 1.0f / fmaxf(sqrtf(nq), 1e-12f);
#pragma unroll
              for (int ct = 0; ct < 2; ++ct) { const size_t o = (size_t)row * 512 + chb + 32 * ct; const float kn = kk[ct] * inrm;
                  RW[o] = rr[ct]; RW[AS + o] = dec[ct]; RW[2 * AS + o] = k2[ct]; RW[3 * AS + o] = vv[ct]; RW[4 * AS + o] = -kn; RW[5 * AS + o] = kn * av[ct]; RW[6 * AS + o] = ag[ct][reg]; }
              if (col == 0) RBON[row * 8 + hd] = bq; }
      } }
}
__device__ __forceinline__ void m1_phase(const Ctx& F, int l, int qi = 1) {
    unsigned* ctr = (unsigned*)(F.ws + O_CTL) + CW_QUEUE + 64 * (4 * l + qi);
    constexpr int NG = (T + 31) / 32, NR = (T + 31) / 32;
    for (;;) { const int u = queue_next(F, ctr); if (u >= NG + NR) break;
        if (u < NG) m1_unit(F, l, 0, 0, u); else { const int r0 = 32 * (u - NG); m1_unit(F, l, r0, r0 + 32 < T ? r0 + 32 : T, -1); } }
}
constexpr int RWC = 64, NRC = (T + RWC - 1) / RWC;
__device__ __forceinline__ void rwkv_chunk_unit(const Ctx& F, int c, int h) {
    LAS float* BH = (LAS float*)F.lds; LAS float* KH = BH + 4160; LAS float* NX = KH + 4160; LAS float* RTT = NX + 4160;
    LAS float* AP = RTT + 4160; LAS float* BZ = AP + 4352; LAS float* Pm = BZ + 4160; LAS float* Qm = Pm + 4160; LAS float* Ge = Qm + 4160; LAS float* segt = Ge + 64;
    const float* RW = (const float*)(F.ws + O_RW); const size_t AS = (size_t)MP * 512; float* MATS = (float*)(F.ws + O_MATS) + (size_t)(c * 8 + h) * 16384;
    int tid = F.tid, w = F.wave; asm volatile("" : "+v"(tid), "+s"(w));
    const int lane = tid & 63, seg = tid >> 6, k = tid & 63;
    __syncthreads();
    { float p[8];
#pragma unroll
      for (int i = 0; i < 8; ++i) { const int s = RWC * c + 8 * seg + i; const float wv = s < T ? RW[AS + (size_t)row_of_seq(s) * 512 + 64 * h + k] : 1.0f; p[i] = i ? p[i - 1] * wv : wv; }
      segt[seg * 64 + k] = p[7];
      __syncthreads();
      float pre = 1.0f, tot = 1.0f;
#pragma unroll
      for (int q = 0; q < 8; ++q) { const float t = segt[q * 64 + k]; if (q < seg) pre *= t; tot *= t; }
      if (seg == 0) Ge[k] = tot;
#pragma unroll
      for (int i = 0; i < 8; ++i) { const int il = 8 * seg + i, s = RWC * c + il; const float G = pre * p[i], Gm1 = i ? pre * p[i - 1] : pre;
          float nk = 0.f, r = 0.f, b = 0.f, kk = 0.f;
          if (s < T) { const size_t o = (size_t)row_of_seq(s) * 512 + 64 * h + k; r = RW[o]; kk = RW[2 * AS + o]; nk = RW[4 * AS + o]; b = RW[5 * AS + o]; }
          const float ig = 1.0f / G;
          NX[k * 65 + il] = nk * Gm1; RTT[k * 65 + il] = r * G; BH[il * 65 + k] = b * ig; KH[il * 65 + k] = kk * ig; } }
    __syncthreads();
    { const int prod = w >> 1; const LAS float* Lm = (prod & 1) ? KH : BH; const LAS float* Rm = (prod < 2) ? NX : RTT;
#pragma unroll
      for (int t = 0; t < 2; ++t) { const int tr = w & 1, tc = t; f32x16 acc = zero16();
          mma32(acc, Lm + 32 * tr * 65, 65, 1, Rm + 32 * tc, 65, 1, 64, lane);
#pragma unroll
          for (int r = 0; r < 16; ++r) { const int j = 32 * tr + rreg(r, lane), i = 32 * tc + (lane & 31); const float v = acc[r];
              if (prod == 0) AP[j * 68 + i] = j < i ? v : 0.f; else if (prod == 1) BZ[j * 65 + i] = j < i ? v : 0.f; else if (prod == 2) Pm[j * 65 + i] = j <= i ? v : 0.f; else Qm[j * 65 + i] = j <= i ? v : 0.f; } } }
    __syncthreads();
    if (w < 2) { LAS float* Yr = (w == 0 ? NX : BZ) + lane * 65;
        for (int ib = 0; ib < 4; ++ib) { float a[16];
#pragma unroll
            for (int ii = 0; ii < 16; ++ii) a[ii] = Yr[16 * ib + ii];
            for (int j = 0; j < 16 * ib; ++j) { const float y = Yr[j]; const LAS float* ap = AP + j * 68 + 16 * ib;
                const f32x4 a0 = *(const LAS f32x4*)ap, a1 = *(const LAS f32x4*)(ap + 4), a2 = *(const LAS f32x4*)(ap + 8), a3 = *(const LAS f32x4*)(ap + 12);
#pragma unroll
                for (int q = 0; q < 4; ++q) { a[q] += y * a0[q]; a[4 + q] += y * a1[q]; a[8 + q] += y * a2[q]; a[12 + q] += y * a3[q]; } }
#pragma unroll
            for (int ii = 1; ii < 16; ++ii)
#pragma unroll
                for (int jj = 0; jj < ii; ++jj) a[ii] += a[jj] * AP[(16 * ib + jj) * 68 + 16 * ib + ii];
#pragma unroll
            for (int ii = 0; ii < 16; ++ii) Yr[16 * ib + ii] = a[ii]; } }
    __syncthreads();
    { const int rb = w >> 1;
#pragma unroll
      for (int t = 0; t < 2; ++t) { const int cb = 2 * (w & 1) + t; f32x16 acc = zero16();
          mma32(acc, (rb < 2 ? NX : BZ) + 32 * (rb & 1) * 65, 65, 1, (cb < 2 ? BH : Pm) + 32 * (cb & 1), 65, 1, 64, lane);
          float* dst = MATS + (rb < 2 ? (cb < 2 ? 0 : 8192) : (cb < 2 ? 4096 : 12288));
#pragma unroll
          for (int r = 0; r < 16; ++r) { const int row = 32 * (rb & 1) + rreg(r, lane), col = 32 * (cb & 1) + (lane & 31); float v = acc[r];
              if (rb < 2 && cb < 2) v = (v + (row == col ? 1.0f : 0.0f)) * Ge[col]; else if (rb < 2) v += RTT[row * 65 + col]; else if (cb < 2) v = (v + KH[row * 65 + col]) * Ge[col]; else v += Qm[row * 65 + col];
              dst[row * 64 + col] = v; } } }
}
template <int SV = 0>
__device__ __forceinline__ void rwkv_state_scan(const Ctx& F, int h, int rg) {
    LAS float* Sx = (LAS float*)F.lds; LAS float* tmp = Sx + 1056; LAS float* ring = tmp + 1024;
    const float* RW = (const float*)(F.ws + O_RW); const size_t AS = (size_t)MP * 512; const float* MATS = (const float*)(F.ws + O_MATS); float* SST8 = (float*)(F.ws + (SV ? O_QKV : O_SSTATE));
    const float* ZERO = (const float*)(F.ws + O_H) + (size_t)8300 * D;
    const int tid = F.tid, lane = F.lane, w = F.wave, fr = lane & 15, kq = lane >> 4, role = w >> 2, cbk = w & 3;
#define RW_DMA(cn) do { const int cc_ = (cn) < NRC ? (cn) : NRC - 1; const float* mp_ = MATS + (size_t)(cc_ * 8 + h) * 16384; LAS float* sl_ = ring + ((cn) % 3) * 9216; \
        _Pragma("unroll") for (int q_ = 0; q_ < 2; ++q_) { const int ch_ = w + 8 * q_; \
            __builtin_amdgcn_global_load_lds((const unsigned*)(mp_ + ch_ * 256 + lane * 4), (LAS unsigned*)(sl_ + ch_ * 256), 16, 0, 0); \
            __builtin_amdgcn_global_load_lds((const unsigned*)(mp_ + 4096 + ch_ * 256 + lane * 4), (LAS unsigned*)(sl_ + 4096 + ch_ * 256), 16, 0, 0); \
            const int j_ = 4 * ch_ + kq, s_ = RWC * cc_ + j_; const float* vp_ = s_ < T ? RW + 3 * AS + (size_t)row_of_seq(s_) * 512 + 64 * h + 16 * rg + fr : ZERO + fr; \
            __builtin_amdgcn_global_load_lds((const unsigned*)vp_, (LAS unsigned*)(sl_ + 8192 + ch_ * 64), 4, 0, 0); } } while (0)
    __syncthreads();
    for (int i = tid; i < 1056; i += NTHR) Sx[i] = 0.f;
    RW_DMA(0); RW_DMA(1);
    asm volatile("s_waitcnt vmcnt(0)" ::: "memory");
    __syncthreads();
    for (int c = 0; c < NRC; ++c) {
        if (SV != 1) RW_DMA(c + 2);
        { const int idx = 2 * tid, v = idx >> 6, kk = idx & 63; const f32x2 sv = (f32x2){Sx[v * 66 + kk], Sx[v * 66 + kk + 1]}; *(f32x2*)(SST8 + ((size_t)(c * 8 + h) * 64 + 16 * rg + v) * 64 + kk) = sv; }
        const LAS float* sl = ring + (c % 3) * 9216;
        float av[16], bv[16]; f32x4 acc = (f32x4){0.f, 0.f, 0.f, 0.f}, acc2 = acc;
        if (role == 0) { const LAS float* mb = sl + 16 * cbk + fr;
#pragma unroll
            for (int t = 0; t < 16; ++t) { av[t] = Sx[fr * 66 + 4 * t + kq]; bv[t] = mb[(4 * t + kq) * 64]; }
        } else { const LAS float* wb = sl + 4096 + 16 * cbk + fr; const LAS float* vt = sl + 8192 + fr;
#pragma unroll
            for (int t = 0; t < 16; ++t) { av[t] = vt[(4 * t + kq) * 16]; bv[t] = wb[(4 * t + kq) * 64]; } }
#pragma unroll
        for (int t = 0; t < (SV == 2 ? 2 : 16); t += 2) { acc = __builtin_amdgcn_mfma_f32_16x16x4f32(av[t], bv[t], acc, 0, 0, 0); acc2 = __builtin_amdgcn_mfma_f32_16x16x4f32(av[t + 1], bv[t + 1], acc2, 0, 0, 0); }
        acc = acc + acc2;
        if (role != 0) *(LAS f32x4*)(tmp + (cbk * 64 + lane) * 4) = acc;
        LBAR();
        if (role == 0) { acc = acc + *(const LAS f32x4*)(tmp + (cbk * 64 + lane) * 4);
#pragma unroll
            for (int r = 0; r < 4; ++r) Sx[(4 * kq + r) * 66 + 16 * cbk + fr] = acc[r]; }
        if (SV != 1) asm volatile("s_waitcnt vmcnt(8)" ::: "memory");
        LBAR();
    }
    asm volatile("s_waitcnt vmcnt(0)" ::: "memory");
#undef RW_DMA
}
__device__ __forceinline__ void rwkv_out_unit(const Ctx& F, int l, int c, int h) {
    LAS float* S_ = (LAS float*)F.lds; LAS float* E_ = S_ + 4160; LAS float* VT_ = E_ + 4096; LAS float* F_ = VT_ + 4096; LAS float* O_ = F_ + 4096;
    const float* RW = (const float*)(F.ws + O_RW); const size_t AS = (size_t)MP * 512; const float* MATS = (const float*)(F.ws + O_MATS) + (size_t)(c * 8 + h) * 16384;
    const float* SST8 = (const float*)(F.ws + O_SSTATE) + (size_t)(c * 8 + h) * 4096; const float* RBON = (const float*)(F.ws + O_RBON); bf16* Y = (bf16*)(F.ws + O_Y);
    int tid = F.tid, w = F.wave; asm volatile("" : "+v"(tid), "+s"(w)); const int lane = tid & 63;
    const f32x4 z4 = (f32x4){0.f, 0.f, 0.f, 0.f};
    f32x4 sv[2], ev[2], fv[2], tv[2];
#pragma unroll
    for (int q = 0; q < 2; ++q) { const int idx = tid + 512 * q, r = idx >> 4, c4 = idx & 15, s = RWC * c + r;
        sv[q] = *(const f32x4*)(SST8 + r * 64 + 4 * c4); ev[q] = *(const f32x4*)(MATS + 8192 + 4 * idx); fv[q] = *(const f32x4*)(MATS + 12288 + 4 * idx);
        tv[q] = s < T ? *(const f32x4*)(RW + 3 * AS + (size_t)row_of_seq(s) * 512 + 64 * h + 4 * c4) : z4; }
    const int li = tid >> 3, part = tid & 7, ls = RWC * c + li, lrow = ls < T ? row_of_seq(ls) : 0; const size_t lo = (size_t)lrow * 512 + 64 * h + 8 * part;
    f32x4 v0 = z4, v1 = z4, g0 = z4, g1 = z4; float bon = 0.f;
    if (ls < T) { v0 = *(const f32x4*)(RW + 3 * AS + lo); v1 = *(const f32x4*)(RW + 3 * AS + lo + 4); g0 = *(const f32x4*)(RW + 6 * AS + lo); g1 = *(const f32x4*)(RW + 6 * AS + lo + 4); bon = RBON[lrow * 8 + h]; }
    __syncthreads();
#pragma unroll
    for (int q = 0; q < 2; ++q) { const int idx = tid + 512 * q, r = idx >> 4, c4 = idx & 15;
        LAS float* d = S_ + r * 65 + 4 * c4; d[0] = sv[q][0]; d[1] = sv[q][1]; d[2] = sv[q][2]; d[3] = sv[q][3];
        *(LAS f32x4*)(E_ + 4 * idx) = ev[q]; *(LAS f32x4*)(F_ + 4 * idx) = fv[q]; *(LAS f32x4*)(VT_ + r * 64 + 4 * c4) = tv[q]; }
    LBAR();
    const int tr = (w >> 1) & 1, tc = w & 1; f32x16 acc = zero16();
    if (w < 4) mma32(acc, S_ + 32 * tr * 65, 65, 1, E_ + 32 * tc, 64, 1, 64, lane);
    else { mma32(acc, VT_ + 32 * tr, 1, 64, F_ + 32 * tc, 64, 1, 64, lane);
#pragma unroll
        for (int r = 0; r < 16; ++r) O_[(32 * tr + rreg(r, lane)) * 65 + 32 * tc + (lane & 31)] = acc[r]; }
    LBAR();
    if (w < 4) {
#pragma unroll
        for (int r = 0; r < 16; ++r) O_[(32 * tr + rreg(r, lane)) * 65 + 32 * tc + (lane & 31)] += acc[r]; }
    LBAR();
    { float x[8]; float sm = 0.f;
#pragma unroll
      for (int q = 0; q < 8; ++q) { x[q] = O_[(8 * part + q) * 65 + li]; sm += x[q]; }
      sm += __shfl_xor(sm, 1); sm += __shfl_xor(sm, 2); sm += __shfl_xor(sm, 4);
      const float mu = sm * (1.0f / 64.0f); float vq = 0.f;
#pragma unroll
      for (int q = 0; q < 8; ++q) { const float d = x[q] - mu; vq += d * d; }
      vq += __shfl_xor(vq, 1); vq += __shfl_xor(vq, 2); vq += __shfl_xor(vq, 4);
      const float rstd = 1.0f / sqrtf(vq * (1.0f / 64.0f) + 64e-5f);
      if (ls < T) { const float* lng = F.kp->in[I_LN] + l * 512 + 64 * h + 8 * part;
          float ov[8];
#pragma unroll
          for (int q = 0; q < 4; ++q) { ov[q] = ((x[q] - mu) * rstd * lng[q] + bon * v0[q]) * g0[q]; ov[4 + q] = ((x[4 + q] - mu) * rstd * lng[4 + q] + bon * v1[q]) * g1[q]; }
          v4u wv; wv.x = cvtpk(ov[0], ov[1]); wv.y = cvtpk(ov[2], ov[3]); wv.z = cvtpk(ov[4], ov[5]); wv.w = cvtpk(ov[6], ov[7]);
          *(v4u*)(Y + (size_t)lrow * D + 1536 + 64 * h + 8 * part) = wv; } }
}
__device__ __forceinline__ void ssd_states_unit(const Ctx& F, int c, int h) {
    LAS float* Bm = (LAS float*)F.lds; LAS float* XD = Bm + 16384; LAS float* csl = XD + 8192; LAS float* lal = csl + 128; LAS float* dtl = lal + 128;
    const float* XBC = (const float*)(F.ws + O_XBC); const float* DT = (const float*)(F.ws + O_DT); const float* LA = (const float*)(F.ws + O_LA);
    float* SST = (float*)(F.ws + O_SST); float* SDEC = (float*)(F.ws + O_SDEC);
    const int tid = F.tid, lane = F.lane, w = F.wave, g = h >> 2;
    __syncthreads();
    if (tid < 128) { const int row = crow(c, tid); lal[tid] = row >= 0 ? LA[row * 8 + h] : 0.f; dtl[tid] = row >= 0 ? DT[row * 8 + h] : 0.f; }
    __syncthreads();
    if (tid < 64) { const float e0 = lal[2 * tid], e1 = lal[2 * tid + 1]; float s = e0 + e1;
#pragma unroll
        for (int o = 1; o < 64; o <<= 1) { const float t = __shfl_up(s, o); if (tid >= o) s += t; }
        csl[2 * tid + 1] = s; csl[2 * tid] = s - e1; }
    __syncthreads();
    const float cs_end = csl[127];
#pragma unroll
    for (int k = 0; k < 8; ++k) { const int idx = tid + 512 * k, j = idx >> 5, c4 = idx & 31, row = crow(c, j);
        const f32x4 v = row >= 0 ? *(const f32x4*)(XBC + (size_t)row * 1024 + 512 + 128 * g + 4 * c4) : (f32x4){0.f, 0.f, 0.f, 0.f};
        *(LAS f32x4*)(Bm + j * 128 + 4 * c4) = v; }
#pragma unroll
    for (int k = 0; k < 4; ++k) { const int idx = tid + 512 * k, j = idx >> 4, c4 = idx & 15, row = crow(c, j);
        f32x4 v = row >= 0 ? *(const f32x4*)(XBC + (size_t)row * 1024 + 64 * h + 4 * c4) : (f32x4){0.f, 0.f, 0.f, 0.f};
        v = v * (dtl[j] * expf(cs_end - csl[j]));
        *(LAS f32x4*)(XD + j * 64 + 4 * c4) = v; }
    __syncthreads();
    const int tr = w >> 2, tc = w & 3;
    f32x16 acc = zero16();
    mma32(acc, XD + 32 * tr, 1, 64, Bm + 32 * tc, 128, 1, 128, lane);
    float* dst = SST + ((size_t)(c * 8 + h) * 64 + 32 * tr) * 128 + 32 * tc + (lane & 31);
#pragma unroll
    for (int r = 0; r < 16; ++r) dst[(size_t)rreg(r, lane) * 128] = acc[r];
    if (tid == 0) SDEC[(c * 8 + h) * 32] = expf(cs_end);
}
__device__ __forceinline__ float ret_logg(int h) { return logf(1.0f - exp2f(-5.0f - (float)h)); }
__device__ __forceinline__ void ret_states_unit(const Ctx& F, int c, int h) {
    LAS float* V = (LAS float*)F.lds; LAS float* KD = V + 16384;
    const float* U = (const float*)(F.ws + O_U); const float* RQK = (const float*)(F.ws + O_RQK); float* RST = (float*)(F.ws + O_RST);
    const int tid = F.tid, lane = F.lane, w = F.wave; const float lg = ret_logg(h);
    __syncthreads();
#pragma unroll
    for (int k = 0; k < 8; ++k) { const int idx = tid + 512 * k, j = idx >> 5, c4 = idx & 31, row = crow(c, j);
        const f32x4 v = row >= 0 ? *(const f32x4*)(U + (size_t)row * NINP + U_RET + 512 + 128 * h + 4 * c4) : (f32x4){0.f, 0.f, 0.f, 0.f};
        *(LAS f32x4*)(V + j * 128 + 4 * c4) = v; }
#pragma unroll
    for (int k = 0; k < 4; ++k) { const int idx = tid + 512 * k, j = idx >> 4, c4 = idx & 15, row = crow(c, j);
        f32x4 v = row >= 0 ? *(const f32x4*)(RQK + (size_t)row * 512 + 256 + 64 * h + 4 * c4) : (f32x4){0.f, 0.f, 0.f, 0.f};
        v = v * expf((float)(127 - j) * lg);
        *(LAS f32x4*)(KD + j * 64 + 4 * c4) = v; }
    __syncthreads();
    const int tr = w >> 1, tc = w & 1;
    f32x16 acc = zero16();
    mma32(acc, V + 32 * tr, 1, 128, KD + 32 * tc, 64, 1, 128, lane);
    float* dst = RST + ((size_t)(c * 4 + h) * 128 + 32 * tr) * 64 + 32 * tc + (lane & 31);
#pragma unroll
    for (int r = 0; r < 16; ++r) dst[(size_t)rreg(r, lane) * 64] = acc[r];
}

__device__ __forceinline__ void scan_job(float* base, size_t cstride, const float* dec, int decstride, float constdec) {
    float s = 0.f;
    for (int c0 = 0; c0 < NCH; c0 += 13) { float t[13];
#pragma unroll
        for (int i = 0; i < 13; ++i) t[i] = base[(size_t)(c0 + i) * cstride];
#pragma unroll
        for (int i = 0; i < 13; ++i) { const float d = dec ? dec[(c0 + i) * decstride] : constdec; base[(size_t)(c0 + i) * cstride] = s; s = d * s + t[i]; } }
}
__device__ __forceinline__ void rwkv_scan(const Ctx& F, int hb) {
    LAS float* st = (LAS float*)F.lds;
    float* RW = (float*)(F.ws + O_RW); const size_t AS = (size_t)MP * 512; float* OUT = RW + 7 * AS;
    const int tid = F.tid, lane = F.lane, rl = lane >> 3, ks = lane & 7, myrow = 8 * F.wave + rl;
    float S[8];
#pragma unroll
    for (int j = 0; j < 8; ++j) S[j] = 0.f;
    for (int s0 = 0; s0 < T; s0 += 32) {
        __syncthreads();
#pragma unroll
        for (int j = 0; j < 6; ++j) { const int idx = tid + 512 * j, stp = idx / 96, rem = idx % 96, arr = rem >> 4, c4 = rem & 15, s = s0 + stp;
            if (s < T) { const int row = row_of_seq(s); const int asel = arr == 0 ? 0 : (arr == 1 ? 1 : (arr == 2 ? 2 : (arr == 3 ? 4 : (arr == 4 ? 5 : 3))));
                *(LAS f32x4*)(st + stp * 384 + arr * 64 + 4 * c4) = *(const f32x4*)(RW + asel * AS + (size_t)row * 512 + 64 * hb + 4 * c4); } }
        __syncthreads();
        const int nst = (T - s0) < 32 ? (T - s0) : 32;
        for (int stp = 0; stp < nst; ++stp) { const LAS float* b = st + stp * 384 + 8 * ks;
            const f32x4 r0 = *(const LAS f32x4*)(b), r1 = *(const LAS f32x4*)(b + 4), w0 = *(const LAS f32x4*)(b + 64), w1 = *(const LAS f32x4*)(b + 68), k0 = *(const LAS f32x4*)(b + 128), k1 = *(const LAS f32x4*)(b + 132),
                        n0 = *(const LAS f32x4*)(b + 192), n1 = *(const LAS f32x4*)(b + 196), b0 = *(const LAS f32x4*)(b + 256), b1 = *(const LAS f32x4*)(b + 260);
            const float vv = st[stp * 384 + 320 + myrow];
            float sa = (S[0] * n0[0] + S[1] * n0[1]) + (S[2] * n0[2] + S[3] * n0[3]) + (S[4] * n1[0] + S[5] * n1[1]) + (S[6] * n1[2] + S[7] * n1[3]);
            sa += __shfl_xor(sa, 1); sa += __shfl_xor(sa, 2); sa += __shfl_xor(sa, 4);
            float o = 0.f;
#pragma unroll
            for (int j = 0; j < 4; ++j) { S[j] = S[j] * w0[j] + sa * b0[j] + vv * k0[j]; o += S[j] * r0[j]; S[4 + j] = S[4 + j] * w1[j] + sa * b1[j] + vv * k1[j]; o += S[4 + j] * r1[j]; }
            o += __shfl_xor(o, 1); o += __shfl_xor(o, 2); o += __shfl_xor(o, 4);
            if (ks == 0) OUT[(size_t)row_of_seq(s0 + stp) * 512 + 64 * hb + myrow] = o; }
    }
}
__device__ __forceinline__ void mla_prep2_unit(const Ctx& F, int l, int un) {
    const float* QKVb = (const float*)(F.ws + O_QKV); const float* U = (const float*)(F.ws + O_U);
    bf16* Q = (bf16*)(F.ws + O_Q); bf16* K = (bf16*)(F.ws + O_K); bf16* VT = (bf16*)(F.ws + O_VT);
    LAS bf16* Vl = (LAS bf16*)F.lds;
    const int lane = F.lane, tid = F.tid;
    const float* gq = F.kp->in[I_QKNQ] + l * 192; const float* gk = F.kp->in[I_QKNK] + l * 192;
    const float gq0 = gq[lane], gq1 = gq[64 + lane], gq2 = gq[128 + lane], gk0 = gk[lane], gk1 = gk[64 + lane], gk2 = gk[128 + lane];
    const float qs = 0.07216878364870322f * 1.4426950408889634f;
    __syncthreads();
#pragma unroll 4
    for (int i = 0; i < 8; ++i) { const int sl = 8 * F.wave + i, s = 64 * un + sl;
        if (s < T) { const int row = row_of_seq(s); const float* qk = QKVb + (size_t)row * MLAN; const f32x2 cs = ((const f32x2*)(F.ws + O_ROPE))[row * 32 + (lane & 31)];
            const float kpe = U[(size_t)row * NINP + 512 + lane];
#pragma unroll
            for (int h = 0; h < 4; ++h) {
                { float x0 = qk[192 * h + lane], x1 = qk[192 * h + 64 + lane], x2 = qk[192 * h + 128 + lane];
                  const float rs = 1.0f / sqrtf(wave_sum(x0 * x0 + x1 * x1 + x2 * x2) * (1.0f / 192.0f) + EPS);
                  x0 *= rs * gq0; x1 *= rs * gq1; x2 *= rs * gq2;
                  const float ot = __shfl_xor(x2, 32); const float rr = lane < 32 ? x2 * cs.x - ot * cs.y : ot * cs.y + x2 * cs.x;
                  bf16* qd = Q + ((size_t)s * 4 + h) * 192; qd[lane] = (bf16)f2bf(x0 * qs); qd[64 + lane] = (bf16)f2bf(x1 * qs); qd[128 + lane] = (bf16)f2bf(rr * qs); }
                { float x0 = qk[768 + 256 * h + lane], x1 = qk[768 + 256 * h + 64 + lane], x2 = kpe;
                  const float rs = 1.0f / sqrtf(wave_sum(x0 * x0 + x1 * x1 + x2 * x2) * (1.0f / 192.0f) + EPS);
                  x0 *= rs * gk0; x1 *= rs * gk1; x2 *= rs * gk2;
                  const float ot = __shfl_xor(x2, 32); const float rr = lane < 32 ? x2 * cs.x - ot * cs.y : ot * cs.y + x2 * cs.x;
                  bf16* kd = K + ((size_t)s * 4 + h) * 192; kd[lane] = (bf16)f2bf(x0); kd[64 + lane] = (bf16)f2bf(x1); kd[128 + lane] = (bf16)f2bf(rr); }
                Vl[(h * 128 + lane) * 66 + sl] = (bf16)f2bf(qk[768 + 256 * h + 128 + lane]); Vl[(h * 128 + 64 + lane) * 66 + sl] = (bf16)f2bf(qk[768 + 256 * h + 192 + lane]);
            } }
        else {
#pragma unroll
            for (int h = 0; h < 4; ++h) { Vl[(h * 128 + lane) * 66 + sl] = 0; Vl[(h * 128 + 64 + lane) * 66 + sl] = 0; } }
    }
    __syncthreads();
#pragma unroll
    for (int k = 0; k < 8; ++k) { const int idx = tid + 512 * k, r = idx >> 3, j = idx & 7; const LAS unsigned* src = (const LAS unsigned*)(Vl + r * 66 + 8 * j);
        v4u w; w.x = src[0]; w.y = src[1]; w.z = src[2]; w.w = src[3];
        *(v4u*)(VT + (size_t)r * TSEQ + 64 * un + 8 * j) = w; }
}
__device__ __forceinline__ void m3_phase(const Ctx& F, int l) {
    const int b2 = F.bid, NB = F.G;
    for (int job = b2; job < 192; job += NB) {
        if (job < 128) { if (!EN_SSD) continue; const int e = job * 512 + F.tid, h = e >> 13, rest = e & 8191; scan_job((float*)(F.ws + O_SST) + (size_t)h * 8192 + rest, (size_t)8 * 8192, (const float*)(F.ws + O_SDEC) + h * 32, 8 * 32, 0.f); }
        else { if (!EN_RET) continue; const int e = (job - 128) * 512 + F.tid, h = e >> 13, rest = e & 8191; scan_job((float*)(F.ws + O_RST) + (size_t)h * 8192 + rest, (size_t)4 * 8192, nullptr, 0, expf(128.0f * ret_logg(h))); }
    }
    if (EN_MLA) for (int un = b2; un < (T + 63) / 64; un += NB) mla_prep2_unit(F, l, un);
}
template <int VAR = 0>
__device__ __forceinline__ void attn_unit(const Ctx& F, int hh, int qb, size_t yoff = O_Y) {
    LAS bf16* L0 = (LAS bf16*)F.lds;
    const bf16* Q = (const bf16*)(F.ws + O_Q); const bf16* K = (const bf16*)(F.ws + O_K); const bf16* VT = (const bf16*)(F.ws + O_VT); bf16* Y = (bf16*)(F.ws + yoff);
    int tid = F.tid, w = F.wave; asm volatile("" : "+v"(tid), "+s"(w));
    const int lane = tid & 63, h = lane >> 5, c = lane & 31, half = w >> 2, wq = w & 3;
    const int sq = 128 * qb + 32 * wq + c;
    bf16x8 qf[12];
#pragma unroll
    for (int ks = 0; ks < 12; ++ks) qf[ks] = *(const bf16x8*)(Q + ((size_t)sq * 4 + hh) * 192 + 16 * ks + 8 * h);
    f32x16 o[4];
#pragma unroll
    for (int t = 0; t < 4; ++t) o[t] = zero16();
    float m = -1e30f, lsum = 0.f;
    const int nst = qb + 1;
    v4u kr[6], vr[4];
    const unsigned kgo = (unsigned)(((tid >> 3) * 4 + hh) * 192 + 8 * (tid & 7)), klo = (unsigned)((tid >> 3) * 200 + 8 * (tid & 7));
    const unsigned vgo = (unsigned)((hh * 128 + (tid >> 2)) * TSEQ + 8 * (tid & 3)), vlo = (unsigned)(12800 + (tid >> 2) * 72 + 8 * (tid & 3));
#define AT_LOADK(st_) do { const bf16* kb_ = K + (size_t)(128 * (st_)) * 768; _Pragma("unroll") for (int j = 0; j < 6; ++j) kr[j] = *(const v4u*)(kb_ + kgo + (j / 3) * 49152 + 64 * (j % 3)); } while (0)
#define AT_LOADV(st_) do { const bf16* vb_ = VT + 128 * (st_); _Pragma("unroll") for (int j = 0; j < 4; ++j) vr[j] = *(const v4u*)(vb_ + vgo + (j >> 1) * 64 + 32 * (j & 1)); } while (0)
#define AT_STOREK() do { _Pragma("unroll") for (int j = 0; j < 6; ++j) *(LAS v4u*)(L0 + klo + (j / 3) * 22016 + 64 * (j % 3)) = kr[j]; } while (0)
#define AT_STOREV() do { _Pragma("unroll") for (int j = 0; j < 4; ++j) *(LAS v4u*)(L0 + vlo + (j >> 1) * 22016 + 32 * (j & 1)) = vr[j]; } while (0)
    __syncthreads();
    AT_LOADK(0); AT_LOADV(0); AT_STOREK(); AT_STOREV(); if (nst > 1) AT_LOADK(1);
    LBAR();
    const LAS bf16* Ks = L0 + half * 22016; const LAS bf16* Vs = Ks + 12800;
    for (int st = 0; st < nst; ++st) {
        const int kt = 2 * st + half;
        f32x16 sa[2];
#pragma unroll
        for (int t2 = 0; t2 < 2; ++t2) { sa[t2] = zero16();
#pragma unroll
            for (int ks = 0; ks < 12; ++ks) { const bf16x8 a = *(const LAS bf16x8*)(Ks + (32 * t2 + c) * 200 + 16 * ks + 8 * h); sa[t2] = __builtin_amdgcn_mfma_f32_32x32x16_bf16(a, qf[ks], sa[t2], 0, 0, 0); } }
        if (st == nst - 1) {
#pragma unroll
            for (int t2 = 0; t2 < 2; ++t2)
#pragma unroll
                for (int r = 0; r < 16; ++r) { const int key = 64 * kt + 32 * t2 + (r & 3) + 8 * (r >> 2) + 4 * h; if (key > sq) sa[t2][r] = -1e30f; } }
        float mx = -1e30f;
#pragma unroll
        for (int t2 = 0; t2 < 2; ++t2)
#pragma unroll
            for (int r = 0; r < 16; ++r) mx = fmaxf(mx, sa[t2][r]);
        mx = fmaxf(mx, __shfl_xor(mx, 32));
        if (__builtin_amdgcn_ballot_w64(mx > m) != 0ull) { const float mn = fmaxf(m, mx), alpha = __builtin_amdgcn_exp2f(m - mn); m = mn; lsum *= alpha;
#pragma unroll
            for (int t = 0; t < 4; ++t) o[t] = o[t] * alpha; }
        float rs = 0.f;
#pragma unroll
        for (int t2 = 0; t2 < 2; ++t2)
#pragma unroll
            for (int r = 0; r < 16; ++r) { const float pv = __builtin_amdgcn_exp2f(sa[t2][r] - m); sa[t2][r] = pv; rs += pv; }
        rs += __shfl_xor(rs, 32);
        lsum += rs;
        LBAR();
        if (st + 1 < nst) { AT_STOREK(); AT_LOADV(st + 1); }
#pragma unroll
        for (int t2 = 0; t2 < 2; ++t2)
#pragma unroll
            for (int s = 0; s < 2; ++s) { v4u pw; pw.x = cvtpk(sa[t2][8 * s], sa[t2][8 * s + 1]); pw.y = cvtpk(sa[t2][8 * s + 2], sa[t2][8 * s + 3]); pw.z = cvtpk(sa[t2][8 * s + 4], sa[t2][8 * s + 5]); pw.w = cvtpk(sa[t2][8 * s + 6], sa[t2][8 * s + 7]);
                const bf16x8 pf = __builtin_bit_cast(bf16x8, pw);
#pragma unroll
                for (int t = 0; t < 4; ++t) { const LAS bf16* vp = Vs + (32 * t + c) * 72 + 32 * t2 + 16 * s + 4 * h; const v2u lo = *(const LAS v2u*)vp, hi = *(const LAS v2u*)(vp + 8);
                    v4u vw; vw.x = lo.x; vw.y = lo.y; vw.z = hi.x; vw.w = hi.y;
                    o[t] = __builtin_amdgcn_mfma_f32_32x32x16_bf16(__builtin_bit_cast(bf16x8, vw), pf, o[t], 0, 0, 0); } }
        LBAR();
        if (st + 1 < nst) { AT_STOREV(); if (st + 2 < nst) AT_LOADK(st + 2); }
    }
#undef AT_LOADK
#undef AT_LOADV
#undef AT_STOREK
#undef AT_STOREV
    LAS float* MB = (LAS float*)F.lds + (wq * 64 + lane) * 67;
    if (half == 1) { MB[0] = m; MB[1] = lsum;
#pragma unroll
        for (int t = 0; t < 4; ++t)
#pragma unroll
            for (int r = 0; r < 16; ++r) MB[2 + 16 * t + r] = o[t][r]; }
    LBAR();
    if (half == 0) { const float m2 = MB[0], l2 = MB[1], mn = fmaxf(m, m2), a1 = __builtin_amdgcn_exp2f(m - mn), a2 = __builtin_amdgcn_exp2f(m2 - mn);
        const float inv = 1.0f / (lsum * a1 + l2 * a2);
        if (sq < T) { bf16* yr = Y + (size_t)row_of_seq(sq) * D + 128 * hh + 4 * h;
#pragma unroll
            for (int t = 0; t < 4; ++t)
#pragma unroll
                for (int rq = 0; rq < 4; ++rq) { float ov[4];
#pragma unroll
                    for (int i = 0; i < 4; ++i) ov[i] = (o[t][4 * rq + i] * a1 + MB[2 + 16 * t + 4 * rq + i] * a2) * inv;
                    v2u wv; wv.x = cvtpk(ov[0], ov[1]); wv.y = cvtpk(ov[2], ov[3]); *(v2u*)(yr + 32 * t + 8 * rq) = wv; } } }
}
__device__ __forceinline__ void ssd_out_unit(const Ctx& F, int l, int c, int h, int ih) {
    LAS float* CS_ = (LAS float*)F.lds; LAS float* BS_ = CS_ + 4352; LAS float* PS_ = BS_ + 8704; LAS float* SC_ = PS_ + 4352; LAS float* XD_ = SC_ + 8448; LAS float* csl = XD_ + 8448; LAS float* lal = csl + 128; LAS float* dtl = lal + 128;
    LAS float* Y_ = CS_;
    const float* XBC = (const float*)(F.ws + O_XBC); const float* DT = (const float*)(F.ws + O_DT); const float* LA = (const float*)(F.ws + O_LA); const float* U = (const float*)(F.ws + O_U);
    const float* SST = (const float*)(F.ws + O_SST); float* YZ = (float*)(F.ws + O_YZ);
    int tid = F.tid, w = F.wave; asm volatile("" : "+v"(tid), "+s"(w));
    const int lane = tid & 63, g = h >> 2;
    const f32x4 z4 = (f32x4){0.f, 0.f, 0.f, 0.f};
    float lav = 0.f, dtv = 0.f;
    if (tid < 128) { const int row = crow(c, tid); if (row >= 0) { lav = LA[row * 8 + h]; dtv = DT[row * 8 + h]; } }
    f32x4 xdv[4], csv[2][2], bsv[2][4], psv[2][2]; float xsv[8], zv[8];
#pragma unroll
    for (int k = 0; k < 4; ++k) { const int idx = tid + 512 * k, j = idx >> 4, c4 = idx & 15, row = crow(c, j); xdv[k] = row >= 0 ? *(const f32x4*)(XBC + (size_t)row * 1024 + 64 * h + 4 * c4) : z4; }
#pragma unroll
    for (int nh = 0; nh < 2; ++nh) {
#pragma unroll
        for (int k = 0; k < 2; ++k) { const int idx = tid + 512 * k, i = idx >> 4, c4 = idx & 15, row = crow(c, 64 * ih + i); csv[nh][k] = row >= 0 ? *(const f32x4*)(XBC + (size_t)row * 1024 + 768 + 128 * g + 64 * nh + 4 * c4) : z4; }
#pragma unroll
        for (int k = 0; k < 4; ++k) { const int idx = tid + 512 * k, j = idx >> 4, c4 = idx & 15, row = crow(c, j); bsv[nh][k] = row >= 0 ? *(const f32x4*)(XBC + (size_t)row * 1024 + 512 + 128 * g + 64 * nh + 4 * c4) : z4; }
#pragma unroll
        for (int k = 0; k < 2; ++k) { const int idx = tid + 512 * k, pp = idx >> 4, c4 = idx & 15; psv[nh][k] = *(const f32x4*)(SST + ((size_t)(c * 8 + h) * 64 + pp) * 128 + 64 * nh + 4 * c4); } }
#pragma unroll
    for (int k = 0; k < 8; ++k) { const int idx = tid + 512 * k, i = idx >> 6, pp = idx & 63, row = crow(c, 64 * ih + i); xsv[k] = 0.f; zv[k] = 0.f;
        if (row >= 0) { xsv[k] = XBC[(size_t)row * 1024 + 64 * h + pp]; zv[k] = U[(size_t)row * NINP + U_SSD + 64 * h + pp]; } }
    __syncthreads();
    if (tid < 128) { lal[tid] = lav; dtl[tid] = dtv; }
    LBAR();
    if (tid < 64) { const float e0 = lal[2 * tid], e1 = lal[2 * tid + 1]; float s = e0 + e1;
#pragma unroll
        for (int o = 1; o < 64; o <<= 1) { const float t = __shfl_up(s, o); if (tid >= o) s += t; }
        csl[2 * tid + 1] = s; csl[2 * tid] = s - e1; }
#pragma unroll
    for (int k = 0; k < 4; ++k) { const int idx = tid + 512 * k, j = idx >> 4, c4 = idx & 15; const f32x4 v = xdv[k] * dtl[j]; LAS float* d = XD_ + (4 * c4) * 132 + j; d[0] = v[0]; d[132] = v[1]; d[264] = v[2]; d[396] = v[3]; }
    f32x16 acc_s = zero16(), acc_y = zero16();
    const int tr = w >> 2, tc = w & 3, tr2 = (w >> 1) & 1, tc2 = w & 1;
#pragma unroll
    for (int nh = 0; nh < 2; ++nh) {
        if (nh) LBAR();
#pragma unroll
        for (int k = 0; k < 2; ++k) { const int idx = tid + 512 * k, i = idx >> 4, c4 = idx & 15; const f32x4 v = csv[nh][k]; *(LAS f32x4*)(CS_ + i * 68 + 4 * c4) = v; }
#pragma unroll
        for (int k = 0; k < 4; ++k) { const int idx = tid + 512 * k, j = idx >> 4, c4 = idx & 15; const f32x4 v = bsv[nh][k]; *(LAS f32x4*)(BS_ + j * 68 + 4 * c4) = v; }
#pragma unroll
        for (int k = 0; k < 2; ++k) { const int idx = tid + 512 * k, pp = idx >> 4, c4 = idx & 15; const f32x4 v = psv[nh][k]; *(LAS f32x4*)(PS_ + pp * 68 + 4 * c4) = v; }
        LBAR();
        mma32bf(acc_s, CS_ + 32 * tr * 68, 68, BS_ + 32 * tc * 68, 68, 64, lane);
        if (w < 4) mma32bf(acc_y, CS_ + 32 * tr2 * 68, 68, PS_ + 32 * tc2 * 68, 68, 64, lane);
    }
    if (w < 4) {
#pragma unroll
        for (int r = 0; r < 16; ++r) acc_y[r] *= expf(csl[64 * ih + 32 * tr2 + rreg(r, lane)]); }
#pragma unroll
    for (int r = 0; r < 16; ++r) { const int i = 32 * tr + rreg(r, lane), j = 32 * tc + (lane & 31), il = 64 * ih + i;
        SC_[i * 132 + j] = j <= il ? acc_s[r] * expf(csl[il] - csl[j]) : 0.f; }
    LBAR();
    if (w < 4) { mma32bf(acc_y, SC_ + 32 * tr2 * 132, 132, XD_ + 32 * tc2 * 132, 132, 128, lane);
#pragma unroll
        for (int r = 0; r < 16; ++r) Y_[(32 * tr2 + rreg(r, lane)) * 68 + 32 * tc2 + (lane & 31)] = acc_y[r]; }
    LBAR();
    const float Dh = F.kp->in[I_SSDD][l * 8 + h];
#pragma unroll
    for (int k = 0; k < 8; ++k) { const int idx = tid + 512 * k, i = idx >> 6, pp = idx & 63, row = crow(c, 64 * ih + i);
        if (row >= 0) YZ[(size_t)row * 512 + 64 * h + pp] = (Y_[i * 68 + pp] + Dh * xsv[k]) * siluf_(zv[k]); }
}
__device__ __forceinline__ void ret_out_unit(const Ctx& F, int l, int c, int h, int ih) {
    LAS float* Q_ = (LAS float*)F.lds; LAS float* KM_ = Q_ + 4352; LAS float* SC_ = KM_ + 8704; LAS float* VH_ = SC_ + 8448; LAS float* SP_ = KM_; LAS float* Y_ = SC_;
    const float* U = (const float*)(F.ws + O_U); const float* RQK = (const float*)(F.ws + O_RQK); const float* RST = (const float*)(F.ws + O_RST); bf16* Y = (bf16*)(F.ws + O_Y);
    int tid = F.tid, w = F.wave; asm volatile("" : "+v"(tid), "+s"(w));
    const int lane = tid & 63; const float lg = ret_logg(h);
    const f32x4 z4 = (f32x4){0.f, 0.f, 0.f, 0.f};
    f32x4 qv[2], kv[4], spv[4], vv[2][4], gv[4];
#pragma unroll
    for (int k = 0; k < 2; ++k) { const int idx = tid + 512 * k, i = idx >> 4, c4 = idx & 15, row = crow(c, 64 * ih + i); qv[k] = row >= 0 ? *(const f32x4*)(RQK + (size_t)row * 512 + 64 * h + 4 * c4) : z4; }
#pragma unroll
    for (int k = 0; k < 4; ++k) { const int idx = tid + 512 * k, j = idx >> 4, c4 = idx & 15, row = crow(c, j); kv[k] = row >= 0 ? *(const f32x4*)(RQK + (size_t)row * 512 + 256 + 64 * h + 4 * c4) : z4; }
#pragma unroll
    for (int k = 0; k < 4; ++k) { const int idx = tid + 512 * k, vx = idx >> 4, c4 = idx & 15; spv[k] = *(const f32x4*)(RST + ((size_t)(c * 4 + h) * 128 + vx) * 64 + 4 * c4); }
#pragma unroll
    for (int jh = 0; jh < 2; ++jh)
#pragma unroll
        for (int k = 0; k < 4; ++k) { const int idx = tid + 512 * k, j = idx >> 5, c4 = idx & 31, row = crow(c, 64 * jh + j); vv[jh][k] = (jh <= ih && row >= 0) ? *(const f32x4*)(U + (size_t)row * NINP + U_RET + 512 + 128 * h + 4 * c4) : z4; }
    const int li = tid >> 3, part = tid & 7, lrow = crow(c, 64 * ih + li);
#pragma unroll
    for (int k = 0; k < 4; ++k) gv[k] = lrow >= 0 ? *(const f32x4*)(U + (size_t)lrow * NINP + U_RET + 1024 + 128 * h + 16 * part + 4 * k) : z4;
    __syncthreads();
#pragma unroll
    for (int k = 0; k < 2; ++k) { const int idx = tid + 512 * k, i = idx >> 4, c4 = idx & 15; const f32x4 v = qv[k]; *(LAS f32x4*)(Q_ + i * 68 + 4 * c4) = v; }
#pragma unroll
    for (int k = 0; k < 4; ++k) { const int idx = tid + 512 * k, j = idx >> 4, c4 = idx & 15; const f32x4 v = kv[k]; *(LAS f32x4*)(KM_ + j * 68 + 4 * c4) = v; }
    LBAR();
    const int tr = w >> 2, tc = w & 3;
    f32x16 acc_s = zero16();
    mma32bf(acc_s, Q_ + 32 * tr * 68, 68, KM_ + 32 * tc * 68, 68, 64, lane);
    LBAR();
#pragma unroll
    for (int k = 0; k < 4; ++k) { const int idx = tid + 512 * k, vx = idx >> 4, c4 = idx & 15; const f32x4 v = spv[k]; *(LAS f32x4*)(SP_ + vx * 68 + 4 * c4) = v; }
#pragma unroll
    for (int r = 0; r < 16; ++r) { const int i = 32 * tr + rreg(r, lane), j = 32 * tc + (lane & 31), il = 64 * ih + i;
        SC_[i * 132 + j] = j <= il ? acc_s[r] * expf((float)(il - j) * lg) : 0.f; }
#pragma unroll
    for (int k = 0; k < 4; ++k) { const int idx = tid + 512 * k, j = idx >> 5, c4 = idx & 31; const f32x4 v = vv[0][k]; LAS float* d = VH_ + (4 * c4) * 68 + j; d[0] = v[0]; d[68] = v[1]; d[136] = v[2]; d[204] = v[3]; }
    LBAR();
    f32x16 acc_y = zero16();
    mma32bf(acc_y, Q_ + 32 * tr * 68, 68, SP_ + 32 * tc * 68, 68, 64, lane);
#pragma unroll
    for (int r = 0; r < 16; ++r) acc_y[r] *= expf((float)(64 * ih + 32 * tr + rreg(r, lane) + 1) * lg);
    mma32bf(acc_y, SC_ + 32 * tr * 132, 132, VH_ + 32 * tc * 68, 68, 64, lane);
    if (ih) { LBAR();
#pragma unroll
        for (int k = 0; k < 4; ++k) { const int idx = tid + 512 * k, j = idx >> 5, c4 = idx & 31; const f32x4 v = vv[1][k]; LAS float* d = VH_ + (4 * c4) * 68 + j; d[0] = v[0]; d[68] = v[1]; d[136] = v[2]; d[204] = v[3]; }
        LBAR();
        mma32bf(acc_y, SC_ + 32 * tr * 132 + 64, 132, VH_ + 32 * tc * 68, 68, 64, lane); }
    LBAR();
#pragma unroll
    for (int r = 0; r < 16; ++r) Y_[(32 * tr + rreg(r, lane)) * 132 + 32 * tc + (lane & 31)] = acc_y[r];
    LBAR();
    { const LAS float* yr = Y_ + li * 132 + 16 * part;
      float s = 0.f;
#pragma unroll
      for (int k = 0; k < 16; ++k) s += yr[k];
      s += __shfl_xor(s, 1); s += __shfl_xor(s, 2); s += __shfl_xor(s, 4);
      const float mu = s * (1.0f / 128.0f); float q = 0.f;
#pragma unroll
      for (int k = 0; k < 16; ++k) { const float d = yr[k] - mu; q += d * d; }
      q += __shfl_xor(q, 1); q += __shfl_xor(q, 2); q += __shfl_xor(q, 4);
      const float rstd = 1.0f / sqrtf(q * (1.0f / 128.0f) + EPS);
      if (lrow >= 0) { const float* ng = F.kp->in[I_RETN] + l * 512 + 128 * h + 16 * part; float ov[16];
#pragma unroll
          for (int k = 0; k < 16; ++k) ov[k] = (yr[k] - mu) * rstd * ng[k] * siluf_(gv[k >> 2][k & 3]);
          bf16* yd = Y + (size_t)lrow * D + 1024 + 128 * h + 16 * part;
          v4u w0, w1; w0.x = cvtpk(ov[0], ov[1]); w0.y = cvtpk(ov[2], ov[3]); w0.z = cvtpk(ov[4], ov[5]); w0.w = cvtpk(ov[6], ov[7]); w1.x = cvtpk(ov[8], ov[9]); w1.y = cvtpk(ov[10], ov[11]); w1.z = cvtpk(ov[12], ov[13]); w1.w = cvtpk(ov[14], ov[15]);
          *(v4u*)yd = w0; *(v4u*)(yd + 8) = w1; } }
}
__device__ __forceinline__ void m4_phase(const Ctx& F, int l, int qi = 0, int only = -1) {
    unsigned* ctr = (unsigned*)(F.ws + O_CTL) + CW_QUEUE + 64 * (4 * l + qi);
    constexpr int N_AT = 4 * NCH, N_CV = 128, N_SO = NCH * 16, N_RO = NCH * 8, N_WO = NRC * 8, N_ALL = N_AT + N_CV + N_SO + N_RO + N_WO;
    int u = queue_next(F, ctr);
    while (u < N_AT) { if (only < 0) attn_unit<0>(F, u & 3, (NCH - 1) - (u >> 2)); else if (only == 0) attn_unit<DUP_VAR>(F, u & 3, (NCH - 1) - (u >> 2), O_QKV); u = queue_next(F, ctr); }
    while (u < N_AT + N_CV) { if (l + 1 < DEPTH && only < 0) { __syncthreads(); convert_layer(F, l + 1, (u - N_AT) * NWAVES + F.wave, N_CV * NWAVES); }
        u = queue_next(F, ctr); }
    while (u < N_AT + N_CV + N_SO + N_RO) { int v = u - N_AT - N_CV;
        if (v < N_RO) { const int c = v >> 3, h = (v >> 1) & 3, ih = v & 1; if (!(c == 0 && ih == 0) && (only < 0 || only == 2)) ret_out_unit(F, l, c, h, ih); }
        else { v -= N_RO; const int c = v >> 4, h = (v >> 1) & 7, ih = v & 1; if (!(c == 0 && ih == 0) && (only < 0 || only == 1)) ssd_out_unit(F, l, c, h, ih); }
        u = queue_next(F, ctr); }
    if (u < N_ALL && only < 0) {
        if (F.tid == 0) { unsigned* sflag = (unsigned*)(F.ws + O_CTL) + CW_QUEUE + 64 * (16 + l); const unsigned nscan = F.G >= 64 ? 32u : (unsigned)F.G; unsigned sp = 0;
            while (__hip_atomic_load(sflag, __ATOMIC_RELAXED, __HIP_MEMORY_SCOPE_AGENT) < nscan) { __builtin_amdgcn_s_sleep(8); if (++sp > (1u << 22)) break; }
            __builtin_amdgcn_fence(__ATOMIC_ACQUIRE, "agent"); asm volatile("s_waitcnt vmcnt(0)" ::: "memory"); }
        __syncthreads(); }
    while (u < N_ALL) { const int v = u - (N_AT + N_CV + N_SO + N_RO); if (only < 0 || only == 3) rwkv_out_unit(F, l, v >> 3, v & 7); u = queue_next(F, ctr); }
}
__device__ __forceinline__ void m5_phase(const Ctx& F, int l) {
#ifdef PROBE_DUP
    { const bf16* Y = (const bf16*)(F.ws + O_Y); const bf16* Y2 = (const bf16*)(F.ws + O_YZ); unsigned cnt = 0;
      for (int row = F.bid * NWAVES + F.wave; row < T; row += F.G * NWAVES) for (int j = 0; j < 8; ++j) cnt += Y[(size_t)row * D + 64 * j + F.lane] != Y2[(size_t)row * D + 64 * j + F.lane];
      if (cnt) atomicAdd((unsigned*)(F.ws + O_CTL) + 8, cnt); }
#endif
#ifdef PROBE_COPY_U
    { const float* U = (const float*)(F.ws + O_U); bf16* Y = (bf16*)(F.ws + O_Y);
      for (int row = F.bid * NWAVES + F.wave; row < T; row += F.G * NWAVES)
        for (int j = 0; j < 4; ++j) { const float* ur = U + (size_t)(PROBE_COPY_META ? SEQ + (row & 15) : row) * NINP + PROBE_COPY_U + 512 * j + 8 * F.lane; const f32x4 a = *(const f32x4*)ur, b = *(const f32x4*)(ur + 4);
          v4u w; w.x = pk2(a[0], a[1]); w.y = pk2(a[2], a[3]); w.z = pk2(b[0], b[1]); w.w = pk2(b[2], b[3]); *(v4u*)(Y + (size_t)row * D + 512 * j + 8 * F.lane) = w; } }
#endif
    if (!EN_SSD) return;
    const float* YZ = (const float*)(F.ws + O_YZ); bf16* Y = (bf16*)(F.ws + O_Y); const float* ng = F.kp->in[I_SSDN] + l * 512 + 8 * F.lane;
    for (int row = F.bid * NWAVES + F.wave; row < T; row += F.G * NWAVES) { const float* yr = YZ + (size_t)row * 512 + 8 * F.lane; const f32x4 a = *(const f32x4*)yr, b = *(const f32x4*)(yr + 4);
        const float sq = wave_sum((a[0] * a[0] + a[1] * a[1]) + (a[2] * a[2] + a[3] * a[3]) + (b[0] * b[0] + b[1] * b[1]) + (b[2] * b[2] + b[3] * b[3]));
        const float rs = 1.0f / sqrtf(sq * (1.0f / 512.0f) + EPS); const f32x4 g0 = *(const f32x4*)ng, g1 = *(const f32x4*)(ng + 4);
        v4u w; w.x = pk2(a[0] * rs * g0[0], a[1] * rs * g0[1]); w.y = pk2(a[2] * rs * g0[2], a[3] * rs * g0[3]); w.z = pk2(b[0] * rs * g1[0], b[1] * rs * g1[1]); w.w = pk2(b[2] * rs * g1[2], b[3] * rs * g1[3]);
        *(v4u*)(Y + (size_t)row * D + 512 + 8 * F.lane) = w; }
}
template <int MODE  , int NT>
__device__ __forceinline__ void meta_gemm(const Ctx& F, const bf16* A16, int lda, const bf16* Bt, int ldb, int ntasks, int K, float* Cf, int ldc, const float* ss_in, float* ss_out, bf16* Ob, float* H, float scale) {
    constexpr int NACC = MODE == 1 ? 2 * NT : NT;
    LAS float* red = (LAS float*)F.lds;
    int tid = F.tid, w = F.wave; asm volatile("" : "+v"(tid), "+s"(w));
    const int lane = tid & 63, g = lane >> 4, c = lane & 15, kper = K >> 3;
    for (int task = F.G - 1 - F.bid; task < ntasks; task += F.G) {
        const int n0 = MODE == 1 ? 256 * ((64 * task) >> 7) + ((64 * task) & 127) : 16 * NT * task;
        f32x4 acc[NACC];
#pragma unroll
        for (int q = 0; q < NACC; ++q) acc[q] = (f32x4){0.f, 0.f, 0.f, 0.f};
        const bf16* ap = A16 + (size_t)c * lda + w * kper + 8 * g; const bf16* bp = Bt + (size_t)(n0 + c) * ldb + w * kper + 8 * g;
#pragma unroll 4
        for (int kk = 0; kk < kper; kk += 32) { const bf16x8 a = *(const bf16x8*)(ap + kk);
#pragma unroll
            for (int t = 0; t < NT; ++t) { acc[t] = __builtin_amdgcn_mfma_f32_16x16x32_bf16(*(const bf16x8*)(bp + (size_t)(16 * t) * ldb + kk), a, acc[t], 0, 0, 0);
                if (MODE == 1) acc[NT + t] = __builtin_amdgcn_mfma_f32_16x16x32_bf16(*(const bf16x8*)(bp + (size_t)(128 + 16 * t) * ldb + kk), a, acc[NT + t], 0, 0, 0); } }
        __syncthreads();
#pragma unroll
        for (int q = 0; q < NACC; ++q) *(LAS f32x4*)(red + ((w * NACC + q) * 64 + lane) * 4) = acc[q];
        __syncthreads();
        if (w == 0) { const int row = SEQ + c; float rs = 1.0f;
            if (ss_in) { float s = 0.f;
#pragma unroll
                for (int q = 0; q < 8; ++q) { const f32x4 x = *(const f32x4*)(ss_in + (size_t)row * 32 + 4 * q); s += (x[0] + x[1]) + (x[2] + x[3]); }
                rs = __builtin_amdgcn_rsqf(s * (1.0f / 2048.0f) + EPS); }
            float sq = 0.f;
#pragma unroll
            for (int t = 0; t < NT; ++t) { f32x4 v = (f32x4){0.f, 0.f, 0.f, 0.f}, v2 = v;
#pragma unroll
                for (int ww = 0; ww < 8; ++ww) { v = v + *(const LAS f32x4*)(red + ((ww * NACC + t) * 64 + lane) * 4); if (MODE == 1) v2 = v2 + *(const LAS f32x4*)(red + ((ww * NACC + NT + t) * 64 + lane) * 4); }
                if (MODE == 0) *(f32x4*)(Cf + (size_t)row * ldc + 16 * NT * task + 16 * t + 4 * g) = v * rs;
                if (MODE == 3) { v2u wv; wv.x = pk2(v[0] * rs, v[1] * rs); wv.y = pk2(v[2] * rs, v[3] * rs); *(v2u*)(Ob + (size_t)row * ldc + 16 * NT * task + 16 * t + 4 * g) = wv; }
                if (MODE == 1) { float o[4];
#pragma unroll
                    for (int i = 0; i < 4; ++i) { const float gv = v[i] * rs, uv = v2[i] * rs; o[i] = gv * uv * __builtin_amdgcn_rcpf(1.0f + __expf(-gv)); }
                    v2u wv; wv.x = pk2(o[0], o[1]); wv.y = pk2(o[2], o[3]); *(v2u*)(Ob + (size_t)row * DFF + 64 * task + 16 * t + 4 * g) = wv; }
                if (MODE == 2) { const size_t off = (size_t)row * D + 64 * task + 16 * t + 4 * g; f32x4 h4 = *(const f32x4*)(H + off); h4 = h4 + v * scale; *(f32x4*)(H + off) = h4;
                    v2u wv; wv.x = pk2(h4[0], h4[1]); wv.y = pk2(h4[2], h4[3]); *(v2u*)(Ob + off) = wv; sq += (h4[0] * h4[0] + h4[1] * h4[1]) + (h4[2] * h4[2] + h4[3] * h4[3]); } }
            if (MODE == 2 && ss_out) { sq += __shfl_xor(sq, 16); sq += __shfl_xor(sq, 32); if (g == 0) __hip_atomic_fetch_add(ss_out + (size_t)row * 32 + task, sq, __ATOMIC_RELAXED, __HIP_MEMORY_SCOPE_AGENT); } }
    }
}
__device__ __forceinline__ void gemm_swiglu(const Ctx& F, int hl, int ssidx) {
    const bf16* A = (const bf16*)(F.ws + O_HB); const bf16* Bt = (const bf16*)(F.ws + O_WGU) + (size_t)hl * 11264 * 2048; const float* ss = (const float*)(F.ws + O_SS) + (size_t)ssidx * MP * 32;
    { pg8::Gemm g{A, Bt, SEQ, 11264, 2048, 2048, 2048, F.wave}; pg8::StaticOrder S; S.init(SEQ, 11264, F.G, F.bid);
      const int full = (S.nwg / F.G) * F.G, rem = S.nwg - full;
      const bool split = false && (2 * rem == F.G);
      if (split) S.lim = full;
      pg8::EpiSwiGLU E{(bf16*)(F.ws + O_ACT), DFF, ss, 1.0f / 2048.0f, EPS, 2};
      pg8::gemm_phase<pg8::EpiSwiGLU, pg8::StaticOrder, true, true, false>(F.lds, g, S, E);
      if (split) { pg8::StaticOrder S2; S2.init(SEQ, 11264, F.G, F.bid); S2.hmbase = full;
          pg8::EpiSwiGLU E2{(bf16*)(F.ws + O_ACT), DFF, ss, 1.0f / 2048.0f, EPS, 1};
          pg8::gemm_phase<pg8::EpiSwiGLU, pg8::StaticOrder, true, true, true>(F.lds, g, S2, E2); } }
    meta_gemm<1, 4>(F, A + (size_t)SEQ * 2048, 2048, Bt, 2048, DFF / 64, 2048, nullptr, 0, ss, nullptr, (bf16*)(F.ws + O_ACT), nullptr, 0.f);
}
__device__ __forceinline__ void gemm_residual(const Ctx& F, const bf16* A, const bf16* Bt, int K, int ssidx, bool to_out, float scale) {
    float* sso = ssidx >= 0 ? (float*)(F.ws + O_SS) + (size_t)ssidx * MP * 32 : nullptr;
    { pg8::Gemm g{A, Bt, SEQ, 2048, K, K, K, F.wave}; pg8::StaticOrder S; S.init(SEQ, 2048, F.G, F.bid);
      pg8::EpiResidual E{(float*)(F.ws + O_H), (bf16*)(F.ws + O_HB), sso, to_out ? F.kp->out : nullptr, SEQ, scale};
      pg8::gemm_phase<pg8::EpiResidual, pg8::StaticOrder, true, true>(F.lds, g, S, E); }
    meta_gemm<2, 4>(F, A + (size_t)SEQ * K, K, Bt, K, 32, K, nullptr, 0, nullptr, sso, (bf16*)(F.ws + O_HB), (float*)(F.ws + O_H), scale);
}
__device__ __forceinline__ void gemm_scalef32(const Ctx& F, const bf16* A, const bf16* Bt, int N, int K, float* C, int ssidx) {
    const float* ss = ssidx >= 0 ? (const float*)(F.ws + O_SS) + (size_t)ssidx * MP * 32 : nullptr;
    { pg8::Gemm g{A, Bt, SEQ, N, K, K, K, F.wave}; pg8::StaticOrder S; S.init(SEQ, N, F.G, F.bid);
      pg8::EpiScaleF32 E{C, N, ss, 1.0f / 2048.0f, EPS};
      pg8::gemm_phase<pg8::EpiScaleF32, pg8::StaticOrder, true, true>(F.lds, g, S, E); }
    meta_gemm<0, 4>(F, A + (size_t)SEQ * K, K, Bt, K, N / 64, K, C, N, ss, nullptr, nullptr, nullptr, 0.f);
}
__global__ void __launch_bounds__(NTHR, 2) hybrid_fwd(P p) {
    extern __shared__ __attribute__((aligned(16))) unsigned char lds_raw[];
    LAS unsigned char* lds = (LAS unsigned char*)lds_raw;
    const int wv = __builtin_amdgcn_readfirstlane((int)threadIdx.x >> 6);
    for (int u = threadIdx.x; u < (LDS_BYTES - LDSCTL_OFF) / 4; u += NTHR) ((LAS unsigned*)(lds + LDSCTL_OFF))[u] = 0u;
    __syncthreads();
    XcdBarrier bar = xcd_barrier_post((unsigned*)(p.ws + O_CTL) + CW_BAR, (volatile LAS unsigned*)(lds + LDSCTL_OFF), wv);
    const int lo = p.ph_lo, hi = p.ph_hi;
#define IN(k) (lo <= (k) && (k) < hi)
#define SEAM(k) do { if (IN(k) && IN((k) + 1)) xcd_barrier(bar, wv); } while (0)
#ifndef NO_P0
    if (IN(0)) { const Ctx F = ctx_make(lds, wv); p0_prologue(F, 0); }
#ifdef DUP_CVT
    if (IN(0)) { const Ctx F = ctx_make(lds, wv); p0_prologue(F, 1); }
#endif
#endif
    SEAM(0);
    for (int hl = 0; hl < 8; ++hl) {
        const int l = hl >> 1, second = hl & 1, base = 1 + 11 * l + (second ? 9 : 0);
        if (IN(base)) { const Ctx F = ctx_make(lds, wv); gemm_swiglu(F, hl, 3 * l + (second ? 2 : 0)); }
#ifdef DUP_GU
        if (IN(base)) { const Ctx F = ctx_make(lds, wv); gemm_swiglu(F, hl, 3 * l + (second ? 2 : 0)); }
#endif
        SEAM(base);
        if (IN(base + 1)) { const Ctx F = ctx_make(lds, wv);
            gemm_residual(F, (const bf16*)(F.ws + O_ACT), (const bf16*)(F.ws + O_WD) + (size_t)hl * 2048 * 5632, 5632, second ? (l < 3 ? 3 * (l + 1) : -1) : 3 * l + 1, hl == 7, 0.5f); }
        if (hl < 7) SEAM(base + 1);
        if (!second) {
            const int mb = base + 2;
            if (IN(mb)) { const Ctx F = ctx_make(lds, wv); gemm_scalef32(F, (const bf16*)(F.ws + O_HB), (const bf16*)(F.ws + O_WIN) + (size_t)l * NINP * D, NINP, 2048, (float*)(F.ws + O_U), 3 * l + 1); }
#ifdef DUP_WIN
            if (IN(mb)) { const Ctx F = ctx_make(lds, wv); gemm_scalef32(F, (const bf16*)(F.ws + O_HB), (const bf16*)(F.ws + O_WIN) + (size_t)l * NINP * D, NINP, 2048, (float*)(F.ws + O_U), 3 * l + 1); }
#endif
            SEAM(mb);
#ifndef NO_M1
            if (IN(mb + 1)) { const Ctx F = ctx_make(lds, wv); m1_phase(F, l); }
#ifdef DUP_M1
            if (IN(mb + 1)) { const Ctx F = ctx_make(lds, wv); m1_phase(F, l, 3); }
#endif
#endif
            SEAM(mb + 1);
            if (IN(mb + 2)) {
                if (EN_MLA) { const Ctx F = ctx_make(lds, wv); gemm_scalef32(F, (const bf16*)(F.ws + O_AMLA), (const bf16*)(F.ws + O_WMLA) + (size_t)l * MLAN * 512, MLAN, 512, (float*)(F.ws + O_QKV), -1); }
#ifndef NO_M2
                { const Ctx F = ctx_make(lds, wv); unsigned* ctr = (unsigned*)(F.ws + O_CTL) + CW_QUEUE + 64 * (4 * l + 2);
                  for (;;) { int u = queue_next(F, ctr); if (u >= NRC * 8 + NCH * 8 + NCH * 4) break;
                      if (u < NRC * 8) { rwkv_chunk_unit(F, u >> 3, u & 7); continue; } u -= NRC * 8;
                      if (u < NCH * 8) { ssd_states_unit(F, u >> 3, u & 7); continue; } u -= NCH * 8;
                      ret_states_unit(F, u >> 2, u & 3); } }
#ifdef DUP_M2Q
                { const Ctx F = ctx_make(lds, wv); unsigned* ctr = (unsigned*)(F.ws + O_CTL) + CW_QUEUE + 64 * (4 * l + 3);
                  for (;;) { int u = queue_next(F, ctr); if (u >= NRC * 8 + NCH * 8 + NCH * 4) break;
                      if (u < NRC * 8) { rwkv_chunk_unit(F, u >> 3, u & 7); continue; } u -= NRC * 8;
                      if (u < NCH * 8) { ssd_states_unit(F, u >> 3, u & 7); continue; } u -= NCH * 8;
                      ret_states_unit(F, u >> 2, u & 3); } }
#endif
#endif
            }
            SEAM(mb + 2);
#ifndef NO_M3
            if (IN(mb + 3)) { const Ctx F = ctx_make(lds, wv); m3_phase(F, l); }
#ifdef DUP_SCAN
            if (IN(mb + 3)) { const Ctx F = ctx_make(lds, wv); if (F.bid < 32) rwkv_state_scan<DUP_SCAN>(F, F.bid >> 2, F.bid & 3); }
#endif
#endif
            SEAM(mb + 3);
#ifndef NO_M4
            if (IN(mb + 4)) { const Ctx F = ctx_make(lds, wv); const int nscan = F.G >= 64 ? 32 : F.G;
                if (F.bid < nscan) { for (int s = F.bid; s < 32; s += nscan) rwkv_state_scan<0>(F, s >> 2, s & 3);
                    asm volatile("s_waitcnt vmcnt(0)" ::: "memory"); __syncthreads();
                    if (F.tid == 0) { __builtin_amdgcn_fence(__ATOMIC_RELEASE, "agent"); asm volatile("s_waitcnt vmcnt(0)" ::: "memory"); __hip_atomic_fetch_add((unsigned*)(F.ws + O_CTL) + CW_QUEUE + 64 * (16 + l), 1u, __ATOMIC_RELAXED, __HIP_MEMORY_SCOPE_AGENT); } } }
            if (IN(mb + 4)) { const Ctx F = ctx_make(lds, wv); m4_phase(F, l); }
#ifdef DUP_M4
            if (IN(mb + 4)) { const Ctx F = ctx_make(lds, wv); m4_phase(F, l, 3, DUP_M4 - 1); }
#endif
#endif
            SEAM(mb + 4);
#ifndef NO_M5
            if (IN(mb + 5)) { const Ctx F = ctx_make(lds, wv); m5_phase(F, l); }
#ifdef DUP_M5
            if (IN(mb + 5)) { const Ctx F = ctx_make(lds, wv); m5_phase(F, l); }
#endif
#endif
            SEAM(mb + 5);
#ifdef DUP_BAR
            for (int q = 0; q < 8; ++q) xcd_barrier(bar, wv);
#endif
            if (IN(mb + 6)) { const Ctx F = ctx_make(lds, wv); gemm_residual(F, (const bf16*)(F.ws + O_Y), (const bf16*)(F.ws + O_WOUT) + (size_t)l * D * D, 2048, 3 * l + 2, false, 1.0f); }
            SEAM(mb + 6);
        }
    }
#ifdef PROBE_DUP
    xcd_barrier(bar, wv);
    { const Ctx F = ctx_make(lds, wv); const float v = (float)__hip_atomic_load((unsigned*)(F.ws + O_CTL) + 8, __ATOMIC_RELAXED, __HIP_MEMORY_SCOPE_AGENT); float* out = F.kp->out;
      for (size_t i = (size_t)F.bid * NTHR + F.tid; i < (size_t)SEQ * D; i += (size_t)F.G * NTHR) out[i] = v; }
#endif
#ifdef PROBE_ADD_META
    xcd_barrier(bar, wv);
    { const Ctx F = ctx_make(lds, wv); const float* H = (const float*)(F.ws + O_H); float* out = F.kp->out;
      for (int row = F.bid * NWAVES + F.wave; row < SEQ; row += F.G * NWAVES)
        for (int j = 0; j < 8; ++j) { const int c = 256 * j + 4 * F.lane; f32x4 v = *(f32x4*)(out + (size_t)row * D + c); v = v + *(const f32x4*)(H + (size_t)(SEQ + (row & 15)) * D + c); *(f32x4*)(out + (size_t)row * D + c) = v; } }
#endif
#undef IN
#undef SEAM
}

extern "C" void kernel_launch(void* const* d_in, const int* in_sizes, int n_in, void* d_out, int out_size, void* d_ws, size_t ws_size, hipStream_t stream) {
    static int grid = 0;
    if (grid == 0) {
        if (n_in != 36 || out_size != SEQ * D || ws_size < WS_END) { fprintf(stderr, "kernel_launch: expected 36 inputs, out %d, ws >= %zu; got n_in %d out %d ws %zu\n", SEQ * D, (size_t)WS_END, n_in, out_size, ws_size); grid = -1; return; }
        int dev = 0, cus = 0, per_cu = 0;
        if (hipGetDevice(&dev) != hipSuccess || hipDeviceGetAttribute(&cus, hipDeviceAttributeMultiprocessorCount, dev) != hipSuccess) { grid = -1; return; }
        if (hipFuncSetAttribute((const void*)hybrid_fwd, hipFuncAttributeMaxDynamicSharedMemorySize, LDS_BYTES) != hipSuccess) { fprintf(stderr, "kernel_launch: hipFuncSetAttribute failed\n"); grid = -1; return; }
        if (hipOccupancyMaxActiveBlocksPerMultiprocessor(&per_cu, (const void*)hybrid_fwd, NTHR, LDS_BYTES) != hipSuccess || per_cu < 1) fprintf(stderr, "kernel_launch: occupancy query reports %d\n", per_cu);
        (void)hipGetLastError();
        grid = cus;
    }
    if (grid < 0) return;
    if (hipMemsetAsync((char*)d_ws + O_CTL, 0, SZ_CTL, stream) != hipSuccess) { fprintf(stderr, "kernel_launch: memset failed\n"); return; }
    P a{};
    for (int i = 0; i < 36; ++i) a.in[i] = (const float*)d_in[i];
    a.out = (float*)d_out; a.ws = (unsigned char*)d_ws;
#if PER_PHASE_LAUNCH
    for (int ph = 0; ph < NPHASE; ++ph) { a.ph_lo = ph; a.ph_hi = ph + 1; hipLaunchKernelGGL(hybrid_fwd, dim3(grid), dim3(NTHR), LDS_BYTES, stream, a); }
#else
    a.ph_lo = 0; a.ph_hi = NPHASE;
    hipLaunchKernelGGL(hybrid_fwd, dim3(grid), dim3(NTHR), LDS_BYTES, stream, a);
#endif
    const hipError_t le = hipPeekAtLastError();
    if (le != hipSuccess) fprintf(stderr, "kernel_launch: launch failed: %s\n", hipGetErrorName(le));
}
```

```cpp
#include <hip/hip_runtime.h>
#include <cstdio>
#include <cstdint>

#define GAS __attribute__((address_space(1)))
#define LAS __attribute__((address_space(3)))
typedef unsigned short bf16;
typedef unsigned v4u __attribute__((ext_vector_type(4)));
typedef unsigned v2u __attribute__((ext_vector_type(2)));
typedef float f32x4 __attribute__((ext_vector_type(4)));
typedef float f32x2 __attribute__((ext_vector_type(2)));
typedef float f32x16 __attribute__((ext_vector_type(16)));
typedef short bf16x8 __attribute__((ext_vector_type(8)));

constexpr int D = 2048, SEQ = 8192, NMETA = 16, T = SEQ + NMETA, MP = 8448, DFF = 5632, DEPTH = 4;
constexpr int NIN = 5320, NINP = 5376, NCH = 65, TSEQ = 8320, MLAN = 1792;
constexpr int U_MLA = 0, U_SSD = 576, U_RET = 2120, U_RWKV = 3656;
constexpr float EPS = 1e-6f;
constexpr int NWAVES = 8, NTHR = 512;
#ifndef EN_MLA
#define EN_MLA 1
#endif
#ifndef EN_SSD
#define EN_SSD 1
#endif
#ifndef EN_RET
#define EN_RET 1
#endif
#ifndef EN_RWKV
#define EN_RWKV 1
#endif
#ifndef PROBE_NOSCAN
#define PROBE_NOSCAN 0
#endif
#ifndef PROBE_ATTCOPY
#define PROBE_ATTCOPY 0
#endif
#ifndef PROBE_COPY_META
#define PROBE_COPY_META 0
#endif
#ifndef DUP_VAR
#define DUP_VAR 0
#endif
#ifndef PER_PHASE_LAUNCH
#define PER_PHASE_LAUNCH 0
#endif
constexpr int NPHASE = 1 + 8 * 2 + 4 * 7;

constexpr size_t O_CTL = 0, SZ_CTL = 13107200;
constexpr int CW_BAR = 4096;
constexpr size_t O_SS = 65536;
constexpr size_t O_WGU = O_CTL + SZ_CTL,                 SZ_WGU = (size_t)8 * 2 * DFF * D * 2;
constexpr size_t O_WD = O_WGU + SZ_WGU,                  SZ_WD = (size_t)8 * D * DFF * 2;
constexpr size_t O_WIN = O_WD + SZ_WD,                   SZ_WIN = (size_t)4 * NINP * D * 2;
constexpr size_t O_WOUT = O_WIN + SZ_WIN,                SZ_WOUT = (size_t)4 * D * D * 2;
constexpr size_t O_WMLA = O_WOUT + SZ_WOUT,              SZ_WMLA = (size_t)4 * MLAN * 512 * 2;
constexpr size_t O_H = O_WMLA + SZ_WMLA,                 SZ_H = (size_t)MP * D * 4;
constexpr size_t O_HB = O_H + SZ_H,                      SZ_HB = (size_t)MP * D * 2;
constexpr size_t O_U = O_HB + SZ_HB,                     SZ_U = (size_t)MP * NINP * 4;
constexpr size_t O_ACT = O_U;
constexpr size_t O_AMLA = O_U + SZ_U,                    SZ_AMLA = (size_t)MP * 512 * 2;
constexpr size_t O_QKV = O_AMLA + SZ_AMLA,               SZ_QKV = (size_t)MP * MLAN * 4;
constexpr size_t O_Q = O_QKV + SZ_QKV,                   SZ_Q = (size_t)TSEQ * 768 * 2;
constexpr size_t O_K = O_Q + SZ_Q;
constexpr size_t O_VT = O_K + SZ_Q,                      SZ_VT = (size_t)4 * 128 * TSEQ * 2;
constexpr size_t O_Y = O_VT + SZ_VT,                     SZ_Y = (size_t)MP * D * 2;
constexpr size_t O_XBC = O_Y + SZ_Y,                     SZ_XBC = (size_t)MP * 1024 * 4;
constexpr size_t O_DT = O_XBC + SZ_XBC,                  SZ_DT = (size_t)MP * 8 * 4;
constexpr size_t O_LA = O_DT + SZ_DT;
constexpr size_t O_SST = O_LA + SZ_DT,                   SZ_SST = (size_t)NCH * 8 * 64 * 128 * 4;
constexpr size_t O_SDEC = O_SST + SZ_SST,                SZ_SDEC = (size_t)NCH * 8 * 128;
constexpr size_t O_YZ = O_SDEC + SZ_SDEC,                SZ_YZ = (size_t)MP * 512 * 4;
constexpr size_t O_RQK = O_YZ + SZ_YZ,                   SZ_RQK = (size_t)MP * 512 * 4;
constexpr size_t O_RST = O_RQK + SZ_RQK,                 SZ_RST = (size_t)NCH * 4 * 128 * 64 * 4;
constexpr size_t O_RW = O_RST + SZ_RST,                  SZ_RW1 = (size_t)MP * 512 * 4;
constexpr size_t O_RBON = O_RW + 8 * SZ_RW1,             SZ_RBON = (size_t)MP * 8 * 4;
constexpr size_t O_ROPE = O_RBON + SZ_RBON,              SZ_ROPE = (size_t)MP * 32 * 8;
constexpr size_t O_MATS = O_ROPE + SZ_ROPE,             SZ_MATS = (size_t)129 * 8 * 16384 * 4;
constexpr size_t O_SSTATE = O_RW + 7 * SZ_RW1;
constexpr size_t WS_END = O_MATS + SZ_MATS;
static_assert((size_t)129 * 8 * 4096 * 4 <= SZ_RW1, "sstate");
static_assert(WS_END <= 1424122240ull, "d_ws map too large");
static_assert(O_SS + (size_t)12 * MP * 32 * 4 <= SZ_CTL, "ctl map");
static_assert((size_t)MP * DFF * 2 <= SZ_U, "act overlays u");

constexpr int RING_BYTES = 131072;
constexpr int LDSCTL_OFF = 143360;
constexpr int LDS_BYTES = 147456;

#define LDS_WAIT() asm volatile("s_waitcnt lgkmcnt(0)" ::: "memory")
#define LBAR() do { asm volatile("s_waitcnt lgkmcnt(0)" ::: "memory"); __builtin_amdgcn_s_barrier(); asm volatile("" ::: "memory"); } while (0)
constexpr int CW_QUEUE = 8192;
#define VM_WAIT() asm volatile("s_waitcnt vmcnt(0)" ::: "memory")
__device__ __forceinline__ unsigned f2bf(float f) { unsigned u = __builtin_bit_cast(unsigned, f); return (u + 0x7fffu + ((u >> 16) & 1u)) >> 16; }
__device__ __forceinline__ unsigned pk2(float lo, float hi) { return f2bf(lo) | (f2bf(hi) << 16); }
typedef __bf16 bf16x2_t __attribute__((ext_vector_type(2)));
__device__ __forceinline__ unsigned cvtpk(float lo, float hi) { const f32x2 v = {lo, hi}; return __builtin_bit_cast(unsigned, __builtin_convertvector(v, bf16x2_t)); }
__device__ __forceinline__ int lane_id() { unsigned ones = ~0u; asm volatile("" : "+s"(ones)); return (int)__builtin_amdgcn_mbcnt_hi(ones, __builtin_amdgcn_mbcnt_lo(ones, 0u)); }
__device__ __forceinline__ float wave_sum(float v) {
#pragma unroll
    for (int o = 1; o < 64; o <<= 1) v += __shfl_xor(v, o);
    return v;
}
__device__ __forceinline__ float sigmoidf_(float x) { return 1.0f / (1.0f + __expf(-x)); }
__device__ __forceinline__ float siluf_(float x) { return x / (1.0f + __expf(-x)); }
__device__ __forceinline__ float softplusf_(float x) { return x > 20.f ? x : log1pf(expf(x)); }
struct UB { const bf16* p;
    __device__ __forceinline__ float operator[](size_t i) const { return __builtin_bit_cast(float, (unsigned)p[i] << 16); }
    __device__ __forceinline__ UB operator+(size_t o) const { return UB{p + o}; } };
__device__ __forceinline__ f32x4 ldu4(const UB u) { const v2u w = *(const v2u*)u.p;
    return (f32x4){__builtin_bit_cast(float, w.x << 16), __builtin_bit_cast(float, w.x & 0xffff0000u), __builtin_bit_cast(float, w.y << 16), __builtin_bit_cast(float, w.y & 0xffff0000u)}; }
__device__ __forceinline__ int row_of_seq(int s) { return s < NMETA ? SEQ + s : s - NMETA; }
__device__ __forceinline__ int seq_of_row(int r) { return r >= SEQ ? r - SEQ : r + NMETA; }
__device__ __forceinline__ int prev_row(int r) { return r == SEQ ? -1 : (r == 0 ? T - 1 : r - 1); }
__device__ __forceinline__ int crow(int c, int p) { return c == 0 ? (p >= 112 ? SEQ + p - 112 : -1) : 128 * (c - 1) + p; }
namespace pg8 {
#define PG8_LAS __attribute__((address_space(3)))
typedef unsigned short bf16_t;
typedef short bf16x8 __attribute__((ext_vector_type(8)));
typedef float f32x4 __attribute__((ext_vector_type(4)));
typedef unsigned u32x4 __attribute__((ext_vector_type(4)));
constexpr int BM = 256, BK = 64, HALF = 128, HTB = HALF * BK * 2  , STAGE_BYTES = 8 * HTB, NXCD = 8, WGM = 8;

__host__ __device__ __forceinline__ int lds_byte(int r, int c) { const int st = (r >> 4) * 2 + (c >> 5), rr = r & 15, cc = c & 31, ob = rr * 64 + cc * 2; return st * 1024 + (ob ^ (((ob >> 9) & 1) << 5)); }
__host__ __device__ __forceinline__ void stage_rc(int b, int& R, int& C) { const int st = b / 1024, sb = b % 1024, swz = sb ^ (((sb >> 9) & 1) << 5); R = (st >> 1) * 16 + swz / 64; C = (st & 1) * 32 + (swz % 64) / 2; }
__host__ __device__ __forceinline__ int perm32(int rho) { const int n = rho >> 4, i = rho & 15; return 8 * (i >> 2) + 4 * n + (i & 3); }

struct Unit { int pm, pn, ah; };
struct Gemm { const bf16_t* A; const bf16_t* Bt; int M, N, K, lda, ldb, wv; };

struct StaticOrder {
    int nM, nN, nwg, G, c, lim, hmbase;
    __host__ __device__ void init(int M, int N, int G_, int c_) { nM = M / BM; nN = N / BM; nwg = nM * nN; G = G_; c = c_; lim = nwg; hmbase = -1; }
    __host__ __device__ bool next(int i, Unit& u) const {
        long L; u.ah = 0;
        if (hmbase >= 0) { if (i > 0) return false; L = hmbase + (c >> 1); u.ah = c & 1; if (L >= nwg) return false; }
        else { L = (long)i * G + c; if (L >= lim) return false; }
        int wgid = (int)L; { const int q = nwg / NXCD, r = nwg % NXCD, xcd = wgid % NXCD, off = wgid / NXCD; wgid = (xcd < r ? xcd * (q + 1) : r * (q + 1) + (xcd - r) * q) + off; }
        const int nig = WGM * nN, gid = wgid / nig, fm = gid * WGM, gsz = (nM - fm) < WGM ? (nM - fm) : WGM;
        u.pm = fm + ((wgid % nig) % gsz); u.pn = (wgid % nig) / gsz; return true;
    }
    __device__ __forceinline__ void a_ready(const Unit&) const {}
    __device__ __forceinline__ void done(const Unit&) const {}
};

__device__ __forceinline__ unsigned cvt_pk_bf16(float lo, float hi) { unsigned r; asm volatile("v_cvt_pk_bf16_f32 %0, %1, %2" : "=v"(r) : "v"(lo), "v"(hi)); return r; }

template <class Epi, class Sched, bool ALIGN_EPI = false, bool SP2 = false, bool HM = false>
__device__ __forceinline__ void gemm_phase(PG8_LAS unsigned char* lds, const Gemm g, const Sched& S, const Epi& E) {
    int tid = g.wv * 64 + lane_id(); asm volatile("" : "+v"(tid)); const int wid = g.wv, lane = tid & 63, wr = wid >> 2, wc = wid & 3, fr = lane & 15, fq = lane >> 4;
    const int K = g.K, nt = K / BK;
    unsigned voffA[2], voffB[2];
#pragma unroll
    for (int i = 0; i < 2; ++i) { int R, C; stage_rc(tid * 16 + i * 8192, R, C); const int Rb = Epi::PERM ? ((R & ~31) + perm32(R & 31)) : R;
        voffA[i] = (unsigned)(R * g.lda + C) * 2u; voffB[i] = (unsigned)(Rb * g.ldb + C) * 2u; }
    const size_t kstep = (size_t)(BK * 2);
    const size_t hA = (size_t)HALF * g.lda * 2, hB = (size_t)HALF * g.ldb * 2;
    const size_t tA = 2 * hA, tB = 2 * hB;
    const unsigned ldsw = (unsigned)wid * 1024u;
    const int aoff = lds_byte(wr * 64 + fr, fq * 8), boff = lds_byte(wc * 32 + fr, fq * 8);
#define PG8_SA(b, h) (((b) * 2 + (h)) * HTB)
#define PG8_SB(b, h) ((4 + (b) * 2 + (h)) * HTB)
#define PG8_STAGE(bufoff, gbase, voff) do { _Pragma("unroll") for (int _i = 0; _i < 2; ++_i) \
        __builtin_amdgcn_global_load_lds((const unsigned*)((const char*)(gbase) + (voff)[_i]), (PG8_LAS unsigned*)(lds + (bufoff) + ldsw + _i * 8192), 16, 0, 0); } while (0)
#define PG8_LDA(dst, b, h) do { _Pragma("unroll") for (int m = 0; m < 4; ++m) _Pragma("unroll") for (int k = 0; k < 2; ++k) dst[m][k] = *(const PG8_LAS bf16x8*)(lds + PG8_SA(b, h) + aoff + m * 2048 + k * 1024); } while (0)
#define PG8_LDB(dst, b, h) do { _Pragma("unroll") for (int n = 0; n < 2; ++n) _Pragma("unroll") for (int k = 0; k < 2; ++k) dst[n][k] = *(const PG8_LAS bf16x8*)(lds + PG8_SB(b, h) + boff + n * 2048 + k * 1024); } while (0)
#define PG8_MMA(ai, bj, At, Bt) do { __builtin_amdgcn_s_setprio(1); _Pragma("unroll") for (int m = 0; m < 4; ++m) _Pragma("unroll") for (int n = 0; n < 2; ++n) _Pragma("unroll") for (int k = 0; k < 2; ++k) \
        acc[ai][bj][m][n] = __builtin_amdgcn_mfma_f32_16x16x32_bf16(Bt[n][k], At[m][k], acc[ai][bj][m][n], 0, 0, 0); __builtin_amdgcn_s_setprio(0); } while (0)
#define PG8_WAIT_V(n) asm volatile("s_waitcnt vmcnt(" #n ")" ::: "memory")
#define PG8_WAIT_L(n) asm volatile("s_waitcnt lgkmcnt(" #n ")" ::: "memory")
#define PG8_BAR __builtin_amdgcn_s_barrier()
#define PG8_SCHED __builtin_amdgcn_sched_barrier(0)
    Unit cur, nxt; int ui = 0;
    if (!S.next(0, cur)) return;
    f32x4 acc[2][2][4][2];
#pragma unroll
    for (int a = 0; a < 2; ++a)
#pragma unroll
        for (int b = 0; b < 2; ++b)
#pragma unroll
            for (int m = 0; m < 4; ++m)
#pragma unroll
                for (int n = 0; n < 2; ++n) acc[a][b][m][n] = (f32x4){0.f, 0.f, 0.f, 0.f};
    bf16x8 At[4][2], B0[2][2], B1[2][2];
    const char* cA = (const char*)g.A + (size_t)cur.pm * tA + (size_t)cur.ah * hA; const char* cB = (const char*)g.Bt + (size_t)cur.pn * tB;
    S.a_ready(cur);
    if constexpr (SP2) {
        PG8_STAGE(PG8_SB(0, 0), cB, voffB); PG8_STAGE(PG8_SB(0, 1), cB + hB, voffB); PG8_STAGE(PG8_SA(0, 0), cA, voffA); PG8_STAGE(PG8_SA(0, 1), cA + hA, voffA);
        if (wr == 1) PG8_BAR;
        PG8_WAIT_V(2); PG8_BAR;
        PG8_STAGE(PG8_SB(1, 0), cB + kstep, voffB); PG8_STAGE(PG8_SA(1, 0), cA + kstep, voffA); PG8_STAGE(PG8_SB(1, 1), cB + hB + kstep, voffB);
        PG8_WAIT_V(6); PG8_BAR;
    } else {
        PG8_STAGE(PG8_SB(0, 0), cB, voffB); PG8_STAGE(PG8_SA(0, 0), cA, voffA); PG8_STAGE(PG8_SB(0, 1), cB + hB, voffB); PG8_STAGE(PG8_SA(0, 1), cA + hA, voffA);
        if (wr == 1) PG8_BAR;
        PG8_WAIT_V(4); PG8_BAR;
        PG8_STAGE(PG8_SB(1, 0), cB + kstep, voffB); PG8_STAGE(PG8_SA(1, 0), cA + kstep, voffA); PG8_STAGE(PG8_SB(1, 1), cB + hB + kstep, voffB);
        PG8_WAIT_V(6); PG8_BAR;
    }
    for (;;) {
        const bool has_next = S.next(ui + 1, nxt);
        const char* nA = has_next ? (const char*)g.A + (size_t)nxt.pm * tA + (size_t)nxt.ah * hA : cA; const char* nB = has_next ? (const char*)g.Bt + (size_t)nxt.pn * tB : cB;
        for (int t = 0; t < nt; t += 2) {
            const bool last = (t == nt - 2);
            const char* a1 = cA + (size_t)(t + 1) * kstep;
            const char* a2 = last ? nA : cA + (size_t)(t + 2) * kstep; const char* b2 = last ? nB : cB + (size_t)(t + 2) * kstep;
            const char* a3 = a2 + kstep; const char* b3 = b2 + kstep;
            if (last && has_next) S.a_ready(nxt);
            if constexpr (SP2) {
            PG8_LDB(B0, 0, 0); PG8_LDB(B1, 0, 1); PG8_SCHED; PG8_LDA(At, 0, 0); PG8_STAGE(PG8_SA(1, 1), a1 + hA, voffA);
            PG8_WAIT_V(8); PG8_WAIT_L(0); PG8_BAR; PG8_MMA(0, 0, At, B0); PG8_MMA(0, 1, At, B1); PG8_BAR; PG8_SCHED;
            if constexpr (!HM) PG8_LDA(At, 0, 1); PG8_STAGE(PG8_SB(0, 0), b2, voffB); PG8_STAGE(PG8_SB(0, 1), b2 + hB, voffB); PG8_STAGE(PG8_SA(0, 0), a2, voffA);
            PG8_WAIT_V(8); PG8_WAIT_L(0); PG8_BAR; if constexpr (!HM) { PG8_MMA(1, 0, At, B0); PG8_MMA(1, 1, At, B1); } PG8_BAR; PG8_SCHED;
            PG8_LDB(B0, 1, 0); PG8_LDB(B1, 1, 1); PG8_SCHED; PG8_LDA(At, 1, 0); PG8_STAGE(PG8_SA(0, 1), a2 + hA, voffA);
            PG8_WAIT_V(8); PG8_WAIT_L(0); PG8_BAR; PG8_MMA(0, 0, At, B0); PG8_MMA(0, 1, At, B1); PG8_BAR; PG8_SCHED;
            if constexpr (!HM) PG8_LDA(At, 1, 1); PG8_STAGE(PG8_SB(1, 0), b3, voffB); PG8_STAGE(PG8_SB(1, 1), b3 + hB, voffB); PG8_STAGE(PG8_SA(1, 0), a3, voffA);
            PG8_WAIT_V(8); PG8_WAIT_L(0); PG8_BAR; if constexpr (!HM) { PG8_MMA(1, 0, At, B0); PG8_MMA(1, 1, At, B1); } PG8_BAR; PG8_SCHED;
            } else {
            PG8_LDB(B0, 0, 0); PG8_SCHED; PG8_LDA(At, 0, 0); PG8_STAGE(PG8_SA(1, 1), a1 + hA, voffA);
            PG8_WAIT_L(8); PG8_BAR; PG8_WAIT_L(0); PG8_MMA(0, 0, At, B0); PG8_BAR; PG8_SCHED;
            PG8_LDB(B1, 0, 1); PG8_STAGE(PG8_SB(0, 0), b2, voffB);
            PG8_BAR; PG8_WAIT_L(0); PG8_MMA(0, 1, At, B1); PG8_BAR;
            PG8_LDA(At, 0, 1); PG8_STAGE(PG8_SA(0, 0), a2, voffA);
            PG8_BAR; PG8_WAIT_L(0); PG8_MMA(1, 0, At, B0); PG8_BAR; PG8_SCHED;
            PG8_STAGE(PG8_SB(0, 1), b2 + hB, voffB);
            PG8_WAIT_V(6); PG8_BAR; PG8_MMA(1, 1, At, B1); PG8_BAR;
            PG8_LDB(B0, 1, 0); PG8_SCHED; PG8_LDA(At, 1, 0); PG8_STAGE(PG8_SA(0, 1), a2 + hA, voffA);
            PG8_WAIT_L(8); PG8_BAR; PG8_WAIT_L(0); PG8_MMA(0, 0, At, B0); PG8_BAR; PG8_SCHED;
            PG8_LDB(B1, 1, 1); PG8_STAGE(PG8_SB(1, 0), b3, voffB);
            PG8_BAR; PG8_WAIT_L(0); PG8_MMA(0, 1, At, B1); PG8_BAR;
            PG8_LDA(At, 1, 1); PG8_STAGE(PG8_SA(1, 0), a3, voffA);
            PG8_BAR; PG8_WAIT_L(0); PG8_MMA(1, 0, At, B0); PG8_BAR; PG8_SCHED;
            PG8_STAGE(PG8_SB(1, 1), b3 + hB, voffB);
            PG8_WAIT_V(6); PG8_BAR; PG8_MMA(1, 1, At, B1); PG8_BAR;
            }
        }
        if constexpr (ALIGN_EPI) { if (wr == 0) PG8_BAR; }
        if constexpr (!Epi::AFTER_DRAIN) { E(acc, cur, wr, wc, fr, fq); S.done(cur); }
        if (!has_next) break;
#pragma unroll
        for (int a = 0; a < 2; ++a)
#pragma unroll
            for (int b = 0; b < 2; ++b)
#pragma unroll
                for (int m = 0; m < 4; ++m)
#pragma unroll
                    for (int n = 0; n < 2; ++n) acc[a][b][m][n] = (f32x4){0.f, 0.f, 0.f, 0.f};
        cur = nxt; cA = nA; cB = nB; ++ui;
        if constexpr (ALIGN_EPI) { if (wr == 1) PG8_BAR; }
    }
    PG8_WAIT_V(0);
    if constexpr (!ALIGN_EPI) { if (wr == 0) PG8_BAR; }
    PG8_BAR;
    if constexpr (Epi::AFTER_DRAIN) { E.fused(acc, cur, wr, wc, fr, fq, lds, wid, lane); S.done(cur); }
#undef PG8_SA
#undef PG8_SB
#undef PG8_STAGE
#undef PG8_LDA
#undef PG8_LDB
#undef PG8_MMA
#undef PG8_WAIT_V
#undef PG8_WAIT_L
#undef PG8_BAR
#undef PG8_SCHED
}

__device__ __forceinline__ float row_ss(const float* ss, int row, int fq) {
    const f32x4 a = *(const f32x4*)(ss + (size_t)row * 32 + 8 * fq), b = *(const f32x4*)(ss + (size_t)row * 32 + 8 * fq + 4);
    float s = ((a[0] + a[1]) + (a[2] + a[3])) + ((b[0] + b[1]) + (b[2] + b[3]));
    s += __shfl_xor(s, 16); s += __shfl_xor(s, 32); return s;
}
struct EpiScaleF32 {
    static constexpr bool PERM = false, AFTER_DRAIN = false;
    float* C; int ldc; const float* ss; float inv_d, eps;
    __device__ __forceinline__ void operator()(const f32x4 (&acc)[2][2][4][2], const Unit& u, int wr, int wc, int fr, int fq) const {
        const int row0 = u.pm * BM + wr * 64 + fr, col0 = u.pn * BM + wc * 32 + 4 * fq;
#pragma unroll
        for (int ai = 0; ai < 2; ++ai)
#pragma unroll
            for (int m = 0; m < 4; ++m) { const int row = row0 + ai * HALF + m * 16; float* rowp = C + (size_t)row * ldc + col0;
                const float rs = ss ? __builtin_amdgcn_rsqf(row_ss(ss, row, fq) * inv_d + eps) : 1.0f;
#pragma unroll
                for (int bj = 0; bj < 2; ++bj)
#pragma unroll
                    for (int n = 0; n < 2; ++n) *(f32x4*)(rowp + bj * HALF + n * 16) = acc[ai][bj][m][n] * rs; }
    }
};
struct EpiScaleBf16 {
    static constexpr bool PERM = true, AFTER_DRAIN = false;
    bf16_t* O; int ldo; const float* ss; float inv_d, eps;
    __device__ __forceinline__ void operator()(const f32x4 (&acc)[2][2][4][2], const Unit& u, int wr, int wc, int fr, int fq) const {
        const int row0 = u.pm * BM + wr * 64 + fr, col0 = u.pn * BM + wc * 32 + 8 * fq;
#pragma unroll
        for (int ai = 0; ai < 2; ++ai)
#pragma unroll
            for (int m = 0; m < 4; ++m) { const int row = row0 + ai * HALF + m * 16; const float rs = __builtin_amdgcn_rsqf(row_ss(ss, row, fq) * inv_d + eps);
#pragma unroll
                for (int bj = 0; bj < 2; ++bj) { const f32x4 v0 = acc[ai][bj][m][0] * rs, v1 = acc[ai][bj][m][1] * rs;
                    u32x4 w; w.x = cvt_pk_bf16(v0[0], v0[1]); w.y = cvt_pk_bf16(v0[2], v0[3]); w.z = cvt_pk_bf16(v1[0], v1[1]); w.w = cvt_pk_bf16(v1[2], v1[3]);
                    *(u32x4*)(O + (size_t)row * ldo + col0 + bj * HALF) = w; } }
    }
};
struct EpiSwiGLU {
    static constexpr bool PERM = true, AFTER_DRAIN = false;
    bf16_t* O; int ldo; const float* ss; float inv_d, eps; int nai;
    __device__ __forceinline__ void operator()(const f32x4 (&acc)[2][2][4][2], const Unit& u, int wr, int wc, int fr, int fq) const {
        const int row0 = u.pm * BM + u.ah * HALF + wr * 64 + fr, col0 = u.pn * HALF + wc * 32 + 8 * fq;
#pragma unroll
        for (int ai = 0; ai < 2; ++ai) { if (ai >= nai) break;
#pragma unroll
            for (int m = 0; m < 4; ++m) { const int row = row0 + ai * HALF + m * 16;
                const float rs = __builtin_amdgcn_rsqf(row_ss(ss, row, fq) * inv_d + eps);
                float o[8];
#pragma unroll
                for (int n = 0; n < 2; ++n)
#pragma unroll
                    for (int j = 0; j < 4; ++j) { const float gv = acc[ai][0][m][n][j] * rs, uv = acc[ai][1][m][n][j] * rs; o[n * 4 + j] = gv * uv * __builtin_amdgcn_rcpf(1.0f + __expf(-gv)); }
                u32x4 w; w.x = cvt_pk_bf16(o[0], o[1]); w.y = cvt_pk_bf16(o[2], o[3]); w.z = cvt_pk_bf16(o[4], o[5]); w.w = cvt_pk_bf16(o[6], o[7]);
                *(u32x4*)(O + (size_t)row * ldo + col0) = w; } }
    }
};
__device__ __forceinline__ float bflo(unsigned w) { return __builtin_bit_cast(float, w << 16); }
__device__ __forceinline__ float bfhi(unsigned w) { return __builtin_bit_cast(float, w & 0xffff0000u); }
struct EpiResidual {
    static constexpr bool PERM = true, AFTER_DRAIN = false;
    bf16_t* HL; bf16_t* HB; float* ss_out; float* out; int out_rows; float scale;
    __device__ __forceinline__ void operator()(const f32x4 (&acc)[2][2][4][2], const Unit& u, int wr, int wc, int fr, int fq) const {
        const int row0 = u.pm * BM + wr * 64 + fr, col0 = u.pn * BM + wc * 32 + 8 * fq;
#pragma unroll
        for (int ai = 0; ai < 2; ++ai)
#pragma unroll
            for (int m = 0; m < 4; ++m) { const int row = row0 + ai * HALF + m * 16; float sq = 0.f;
#pragma unroll
                for (int bj = 0; bj < 2; ++bj) { const size_t off = (size_t)row * 2048 + col0 + bj * HALF;
                    const u32x4 hi = *(const u32x4*)(HB + off), lo = *(const u32x4*)(HL + off);
                    f32x4 h0 = (f32x4){bflo(hi.x) + bflo(lo.x), bfhi(hi.x) + bfhi(lo.x), bflo(hi.y) + bflo(lo.y), bfhi(hi.y) + bfhi(lo.y)};
                    f32x4 h1 = (f32x4){bflo(hi.z) + bflo(lo.z), bfhi(hi.z) + bfhi(lo.z), bflo(hi.w) + bflo(lo.w), bfhi(hi.w) + bfhi(lo.w)};
                    h0 = h0 + acc[ai][bj][m][0] * scale; h1 = h1 + acc[ai][bj][m][1] * scale;
                    if (out && row < out_rows) { *(f32x4*)(out + off) = h0; *(f32x4*)(out + off + 4) = h1; }
                    u32x4 w; w.x = cvt_pk_bf16(h0[0], h0[1]); w.y = cvt_pk_bf16(h0[2], h0[3]); w.z = cvt_pk_bf16(h1[0], h1[1]); w.w = cvt_pk_bf16(h1[2], h1[3]);
                    u32x4 l2; l2.x = cvt_pk_bf16(h0[0] - bflo(w.x), h0[1] - bfhi(w.x)); l2.y = cvt_pk_bf16(h0[2] - bflo(w.y), h0[3] - bfhi(w.y)); l2.z = cvt_pk_bf16(h1[0] - bflo(w.z), h1[1] - bfhi(w.z)); l2.w = cvt_pk_bf16(h1[2] - bflo(w.w), h1[3] - bfhi(w.w));
                    *(u32x4*)(HB + off) = w; *(u32x4*)(HL + off) = l2;
                    sq += (h0[0] * h0[0] + h0[1] * h0[1]) + (h0[2] * h0[2] + h0[3] * h0[3]) + (h1[0] * h1[0] + h1[1] * h1[1]) + (h1[2] * h1[2] + h1[3] * h1[3]); }
                sq += __shfl_xor(sq, 16); sq += __shfl_xor(sq, 32);
                if (fq == 0 && ss_out) __hip_atomic_fetch_add(ss_out + (size_t)row * 32 + u.pn * 4 + wc, sq, __ATOMIC_RELAXED, __HIP_MEMORY_SCOPE_AGENT); }
    }
};
}
#define XB_TMO      128
#define XB_XCNT(j)  (256  + 64 * (j))
#define XB_XSUB(j)  (1280 + 64 * (j))
#define XB_XGEN(j)  (2304 + 64 * (j))
#define XB_TOP      3328
#define XB_TOPGEN   3392
#define XCD_BAR_WORDS 3456
#define XB_SPIN_CAP (1u << 18)

__device__ __forceinline__ unsigned xb_ld(unsigned* p)              { return __hip_atomic_load(p, __ATOMIC_RELAXED, __HIP_MEMORY_SCOPE_AGENT); }
__device__ __forceinline__ unsigned xb_add(unsigned* p, unsigned v) { return __hip_atomic_fetch_add(p, v, __ATOMIC_RELAXED, __HIP_MEMORY_SCOPE_AGENT); }
__device__ __forceinline__ unsigned xb_xcc_id() { return (unsigned)__builtin_amdgcn_s_getreg((3 << 11) | 20) & 0xFu; }
#define XB_SPIN(cond, bar) do { unsigned _sp = 0; while (cond) { __builtin_amdgcn_s_sleep(1); \
    if ((++_sp & 255u) == 0u) { if (xb_ld(&(bar)[XB_TMO])) break; if (_sp > XB_SPIN_CAP) { atomicAdd(&(bar)[XB_TMO], 1u); break; } } } } while (0)

struct XcdBarrier {
    unsigned* bar; unsigned x;
    volatile LAS unsigned* st;
};

__device__ __forceinline__ XcdBarrier xcd_barrier_post(unsigned* bar, volatile LAS unsigned* st, int wv) {
    XcdBarrier b; b.bar = bar; b.x = xb_xcc_id(); b.st = st;
    if ((wv == 0 && lane_id() == 0)) (void)xb_add(&bar[XB_XCNT(b.x)], 1u);
    return b;
}
__device__ __forceinline__ void xcd_barrier_complete(unsigned* bar, unsigned x, unsigned& nloc, unsigned& nx) {
    const unsigned G = gridDim.x * gridDim.y * gridDim.z;
    unsigned sum, cnt, mine, sp = 0u;
    for (;;) {
        sum = 0u; cnt = 0u; mine = 0u;
#pragma unroll
        for (unsigned j = 0; j < 16; ++j) { const unsigned c = xb_ld(&bar[XB_XCNT(j)]); sum += c; cnt += (c > 0u) ? 1u : 0u; mine = (j == x) ? c : mine; }
        if (sum == G) break;
        __builtin_amdgcn_s_sleep(1);
        if ((++sp & 255u) == 0u) { if (xb_ld(&bar[XB_TMO])) break; if (sp > XB_SPIN_CAP) { atomicAdd(&bar[XB_TMO], 1u); break; } }
    }
    nloc = mine > 0u ? mine : 1u; nx = cnt > 0u ? cnt : 1u;
}

__device__ __forceinline__ void xcd_barrier(const XcdBarrier& b, int wv) {
    asm volatile("s_waitcnt vmcnt(0)" ::: "memory");
    __syncthreads();
    if ((wv == 0 && lane_id() == 0)) {
        unsigned* bar = b.bar;
        __builtin_amdgcn_s_waitcnt(0);
        unsigned nloc = b.st[0], nx = b.st[1];
        if (nloc == 0u) { xcd_barrier_complete(bar, b.x, nloc, nx); b.st[0] = nloc; b.st[1] = nx; }
        const unsigned old = xb_add(&bar[XB_XSUB(b.x)], 1u);
        const unsigned gen = old / nloc;
        if (old + 1u == (gen + 1u) * nloc) {
            __builtin_amdgcn_fence(__ATOMIC_RELEASE, "agent");
            asm volatile("s_waitcnt vmcnt(0)" ::: "memory");
            const unsigned og = xb_add(&bar[XB_TOP], 1u);
            const unsigned tg = og / nx;
            if (og + 1u == (tg + 1u) * nx) xb_add(&bar[XB_TOPGEN], 1u);
            else XB_SPIN(xb_ld(&bar[XB_TOPGEN]) == tg, bar);
            __builtin_amdgcn_fence(__ATOMIC_ACQUIRE, "agent");
            xb_add(&bar[XB_XGEN(b.x)], 1u);
            asm volatile("s_waitcnt vmcnt(0)" ::: "memory");
        } else {
            XB_SPIN(xb_ld(&bar[XB_XGEN(b.x)]) == gen, bar);
            __builtin_amdgcn_fence(__ATOMIC_ACQUIRE, "agent");
            asm volatile("s_waitcnt vmcnt(0)" ::: "memory");
        }
    }
    __syncthreads();
}

struct P { const float* in[36]; float* out; unsigned char* ws; int ph_lo, ph_hi; };
enum { I_X = 0, I_META, I_F1N, I_F1G, I_F1U, I_F1D, I_MIXN, I_WIN, I_WOUT, I_QN, I_WQ, I_KVN, I_WKV, I_QKNQ, I_QKNK, I_CONVW, I_CONVB, I_DTB, I_ALOG, I_SSDD, I_SSDN, I_RETN,
       I_MU, I_W0, I_W2, I_A0, I_A2, I_G2, I_KK, I_KA, I_RK, I_LN, I_F2N, I_F2G, I_F2U, I_F2D };
#define CAS __attribute__((address_space(4)))
typedef const CAS P* KPtr;
struct Ctx { LAS unsigned char* lds; unsigned char* ws; KPtr kp; int tid, lane, wave, G, bid; };
__device__ __forceinline__ Ctx ctx_make(LAS unsigned char* lds, int wv) {
    Ctx F; KPtr kp = (KPtr)__builtin_amdgcn_kernarg_segment_ptr(); asm volatile("" : "+s"(kp)); int t = wv * 64 + lane_id(); asm volatile("" : "+v"(t));
    F.lds = lds; F.kp = kp; F.ws = kp->ws; F.tid = t; F.lane = t & 63; F.wave = __builtin_amdgcn_readfirstlane(t >> 6); F.G = gridDim.x; F.bid = blockIdx.x; return F;
}


__device__ __forceinline__ int queue_next(const Ctx& F, unsigned* ctr) {
    volatile LAS unsigned* slot = (volatile LAS unsigned*)(F.lds + LDSCTL_OFF + 64);
    __syncthreads();
    if (F.tid == 0) *slot = __hip_atomic_fetch_add(ctr, 1u, __ATOMIC_RELAXED, __HIP_MEMORY_SCOPE_AGENT);
    __syncthreads();
    return (int)*slot;
}
__device__ __forceinline__ f32x16 zero16() { f32x16 z;
#pragma unroll
    for (int i = 0; i < 16; ++i) z[i] = 0.f; return z; }
__device__ __forceinline__ void mma32(f32x16& acc, const LAS float* Ap, int sAi, int sAk, const LAS float* Bp, int sBk, int sBj, int K, int lane) {
    const int r = lane & 31, hh = lane >> 5;
    const LAS float* a = Ap + r * sAi + hh * sAk; const LAS float* b = Bp + hh * sBk + r * sBj;
#pragma unroll 4
    for (int k = 0; k < K; k += 2) acc = __builtin_amdgcn_mfma_f32_32x32x2f32(a[k * sAk], b[k * sBk], acc, 0, 0, 0);
}
__device__ __forceinline__ void mma32bf(f32x16& acc, const LAS float* Ap, int sAi, const LAS float* Bp, int sBj, int K, int lane) {
    const int r = lane & 31, hh = lane >> 5; const LAS float* a = Ap + r * sAi + 8 * hh; const LAS float* b = Bp + r * sBj + 8 * hh;
#pragma unroll 2
    for (int k = 0; k < K; k += 16) { const f32x4 a0 = *(const LAS f32x4*)(a + k), a1 = *(const LAS f32x4*)(a + k + 4), b0 = *(const LAS f32x4*)(b + k), b1 = *(const LAS f32x4*)(b + k + 4);
        v4u aw, bw; aw.x = cvtpk(a0[0], a0[1]); aw.y = cvtpk(a0[2], a0[3]); aw.z = cvtpk(a1[0], a1[1]); aw.w = cvtpk(a1[2], a1[3]); bw.x = cvtpk(b0[0], b0[1]); bw.y = cvtpk(b0[2], b0[3]); bw.z = cvtpk(b1[0], b1[1]); bw.w = cvtpk(b1[2], b1[3]);
        acc = __builtin_amdgcn_mfma_f32_32x32x16_bf16(__builtin_bit_cast(bf16x8, aw), __builtin_bit_cast(bf16x8, bw), acc, 0, 0, 0); }
}
__device__ __forceinline__ int rreg(int reg, int lane) { return (reg & 3) + 8 * (reg >> 2) + 4 * (lane >> 5); }

__device__ __forceinline__ void cvt_tile(const float* src, int srcN, const float* gain, int valid, bf16* dst, int ldd, LAS float* scr, int lane) {
    const int c4 = lane & 15, r0 = lane >> 4;
    f32x4 v[16];
#pragma unroll
    for (int i = 0; i < 16; ++i) v[i] = (4 * c4 < valid) ? *(const f32x4*)(src + (size_t)(r0 + 4 * i) * srcN + 4 * c4) : (f32x4){0.f, 0.f, 0.f, 0.f};
#pragma unroll
    for (int i = 0; i < 16; ++i) { const int kk = r0 + 4 * i; const float gk = gain ? gain[kk] : 1.0f; LAS float* d = scr + kk * 65 + 4 * c4; d[0] = v[i][0] * gk; d[1] = v[i][1] * gk; d[2] = v[i][2] * gk; d[3] = v[i][3] * gk; }
    LDS_WAIT(); asm volatile("" ::: "memory");
    const int c8 = lane & 7;
#pragma unroll
    for (int j = 0; j < 8; ++j) { const int n = (lane >> 3) + 8 * j; const LAS float* s = scr + (8 * c8) * 65 + n;
        v4u o; o.x = pk2(s[0], s[65]); o.y = pk2(s[130], s[195]); o.z = pk2(s[260], s[325]); o.w = pk2(s[390], s[455]);
        *(v4u*)(dst + (size_t)n * ldd + 8 * c8) = o; }
    LDS_WAIT(); asm volatile("" ::: "memory");
}
__device__ __forceinline__ void convert_layer(const Ctx& F, int L, int gw, int NGW) {
    LAS float* scr = (LAS float*)(F.lds + F.wave * 17408);
    const int lane = F.lane;
    constexpr int IT_GU = 2 * 32 * 176, IT_D = 2 * 88 * 32, IT_IN = 32 * 84, IT_OUT = 32 * 32, IT_MLA = 8 * 28;
    bf16* WGU = (bf16*)(F.ws + O_WGU); bf16* WD = (bf16*)(F.ws + O_WD); bf16* WIN = (bf16*)(F.ws + O_WIN); bf16* WOUT = (bf16*)(F.ws + O_WOUT); bf16* WMLA = (bf16*)(F.ws + O_WMLA);
    const int l = L;
    for (int it = gw; it < IT_GU + IT_D + IT_IN + IT_OUT + IT_MLA; it += NGW) {
        int r = it;
        if (r < IT_GU) { const int which = r / 5632, f = 2 * l + which, q = r % 5632, kb = q / 176, nb = q % 176, n0 = 64 * nb, pn = n0 >> 8, within = n0 & 255, isup = within >= 128, f0 = 128 * pn + (within & 127);
            const float* src = (which ? (isup ? F.kp->in[I_F2U] : F.kp->in[I_F2G]) : (isup ? F.kp->in[I_F1U] : F.kp->in[I_F1G])) + (size_t)l * D * DFF + (size_t)(64 * kb) * DFF + f0;
            const float* gain = (which ? F.kp->in[I_F2N] : F.kp->in[I_F1N]) + l * D + 64 * kb;
            cvt_tile(src, DFF, gain, 64, WGU + (size_t)f * 11264 * 2048 + (size_t)n0 * 2048 + 64 * kb, 2048, scr, lane); continue; }
        r -= IT_GU;
        if (r < IT_D) { const int which = r / 2816, f = 2 * l + which, q = r % 2816, kb = q / 32, nb = q % 32;
            const float* src = (which ? F.kp->in[I_F2D] : F.kp->in[I_F1D]) + (size_t)l * DFF * D + (size_t)(64 * kb) * D + 64 * nb;
            cvt_tile(src, D, nullptr, 64, WD + (size_t)f * 2048 * 5632 + (size_t)(64 * nb) * 5632 + 64 * kb, 5632, scr, lane); continue; }
        r -= IT_D;
        if (r < IT_IN) { const int q = r, kb = q / 84, nb = q % 84, n0 = 64 * nb; int valid = NIN - n0; valid = valid < 0 ? 0 : (valid > 64 ? 64 : valid);
            const float* src = F.kp->in[I_WIN] + (size_t)l * D * NIN + (size_t)(64 * kb) * NIN + n0;
            cvt_tile(src, NIN, F.kp->in[I_MIXN] + l * D + 64 * kb, valid, WIN + (size_t)l * NINP * D + (size_t)n0 * D + 64 * kb, D, scr, lane); continue; }
        r -= IT_IN;
        if (r < IT_OUT) { const int q = r, kb = q / 32, nb = q % 32;
            const float* src = F.kp->in[I_WOUT] + (size_t)l * D * D + (size_t)(64 * kb) * D + 64 * nb;
            cvt_tile(src, D, nullptr, 64, WOUT + (size_t)l * D * D + (size_t)(64 * nb) * D + 64 * kb, D, scr, lane); continue; }
        r -= IT_OUT;
        { const int q = r, kb = q / 28, nb = q % 28, n0 = 64 * nb, k0 = 64 * kb;
            const float* src; int srcN, valid;
            if (n0 < 768) { valid = k0 < 384 ? 64 : 0; src = F.kp->in[I_WQ] + (size_t)l * 384 * 768 + (size_t)k0 * 768 + n0; srcN = 768; }
            else { valid = k0 >= 384 ? 64 : 0; src = F.kp->in[I_WKV] + (size_t)l * 128 * 1024 + (size_t)(k0 - 384) * 1024 + (n0 - 768); srcN = 1024; }
            cvt_tile(src, srcN, nullptr, valid, WMLA + (size_t)l * MLAN * 512 + (size_t)n0 * 512 + k0, 512, scr, lane); }
    }
}
__device__ __forceinline__ void p0_prologue(const Ctx& F, int cvt_only) {
    const int gw = F.bid * NWAVES + F.wave, NGW = F.G * NWAVES, lane = F.lane;
    convert_layer(F, 0, gw, NGW);
    if (cvt_only) return;
    bf16* HL = (bf16*)(F.ws + O_H); bf16* HB = (bf16*)(F.ws + O_HB); float* SS = (float*)(F.ws + O_SS); bf16* Y = (bf16*)(F.ws + O_Y); f32x2* ROPE = (f32x2*)(F.ws + O_ROPE);
    for (int row = gw; row < MP; row += NGW) {
        const float* src = row < SEQ ? F.kp->in[I_X] + (size_t)row * D : F.kp->in[I_META] + (size_t)(row - SEQ) * D;
        float sq = 0.f;
#pragma unroll
        for (int j = 0; j < 8; ++j) { f32x4 v = (f32x4){0.f, 0.f, 0.f, 0.f}; if (row < T) v = *(const f32x4*)(src + 256 * j + 4 * lane);
            v2u w; w.x = cvtpk(v[0], v[1]); w.y = cvtpk(v[2], v[3]); *(v2u*)(HB + (size_t)row * D + 256 * j + 4 * lane) = w;
            v2u lw; lw.x = cvtpk(v[0] - pg8::bflo(w.x), v[1] - pg8::bfhi(w.x)); lw.y = cvtpk(v[2] - pg8::bflo(w.y), v[3] - pg8::bfhi(w.y)); *(v2u*)(HL + (size_t)row * D + 256 * j + 4 * lane) = lw;
            sq += (v[0] * v[0] + v[1] * v[1]) + (v[2] * v[2] + v[3] * v[3]); }
        sq = wave_sum(sq); if (lane == 0) __hip_atomic_fetch_add(SS + (size_t)row * 32, sq, __ATOMIC_RELAXED, __HIP_MEMORY_SCOPE_AGENT);
#ifdef PROBE_ZERO_Y
        if (true) {
#else
        if (row >= T) {
#endif
#pragma unroll
            for (int j = 0; j < 4; ++j) *(v4u*)(Y + (size_t)row * D + 512 * j + 8 * lane) = (v4u){0u, 0u, 0u, 0u}; }
#ifdef PROBE_ZERO_Y
        if (row < T && lane < 32) { const float inv = powf(10000.0f, -(float)lane / 32.0f); const float ang = (float)seq_of_row(row) * inv; float sn, cs; sincosf(ang, &sn, &cs); ROPE[row * 32 + lane] = (f32x2){cs, sn}; }
#else
        else if (lane < 32) { const float inv = powf(10000.0f, -(float)lane / 32.0f); const float ang = (float)seq_of_row(row) * inv; float sn, cs; sincosf(ang, &sn, &cs); ROPE[row * 32 + lane] = (f32x2){cs, sn}; }
#endif
    }
}

__device__ __forceinline__ void m1_unit(const Ctx& F, int l, int r0, int r1, int grp) {
    const int lane = F.lane, tid = F.tid;
    const float* U = (const float*)(F.ws + O_U);
    if (r0 < r1) { bf16* AM = (bf16*)(F.ws + O_AMLA); const float* qn = F.kp->in[I_QN] + l * 384; const float* kvn = F.kp->in[I_KVN] + l * 128;
#pragma unroll 4
      for (int row = r0 + F.wave; row < r1; row += NWAVES) { const float* ur = U + (size_t)row * NINP + 8 * lane; const f32x4 a = *(const f32x4*)ur, b = *(const f32x4*)(ur + 4);
        const float sq = (a[0] * a[0] + a[1] * a[1]) + (a[2] * a[2] + a[3] * a[3]) + (b[0] * b[0] + b[1] * b[1]) + (b[2] * b[2] + b[3] * b[3]);
        const float sq_q = wave_sum(lane < 48 ? sq : 0.f), sq_kv = wave_sum(lane >= 48 ? sq : 0.f);
        const float rs = lane < 48 ? 1.0f / sqrtf(sq_q * (1.0f / 384.0f) + EPS) : 1.0f / sqrtf(sq_kv * (1.0f / 128.0f) + EPS);
        const float* gp = lane < 48 ? qn + 8 * lane : kvn + 8 * (lane - 48); const f32x4 g0 = *(const f32x4*)gp, g1 = *(const f32x4*)(gp + 4);
        v4u w; w.x = pk2(a[0] * rs * g0[0], a[1] * rs * g0[1]); w.y = pk2(a[2] * rs * g0[2], a[3] * rs * g0[3]); w.z = pk2(b[0] * rs * g1[0], b[1] * rs * g1[1]); w.w = pk2(b[2] * rs * g1[2], b[3] * rs * g1[3]);
        *(v4u*)(AM + (size_t)row * 512 + 8 * lane) = w; } }
    if (r0 < r1) { float* XBC = (float*)(F.ws + O_XBC); float* DT = (float*)(F.ws + O_DT); float* LA = (float*)(F.ws + O_LA);
      const float* cw = F.kp->in[I_CONVW] + l * 4096; const float* cb = F.kp->in[I_CONVB] + l * 1024;
#pragma unroll 4
      for (int row = r0 + F.wave; row < r1; row += NWAVES) { const int p1 = prev_row(row), p2 = p1 >= 0 ? prev_row(p1) : -1, p3 = p2 >= 0 ? prev_row(p2) : -1;
#pragma unroll
        for (int j = 0; j < 4; ++j) { const int ch = 256 * j + 4 * lane; const size_t uo = U_SSD + 512 + ch; const f32x4 z4 = (f32x4){0.f, 0.f, 0.f, 0.f};
            const f32x4 x3 = *(const f32x4*)(U + (size_t)row * NINP + uo), x2 = p1 >= 0 ? *(const f32x4*)(U + (size_t)p1 * NINP + uo) : z4, x1 = p2 >= 0 ? *(const f32x4*)(U + (size_t)p2 * NINP + uo) : z4, x0 = p3 >= 0 ? *(const f32x4*)(U + (size_t)p3 * NINP + uo) : z4;
            f32x4 o = *(const f32x4*)(cb + ch) + *(const f32x4*)(cw + ch) * x0 + *(const f32x4*)(cw + 1024 + ch) * x1 + *(const f32x4*)(cw + 2048 + ch) * x2 + *(const f32x4*)(cw + 3072 + ch) * x3;
            o[0] = siluf_(o[0]); o[1] = siluf_(o[1]); o[2] = siluf_(o[2]); o[3] = siluf_(o[3]);
            *(f32x4*)(XBC + (size_t)row * 1024 + ch) = o; }
        if (lane < 8) { const float dt = softplusf_(U[(size_t)row * NINP + U_SSD + 1536 + lane] + F.kp->in[I_DTB][l * 8 + lane]); DT[row * 8 + lane] = dt; LA[row * 8 + lane] = -expf(F.kp->in[I_ALOG][l * 8 + lane]) * dt; } } }
    if (r0 < r1) { float* RQK = (float*)(F.ws + O_RQK); const f32x2* ROPE = (const f32x2*)(F.ws + O_ROPE);
#pragma unroll 4
      for (int row = r0 + F.wave; row < r1; row += NWAVES) {
#pragma unroll
        for (int j = 0; j < 4; ++j) { const int idx = lane + 64 * j, qk = idx >> 7, hh = (idx >> 5) & 3, i = idx & 31; const f32x2 cs = ROPE[row * 32 + i];
            const float x1 = U[(size_t)row * NINP + U_RET + qk * 256 + hh * 64 + i], x2 = U[(size_t)row * NINP + U_RET + qk * 256 + hh * 64 + 32 + i]; const float sc = qk ? 0.125f : 1.0f;
            RQK[(size_t)row * 512 + qk * 256 + hh * 64 + i] = (x1 * cs.x - x2 * cs.y) * sc; RQK[(size_t)row * 512 + qk * 256 + hh * 64 + 32 + i] = (x1 * cs.y + x2 * cs.x) * sc; } } }
    if (grp >= 0) { LAS float* xl = (LAS float*)F.lds; const int hd = F.wave, col = lane & 31;
      float* RW = (float*)(F.ws + O_RW); const size_t AS = (size_t)MP * 512; float* RBON = (float*)(F.ws + O_RBON);
      const float* MU = F.kp->in[I_MU] + l * 1664; const float* W2 = F.kp->in[I_W2] + l * 32 * 512; const float* A2 = F.kp->in[I_A2] + l * 32 * 512; const float* G2 = F.kp->in[I_G2] + l * 64 * 512;
      const int r0 = 32 * grp;
      __syncthreads();
#pragma unroll
      for (int j = 0; j < 8; ++j) { const int idx = tid + 512 * j, tk = idx >> 7, cl = idx & 127, row = r0 + tk; float xs = 0.f;
          if (row < T) { const int pr = prev_row(row); const size_t uc = U_RWKV + 1536 + cl; const float x = U[(size_t)row * NINP + uc], xp = pr >= 0 ? U[(size_t)pr * NINP + uc] : 0.f; xs = x + (xp - x) * MU[1536 + cl];
              if (cl < 32) xs = tanhf(xs); else if (cl >= 64) xs = sigmoidf_(xs); }
          xl[tk * 132 + cl] = xs; }
      __syncthreads();
      float w0c[2], a0c[2], kkc[2], kac[2], rkc[2], muR[2], muK[2], muV[2];
#pragma unroll
      for (int ct = 0; ct < 2; ++ct) { const int ch = 64 * hd + 32 * ct + col; w0c[ct] = F.kp->in[I_W0][l * 512 + ch]; a0c[ct] = F.kp->in[I_A0][l * 512 + ch]; kkc[ct] = F.kp->in[I_KK][l * 512 + ch]; kac[ct] = F.kp->in[I_KA][l * 512 + ch]; rkc[ct] = F.kp->in[I_RK][l * 512 + ch];
          muR[ct] = MU[ch]; muK[ct] = MU[512 + ch]; muV[ct] = MU[1024 + ch]; }
      { constexpr int tb = 0;
          f32x16 aw[2], aa[2], ag[2];
#pragma unroll
          for (int ct = 0; ct < 2; ++ct) { aw[ct] = zero16(); aa[ct] = zero16(); ag[ct] = zero16(); }
          const LAS float* xa = xl + (32 * tb + col) * 132 + (lane >> 5); const int chb = 64 * hd + col, kh = lane >> 5;
#define M1_LORA(ACC, WM, XO, NB) do { _Pragma("unroll") for (int hb_ = 0; hb_ < (NB); ++hb_) { float bq_[16][2], xq_[16]; \
              _Pragma("unroll") for (int t_ = 0; t_ < 16; ++t_) { const float* wb_ = (WM) + 1024 * (16 * hb_ + t_); bq_[t_][0] = wb_[wvo]; bq_[t_][1] = wb_[wvo + 32]; xq_[t_] = xa[(XO) + 2 * (16 * hb_ + t_)]; } \
              _Pragma("unroll") for (int t_ = 0; t_ < 16; ++t_) { ACC[0] = __builtin_amdgcn_mfma_f32_32x32x2f32(xq_[t_], bq_[t_][0], ACC[0], 0, 0, 0); ACC[1] = __builtin_amdgcn_mfma_f32_32x32x2f32(xq_[t_], bq_[t_][1], ACC[1], 0, 0, 0); } } } while (0)
          const unsigned wvo = (unsigned)(kh * 512 + chb);
          M1_LORA(aw, W2, 0, 1); M1_LORA(aa, A2, 32, 1); M1_LORA(ag, G2, 64, 2);
#undef M1_LORA
#pragma unroll 4
          for (int reg = 0; reg < 16; ++reg) { const int row = r0 + 32 * tb + rreg(reg, lane); if (row >= T) continue;
              const int pr = prev_row(row); float rr[2], k2[2], vv[2], kk[2], av[2], dec[2]; float nq = 0.f, bq = 0.f;
#pragma unroll
              for (int ct = 0; ct < 2; ++ct) { const float* ur = U + (size_t)row * NINP + U_RWKV + chb + 32 * ct; const float* up = U + (size_t)(pr >= 0 ? pr : 0) * NINP + U_RWKV + chb + 32 * ct;
                  float r = ur[0], k = ur[512], v = ur[1024]; const float rp = pr >= 0 ? up[0] : 0.f, kp = pr >= 0 ? up[512] : 0.f, vp = pr >= 0 ? up[1024] : 0.f;
                  r += (rp - r) * muR[ct]; k += (kp - k) * muK[ct]; v += (vp - v) * muV[ct];
                  float wr = w0c[ct] + aw[ct][reg]; wr = -softplusf_(-wr) - 0.5f; dec[ct] = expf(-expf(wr));
                  av[ct] = sigmoidf_(a0c[ct] + aa[ct][reg]);
                  kk[ct] = k * kkc[ct]; k2[ct] = k * (1.0f + (av[ct] - 1.0f) * kac[ct]); rr[ct] = r; vv[ct] = v;
                  nq += kk[ct] * kk[ct]; bq += r * k2[ct] * rkc[ct]; }
#pragma unroll
              for (int o = 1; o < 32; o <<= 1) { nq += __shfl_xor(nq, o); bq += __shfl_xor(bq, o); }
              const float inrm = 1.0f / fmaxf(sqrtf(nq), 1e-12f);
#pragma unroll
              for (int ct = 0; ct < 2; ++ct) { const size_t o = (size_t)row * 512 + chb + 32 * ct; const float kn = kk[ct] * inrm;
                  RW[o] = rr[ct]; RW[AS + o] = dec[ct]; RW[2 * AS + o] = k2[ct]; RW[3 * AS + o] = vv[ct]; RW[4 * AS + o] = -kn; RW[5 * AS + o] = kn * av[ct]; RW[6 * AS + o] = ag[ct][reg]; }
              if (col == 0) RBON[row * 8 + hd] = bq; }
      } }
}
__device__ __forceinline__ void m1_phase(const Ctx& F, int l, int qi = 1) {
    unsigned* ctr = (unsigned*)(F.ws + O_CTL) + CW_QUEUE + 64 * (4 * l + qi);
    constexpr int NG = (T + 31) / 32, NR = (T + 31) / 32;
    for (;;) { const int u = queue_next(F, ctr); if (u >= NG + NR) break;
        if (u < NG) m1_unit(F, l, 0, 0, u); else { const int r0 = 32 * (u - NG); m1_unit(F, l, r0, r0 + 32 < T ? r0 + 32 : T, -1); } }
}
constexpr int RWC = 64, NRC = (T + RWC - 1) / RWC;
__device__ __forceinline__ void rwkv_chunk_unit(const Ctx& F, int c, int h) {
    LAS float* BH = (LAS float*)F.lds; LAS float* KH = BH + 4160; LAS float* NX = KH + 4160; LAS float* RTT = NX + 4160;
    LAS float* AP = RTT + 4160; LAS float* BZ = AP + 4352; LAS float* Pm = BZ + 4160; LAS float* Qm = Pm + 4160; LAS float* Ge = Qm + 4160; LAS float* segt = Ge + 64;
    const float* RW = (const float*)(F.ws + O_RW); const size_t AS = (size_t)MP * 512; float* MATS = (float*)(F.ws + O_MATS) + (size_t)(c * 8 + h) * 16384;
    int tid = F.tid, w = F.wave; asm volatile("" : "+v"(tid), "+s"(w));
    const int lane = tid & 63, seg = tid >> 6, k = tid & 63;
    __syncthreads();
    { float p[8];
#pragma unroll
      for (int i = 0; i < 8; ++i) { const int s = RWC * c + 8 * seg + i; const float wv = s < T ? RW[AS + (size_t)row_of_seq(s) * 512 + 64 * h + k] : 1.0f; p[i] = i ? p[i - 1] * wv : wv; }
      segt[seg * 64 + k] = p[7];
      __syncthreads();
      float pre = 1.0f, tot = 1.0f;
#pragma unroll
      for (int q = 0; q < 8; ++q) { const float t = segt[q * 64 + k]; if (q < seg) pre *= t; tot *= t; }
      if (seg == 0) Ge[k] = tot;
#pragma unroll
      for (int i = 0; i < 8; ++i) { const int il = 8 * seg + i, s = RWC * c + il; const float G = pre * p[i], Gm1 = i ? pre * p[i - 1] : pre;
          float nk = 0.f, r = 0.f, b = 0.f, kk = 0.f;
          if (s < T) { const size_t o = (size_t)row_of_seq(s) * 512 + 64 * h + k; r = RW[o]; kk = RW[2 * AS + o]; nk = RW[4 * AS + o]; b = RW[5 * AS + o]; }
          const float ig = 1.0f / G;
          NX[k * 65 + il] = nk * Gm1; RTT[k * 65 + il] = r * G; BH[il * 65 + k] = b * ig; KH[il * 65 + k] = kk * ig; } }
    __syncthreads();
    { const int prod = w >> 1; const LAS float* Lm = (prod & 1) ? KH : BH; const LAS float* Rm = (prod < 2) ? NX : RTT;
#pragma unroll
      for (int t = 0; t < 2; ++t) { const int tr = w & 1, tc = t; f32x16 acc = zero16();
          mma32(acc, Lm + 32 * tr * 65, 65, 1, Rm + 32 * tc, 65, 1, 64, lane);
#pragma unroll
          for (int r = 0; r < 16; ++r) { const int j = 32 * tr + rreg(r, lane), i = 32 * tc + (lane & 31); const float v = acc[r];
              if (prod == 0) AP[j * 68 + i] = j < i ? v : 0.f; else if (prod == 1) BZ[j * 65 + i] = j < i ? v : 0.f; else if (prod == 2) Pm[j * 65 + i] = j <= i ? v : 0.f; else Qm[j * 65 + i] = j <= i ? v : 0.f; } } }
    __syncthreads();
    if (w < 2) { LAS float* Yr = (w == 0 ? NX : BZ) + lane * 65;
        for (int ib = 0; ib < 4; ++ib) { float a[16];
#pragma unroll
            for (int ii = 0; ii < 16; ++ii) a[ii] = Yr[16 * ib + ii];
            for (int j = 0; j < 16 * ib; ++j) { const float y = Yr[j]; const LAS float* ap = AP + j * 68 + 16 * ib;
                const f32x4 a0 = *(const LAS f32x4*)ap, a1 = *(const LAS f32x4*)(ap + 4), a2 = *(const LAS f32x4*)(ap + 8), a3 = *(const LAS f32x4*)(ap + 12);
#pragma unroll
                for (int q = 0; q < 4; ++q) { a[q] += y * a0[q]; a[4 + q] += y * a1[q]; a[8 + q] += y * a2[q]; a[12 + q] += y * a3[q]; } }
#pragma unroll
            for (int ii = 1; ii < 16; ++ii)
#pragma unroll
                for (int jj = 0; jj < ii; ++jj) a[ii] += a[jj] * AP[(16 * ib + jj) * 68 + 16 * ib + ii];
#pragma unroll
            for (int ii = 0; ii < 16; ++ii) Yr[16 * ib + ii] = a[ii]; } }
    __syncthreads();
    { const int rb = w >> 1;
#pragma unroll
      for (int t = 0; t < 2; ++t) { const int cb = 2 * (w & 1) + t; f32x16 acc = zero16();
          mma32(acc, (rb < 2 ? NX : BZ) + 32 * (rb & 1) * 65, 65, 1, (cb < 2 ? BH : Pm) + 32 * (cb & 1), 65, 1, 64, lane);
          float* dst = MATS + (rb < 2 ? (cb < 2 ? 0 : 8192) : (cb < 2 ? 4096 : 12288));
#pragma unroll
          for (int r = 0; r < 16; ++r) { const int row = 32 * (rb & 1) + rreg(r, lane), col = 32 * (cb & 1) + (lane & 31); float v = acc[r];
              if (rb < 2 && cb < 2) v = (v + (row == col ? 1.0f : 0.0f)) * Ge[col]; else if (rb < 2) v += RTT[row * 65 + col]; else if (cb < 2) v = (v + KH[row * 65 + col]) * Ge[col]; else v += Qm[row * 65 + col];
              dst[row * 64 + col] = v; } } }
}
template <int SV = 0>
__device__ __forceinline__ void rwkv_state_scan(const Ctx& F, int h, int rg) {
    LAS float* Sx = (LAS float*)F.lds; LAS float* tmp = Sx + 1056; LAS float* ring = tmp + 1024;
    const float* RW = (const float*)(F.ws + O_RW); const size_t AS = (size_t)MP * 512; const float* MATS = (const float*)(F.ws + O_MATS); float* SST8 = (float*)(F.ws + (SV ? O_QKV : O_SSTATE));
    const float* ZERO = (const float*)((const bf16*)(F.ws + O_H) + (size_t)8300 * D);
    const int tid = F.tid, lane = F.lane, w = F.wave, fr = lane & 15, kq = lane >> 4, role = w >> 2, cbk = w & 3;
#define RW_DMA(cn) do { const int cc_ = (cn) < NRC ? (cn) : NRC - 1; const float* mp_ = MATS + (size_t)(cc_ * 8 + h) * 16384; LAS float* sl_ = ring + ((cn) % 3) * 9216; \
        _Pragma("unroll") for (int q_ = 0; q_ < 2; ++q_) { const int ch_ = w + 8 * q_; \
            __builtin_amdgcn_global_load_lds((const unsigned*)(mp_ + ch_ * 256 + lane * 4), (LAS unsigned*)(sl_ + ch_ * 256), 16, 0, 0); \
            __builtin_amdgcn_global_load_lds((const unsigned*)(mp_ + 4096 + ch_ * 256 + lane * 4), (LAS unsigned*)(sl_ + 4096 + ch_ * 256), 16, 0, 0); \
            const int j_ = 4 * ch_ + kq, s_ = RWC * cc_ + j_; const float* vp_ = s_ < T ? RW + 3 * AS + (size_t)row_of_seq(s_) * 512 + 64 * h + 16 * rg + fr : ZERO + fr; \
            __builtin_amdgcn_global_load_lds((const unsigned*)vp_, (LAS unsigned*)(sl_ + 8192 + ch_ * 64), 4, 0, 0); } } while (0)
    __syncthreads();
    for (int i = tid; i < 1056; i += NTHR) Sx[i] = 0.f;
    RW_DMA(0); RW_DMA(1);
    asm volatile("s_waitcnt vmcnt(0)" ::: "memory");
    __syncthreads();
    for (int c = 0; c < NRC; ++c) {
        if (SV != 1) RW_DMA(c + 2);
        { const int idx = 2 * tid, v = idx >> 6, kk = idx & 63; const f32x2 sv = (f32x2){Sx[v * 66 + kk], Sx[v * 66 + kk + 1]}; *(f32x2*)(SST8 + ((size_t)(c * 8 + h) * 64 + 16 * rg + v) * 64 + kk) = sv; }
        const LAS float* sl = ring + (c % 3) * 9216;
        float av[16], bv[16]; f32x4 acc = (f32x4){0.f, 0.f, 0.f, 0.f}, acc2 = acc;
        if (role == 0) { const LAS float* mb = sl + 16 * cbk + fr;
#pragma unroll
            for (int t = 0; t < 16; ++t) { av[t] = Sx[fr * 66 + 4 * t + kq]; bv[t] = mb[(4 * t + kq) * 64]; }
        } else { const LAS float* wb = sl + 4096 + 16 * cbk + fr; const LAS float* vt = sl + 8192 + fr;
#pragma unroll
            for (int t = 0; t < 16; ++t) { av[t] = vt[(4 * t + kq) * 16]; bv[t] = wb[(4 * t + kq) * 64]; } }
#pragma unroll
        for (int t = 0; t < (SV == 2 ? 2 : 16); t += 2) { acc = __builtin_amdgcn_mfma_f32_16x16x4f32(av[t], bv[t], acc, 0, 0, 0); acc2 = __builtin_amdgcn_mfma_f32_16x16x4f32(av[t + 1], bv[t + 1], acc2, 0, 0, 0); }
        acc = acc + acc2;
        if (role != 0) *(LAS f32x4*)(tmp + (cbk * 64 + lane) * 4) = acc;
        LBAR();
        if (role == 0) { acc = acc + *(const LAS f32x4*)(tmp + (cbk * 64 + lane) * 4);
#pragma unroll
            for (int r = 0; r < 4; ++r) Sx[(4 * kq + r) * 66 + 16 * cbk + fr] = acc[r]; }
        if (SV != 1) asm volatile("s_waitcnt vmcnt(8)" ::: "memory");
        LBAR();
    }
    asm volatile("s_waitcnt vmcnt(0)" ::: "memory");
#undef RW_DMA
}
__device__ __forceinline__ void rwkv_out_unit(const Ctx& F, int l, int c, int h) {
    LAS float* S_ = (LAS float*)F.lds; LAS float* E_ = S_ + 4160; LAS float* VT_ = E_ + 4096; LAS float* F_ = VT_ + 4096; LAS float* O_ = F_ + 4096;
    const float* RW = (const float*)(F.ws + O_RW); const size_t AS = (size_t)MP * 512; const float* MATS = (const float*)(F.ws + O_MATS) + (size_t)(c * 8 + h) * 16384;
    const float* SST8 = (const float*)(F.ws + O_SSTATE) + (size_t)(c * 8 + h) * 4096; const float* RBON = (const float*)(F.ws + O_RBON); bf16* Y = (bf16*)(F.ws + O_Y);
    int tid = F.tid, w = F.wave; asm volatile("" : "+v"(tid), "+s"(w)); const int lane = tid & 63;
    const f32x4 z4 = (f32x4){0.f, 0.f, 0.f, 0.f};
    f32x4 sv[2], ev[2], fv[2], tv[2];
#pragma unroll
    for (int q = 0; q < 2; ++q) { const int idx = tid + 512 * q, r = idx >> 4, c4 = idx & 15, s = RWC * c + r;
        sv[q] = *(const f32x4*)(SST8 + r * 64 + 4 * c4); ev[q] = *(const f32x4*)(MATS + 8192 + 4 * idx); fv[q] = *(const f32x4*)(MATS + 12288 + 4 * idx);
        tv[q] = s < T ? *(const f32x4*)(RW + 3 * AS + (size_t)row_of_seq(s) * 512 + 64 * h + 4 * c4) : z4; }
    const int li = tid >> 3, part = tid & 7, ls = RWC * c + li, lrow = ls < T ? row_of_seq(ls) : 0; const size_t lo = (size_t)lrow * 512 + 64 * h + 8 * part;
    f32x4 v0 = z4, v1 = z4, g0 = z4, g1 = z4; float bon = 0.f;
    if (ls < T) { v0 = *(const f32x4*)(RW + 3 * AS + lo); v1 = *(const f32x4*)(RW + 3 * AS + lo + 4); g0 = *(const f32x4*)(RW + 6 * AS + lo); g1 = *(const f32x4*)(RW + 6 * AS + lo + 4); bon = RBON[lrow * 8 + h]; }
    __syncthreads();
#pragma unroll
    for (int q = 0; q < 2; ++q) { const int idx = tid + 512 * q, r = idx >> 4, c4 = idx & 15;
        LAS float* d = S_ + r * 65 + 4 * c4; d[0] = sv[q][0]; d[1] = sv[q][1]; d[2] = sv[q][2]; d[3] = sv[q][3];
        *(LAS f32x4*)(E_ + 4 * idx) = ev[q]; *(LAS f32x4*)(F_ + 4 * idx) = fv[q]; *(LAS f32x4*)(VT_ + r * 64 + 4 * c4) = tv[q]; }
    LBAR();
    const int tr = (w >> 1) & 1, tc = w & 1; f32x16 acc = zero16();
    if (w < 4) mma32(acc, S_ + 32 * tr * 65, 65, 1, E_ + 32 * tc, 64, 1, 64, lane);
    else { mma32(acc, VT_ + 32 * tr, 1, 64, F_ + 32 * tc, 64, 1, 64, lane);
#pragma unroll
        for (int r = 0; r < 16; ++r) O_[(32 * tr + rreg(r, lane)) * 65 + 32 * tc + (lane & 31)] = acc[r]; }
    LBAR();
    if (w < 4) {
#pragma unroll
        for (int r = 0; r < 16; ++r) O_[(32 * tr + rreg(r, lane)) * 65 + 32 * tc + (lane & 31)] += acc[r]; }
    LBAR();
    { float x[8]; float sm = 0.f;
#pragma unroll
      for (int q = 0; q < 8; ++q) { x[q] = O_[(8 * part + q) * 65 + li]; sm += x[q]; }
      sm += __shfl_xor(sm, 1); sm += __shfl_xor(sm, 2); sm += __shfl_xor(sm, 4);
      const float mu = sm * (1.0f / 64.0f); float vq = 0.f;
#pragma unroll
      for (int q = 0; q < 8; ++q) { const float d = x[q] - mu; vq += d * d; }
      vq += __shfl_xor(vq, 1); vq += __shfl_xor(vq, 2); vq += __shfl_xor(vq, 4);
      const float rstd = 1.0f / sqrtf(vq * (1.0f / 64.0f) + 64e-5f);
      if (ls < T) { const float* lng = F.kp->in[I_LN] + l * 512 + 64 * h + 8 * part;
          float ov[8];
#pragma unroll
          for (int q = 0; q < 4; ++q) { ov[q] = ((x[q] - mu) * rstd * lng[q] + bon * v0[q]) * g0[q]; ov[4 + q] = ((x[4 + q] - mu) * rstd * lng[4 + q] + bon * v1[q]) * g1[q]; }
          v4u wv; wv.x = cvtpk(ov[0], ov[1]); wv.y = cvtpk(ov[2], ov[3]); wv.z = cvtpk(ov[4], ov[5]); wv.w = cvtpk(ov[6], ov[7]);
          *(v4u*)(Y + (size_t)lrow * D + 1536 + 64 * h + 8 * part) = wv; } }
}
__device__ __forceinline__ void ssd_states_unit(const Ctx& F, int c, int h) {
    LAS float* Bm = (LAS float*)F.lds; LAS float* XD = Bm + 16384; LAS float* csl = XD + 8192; LAS float* lal = csl + 128; LAS float* dtl = lal + 128;
    const float* XBC = (const float*)(F.ws + O_XBC); const float* DT = (const float*)(F.ws + O_DT); const float* LA = (const float*)(F.ws + O_LA);
    float* SST = (float*)(F.ws + O_SST); float* SDEC = (float*)(F.ws + O_SDEC);
    const int tid = F.tid, lane = F.lane, w = F.wave, g = h >> 2;
    __syncthreads();
    if (tid < 128) { const int row = crow(c, tid); lal[tid] = row >= 0 ? LA[row * 8 + h] : 0.f; dtl[tid] = row >= 0 ? DT[row * 8 + h] : 0.f; }
    __syncthreads();
    if (tid < 64) { const float e0 = lal[2 * tid], e1 = lal[2 * tid + 1]; float s = e0 + e1;
#pragma unroll
        for (int o = 1; o < 64; o <<= 1) { const float t = __shfl_up(s, o); if (tid >= o) s += t; }
        csl[2 * tid + 1] = s; csl[2 * tid] = s - e1; }
    __syncthreads();
    const float cs_end = csl[127];
#pragma unroll
    for (int k = 0; k < 8; ++k) { const int idx = tid + 512 * k, j = idx >> 5, c4 = idx & 31, row = crow(c, j);
        const f32x4 v = row >= 0 ? *(const f32x4*)(XBC + (size_t)row * 1024 + 512 + 128 * g + 4 * c4) : (f32x4){0.f, 0.f, 0.f, 0.f};
        *(LAS f32x4*)(Bm + j * 128 + 4 * c4) = v; }
#pragma unroll
    for (int k = 0; k < 4; ++k) { const int idx = tid + 512 * k, j = idx >> 4, c4 = idx & 15, row = crow(c, j);
        f32x4 v = row >= 0 ? *(const f32x4*)(XBC + (size_t)row * 1024 + 64 * h + 4 * c4) : (f32x4){0.f, 0.f, 0.f, 0.f};
        v = v * (dtl[j] * expf(cs_end - csl[j]));
        *(LAS f32x4*)(XD + j * 64 + 4 * c4) = v; }
    __syncthreads();
    const int tr = w >> 2, tc = w & 3;
    f32x16 acc = zero16();
    mma32(acc, XD + 32 * tr, 1, 64, Bm + 32 * tc, 128, 1, 128, lane);
    float* dst = SST + ((size_t)(c * 8 + h) * 64 + 32 * tr) * 128 + 32 * tc + (lane & 31);
#pragma unroll
    for (int r = 0; r < 16; ++r) dst[(size_t)rreg(r, lane) * 128] = acc[r];
    if (tid == 0) SDEC[(c * 8 + h) * 32] = expf(cs_end);
}
__device__ __forceinline__ float ret_logg(int h) { return logf(1.0f - exp2f(-5.0f - (float)h)); }
__device__ __forceinline__ void ret_states_unit(const Ctx& F, int c, int h) {
    LAS float* V = (LAS float*)F.lds; LAS float* KD = V + 16384;
    const float* U = (const float*)(F.ws + O_U); const float* RQK = (const float*)(F.ws + O_RQK); float* RST = (float*)(F.ws + O_RST);
    const int tid = F.tid, lane = F.lane, w = F.wave; const float lg = ret_logg(h);
    __syncthreads();
#pragma unroll
    for (int k = 0; k < 8; ++k) { const int idx = tid + 512 * k, j = idx >> 5, c4 = idx & 31, row = crow(c, j);
        const f32x4 v = row >= 0 ? *(const f32x4*)(U + (size_t)row * NINP + U_RET + 512 + 128 * h + 4 * c4) : (f32x4){0.f, 0.f, 0.f, 0.f};
        *(LAS f32x4*)(V + j * 128 + 4 * c4) = v; }
#pragma unroll
    for (int k = 0; k < 4; ++k) { const int idx = tid + 512 * k, j = idx >> 4, c4 = idx & 15, row = crow(c, j);
        f32x4 v = row >= 0 ? *(const f32x4*)(RQK + (size_t)row * 512 + 256 + 64 * h + 4 * c4) : (f32x4){0.f, 0.f, 0.f, 0.f};
        v = v * expf((float)(127 - j) * lg);
        *(LAS f32x4*)(KD + j * 64 + 4 * c4) = v; }
    __syncthreads();
    const int tr = w >> 1, tc = w & 1;
    f32x16 acc = zero16();
    mma32(acc, V + 32 * tr, 1, 128, KD + 32 * tc, 64, 1, 128, lane);
    float* dst = RST + ((size_t)(c * 4 + h) * 128 + 32 * tr) * 64 + 32 * tc + (lane & 31);
#pragma unroll
    for (int r = 0; r < 16; ++r) dst[(size_t)rreg(r, lane) * 64] = acc[r];
}

__device__ __forceinline__ void scan_job(float* base, size_t cstride, const float* dec, int decstride, float constdec) {
    float s = 0.f;
    for (int c0 = 0; c0 < NCH; c0 += 13) { float t[13];
#pragma unroll
        for (int i = 0; i < 13; ++i) t[i] = base[(size_t)(c0 + i) * cstride];
#pragma unroll
        for (int i = 0; i < 13; ++i) { const float d = dec ? dec[(c0 + i) * decstride] : constdec; base[(size_t)(c0 + i) * cstride] = s; s = d * s + t[i]; } }
}
__device__ __forceinline__ void rwkv_scan(const Ctx& F, int hb) {
    LAS float* st = (LAS float*)F.lds;
    float* RW = (float*)(F.ws + O_RW); const size_t AS = (size_t)MP * 512; float* OUT = RW + 7 * AS;
    const int tid = F.tid, lane = F.lane, rl = lane >> 3, ks = lane & 7, myrow = 8 * F.wave + rl;
    float S[8];
#pragma unroll
    for (int j = 0; j < 8; ++j) S[j] = 0.f;
    for (int s0 = 0; s0 < T; s0 += 32) {
        __syncthreads();
#pragma unroll
        for (int j = 0; j < 6; ++j) { const int idx = tid + 512 * j, stp = idx / 96, rem = idx % 96, arr = rem >> 4, c4 = rem & 15, s = s0 + stp;
            if (s < T) { const int row = row_of_seq(s); const int asel = arr == 0 ? 0 : (arr == 1 ? 1 : (arr == 2 ? 2 : (arr == 3 ? 4 : (arr == 4 ? 5 : 3))));
                *(LAS f32x4*)(st + stp * 384 + arr * 64 + 4 * c4) = *(const f32x4*)(RW + asel * AS + (size_t)row * 512 + 64 * hb + 4 * c4); } }
        __syncthreads();
        const int nst = (T - s0) < 32 ? (T - s0) : 32;
        for (int stp = 0; stp < nst; ++stp) { const LAS float* b = st + stp * 384 + 8 * ks;
            const f32x4 r0 = *(const LAS f32x4*)(b), r1 = *(const LAS f32x4*)(b + 4), w0 = *(const LAS f32x4*)(b + 64), w1 = *(const LAS f32x4*)(b + 68), k0 = *(const LAS f32x4*)(b + 128), k1 = *(const LAS f32x4*)(b + 132),
                        n0 = *(const LAS f32x4*)(b + 192), n1 = *(const LAS f32x4*)(b + 196), b0 = *(const LAS f32x4*)(b + 256), b1 = *(const LAS f32x4*)(b + 260);
            const float vv = st[stp * 384 + 320 + myrow];
            float sa = (S[0] * n0[0] + S[1] * n0[1]) + (S[2] * n0[2] + S[3] * n0[3]) + (S[4] * n1[0] + S[5] * n1[1]) + (S[6] * n1[2] + S[7] * n1[3]);
            sa += __shfl_xor(sa, 1); sa += __shfl_xor(sa, 2); sa += __shfl_xor(sa, 4);
            float o = 0.f;
#pragma unroll
            for (int j = 0; j < 4; ++j) { S[j] = S[j] * w0[j] + sa * b0[j] + vv * k0[j]; o += S[j] * r0[j]; S[4 + j] = S[4 + j] * w1[j] + sa * b1[j] + vv * k1[j]; o += S[4 + j] * r1[j]; }
            o += __shfl_xor(o, 1); o += __shfl_xor(o, 2); o += __shfl_xor(o, 4);
            if (ks == 0) OUT[(size_t)row_of_seq(s0 + stp) * 512 + 64 * hb + myrow] = o; }
    }
}
__device__ __forceinline__ void mla_prep2_unit(const Ctx& F, int l, int un) {
    const float* QKVb = (const float*)(F.ws + O_QKV); const float* U = (const float*)(F.ws + O_U);
    bf16* Q = (bf16*)(F.ws + O_Q); bf16* K = (bf16*)(F.ws + O_K); bf16* VT = (bf16*)(F.ws + O_VT);
    LAS bf16* Vl = (LAS bf16*)F.lds;
    const int lane = F.lane, tid = F.tid;
    const float* gq = F.kp->in[I_QKNQ] + l * 192; const float* gk = F.kp->in[I_QKNK] + l * 192;
    const float gq0 = gq[lane], gq1 = gq[64 + lane], gq2 = gq[128 + lane], gk0 = gk[lane], gk1 = gk[64 + lane], gk2 = gk[128 + lane];
    const float qs = 0.07216878364870322f * 1.4426950408889634f;
    __syncthreads();
#pragma unroll 4
    for (int i = 0; i < 8; ++i) { const int sl = 8 * F.wave + i, s = 64 * un + sl;
        if (s < T) { const int row = row_of_seq(s); const float* qk = QKVb + (size_t)row * MLAN; const f32x2 cs = ((const f32x2*)(F.ws + O_ROPE))[row * 32 + (lane & 31)];
            const float kpe = U[(size_t)row * NINP + 512 + lane];
#pragma unroll
            for (int h = 0; h < 4; ++h) {
                { float x0 = qk[192 * h + lane], x1 = qk[192 * h + 64 + lane], x2 = qk[192 * h + 128 + lane];
                  const float rs = 1.0f / sqrtf(wave_sum(x0 * x0 + x1 * x1 + x2 * x2) * (1.0f / 192.0f) + EPS);
                  x0 *= rs * gq0; x1 *= rs * gq1; x2 *= rs * gq2;
                  const float ot = __shfl_xor(x2, 32); const float rr = lane < 32 ? x2 * cs.x - ot * cs.y : ot * cs.y + x2 * cs.x;
                  bf16* qd = Q + ((size_t)s * 4 + h) * 192; qd[lane] = (bf16)f2bf(x0 * qs); qd[64 + lane] = (bf16)f2bf(x1 * qs); qd[128 + lane] = (bf16)f2bf(rr * qs); }
                { float x0 = qk[768 + 256 * h + lane], x1 = qk[768 + 256 * h + 64 + lane], x2 = kpe;
                  const float rs = 1.0f / sqrtf(wave_sum(x0 * x0 + x1 * x1 + x2 * x2) * (1.0f / 192.0f) + EPS);
                  x0 *= rs * gk0; x1 *= rs * gk1; x2 *= rs * gk2;
                  const float ot = __shfl_xor(x2, 32); const float rr = lane < 32 ? x2 * cs.x - ot * cs.y : ot * cs.y + x2 * cs.x;
                  bf16* kd = K + ((size_t)s * 4 + h) * 192; kd[lane] = (bf16)f2bf(x0); kd[64 + lane] = (bf16)f2bf(x1); kd[128 + lane] = (bf16)f2bf(rr); }
                Vl[(h * 128 + lane) * 66 + sl] = (bf16)f2bf(qk[768 + 256 * h + 128 + lane]); Vl[(h * 128 + 64 + lane) * 66 + sl] = (bf16)f2bf(qk[768 + 256 * h + 192 + lane]);
            } }
        else {
#pragma unroll
            for (int h = 0; h < 4; ++h) { Vl[(h * 128 + lane) * 66 + sl] = 0; Vl[(h * 128 + 64 + lane) * 66 + sl] = 0; } }
    }
    __syncthreads();
#pragma unroll
    for (int k = 0; k < 8; ++k) { const int idx = tid + 512 * k, r = idx >> 3, j = idx & 7; const LAS unsigned* src = (const LAS unsigned*)(Vl + r * 66 + 8 * j);
        v4u w; w.x = src[0]; w.y = src[1]; w.z = src[2]; w.w = src[3];
        *(v4u*)(VT + (size_t)r * TSEQ + 64 * un + 8 * j) = w; }
}
__device__ __forceinline__ void m3_phase(const Ctx& F, int l) {
    const int b2 = F.bid, NB = F.G;
    for (int job = b2; job < 192; job += NB) {
        if (job < 128) { if (!EN_SSD) continue; const int e = job * 512 + F.tid, h = e >> 13, rest = e & 8191; scan_job((float*)(F.ws + O_SST) + (size_t)h * 8192 + rest, (size_t)8 * 8192, (const float*)(F.ws + O_SDEC) + h * 32, 8 * 32, 0.f); }
        else { if (!EN_RET) continue; const int e = (job - 128) * 512 + F.tid, h = e >> 13, rest = e & 8191; scan_job((float*)(F.ws + O_RST) + (size_t)h * 8192 + rest, (size_t)4 * 8192, nullptr, 0, expf(128.0f * ret_logg(h))); }
    }
    if (EN_MLA) for (int un = b2; un < (T + 63) / 64; un += NB) mla_prep2_unit(F, l, un);
}
template <int VAR = 0>
__device__ __forceinline__ void attn_unit(const Ctx& F, int hh, int qb, size_t yoff = O_Y) {
    LAS bf16* L0 = (LAS bf16*)F.lds;
    const bf16* Q = (const bf16*)(F.ws + O_Q); const bf16* K = (const bf16*)(F.ws + O_K); const bf16* VT = (const bf16*)(F.ws + O_VT); bf16* Y = (bf16*)(F.ws + yoff);
    int tid = F.tid, w = F.wave; asm volatile("" : "+v"(tid), "+s"(w));
    const int lane = tid & 63, h = lane >> 5, c = lane & 31, half = w >> 2, wq = w & 3;
    const int sq = 128 * qb + 32 * wq + c;
    bf16x8 qf[12];
#pragma unroll
    for (int ks = 0; ks < 12; ++ks) qf[ks] = *(const bf16x8*)(Q + ((size_t)sq * 4 + hh) * 192 + 16 * ks + 8 * h);
    f32x16 o[4];
#pragma unroll
    for (int t = 0; t < 4; ++t) o[t] = zero16();
    float m = -1e30f, lsum = 0.f;
    const int nst = qb + 1;
    v4u kr[6], vr[4];
    const unsigned kgo = (unsigned)(((tid >> 3) * 4 + hh) * 192 + 8 * (tid & 7)), klo = (unsigned)((tid >> 3) * 200 + 8 * (tid & 7));
    const unsigned vgo = (unsigned)((hh * 128 + (tid >> 2)) * TSEQ + 8 * (tid & 3)), vlo = (unsigned)(12800 + (tid >> 2) * 72 + 8 * (tid & 3));
#define AT_LOADK(st_) do { const bf16* kb_ = K + (size_t)(128 * (st_)) * 768; _Pragma("unroll") for (int j = 0; j < 6; ++j) kr[j] = *(const v4u*)(kb_ + kgo + (j / 3) * 49152 + 64 * (j % 3)); } while (0)
#define AT_LOADV(st_) do { const bf16* vb_ = VT + 128 * (st_); _Pragma("unroll") for (int j = 0; j < 4; ++j) vr[j] = *(const v4u*)(vb_ + vgo + (j >> 1) * 64 + 32 * (j & 1)); } while (0)
#define AT_STOREK() do { _Pragma("unroll") for (int j = 0; j < 6; ++j) *(LAS v4u*)(L0 + klo + (j / 3) * 22016 + 64 * (j % 3)) = kr[j]; } while (0)
#define AT_STOREV() do { _Pragma("unroll") for (int j = 0; j < 4; ++j) *(LAS v4u*)(L0 + vlo + (j >> 1) * 22016 + 32 * (j & 1)) = vr[j]; } while (0)
    __syncthreads();
    AT_LOADK(0); AT_LOADV(0); AT_STOREK(); AT_STOREV(); if (nst > 1) AT_LOADK(1);
    LBAR();
    const LAS bf16* Ks = L0 + half * 22016; const LAS bf16* Vs = Ks + 12800;
    for (int st = 0; st < nst; ++st) {
        const int kt = 2 * st + half;
        f32x16 sa[2];
#pragma unroll
        for (int t2 = 0; t2 < 2; ++t2) { sa[t2] = zero16();
#pragma unroll
            for (int ks = 0; ks < 12; ++ks) { const bf16x8 a = *(const LAS bf16x8*)(Ks + (32 * t2 + c) * 200 + 16 * ks + 8 * h); sa[t2] = __builtin_amdgcn_mfma_f32_32x32x16_bf16(a, qf[ks], sa[t2], 0, 0, 0); } }
        if (st == nst - 1) {
#pragma unroll
            for (int t2 = 0; t2 < 2; ++t2)
#pragma unroll
                for (int r = 0; r < 16; ++r) { const int key = 64 * kt + 32 * t2 + (r & 3) + 8 * (r >> 2) + 4 * h; if (key > sq) sa[t2][r] = -1e30f; } }
        float mx = -1e30f;
#pragma unroll
        for (int t2 = 0; t2 < 2; ++t2)
#pragma unroll
            for (int r = 0; r < 16; ++r) mx = fmaxf(mx, sa[t2][r]);
        mx = fmaxf(mx, __shfl_xor(mx, 32));
        if (__builtin_amdgcn_ballot_w64(mx > m) != 0ull) { const float mn = fmaxf(m, mx), alpha = __builtin_amdgcn_exp2f(m - mn); m = mn; lsum *= alpha;
#pragma unroll
            for (int t = 0; t < 4; ++t) o[t] = o[t] * alpha; }
        float rs = 0.f;
#pragma unroll
        for (int t2 = 0; t2 < 2; ++t2)
#pragma unroll
            for (int r = 0; r < 16; ++r) { const float pv = __builtin_amdgcn_exp2f(sa[t2][r] - m); sa[t2][r] = pv; rs += pv; }
        rs += __shfl_xor(rs, 32);
        lsum += rs;
        LBAR();
        if (st + 1 < nst) { AT_STOREK(); AT_LOADV(st + 1); }
#pragma unroll
        for (int t2 = 0; t2 < 2; ++t2)
#pragma unroll
            for (int s = 0; s < 2; ++s) { v4u pw; pw.x = cvtpk(sa[t2][8 * s], sa[t2][8 * s + 1]); pw.y = cvtpk(sa[t2][8 * s + 2], sa[t2][8 * s + 3]); pw.z = cvtpk(sa[t2][8 * s + 4], sa[t2][8 * s + 5]); pw.w = cvtpk(sa[t2][8 * s + 6], sa[t2][8 * s + 7]);
                const bf16x8 pf = __builtin_bit_cast(bf16x8, pw);
#pragma unroll
                for (int t = 0; t < 4; ++t) { const LAS bf16* vp = Vs + (32 * t + c) * 72 + 32 * t2 + 16 * s + 4 * h; const v2u lo = *(const LAS v2u*)vp, hi = *(const LAS v2u*)(vp + 8);
                    v4u vw; vw.x = lo.x; vw.y = lo.y; vw.z = hi.x; vw.w = hi.y;
                    o[t] = __builtin_amdgcn_mfma_f32_32x32x16_bf16(__builtin_bit_cast(bf16x8, vw), pf, o[t], 0, 0, 0); } }
        LBAR();
        if (st + 1 < nst) { AT_STOREV(); if (st + 2 < nst) AT_LOADK(st + 2); }
    }
#undef AT_LOADK
#undef AT_LOADV
#undef AT_STOREK
#undef AT_STOREV
    LAS float* MB = (LAS float*)F.lds + (wq * 64 + lane) * 67;
    if (half == 1) { MB[0] = m; MB[1] = lsum;
#pragma unroll
        for (int t = 0; t < 4; ++t)
#pragma unroll
            for (int r = 0; r < 16; ++r) MB[2 + 16 * t + r] = o[t][r]; }
    LBAR();
    if (half == 0) { const float m2 = MB[0], l2 = MB[1], mn = fmaxf(m, m2), a1 = __builtin_amdgcn_exp2f(m - mn), a2 = __builtin_amdgcn_exp2f(m2 - mn);
        const float inv = 1.0f / (lsum * a1 + l2 * a2);
        if (sq < T) { bf16* yr = Y + (size_t)row_of_seq(sq) * D + 128 * hh + 4 * h;
#pragma unroll
            for (int t = 0; t < 4; ++t)
#pragma unroll
                for (int rq = 0; rq < 4; ++rq) { float ov[4];
#pragma unroll
                    for (int i = 0; i < 4; ++i) ov[i] = (o[t][4 * rq + i] * a1 + MB[2 + 16 * t + 4 * rq + i] * a2) * inv;
                    v2u wv; wv.x = cvtpk(ov[0], ov[1]); wv.y = cvtpk(ov[2], ov[3]); *(v2u*)(yr + 32 * t + 8 * rq) = wv; } } }
}
__device__ __forceinline__ void ssd_out_unit(const Ctx& F, int l, int c, int h, int ih) {
    LAS float* CS_ = (LAS float*)F.lds; LAS float* BS_ = CS_ + 4352; LAS float* PS_ = BS_ + 8704; LAS float* SC_ = PS_ + 4352; LAS float* XD_ = SC_ + 8448; LAS float* csl = XD_ + 8448; LAS float* lal = csl + 128; LAS float* dtl = lal + 128;
    LAS float* Y_ = CS_;
    const float* XBC = (const float*)(F.ws + O_XBC); const float* DT = (const float*)(F.ws + O_DT); const float* LA = (const float*)(F.ws + O_LA); const float* U = (const float*)(F.ws + O_U);
    const float* SST = (const float*)(F.ws + O_SST); float* YZ = (float*)(F.ws + O_YZ);
    int tid = F.tid, w = F.wave; asm volatile("" : "+v"(tid), "+s"(w));
    const int lane = tid & 63, g = h >> 2;
    const f32x4 z4 = (f32x4){0.f, 0.f, 0.f, 0.f};
    float lav = 0.f, dtv = 0.f;
    if (tid < 128) { const int row = crow(c, tid); if (row >= 0) { lav = LA[row * 8 + h]; dtv = DT[row * 8 + h]; } }
    f32x4 xdv[4], csv[2][2], bsv[2][4], psv[2][2]; float xsv[8], zv[8];
#pragma unroll
    for (int k = 0; k < 4; ++k) { const int idx = tid + 512 * k, j = idx >> 4, c4 = idx & 15, row = crow(c, j); xdv[k] = row >= 0 ? *(const f32x4*)(XBC + (size_t)row * 1024 + 64 * h + 4 * c4) : z4; }
#pragma unroll
    for (int nh = 0; nh < 2; ++nh) {
#pragma unroll
        for (int k = 0; k < 2; ++k) { const int idx = tid + 512 * k, i = idx >> 4, c4 = idx & 15, row = crow(c, 64 * ih + i); csv[nh][k] = row >= 0 ? *(const f32x4*)(XBC + (size_t)row * 1024 + 768 + 128 * g + 64 * nh + 4 * c4) : z4; }
#pragma unroll
        for (int k = 0; k < 4; ++k) { const int idx = tid + 512 * k, j = idx >> 4, c4 = idx & 15, row = crow(c, j); bsv[nh][k] = row >= 0 ? *(const f32x4*)(XBC + (size_t)row * 1024 + 512 + 128 * g + 64 * nh + 4 * c4) : z4; }
#pragma unroll
        for (int k = 0; k < 2; ++k) { const int idx = tid + 512 * k, pp = idx >> 4, c4 = idx & 15; psv[nh][k] = *(const f32x4*)(SST + ((size_t)(c * 8 + h) * 64 + pp) * 128 + 64 * nh + 4 * c4); } }
#pragma unroll
    for (int k = 0; k < 8; ++k) { const int idx = tid + 512 * k, i = idx >> 6, pp = idx & 63, row = crow(c, 64 * ih + i); xsv[k] = 0.f; zv[k] = 0.f;
        if (row >= 0) { xsv[k] = XBC[(size_t)row * 1024 + 64 * h + pp]; zv[k] = U[(size_t)row * NINP + U_SSD + 64 * h + pp]; } }
    __syncthreads();
    if (tid < 128) { lal[tid] = lav; dtl[tid] = dtv; }
    LBAR();
    if (tid < 64) { const float e0 = lal[2 * tid], e1 = lal[2 * tid + 1]; float s = e0 + e1;
#pragma unroll
        for (int o = 1; o < 64; o <<= 1) { const float t = __shfl_up(s, o); if (tid >= o) s += t; }
        csl[2 * tid + 1] = s; csl[2 * tid] = s - e1; }
#pragma unroll
    for (int k = 0; k < 4; ++k) { const int idx = tid + 512 * k, j = idx >> 4, c4 = idx & 15; const f32x4 v = xdv[k] * dtl[j]; LAS float* d = XD_ + (4 * c4) * 132 + j; d[0] = v[0]; d[132] = v[1]; d[264] = v[2]; d[396] = v[3]; }
    f32x16 acc_s = zero16(), acc_y = zero16();
    const int tr = w >> 2, tc = w & 3, tr2 = (w >> 1) & 1, tc2 = w & 1;
#pragma unroll
    for (int nh = 0; nh < 2; ++nh) {
        if (nh) LBAR();
#pragma unroll
        for (int k = 0; k < 2; ++k) { const int idx = tid + 512 * k, i = idx >> 4, c4 = idx & 15; const f32x4 v = csv[nh][k]; *(LAS f32x4*)(CS_ + i * 68 + 4 * c4) = v; }
#pragma unroll
        for (int k = 0; k < 4; ++k) { const int idx = tid + 512 * k, j = idx >> 4, c4 = idx & 15; const f32x4 v = bsv[nh][k]; *(LAS f32x4*)(BS_ + j * 68 + 4 * c4) = v; }
#pragma unroll
        for (int k = 0; k < 2; ++k) { const int idx = tid + 512 * k, pp = idx >> 4, c4 = idx & 15; const f32x4 v = psv[nh][k]; *(LAS f32x4*)(PS_ + pp * 68 + 4 * c4) = v; }
        LBAR();
        mma32bf(acc_s, CS_ + 32 * tr * 68, 68, BS_ + 32 * tc * 68, 68, 64, lane);
        if (w < 4) mma32bf(acc_y, CS_ + 32 * tr2 * 68, 68, PS_ + 32 * tc2 * 68, 68, 64, lane);
    }
    if (w < 4) {
#pragma unroll
        for (int r = 0; r < 16; ++r) acc_y[r] *= expf(csl[64 * ih + 32 * tr2 + rreg(r, lane)]); }
#pragma unroll
    for (int r = 0; r < 16; ++r) { const int i = 32 * tr + rreg(r, lane), j = 32 * tc + (lane & 31), il = 64 * ih + i;
        SC_[i * 132 + j] = j <= il ? acc_s[r] * expf(csl[il] - csl[j]) : 0.f; }
    LBAR();
    if (w < 4) { mma32bf(acc_y, SC_ + 32 * tr2 * 132, 132, XD_ + 32 * tc2 * 132, 132, 128, lane);
#pragma unroll
        for (int r = 0; r < 16; ++r) Y_[(32 * tr2 + rreg(r, lane)) * 68 + 32 * tc2 + (lane & 31)] = acc_y[r]; }
    LBAR();
    const float Dh = F.kp->in[I_SSDD][l * 8 + h];
#pragma unroll
    for (int k = 0; k < 8; ++k) { const int idx = tid + 512 * k, i = idx >> 6, pp = idx & 63, row = crow(c, 64 * ih + i);
        if (row >= 0) YZ[(size_t)row * 512 + 64 * h + pp] = (Y_[i * 68 + pp] + Dh * xsv[k]) * siluf_(zv[k]); }
}
__device__ __forceinline__ void ret_out_unit(const Ctx& F, int l, int c, int h, int ih) {
    LAS float* Q_ = (LAS float*)F.lds; LAS float* KM_ = Q_ + 4352; LAS float* SC_ = KM_ + 8704; LAS float* VH_ = SC_ + 8448; LAS float* SP_ = KM_; LAS float* Y_ = SC_;
    const float* U = (const float*)(F.ws + O_U); const float* RQK = (const float*)(F.ws + O_RQK); const float* RST = (const float*)(F.ws + O_RST); bf16* Y = (bf16*)(F.ws + O_Y);
    int tid = F.tid, w = F.wave; asm volatile("" : "+v"(tid), "+s"(w));
    const int lane = tid & 63; const float lg = ret_logg(h);
    const f32x4 z4 = (f32x4){0.f, 0.f, 0.f, 0.f};
    f32x4 qv[2], kv[4], spv[4], vv[2][4], gv[4];
#pragma unroll
    for (int k = 0; k < 2; ++k) { const int idx = tid + 512 * k, i = idx >> 4, c4 = idx & 15, row = crow(c, 64 * ih + i); qv[k] = row >= 0 ? *(const f32x4*)(RQK + (size_t)row * 512 + 64 * h + 4 * c4) : z4; }
#pragma unroll
    for (int k = 0; k < 4; ++k) { const int idx = tid + 512 * k, j = idx >> 4, c4 = idx & 15, row = crow(c, j); kv[k] = row >= 0 ? *(const f32x4*)(RQK + (size_t)row * 512 + 256 + 64 * h + 4 * c4) : z4; }
#pragma unroll
    for (int k = 0; k < 4; ++k) { const int idx = tid + 512 * k, vx = idx >> 4, c4 = idx & 15; spv[k] = *(const f32x4*)(RST + ((size_t)(c * 4 + h) * 128 + vx) * 64 + 4 * c4); }
#pragma unroll
    for (int jh = 0; jh < 2; ++jh)
#pragma unroll
        for (int k = 0; k < 4; ++k) { const int idx = tid + 512 * k, j = idx >> 5, c4 = idx & 31, row = crow(c, 64 * jh + j); vv[jh][k] = (jh <= ih && row >= 0) ? *(const f32x4*)(U + (size_t)row * NINP + U_RET + 512 + 128 * h + 4 * c4) : z4; }
    const int li = tid >> 3, part = tid & 7, lrow = crow(c, 64 * ih + li);
#pragma unroll
    for (int k = 0; k < 4; ++k) gv[k] = lrow >= 0 ? *(const f32x4*)(U + (size_t)lrow * NINP + U_RET + 1024 + 128 * h + 16 * part + 4 * k) : z4;
    __syncthreads();
#pragma unroll
    for (int k = 0; k < 2; ++k) { const int idx = tid + 512 * k, i = idx >> 4, c4 = idx & 15; const f32x4 v = qv[k]; *(LAS f32x4*)(Q_ + i * 68 + 4 * c4) = v; }
#pragma unroll
    for (int k = 0; k < 4; ++k) { const int idx = tid + 512 * k, j = idx >> 4, c4 = idx & 15; const f32x4 v = kv[k]; *(LAS f32x4*)(KM_ + j * 68 + 4 * c4) = v; }
    LBAR();
    const int tr = w >> 2, tc = w & 3;
    f32x16 acc_s = zero16();
    mma32bf(acc_s, Q_ + 32 * tr * 68, 68, KM_ + 32 * tc * 68, 68, 64, lane);
    LBAR();
#pragma unroll
    for (int k = 0; k < 4; ++k) { const int idx = tid + 512 * k, vx = idx >> 4, c4 = idx & 15; const f32x4 v = spv[k]; *(LAS f32x4*)(SP_ + vx * 68 + 4 * c4) = v; }
#pragma unroll
    for (int r = 0; r < 16; ++r) { const int i = 32 * tr + rreg(r, lane), j = 32 * tc + (lane & 31), il = 64 * ih + i;
        SC_[i * 132 + j] = j <= il ? acc_s[r] * expf((float)(il - j) * lg) : 0.f; }
#pragma unroll
    for (int k = 0; k < 4; ++k) { const int idx = tid + 512 * k, j = idx >> 5, c4 = idx & 31; const f32x4 v = vv[0][k]; LAS float* d = VH_ + (4 * c4) * 68 + j; d[0] = v[0]; d[68] = v[1]; d[136] = v[2]; d[204] = v[3]; }
    LBAR();
    f32x16 acc_y = zero16();
    mma32bf(acc_y, Q_ + 32 * tr * 68, 68, SP_ + 32 * tc * 68, 68, 64, lane);
#pragma unroll
    for (int r = 0; r < 16; ++r) acc_y[r] *= expf((float)(64 * ih + 32 * tr + rreg(r, lane) + 1) * lg);
    mma32bf(acc_y, SC_ + 32 * tr * 132, 132, VH_ + 32 * tc * 68, 68, 64, lane);
    if (ih) { LBAR();
#pragma unroll
        for (int k = 0; k < 4; ++k) { const int idx = tid + 512 * k, j = idx >> 5, c4 = idx & 31; const f32x4 v = vv[1][k]; LAS float* d = VH_ + (4 * c4) * 68 + j; d[0] = v[0]; d[68] = v[1]; d[136] = v[2]; d[204] = v[3]; }
        LBAR();
        mma32bf(acc_y, SC_ + 32 * tr * 132 + 64, 132, VH_ + 32 * tc * 68, 68, 64, lane); }
    LBAR();
#pragma unroll
    for (int r = 0; r < 16; ++r) Y_[(32 * tr + rreg(r, lane)) * 132 + 32 * tc + (lane & 31)] = acc_y[r];
    LBAR();
    { const LAS float* yr = Y_ + li * 132 + 16 * part;
      float s = 0.f;
#pragma unroll
      for (int k = 0; k < 16; ++k) s += yr[k];
      s += __shfl_xor(s, 1); s += __shfl_xor(s, 2); s += __shfl_xor(s, 4);
      const float mu = s * (1.0f / 128.0f); float q = 0.f;
#pragma unroll
      for (int k = 0; k < 16; ++k) { const float d = yr[k] - mu; q += d * d; }
      q += __shfl_xor(q, 1); q += __shfl_xor(q, 2); q += __shfl_xor(q, 4);
      const float rstd = 1.0f / sqrtf(q * (1.0f / 128.0f) + EPS);
      if (lrow >= 0) { const float* ng = F.kp->in[I_RETN] + l * 512 + 128 * h + 16 * part; float ov[16];
#pragma unroll
          for (int k = 0; k < 16; ++k) ov[k] = (yr[k] - mu) * rstd * ng[k] * siluf_(gv[k >> 2][k & 3]);
          bf16* yd = Y + (size_t)lrow * D + 1024 + 128 * h + 16 * part;
          v4u w0, w1; w0.x = cvtpk(ov[0], ov[1]); w0.y = cvtpk(ov[2], ov[3]); w0.z = cvtpk(ov[4], ov[5]); w0.w = cvtpk(ov[6], ov[7]); w1.x = cvtpk(ov[8], ov[9]); w1.y = cvtpk(ov[10], ov[11]); w1.z = cvtpk(ov[12], ov[13]); w1.w = cvtpk(ov[14], ov[15]);
          *(v4u*)yd = w0; *(v4u*)(yd + 8) = w1; } }
}
__device__ __forceinline__ void m4_phase(const Ctx& F, int l, int qi = 0, int only = -1) {
    unsigned* ctr = (unsigned*)(F.ws + O_CTL) + CW_QUEUE + 64 * (4 * l + qi);
    constexpr int N_AT = 4 * NCH, N_CV = 128, N_SO = NCH * 16, N_RO = NCH * 8, N_WO = NRC * 8, N_ALL = N_AT + N_CV + N_SO + N_RO + N_WO;
    int u = queue_next(F, ctr);
    while (u < N_AT) { if (only < 0) attn_unit<0>(F, u & 3, (NCH - 1) - (u >> 2)); else if (only == 0) attn_unit<DUP_VAR>(F, u & 3, (NCH - 1) - (u >> 2), O_QKV); u = queue_next(F, ctr); }
    while (u < N_AT + N_CV) { if (l + 1 < DEPTH && only < 0) { __syncthreads(); convert_layer(F, l + 1, (u - N_AT) * NWAVES + F.wave, N_CV * NWAVES); }
        u = queue_next(F, ctr); }
    while (u < N_AT + N_CV + N_SO + N_RO) { int v = u - N_AT - N_CV;
        if (v < N_RO) { const int c = v >> 3, h = (v >> 1) & 3, ih = v & 1; if (!(c == 0 && ih == 0) && (only < 0 || only == 2)) ret_out_unit(F, l, c, h, ih); }
        else { v -= N_RO; const int c = v >> 4, h = (v >> 1) & 7, ih = v & 1; if (!(c == 0 && ih == 0) && (only < 0 || only == 1)) ssd_out_unit(F, l, c, h, ih); }
        u = queue_next(F, ctr); }
    if (u < N_ALL && only < 0) {
        if (F.tid == 0) { unsigned* sflag = (unsigned*)(F.ws + O_CTL) + CW_QUEUE + 64 * (16 + l); const unsigned nscan = F.G >= 64 ? 32u : (unsigned)F.G; unsigned sp = 0;
            while (__hip_atomic_load(sflag, __ATOMIC_RELAXED, __HIP_MEMORY_SCOPE_AGENT) < nscan) { __builtin_amdgcn_s_sleep(8); if (++sp > (1u << 22)) break; }
            __builtin_amdgcn_fence(__ATOMIC_ACQUIRE, "agent"); asm volatile("s_waitcnt vmcnt(0)" ::: "memory"); }
        __syncthreads(); }
    while (u < N_ALL) { const int v = u - (N_AT + N_CV + N_SO + N_RO); if (only < 0 || only == 3) rwkv_out_unit(F, l, v >> 3, v & 7); u = queue_next(F, ctr); }
}
__device__ __forceinline__ void m5_phase(const Ctx& F, int l) {
#ifdef PROBE_DUP
    { const bf16* Y = (const bf16*)(F.ws + O_Y); const bf16* Y2 = (const bf16*)(F.ws + O_YZ); unsigned cnt = 0;
      for (int row = F.bid * NWAVES + F.wave; row < T; row += F.G * NWAVES) for (int j = 0; j < 8; ++j) cnt += Y[(size_t)row * D + 64 * j + F.lane] != Y2[(size_t)row * D + 64 * j + F.lane];
      if (cnt) atomicAdd((unsigned*)(F.ws + O_CTL) + 8, cnt); }
#endif
#ifdef PROBE_COPY_U
    { const float* U = (const float*)(F.ws + O_U); bf16* Y = (bf16*)(F.ws + O_Y);
      for (int row = F.bid * NWAVES + F.wave; row < T; row += F.G * NWAVES)
        for (int j = 0; j < 4; ++j) { const float* ur = U + (size_t)(PROBE_COPY_META ? SEQ + (row & 15) : row) * NINP + PROBE_COPY_U + 512 * j + 8 * F.lane; const f32x4 a = *(const f32x4*)ur, b = *(const f32x4*)(ur + 4);
          v4u w; w.x = pk2(a[0], a[1]); w.y = pk2(a[2], a[3]); w.z = pk2(b[0], b[1]); w.w = pk2(b[2], b[3]); *(v4u*)(Y + (size_t)row * D + 512 * j + 8 * F.lane) = w; } }
#endif
    if (!EN_SSD) return;
    const float* YZ = (const float*)(F.ws + O_YZ); bf16* Y = (bf16*)(F.ws + O_Y); const float* ng = F.kp->in[I_SSDN] + l * 512 + 8 * F.lane;
    for (int row = F.bid * NWAVES + F.wave; row < T; row += F.G * NWAVES) { const float* yr = YZ + (size_t)row * 512 + 8 * F.lane; const f32x4 a = *(const f32x4*)yr, b = *(const f32x4*)(yr + 4);
        const float sq = wave_sum((a[0] * a[0] + a[1] * a[1]) + (a[2] * a[2] + a[3] * a[3]) + (b[0] * b[0] + b[1] * b[1]) + (b[2] * b[2] + b[3] * b[3]));
        const float rs = 1.0f / sqrtf(sq * (1.0f / 512.0f) + EPS); const f32x4 g0 = *(const f32x4*)ng, g1 = *(const f32x4*)(ng + 4);
        v4u w; w.x = pk2(a[0] * rs * g0[0], a[1] * rs * g0[1]); w.y = pk2(a[2] * rs * g0[2], a[3] * rs * g0[3]); w.z = pk2(b[0] * rs * g1[0], b[1] * rs * g1[1]); w.w = pk2(b[2] * rs * g1[2], b[3] * rs * g1[3]);
        *(v4u*)(Y + (size_t)row * D + 512 + 8 * F.lane) = w; }
}
template <int MODE  , int NT>
__device__ __forceinline__ void meta_gemm(const Ctx& F, const bf16* A16, int lda, const bf16* Bt, int ldb, int ntasks, int K, float* Cf, int ldc, const float* ss_in, float* ss_out, bf16* Ob, bf16* HL, float scale) {
    constexpr int NACC = MODE == 1 ? 2 * NT : NT;
    LAS float* red = (LAS float*)F.lds;
    int tid = F.tid, w = F.wave; asm volatile("" : "+v"(tid), "+s"(w));
    const int lane = tid & 63, g = lane >> 4, c = lane & 15, kper = K >> 3;
    for (int task = F.G - 1 - F.bid; task < ntasks; task += F.G) {
        const int n0 = MODE == 1 ? 256 * ((64 * task) >> 7) + ((64 * task) & 127) : 16 * NT * task;
        f32x4 acc[NACC];
#pragma unroll
        for (int q = 0; q < NACC; ++q) acc[q] = (f32x4){0.f, 0.f, 0.f, 0.f};
        const bf16* ap = A16 + (size_t)c * lda + w * kper + 8 * g; const bf16* bp = Bt + (size_t)(n0 + c) * ldb + w * kper + 8 * g;
#pragma unroll 4
        for (int kk = 0; kk < kper; kk += 32) { const bf16x8 a = *(const bf16x8*)(ap + kk);
#pragma unroll
            for (int t = 0; t < NT; ++t) { acc[t] = __builtin_amdgcn_mfma_f32_16x16x32_bf16(*(const bf16x8*)(bp + (size_t)(16 * t) * ldb + kk), a, acc[t], 0, 0, 0);
                if (MODE == 1) acc[NT + t] = __builtin_amdgcn_mfma_f32_16x16x32_bf16(*(const bf16x8*)(bp + (size_t)(128 + 16 * t) * ldb + kk), a, acc[NT + t], 0, 0, 0); } }
        __syncthreads();
#pragma unroll
        for (int q = 0; q < NACC; ++q) *(LAS f32x4*)(red + ((w * NACC + q) * 64 + lane) * 4) = acc[q];
        __syncthreads();
        if (w == 0) { const int row = SEQ + c; float rs = 1.0f;
            if (ss_in) { float s = 0.f;
#pragma unroll
                for (int q = 0; q < 8; ++q) { const f32x4 x = *(const f32x4*)(ss_in + (size_t)row * 32 + 4 * q); s += (x[0] + x[1]) + (x[2] + x[3]); }
                rs = __builtin_amdgcn_rsqf(s * (1.0f / 2048.0f) + EPS); }
            float sq = 0.f;
#pragma unroll
            for (int t = 0; t < NT; ++t) { f32x4 v = (f32x4){0.f, 0.f, 0.f, 0.f}, v2 = v;
#pragma unroll
                for (int ww = 0; ww < 8; ++ww) { v = v + *(const LAS f32x4*)(red + ((ww * NACC + t) * 64 + lane) * 4); if (MODE == 1) v2 = v2 + *(const LAS f32x4*)(red + ((ww * NACC + NT + t) * 64 + lane) * 4); }
                if (MODE == 0) *(f32x4*)(Cf + (size_t)row * ldc + 16 * NT * task + 16 * t + 4 * g) = v * rs;
                if (MODE == 3) { v2u wv; wv.x = pk2(v[0] * rs, v[1] * rs); wv.y = pk2(v[2] * rs, v[3] * rs); *(v2u*)(Ob + (size_t)row * ldc + 16 * NT * task + 16 * t + 4 * g) = wv; }
                if (MODE == 1) { float o[4];
#pragma unroll
                    for (int i = 0; i < 4; ++i) { const float gv = v[i] * rs, uv = v2[i] * rs; o[i] = gv * uv * __builtin_amdgcn_rcpf(1.0f + __expf(-gv)); }
                    v2u wv; wv.x = pk2(o[0], o[1]); wv.y = pk2(o[2], o[3]); *(v2u*)(Ob + (size_t)row * DFF + 64 * task + 16 * t + 4 * g) = wv; }
                if (MODE == 2) { const size_t off = (size_t)row * D + 64 * task + 16 * t + 4 * g; const v2u hi = *(const v2u*)(Ob + off), lo = *(const v2u*)(HL + off);
                    f32x4 h4 = (f32x4){pg8::bflo(hi.x) + pg8::bflo(lo.x), pg8::bfhi(hi.x) + pg8::bfhi(lo.x), pg8::bflo(hi.y) + pg8::bflo(lo.y), pg8::bfhi(hi.y) + pg8::bfhi(lo.y)}; h4 = h4 + v * scale;
                    v2u wv; wv.x = cvtpk(h4[0], h4[1]); wv.y = cvtpk(h4[2], h4[3]); v2u lv; lv.x = cvtpk(h4[0] - pg8::bflo(wv.x), h4[1] - pg8::bfhi(wv.x)); lv.y = cvtpk(h4[2] - pg8::bflo(wv.y), h4[3] - pg8::bfhi(wv.y));
                    *(v2u*)(Ob + off) = wv; *(v2u*)(HL + off) = lv; sq += (h4[0] * h4[0] + h4[1] * h4[1]) + (h4[2] * h4[2] + h4[3] * h4[3]); } }
            if (MODE == 2 && ss_out) { sq += __shfl_xor(sq, 16); sq += __shfl_xor(sq, 32); if (g == 0) __hip_atomic_fetch_add(ss_out + (size_t)row * 32 + task, sq, __ATOMIC_RELAXED, __HIP_MEMORY_SCOPE_AGENT); } }
    }    __syncthreads();
}
__device__ __forceinline__ void gemm_swiglu(const Ctx& F, int hl, int ssidx) {
    const bf16* A = (const bf16*)(F.ws + O_HB); const bf16* Bt = (const bf16*)(F.ws + O_WGU) + (size_t)hl * 11264 * 2048; const float* ss = (const float*)(F.ws + O_SS) + (size_t)ssidx * MP * 32;
    { pg8::Gemm g{A, Bt, SEQ, 11264, 2048, 2048, 2048, F.wave}; pg8::StaticOrder S; S.init(SEQ, 11264, F.G, F.bid);
      const int full = (S.nwg / F.G) * F.G, rem = S.nwg - full;
      const bool split = false && (2 * rem == F.G);
      if (split) S.lim = full;
      pg8::EpiSwiGLU E{(bf16*)(F.ws + O_ACT), DFF, ss, 1.0f / 2048.0f, EPS, 2};
      pg8::gemm_phase<pg8::EpiSwiGLU, pg8::StaticOrder, true, true, false>(F.lds, g, S, E);
      if (split) { pg8::StaticOrder S2; S2.init(SEQ, 11264, F.G, F.bid); S2.hmbase = full;
          pg8::EpiSwiGLU E2{(bf16*)(F.ws + O_ACT), DFF, ss, 1.0f / 2048.0f, EPS, 1};
          pg8::gemm_phase<pg8::EpiSwiGLU, pg8::StaticOrder, true, true, true>(F.lds, g, S2, E2); } }
    meta_gemm<1, 4>(F, A + (size_t)SEQ * 2048, 2048, Bt, 2048, DFF / 64, 2048, nullptr, 0, ss, nullptr, (bf16*)(F.ws + O_ACT), nullptr, 0.f);
}
__device__ __forceinline__ void gemm_residual(const Ctx& F, const bf16* A, const bf16* Bt, int K, int ssidx, bool to_out, float scale) {
    float* sso = ssidx >= 0 ? (float*)(F.ws + O_SS) + (size_t)ssidx * MP * 32 : nullptr;
    { pg8::Gemm g{A, Bt, SEQ, 2048, K, K, K, F.wave}; pg8::StaticOrder S; S.init(SEQ, 2048, F.G, F.bid);
      pg8::EpiResidual E{(bf16*)(F.ws + O_H), (bf16*)(F.ws + O_HB), sso, to_out ? F.kp->out : nullptr, SEQ, scale};
      pg8::gemm_phase<pg8::EpiResidual, pg8::StaticOrder, true, true>(F.lds, g, S, E); }
    meta_gemm<2, 4>(F, A + (size_t)SEQ * K, K, Bt, K, 32, K, nullptr, 0, nullptr, sso, (bf16*)(F.ws + O_HB), (bf16*)(F.ws + O_H), scale);
}
__device__ __forceinline__ void gemm_residual_dummy(const Ctx& F, const bf16* A, const bf16* Bt, int K) {
    { pg8::Gemm g{A, Bt, SEQ, 2048, K, K, K, F.wave}; pg8::StaticOrder S; S.init(SEQ, 2048, F.G, F.bid);
      pg8::EpiResidual E{(bf16*)(F.ws + O_RW), (bf16*)(F.ws + O_RW + (size_t)72 * 1024 * 1024), nullptr, nullptr, SEQ, 0.5f};
      pg8::gemm_phase<pg8::EpiResidual, pg8::StaticOrder, true, true>(F.lds, g, S, E); }
}
__device__ __forceinline__ void gemm_scalef32(const Ctx& F, const bf16* A, const bf16* Bt, int N, int K, float* C, int ssidx) {
    const float* ss = ssidx >= 0 ? (const float*)(F.ws + O_SS) + (size_t)ssidx * MP * 32 : nullptr;
    { pg8::Gemm g{A, Bt, SEQ, N, K, K, K, F.wave}; pg8::StaticOrder S; S.init(SEQ, N, F.G, F.bid);
      pg8::EpiScaleF32 E{C, N, ss, 1.0f / 2048.0f, EPS};
      pg8::gemm_phase<pg8::EpiScaleF32, pg8::StaticOrder, true, true>(F.lds, g, S, E); }
    meta_gemm<0, 4>(F, A + (size_t)SEQ * K, K, Bt, K, N / 64, K, C, N, ss, nullptr, nullptr, nullptr, 0.f);
}
__global__ void __launch_bounds__(NTHR, 2) hybrid_fwd(P p) {
    extern __shared__ __attribute__((aligned(16))) unsigned char lds_raw[];
    LAS unsigned char* lds = (LAS unsigned char*)lds_raw;
    const int wv = __builtin_amdgcn_readfirstlane((int)threadIdx.x >> 6);
    for (int u = threadIdx.x; u < (LDS_BYTES - LDSCTL_OFF) / 4; u += NTHR) ((LAS unsigned*)(lds + LDSCTL_OFF))[u] = 0u;
    __syncthreads();
    XcdBarrier bar = xcd_barrier_post((unsigned*)(p.ws + O_CTL) + CW_BAR, (volatile LAS unsigned*)(lds + LDSCTL_OFF), wv);
    const int lo = p.ph_lo, hi = p.ph_hi;
#define IN(k) (lo <= (k) && (k) < hi)
#define SEAM(k) do { if (IN(k) && IN((k) + 1)) xcd_barrier(bar, wv); } while (0)
#ifndef NO_P0
    if (IN(0)) { const Ctx F = ctx_make(lds, wv); p0_prologue(F, 0); }
#ifdef DUP_CVT
    if (IN(0)) { const Ctx F = ctx_make(lds, wv); p0_prologue(F, 1); }
#endif
#endif
    SEAM(0);
    for (int hl = 0; hl < 8; ++hl) {
        const int l = hl >> 1, second = hl & 1, base = 1 + 11 * l + (second ? 9 : 0);
        if (IN(base)) { const Ctx F = ctx_make(lds, wv); gemm_swiglu(F, hl, 3 * l + (second ? 2 : 0)); }
#ifdef DUP_GU
        if (IN(base)) { const Ctx F = ctx_make(lds, wv); gemm_swiglu(F, hl, 3 * l + (second ? 2 : 0)); }
#endif
        SEAM(base);
        if (IN(base + 1)) { const Ctx F = ctx_make(lds, wv);
            gemm_residual(F, (const bf16*)(F.ws + O_ACT), (const bf16*)(F.ws + O_WD) + (size_t)hl * 2048 * 5632, 5632, second ? (l < 3 ? 3 * (l + 1) : -1) : 3 * l + 1, hl == 7, 0.5f); }
#ifdef DUP_DOWN
        if (IN(base + 1)) { const Ctx F = ctx_make(lds, wv); if (DUP_DOWN == 1) gemm_residual_dummy(F, (const bf16*)(F.ws + O_ACT), (const bf16*)(F.ws + O_WD) + (size_t)hl * 2048 * 5632, 5632); else gemm_residual_dummy(F, (const bf16*)(F.ws + O_Y), (const bf16*)(F.ws + O_WOUT) + (size_t)l * D * D, 2048); }
#endif
        if (hl < 7) SEAM(base + 1);
        if (!second) {
            const int mb = base + 2;
            if (IN(mb)) { const Ctx F = ctx_make(lds, wv); gemm_scalef32(F, (const bf16*)(F.ws + O_HB), (const bf16*)(F.ws + O_WIN) + (size_t)l * NINP * D, NINP, 2048, (float*)(F.ws + O_U), 3 * l + 1); }
#ifdef DUP_WIN
            if (IN(mb)) { const Ctx F = ctx_make(lds, wv); gemm_scalef32(F, (const bf16*)(F.ws + O_HB), (const bf16*)(F.ws + O_WIN) + (size_t)l * NINP * D, NINP, 2048, (float*)(F.ws + O_U), 3 * l + 1); }
#endif
            SEAM(mb);
#ifndef NO_M1
            if (IN(mb + 1)) { const Ctx F = ctx_make(lds, wv); m1_phase(F, l); }
#ifdef DUP_M1
            if (IN(mb + 1)) { const Ctx F = ctx_make(lds, wv); m1_phase(F, l, 3); }
#endif
#endif
            SEAM(mb + 1);
            if (IN(mb + 2)) {
                if (EN_MLA) { const Ctx F = ctx_make(lds, wv); gemm_scalef32(F, (const bf16*)(F.ws + O_AMLA), (const bf16*)(F.ws + O_WMLA) + (size_t)l * MLAN * 512, MLAN, 512, (float*)(F.ws + O_QKV), -1); }
#ifndef NO_M2
                { const Ctx F = ctx_make(lds, wv); unsigned* ctr = (unsigned*)(F.ws + O_CTL) + CW_QUEUE + 64 * (4 * l + 2);
                  for (;;) { int u = queue_next(F, ctr); if (u >= NRC * 8 + NCH * 8 + NCH * 4) break;
                      if (u < NRC * 8) { rwkv_chunk_unit(F, u >> 3, u & 7); continue; } u -= NRC * 8;
                      if (u < NCH * 8) { ssd_states_unit(F, u >> 3, u & 7); continue; } u -= NCH * 8;
                      ret_states_unit(F, u >> 2, u & 3); } }
#ifdef DUP_M2Q
                { const Ctx F = ctx_make(lds, wv); unsigned* ctr = (unsigned*)(F.ws + O_CTL) + CW_QUEUE + 64 * (4 * l + 3);
                  for (;;) { int u = queue_next(F, ctr); if (u >= NRC * 8 + NCH * 8 + NCH * 4) break;
                      if (u < NRC * 8) { rwkv_chunk_unit(F, u >> 3, u & 7); continue; } u -= NRC * 8;
                      if (u < NCH * 8) { ssd_states_unit(F, u >> 3, u & 7); continue; } u -= NCH * 8;
                      ret_states_unit(F, u >> 2, u & 3); } }
#endif
#endif
            }
            SEAM(mb + 2);
#ifndef NO_M3
            if (IN(mb + 3)) { const Ctx F = ctx_make(lds, wv); m3_phase(F, l); }
#ifdef DUP_SCAN
            if (IN(mb + 3)) { const Ctx F = ctx_make(lds, wv); if (F.bid < 32) rwkv_state_scan<DUP_SCAN>(F, F.bid >> 2, F.bid & 3); }
#endif
#endif
            SEAM(mb + 3);
#ifndef NO_M4
            if (IN(mb + 4)) { const Ctx F = ctx_make(lds, wv); const int nscan = F.G >= 64 ? 32 : F.G;
                if (F.bid < nscan) { for (int s = F.bid; s < 32; s += nscan) rwkv_state_scan<0>(F, s >> 2, s & 3);
                    asm volatile("s_waitcnt vmcnt(0)" ::: "memory"); __syncthreads();
                    if (F.tid == 0) { __builtin_amdgcn_fence(__ATOMIC_RELEASE, "agent"); asm volatile("s_waitcnt vmcnt(0)" ::: "memory"); __hip_atomic_fetch_add((unsigned*)(F.ws + O_CTL) + CW_QUEUE + 64 * (16 + l), 1u, __ATOMIC_RELAXED, __HIP_MEMORY_SCOPE_AGENT); } } }
            if (IN(mb + 4)) { const Ctx F = ctx_make(lds, wv); m4_phase(F, l); }
#ifdef DUP_M4
            if (IN(mb + 4)) { const Ctx F = ctx_make(lds, wv); m4_phase(F, l, 3, DUP_M4 - 1); }
#endif
#endif
            SEAM(mb + 4);
#ifndef NO_M5
            if (IN(mb + 5)) { const Ctx F = ctx_make(lds, wv); m5_phase(F, l); }
#ifdef DUP_M5
            if (IN(mb + 5)) { const Ctx F = ctx_make(lds, wv); m5_phase(F, l); }
#endif
#endif
            SEAM(mb + 5);
#ifdef DUP_BAR
            for (int q = 0; q < 8; ++q) xcd_barrier(bar, wv);
#endif
            if (IN(mb + 6)) { const Ctx F = ctx_make(lds, wv); gemm_residual(F, (const bf16*)(F.ws + O_Y), (const bf16*)(F.ws + O_WOUT) + (size_t)l * D * D, 2048, 3 * l + 2, false, 1.0f); }
            SEAM(mb + 6);
        }
    }
#ifdef PROBE_DUP
    xcd_barrier(bar, wv);
    { const Ctx F = ctx_make(lds, wv); const float v = (float)__hip_atomic_load((unsigned*)(F.ws + O_CTL) + 8, __ATOMIC_RELAXED, __HIP_MEMORY_SCOPE_AGENT); float* out = F.kp->out;
      for (size_t i = (size_t)F.bid * NTHR + F.tid; i < (size_t)SEQ * D; i += (size_t)F.G * NTHR) out[i] = v; }
#endif
#ifdef PROBE_ADD_META
    xcd_barrier(bar, wv);
    { const Ctx F = ctx_make(lds, wv); const float* H = (const float*)(F.ws + O_H); float* out = F.kp->out;
      for (int row = F.bid * NWAVES + F.wave; row < SEQ; row += F.G * NWAVES)
        for (int j = 0; j < 8; ++j) { const int c = 256 * j + 4 * F.lane; f32x4 v = *(f32x4*)(out + (size_t)row * D + c); v = v + *(const f32x4*)(H + (size_t)(SEQ + (row & 15)) * D + c); *(f32x4*)(out + (size_t)row * D + c) = v; } }
#endif
#undef IN
#undef SEAM
}

extern "C" void kernel_launch(void* const* d_in, const int* in_sizes, int n_in, void* d_out, int out_size, void* d_ws, size_t ws_size, hipStream_t stream) {
    static int grid = 0;
    if (grid == 0) {
        if (n_in != 36 || out_size != SEQ * D || ws_size < WS_END) { fprintf(stderr, "kernel_launch: expected 36 inputs, out %d, ws >= %zu; got n_in %d out %d ws %zu\n", SEQ * D, (size_t)WS_END, n_in, out_size, ws_size); grid = -1; return; }
        int dev = 0, cus = 0, per_cu = 0;
        if (hipGetDevice(&dev) != hipSuccess || hipDeviceGetAttribute(&cus, hipDeviceAttributeMultiprocessorCount, dev) != hipSuccess) { grid = -1; return; }
        if (hipFuncSetAttribute((const void*)hybrid_fwd, hipFuncAttributeMaxDynamicSharedMemorySize, LDS_BYTES) != hipSuccess) { fprintf(stderr, "kernel_launch: hipFuncSetAttribute failed\n"); grid = -1; return; }
        if (hipOccupancyMaxActiveBlocksPerMultiprocessor(&per_cu, (const void*)hybrid_fwd, NTHR, LDS_BYTES) != hipSuccess || per_cu < 1) fprintf(stderr, "kernel_launch: occupancy query reports %d\n", per_cu);
        (void)hipGetLastError();
        grid = cus;
    }
    if (grid < 0) return;
    if (hipMemsetAsync((char*)d_ws + O_CTL, 0, SZ_CTL, stream) != hipSuccess) { fprintf(stderr, "kernel_launch: memset failed\n"); return; }
    P a{};
    for (int i = 0; i < 36; ++i) a.in[i] = (const float*)d_in[i];
    a.out = (float*)d_out; a.ws = (unsigned char*)d_ws;
#if PER_PHASE_LAUNCH
    for (int ph = 0; ph < NPHASE; ++ph) { a.ph_lo = ph; a.ph_hi = ph + 1; hipLaunchKernelGGL(hybrid_fwd, dim3(grid), dim3(NTHR), LDS_BYTES, stream, a); }
#else
    a.ph_lo = 0; a.ph_hi = NPHASE;
    hipLaunchKernelGGL(hybrid_fwd, dim3(grid), dim3(NTHR), LDS_BYTES, stream, a);
#endif
    const hipError_t le = hipPeekAtLastError();
    if (le != hipSuccess) fprintf(stderr, "kernel_launch: launch failed: %s\n", hipGetErrorName(le));
}
```

```cpp
#include <hip/hip_runtime.h>
#include <cstdio>
#include <cstdint>

#define GAS __attribute__((address_space(1)))
#define LAS __attribute__((address_space(3)))
typedef unsigned short bf16;
typedef unsigned v4u __attribute__((ext_vector_type(4)));
typedef unsigned v2u __attribute__((ext_vector_type(2)));
typedef float f32x4 __attribute__((ext_vector_type(4)));
typedef float f32x2 __attribute__((ext_vector_type(2)));
typedef float f32x16 __attribute__((ext_vector_type(16)));
typedef short bf16x8 __attribute__((ext_vector_type(8)));

constexpr int D = 2048, SEQ = 8192, NMETA = 16, T = SEQ + NMETA, MP = 8448, DFF = 5632, DEPTH = 4;
constexpr int NIN = 5320, NINP = 5376, NCH = 65, TSEQ = 8320, MLAN = 1792;
constexpr int U_MLA = 0, U_SSD = 576, U_RET = 2120, U_RWKV = 3656;
constexpr float EPS = 1e-6f;
constexpr int NWAVES = 8, NTHR = 512;
#ifndef EN_MLA
#define EN_MLA 1
#endif
#ifndef EN_SSD
#define EN_SSD 1
#endif
#ifndef EN_RET
#define EN_RET 1
#endif
#ifndef EN_RWKV
#define EN_RWKV 1
#endif
#ifndef PROBE_NOSCAN
#define PROBE_NOSCAN 0
#endif
#ifndef PROBE_ATTCOPY
#define PROBE_ATTCOPY 0
#endif
#ifndef PROBE_COPY_META
#define PROBE_COPY_META 0
#endif
#ifndef DUP_VAR
#define DUP_VAR 0
#endif
#ifndef PER_PHASE_LAUNCH
#define PER_PHASE_LAUNCH 0
#endif
constexpr int NPHASE = 1 + 8 * 2 + 4 * 7;

constexpr size_t O_CTL = 0, SZ_CTL = 13107200;
constexpr int CW_BAR = 4096;
constexpr size_t O_SS = 65536;
constexpr size_t O_WGU = O_CTL + SZ_CTL,                 SZ_WGU = (size_t)8 * 2 * DFF * D * 2;
constexpr size_t O_WD = O_WGU + SZ_WGU,                  SZ_WD = (size_t)8 * D * DFF * 2;
constexpr size_t O_WIN = O_WD + SZ_WD,                   SZ_WIN = (size_t)4 * NINP * D * 2;
constexpr size_t O_WOUT = O_WIN + SZ_WIN,                SZ_WOUT = (size_t)4 * D * D * 2;
constexpr size_t O_WMLA = O_WOUT + SZ_WOUT,              SZ_WMLA = (size_t)4 * MLAN * 512 * 2;
constexpr size_t O_H = O_WMLA + SZ_WMLA,                 SZ_H = (size_t)MP * D * 4;
constexpr size_t O_HB = O_H + SZ_H,                      SZ_HB = (size_t)MP * D * 2;
constexpr size_t O_U = O_HB + SZ_HB,                     SZ_U = (size_t)MP * NINP * 4;
constexpr size_t O_ACT = O_U;
constexpr size_t O_AMLA = O_U + SZ_U,                    SZ_AMLA = (size_t)MP * 512 * 2;
constexpr size_t O_QKV = O_AMLA + SZ_AMLA,               SZ_QKV = (size_t)MP * MLAN * 4;
constexpr size_t O_Q = O_QKV + SZ_QKV,                   SZ_Q = (size_t)TSEQ * 768 * 2;
constexpr size_t O_K = O_Q + SZ_Q;
constexpr size_t O_VT = O_K + SZ_Q,                      SZ_VT = (size_t)4 * 128 * TSEQ * 2;
constexpr size_t O_Y = O_VT + SZ_VT,                     SZ_Y = (size_t)MP * D * 2;
constexpr size_t O_XBC = O_Y + SZ_Y,                     SZ_XBC = (size_t)MP * 1024 * 4;
constexpr size_t O_DT = O_XBC + SZ_XBC,                  SZ_DT = (size_t)MP * 8 * 4;
constexpr size_t O_LA = O_DT + SZ_DT;
constexpr size_t O_SST = O_LA + SZ_DT,                   SZ_SST = (size_t)NCH * 8 * 64 * 128 * 4;
constexpr size_t O_SDEC = O_SST + SZ_SST,                SZ_SDEC = (size_t)NCH * 8 * 128;
constexpr size_t O_YZ = O_SDEC + SZ_SDEC,                SZ_YZ = (size_t)MP * 512 * 4;
constexpr size_t O_RQK = O_YZ + SZ_YZ,                   SZ_RQK = (size_t)MP * 512 * 4;
constexpr size_t O_RST = O_RQK + SZ_RQK,                 SZ_RST = (size_t)NCH * 4 * 128 * 64 * 4;
constexpr size_t O_RW = O_RST + SZ_RST,                  SZ_RW1 = (size_t)MP * 512 * 4;
constexpr size_t O_RBON = O_RW + 8 * SZ_RW1,             SZ_RBON = (size_t)MP * 8 * 4;
constexpr size_t O_ROPE = O_RBON + SZ_RBON,              SZ_ROPE = (size_t)MP * 32 * 8;
constexpr size_t O_MATS = O_ROPE + SZ_ROPE,             SZ_MATS = (size_t)129 * 8 * 16384 * 4;
constexpr size_t O_SSTATE = O_RW + 7 * SZ_RW1;
constexpr size_t WS_END = O_MATS + SZ_MATS;
static_assert((size_t)129 * 8 * 4096 * 4 <= SZ_RW1, "sstate");
static_assert(WS_END <= 1424122240ull, "d_ws map too large");
static_assert(O_SS + (size_t)12 * MP * 32 * 4 <= SZ_CTL, "ctl map");
static_assert((size_t)MP * DFF * 2 <= SZ_U, "act overlays u");

constexpr int RING_BYTES = 131072;
constexpr int LDSCTL_OFF = 143360;
constexpr int LDS_BYTES = 147456;

#define LDS_WAIT() asm volatile("s_waitcnt lgkmcnt(0)" ::: "memory")
#define LBAR() do { asm volatile("s_waitcnt lgkmcnt(0)" ::: "memory"); __builtin_amdgcn_s_barrier(); asm volatile("" ::: "memory"); } while (0)
constexpr int CW_QUEUE = 8192;
#define VM_WAIT() asm volatile("s_waitcnt vmcnt(0)" ::: "memory")
__device__ __forceinline__ unsigned f2bf(float f) { unsigned u = __builtin_bit_cast(unsigned, f); return (u + 0x7fffu + ((u >> 16) & 1u)) >> 16; }
__device__ __forceinline__ unsigned pk2(float lo, float hi) { return f2bf(lo) | (f2bf(hi) << 16); }
typedef __bf16 bf16x2_t __attribute__((ext_vector_type(2)));
__device__ __forceinline__ unsigned cvtpk(float lo, float hi) { const f32x2 v = {lo, hi}; return __builtin_bit_cast(unsigned, __builtin_convertvector(v, bf16x2_t)); }
__device__ __forceinline__ int lane_id() { unsigned ones = ~0u; asm volatile("" : "+s"(ones)); return (int)__builtin_amdgcn_mbcnt_hi(ones, __builtin_amdgcn_mbcnt_lo(ones, 0u)); }
template <int CTRL> __device__ __forceinline__ float dpp_(float v) { return __builtin_bit_cast(float, __builtin_amdgcn_update_dpp(0, __builtin_bit_cast(int, v), CTRL, 0xF, 0xF, true)); }
__device__ __forceinline__ float rdlane(float v, int l) { return __builtin_bit_cast(float, __builtin_amdgcn_readlane(__builtin_bit_cast(int, v), l)); }
__device__ __forceinline__ float sum4(float v) { v += dpp_<0xB1>(v); v += dpp_<0x4E>(v); return v; }
__device__ __forceinline__ float sum8(float v) { v = sum4(v); v += dpp_<0x141>(v); return v; }
__device__ __forceinline__ float sum16(float v) { v = sum8(v); v += dpp_<0x140>(v); return v; }
__device__ __forceinline__ float wave_sum(float v) { v = sum16(v); return (rdlane(v, 0) + rdlane(v, 16)) + (rdlane(v, 32) + rdlane(v, 48)); }
__device__ __forceinline__ float sum32(float v, int lane) { v = sum16(v); const float lo = rdlane(v, 0) + rdlane(v, 16), hi = rdlane(v, 32) + rdlane(v, 48); return (lane & 32) ? hi : lo; }
__device__ __forceinline__ float xor32f(float v, int lane) {
    const unsigned x = __builtin_bit_cast(unsigned, v); const auto r = __builtin_amdgcn_permlane32_swap(x, x, false, false);
    return __builtin_bit_cast(float, (lane & 32) ? r[0] : r[1]); }
#ifndef TIME_BLK
#define TIME_BLK 0
#endif
#ifndef TIME_USCALE
#define TIME_USCALE 64
#endif
#ifdef TIME_ALL
#define TU_BLK_ true
#else
#define TU_BLK_ (blockIdx.x == TIME_BLK)
#endif
#ifdef TIME_UNIT
#define TU_B(id) do { if ((id) == TIME_UNIT && TU_BLK_ && threadIdx.x == 0) { ((volatile LAS unsigned long long*)(F.lds + LDSCTL_OFF + 1024))[2] = wall_clock64(); } } while (0)
#define TU_E(id) do { if ((id) == TIME_UNIT && TU_BLK_ && threadIdx.x == 0) { volatile LAS unsigned long long* tq_ = (volatile LAS unsigned long long*)(F.lds + LDSCTL_OFF + 1024); tq_[3] += wall_clock64() - tq_[2]; tq_[4] += 1ull; } } while (0)
#else
#define TU_B(id) do { } while (0)
#define TU_E(id) do { } while (0)
#endif
__device__ __forceinline__ float sigmoidf_(float x) { return 1.0f / (1.0f + __expf(-x)); }
__device__ __forceinline__ float siluf_(float x) { return x / (1.0f + __expf(-x)); }
__device__ __forceinline__ float softplusf_(float x) { return x > 20.f ? x : log1pf(expf(x)); }
struct UB { const bf16* p;
    __device__ __forceinline__ float operator[](size_t i) const { return __builtin_bit_cast(float, (unsigned)p[i] << 16); }
    __device__ __forceinline__ UB operator+(size_t o) const { return UB{p + o}; } };
__device__ __forceinline__ f32x4 ldu4(const UB u) { const v2u w = *(const v2u*)u.p;
    return (f32x4){__builtin_bit_cast(float, w.x << 16), __builtin_bit_cast(float, w.x & 0xffff0000u), __builtin_bit_cast(float, w.y << 16), __builtin_bit_cast(float, w.y & 0xffff0000u)}; }
__device__ __forceinline__ int row_of_seq(int s) { return s < NMETA ? SEQ + s : s - NMETA; }
__device__ __forceinline__ int seq_of_row(int r) { return r >= SEQ ? r - SEQ : r + NMETA; }
__device__ __forceinline__ int prev_row(int r) { return r == SEQ ? -1 : (r == 0 ? T - 1 : r - 1); }
__device__ __forceinline__ int crow(int c, int p) { return c == 0 ? (p >= 112 ? SEQ + p - 112 : -1) : 128 * (c - 1) + p; }
namespace pg8 {
#define PG8_LAS __attribute__((address_space(3)))
typedef unsigned short bf16_t;
typedef short bf16x8 __attribute__((ext_vector_type(8)));
typedef float f32x4 __attribute__((ext_vector_type(4)));
typedef unsigned u32x4 __attribute__((ext_vector_type(4)));
constexpr int BM = 256, BK = 64, HALF = 128, HTB = HALF * BK * 2  , STAGE_BYTES = 8 * HTB, NXCD = 8, WGM = 8;

__host__ __device__ __forceinline__ int lds_byte(int r, int c) { const int st = (r >> 4) * 2 + (c >> 5), rr = r & 15, cc = c & 31, ob = rr * 64 + cc * 2; return st * 1024 + (ob ^ (((ob >> 9) & 1) << 5)); }
__host__ __device__ __forceinline__ void stage_rc(int b, int& R, int& C) { const int st = b / 1024, sb = b % 1024, swz = sb ^ (((sb >> 9) & 1) << 5); R = (st >> 1) * 16 + swz / 64; C = (st & 1) * 32 + (swz % 64) / 2; }
__host__ __device__ __forceinline__ int perm32(int rho) { const int n = rho >> 4, i = rho & 15; return 8 * (i >> 2) + 4 * n + (i & 3); }

struct Unit { int pm, pn, ah; };
struct Gemm { const bf16_t* A; const bf16_t* Bt; int M, N, K, lda, ldb, wv; };

struct StaticOrder {
    int nM, nN, nwg, G, c, lim, hmbase;
    __host__ __device__ void init(int M, int N, int G_, int c_) { nM = M / BM; nN = N / BM; nwg = nM * nN; G = G_; c = c_; lim = nwg; hmbase = -1; }
    __host__ __device__ bool next(int i, Unit& u) const {
        long L; u.ah = 0;
        if (hmbase >= 0) { if (i > 0) return false; L = hmbase + (c >> 1); u.ah = c & 1; if (L >= nwg) return false; }
        else { L = (long)i * G + c; if (L >= lim) return false; }
        int wgid = (int)L; { const int q = nwg / NXCD, r = nwg % NXCD, xcd = wgid % NXCD, off = wgid / NXCD; wgid = (xcd < r ? xcd * (q + 1) : r * (q + 1) + (xcd - r) * q) + off; }
        const int nig = WGM * nN, gid = wgid / nig, fm = gid * WGM, gsz = (nM - fm) < WGM ? (nM - fm) : WGM;
        u.pm = fm + ((wgid % nig) % gsz); u.pn = (wgid % nig) / gsz; return true;
    }
    __device__ __forceinline__ void a_ready(const Unit&) const {}
    __device__ __forceinline__ void done(const Unit&) const {}
};

__device__ __forceinline__ unsigned cvt_pk_bf16(float lo, float hi) { unsigned r; asm volatile("v_cvt_pk_bf16_f32 %0, %1, %2" : "=v"(r) : "v"(lo), "v"(hi)); return r; }

template <class Epi, class Sched, bool ALIGN_EPI = false, bool SP2 = false, bool HM = false>
__device__ __forceinline__ void gemm_phase(PG8_LAS unsigned char* lds, const Gemm g, const Sched& S, const Epi& E) {
    int tid = g.wv * 64 + lane_id(); asm volatile("" : "+v"(tid)); const int wid = g.wv, lane = tid & 63, wr = wid >> 2, wc = wid & 3, fr = lane & 15, fq = lane >> 4;
    const int K = g.K, nt = K / BK;
    unsigned voffA[2], voffB[2];
#pragma unroll
    for (int i = 0; i < 2; ++i) { int R, C; stage_rc(tid * 16 + i * 8192, R, C); const int Rb = Epi::PERM ? ((R & ~31) + perm32(R & 31)) : R;
        voffA[i] = (unsigned)(R * g.lda + C) * 2u; voffB[i] = (unsigned)(Rb * g.ldb + C) * 2u; }
    const size_t kstep = (size_t)(BK * 2);
    const size_t hA = (size_t)HALF * g.lda * 2, hB = (size_t)HALF * g.ldb * 2;
    const size_t tA = 2 * hA, tB = 2 * hB;
    const unsigned ldsw = (unsigned)wid * 1024u;
    const int aoff = lds_byte(wr * 64 + fr, fq * 8), boff = lds_byte(wc * 32 + fr, fq * 8);
#define PG8_SA(b, h) (((b) * 2 + (h)) * HTB)
#define PG8_SB(b, h) ((4 + (b) * 2 + (h)) * HTB)
#define PG8_STAGE(bufoff, gbase, voff) do { _Pragma("unroll") for (int _i = 0; _i < 2; ++_i) \
        __builtin_amdgcn_global_load_lds((const unsigned*)((const char*)(gbase) + (voff)[_i]), (PG8_LAS unsigned*)(lds + (bufoff) + ldsw + _i * 8192), 16, 0, 0); } while (0)
#define PG8_LDA(dst, b, h) do { _Pragma("unroll") for (int m = 0; m < 4; ++m) _Pragma("unroll") for (int k = 0; k < 2; ++k) dst[m][k] = *(const PG8_LAS bf16x8*)(lds + PG8_SA(b, h) + aoff + m * 2048 + k * 1024); } while (0)
#define PG8_LDB(dst, b, h) do { _Pragma("unroll") for (int n = 0; n < 2; ++n) _Pragma("unroll") for (int k = 0; k < 2; ++k) dst[n][k] = *(const PG8_LAS bf16x8*)(lds + PG8_SB(b, h) + boff + n * 2048 + k * 1024); } while (0)
#define PG8_MMA(ai, bj, At, Bt) do { __builtin_amdgcn_s_setprio(1); _Pragma("unroll") for (int m = 0; m < 4; ++m) _Pragma("unroll") for (int n = 0; n < 2; ++n) _Pragma("unroll") for (int k = 0; k < 2; ++k) \
        acc[ai][bj][m][n] = __builtin_amdgcn_mfma_f32_16x16x32_bf16(Bt[n][k], At[m][k], acc[ai][bj][m][n], 0, 0, 0); __builtin_amdgcn_s_setprio(0); } while (0)
#define PG8_WAIT_V(n) asm volatile("s_waitcnt vmcnt(" #n ")" ::: "memory")
#define PG8_WAIT_L(n) asm volatile("s_waitcnt lgkmcnt(" #n ")" ::: "memory")
#define PG8_BAR __builtin_amdgcn_s_barrier()
#define PG8_SCHED __builtin_amdgcn_sched_barrier(0)
    Unit cur, nxt; int ui = 0;
    if (!S.next(0, cur)) return;
    f32x4 acc[2][2][4][2];
#pragma unroll
    for (int a = 0; a < 2; ++a)
#pragma unroll
        for (int b = 0; b < 2; ++b)
#pragma unroll
            for (int m = 0; m < 4; ++m)
#pragma unroll
                for (int n = 0; n < 2; ++n) acc[a][b][m][n] = (f32x4){0.f, 0.f, 0.f, 0.f};
    bf16x8 At[4][2], B0[2][2], B1[2][2];
    const char* cA = (const char*)g.A + (size_t)cur.pm * tA + (size_t)cur.ah * hA; const char* cB = (const char*)g.Bt + (size_t)cur.pn * tB;
    S.a_ready(cur);
    if constexpr (SP2) {
        PG8_STAGE(PG8_SB(0, 0), cB, voffB); PG8_STAGE(PG8_SB(0, 1), cB + hB, voffB); PG8_STAGE(PG8_SA(0, 0), cA, voffA); PG8_STAGE(PG8_SA(0, 1), cA + hA, voffA);
        if (wr == 1) PG8_BAR;
        PG8_WAIT_V(2); PG8_BAR;
        PG8_STAGE(PG8_SB(1, 0), cB + kstep, voffB); PG8_STAGE(PG8_SA(1, 0), cA + kstep, voffA); PG8_STAGE(PG8_SB(1, 1), cB + hB + kstep, voffB);
        PG8_WAIT_V(6); PG8_BAR;
    } else {
        PG8_STAGE(PG8_SB(0, 0), cB, voffB); PG8_STAGE(PG8_SA(0, 0), cA, voffA); PG8_STAGE(PG8_SB(0, 1), cB + hB, voffB); PG8_STAGE(PG8_SA(0, 1), cA + hA, voffA);
        if (wr == 1) PG8_BAR;
        PG8_WAIT_V(4); PG8_BAR;
        PG8_STAGE(PG8_SB(1, 0), cB + kstep, voffB); PG8_STAGE(PG8_SA(1, 0), cA + kstep, voffA); PG8_STAGE(PG8_SB(1, 1), cB + hB + kstep, voffB);
        PG8_WAIT_V(6); PG8_BAR;
    }
    for (;;) {
        const bool has_next = S.next(ui + 1, nxt);
        const char* nA = has_next ? (const char*)g.A + (size_t)nxt.pm * tA + (size_t)nxt.ah * hA : cA; const char* nB = has_next ? (const char*)g.Bt + (size_t)nxt.pn * tB : cB;
        for (int t = 0; t < nt; t += 2) {
            const bool last = (t == nt - 2);
            const char* a1 = cA + (size_t)(t + 1) * kstep;
            const char* a2 = last ? nA : cA + (size_t)(t + 2) * kstep; const char* b2 = last ? nB : cB + (size_t)(t + 2) * kstep;
            const char* a3 = a2 + kstep; const char* b3 = b2 + kstep;
            if (last && has_next) S.a_ready(nxt);
            if constexpr (SP2) {
            PG8_LDB(B0, 0, 0); PG8_LDB(B1, 0, 1); PG8_SCHED; PG8_LDA(At, 0, 0); PG8_STAGE(PG8_SA(1, 1), a1 + hA, voffA);
            PG8_WAIT_V(8); PG8_WAIT_L(0); PG8_BAR; PG8_MMA(0, 0, At, B0); PG8_MMA(0, 1, At, B1); PG8_BAR; PG8_SCHED;
            if constexpr (!HM) PG8_LDA(At, 0, 1); PG8_STAGE(PG8_SB(0, 0), b2, voffB); PG8_STAGE(PG8_SB(0, 1), b2 + hB, voffB); PG8_STAGE(PG8_SA(0, 0), a2, voffA);
            PG8_WAIT_V(8); PG8_WAIT_L(0); PG8_BAR; if constexpr (!HM) { PG8_MMA(1, 0, At, B0); PG8_MMA(1, 1, At, B1); } PG8_BAR; PG8_SCHED;
            PG8_LDB(B0, 1, 0); PG8_LDB(B1, 1, 1); PG8_SCHED; PG8_LDA(At, 1, 0); PG8_STAGE(PG8_SA(0, 1), a2 + hA, voffA);
            PG8_WAIT_V(8); PG8_WAIT_L(0); PG8_BAR; PG8_MMA(0, 0, At, B0); PG8_MMA(0, 1, At, B1); PG8_BAR; PG8_SCHED;
            if constexpr (!HM) PG8_LDA(At, 1, 1); PG8_STAGE(PG8_SB(1, 0), b3, voffB); PG8_STAGE(PG8_SB(1, 1), b3 + hB, voffB); PG8_STAGE(PG8_SA(1, 0), a3, voffA);
            PG8_WAIT_V(8); PG8_WAIT_L(0); PG8_BAR; if constexpr (!HM) { PG8_MMA(1, 0, At, B0); PG8_MMA(1, 1, At, B1); } PG8_BAR; PG8_SCHED;
            } else {
            PG8_LDB(B0, 0, 0); PG8_SCHED; PG8_LDA(At, 0, 0); PG8_STAGE(PG8_SA(1, 1), a1 + hA, voffA);
            PG8_WAIT_L(8); PG8_BAR; PG8_WAIT_L(0); PG8_MMA(0, 0, At, B0); PG8_BAR; PG8_SCHED;
            PG8_LDB(B1, 0, 1); PG8_STAGE(PG8_SB(0, 0), b2, voffB);
            PG8_BAR; PG8_WAIT_L(0); PG8_MMA(0, 1, At, B1); PG8_BAR;
            PG8_LDA(At, 0, 1); PG8_STAGE(PG8_SA(0, 0), a2, voffA);
            PG8_BAR; PG8_WAIT_L(0); PG8_MMA(1, 0, At, B0); PG8_BAR; PG8_SCHED;
            PG8_STAGE(PG8_SB(0, 1), b2 + hB, voffB);
            PG8_WAIT_V(6); PG8_BAR; PG8_MMA(1, 1, At, B1); PG8_BAR;
            PG8_LDB(B0, 1, 0); PG8_SCHED; PG8_LDA(At, 1, 0); PG8_STAGE(PG8_SA(0, 1), a2 + hA, voffA);
            PG8_WAIT_L(8); PG8_BAR; PG8_WAIT_L(0); PG8_MMA(0, 0, At, B0); PG8_BAR; PG8_SCHED;
            PG8_LDB(B1, 1, 1); PG8_STAGE(PG8_SB(1, 0), b3, voffB);
            PG8_BAR; PG8_WAIT_L(0); PG8_MMA(0, 1, At, B1); PG8_BAR;
            PG8_LDA(At, 1, 1); PG8_STAGE(PG8_SA(1, 0), a3, voffA);
            PG8_BAR; PG8_WAIT_L(0); PG8_MMA(1, 0, At, B0); PG8_BAR; PG8_SCHED;
            PG8_STAGE(PG8_SB(1, 1), b3 + hB, voffB);
            PG8_WAIT_V(6); PG8_BAR; PG8_MMA(1, 1, At, B1); PG8_BAR;
            }
        }
        if constexpr (ALIGN_EPI) { if (wr == 0) PG8_BAR; }
        if constexpr (!Epi::AFTER_DRAIN) { E(acc, cur, wr, wc, fr, fq); S.done(cur); }
        if (!has_next) break;
#pragma unroll
        for (int a = 0; a < 2; ++a)
#pragma unroll
            for (int b = 0; b < 2; ++b)
#pragma unroll
                for (int m = 0; m < 4; ++m)
#pragma unroll
                    for (int n = 0; n < 2; ++n) acc[a][b][m][n] = (f32x4){0.f, 0.f, 0.f, 0.f};
        cur = nxt; cA = nA; cB = nB; ++ui;
        if constexpr (ALIGN_EPI) { if (wr == 1) PG8_BAR; }
    }
    PG8_WAIT_V(0);
    if constexpr (!ALIGN_EPI) { if (wr == 0) PG8_BAR; }
    PG8_BAR;
    if constexpr (Epi::AFTER_DRAIN) { E.fused(acc, cur, wr, wc, fr, fq, lds, wid, lane); S.done(cur); }
#undef PG8_SA
#undef PG8_SB
#undef PG8_STAGE
#undef PG8_LDA
#undef PG8_LDB
#undef PG8_MMA
#undef PG8_WAIT_V
#undef PG8_WAIT_L
#undef PG8_BAR
#undef PG8_SCHED
}

__device__ __forceinline__ float row_ss(const float* ss, int row, int fq) {
    const f32x4 a = *(const f32x4*)(ss + (size_t)row * 32 + 8 * fq), b = *(const f32x4*)(ss + (size_t)row * 32 + 8 * fq + 4);
    float s = ((a[0] + a[1]) + (a[2] + a[3])) + ((b[0] + b[1]) + (b[2] + b[3]));
    s += __shfl_xor(s, 16); s += __shfl_xor(s, 32); return s;
}
struct EpiScaleF32 {
    static constexpr bool PERM = false, AFTER_DRAIN = false;
    float* C; int ldc; const float* ss; float inv_d, eps;
    __device__ __forceinline__ void operator()(const f32x4 (&acc)[2][2][4][2], const Unit& u, int wr, int wc, int fr, int fq) const {
        const int row0 = u.pm * BM + wr * 64 + fr, col0 = u.pn * BM + wc * 32 + 4 * fq;
#pragma unroll
        for (int ai = 0; ai < 2; ++ai)
#pragma unroll
            for (int m = 0; m < 4; ++m) { const int row = row0 + ai * HALF + m * 16; float* rowp = C + (size_t)row * ldc + col0;
                const float rs = ss ? __builtin_amdgcn_rsqf(row_ss(ss, row, fq) * inv_d + eps) : 1.0f;
#pragma unroll
                for (int bj = 0; bj < 2; ++bj)
#pragma unroll
                    for (int n = 0; n < 2; ++n) *(f32x4*)(rowp + bj * HALF + n * 16) = acc[ai][bj][m][n] * rs; }
    }
};
struct EpiScaleBf16 {
    static constexpr bool PERM = true, AFTER_DRAIN = false;
    bf16_t* O; int ldo; const float* ss; float inv_d, eps;
    __device__ __forceinline__ void operator()(const f32x4 (&acc)[2][2][4][2], const Unit& u, int wr, int wc, int fr, int fq) const {
        const int row0 = u.pm * BM + wr * 64 + fr, col0 = u.pn * BM + wc * 32 + 8 * fq;
#pragma unroll
        for (int ai = 0; ai < 2; ++ai)
#pragma unroll
            for (int m = 0; m < 4; ++m) { const int row = row0 + ai * HALF + m * 16; const float rs = __builtin_amdgcn_rsqf(row_ss(ss, row, fq) * inv_d + eps);
#pragma unroll
                for (int bj = 0; bj < 2; ++bj) { const f32x4 v0 = acc[ai][bj][m][0] * rs, v1 = acc[ai][bj][m][1] * rs;
                    u32x4 w; w.x = cvt_pk_bf16(v0[0], v0[1]); w.y = cvt_pk_bf16(v0[2], v0[3]); w.z = cvt_pk_bf16(v1[0], v1[1]); w.w = cvt_pk_bf16(v1[2], v1[3]);
                    *(u32x4*)(O + (size_t)row * ldo + col0 + bj * HALF) = w; } }
    }
};
struct EpiSwiGLU {
    static constexpr bool PERM = true, AFTER_DRAIN = false;
    bf16_t* O; int ldo; const float* ss; float inv_d, eps; int nai;
    __device__ __forceinline__ void operator()(const f32x4 (&acc)[2][2][4][2], const Unit& u, int wr, int wc, int fr, int fq) const {
        const int row0 = u.pm * BM + u.ah * HALF + wr * 64 + fr, col0 = u.pn * HALF + wc * 32 + 8 * fq;
#pragma unroll
        for (int ai = 0; ai < 2; ++ai) { if (ai >= nai) break;
#pragma unroll
            for (int m = 0; m < 4; ++m) { const int row = row0 + ai * HALF + m * 16;
                const float rs = __builtin_amdgcn_rsqf(row_ss(ss, row, fq) * inv_d + eps);
                float o[8];
#pragma unroll
                for (int n = 0; n < 2; ++n)
#pragma unroll
                    for (int j = 0; j < 4; ++j) { const float gv = acc[ai][0][m][n][j] * rs, uv = acc[ai][1][m][n][j] * rs; o[n * 4 + j] = gv * uv * __builtin_amdgcn_rcpf(1.0f + __expf(-gv)); }
                u32x4 w; w.x = cvt_pk_bf16(o[0], o[1]); w.y = cvt_pk_bf16(o[2], o[3]); w.z = cvt_pk_bf16(o[4], o[5]); w.w = cvt_pk_bf16(o[6], o[7]);
                *(u32x4*)(O + (size_t)row * ldo + col0) = w; } }
    }
};
__device__ __forceinline__ float bflo(unsigned w) { return __builtin_bit_cast(float, w << 16); }
__device__ __forceinline__ float bfhi(unsigned w) { return __builtin_bit_cast(float, w & 0xffff0000u); }
struct EpiResidual {
    static constexpr bool PERM = true, AFTER_DRAIN = false;
    bf16_t* HL; bf16_t* HB; float* ss_out; float* out; int out_rows; float scale;
    __device__ __forceinline__ void operator()(const f32x4 (&acc)[2][2][4][2], const Unit& u, int wr, int wc, int fr, int fq) const {
        const int row0 = u.pm * BM + wr * 64 + fr, col0 = u.pn * BM + wc * 32 + 8 * fq;
#pragma unroll
        for (int ai = 0; ai < 2; ++ai)
#pragma unroll
            for (int m = 0; m < 4; ++m) { const int row = row0 + ai * HALF + m * 16; float sq = 0.f;
#pragma unroll
                for (int bj = 0; bj < 2; ++bj) { const size_t off = (size_t)row * 2048 + col0 + bj * HALF;
                    const u32x4 hi = *(const u32x4*)(HB + off), lo = *(const u32x4*)(HL + off);
                    f32x4 h0 = (f32x4){bflo(hi.x) + bflo(lo.x), bfhi(hi.x) + bfhi(lo.x), bflo(hi.y) + bflo(lo.y), bfhi(hi.y) + bfhi(lo.y)};
                    f32x4 h1 = (f32x4){bflo(hi.z) + bflo(lo.z), bfhi(hi.z) + bfhi(lo.z), bflo(hi.w) + bflo(lo.w), bfhi(hi.w) + bfhi(lo.w)};
                    h0 = h0 + acc[ai][bj][m][0] * scale; h1 = h1 + acc[ai][bj][m][1] * scale;
                    if (out && row < out_rows) { *(f32x4*)(out + off) = h0; *(f32x4*)(out + off + 4) = h1; }
                    u32x4 w; w.x = cvt_pk_bf16(h0[0], h0[1]); w.y = cvt_pk_bf16(h0[2], h0[3]); w.z = cvt_pk_bf16(h1[0], h1[1]); w.w = cvt_pk_bf16(h1[2], h1[3]);
                    u32x4 l2; l2.x = cvt_pk_bf16(h0[0] - bflo(w.x), h0[1] - bfhi(w.x)); l2.y = cvt_pk_bf16(h0[2] - bflo(w.y), h0[3] - bfhi(w.y)); l2.z = cvt_pk_bf16(h1[0] - bflo(w.z), h1[1] - bfhi(w.z)); l2.w = cvt_pk_bf16(h1[2] - bflo(w.w), h1[3] - bfhi(w.w));
                    *(u32x4*)(HB + off) = w; *(u32x4*)(HL + off) = l2;
                    sq += (h0[0] * h0[0] + h0[1] * h0[1]) + (h0[2] * h0[2] + h0[3] * h0[3]) + (h1[0] * h1[0] + h1[1] * h1[1]) + (h1[2] * h1[2] + h1[3] * h1[3]); }
                sq += __shfl_xor(sq, 16); sq += __shfl_xor(sq, 32);
                if (fq == 0 && ss_out) __hip_atomic_fetch_add(ss_out + (size_t)row * 32 + u.pn * 4 + wc, sq, __ATOMIC_RELAXED, __HIP_MEMORY_SCOPE_AGENT); }
    }
};
}
#define XB_TMO      128
#define XB_XCNT(j)  (256  + 64 * (j))
#define XB_XSUB(j)  (1280 + 64 * (j))
#define XB_XGEN(j)  (2304 + 64 * (j))
#define XB_TOP      3328
#define XB_TOPGEN   3392
#define XCD_BAR_WORDS 3456
#define XB_SPIN_CAP (1u << 18)

__device__ __forceinline__ unsigned xb_ld(unsigned* p)              { return __hip_atomic_load(p, __ATOMIC_RELAXED, __HIP_MEMORY_SCOPE_AGENT); }
__device__ __forceinline__ unsigned xb_add(unsigned* p, unsigned v) { return __hip_atomic_fetch_add(p, v, __ATOMIC_RELAXED, __HIP_MEMORY_SCOPE_AGENT); }
__device__ __forceinline__ unsigned xb_xcc_id() { return (unsigned)__builtin_amdgcn_s_getreg((3 << 11) | 20) & 0xFu; }
#define XB_SPIN(cond, bar) do { unsigned _sp = 0; while (cond) { __builtin_amdgcn_s_sleep(1); \
    if ((++_sp & 255u) == 0u) { if (xb_ld(&(bar)[XB_TMO])) break; if (_sp > XB_SPIN_CAP) { atomicAdd(&(bar)[XB_TMO], 1u); break; } } } } while (0)

struct XcdBarrier {
    unsigned* bar; unsigned x;
    volatile LAS unsigned* st;
};

__device__ __forceinline__ XcdBarrier xcd_barrier_post(unsigned* bar, volatile LAS unsigned* st, int wv) {
    XcdBarrier b; b.bar = bar; b.x = xb_xcc_id(); b.st = st;
    if ((wv == 0 && lane_id() == 0)) (void)xb_add(&bar[XB_XCNT(b.x)], 1u);
    return b;
}
__device__ __forceinline__ void xcd_barrier_complete(unsigned* bar, unsigned x, unsigned& nloc, unsigned& nx) {
    const unsigned G = gridDim.x * gridDim.y * gridDim.z;
    unsigned sum, cnt, mine, sp = 0u;
    for (;;) {
        sum = 0u; cnt = 0u; mine = 0u;
#pragma unroll
        for (unsigned j = 0; j < 16; ++j) { const unsigned c = xb_ld(&bar[XB_XCNT(j)]); sum += c; cnt += (c > 0u) ? 1u : 0u; mine = (j == x) ? c : mine; }
        if (sum == G) break;
        __builtin_amdgcn_s_sleep(1);
        if ((++sp & 255u) == 0u) { if (xb_ld(&bar[XB_TMO])) break; if (sp > XB_SPIN_CAP) { atomicAdd(&bar[XB_TMO], 1u); break; } }
    }
    nloc = mine > 0u ? mine : 1u; nx = cnt > 0u ? cnt : 1u;
}

__device__ __forceinline__ void xcd_barrier(const XcdBarrier& b, int wv) {
    asm volatile("s_waitcnt vmcnt(0)" ::: "memory");
    __syncthreads();
    if ((wv == 0 && lane_id() == 0)) {
        unsigned* bar = b.bar;
        __builtin_amdgcn_s_waitcnt(0);
        unsigned nloc = b.st[0], nx = b.st[1];
        if (nloc == 0u) { xcd_barrier_complete(bar, b.x, nloc, nx); b.st[0] = nloc; b.st[1] = nx; }
        const unsigned old = xb_add(&bar[XB_XSUB(b.x)], 1u);
        const unsigned gen = old / nloc;
        if (old + 1u == (gen + 1u) * nloc) {
            __builtin_amdgcn_fence(__ATOMIC_RELEASE, "agent");
            asm volatile("s_waitcnt vmcnt(0)" ::: "memory");
            const unsigned og = xb_add(&bar[XB_TOP], 1u);
            const unsigned tg = og / nx;
            if (og + 1u == (tg + 1u) * nx) xb_add(&bar[XB_TOPGEN], 1u);
            else XB_SPIN(xb_ld(&bar[XB_TOPGEN]) == tg, bar);
            __builtin_amdgcn_fence(__ATOMIC_ACQUIRE, "agent");
            xb_add(&bar[XB_XGEN(b.x)], 1u);
            asm volatile("s_waitcnt vmcnt(0)" ::: "memory");
        } else {
            XB_SPIN(xb_ld(&bar[XB_XGEN(b.x)]) == gen, bar);
            __builtin_amdgcn_fence(__ATOMIC_ACQUIRE, "agent");
            asm volatile("s_waitcnt vmcnt(0)" ::: "memory");
        }
    }
    __syncthreads();
}

struct P { const float* in[36]; float* out; unsigned char* ws; int ph_lo, ph_hi; };
enum { I_X = 0, I_META, I_F1N, I_F1G, I_F1U, I_F1D, I_MIXN, I_WIN, I_WOUT, I_QN, I_WQ, I_KVN, I_WKV, I_QKNQ, I_QKNK, I_CONVW, I_CONVB, I_DTB, I_ALOG, I_SSDD, I_SSDN, I_RETN,
       I_MU, I_W0, I_W2, I_A0, I_A2, I_G2, I_KK, I_KA, I_RK, I_LN, I_F2N, I_F2G, I_F2U, I_F2D };
#define CAS __attribute__((address_space(4)))
typedef const CAS P* KPtr;
struct Ctx { LAS unsigned char* lds; unsigned char* ws; KPtr kp; int tid, lane, wave, G, bid; };
__device__ __forceinline__ Ctx ctx_make(LAS unsigned char* lds, int wv) {
    Ctx F; KPtr kp = (KPtr)__builtin_amdgcn_kernarg_segment_ptr(); asm volatile("" : "+s"(kp)); int t = wv * 64 + lane_id(); asm volatile("" : "+v"(t));
    F.lds = lds; F.kp = kp; F.ws = kp->ws; F.tid = t; F.lane = t & 63; F.wave = __builtin_amdgcn_readfirstlane(t >> 6); F.G = gridDim.x; F.bid = blockIdx.x; return F;
}


__device__ __forceinline__ int queue_next(const Ctx& F, unsigned* ctr) {
    volatile LAS unsigned* slot = (volatile LAS unsigned*)(F.lds + LDSCTL_OFF + 64);
    __syncthreads();
    if (F.tid == 0) *slot = __hip_atomic_fetch_add(ctr, 1u, __ATOMIC_RELAXED, __HIP_MEMORY_SCOPE_AGENT);
    __syncthreads();
    return (int)*slot;
}
__device__ __forceinline__ f32x16 zero16() { f32x16 z;
#pragma unroll
    for (int i = 0; i < 16; ++i) z[i] = 0.f; return z; }
__device__ __forceinline__ void mma32(f32x16& acc, const LAS float* Ap, int sAi, int sAk, const LAS float* Bp, int sBk, int sBj, int K, int lane) {
    const int r = lane & 31, hh = lane >> 5;
    const LAS float* a = Ap + r * sAi + hh * sAk; const LAS float* b = Bp + hh * sBk + r * sBj;
#pragma unroll 4
    for (int k = 0; k < K; k += 2) acc = __builtin_amdgcn_mfma_f32_32x32x2f32(a[k * sAk], b[k * sBk], acc, 0, 0, 0);
}
__device__ __forceinline__ void mma32bf(f32x16& acc, const LAS float* Ap, int sAi, const LAS float* Bp, int sBj, int K, int lane) {
    const int r = lane & 31, hh = lane >> 5; const LAS float* a = Ap + r * sAi + 8 * hh; const LAS float* b = Bp + r * sBj + 8 * hh;
#pragma unroll 2
    for (int k = 0; k < K; k += 16) { const f32x4 a0 = *(const LAS f32x4*)(a + k), a1 = *(const LAS f32x4*)(a + k + 4), b0 = *(const LAS f32x4*)(b + k), b1 = *(const LAS f32x4*)(b + k + 4);
        v4u aw, bw; aw.x = cvtpk(a0[0], a0[1]); aw.y = cvtpk(a0[2], a0[3]); aw.z = cvtpk(a1[0], a1[1]); aw.w = cvtpk(a1[2], a1[3]); bw.x = cvtpk(b0[0], b0[1]); bw.y = cvtpk(b0[2], b0[3]); bw.z = cvtpk(b1[0], b1[1]); bw.w = cvtpk(b1[2], b1[3]);
        acc = __builtin_amdgcn_mfma_f32_32x32x16_bf16(__builtin_bit_cast(bf16x8, aw), __builtin_bit_cast(bf16x8, bw), acc, 0, 0, 0); }
}
__device__ __forceinline__ int rreg(int reg, int lane) { return (reg & 3) + 8 * (reg >> 2) + 4 * (lane >> 5); }

struct TileD { const float* src; const float* gain; bf16* dst; int srcN, valid, ldd; };
__device__ __forceinline__ void cvt_load(const TileD& t, f32x4 (&v)[16], float (&g)[8], int lane) {
    const int c4 = lane & 15, r0 = lane >> 4, c8 = lane & 7; const float* p = t.src + (size_t)r0 * t.srcN + 4 * c4; const size_t st = (size_t)4 * t.srcN;
#pragma unroll
    for (int i = 0; i < 16; ++i) { v[i] = (4 * c4 < t.valid) ? *(const f32x4*)p : (f32x4){0.f, 0.f, 0.f, 0.f}; p += st; }
#pragma unroll
    for (int e = 0; e < 8; ++e) g[e] = t.gain ? t.gain[8 * c8 + e] : 1.0f;
}
__device__ __forceinline__ void cvt_store(const TileD& t, const f32x4 (&v)[16], const float (&g)[8], LAS float* scr, int lane) {
    const int c4 = lane & 15, r0 = lane >> 4;
#pragma unroll
    for (int i = 0; i < 16; ++i) { const int kk = r0 + 4 * i; LAS float* d = scr + kk * 65 + 4 * c4; d[0] = v[i][0]; d[1] = v[i][1]; d[2] = v[i][2]; d[3] = v[i][3]; }
    LDS_WAIT(); asm volatile("" ::: "memory");
    const int c8 = lane & 7;
#pragma unroll
    for (int j = 0; j < 8; ++j) { const int n = (lane >> 3) + 8 * j; const LAS float* s = scr + (8 * c8) * 65 + n;
        v4u o; o.x = pk2(s[0] * g[0], s[65] * g[1]); o.y = pk2(s[130] * g[2], s[195] * g[3]); o.z = pk2(s[260] * g[4], s[325] * g[5]); o.w = pk2(s[390] * g[6], s[455] * g[7]);
        *(v4u*)(t.dst + (size_t)n * t.ldd + 8 * c8) = o; }
    LDS_WAIT(); asm volatile("" ::: "memory");
}
constexpr int IT_GU = 2 * 32 * 176, IT_D = 2 * 88 * 32, IT_IN = 32 * 84, IT_OUT = 32 * 32, IT_MLA = 8 * 28, IT_ALL = IT_GU + IT_D + IT_IN + IT_OUT + IT_MLA;
__device__ __forceinline__ TileD tile_desc(const Ctx& F, int l, int it) {
    bf16* WGU = (bf16*)(F.ws + O_WGU); bf16* WD = (bf16*)(F.ws + O_WD); bf16* WIN = (bf16*)(F.ws + O_WIN); bf16* WOUT = (bf16*)(F.ws + O_WOUT); bf16* WMLA = (bf16*)(F.ws + O_WMLA);
    TileD t; int r = it;
    if (r < IT_GU) { const int which = r / 5632, f = 2 * l + which, q = r % 5632, kb = q / 176, nb = q % 176, n0 = 64 * nb, pn = n0 >> 8, within = n0 & 255, isup = within >= 128, f0 = 128 * pn + (within & 127);
        t.src = (which ? (isup ? F.kp->in[I_F2U] : F.kp->in[I_F2G]) : (isup ? F.kp->in[I_F1U] : F.kp->in[I_F1G])) + (size_t)l * D * DFF + (size_t)(64 * kb) * DFF + f0; t.srcN = DFF;
        t.gain = (which ? F.kp->in[I_F2N] : F.kp->in[I_F1N]) + l * D + 64 * kb; t.valid = 64; t.dst = WGU + (size_t)f * 11264 * 2048 + (size_t)n0 * 2048 + 64 * kb; t.ldd = 2048; return t; }
    r -= IT_GU;
    if (r < IT_D) { const int which = r / 2816, f = 2 * l + which, q = r % 2816, kb = q / 32, nb = q % 32;
        t.src = (which ? F.kp->in[I_F2D] : F.kp->in[I_F1D]) + (size_t)l * DFF * D + (size_t)(64 * kb) * D + 64 * nb; t.srcN = D; t.gain = nullptr; t.valid = 64;
        t.dst = WD + (size_t)f * 2048 * 5632 + (size_t)(64 * nb) * 5632 + 64 * kb; t.ldd = 5632; return t; }
    r -= IT_D;
    if (r < IT_IN) { const int q = r, kb = q / 84, nb = q % 84, n0 = 64 * nb; int valid = NIN - n0; valid = valid < 0 ? 0 : (valid > 64 ? 64 : valid);
        t.src = F.kp->in[I_WIN] + (size_t)l * D * NIN + (size_t)(64 * kb) * NIN + n0; t.srcN = NIN; t.gain = F.kp->in[I_MIXN] + l * D + 64 * kb; t.valid = valid;
        t.dst = WIN + (size_t)l * NINP * D + (size_t)n0 * D + 64 * kb; t.ldd = D; return t; }
    r -= IT_IN;
    if (r < IT_OUT) { const int q = r, kb = q / 32, nb = q % 32;
        t.src = F.kp->in[I_WOUT] + (size_t)l * D * D + (size_t)(64 * kb) * D + 64 * nb; t.srcN = D; t.gain = nullptr; t.valid = 64; t.dst = WOUT + (size_t)l * D * D + (size_t)(64 * nb) * D + 64 * kb; t.ldd = D; return t; }
    r -= IT_OUT;
    { const int q = r, kb = q / 28, nb = q % 28, n0 = 64 * nb, k0 = 64 * kb;
        if (n0 < 768) { t.valid = k0 < 384 ? 64 : 0; t.src = F.kp->in[I_WQ] + (size_t)l * 384 * 768 + (size_t)(k0 < 384 ? k0 : 0) * 768 + n0; t.srcN = 768; }
        else { t.valid = k0 >= 384 ? 64 : 0; t.src = F.kp->in[I_WKV] + (size_t)l * 128 * 1024 + (size_t)(k0 >= 384 ? k0 - 384 : 0) * 1024 + (n0 - 768); t.srcN = 1024; }
        t.gain = nullptr; t.dst = WMLA + (size_t)l * MLAN * 512 + (size_t)n0 * 512 + k0; t.ldd = 512; return t; }
}
__device__ __forceinline__ void convert_layer(const Ctx& F, int L, int gw, int NGW) {
    LAS float* scr = (LAS float*)(F.lds + F.wave * 17408);
    const int lane = F.lane;
    int it = gw; if (it >= IT_ALL) return;
    f32x4 va[16], vb[16]; float ga[8], gb[8]; TileD ta = tile_desc(F, L, it), tb = ta;
    cvt_load(ta, va, ga, lane);
    for (;;) {
        int nx = it + NGW; if (nx < IT_ALL) { tb = tile_desc(F, L, nx); cvt_load(tb, vb, gb, lane); }
        cvt_store(ta, va, ga, scr, lane);
        if (nx >= IT_ALL) break; it = nx;
        nx = it + NGW; if (nx < IT_ALL) { ta = tile_desc(F, L, nx); cvt_load(ta, va, ga, lane); }
        cvt_store(tb, vb, gb, scr, lane);
        if (nx >= IT_ALL) break; it = nx;
    }
}
__device__ __forceinline__ void p0_prologue(const Ctx& F, int cvt_only) {
    const int gw = F.bid * NWAVES + F.wave, NGW = F.G * NWAVES, lane = F.lane;
    convert_layer(F, 0, gw, NGW);
    if (cvt_only) return;
    bf16* HL = (bf16*)(F.ws + O_H); bf16* HB = (bf16*)(F.ws + O_HB); float* SS = (float*)(F.ws + O_SS); bf16* Y = (bf16*)(F.ws + O_Y); f32x2* ROPE = (f32x2*)(F.ws + O_ROPE);
    for (int row = gw; row < MP; row += NGW) {
        const float* src = row < SEQ ? F.kp->in[I_X] + (size_t)row * D : F.kp->in[I_META] + (size_t)(row - SEQ) * D;
        float sq = 0.f;
#pragma unroll
        for (int j = 0; j < 8; ++j) { f32x4 v = (f32x4){0.f, 0.f, 0.f, 0.f}; if (row < T) v = *(const f32x4*)(src + 256 * j + 4 * lane);
            v2u w; w.x = cvtpk(v[0], v[1]); w.y = cvtpk(v[2], v[3]); *(v2u*)(HB + (size_t)row * D + 256 * j + 4 * lane) = w;
            v2u lw; lw.x = cvtpk(v[0] - pg8::bflo(w.x), v[1] - pg8::bfhi(w.x)); lw.y = cvtpk(v[2] - pg8::bflo(w.y), v[3] - pg8::bfhi(w.y)); *(v2u*)(HL + (size_t)row * D + 256 * j + 4 * lane) = lw;
            sq += (v[0] * v[0] + v[1] * v[1]) + (v[2] * v[2] + v[3] * v[3]); }
        sq = wave_sum(sq); if (lane == 0) __hip_atomic_fetch_add(SS + (size_t)row * 32, sq, __ATOMIC_RELAXED, __HIP_MEMORY_SCOPE_AGENT);
#ifdef PROBE_ZERO_Y
        if (true) {
#else
        if (row >= T) {
#endif
#pragma unroll
            for (int j = 0; j < 4; ++j) *(v4u*)(Y + (size_t)row * D + 512 * j + 8 * lane) = (v4u){0u, 0u, 0u, 0u}; }
#ifdef PROBE_ZERO_Y
        if (row < T && lane < 32) { const float inv = powf(10000.0f, -(float)lane / 32.0f); const float ang = (float)seq_of_row(row) * inv; float sn, cs; sincosf(ang, &sn, &cs); ROPE[row * 32 + lane] = (f32x2){cs, sn}; }
#else
        else if (lane < 32) { const float inv = powf(10000.0f, -(float)lane / 32.0f); const float ang = (float)seq_of_row(row) * inv; float sn, cs; sincosf(ang, &sn, &cs); ROPE[row * 32 + lane] = (f32x2){cs, sn}; }
#endif
    }
}

__device__ __forceinline__ void m1_unit(const Ctx& F, int l, int r0, int r1, int grp) {
    const int lane = F.lane, tid = F.tid;
    const float* U = (const float*)(F.ws + O_U);
    if (r0 < r1) { bf16* AM = (bf16*)(F.ws + O_AMLA); const float* qn = F.kp->in[I_QN] + l * 384; const float* kvn = F.kp->in[I_KVN] + l * 128;
      const float* gp = lane < 48 ? qn + 8 * lane : kvn + 8 * (lane - 48); const f32x4 g0 = *(const f32x4*)gp, g1 = *(const f32x4*)(gp + 4);
      f32x4 a4[4], b4[4];
#pragma unroll
      for (int i = 0; i < 4; ++i) { const int row = r0 + F.wave + 8 * i; const float* ur = U + (size_t)(row < r1 ? row : r0) * NINP + 8 * lane; a4[i] = *(const f32x4*)ur; b4[i] = *(const f32x4*)(ur + 4); }
#pragma unroll
      for (int i = 0; i < 4; ++i) { const int row = r0 + F.wave + 8 * i; const f32x4 a = a4[i], b = b4[i];
        const float sq = (a[0] * a[0] + a[1] * a[1]) + (a[2] * a[2] + a[3] * a[3]) + (b[0] * b[0] + b[1] * b[1]) + (b[2] * b[2] + b[3] * b[3]);
        const float sq_q = wave_sum(lane < 48 ? sq : 0.f), sq_kv = wave_sum(lane >= 48 ? sq : 0.f);
        const float rs = lane < 48 ? 1.0f / sqrtf(sq_q * (1.0f / 384.0f) + EPS) : 1.0f / sqrtf(sq_kv * (1.0f / 128.0f) + EPS);
        v4u w; w.x = pk2(a[0] * rs * g0[0], a[1] * rs * g0[1]); w.y = pk2(a[2] * rs * g0[2], a[3] * rs * g0[3]); w.z = pk2(b[0] * rs * g1[0], b[1] * rs * g1[1]); w.w = pk2(b[2] * rs * g1[2], b[3] * rs * g1[3]);
        if (row < r1) *(v4u*)(AM + (size_t)row * 512 + 8 * lane) = w; } }
    if (r0 < r1) { float* RQK = (float*)(F.ws + O_RQK); const f32x2* ROPE = (const f32x2*)(F.ws + O_ROPE);
      f32x2 cs[4][4]; float x1[4][4], x2[4][4];
#pragma unroll
      for (int i = 0; i < 4; ++i) { const int row = r0 + F.wave + 8 * i, rc = row < r1 ? row : r0;
#pragma unroll
        for (int j = 0; j < 4; ++j) { const int idx = lane + 64 * j, qk = idx >> 7, hh = (idx >> 5) & 3, i5 = idx & 31; cs[i][j] = ROPE[rc * 32 + i5];
            x1[i][j] = U[(size_t)rc * NINP + U_RET + qk * 256 + hh * 64 + i5]; x2[i][j] = U[(size_t)rc * NINP + U_RET + qk * 256 + hh * 64 + 32 + i5]; } }
#pragma unroll
      for (int i = 0; i < 4; ++i) { const int row = r0 + F.wave + 8 * i; if (row < r1) {
#pragma unroll
        for (int j = 0; j < 4; ++j) { const int idx = lane + 64 * j, qk = idx >> 7, hh = (idx >> 5) & 3, i5 = idx & 31; const float sc = qk ? 0.125f : 1.0f;
            RQK[(size_t)row * 512 + qk * 256 + hh * 64 + i5] = (x1[i][j] * cs[i][j].x - x2[i][j] * cs[i][j].y) * sc; RQK[(size_t)row * 512 + qk * 256 + hh * 64 + 32 + i5] = (x1[i][j] * cs[i][j].y + x2[i][j] * cs[i][j].x) * sc; } } } }
    if (r0 < r1) { float* XBC = (float*)(F.ws + O_XBC); float* DT = (float*)(F.ws + O_DT); float* LA = (float*)(F.ws + O_LA);
      const float* cw = F.kp->in[I_CONVW] + l * 4096; const float* cb = F.kp->in[I_CONVB] + l * 1024;
      int rw[4], p1[4], p2[4], p3[4]; float dtr[4];
#pragma unroll
      for (int i = 0; i < 4; ++i) { const int row = r0 + F.wave + 8 * i; rw[i] = row < r1 ? row : r0; p1[i] = prev_row(rw[i]); p2[i] = p1[i] >= 0 ? prev_row(p1[i]) : -1; p3[i] = p2[i] >= 0 ? prev_row(p2[i]) : -1;
          dtr[i] = U[(size_t)rw[i] * NINP + U_SSD + 1536 + (lane & 7)]; }
#pragma unroll 1
      for (int j = 0; j < 4; ++j) { const int ch = 256 * j + 4 * lane; const size_t uo = U_SSD + 512 + ch; const f32x4 z4 = (f32x4){0.f, 0.f, 0.f, 0.f};
          const f32x4 wb = *(const f32x4*)(cb + ch), w0 = *(const f32x4*)(cw + ch), w1 = *(const f32x4*)(cw + 1024 + ch), w2 = *(const f32x4*)(cw + 2048 + ch), w3 = *(const f32x4*)(cw + 3072 + ch);
          f32x4 x0[4], x1[4], x2[4], x3[4];
#pragma unroll
          for (int i = 0; i < 4; ++i) { x3[i] = *(const f32x4*)(U + (size_t)rw[i] * NINP + uo); x2[i] = p1[i] >= 0 ? *(const f32x4*)(U + (size_t)p1[i] * NINP + uo) : z4;
              x1[i] = p2[i] >= 0 ? *(const f32x4*)(U + (size_t)p2[i] * NINP + uo) : z4; x0[i] = p3[i] >= 0 ? *(const f32x4*)(U + (size_t)p3[i] * NINP + uo) : z4; }
#pragma unroll
          for (int i = 0; i < 4; ++i) { f32x4 o = wb + w0 * x0[i] + w1 * x1[i] + w2 * x2[i] + w3 * x3[i];
              o[0] = siluf_(o[0]); o[1] = siluf_(o[1]); o[2] = siluf_(o[2]); o[3] = siluf_(o[3]);
              if (r0 + F.wave + 8 * i < r1) *(f32x4*)(XBC + (size_t)rw[i] * 1024 + ch) = o; } }
#pragma unroll
      for (int i = 0; i < 4; ++i) if (lane < 8 && r0 + F.wave + 8 * i < r1) { const float dt = softplusf_(dtr[i] + F.kp->in[I_DTB][l * 8 + lane]); DT[rw[i] * 8 + lane] = dt; LA[rw[i] * 8 + lane] = -expf(F.kp->in[I_ALOG][l * 8 + lane]) * dt; } }
    if (grp >= 0) { LAS float* xl = (LAS float*)F.lds; const int hd = F.wave, col = lane & 31;
      float* RW = (float*)(F.ws + O_RW); const size_t AS = (size_t)MP * 512; float* RBON = (float*)(F.ws + O_RBON);
      const float* MU = F.kp->in[I_MU] + l * 1664; const float* W2 = F.kp->in[I_W2] + l * 32 * 512; const float* A2 = F.kp->in[I_A2] + l * 32 * 512; const float* G2 = F.kp->in[I_G2] + l * 64 * 512;
      const int r0 = 32 * grp;
      __syncthreads();
#pragma unroll
      for (int j = 0; j < 8; ++j) { const int idx = tid + 512 * j, tk = idx >> 7, cl = idx & 127, row = r0 + tk; float xs = 0.f;
          if (row < T) { const int pr = prev_row(row); const size_t uc = U_RWKV + 1536 + cl; const float x = U[(size_t)row * NINP + uc], xp = pr >= 0 ? U[(size_t)pr * NINP + uc] : 0.f; xs = x + (xp - x) * MU[1536 + cl];
              if (cl < 32) xs = tanhf(xs); else if (cl >= 64) xs = sigmoidf_(xs); }
          xl[tk * 132 + cl] = xs; }
      __syncthreads();
      float w0c[2], a0c[2], kkc[2], kac[2], rkc[2], muR[2], muK[2], muV[2];
#pragma unroll
      for (int ct = 0; ct < 2; ++ct) { const int ch = 64 * hd + 32 * ct + col; w0c[ct] = F.kp->in[I_W0][l * 512 + ch]; a0c[ct] = F.kp->in[I_A0][l * 512 + ch]; kkc[ct] = F.kp->in[I_KK][l * 512 + ch]; kac[ct] = F.kp->in[I_KA][l * 512 + ch]; rkc[ct] = F.kp->in[I_RK][l * 512 + ch];
          muR[ct] = MU[ch]; muK[ct] = MU[512 + ch]; muV[ct] = MU[1024 + ch]; }
      { constexpr int tb = 0;
          f32x16 aw[2], aa[2], ag[2];
#pragma unroll
          for (int ct = 0; ct < 2; ++ct) { aw[ct] = zero16(); aa[ct] = zero16(); ag[ct] = zero16(); }
          const LAS float* xa = xl + (32 * tb + col) * 132 + (lane >> 5); const int chb = 64 * hd + col, kh = lane >> 5;
#define M1_LORA(ACC, WM, XO, NB) do { _Pragma("unroll") for (int hb_ = 0; hb_ < (NB); ++hb_) { float bq_[16][2], xq_[16]; \
              _Pragma("unroll") for (int t_ = 0; t_ < 16; ++t_) { const float* wb_ = (WM) + 1024 * (16 * hb_ + t_); bq_[t_][0] = wb_[wvo]; bq_[t_][1] = wb_[wvo + 32]; xq_[t_] = xa[(XO) + 2 * (16 * hb_ + t_)]; } \
              _Pragma("unroll") for (int t_ = 0; t_ < 16; ++t_) { ACC[0] = __builtin_amdgcn_mfma_f32_32x32x2f32(xq_[t_], bq_[t_][0], ACC[0], 0, 0, 0); ACC[1] = __builtin_amdgcn_mfma_f32_32x32x2f32(xq_[t_], bq_[t_][1], ACC[1], 0, 0, 0); } } } while (0)
          const unsigned wvo = (unsigned)(kh * 512 + chb);
          M1_LORA(aw, W2, 0, 1); M1_LORA(aa, A2, 32, 1); M1_LORA(ag, G2, 64, 2);
#undef M1_LORA
#pragma unroll
          for (int rb = 0; rb < 16; rb += 4) {
              float uc[4][2][3], upv[4][2][3];
#pragma unroll
              for (int q = 0; q < 4; ++q) { const int row = r0 + 32 * tb + rreg(rb + q, lane), rc = row < T ? row : 0, pr = prev_row(rc);
#pragma unroll
                  for (int ct = 0; ct < 2; ++ct) { const float* ur = U + (size_t)rc * NINP + U_RWKV + chb + 32 * ct; const float* up = U + (size_t)(pr >= 0 ? pr : 0) * NINP + U_RWKV + chb + 32 * ct;
                      uc[q][ct][0] = ur[0]; uc[q][ct][1] = ur[512]; uc[q][ct][2] = ur[1024]; upv[q][ct][0] = pr >= 0 ? up[0] : 0.f; upv[q][ct][1] = pr >= 0 ? up[512] : 0.f; upv[q][ct][2] = pr >= 0 ? up[1024] : 0.f; } }
#pragma unroll
              for (int q = 0; q < 4; ++q) { const int reg = rb + q; const int row = r0 + 32 * tb + rreg(reg, lane); const bool ok = row < T;
                  float rr[2], k2[2], vv[2], kk[2], av[2], dec[2]; float nq = 0.f, bq = 0.f;
#pragma unroll
                  for (int ct = 0; ct < 2; ++ct) { float r = uc[q][ct][0], k = uc[q][ct][1], v = uc[q][ct][2];
                      r += (upv[q][ct][0] - r) * muR[ct]; k += (upv[q][ct][1] - k) * muK[ct]; v += (upv[q][ct][2] - v) * muV[ct];
                      float wr = w0c[ct] + aw[ct][reg]; wr = -softplusf_(-wr) - 0.5f; dec[ct] = expf(-expf(wr));
                      av[ct] = sigmoidf_(a0c[ct] + aa[ct][reg]);
                      kk[ct] = k * kkc[ct]; k2[ct] = k * (1.0f + (av[ct] - 1.0f) * kac[ct]); rr[ct] = r; vv[ct] = v;
                      nq += kk[ct] * kk[ct]; bq += r * k2[ct] * rkc[ct]; }
                  nq = sum32(nq, lane); bq = sum32(bq, lane);
                  const float inrm = 1.0f / fmaxf(sqrtf(nq), 1e-12f);
                  if (ok) {
#pragma unroll
                      for (int ct = 0; ct < 2; ++ct) { const size_t o = (size_t)row * 512 + chb + 32 * ct; const float kn = kk[ct] * inrm;
                          RW[o] = rr[ct]; RW[AS + o] = dec[ct]; RW[2 * AS + o] = k2[ct]; RW[3 * AS + o] = vv[ct]; RW[4 * AS + o] = -kn; RW[5 * AS + o] = kn * av[ct]; RW[6 * AS + o] = ag[ct][reg]; }
                      if (col == 0) RBON[row * 8 + hd] = bq; } } }
      } }
}
__device__ __forceinline__ void m1_phase(const Ctx& F, int l, int qi = 1) {
    unsigned* ctr = (unsigned*)(F.ws + O_CTL) + CW_QUEUE + 64 * (4 * l + qi);
    constexpr int NG = (T + 31) / 32, NR = (T + 31) / 32;
    for (;;) { const int u = queue_next(F, ctr); if (u >= NG + NR) break;
        if (u < NG) m1_unit(F, l, 0, 0, u); else { const int r0 = 32 * (u - NG); m1_unit(F, l, r0, r0 + 32 < T ? r0 + 32 : T, -1); } }
}
constexpr int RWC = 64, NRC = (T + RWC - 1) / RWC;
__device__ __forceinline__ void rwkv_chunk_unit(const Ctx& F, int c, int h) {
    LAS float* BH = (LAS float*)F.lds; LAS float* KH = BH + 4160; LAS float* NX = KH + 4160; LAS float* RTT = NX + 4160;
    LAS float* AP = RTT + 4160; LAS float* BZ = AP + 4352; LAS float* Pm = BZ + 4160; LAS float* Qm = Pm + 4160; LAS float* Ge = Qm + 4160; LAS float* segt = Ge + 64;
    const float* RW = (const float*)(F.ws + O_RW); const size_t AS = (size_t)MP * 512; float* MATS = (float*)(F.ws + O_MATS) + (size_t)(c * 8 + h) * 16384;
    int tid = F.tid, w = F.wave; asm volatile("" : "+v"(tid), "+s"(w));
    const int lane = tid & 63, seg = tid >> 6, k = tid & 63;
    __syncthreads();
    TU_B(1); TU_B(2);
    { float p[8];
#pragma unroll
      for (int i = 0; i < 8; ++i) { const int s = RWC * c + 8 * seg + i; const float wv = s < T ? RW[AS + (size_t)row_of_seq(s) * 512 + 64 * h + k] : 1.0f; p[i] = i ? p[i - 1] * wv : wv; }
      segt[seg * 64 + k] = p[7];
      __syncthreads();
      float pre = 1.0f, tot = 1.0f;
#pragma unroll
      for (int q = 0; q < 8; ++q) { const float t = segt[q * 64 + k]; if (q < seg) pre *= t; tot *= t; }
      if (seg == 0) Ge[k] = tot;
#pragma unroll
      for (int i = 0; i < 8; ++i) { const int il = 8 * seg + i, s = RWC * c + il; const float G = pre * p[i], Gm1 = i ? pre * p[i - 1] : pre;
          float nk = 0.f, r = 0.f, b = 0.f, kk = 0.f;
          if (s < T) { const size_t o = (size_t)row_of_seq(s) * 512 + 64 * h + k; r = RW[o]; kk = RW[2 * AS + o]; nk = RW[4 * AS + o]; b = RW[5 * AS + o]; }
          const float ig = 1.0f / G;
          NX[k * 65 + il] = nk * Gm1; RTT[k * 65 + il] = r * G; BH[il * 65 + k] = b * ig; KH[il * 65 + k] = kk * ig; } }
    __syncthreads();
    TU_E(2); TU_B(3);
    { const int prod = w >> 1; const LAS float* Lm = (prod & 1) ? KH : BH; const LAS float* Rm = (prod < 2) ? NX : RTT;
#pragma unroll
      for (int t = 0; t < 2; ++t) { const int tr = w & 1, tc = t; f32x16 acc = zero16();
          mma32(acc, Lm + 32 * tr * 65, 65, 1, Rm + 32 * tc, 65, 1, 64, lane);
#pragma unroll
          for (int r = 0; r < 16; ++r) { const int j = 32 * tr + rreg(r, lane), i = 32 * tc + (lane & 31); const float v = acc[r];
              if (prod == 0) AP[j * 68 + i] = j < i ? v : 0.f; else if (prod == 1) BZ[j * 65 + i] = j < i ? v : 0.f; else if (prod == 2) Pm[j * 65 + i] = j <= i ? v : 0.f; else Qm[j * 65 + i] = j <= i ? v : 0.f; } } }
    __syncthreads();
    TU_E(3); TU_B(4);
    if (w < 2) { LAS float* Yr = (w == 0 ? NX : BZ) + lane * 65;
        for (int ib = 0; ib < 4; ++ib) { float a[16];
#pragma unroll
            for (int ii = 0; ii < 16; ++ii) a[ii] = Yr[16 * ib + ii];
#pragma unroll 4
            for (int j = 0; j < 16 * ib; ++j) { const float y = Yr[j]; const LAS float* ap = AP + j * 68 + 16 * ib;
                const f32x4 a0 = *(const LAS f32x4*)ap, a1 = *(const LAS f32x4*)(ap + 4), a2 = *(const LAS f32x4*)(ap + 8), a3 = *(const LAS f32x4*)(ap + 12);
#pragma unroll
                for (int q = 0; q < 4; ++q) { a[q] += y * a0[q]; a[4 + q] += y * a1[q]; a[8 + q] += y * a2[q]; a[12 + q] += y * a3[q]; } }
#pragma unroll
            for (int ii = 1; ii < 16; ++ii)
#pragma unroll
                for (int jj = 0; jj < ii; ++jj) a[ii] += a[jj] * AP[(16 * ib + jj) * 68 + 16 * ib + ii];
#pragma unroll
            for (int ii = 0; ii < 16; ++ii) Yr[16 * ib + ii] = a[ii]; } }
    __syncthreads();
    TU_E(4); TU_B(5);
    { const int rb = w >> 1;
#pragma unroll
      for (int t = 0; t < 2; ++t) { const int cb = 2 * (w & 1) + t; f32x16 acc = zero16();
          mma32(acc, (rb < 2 ? NX : BZ) + 32 * (rb & 1) * 65, 65, 1, (cb < 2 ? BH : Pm) + 32 * (cb & 1), 65, 1, 64, lane);
          float* dst = MATS + (rb < 2 ? (cb < 2 ? 0 : 8192) : (cb < 2 ? 4096 : 12288));
#pragma unroll
          for (int r = 0; r < 16; ++r) { const int row = 32 * (rb & 1) + rreg(r, lane), col = 32 * (cb & 1) + (lane & 31); float v = acc[r];
              if (rb < 2 && cb < 2) v = (v + (row == col ? 1.0f : 0.0f)) * Ge[col]; else if (rb < 2) v += RTT[row * 65 + col]; else if (cb < 2) v = (v + KH[row * 65 + col]) * Ge[col]; else v += Qm[row * 65 + col];
              dst[row * 64 + col] = v; } } }
    TU_E(5); TU_E(1);
}
template <int SV = 0>
__device__ __forceinline__ void rwkv_state_scan(const Ctx& F, int h, int rg) {
    LAS float* Sx = (LAS float*)F.lds; LAS float* tmp = Sx + 1056; LAS float* ring = tmp + 1024;
    const float* RW = (const float*)(F.ws + O_RW); const size_t AS = (size_t)MP * 512; const float* MATS = (const float*)(F.ws + O_MATS); float* SST8 = (float*)(F.ws + (SV ? O_QKV : O_SSTATE));
    const float* ZERO = (const float*)((const bf16*)(F.ws + O_H) + (size_t)8300 * D);
    const int tid = F.tid, lane = F.lane, w = F.wave, fr = lane & 15, kq = lane >> 4, role = w >> 2, cbk = w & 3;
#define RW_DMA(cn) do { const int cc_ = (cn) < NRC ? (cn) : NRC - 1; const float* mp_ = MATS + (size_t)(cc_ * 8 + h) * 16384; LAS float* sl_ = ring + ((cn) % 3) * 9216; \
        _Pragma("unroll") for (int q_ = 0; q_ < 2; ++q_) { const int ch_ = w + 8 * q_; \
            __builtin_amdgcn_global_load_lds((const unsigned*)(mp_ + ch_ * 256 + lane * 4), (LAS unsigned*)(sl_ + ch_ * 256), 16, 0, 0); \
            __builtin_amdgcn_global_load_lds((const unsigned*)(mp_ + 4096 + ch_ * 256 + lane * 4), (LAS unsigned*)(sl_ + 4096 + ch_ * 256), 16, 0, 0); \
            const int j_ = 4 * ch_ + kq, s_ = RWC * cc_ + j_; const float* vp_ = s_ < T ? RW + 3 * AS + (size_t)row_of_seq(s_) * 512 + 64 * h + 16 * rg + fr : ZERO + fr; \
            __builtin_amdgcn_global_load_lds((const unsigned*)vp_, (LAS unsigned*)(sl_ + 8192 + ch_ * 64), 4, 0, 0); } } while (0)
    __syncthreads();
    for (int i = tid; i < 1056; i += NTHR) Sx[i] = 0.f;
    RW_DMA(0); RW_DMA(1);
    asm volatile("s_waitcnt vmcnt(0)" ::: "memory");
    __syncthreads();
    for (int c = 0; c < NRC; ++c) {
        if (SV != 1) RW_DMA(c + 2);
        { const int idx = 2 * tid, v = idx >> 6, kk = idx & 63; const f32x2 sv = (f32x2){Sx[v * 66 + kk], Sx[v * 66 + kk + 1]}; *(f32x2*)(SST8 + ((size_t)(c * 8 + h) * 64 + 16 * rg + v) * 64 + kk) = sv; }
        const LAS float* sl = ring + (c % 3) * 9216;
        float av[16], bv[16]; f32x4 acc = (f32x4){0.f, 0.f, 0.f, 0.f}, acc2 = acc;
        if (role == 0) { const LAS float* mb = sl + 16 * cbk + fr;
#pragma unroll
            for (int t = 0; t < 16; ++t) { av[t] = Sx[fr * 66 + 4 * t + kq]; bv[t] = mb[(4 * t + kq) * 64]; }
        } else { const LAS float* wb = sl + 4096 + 16 * cbk + fr; const LAS float* vt = sl + 8192 + fr;
#pragma unroll
            for (int t = 0; t < 16; ++t) { av[t] = vt[(4 * t + kq) * 16]; bv[t] = wb[(4 * t + kq) * 64]; } }
#pragma unroll
        for (int t = 0; t < (SV == 2 ? 2 : 16); t += 2) { acc = __builtin_amdgcn_mfma_f32_16x16x4f32(av[t], bv[t], acc, 0, 0, 0); acc2 = __builtin_amdgcn_mfma_f32_16x16x4f32(av[t + 1], bv[t + 1], acc2, 0, 0, 0); }
        acc = acc + acc2;
        if (role != 0) *(LAS f32x4*)(tmp + (cbk * 64 + lane) * 4) = acc;
        LBAR();
        if (role == 0) { acc = acc + *(const LAS f32x4*)(tmp + (cbk * 64 + lane) * 4);
#pragma unroll
            for (int r = 0; r < 4; ++r) Sx[(4 * kq + r) * 66 + 16 * cbk + fr] = acc[r]; }
        if (SV != 1) asm volatile("s_waitcnt vmcnt(8)" ::: "memory");
        LBAR();
    }
    asm volatile("s_waitcnt vmcnt(0)" ::: "memory");
#undef RW_DMA
}
__device__ __forceinline__ void rwkv_out_unit(const Ctx& F, int l, int c, int h) {
    LAS float* S_ = (LAS float*)F.lds; LAS float* E_ = S_ + 4160; LAS float* VT_ = E_ + 4096; LAS float* F_ = VT_ + 4096; LAS float* O_ = F_ + 4096;
    const float* RW = (const float*)(F.ws + O_RW); const size_t AS = (size_t)MP * 512; const float* MATS = (const float*)(F.ws + O_MATS) + (size_t)(c * 8 + h) * 16384;
    const float* SST8 = (const float*)(F.ws + O_SSTATE) + (size_t)(c * 8 + h) * 4096; const float* RBON = (const float*)(F.ws + O_RBON); bf16* Y = (bf16*)(F.ws + O_Y);
    int tid = F.tid, w = F.wave; asm volatile("" : "+v"(tid), "+s"(w)); const int lane = tid & 63;
    const f32x4 z4 = (f32x4){0.f, 0.f, 0.f, 0.f};
    f32x4 sv[2], ev[2], fv[2], tv[2];
#pragma unroll
    for (int q = 0; q < 2; ++q) { const int idx = tid + 512 * q, r = idx >> 4, c4 = idx & 15, s = RWC * c + r;
        sv[q] = *(const f32x4*)(SST8 + r * 64 + 4 * c4); ev[q] = *(const f32x4*)(MATS + 8192 + 4 * idx); fv[q] = *(const f32x4*)(MATS + 12288 + 4 * idx);
        tv[q] = s < T ? *(const f32x4*)(RW + 3 * AS + (size_t)row_of_seq(s) * 512 + 64 * h + 4 * c4) : z4; }
    const int li = tid >> 3, part = tid & 7, ls = RWC * c + li, lrow = ls < T ? row_of_seq(ls) : 0; const size_t lo = (size_t)lrow * 512 + 64 * h + 8 * part;
    f32x4 v0 = z4, v1 = z4, g0 = z4, g1 = z4; float bon = 0.f;
    if (ls < T) { v0 = *(const f32x4*)(RW + 3 * AS + lo); v1 = *(const f32x4*)(RW + 3 * AS + lo + 4); g0 = *(const f32x4*)(RW + 6 * AS + lo); g1 = *(const f32x4*)(RW + 6 * AS + lo + 4); bon = RBON[lrow * 8 + h]; }
    __syncthreads();
#pragma unroll
    for (int q = 0; q < 2; ++q) { const int idx = tid + 512 * q, r = idx >> 4, c4 = idx & 15;
        LAS float* d = S_ + r * 65 + 4 * c4; d[0] = sv[q][0]; d[1] = sv[q][1]; d[2] = sv[q][2]; d[3] = sv[q][3];
        *(LAS f32x4*)(E_ + 4 * idx) = ev[q]; *(LAS f32x4*)(F_ + 4 * idx) = fv[q]; *(LAS f32x4*)(VT_ + r * 64 + 4 * c4) = tv[q]; }
    LBAR();
    const int tr = (w >> 1) & 1, tc = w & 1; f32x16 acc = zero16();
    if (w < 4) mma32(acc, S_ + 32 * tr * 65, 65, 1, E_ + 32 * tc, 64, 1, 64, lane);
    else { mma32(acc, VT_ + 32 * tr, 1, 64, F_ + 32 * tc, 64, 1, 64, lane);
#pragma unroll
        for (int r = 0; r < 16; ++r) O_[(32 * tr + rreg(r, lane)) * 65 + 32 * tc + (lane & 31)] = acc[r]; }
    LBAR();
    if (w < 4) {
#pragma unroll
        for (int r = 0; r < 16; ++r) O_[(32 * tr + rreg(r, lane)) * 65 + 32 * tc + (lane & 31)] += acc[r]; }
    LBAR();
    { float x[8]; float sm = 0.f;
#pragma unroll
      for (int q = 0; q < 8; ++q) { x[q] = O_[(8 * part + q) * 65 + li]; sm += x[q]; }
      sm = sum8(sm);
      const float mu = sm * (1.0f / 64.0f); float vq = 0.f;
#pragma unroll
      for (int q = 0; q < 8; ++q) { const float d = x[q] - mu; vq += d * d; }
      vq = sum8(vq);
      const float rstd = 1.0f / sqrtf(vq * (1.0f / 64.0f) + 64e-5f);
      if (ls < T) { const float* lng = F.kp->in[I_LN] + l * 512 + 64 * h + 8 * part;
          float ov[8];
#pragma unroll
          for (int q = 0; q < 4; ++q) { ov[q] = ((x[q] - mu) * rstd * lng[q] + bon * v0[q]) * g0[q]; ov[4 + q] = ((x[4 + q] - mu) * rstd * lng[4 + q] + bon * v1[q]) * g1[q]; }
          v4u wv; wv.x = cvtpk(ov[0], ov[1]); wv.y = cvtpk(ov[2], ov[3]); wv.z = cvtpk(ov[4], ov[5]); wv.w = cvtpk(ov[6], ov[7]);
          *(v4u*)(Y + (size_t)lrow * D + 1536 + 64 * h + 8 * part) = wv; } }
}
__device__ __forceinline__ void ssd_states_unit(const Ctx& F, int c, int h) {
    LAS float* Bm = (LAS float*)F.lds; LAS float* XD = Bm + 16384; LAS float* csl = XD + 8192; LAS float* lal = csl + 128; LAS float* dtl = lal + 128;
    const float* XBC = (const float*)(F.ws + O_XBC); const float* DT = (const float*)(F.ws + O_DT); const float* LA = (const float*)(F.ws + O_LA);
    float* SST = (float*)(F.ws + O_SST); float* SDEC = (float*)(F.ws + O_SDEC);
    const int tid = F.tid, lane = F.lane, w = F.wave, g = h >> 2;
    __syncthreads();
    TU_B(6);
    if (tid < 128) { const int row = crow(c, tid); lal[tid] = row >= 0 ? LA[row * 8 + h] : 0.f; dtl[tid] = row >= 0 ? DT[row * 8 + h] : 0.f; }
    __syncthreads();
    if (tid < 64) { const float e0 = lal[2 * tid], e1 = lal[2 * tid + 1]; float s = e0 + e1;
#pragma unroll
        for (int o = 1; o < 64; o <<= 1) { const float t = __shfl_up(s, o); if (tid >= o) s += t; }
        csl[2 * tid + 1] = s; csl[2 * tid] = s - e1; }
    __syncthreads();
    const float cs_end = csl[127];
#pragma unroll
    for (int k = 0; k < 8; ++k) { const int idx = tid + 512 * k, j = idx >> 5, c4 = idx & 31, row = crow(c, j);
        const f32x4 v = row >= 0 ? *(const f32x4*)(XBC + (size_t)row * 1024 + 512 + 128 * g + 4 * c4) : (f32x4){0.f, 0.f, 0.f, 0.f};
        *(LAS f32x4*)(Bm + j * 128 + 4 * c4) = v; }
#pragma unroll
    for (int k = 0; k < 4; ++k) { const int idx = tid + 512 * k, j = idx >> 4, c4 = idx & 15, row = crow(c, j);
        f32x4 v = row >= 0 ? *(const f32x4*)(XBC + (size_t)row * 1024 + 64 * h + 4 * c4) : (f32x4){0.f, 0.f, 0.f, 0.f};
        v = v * (dtl[j] * expf(cs_end - csl[j]));
        *(LAS f32x4*)(XD + j * 64 + 4 * c4) = v; }
    __syncthreads();
    const int tr = w >> 2, tc = w & 3;
    f32x16 acc = zero16();
    mma32(acc, XD + 32 * tr, 1, 64, Bm + 32 * tc, 128, 1, 128, lane);
    float* dst = SST + ((size_t)(c * 8 + h) * 64 + 32 * tr) * 128 + 32 * tc + (lane & 31);
#pragma unroll
    for (int r = 0; r < 16; ++r) dst[(size_t)rreg(r, lane) * 128] = acc[r];
    TU_E(6);
    if (tid == 0) SDEC[(c * 8 + h) * 32] = expf(cs_end);
}
__device__ __forceinline__ float ret_logg(int h) { return logf(1.0f - exp2f(-5.0f - (float)h)); }
__device__ __forceinline__ void ret_states_unit(const Ctx& F, int c, int h) {
    LAS float* V = (LAS float*)F.lds; LAS float* KD = V + 16384;
    const float* U = (const float*)(F.ws + O_U); const float* RQK = (const float*)(F.ws + O_RQK); float* RST = (float*)(F.ws + O_RST);
    const int tid = F.tid, lane = F.lane, w = F.wave; const float lg = ret_logg(h);
    __syncthreads();
    TU_B(7);
#pragma unroll
    for (int k = 0; k < 8; ++k) { const int idx = tid + 512 * k, j = idx >> 5, c4 = idx & 31, row = crow(c, j);
        const f32x4 v = row >= 0 ? *(const f32x4*)(U + (size_t)row * NINP + U_RET + 512 + 128 * h + 4 * c4) : (f32x4){0.f, 0.f, 0.f, 0.f};
        *(LAS f32x4*)(V + j * 128 + 4 * c4) = v; }
#pragma unroll
    for (int k = 0; k < 4; ++k) { const int idx = tid + 512 * k, j = idx >> 4, c4 = idx & 15, row = crow(c, j);
        f32x4 v = row >= 0 ? *(const f32x4*)(RQK + (size_t)row * 512 + 256 + 64 * h + 4 * c4) : (f32x4){0.f, 0.f, 0.f, 0.f};
        v = v * expf((float)(127 - j) * lg);
        *(LAS f32x4*)(KD + j * 64 + 4 * c4) = v; }
    __syncthreads();
    const int tr = w >> 1, tc = w & 1;
    f32x16 acc = zero16();
    mma32(acc, V + 32 * tr, 1, 128, KD + 32 * tc, 64, 1, 128, lane);
    float* dst = RST + ((size_t)(c * 4 + h) * 128 + 32 * tr) * 64 + 32 * tc + (lane & 31);
#pragma unroll
    for (int r = 0; r < 16; ++r) dst[(size_t)rreg(r, lane) * 64] = acc[r];
    TU_E(7);
}

__device__ __forceinline__ void scan_job(float* base, size_t cstride, const float* dec, int decstride, float constdec) {
    float s = 0.f; float t[13], d[13];
#pragma unroll
    for (int i = 0; i < 13; ++i) { t[i] = base[(size_t)i * cstride]; d[i] = dec ? dec[i * decstride] : constdec; }
#pragma unroll
    for (int c0 = 0; c0 < NCH; c0 += 13) { float tn[13], dn[13];
        if (c0 + 13 < NCH) {
#pragma unroll
            for (int i = 0; i < 13; ++i) { tn[i] = base[(size_t)(c0 + 13 + i) * cstride]; dn[i] = dec ? dec[(c0 + 13 + i) * decstride] : constdec; } }
#pragma unroll
        for (int i = 0; i < 13; ++i) { base[(size_t)(c0 + i) * cstride] = s; s = d[i] * s + t[i]; }
#pragma unroll
        for (int i = 0; i < 13; ++i) { t[i] = tn[i]; d[i] = dn[i]; } }
}
__device__ __forceinline__ void rwkv_scan(const Ctx& F, int hb) {
    LAS float* st = (LAS float*)F.lds;
    float* RW = (float*)(F.ws + O_RW); const size_t AS = (size_t)MP * 512; float* OUT = RW + 7 * AS;
    const int tid = F.tid, lane = F.lane, rl = lane >> 3, ks = lane & 7, myrow = 8 * F.wave + rl;
    float S[8];
#pragma unroll
    for (int j = 0; j < 8; ++j) S[j] = 0.f;
    for (int s0 = 0; s0 < T; s0 += 32) {
        __syncthreads();
#pragma unroll
        for (int j = 0; j < 6; ++j) { const int idx = tid + 512 * j, stp = idx / 96, rem = idx % 96, arr = rem >> 4, c4 = rem & 15, s = s0 + stp;
            if (s < T) { const int row = row_of_seq(s); const int asel = arr == 0 ? 0 : (arr == 1 ? 1 : (arr == 2 ? 2 : (arr == 3 ? 4 : (arr == 4 ? 5 : 3))));
                *(LAS f32x4*)(st + stp * 384 + arr * 64 + 4 * c4) = *(const f32x4*)(RW + asel * AS + (size_t)row * 512 + 64 * hb + 4 * c4); } }
        __syncthreads();
        const int nst = (T - s0) < 32 ? (T - s0) : 32;
        for (int stp = 0; stp < nst; ++stp) { const LAS float* b = st + stp * 384 + 8 * ks;
            const f32x4 r0 = *(const LAS f32x4*)(b), r1 = *(const LAS f32x4*)(b + 4), w0 = *(const LAS f32x4*)(b + 64), w1 = *(const LAS f32x4*)(b + 68), k0 = *(const LAS f32x4*)(b + 128), k1 = *(const LAS f32x4*)(b + 132),
                        n0 = *(const LAS f32x4*)(b + 192), n1 = *(const LAS f32x4*)(b + 196), b0 = *(const LAS f32x4*)(b + 256), b1 = *(const LAS f32x4*)(b + 260);
            const float vv = st[stp * 384 + 320 + myrow];
            float sa = (S[0] * n0[0] + S[1] * n0[1]) + (S[2] * n0[2] + S[3] * n0[3]) + (S[4] * n1[0] + S[5] * n1[1]) + (S[6] * n1[2] + S[7] * n1[3]);
            sa += __shfl_xor(sa, 1); sa += __shfl_xor(sa, 2); sa += __shfl_xor(sa, 4);
            float o = 0.f;
#pragma unroll
            for (int j = 0; j < 4; ++j) { S[j] = S[j] * w0[j] + sa * b0[j] + vv * k0[j]; o += S[j] * r0[j]; S[4 + j] = S[4 + j] * w1[j] + sa * b1[j] + vv * k1[j]; o += S[4 + j] * r1[j]; }
            o += __shfl_xor(o, 1); o += __shfl_xor(o, 2); o += __shfl_xor(o, 4);
            if (ks == 0) OUT[(size_t)row_of_seq(s0 + stp) * 512 + 64 * hb + myrow] = o; }
    }
}
__device__ __forceinline__ void mla_prep2_unit(const Ctx& F, int l, int un) {
    const float* QKVb = (const float*)(F.ws + O_QKV); const float* U = (const float*)(F.ws + O_U);
    bf16* Q = (bf16*)(F.ws + O_Q); bf16* K = (bf16*)(F.ws + O_K); bf16* VT = (bf16*)(F.ws + O_VT);
    LAS bf16* Vl = (LAS bf16*)F.lds;
    const int lane = F.lane, tid = F.tid;
    const float* gq = F.kp->in[I_QKNQ] + l * 192; const float* gk = F.kp->in[I_QKNK] + l * 192;
    const float gq0 = gq[lane], gq1 = gq[64 + lane], gq2 = gq[128 + lane], gk0 = gk[lane], gk1 = gk[64 + lane], gk2 = gk[128 + lane];
    const float qs = 0.07216878364870322f * 1.4426950408889634f;
    __syncthreads();
#pragma unroll 1
    for (int ib = 0; ib < 8; ib += 4) {
        float xq[4][12], xk[4][8], xv[4][8], kpe[4]; f32x2 cs[4];
#pragma unroll
        for (int p = 0; p < 4; ++p) { const int s = 64 * un + 8 * F.wave + ib + p; const int row = s < T ? row_of_seq(s) : 0; const float* qk = QKVb + (size_t)row * MLAN;
            cs[p] = ((const f32x2*)(F.ws + O_ROPE))[row * 32 + (lane & 31)]; kpe[p] = U[(size_t)row * NINP + 512 + lane];
#pragma unroll
            for (int h = 0; h < 4; ++h) { xq[p][3 * h] = qk[192 * h + lane]; xq[p][3 * h + 1] = qk[192 * h + 64 + lane]; xq[p][3 * h + 2] = qk[192 * h + 128 + lane];
                xk[p][2 * h] = qk[768 + 256 * h + lane]; xk[p][2 * h + 1] = qk[768 + 256 * h + 64 + lane]; xv[p][2 * h] = qk[768 + 256 * h + 128 + lane]; xv[p][2 * h + 1] = qk[768 + 256 * h + 192 + lane]; } }
#pragma unroll
        for (int p = 0; p < 4; ++p) { const int sl = 8 * F.wave + ib + p, s = 64 * un + sl; const bool ok = s < T;
#pragma unroll
            for (int h = 0; h < 4; ++h) {
                { float x0 = xq[p][3 * h], x1 = xq[p][3 * h + 1], x2 = xq[p][3 * h + 2];
                  const float rs = 1.0f / sqrtf(wave_sum(x0 * x0 + x1 * x1 + x2 * x2) * (1.0f / 192.0f) + EPS);
                  x0 *= rs * gq0; x1 *= rs * gq1; x2 *= rs * gq2;
                  const float ot = xor32f(x2, lane); const float rr = lane < 32 ? x2 * cs[p].x - ot * cs[p].y : ot * cs[p].y + x2 * cs[p].x;
                  bf16* qd = Q + ((size_t)s * 4 + h) * 192; qd[lane] = (bf16)f2bf(x0 * qs); qd[64 + lane] = (bf16)f2bf(x1 * qs); qd[128 + lane] = (bf16)f2bf(rr * qs); }
                { float x0 = xk[p][2 * h], x1 = xk[p][2 * h + 1], x2 = kpe[p];
                  const float rs = 1.0f / sqrtf(wave_sum(x0 * x0 + x1 * x1 + x2 * x2) * (1.0f / 192.0f) + EPS);
                  x0 *= rs * gk0; x1 *= rs * gk1; x2 *= rs * gk2;
                  const float ot = xor32f(x2, lane); const float rr = lane < 32 ? x2 * cs[p].x - ot * cs[p].y : ot * cs[p].y + x2 * cs[p].x;
                  bf16* kd = K + ((size_t)s * 4 + h) * 192; kd[lane] = (bf16)f2bf(x0); kd[64 + lane] = (bf16)f2bf(x1); kd[128 + lane] = (bf16)f2bf(rr); }
                Vl[(h * 128 + lane) * 66 + sl] = ok ? (bf16)f2bf(xv[p][2 * h]) : (bf16)0; Vl[(h * 128 + 64 + lane) * 66 + sl] = ok ? (bf16)f2bf(xv[p][2 * h + 1]) : (bf16)0; } }
    }
    __syncthreads();
#pragma unroll
    for (int k = 0; k < 8; ++k) { const int idx = tid + 512 * k, r = idx >> 3, j = idx & 7; const LAS unsigned* src = (const LAS unsigned*)(Vl + r * 66 + 8 * j);
        v4u w; w.x = src[0]; w.y = src[1]; w.z = src[2]; w.w = src[3];
        *(v4u*)(VT + (size_t)r * TSEQ + 64 * un + 8 * j) = w; }
}
__device__ __forceinline__ void m3_phase(const Ctx& F, int l) {
    const int b2 = F.bid, NB = F.G;
    for (int job = b2; job < 192; job += NB) {
        if (job < 128) { if (!EN_SSD) continue; const int e = job * 512 + F.tid, h = e >> 13, rest = e & 8191; scan_job((float*)(F.ws + O_SST) + (size_t)h * 8192 + rest, (size_t)8 * 8192, (const float*)(F.ws + O_SDEC) + h * 32, 8 * 32, 0.f); }
        else { if (!EN_RET) continue; const int e = (job - 128) * 512 + F.tid, h = e >> 13, rest = e & 8191; scan_job((float*)(F.ws + O_RST) + (size_t)h * 8192 + rest, (size_t)4 * 8192, nullptr, 0, expf(128.0f * ret_logg(h))); }
    }
    if (EN_MLA) for (int un = NB - 1 - b2; un < (T + 63) / 64; un += NB) mla_prep2_unit(F, l, un);
}
template <int VAR = 0>
__device__ __forceinline__ void attn_unit(const Ctx& F, int hh, int qb, size_t yoff = O_Y) {
    LAS bf16* L0 = (LAS bf16*)F.lds;
    const bf16* Q = (const bf16*)(F.ws + O_Q); const bf16* K = (const bf16*)(F.ws + O_K); const bf16* VT = (const bf16*)(F.ws + O_VT); bf16* Y = (bf16*)(F.ws + yoff);
    int tid = F.tid, w = F.wave; asm volatile("" : "+v"(tid), "+s"(w));
    const int lane = tid & 63, h = lane >> 5, c = lane & 31, half = w >> 2, wq = w & 3;
    const int sq = 128 * qb + 32 * wq + c;
    bf16x8 qf[12];
#pragma unroll
    for (int ks = 0; ks < 12; ++ks) qf[ks] = *(const bf16x8*)(Q + ((size_t)sq * 4 + hh) * 192 + 16 * ks + 8 * h);
    f32x16 o[4];
#pragma unroll
    for (int t = 0; t < 4; ++t) o[t] = zero16();
    float m = -1e30f, lsum = 0.f;
    const int nst = qb + 1;
    v4u kr[6], vr[4];
    const unsigned kgo = (unsigned)(((tid >> 3) * 4 + hh) * 192 + 8 * (tid & 7)), klo = (unsigned)((tid >> 3) * 200 + 8 * (tid & 7));
    const unsigned vgo = (unsigned)((hh * 128 + (tid >> 2)) * TSEQ + 8 * (tid & 3)), vlo = (unsigned)(12800 + (tid >> 2) * 72 + 8 * (tid & 3));
#define AT_LOADK(st_) do { const bf16* kb_ = K + (size_t)(128 * (st_)) * 768; _Pragma("unroll") for (int j = 0; j < 6; ++j) kr[j] = *(const v4u*)(kb_ + kgo + (j / 3) * 49152 + 64 * (j % 3)); } while (0)
#define AT_LOADV(st_) do { const bf16* vb_ = VT + 128 * (st_); _Pragma("unroll") for (int j = 0; j < 4; ++j) vr[j] = *(const v4u*)(vb_ + vgo + (j >> 1) * 64 + 32 * (j & 1)); } while (0)
#define AT_STOREK() do { _Pragma("unroll") for (int j = 0; j < 6; ++j) *(LAS v4u*)(L0 + klo + (j / 3) * 22016 + 64 * (j % 3)) = kr[j]; } while (0)
#define AT_STOREV() do { _Pragma("unroll") for (int j = 0; j < 4; ++j) *(LAS v4u*)(L0 + vlo + (j >> 1) * 22016 + 32 * (j & 1)) = vr[j]; } while (0)
    __syncthreads();
    AT_LOADK(0); AT_LOADV(0); AT_STOREK(); AT_STOREV(); if (nst > 1) AT_LOADK(1);
    LBAR();
    const LAS bf16* Ks = L0 + half * 22016; const LAS bf16* Vs = Ks + 12800;
    for (int st = 0; st < nst; ++st) {
        const int kt = 2 * st + half;
        f32x16 sa[2];
#pragma unroll
        for (int t2 = 0; t2 < 2; ++t2) { sa[t2] = zero16();
#pragma unroll
            for (int ks = 0; ks < 12; ++ks) { const bf16x8 a = *(const LAS bf16x8*)(Ks + (32 * t2 + c) * 200 + 16 * ks + 8 * h); sa[t2] = __builtin_amdgcn_mfma_f32_32x32x16_bf16(a, qf[ks], sa[t2], 0, 0, 0); } }
        if (st == nst - 1) {
#pragma unroll
            for (int t2 = 0; t2 < 2; ++t2)
#pragma unroll
                for (int r = 0; r < 16; ++r) { const int key = 64 * kt + 32 * t2 + (r & 3) + 8 * (r >> 2) + 4 * h; if (key > sq) sa[t2][r] = -1e30f; } }
        float mx = -1e30f;
#pragma unroll
        for (int t2 = 0; t2 < 2; ++t2)
#pragma unroll
            for (int r = 0; r < 16; ++r) mx = fmaxf(mx, sa[t2][r]);
        mx = fmaxf(mx, __shfl_xor(mx, 32));
        if (__builtin_amdgcn_ballot_w64(mx > m) != 0ull) { const float mn = fmaxf(m, mx), alpha = __builtin_amdgcn_exp2f(m - mn); m = mn; lsum *= alpha;
#pragma unroll
            for (int t = 0; t < 4; ++t) o[t] = o[t] * alpha; }
        float rs = 0.f;
#pragma unroll
        for (int t2 = 0; t2 < 2; ++t2)
#pragma unroll
            for (int r = 0; r < 16; ++r) { const float pv = __builtin_amdgcn_exp2f(sa[t2][r] - m); sa[t2][r] = pv; rs += pv; }
        rs += __shfl_xor(rs, 32);
        lsum += rs;
        LBAR();
        if (st + 1 < nst) { AT_STOREK(); AT_LOADV(st + 1); }
#pragma unroll
        for (int t2 = 0; t2 < 2; ++t2)
#pragma unroll
            for (int s = 0; s < 2; ++s) { v4u pw; pw.x = cvtpk(sa[t2][8 * s], sa[t2][8 * s + 1]); pw.y = cvtpk(sa[t2][8 * s + 2], sa[t2][8 * s + 3]); pw.z = cvtpk(sa[t2][8 * s + 4], sa[t2][8 * s + 5]); pw.w = cvtpk(sa[t2][8 * s + 6], sa[t2][8 * s + 7]);
                const bf16x8 pf = __builtin_bit_cast(bf16x8, pw);
#pragma unroll
                for (int t = 0; t < 4; ++t) { const LAS bf16* vp = Vs + (32 * t + c) * 72 + 32 * t2 + 16 * s + 4 * h; const v2u lo = *(const LAS v2u*)vp, hi = *(const LAS v2u*)(vp + 8);
                    v4u vw; vw.x = lo.x; vw.y = lo.y; vw.z = hi.x; vw.w = hi.y;
                    o[t] = __builtin_amdgcn_mfma_f32_32x32x16_bf16(__builtin_bit_cast(bf16x8, vw), pf, o[t], 0, 0, 0); } }
        LBAR();
        if (st + 1 < nst) { AT_STOREV(); if (st + 2 < nst) AT_LOADK(st + 2); }
    }
#undef AT_LOADK
#undef AT_LOADV
#undef AT_STOREK
#undef AT_STOREV
    LAS float* MB = (LAS float*)F.lds + (wq * 64 + lane) * 67;
    if (half == 1) { MB[0] = m; MB[1] = lsum;
#pragma unroll
        for (int t = 0; t < 4; ++t)
#pragma unroll
            for (int r = 0; r < 16; ++r) MB[2 + 16 * t + r] = o[t][r]; }
    LBAR();
    if (half == 0) { const float m2 = MB[0], l2 = MB[1], mn = fmaxf(m, m2), a1 = __builtin_amdgcn_exp2f(m - mn), a2 = __builtin_amdgcn_exp2f(m2 - mn);
        const float inv = 1.0f / (lsum * a1 + l2 * a2);
        if (sq < T) { bf16* yr = Y + (size_t)row_of_seq(sq) * D + 128 * hh + 4 * h;
#pragma unroll
            for (int t = 0; t < 4; ++t)
#pragma unroll
                for (int rq = 0; rq < 4; ++rq) { float ov[4];
#pragma unroll
                    for (int i = 0; i < 4; ++i) ov[i] = (o[t][4 * rq + i] * a1 + MB[2 + 16 * t + 4 * rq + i] * a2) * inv;
                    v2u wv; wv.x = cvtpk(ov[0], ov[1]); wv.y = cvtpk(ov[2], ov[3]); *(v2u*)(yr + 32 * t + 8 * rq) = wv; } } }
}
__device__ __forceinline__ void ssd_out_unit(const Ctx& F, int l, int c, int h, int ih) {
    LAS float* CS_ = (LAS float*)F.lds; LAS float* BS_ = CS_ + 4352; LAS float* PS_ = BS_ + 8704; LAS float* SC_ = PS_ + 4352; LAS float* XD_ = SC_ + 8448; LAS float* csl = XD_ + 8448; LAS float* lal = csl + 128; LAS float* dtl = lal + 128;
    LAS float* Y_ = CS_;
    const float* XBC = (const float*)(F.ws + O_XBC); const float* DT = (const float*)(F.ws + O_DT); const float* LA = (const float*)(F.ws + O_LA); const float* U = (const float*)(F.ws + O_U);
    const float* SST = (const float*)(F.ws + O_SST); float* YZ = (float*)(F.ws + O_YZ);
    int tid = F.tid, w = F.wave; asm volatile("" : "+v"(tid), "+s"(w));
    const int lane = tid & 63, g = h >> 2;
    const f32x4 z4 = (f32x4){0.f, 0.f, 0.f, 0.f};
    float lav = 0.f, dtv = 0.f;
    if (tid < 128) { const int row = crow(c, tid); if (row >= 0) { lav = LA[row * 8 + h]; dtv = DT[row * 8 + h]; } }
    f32x4 xdv[4], csv[2][2], bsv[2][4], psv[2][2]; float xsv[8], zv[8];
#pragma unroll
    for (int k = 0; k < 4; ++k) { const int idx = tid + 512 * k, j = idx >> 4, c4 = idx & 15, row = crow(c, j); xdv[k] = row >= 0 ? *(const f32x4*)(XBC + (size_t)row * 1024 + 64 * h + 4 * c4) : z4; }
#pragma unroll
    for (int nh = 0; nh < 2; ++nh) {
#pragma unroll
        for (int k = 0; k < 2; ++k) { const int idx = tid + 512 * k, i = idx >> 4, c4 = idx & 15, row = crow(c, 64 * ih + i); csv[nh][k] = row >= 0 ? *(const f32x4*)(XBC + (size_t)row * 1024 + 768 + 128 * g + 64 * nh + 4 * c4) : z4; }
#pragma unroll
        for (int k = 0; k < 4; ++k) { const int idx = tid + 512 * k, j = idx >> 4, c4 = idx & 15, row = crow(c, j); bsv[nh][k] = row >= 0 ? *(const f32x4*)(XBC + (size_t)row * 1024 + 512 + 128 * g + 64 * nh + 4 * c4) : z4; }
#pragma unroll
        for (int k = 0; k < 2; ++k) { const int idx = tid + 512 * k, pp = idx >> 4, c4 = idx & 15; psv[nh][k] = *(const f32x4*)(SST + ((size_t)(c * 8 + h) * 64 + pp) * 128 + 64 * nh + 4 * c4); } }
#pragma unroll
    for (int k = 0; k < 8; ++k) { const int idx = tid + 512 * k, i = idx >> 6, pp = idx & 63, row = crow(c, 64 * ih + i); xsv[k] = 0.f; zv[k] = 0.f;
        if (row >= 0) { xsv[k] = XBC[(size_t)row * 1024 + 64 * h + pp]; zv[k] = U[(size_t)row * NINP + U_SSD + 64 * h + pp]; } }
    __syncthreads();
    if (tid < 128) { lal[tid] = lav; dtl[tid] = dtv; }
    LBAR();
    if (tid < 64) { const float e0 = lal[2 * tid], e1 = lal[2 * tid + 1]; float s = e0 + e1;
#pragma unroll
        for (int o = 1; o < 64; o <<= 1) { const float t = __shfl_up(s, o); if (tid >= o) s += t; }
        csl[2 * tid + 1] = s; csl[2 * tid] = s - e1; }
#pragma unroll
    for (int k = 0; k < 4; ++k) { const int idx = tid + 512 * k, j = idx >> 4, c4 = idx & 15; const f32x4 v = xdv[k] * dtl[j]; LAS float* d = XD_ + (4 * c4) * 132 + j; d[0] = v[0]; d[132] = v[1]; d[264] = v[2]; d[396] = v[3]; }
    f32x16 acc_s = zero16(), acc_y = zero16();
    const int tr = w >> 2, tc = w & 3, tr2 = (w >> 1) & 1, tc2 = w & 1;
#pragma unroll
    for (int nh = 0; nh < 2; ++nh) {
        if (nh) LBAR();
#pragma unroll
        for (int k = 0; k < 2; ++k) { const int idx = tid + 512 * k, i = idx >> 4, c4 = idx & 15; const f32x4 v = csv[nh][k]; *(LAS f32x4*)(CS_ + i * 68 + 4 * c4) = v; }
#pragma unroll
        for (int k = 0; k < 4; ++k) { const int idx = tid + 512 * k, j = idx >> 4, c4 = idx & 15; const f32x4 v = bsv[nh][k]; *(LAS f32x4*)(BS_ + j * 68 + 4 * c4) = v; }
#pragma unroll
        for (int k = 0; k < 2; ++k) { const int idx = tid + 512 * k, pp = idx >> 4, c4 = idx & 15; const f32x4 v = psv[nh][k]; *(LAS f32x4*)(PS_ + pp * 68 + 4 * c4) = v; }
        LBAR();
        mma32bf(acc_s, CS_ + 32 * tr * 68, 68, BS_ + 32 * tc * 68, 68, 64, lane);
        if (w < 4) mma32bf(acc_y, CS_ + 32 * tr2 * 68, 68, PS_ + 32 * tc2 * 68, 68, 64, lane);
    }
    if (w < 4) {
#pragma unroll
        for (int r = 0; r < 16; ++r) acc_y[r] *= expf(csl[64 * ih + 32 * tr2 + rreg(r, lane)]); }
#pragma unroll
    for (int r = 0; r < 16; ++r) { const int i = 32 * tr + rreg(r, lane), j = 32 * tc + (lane & 31), il = 64 * ih + i;
        SC_[i * 132 + j] = j <= il ? acc_s[r] * expf(csl[il] - csl[j]) : 0.f; }
    LBAR();
    if (w < 4) { mma32bf(acc_y, SC_ + 32 * tr2 * 132, 132, XD_ + 32 * tc2 * 132, 132, 128, lane);
#pragma unroll
        for (int r = 0; r < 16; ++r) Y_[(32 * tr2 + rreg(r, lane)) * 68 + 32 * tc2 + (lane & 31)] = acc_y[r]; }
    LBAR();
    const float Dh = F.kp->in[I_SSDD][l * 8 + h];
#pragma unroll
    for (int k = 0; k < 8; ++k) { const int idx = tid + 512 * k, i = idx >> 6, pp = idx & 63, row = crow(c, 64 * ih + i);
        if (row >= 0) YZ[(size_t)row * 512 + 64 * h + pp] = (Y_[i * 68 + pp] + Dh * xsv[k]) * siluf_(zv[k]); }
}
__device__ __forceinline__ void ret_out_unit(const Ctx& F, int l, int c, int h, int ih) {
    LAS float* Q_ = (LAS float*)F.lds; LAS float* KM_ = Q_ + 4352; LAS float* SC_ = KM_ + 8704; LAS float* VH_ = SC_ + 8448; LAS float* SP_ = KM_; LAS float* Y_ = SC_;
    const float* U = (const float*)(F.ws + O_U); const float* RQK = (const float*)(F.ws + O_RQK); const float* RST = (const float*)(F.ws + O_RST); bf16* Y = (bf16*)(F.ws + O_Y);
    int tid = F.tid, w = F.wave; asm volatile("" : "+v"(tid), "+s"(w));
    const int lane = tid & 63; const float lg = ret_logg(h);
    const f32x4 z4 = (f32x4){0.f, 0.f, 0.f, 0.f};
    f32x4 qv[2], kv[4], spv[4], vv[2][4], gv[4];
#pragma unroll
    for (int k = 0; k < 2; ++k) { const int idx = tid + 512 * k, i = idx >> 4, c4 = idx & 15, row = crow(c, 64 * ih + i); qv[k] = row >= 0 ? *(const f32x4*)(RQK + (size_t)row * 512 + 64 * h + 4 * c4) : z4; }
#pragma unroll
    for (int k = 0; k < 4; ++k) { const int idx = tid + 512 * k, j = idx >> 4, c4 = idx & 15, row = crow(c, j); kv[k] = row >= 0 ? *(const f32x4*)(RQK + (size_t)row * 512 + 256 + 64 * h + 4 * c4) : z4; }
#pragma unroll
    for (int k = 0; k < 4; ++k) { const int idx = tid + 512 * k, vx = idx >> 4, c4 = idx & 15; spv[k] = *(const f32x4*)(RST + ((size_t)(c * 4 + h) * 128 + vx) * 64 + 4 * c4); }
#pragma unroll
    for (int jh = 0; jh < 2; ++jh)
#pragma unroll
        for (int k = 0; k < 4; ++k) { const int idx = tid + 512 * k, j = idx >> 5, c4 = idx & 31, row = crow(c, 64 * jh + j); vv[jh][k] = (jh <= ih && row >= 0) ? *(const f32x4*)(U + (size_t)row * NINP + U_RET + 512 + 128 * h + 4 * c4) : z4; }
    const int li = tid >> 3, part = tid & 7, lrow = crow(c, 64 * ih + li);
#pragma unroll
    for (int k = 0; k < 4; ++k) gv[k] = lrow >= 0 ? *(const f32x4*)(U + (size_t)lrow * NINP + U_RET + 1024 + 128 * h + 16 * part + 4 * k) : z4;
    __syncthreads();
#pragma unroll
    for (int k = 0; k < 2; ++k) { const int idx = tid + 512 * k, i = idx >> 4, c4 = idx & 15; const f32x4 v = qv[k]; *(LAS f32x4*)(Q_ + i * 68 + 4 * c4) = v; }
#pragma unroll
    for (int k = 0; k < 4; ++k) { const int idx = tid + 512 * k, j = idx >> 4, c4 = idx & 15; const f32x4 v = kv[k]; *(LAS f32x4*)(KM_ + j * 68 + 4 * c4) = v; }
    LBAR();
    const int tr = w >> 2, tc = w & 3;
    f32x16 acc_s = zero16();
    mma32bf(acc_s, Q_ + 32 * tr * 68, 68, KM_ + 32 * tc * 68, 68, 64, lane);
    LBAR();
#pragma unroll
    for (int k = 0; k < 4; ++k) { const int idx = tid + 512 * k, vx = idx >> 4, c4 = idx & 15; const f32x4 v = spv[k]; *(LAS f32x4*)(SP_ + vx * 68 + 4 * c4) = v; }
#pragma unroll
    for (int r = 0; r < 16; ++r) { const int i = 32 * tr + rreg(r, lane), j = 32 * tc + (lane & 31), il = 64 * ih + i;
        SC_[i * 132 + j] = j <= il ? acc_s[r] * expf((float)(il - j) * lg) : 0.f; }
#pragma unroll
    for (int k = 0; k < 4; ++k) { const int idx = tid + 512 * k, j = idx >> 5, c4 = idx & 31; const f32x4 v = vv[0][k]; LAS float* d = VH_ + (4 * c4) * 68 + j; d[0] = v[0]; d[68] = v[1]; d[136] = v[2]; d[204] = v[3]; }
    LBAR();
    f32x16 acc_y = zero16();
    mma32bf(acc_y, Q_ + 32 * tr * 68, 68, SP_ + 32 * tc * 68, 68, 64, lane);
#pragma unroll
    for (int r = 0; r < 16; ++r) acc_y[r] *= expf((float)(64 * ih + 32 * tr + rreg(r, lane) + 1) * lg);
    mma32bf(acc_y, SC_ + 32 * tr * 132, 132, VH_ + 32 * tc * 68, 68, 64, lane);
    if (ih) { LBAR();
#pragma unroll
        for (int k = 0; k < 4; ++k) { const int idx = tid + 512 * k, j = idx >> 5, c4 = idx & 31; const f32x4 v = vv[1][k]; LAS float* d = VH_ + (4 * c4) * 68 + j; d[0] = v[0]; d[68] = v[1]; d[136] = v[2]; d[204] = v[3]; }
        LBAR();
        mma32bf(acc_y, SC_ + 32 * tr * 132 + 64, 132, VH_ + 32 * tc * 68, 68, 64, lane); }
    LBAR();
#pragma unroll
    for (int r = 0; r < 16; ++r) Y_[(32 * tr + rreg(r, lane)) * 132 + 32 * tc + (lane & 31)] = acc_y[r];
    LBAR();
    { const LAS float* yr = Y_ + li * 132 + 16 * part;
      float s = 0.f;
#pragma unroll
      for (int k = 0; k < 16; ++k) s += yr[k];
      s = sum8(s);
      const float mu = s * (1.0f / 128.0f); float q = 0.f;
#pragma unroll
      for (int k = 0; k < 16; ++k) { const float d = yr[k] - mu; q += d * d; }
      q = sum8(q);
      const float rstd = 1.0f / sqrtf(q * (1.0f / 128.0f) + EPS);
      if (lrow >= 0) { const float* ng = F.kp->in[I_RETN] + l * 512 + 128 * h + 16 * part; float ov[16];
#pragma unroll
          for (int k = 0; k < 16; ++k) ov[k] = (yr[k] - mu) * rstd * ng[k] * siluf_(gv[k >> 2][k & 3]);
          bf16* yd = Y + (size_t)lrow * D + 1024 + 128 * h + 16 * part;
          v4u w0, w1; w0.x = cvtpk(ov[0], ov[1]); w0.y = cvtpk(ov[2], ov[3]); w0.z = cvtpk(ov[4], ov[5]); w0.w = cvtpk(ov[6], ov[7]); w1.x = cvtpk(ov[8], ov[9]); w1.y = cvtpk(ov[10], ov[11]); w1.z = cvtpk(ov[12], ov[13]); w1.w = cvtpk(ov[14], ov[15]);
          *(v4u*)yd = w0; *(v4u*)(yd + 8) = w1; } }
}
__device__ __forceinline__ void m4_phase(const Ctx& F, int l, int qi = 0, int only = -1) {
    unsigned* ctr = (unsigned*)(F.ws + O_CTL) + CW_QUEUE + 64 * (4 * l + qi);
    constexpr int N_AT = 4 * NCH, N_CV = 128, G_RO = 2, G_SO = 4, G_WO = 4, N_RO = NCH * 8 / G_RO, N_SO = NCH * 16 / G_SO, N_WO = NRC * 8 / G_WO, N_ALL = N_AT + N_CV + N_SO + N_RO + N_WO;
    static_assert((NCH * 8) % G_RO == 0 && (NCH * 16) % G_SO == 0 && (NRC * 8) % G_WO == 0, "ticket grains");
    int u; TU_B(16); u = queue_next(F, ctr); TU_E(16);
    while (u < N_AT) { TU_B(10); if (only < 0) attn_unit<0>(F, u & 3, (NCH - 1) - (u >> 2)); else if (only == 0) attn_unit<DUP_VAR>(F, u & 3, (NCH - 1) - (u >> 2), O_QKV); TU_E(10); TU_B(16); u = queue_next(F, ctr); TU_E(16); }
    while (u < N_AT + N_CV) { TU_B(11); if (l + 1 < DEPTH && only < 0) { __syncthreads(); convert_layer(F, l + 1, (u - N_AT) * NWAVES + F.wave, N_CV * NWAVES); } TU_E(11);
        TU_B(16); u = queue_next(F, ctr); TU_E(16); }
    while (u < N_AT + N_CV + N_SO + N_RO) { int t = u - N_AT - N_CV;
        if (t < N_RO) { TU_B(12);
#pragma unroll 1
            for (int g = 0; g < G_RO; ++g) { const int v = G_RO * t + g, c = v >> 3, h = (v >> 1) & 3, ih = v & 1; if (!(c == 0 && ih == 0) && (only < 0 || only == 2)) ret_out_unit(F, l, c, h, ih); } TU_E(12); }
        else { TU_B(13); t -= N_RO;
#pragma unroll 1
            for (int g = 0; g < G_SO; ++g) { const int v = G_SO * t + g, c = v >> 4, h = (v >> 1) & 7, ih = v & 1; if (!(c == 0 && ih == 0) && (only < 0 || only == 1)) ssd_out_unit(F, l, c, h, ih); } TU_E(13); }
        TU_B(16); u = queue_next(F, ctr); TU_E(16); }
    TU_B(15);
    if (u < N_ALL && only < 0) {
        if (F.tid == 0) { unsigned* sflag = (unsigned*)(F.ws + O_CTL) + CW_QUEUE + 64 * (16 + l); const unsigned nscan = F.G >= 64 ? 32u : (unsigned)F.G; unsigned sp = 0;
            while (__hip_atomic_load(sflag, __ATOMIC_RELAXED, __HIP_MEMORY_SCOPE_AGENT) < nscan) { __builtin_amdgcn_s_sleep(8); if (++sp > (1u << 22)) break; }
            __builtin_amdgcn_fence(__ATOMIC_ACQUIRE, "agent"); asm volatile("s_waitcnt vmcnt(0)" ::: "memory"); }
        __syncthreads(); }
    TU_E(15);
    while (u < N_ALL) { TU_B(14); const int t = u - (N_AT + N_CV + N_SO + N_RO);
#pragma unroll 1
        for (int g = 0; g < G_WO; ++g) { const int v = G_WO * t + g; if (only < 0 || only == 3) rwkv_out_unit(F, l, v >> 3, v & 7); } TU_E(14); TU_B(16); u = queue_next(F, ctr); TU_E(16); }
}
__device__ __forceinline__ void m5_phase(const Ctx& F, int l) {
#ifdef PROBE_DUP
    { const bf16* Y = (const bf16*)(F.ws + O_Y); const bf16* Y2 = (const bf16*)(F.ws + O_YZ); unsigned cnt = 0;
      for (int row = F.bid * NWAVES + F.wave; row < T; row += F.G * NWAVES) for (int j = 0; j < 8; ++j) cnt += Y[(size_t)row * D + 64 * j + F.lane] != Y2[(size_t)row * D + 64 * j + F.lane];
      if (cnt) atomicAdd((unsigned*)(F.ws + O_CTL) + 8, cnt); }
#endif
#ifdef PROBE_COPY_U
    { const float* U = (const float*)(F.ws + O_U); bf16* Y = (bf16*)(F.ws + O_Y);
      for (int row = F.bid * NWAVES + F.wave; row < T; row += F.G * NWAVES)
        for (int j = 0; j < 4; ++j) { const float* ur = U + (size_t)(PROBE_COPY_META ? SEQ + (row & 15) : row) * NINP + PROBE_COPY_U + 512 * j + 8 * F.lane; const f32x4 a = *(const f32x4*)ur, b = *(const f32x4*)(ur + 4);
          v4u w; w.x = pk2(a[0], a[1]); w.y = pk2(a[2], a[3]); w.z = pk2(b[0], b[1]); w.w = pk2(b[2], b[3]); *(v4u*)(Y + (size_t)row * D + 512 * j + 8 * F.lane) = w; } }
#endif
    if (!EN_SSD) return;
    const float* YZ = (const float*)(F.ws + O_YZ); bf16* Y = (bf16*)(F.ws + O_Y); const float* ng = F.kp->in[I_SSDN] + l * 512 + 8 * F.lane;
    for (int row = F.bid * NWAVES + F.wave; row < T; row += F.G * NWAVES) { const float* yr = YZ + (size_t)row * 512 + 8 * F.lane; const f32x4 a = *(const f32x4*)yr, b = *(const f32x4*)(yr + 4);
        const float sq = wave_sum((a[0] * a[0] + a[1] * a[1]) + (a[2] * a[2] + a[3] * a[3]) + (b[0] * b[0] + b[1] * b[1]) + (b[2] * b[2] + b[3] * b[3]));
        const float rs = 1.0f / sqrtf(sq * (1.0f / 512.0f) + EPS); const f32x4 g0 = *(const f32x4*)ng, g1 = *(const f32x4*)(ng + 4);
        v4u w; w.x = pk2(a[0] * rs * g0[0], a[1] * rs * g0[1]); w.y = pk2(a[2] * rs * g0[2], a[3] * rs * g0[3]); w.z = pk2(b[0] * rs * g1[0], b[1] * rs * g1[1]); w.w = pk2(b[2] * rs * g1[2], b[3] * rs * g1[3]);
        *(v4u*)(Y + (size_t)row * D + 512 + 8 * F.lane) = w; }
}
template <int MODE  , int NT>
__device__ __forceinline__ void meta_gemm(const Ctx& F, const bf16* A16, int lda, const bf16* Bt, int ldb, int ntasks, int K, float* Cf, int ldc, const float* ss_in, float* ss_out, bf16* Ob, bf16* HL, float scale) {
    constexpr int NACC = MODE == 1 ? 2 * NT : NT;
    LAS float* red = (LAS float*)F.lds;
    int tid = F.tid, w = F.wave; asm volatile("" : "+v"(tid), "+s"(w));
    const int lane = tid & 63, g = lane >> 4, c = lane & 15, kper = K >> 3;
    for (int task = F.G - 1 - F.bid; task < ntasks; task += F.G) {
        const int n0 = MODE == 1 ? 256 * ((64 * task) >> 7) + ((64 * task) & 127) : 16 * NT * task;
        f32x4 acc[NACC];
#pragma unroll
        for (int q = 0; q < NACC; ++q) acc[q] = (f32x4){0.f, 0.f, 0.f, 0.f};
        const bf16* ap = A16 + (size_t)c * lda + w * kper + 8 * g; const bf16* bp = Bt + (size_t)(n0 + c) * ldb + w * kper + 8 * g;
#pragma unroll 4
        for (int kk = 0; kk < kper; kk += 32) { const bf16x8 a = *(const bf16x8*)(ap + kk);
#pragma unroll
            for (int t = 0; t < NT; ++t) { acc[t] = __builtin_amdgcn_mfma_f32_16x16x32_bf16(*(const bf16x8*)(bp + (size_t)(16 * t) * ldb + kk), a, acc[t], 0, 0, 0);
                if (MODE == 1) acc[NT + t] = __builtin_amdgcn_mfma_f32_16x16x32_bf16(*(const bf16x8*)(bp + (size_t)(128 + 16 * t) * ldb + kk), a, acc[NT + t], 0, 0, 0); } }
        __syncthreads();
#pragma unroll
        for (int q = 0; q < NACC; ++q) *(LAS f32x4*)(red + ((w * NACC + q) * 64 + lane) * 4) = acc[q];
        __syncthreads();
        if (w == 0) { const int row = SEQ + c; float rs = 1.0f;
            if (ss_in) { float s = 0.f;
#pragma unroll
                for (int q = 0; q < 8; ++q) { const f32x4 x = *(const f32x4*)(ss_in + (size_t)row * 32 + 4 * q); s += (x[0] + x[1]) + (x[2] + x[3]); }
                rs = __builtin_amdgcn_rsqf(s * (1.0f / 2048.0f) + EPS); }
            float sq = 0.f;
#pragma unroll
            for (int t = 0; t < NT; ++t) { f32x4 v = (f32x4){0.f, 0.f, 0.f, 0.f}, v2 = v;
#pragma unroll
                for (int ww = 0; ww < 8; ++ww) { v = v + *(const LAS f32x4*)(red + ((ww * NACC + t) * 64 + lane) * 4); if (MODE == 1) v2 = v2 + *(const LAS f32x4*)(red + ((ww * NACC + NT + t) * 64 + lane) * 4); }
                if (MODE == 0) *(f32x4*)(Cf + (size_t)row * ldc + 16 * NT * task + 16 * t + 4 * g) = v * rs;
                if (MODE == 3) { v2u wv; wv.x = pk2(v[0] * rs, v[1] * rs); wv.y = pk2(v[2] * rs, v[3] * rs); *(v2u*)(Ob + (size_t)row * ldc + 16 * NT * task + 16 * t + 4 * g) = wv; }
                if (MODE == 1) { float o[4];
#pragma unroll
                    for (int i = 0; i < 4; ++i) { const float gv = v[i] * rs, uv = v2[i] * rs; o[i] = gv * uv * __builtin_amdgcn_rcpf(1.0f + __expf(-gv)); }
                    v2u wv; wv.x = pk2(o[0], o[1]); wv.y = pk2(o[2], o[3]); *(v2u*)(Ob + (size_t)row * DFF + 64 * task + 16 * t + 4 * g) = wv; }
                if (MODE == 2) { const size_t off = (size_t)row * D + 64 * task + 16 * t + 4 * g; const v2u hi = *(const v2u*)(Ob + off), lo = *(const v2u*)(HL + off);
                    f32x4 h4 = (f32x4){pg8::bflo(hi.x) + pg8::bflo(lo.x), pg8::bfhi(hi.x) + pg8::bfhi(lo.x), pg8::bflo(hi.y) + pg8::bflo(lo.y), pg8::bfhi(hi.y) + pg8::bfhi(lo.y)}; h4 = h4 + v * scale;
                    v2u wv; wv.x = cvtpk(h4[0], h4[1]); wv.y = cvtpk(h4[2], h4[3]); v2u lv; lv.x = cvtpk(h4[0] - pg8::bflo(wv.x), h4[1] - pg8::bfhi(wv.x)); lv.y = cvtpk(h4[2] - pg8::bflo(wv.y), h4[3] - pg8::bfhi(wv.y));
                    *(v2u*)(Ob + off) = wv; *(v2u*)(HL + off) = lv; sq += (h4[0] * h4[0] + h4[1] * h4[1]) + (h4[2] * h4[2] + h4[3] * h4[3]); } }
            if (MODE == 2 && ss_out) { sq += __shfl_xor(sq, 16); sq += __shfl_xor(sq, 32); if (g == 0) __hip_atomic_fetch_add(ss_out + (size_t)row * 32 + task, sq, __ATOMIC_RELAXED, __HIP_MEMORY_SCOPE_AGENT); } }
    }    __syncthreads();
}
__device__ __forceinline__ void gemm_swiglu(const Ctx& F, int hl, int ssidx) {
    const bf16* A = (const bf16*)(F.ws + O_HB); const bf16* Bt = (const bf16*)(F.ws + O_WGU) + (size_t)hl * 11264 * 2048; const float* ss = (const float*)(F.ws + O_SS) + (size_t)ssidx * MP * 32;
    { pg8::Gemm g{A, Bt, SEQ, 11264, 2048, 2048, 2048, F.wave}; pg8::StaticOrder S; S.init(SEQ, 11264, F.G, F.bid);
      const int full = (S.nwg / F.G) * F.G, rem = S.nwg - full;
      const bool split = false && (2 * rem == F.G);
      if (split) S.lim = full;
      pg8::EpiSwiGLU E{(bf16*)(F.ws + O_ACT), DFF, ss, 1.0f / 2048.0f, EPS, 2};
      pg8::gemm_phase<pg8::EpiSwiGLU, pg8::StaticOrder, true, true, false>(F.lds, g, S, E);
      if (split) { pg8::StaticOrder S2; S2.init(SEQ, 11264, F.G, F.bid); S2.hmbase = full;
          pg8::EpiSwiGLU E2{(bf16*)(F.ws + O_ACT), DFF, ss, 1.0f / 2048.0f, EPS, 1};
          pg8::gemm_phase<pg8::EpiSwiGLU, pg8::StaticOrder, true, true, true>(F.lds, g, S2, E2); } }
    meta_gemm<1, 4>(F, A + (size_t)SEQ * 2048, 2048, Bt, 2048, DFF / 64, 2048, nullptr, 0, ss, nullptr, (bf16*)(F.ws + O_ACT), nullptr, 0.f);
}
__device__ __forceinline__ void gemm_residual(const Ctx& F, const bf16* A, const bf16* Bt, int K, int ssidx, bool to_out, float scale) {
    float* sso = ssidx >= 0 ? (float*)(F.ws + O_SS) + (size_t)ssidx * MP * 32 : nullptr;
    { pg8::Gemm g{A, Bt, SEQ, 2048, K, K, K, F.wave}; pg8::StaticOrder S; S.init(SEQ, 2048, F.G, F.bid);
      pg8::EpiResidual E{(bf16*)(F.ws + O_H), (bf16*)(F.ws + O_HB), sso, to_out ? F.kp->out : nullptr, SEQ, scale};
      pg8::gemm_phase<pg8::EpiResidual, pg8::StaticOrder, true, true>(F.lds, g, S, E); }
    meta_gemm<2, 4>(F, A + (size_t)SEQ * K, K, Bt, K, 32, K, nullptr, 0, nullptr, sso, (bf16*)(F.ws + O_HB), (bf16*)(F.ws + O_H), scale);
}
__device__ __forceinline__ void gemm_residual_dummy(const Ctx& F, const bf16* A, const bf16* Bt, int K) {
    { pg8::Gemm g{A, Bt, SEQ, 2048, K, K, K, F.wave}; pg8::StaticOrder S; S.init(SEQ, 2048, F.G, F.bid);
      pg8::EpiResidual E{(bf16*)(F.ws + O_RW), (bf16*)(F.ws + O_RW + (size_t)72 * 1024 * 1024), nullptr, nullptr, SEQ, 0.5f};
      pg8::gemm_phase<pg8::EpiResidual, pg8::StaticOrder, true, true>(F.lds, g, S, E); }
}
__device__ __forceinline__ void gemm_scalef32(const Ctx& F, const bf16* A, const bf16* Bt, int N, int K, float* C, int ssidx) {
    const float* ss = ssidx >= 0 ? (const float*)(F.ws + O_SS) + (size_t)ssidx * MP * 32 : nullptr;
    { pg8::Gemm g{A, Bt, SEQ, N, K, K, K, F.wave}; pg8::StaticOrder S; S.init(SEQ, N, F.G, F.bid);
      pg8::EpiScaleF32 E{C, N, ss, 1.0f / 2048.0f, EPS};
      pg8::gemm_phase<pg8::EpiScaleF32, pg8::StaticOrder, true, true>(F.lds, g, S, E); }
    meta_gemm<0, 4>(F, A + (size_t)SEQ * K, K, Bt, K, N / 64, K, C, N, ss, nullptr, nullptr, nullptr, 0.f);
}
__global__ void __launch_bounds__(NTHR, 2) hybrid_fwd(P p) {
    extern __shared__ __attribute__((aligned(16))) unsigned char lds_raw[];
    LAS unsigned char* lds = (LAS unsigned char*)lds_raw;
    const int wv = __builtin_amdgcn_readfirstlane((int)threadIdx.x >> 6);
    for (int u = threadIdx.x; u < (LDS_BYTES - LDSCTL_OFF) / 4; u += NTHR) ((LAS unsigned*)(lds + LDSCTL_OFF))[u] = 0u;
    __syncthreads();
    XcdBarrier bar = xcd_barrier_post((unsigned*)(p.ws + O_CTL) + CW_BAR, (volatile LAS unsigned*)(lds + LDSCTL_OFF), wv);
    const int lo = p.ph_lo, hi = p.ph_hi;
#ifdef TIME_MASK
    if (blockIdx.x == TIME_BLK && threadIdx.x == 0) { volatile LAS unsigned long long* tp_ = (volatile LAS unsigned long long*)(lds + LDSCTL_OFF + 1024); tp_[0] = wall_clock64(); tp_[1] = 0ull; }
#endif
#define IN(k) (lo <= (k) && (k) < hi)
#ifdef TIME_MASK
#ifndef TIME_PRE
#define TIME_PRE 0
#endif
#define TMARK(kind, post) do { if (blockIdx.x == TIME_BLK && threadIdx.x == 0) { const unsigned long long now_ = wall_clock64(); volatile LAS unsigned long long* tp_ = (volatile LAS unsigned long long*)(lds + LDSCTL_OFF + 1024); \
    if ((((post) ? TIME_MASK : TIME_PRE) >> (kind)) & 1) tp_[1] += now_ - tp_[0]; if (post) tp_[0] = now_; } } while (0)
#define SEAM(k, kind) do { TMARK(kind, 0); if (IN(k) && IN((k) + 1)) xcd_barrier(bar, wv); TMARK(kind, 1); } while (0)
#else
#define TMARK(kind, post) do { } while (0)
#define SEAM(k, kind) do { if (IN(k) && IN((k) + 1)) xcd_barrier(bar, wv); } while (0)
#endif
#ifndef NO_P0
    if (IN(0)) { const Ctx F = ctx_make(lds, wv); p0_prologue(F, 0); }
#ifdef DUP_CVT
    if (IN(0)) { const Ctx F = ctx_make(lds, wv); p0_prologue(F, 1); }
#endif
#endif
    SEAM(0, 0);
    for (int hl = 0; hl < 8; ++hl) {
        const int l = hl >> 1, second = hl & 1, base = 1 + 11 * l + (second ? 9 : 0);
        if (IN(base)) { const Ctx F = ctx_make(lds, wv); gemm_swiglu(F, hl, 3 * l + (second ? 2 : 0)); }
#ifdef DUP_GU
        if (IN(base)) { const Ctx F = ctx_make(lds, wv); gemm_swiglu(F, hl, 3 * l + (second ? 2 : 0)); }
#endif
        SEAM(base, 1);
        if (IN(base + 1)) { const Ctx F = ctx_make(lds, wv);
            gemm_residual(F, (const bf16*)(F.ws + O_ACT), (const bf16*)(F.ws + O_WD) + (size_t)hl * 2048 * 5632, 5632, second ? (l < 3 ? 3 * (l + 1) : -1) : 3 * l + 1, hl == 7, 0.5f); }
#ifdef DUP_DOWN
        if (IN(base + 1)) { const Ctx F = ctx_make(lds, wv); if (DUP_DOWN == 1) gemm_residual_dummy(F, (const bf16*)(F.ws + O_ACT), (const bf16*)(F.ws + O_WD) + (size_t)hl * 2048 * 5632, 5632); else gemm_residual_dummy(F, (const bf16*)(F.ws + O_Y), (const bf16*)(F.ws + O_WOUT) + (size_t)l * D * D, 2048); }
#endif
        if (hl < 7) SEAM(base + 1, 2);
        if (!second) {
            const int mb = base + 2;
            if (IN(mb)) { const Ctx F = ctx_make(lds, wv); gemm_scalef32(F, (const bf16*)(F.ws + O_HB), (const bf16*)(F.ws + O_WIN) + (size_t)l * NINP * D, NINP, 2048, (float*)(F.ws + O_U), 3 * l + 1); }
#ifdef DUP_WIN
            if (IN(mb)) { const Ctx F = ctx_make(lds, wv); gemm_scalef32(F, (const bf16*)(F.ws + O_HB), (const bf16*)(F.ws + O_WIN) + (size_t)l * NINP * D, NINP, 2048, (float*)(F.ws + O_U), 3 * l + 1); }
#endif
            SEAM(mb, 3);
#ifndef NO_M1
            if (IN(mb + 1)) { const Ctx F = ctx_make(lds, wv); m1_phase(F, l); }
#ifdef DUP_M1
            if (IN(mb + 1)) { const Ctx F = ctx_make(lds, wv); m1_phase(F, l, 3); }
#endif
#endif
            SEAM(mb + 1, 4);
            if (IN(mb + 2)) {
                if (EN_MLA) { const Ctx F = ctx_make(lds, wv); gemm_scalef32(F, (const bf16*)(F.ws + O_AMLA), (const bf16*)(F.ws + O_WMLA) + (size_t)l * MLAN * 512, MLAN, 512, (float*)(F.ws + O_QKV), -1); }
#ifndef NO_M2
                { const Ctx F = ctx_make(lds, wv); unsigned* ctr = (unsigned*)(F.ws + O_CTL) + CW_QUEUE + 64 * (4 * l + 2);
                  for (;;) { int u = queue_next(F, ctr); if (u >= NRC * 8 + NCH * 4 + NCH * 2) break;
                      if (u < NRC * 8) { rwkv_chunk_unit(F, u >> 3, u & 7); continue; } u -= NRC * 8;
                      if (u < NCH * 4) { ssd_states_unit(F, u >> 2, 2 * (u & 3)); ssd_states_unit(F, u >> 2, 2 * (u & 3) + 1); continue; } u -= NCH * 4;
                      ret_states_unit(F, u >> 1, 2 * (u & 1)); ret_states_unit(F, u >> 1, 2 * (u & 1) + 1); } }
#ifdef DUP_M2Q
                { const Ctx F = ctx_make(lds, wv); unsigned* ctr = (unsigned*)(F.ws + O_CTL) + CW_QUEUE + 64 * (4 * l + 3);
                  for (;;) { int u = queue_next(F, ctr); if (u >= NRC * 8 + NCH * 4 + NCH * 2) break;
                      if (u < NRC * 8) { rwkv_chunk_unit(F, u >> 3, u & 7); continue; } u -= NRC * 8;
                      if (u < NCH * 4) { ssd_states_unit(F, u >> 2, 2 * (u & 3)); ssd_states_unit(F, u >> 2, 2 * (u & 3) + 1); continue; } u -= NCH * 4;
                      ret_states_unit(F, u >> 1, 2 * (u & 1)); ret_states_unit(F, u >> 1, 2 * (u & 1) + 1); } }
#endif
#endif
            }
            SEAM(mb + 2, 5);
#ifndef NO_M3
            if (IN(mb + 3)) { const Ctx F = ctx_make(lds, wv); m3_phase(F, l); }
#ifdef DUP_SCAN
            if (IN(mb + 3)) { const Ctx F = ctx_make(lds, wv); if (F.bid < 32) rwkv_state_scan<DUP_SCAN>(F, F.bid >> 2, F.bid & 3); }
#endif
#endif
            SEAM(mb + 3, 6);
#ifndef NO_M4
            if (IN(mb + 4)) { const Ctx F = ctx_make(lds, wv); const int nscan = F.G >= 64 ? 32 : F.G;
                if (F.bid < nscan) { for (int s = F.bid; s < 32; s += nscan) rwkv_state_scan<0>(F, s >> 2, s & 3);
                    asm volatile("s_waitcnt vmcnt(0)" ::: "memory"); __syncthreads();
                    if (F.tid == 0) { __builtin_amdgcn_fence(__ATOMIC_RELEASE, "agent"); asm volatile("s_waitcnt vmcnt(0)" ::: "memory"); __hip_atomic_fetch_add((unsigned*)(F.ws + O_CTL) + CW_QUEUE + 64 * (16 + l), 1u, __ATOMIC_RELAXED, __HIP_MEMORY_SCOPE_AGENT); } } }
            if (IN(mb + 4)) { const Ctx F = ctx_make(lds, wv); m4_phase(F, l); }
#ifdef DUP_M4
            if (IN(mb + 4)) { const Ctx F = ctx_make(lds, wv); m4_phase(F, l, 3, DUP_M4 - 1); }
#endif
#endif
            SEAM(mb + 4, 7);
#ifndef NO_M5
            if (IN(mb + 5)) { const Ctx F = ctx_make(lds, wv); m5_phase(F, l); }
#ifdef DUP_M5
            if (IN(mb + 5)) { const Ctx F = ctx_make(lds, wv); m5_phase(F, l); }
#endif
#endif
            SEAM(mb + 5, 8);
#ifdef DUP_BAR
            for (int q = 0; q < 8; ++q) xcd_barrier(bar, wv);
#endif
            if (IN(mb + 6)) { const Ctx F = ctx_make(lds, wv); gemm_residual(F, (const bf16*)(F.ws + O_Y), (const bf16*)(F.ws + O_WOUT) + (size_t)l * D * D, 2048, 3 * l + 2, false, 1.0f); }
            SEAM(mb + 6, 9);
        }
    }
#ifdef TIME_MASK
    TMARK(2, 0); TMARK(2, 1);
#ifdef TIME_ALL
    if (threadIdx.x == 0) { volatile LAS unsigned long long* tq_ = (volatile LAS unsigned long long*)(lds + LDSCTL_OFF + 1024); unsigned long long* gw_ = (unsigned long long*)(p.ws + O_CTL + 4096);
        if (tq_[4]) { __hip_atomic_fetch_add(gw_, tq_[3], __ATOMIC_RELAXED, __HIP_MEMORY_SCOPE_AGENT); __hip_atomic_fetch_add(gw_ + 1, tq_[4], __ATOMIC_RELAXED, __HIP_MEMORY_SCOPE_AGENT); } }
    xcd_barrier(bar, wv);
    if (blockIdx.x == TIME_BLK && threadIdx.x == 0) { volatile LAS unsigned long long* tq_ = (volatile LAS unsigned long long*)(lds + LDSCTL_OFF + 1024); unsigned long long* gw_ = (unsigned long long*)(p.ws + O_CTL + 4096);
        tq_[3] = __hip_atomic_load(gw_, __ATOMIC_RELAXED, __HIP_MEMORY_SCOPE_AGENT); tq_[4] = __hip_atomic_load(gw_ + 1, __ATOMIC_RELAXED, __HIP_MEMORY_SCOPE_AGENT); tq_[0] = wall_clock64(); }
#endif
    if (blockIdx.x == TIME_BLK && threadIdx.x == 0) { volatile LAS unsigned long long* tp_ = (volatile LAS unsigned long long*)(lds + LDSCTL_OFF + 1024); const unsigned long long t0_ = tp_[0]; unsigned long long d_ = tp_[1];
#ifdef TIME_UNIT
#ifdef TIME_USUM
        d_ += tp_[3];
#else
        d_ += tp_[3] * TIME_USCALE / (tp_[4] ? tp_[4] : 1ull);
#endif
#endif

        while (wall_clock64() - t0_ < d_) __builtin_amdgcn_s_sleep(8); }
#endif
#ifdef PROBE_DUP
    xcd_barrier(bar, wv);
    { const Ctx F = ctx_make(lds, wv); const float v = (float)__hip_atomic_load((unsigned*)(F.ws + O_CTL) + 8, __ATOMIC_RELAXED, __HIP_MEMORY_SCOPE_AGENT); float* out = F.kp->out;
      for (size_t i = (size_t)F.bid * NTHR + F.tid; i < (size_t)SEQ * D; i += (size_t)F.G * NTHR) out[i] = v; }
#endif
#ifdef PROBE_ADD_META
    xcd_barrier(bar, wv);
    { const Ctx F = ctx_make(lds, wv); const float* H = (const float*)(F.ws + O_H); float* out = F.kp->out;
      for (int row = F.bid * NWAVES + F.wave; row < SEQ; row += F.G * NWAVES)
        for (int j = 0; j < 8; ++j) { const int c = 256 * j + 4 * F.lane; f32x4 v = *(f32x4*)(out + (size_t)row * D + c); v = v + *(const f32x4*)(H + (size_t)(SEQ + (row & 15)) * D + c); *(f32x4*)(out + (size_t)row * D + c) = v; } }
#endif
#undef IN
#undef SEAM
}

extern "C" void kernel_launch(void* const* d_in, const int* in_sizes, int n_in, void* d_out, int out_size, void* d_ws, size_t ws_size, hipStream_t stream) {
    static int grid = 0;
    if (grid == 0) {
        if (n_in != 36 || out_size != SEQ * D || ws_size < WS_END) { fprintf(stderr, "kernel_launch: expected 36 inputs, out %d, ws >= %zu; got n_in %d out %d ws %zu\n", SEQ * D, (size_t)WS_END, n_in, out_size, ws_size); grid = -1; return; }
        int dev = 0, cus = 0, per_cu = 0;
        if (hipGetDevice(&dev) != hipSuccess || hipDeviceGetAttribute(&cus, hipDeviceAttributeMultiprocessorCount, dev) != hipSuccess) { grid = -1; return; }
        if (hipFuncSetAttribute((const void*)hybrid_fwd, hipFuncAttributeMaxDynamicSharedMemorySize, LDS_BYTES) != hipSuccess) { fprintf(stderr, "kernel_launch: hipFuncSetAttribute failed\n"); grid = -1; return; }
        if (hipOccupancyMaxActiveBlocksPerMultiprocessor(&per_cu, (const void*)hybrid_fwd, NTHR, LDS_BYTES) != hipSuccess || per_cu < 1) fprintf(stderr, "kernel_launch: occupancy query reports %d\n", per_cu);
        (void)hipGetLastError();
        grid = cus;
    }
    if (grid < 0) return;
    if (hipMemsetAsync((char*)d_ws + O_CTL, 0, SZ_CTL, stream) != hipSuccess) { fprintf(stderr, "kernel_launch: memset failed\n"); return; }
    P a{};
    for (int i = 0; i < 36; ++i) a.in[i] = (const float*)d_in[i];
    a.out = (float*)d_out; a.ws = (unsigned char*)d_ws;
#if PER_PHASE_LAUNCH
    for (int ph = 0; ph < NPHASE; ++ph) { a.ph_lo = ph; a.ph_hi = ph + 1; hipLaunchKernelGGL(hybrid_fwd, dim3(grid), dim3(NTHR), LDS_BYTES, stream, a); }
#else
    a.ph_lo = 0; a.ph_hi = NPHASE;
    hipLaunchKernelGGL(hybrid_fwd, dim3(grid), dim3(NTHR), LDS_BYTES, stream, a);
#endif
    const hipError_t le = hipPeekAtLastError();
    if (le != hipSuccess) fprintf(stderr, "kernel_launch: launch failed: %s\n", hipGetErrorName(le));
}
```

```cpp
#include <hip/hip_runtime.h>
#include <cstdio>
#include <cstdint>

#define GAS __attribute__((address_space(1)))
#define LAS __attribute__((address_space(3)))
typedef unsigned short bf16;
typedef unsigned v4u __attribute__((ext_vector_type(4)));
typedef unsigned v2u __attribute__((ext_vector_type(2)));
typedef float f32x4 __attribute__((ext_vector_type(4)));
typedef float f32x2 __attribute__((ext_vector_type(2)));
typedef float f32x16 __attribute__((ext_vector_type(16)));
typedef short bf16x8 __attribute__((ext_vector_type(8)));

constexpr int D = 2048, SEQ = 8192, NMETA = 16, T = SEQ + NMETA, MP = 8448, DFF = 5632, DEPTH = 4;
constexpr int NIN = 5320, NINP = 5376, NCH = 65, TSEQ = 8320, MLAN = 1792;
constexpr int U_MLA = 0, U_SSD = 576, U_RET = 2120, U_RWKV = 3656;
constexpr float EPS = 1e-6f;
constexpr int NWAVES = 8, NTHR = 512;
#ifndef EN_MLA
#define EN_MLA 1
#endif
#ifndef EN_SSD
#define EN_SSD 1
#endif
#ifndef EN_RET
#define EN_RET 1
#endif
#ifndef EN_RWKV
#define EN_RWKV 1
#endif
#ifndef PROBE_NOSCAN
#define PROBE_NOSCAN 0
#endif
#ifndef PROBE_ATTCOPY
#define PROBE_ATTCOPY 0
#endif
#ifndef PROBE_COPY_META
#define PROBE_COPY_META 0
#endif
#ifndef DUP_VAR
#define DUP_VAR 0
#endif
#ifndef PER_PHASE_LAUNCH
#define PER_PHASE_LAUNCH 0
#endif
constexpr int NPHASE = 1 + 8 * 2 + 4 * 7;

constexpr size_t O_CTL = 0, SZ_CTL = 13107200;
constexpr int CW_BAR = 4096;
constexpr size_t O_SS = 65536;
constexpr size_t O_WGU = O_CTL + SZ_CTL,                 SZ_WGU = (size_t)8 * 2 * DFF * D * 2;
constexpr size_t O_WD = O_WGU + SZ_WGU,                  SZ_WD = (size_t)8 * D * DFF * 2;
constexpr size_t O_WIN = O_WD + SZ_WD,                   SZ_WIN = (size_t)4 * NINP * D * 2;
constexpr size_t O_WOUT = O_WIN + SZ_WIN,                SZ_WOUT = (size_t)4 * D * D * 2;
constexpr size_t O_WMLA = O_WOUT + SZ_WOUT,              SZ_WMLA = (size_t)4 * MLAN * 512 * 2;
constexpr size_t O_H = O_WMLA + SZ_WMLA,                 SZ_H = (size_t)MP * D * 4;
constexpr size_t O_HB = O_H + SZ_H,                      SZ_HB = (size_t)MP * D * 2;
constexpr size_t O_U = O_HB + SZ_HB,                     SZ_U = (size_t)MP * NINP * 4;
constexpr size_t O_ACT = O_U;
constexpr size_t O_AMLA = O_U + SZ_U,                    SZ_AMLA = (size_t)MP * 512 * 2;
constexpr size_t O_QKV = O_AMLA + SZ_AMLA,               SZ_QKV = (size_t)MP * MLAN * 4;
constexpr size_t O_Q = O_QKV + SZ_QKV,                   SZ_Q = (size_t)TSEQ * 768 * 2;
constexpr size_t O_K = O_Q + SZ_Q;
constexpr size_t O_VT = O_K + SZ_Q,                      SZ_VT = (size_t)4 * 128 * TSEQ * 2;
constexpr size_t O_Y = O_VT + SZ_VT,                     SZ_Y = (size_t)MP * D * 2;
constexpr size_t O_XBC = O_Y + SZ_Y,                     SZ_XBC = (size_t)MP * 1024 * 4;
constexpr size_t O_DT = O_XBC + SZ_XBC,                  SZ_DT = (size_t)MP * 8 * 4;
constexpr size_t O_LA = O_DT + SZ_DT;
constexpr size_t O_SST = O_LA + SZ_DT,                   SZ_SST = (size_t)NCH * 8 * 64 * 128 * 4;
constexpr size_t O_SDEC = O_SST + SZ_SST,                SZ_SDEC = (size_t)NCH * 8 * 128;
constexpr size_t O_YZ = O_SDEC + SZ_SDEC,                SZ_YZ = (size_t)MP * 512 * 4;
constexpr size_t O_RQK = O_YZ + SZ_YZ,                   SZ_RQK = (size_t)MP * 512 * 4;
constexpr size_t O_RST = O_RQK + SZ_RQK,                 SZ_RST = (size_t)NCH * 4 * 128 * 64 * 4;
constexpr size_t O_RW = O_RST + SZ_RST,                  SZ_RW1 = (size_t)MP * 512 * 4;
constexpr size_t O_RBON = O_RW + 8 * SZ_RW1,             SZ_RBON = (size_t)MP * 8 * 4;
constexpr size_t O_ROPE = O_RBON + SZ_RBON,              SZ_ROPE = (size_t)MP * 32 * 8;
constexpr size_t O_MATS = O_ROPE + SZ_ROPE,             SZ_MATS = (size_t)129 * 8 * 16384 * 4;
constexpr size_t O_SSTATE = O_RW + 7 * SZ_RW1;
constexpr size_t WS_END = O_MATS + SZ_MATS;
static_assert((size_t)129 * 8 * 4096 * 4 <= SZ_RW1, "sstate");
static_assert(WS_END <= 1424122240ull, "d_ws map too large");
static_assert(O_SS + (size_t)12 * MP * 32 * 4 <= SZ_CTL, "ctl map");
static_assert((size_t)MP * DFF * 2 <= SZ_U, "act overlays u");

constexpr int RING_BYTES = 131072;
constexpr int LDSCTL_OFF = 143360;
constexpr int LDS_BYTES = 147456;

#define LDS_WAIT() asm volatile("s_waitcnt lgkmcnt(0)" ::: "memory")
#define LBAR() do { asm volatile("s_waitcnt lgkmcnt(0)" ::: "memory"); __builtin_amdgcn_s_barrier(); asm volatile("" ::: "memory"); } while (0)
constexpr int CW_QUEUE = 8192;
#define VM_WAIT() asm volatile("s_waitcnt vmcnt(0)" ::: "memory")
__device__ __forceinline__ unsigned f2bf(float f) { unsigned u = __builtin_bit_cast(unsigned, f); return (u + 0x7fffu + ((u >> 16) & 1u)) >> 16; }
__device__ __forceinline__ unsigned pk2(float lo, float hi) { return f2bf(lo) | (f2bf(hi) << 16); }
typedef __bf16 bf16x2_t __attribute__((ext_vector_type(2)));
__device__ __forceinline__ unsigned cvtpk(float lo, float hi) { const f32x2 v = {lo, hi}; return __builtin_bit_cast(unsigned, __builtin_convertvector(v, bf16x2_t)); }
__device__ __forceinline__ int lane_id() { unsigned ones = ~0u; asm volatile("" : "+s"(ones)); return (int)__builtin_amdgcn_mbcnt_hi(ones, __builtin_amdgcn_mbcnt_lo(ones, 0u)); }
template <int CTRL> __device__ __forceinline__ float dpp_(float v) { return __builtin_bit_cast(float, __builtin_amdgcn_update_dpp(0, __builtin_bit_cast(int, v), CTRL, 0xF, 0xF, true)); }
__device__ __forceinline__ float rdlane(float v, int l) { return __builtin_bit_cast(float, __builtin_amdgcn_readlane(__builtin_bit_cast(int, v), l)); }
__device__ __forceinline__ float sum4(float v) { v += dpp_<0xB1>(v); v += dpp_<0x4E>(v); return v; }
__device__ __forceinline__ float sum8(float v) { v = sum4(v); v += dpp_<0x141>(v); return v; }
__device__ __forceinline__ float sum16(float v) { v = sum8(v); v += dpp_<0x140>(v); return v; }
__device__ __forceinline__ float wave_sum(float v) { v = sum16(v); return (rdlane(v, 0) + rdlane(v, 16)) + (rdlane(v, 32) + rdlane(v, 48)); }
__device__ __forceinline__ float sum32(float v, int lane) { v = sum16(v); const float lo = rdlane(v, 0) + rdlane(v, 16), hi = rdlane(v, 32) + rdlane(v, 48); return (lane & 32) ? hi : lo; }
__device__ __forceinline__ float xor32f(float v, int lane) {
    const unsigned x = __builtin_bit_cast(unsigned, v); const auto r = __builtin_amdgcn_permlane32_swap(x, x, false, false);
    return __builtin_bit_cast(float, (lane & 32) ? r[0] : r[1]); }
__device__ __forceinline__ float sigmoidf_(float x) { return 1.0f / (1.0f + __expf(-x)); }
__device__ __forceinline__ float siluf_(float x) { return x / (1.0f + __expf(-x)); }
__device__ __forceinline__ float softplusf_(float x) { return x > 20.f ? x : log1pf(expf(x)); }
struct UB { const bf16* p;
    __device__ __forceinline__ float operator[](size_t i) const { return __builtin_bit_cast(float, (unsigned)p[i] << 16); }
    __device__ __forceinline__ UB operator+(size_t o) const { return UB{p + o}; } };
__device__ __forceinline__ f32x4 ldu4(const UB u) { const v2u w = *(const v2u*)u.p;
    return (f32x4){__builtin_bit_cast(float, w.x << 16), __builtin_bit_cast(float, w.x & 0xffff0000u), __builtin_bit_cast(float, w.y << 16), __builtin_bit_cast(float, w.y & 0xffff0000u)}; }
__device__ __forceinline__ int row_of_seq(int s) { return s < NMETA ? SEQ + s : s - NMETA; }
__device__ __forceinline__ int seq_of_row(int r) { return r >= SEQ ? r - SEQ : r + NMETA; }
__device__ __forceinline__ int prev_row(int r) { return r == SEQ ? -1 : (r == 0 ? T - 1 : r - 1); }
__device__ __forceinline__ int crow(int c, int p) { return c == 0 ? (p >= 112 ? SEQ + p - 112 : -1) : 128 * (c - 1) + p; }
namespace pg8 {
#define PG8_LAS __attribute__((address_space(3)))
typedef unsigned short bf16_t;
typedef short bf16x8 __attribute__((ext_vector_type(8)));
typedef float f32x4 __attribute__((ext_vector_type(4)));
typedef unsigned u32x4 __attribute__((ext_vector_type(4)));
constexpr int BM = 256, BK = 64, HALF = 128, HTB = HALF * BK * 2  , STAGE_BYTES = 8 * HTB, NXCD = 8, WGM = 8;

__host__ __device__ __forceinline__ int lds_byte(int r, int c) { const int st = (r >> 4) * 2 + (c >> 5), rr = r & 15, cc = c & 31, ob = rr * 64 + cc * 2; return st * 1024 + (ob ^ (((ob >> 9) & 1) << 5)); }
__host__ __device__ __forceinline__ void stage_rc(int b, int& R, int& C) { const int st = b / 1024, sb = b % 1024, swz = sb ^ (((sb >> 9) & 1) << 5); R = (st >> 1) * 16 + swz / 64; C = (st & 1) * 32 + (swz % 64) / 2; }
__host__ __device__ __forceinline__ int perm32(int rho) { const int n = rho >> 4, i = rho & 15; return 8 * (i >> 2) + 4 * n + (i & 3); }

struct Unit { int pm, pn, ah; };
struct Gemm { const bf16_t* A; const bf16_t* Bt; int M, N, K, lda, ldb, wv; };

struct StaticOrder {
    int nM, nN, nwg, G, c, lim, hmbase;
    __host__ __device__ void init(int M, int N, int G_, int c_) { nM = M / BM; nN = N / BM; nwg = nM * nN; G = G_; c = c_; lim = nwg; hmbase = -1; }
    __host__ __device__ bool next(int i, Unit& u) const {
        long L; u.ah = 0;
        if (hmbase >= 0) { if (i > 0) return false; L = hmbase + (c >> 1); u.ah = c & 1; if (L >= nwg) return false; }
        else { L = (long)i * G + c; if (L >= lim) return false; }
        int wgid = (int)L; { const int q = nwg / NXCD, r = nwg % NXCD, xcd = wgid % NXCD, off = wgid / NXCD; wgid = (xcd < r ? xcd * (q + 1) : r * (q + 1) + (xcd - r) * q) + off; }
        const int nig = WGM * nN, gid = wgid / nig, fm = gid * WGM, gsz = (nM - fm) < WGM ? (nM - fm) : WGM;
        u.pm = fm + ((wgid % nig) % gsz); u.pn = (wgid % nig) / gsz; return true;
    }
    __device__ __forceinline__ void a_ready(const Unit&) const {}
    __device__ __forceinline__ void done(const Unit&) const {}
};

__device__ __forceinline__ unsigned cvt_pk_bf16(float lo, float hi) { unsigned r; asm volatile("v_cvt_pk_bf16_f32 %0, %1, %2" : "=v"(r) : "v"(lo), "v"(hi)); return r; }

template <class Epi, class Sched, bool ALIGN_EPI = false, bool SP2 = false, bool HM = false>
__device__ __forceinline__ void gemm_phase(PG8_LAS unsigned char* lds, const Gemm g, const Sched& S, const Epi& E) {
    int tid = g.wv * 64 + lane_id(); asm volatile("" : "+v"(tid)); const int wid = g.wv, lane = tid & 63, wr = wid >> 2, wc = wid & 3, fr = lane & 15, fq = lane >> 4;
    const int K = g.K, nt = K / BK;
    unsigned voffA[2], voffB[2];
#pragma unroll
    for (int i = 0; i < 2; ++i) { int R, C; stage_rc(tid * 16 + i * 8192, R, C); const int Rb = Epi::PERM ? ((R & ~31) + perm32(R & 31)) : R;
        voffA[i] = (unsigned)(R * g.lda + C) * 2u; voffB[i] = (unsigned)(Rb * g.ldb + C) * 2u; }
    const size_t kstep = (size_t)(BK * 2);
    const size_t hA = (size_t)HALF * g.lda * 2, hB = (size_t)HALF * g.ldb * 2;
    const size_t tA = 2 * hA, tB = 2 * hB;
    const unsigned ldsw = (unsigned)wid * 1024u;
    const int aoff = lds_byte(wr * 64 + fr, fq * 8), boff = lds_byte(wc * 32 + fr, fq * 8);
#define PG8_SA(b, h) (((b) * 2 + (h)) * HTB)
#define PG8_SB(b, h) ((4 + (b) * 2 + (h)) * HTB)
#define PG8_STAGE(bufoff, gbase, voff) do { _Pragma("unroll") for (int _i = 0; _i < 2; ++_i) \
        __builtin_amdgcn_global_load_lds((const unsigned*)((const char*)(gbase) + (voff)[_i]), (PG8_LAS unsigned*)(lds + (bufoff) + ldsw + _i * 8192), 16, 0, 0); } while (0)
#define PG8_LDA(dst, b, h) do { _Pragma("unroll") for (int m = 0; m < 4; ++m) _Pragma("unroll") for (int k = 0; k < 2; ++k) dst[m][k] = *(const PG8_LAS bf16x8*)(lds + PG8_SA(b, h) + aoff + m * 2048 + k * 1024); } while (0)
#define PG8_LDB(dst, b, h) do { _Pragma("unroll") for (int n = 0; n < 2; ++n) _Pragma("unroll") for (int k = 0; k < 2; ++k) dst[n][k] = *(const PG8_LAS bf16x8*)(lds + PG8_SB(b, h) + boff + n * 2048 + k * 1024); } while (0)
#define PG8_MMA(ai, bj, At, Bt) do { __builtin_amdgcn_s_setprio(1); _Pragma("unroll") for (int m = 0; m < 4; ++m) _Pragma("unroll") for (int n = 0; n < 2; ++n) _Pragma("unroll") for (int k = 0; k < 2; ++k) \
        acc[ai][bj][m][n] = __builtin_amdgcn_mfma_f32_16x16x32_bf16(Bt[n][k], At[m][k], acc[ai][bj][m][n], 0, 0, 0); __builtin_amdgcn_s_setprio(0); } while (0)
#define PG8_WAIT_V(n) asm volatile("s_waitcnt vmcnt(" #n ")" ::: "memory")
#define PG8_WAIT_L(n) asm volatile("s_waitcnt lgkmcnt(" #n ")" ::: "memory")
#define PG8_BAR __builtin_amdgcn_s_barrier()
#define PG8_SCHED __builtin_amdgcn_sched_barrier(0)
    Unit cur, nxt; int ui = 0;
    if (!S.next(0, cur)) return;
    f32x4 acc[2][2][4][2];
#pragma unroll
    for (int a = 0; a < 2; ++a)
#pragma unroll
        for (int b = 0; b < 2; ++b)
#pragma unroll
            for (int m = 0; m < 4; ++m)
#pragma unroll
                for (int n = 0; n < 2; ++n) acc[a][b][m][n] = (f32x4){0.f, 0.f, 0.f, 0.f};
    bf16x8 At[4][2], B0[2][2], B1[2][2];
    const char* cA = (const char*)g.A + (size_t)cur.pm * tA + (size_t)cur.ah * hA; const char* cB = (const char*)g.Bt + (size_t)cur.pn * tB;
    S.a_ready(cur);
    if constexpr (SP2) {
        PG8_STAGE(PG8_SB(0, 0), cB, voffB); PG8_STAGE(PG8_SB(0, 1), cB + hB, voffB); PG8_STAGE(PG8_SA(0, 0), cA, voffA); PG8_STAGE(PG8_SA(0, 1), cA + hA, voffA);
        if (wr == 1) PG8_BAR;
        PG8_WAIT_V(2); PG8_BAR;
        PG8_STAGE(PG8_SB(1, 0), cB + kstep, voffB); PG8_STAGE(PG8_SA(1, 0), cA + kstep, voffA); PG8_STAGE(PG8_SB(1, 1), cB + hB + kstep, voffB);
        PG8_WAIT_V(6); PG8_BAR;
    } else {
        PG8_STAGE(PG8_SB(0, 0), cB, voffB); PG8_STAGE(PG8_SA(0, 0), cA, voffA); PG8_STAGE(PG8_SB(0, 1), cB + hB, voffB); PG8_STAGE(PG8_SA(0, 1), cA + hA, voffA);
        if (wr == 1) PG8_BAR;
        PG8_WAIT_V(4); PG8_BAR;
        PG8_STAGE(PG8_SB(1, 0), cB + kstep, voffB); PG8_STAGE(PG8_SA(1, 0), cA + kstep, voffA); PG8_STAGE(PG8_SB(1, 1), cB + hB + kstep, voffB);
        PG8_WAIT_V(6); PG8_BAR;
    }
    for (;;) {
        const bool has_next = S.next(ui + 1, nxt);
        const char* nA = has_next ? (const char*)g.A + (size_t)nxt.pm * tA + (size_t)nxt.ah * hA : cA; const char* nB = has_next ? (const char*)g.Bt + (size_t)nxt.pn * tB : cB;
        for (int t = 0; t < nt; t += 2) {
            const bool last = (t == nt - 2);
            const char* a1 = cA + (size_t)(t + 1) * kstep;
            const char* a2 = last ? nA : cA + (size_t)(t + 2) * kstep; const char* b2 = last ? nB : cB + (size_t)(t + 2) * kstep;
            const char* a3 = a2 + kstep; const char* b3 = b2 + kstep;
            if (last && has_next) S.a_ready(nxt);
            if constexpr (SP2) {
            PG8_LDB(B0, 0, 0); PG8_LDB(B1, 0, 1); PG8_SCHED; PG8_LDA(At, 0, 0); PG8_STAGE(PG8_SA(1, 1), a1 + hA, voffA);
            PG8_WAIT_V(8); PG8_WAIT_L(0); PG8_BAR; PG8_MMA(0, 0, At, B0); PG8_MMA(0, 1, At, B1); PG8_BAR; PG8_SCHED;
            if constexpr (!HM) PG8_LDA(At, 0, 1); PG8_STAGE(PG8_SB(0, 0), b2, voffB); PG8_STAGE(PG8_SB(0, 1), b2 + hB, voffB); PG8_STAGE(PG8_SA(0, 0), a2, voffA);
            PG8_WAIT_V(8); PG8_WAIT_L(0); PG8_BAR; if constexpr (!HM) { PG8_MMA(1, 0, At, B0); PG8_MMA(1, 1, At, B1); } PG8_BAR; PG8_SCHED;
            PG8_LDB(B0, 1, 0); PG8_LDB(B1, 1, 1); PG8_SCHED; PG8_LDA(At, 1, 0); PG8_STAGE(PG8_SA(0, 1), a2 + hA, voffA);
            PG8_WAIT_V(8); PG8_WAIT_L(0); PG8_BAR; PG8_MMA(0, 0, At, B0); PG8_MMA(0, 1, At, B1); PG8_BAR; PG8_SCHED;
            if constexpr (!HM) PG8_LDA(At, 1, 1); PG8_STAGE(PG8_SB(1, 0), b3, voffB); PG8_STAGE(PG8_SB(1, 1), b3 + hB, voffB); PG8_STAGE(PG8_SA(1, 0), a3, voffA);
            PG8_WAIT_V(8); PG8_WAIT_L(0); PG8_BAR; if constexpr (!HM) { PG8_MMA(1, 0, At, B0); PG8_MMA(1, 1, At, B1); } PG8_BAR; PG8_SCHED;
            } else {
            PG8_LDB(B0, 0, 0); PG8_SCHED; PG8_LDA(At, 0, 0); PG8_STAGE(PG8_SA(1, 1), a1 + hA, voffA);
            PG8_WAIT_L(8); PG8_BAR; PG8_WAIT_L(0); PG8_MMA(0, 0, At, B0); PG8_BAR; PG8_SCHED;
            PG8_LDB(B1, 0, 1); PG8_STAGE(PG8_SB(0, 0), b2, voffB);
            PG8_BAR; PG8_WAIT_L(0); PG8_MMA(0, 1, At, B1); PG8_BAR;
            PG8_LDA(At, 0, 1); PG8_STAGE(PG8_SA(0, 0), a2, voffA);
            PG8_BAR; PG8_WAIT_L(0); PG8_MMA(1, 0, At, B0); PG8_BAR; PG8_SCHED;
            PG8_STAGE(PG8_SB(0, 1), b2 + hB, voffB);
            PG8_WAIT_V(6); PG8_BAR; PG8_MMA(1, 1, At, B1); PG8_BAR;
            PG8_LDB(B0, 1, 0); PG8_SCHED; PG8_LDA(At, 1, 0); PG8_STAGE(PG8_SA(0, 1), a2 + hA, voffA);
            PG8_WAIT_L(8); PG8_BAR; PG8_WAIT_L(0); PG8_MMA(0, 0, At, B0); PG8_BAR; PG8_SCHED;
            PG8_LDB(B1, 1, 1); PG8_STAGE(PG8_SB(1, 0), b3, voffB);
            PG8_BAR; PG8_WAIT_L(0); PG8_MMA(0, 1, At, B1); PG8_BAR;
            PG8_LDA(At, 1, 1); PG8_STAGE(PG8_SA(1, 0), a3, voffA);
            PG8_BAR; PG8_WAIT_L(0); PG8_MMA(1, 0, At, B0); PG8_BAR; PG8_SCHED;
            PG8_STAGE(PG8_SB(1, 1), b3 + hB, voffB);
            PG8_WAIT_V(6); PG8_BAR; PG8_MMA(1, 1, At, B1); PG8_BAR;
            }
        }
        if constexpr (ALIGN_EPI) { if (wr == 0) PG8_BAR; }
        if constexpr (!Epi::AFTER_DRAIN) { E(acc, cur, wr, wc, fr, fq); S.done(cur); }
        if (!has_next) break;
#pragma unroll
        for (int a = 0; a < 2; ++a)
#pragma unroll
            for (int b = 0; b < 2; ++b)
#pragma unroll
                for (int m = 0; m < 4; ++m)
#pragma unroll
                    for (int n = 0; n < 2; ++n) acc[a][b][m][n] = (f32x4){0.f, 0.f, 0.f, 0.f};
        cur = nxt; cA = nA; cB = nB; ++ui;
        if constexpr (ALIGN_EPI) { if (wr == 1) PG8_BAR; }
    }
    PG8_WAIT_V(0);
    if constexpr (!ALIGN_EPI) { if (wr == 0) PG8_BAR; }
    PG8_BAR;
    if constexpr (Epi::AFTER_DRAIN) { E.fused(acc, cur, wr, wc, fr, fq, lds, wid, lane); S.done(cur); }
#undef PG8_SA
#undef PG8_SB
#undef PG8_STAGE
#undef PG8_LDA
#undef PG8_LDB
#undef PG8_MMA
#undef PG8_WAIT_V
#undef PG8_WAIT_L
#undef PG8_BAR
#undef PG8_SCHED
}

__device__ __forceinline__ float row_ss(const float* ss, int row, int fq) {
    const f32x4 a = *(const f32x4*)(ss + (size_t)row * 32 + 8 * fq), b = *(const f32x4*)(ss + (size_t)row * 32 + 8 * fq + 4);
    float s = ((a[0] + a[1]) + (a[2] + a[3])) + ((b[0] + b[1]) + (b[2] + b[3]));
    s += __shfl_xor(s, 16); s += __shfl_xor(s, 32); return s;
}
struct EpiScaleF32 {
    static constexpr bool PERM = false, AFTER_DRAIN = false;
    float* C; int ldc; const float* ss; float inv_d, eps;
    __device__ __forceinline__ void operator()(const f32x4 (&acc)[2][2][4][2], const Unit& u, int wr, int wc, int fr, int fq) const {
        const int row0 = u.pm * BM + wr * 64 + fr, col0 = u.pn * BM + wc * 32 + 4 * fq;
#pragma unroll
        for (int ai = 0; ai < 2; ++ai)
#pragma unroll
            for (int m = 0; m < 4; ++m) { const int row = row0 + ai * HALF + m * 16; float* rowp = C + (size_t)row * ldc + col0;
                const float rs = ss ? __builtin_amdgcn_rsqf(row_ss(ss, row, fq) * inv_d + eps) : 1.0f;
#pragma unroll
                for (int bj = 0; bj < 2; ++bj)
#pragma unroll
                    for (int n = 0; n < 2; ++n) *(f32x4*)(rowp + bj * HALF + n * 16) = acc[ai][bj][m][n] * rs; }
    }
};
struct EpiScaleBf16 {
    static constexpr bool PERM = true, AFTER_DRAIN = false;
    bf16_t* O; int ldo; const float* ss; float inv_d, eps;
    __device__ __forceinline__ void operator()(const f32x4 (&acc)[2][2][4][2], const Unit& u, int wr, int wc, int fr, int fq) const {
        const int row0 = u.pm * BM + wr * 64 + fr, col0 = u.pn * BM + wc * 32 + 8 * fq;
#pragma unroll
        for (int ai = 0; ai < 2; ++ai)
#pragma unroll
            for (int m = 0; m < 4; ++m) { const int row = row0 + ai * HALF + m * 16; const float rs = __builtin_amdgcn_rsqf(row_ss(ss, row, fq) * inv_d + eps);
#pragma unroll
                for (int bj = 0; bj < 2; ++bj) { const f32x4 v0 = acc[ai][bj][m][0] * rs, v1 = acc[ai][bj][m][1] * rs;
                    u32x4 w; w.x = cvt_pk_bf16(v0[0], v0[1]); w.y = cvt_pk_bf16(v0[2], v0[3]); w.z = cvt_pk_bf16(v1[0], v1[1]); w.w = cvt_pk_bf16(v1[2], v1[3]);
                    *(u32x4*)(O + (size_t)row * ldo + col0 + bj * HALF) = w; } }
    }
};
struct EpiSwiGLU {
    static constexpr bool PERM = true, AFTER_DRAIN = false;
    bf16_t* O; int ldo; const float* ss; float inv_d, eps; int nai;
    __device__ __forceinline__ void operator()(const f32x4 (&acc)[2][2][4][2], const Unit& u, int wr, int wc, int fr, int fq) const {
        const int row0 = u.pm * BM + u.ah * HALF + wr * 64 + fr, col0 = u.pn * HALF + wc * 32 + 8 * fq;
#pragma unroll
        for (int ai = 0; ai < 2; ++ai) { if (ai >= nai) break;
#pragma unroll
            for (int m = 0; m < 4; ++m) { const int row = row0 + ai * HALF + m * 16;
                const float rs = __builtin_amdgcn_rsqf(row_ss(ss, row, fq) * inv_d + eps);
                float o[8];
#pragma unroll
                for (int n = 0; n < 2; ++n)
#pragma unroll
                    for (int j = 0; j < 4; ++j) { const float gv = acc[ai][0][m][n][j] * rs, uv = acc[ai][1][m][n][j] * rs; o[n * 4 + j] = gv * uv * __builtin_amdgcn_rcpf(1.0f + __expf(-gv)); }
                u32x4 w; w.x = cvt_pk_bf16(o[0], o[1]); w.y = cvt_pk_bf16(o[2], o[3]); w.z = cvt_pk_bf16(o[4], o[5]); w.w = cvt_pk_bf16(o[6], o[7]);
                *(u32x4*)(O + (size_t)row * ldo + col0) = w; } }
    }
};
__device__ __forceinline__ float bflo(unsigned w) { return __builtin_bit_cast(float, w << 16); }
__device__ __forceinline__ float bfhi(unsigned w) { return __builtin_bit_cast(float, w & 0xffff0000u); }
struct EpiResidual {
    static constexpr bool PERM = true, AFTER_DRAIN = false;
    bf16_t* HL; bf16_t* HB; float* ss_out; float* out; int out_rows; float scale;
    __device__ __forceinline__ void operator()(const f32x4 (&acc)[2][2][4][2], const Unit& u, int wr, int wc, int fr, int fq) const {
        const int row0 = u.pm * BM + wr * 64 + fr, col0 = u.pn * BM + wc * 32 + 8 * fq;
#pragma unroll
        for (int ai = 0; ai < 2; ++ai)
#pragma unroll
            for (int m = 0; m < 4; ++m) { const int row = row0 + ai * HALF + m * 16; float sq = 0.f;
#pragma unroll
                for (int bj = 0; bj < 2; ++bj) { const size_t off = (size_t)row * 2048 + col0 + bj * HALF;
                    const u32x4 hi = *(const u32x4*)(HB + off), lo = *(const u32x4*)(HL + off);
                    f32x4 h0 = (f32x4){bflo(hi.x) + bflo(lo.x), bfhi(hi.x) + bfhi(lo.x), bflo(hi.y) + bflo(lo.y), bfhi(hi.y) + bfhi(lo.y)};
                    f32x4 h1 = (f32x4){bflo(hi.z) + bflo(lo.z), bfhi(hi.z) + bfhi(lo.z), bflo(hi.w) + bflo(lo.w), bfhi(hi.w) + bfhi(lo.w)};
                    h0 = h0 + acc[ai][bj][m][0] * scale; h1 = h1 + acc[ai][bj][m][1] * scale;
                    if (out && row < out_rows) { *(f32x4*)(out + off) = h0; *(f32x4*)(out + off + 4) = h1; }
                    u32x4 w; w.x = cvt_pk_bf16(h0[0], h0[1]); w.y = cvt_pk_bf16(h0[2], h0[3]); w.z = cvt_pk_bf16(h1[0], h1[1]); w.w = cvt_pk_bf16(h1[2], h1[3]);
                    u32x4 l2; l2.x = cvt_pk_bf16(h0[0] - bflo(w.x), h0[1] - bfhi(w.x)); l2.y = cvt_pk_bf16(h0[2] - bflo(w.y), h0[3] - bfhi(w.y)); l2.z = cvt_pk_bf16(h1[0] - bflo(w.z), h1[1] - bfhi(w.z)); l2.w = cvt_pk_bf16(h1[2] - bflo(w.w), h1[3] - bfhi(w.w));
                    *(u32x4*)(HB + off) = w; *(u32x4*)(HL + off) = l2;
                    sq += (h0[0] * h0[0] + h0[1] * h0[1]) + (h0[2] * h0[2] + h0[3] * h0[3]) + (h1[0] * h1[0] + h1[1] * h1[1]) + (h1[2] * h1[2] + h1[3] * h1[3]); }
                sq += __shfl_xor(sq, 16); sq += __shfl_xor(sq, 32);
                if (fq == 0 && ss_out) __hip_atomic_fetch_add(ss_out + (size_t)row * 32 + u.pn * 4 + wc, sq, __ATOMIC_RELAXED, __HIP_MEMORY_SCOPE_AGENT); }
    }
};
}
#define XB_TMO      128
#define XB_XCNT(j)  (256  + 64 * (j))
#define XB_XSUB(j)  (1280 + 64 * (j))
#define XB_XGEN(j)  (2304 + 64 * (j))
#define XB_TOP      3328
#define XB_TOPGEN   3392
#define XCD_BAR_WORDS 3456
#define XB_SPIN_CAP (1u << 18)

__device__ __forceinline__ unsigned xb_ld(unsigned* p)              { return __hip_atomic_load(p, __ATOMIC_RELAXED, __HIP_MEMORY_SCOPE_AGENT); }
__device__ __forceinline__ unsigned xb_add(unsigned* p, unsigned v) { return __hip_atomic_fetch_add(p, v, __ATOMIC_RELAXED, __HIP_MEMORY_SCOPE_AGENT); }
__device__ __forceinline__ unsigned xb_xcc_id() { return (unsigned)__builtin_amdgcn_s_getreg((3 << 11) | 20) & 0xFu; }
#define XB_SPIN(cond, bar) do { unsigned _sp = 0; while (cond) { __builtin_amdgcn_s_sleep(1); \
    if ((++_sp & 255u) == 0u) { if (xb_ld(&(bar)[XB_TMO])) break; if (_sp > XB_SPIN_CAP) { atomicAdd(&(bar)[XB_TMO], 1u); break; } } } } while (0)

struct XcdBarrier {
    unsigned* bar; unsigned x;
    volatile LAS unsigned* st;
};

__device__ __forceinline__ XcdBarrier xcd_barrier_post(unsigned* bar, volatile LAS unsigned* st, int wv) {
    XcdBarrier b; b.bar = bar; b.x = xb_xcc_id(); b.st = st;
    if ((wv == 0 && lane_id() == 0)) (void)xb_add(&bar[XB_XCNT(b.x)], 1u);
    return b;
}
__device__ __forceinline__ void xcd_barrier_complete(unsigned* bar, unsigned x, unsigned& nloc, unsigned& nx) {
    const unsigned G = gridDim.x * gridDim.y * gridDim.z;
    unsigned sum, cnt, mine, sp = 0u;
    for (;;) {
        sum = 0u; cnt = 0u; mine = 0u;
#pragma unroll
        for (unsigned j = 0; j < 16; ++j) { const unsigned c = xb_ld(&bar[XB_XCNT(j)]); sum += c; cnt += (c > 0u) ? 1u : 0u; mine = (j == x) ? c : mine; }
        if (sum == G) break;
        __builtin_amdgcn_s_sleep(1);
        if ((++sp & 255u) == 0u) { if (xb_ld(&bar[XB_TMO])) break; if (sp > XB_SPIN_CAP) { atomicAdd(&bar[XB_TMO], 1u); break; } }
    }
    nloc = mine > 0u ? mine : 1u; nx = cnt > 0u ? cnt : 1u;
}

__device__ __forceinline__ void xcd_barrier(const XcdBarrier& b, int wv) {
    asm volatile("s_waitcnt vmcnt(0)" ::: "memory");
    __syncthreads();
    if ((wv == 0 && lane_id() == 0)) {
        unsigned* bar = b.bar;
        __builtin_amdgcn_s_waitcnt(0);
        unsigned nloc = b.st[0], nx = b.st[1];
        if (nloc == 0u) { xcd_barrier_complete(bar, b.x, nloc, nx); b.st[0] = nloc; b.st[1] = nx; }
        const unsigned old = xb_add(&bar[XB_XSUB(b.x)], 1u);
        const unsigned gen = old / nloc;
        if (old + 1u == (gen + 1u) * nloc) {
            __builtin_amdgcn_fence(__ATOMIC_RELEASE, "agent");
            asm volatile("s_waitcnt vmcnt(0)" ::: "memory");
            const unsigned og = xb_add(&bar[XB_TOP], 1u);
            const unsigned tg = og / nx;
            if (og + 1u == (tg + 1u) * nx) xb_add(&bar[XB_TOPGEN], 1u);
            else XB_SPIN(xb_ld(&bar[XB_TOPGEN]) == tg, bar);
            __builtin_amdgcn_fence(__ATOMIC_ACQUIRE, "agent");
            xb_add(&bar[XB_XGEN(b.x)], 1u);
            asm volatile("s_waitcnt vmcnt(0)" ::: "memory");
        } else {
            XB_SPIN(xb_ld(&bar[XB_XGEN(b.x)]) == gen, bar);
            __builtin_amdgcn_fence(__ATOMIC_ACQUIRE, "agent");
            asm volatile("s_waitcnt vmcnt(0)" ::: "memory");
        }
    }
    __syncthreads();
}

struct P { const float* in[36]; float* out; unsigned char* ws; int ph_lo, ph_hi; };
enum { I_X = 0, I_META, I_F1N, I_F1G, I_F1U, I_F1D, I_MIXN, I_WIN, I_WOUT, I_QN, I_WQ, I_KVN, I_WKV, I_QKNQ, I_QKNK, I_CONVW, I_CONVB, I_DTB, I_ALOG, I_SSDD, I_SSDN, I_RETN,
       I_MU, I_W0, I_W2, I_A0, I_A2, I_G2, I_KK, I_KA, I_RK, I_LN, I_F2N, I_F2G, I_F2U, I_F2D };
#define CAS __attribute__((address_space(4)))
typedef const CAS P* KPtr;
struct Ctx { LAS unsigned char* lds; unsigned char* ws; KPtr kp; int tid, lane, wave, G, bid; };
__device__ __forceinline__ Ctx ctx_make(LAS unsigned char* lds, int wv) {
    Ctx F; KPtr kp = (KPtr)__builtin_amdgcn_kernarg_segment_ptr(); asm volatile("" : "+s"(kp)); int t = wv * 64 + lane_id(); asm volatile("" : "+v"(t));
    F.lds = lds; F.kp = kp; F.ws = kp->ws; F.tid = t; F.lane = t & 63; F.wave = __builtin_amdgcn_readfirstlane(t >> 6); F.G = gridDim.x; F.bid = blockIdx.x; return F;
}


__device__ __forceinline__ int queue_next(const Ctx& F, unsigned* ctr) {
    volatile LAS unsigned* slot = (volatile LAS unsigned*)(F.lds + LDSCTL_OFF + 64);
    __syncthreads();
    if (F.tid == 0) *slot = __hip_atomic_fetch_add(ctr, 1u, __ATOMIC_RELAXED, __HIP_MEMORY_SCOPE_AGENT);
    __syncthreads();
    return (int)*slot;
}
__device__ __forceinline__ f32x16 zero16() { f32x16 z;
#pragma unroll
    for (int i = 0; i < 16; ++i) z[i] = 0.f; return z; }
__device__ __forceinline__ void mma32(f32x16& acc, const LAS float* Ap, int sAi, int sAk, const LAS float* Bp, int sBk, int sBj, int K, int lane) {
    const int r = lane & 31, hh = lane >> 5;
    const LAS float* a = Ap + r * sAi + hh * sAk; const LAS float* b = Bp + hh * sBk + r * sBj;
#pragma unroll 4
    for (int k = 0; k < K; k += 2) acc = __builtin_amdgcn_mfma_f32_32x32x2f32(a[k * sAk], b[k * sBk], acc, 0, 0, 0);
}
__device__ __forceinline__ void mma32bf(f32x16& acc, const LAS float* Ap, int sAi, const LAS float* Bp, int sBj, int K, int lane) {
    const int r = lane & 31, hh = lane >> 5; const LAS float* a = Ap + r * sAi + 8 * hh; const LAS float* b = Bp + r * sBj + 8 * hh;
#pragma unroll 2
    for (int k = 0; k < K; k += 16) { const f32x4 a0 = *(const LAS f32x4*)(a + k), a1 = *(const LAS f32x4*)(a + k + 4), b0 = *(const LAS f32x4*)(b + k), b1 = *(const LAS f32x4*)(b + k + 4);
        v4u aw, bw; aw.x = cvtpk(a0[0], a0[1]); aw.y = cvtpk(a0[2], a0[3]); aw.z = cvtpk(a1[0], a1[1]); aw.w = cvtpk(a1[2], a1[3]); bw.x = cvtpk(b0[0], b0[1]); bw.y = cvtpk(b0[2], b0[3]); bw.z = cvtpk(b1[0], b1[1]); bw.w = cvtpk(b1[2], b1[3]);
        acc = __builtin_amdgcn_mfma_f32_32x32x16_bf16(__builtin_bit_cast(bf16x8, aw), __builtin_bit_cast(bf16x8, bw), acc, 0, 0, 0); }
}
__device__ __forceinline__ int rreg(int reg, int lane) { return (reg & 3) + 8 * (reg >> 2) + 4 * (lane >> 5); }

__device__ __forceinline__ void cvt_tile(const float* src, int srcN, const float* gain, int valid, bf16* dst, int ldd, LAS float* scr, int lane) {
    const int c4 = lane & 15, r0 = lane >> 4;
    f32x4 v[16];
#pragma unroll
    for (int i = 0; i < 16; ++i) v[i] = (4 * c4 < valid) ? *(const f32x4*)(src + (size_t)(r0 + 4 * i) * srcN + 4 * c4) : (f32x4){0.f, 0.f, 0.f, 0.f};
#pragma unroll
    for (int i = 0; i < 16; ++i) { const int kk = r0 + 4 * i; const float gk = gain ? gain[kk] : 1.0f; LAS float* d = scr + kk * 65 + 4 * c4; d[0] = v[i][0] * gk; d[1] = v[i][1] * gk; d[2] = v[i][2] * gk; d[3] = v[i][3] * gk; }
    LDS_WAIT(); asm volatile("" ::: "memory");
    const int c8 = lane & 7;
#pragma unroll
    for (int j = 0; j < 8; ++j) { const int n = (lane >> 3) + 8 * j; const LAS float* s = scr + (8 * c8) * 65 + n;
        v4u o; o.x = pk2(s[0], s[65]); o.y = pk2(s[130], s[195]); o.z = pk2(s[260], s[325]); o.w = pk2(s[390], s[455]);
        *(v4u*)(dst + (size_t)n * ldd + 8 * c8) = o; }
    LDS_WAIT(); asm volatile("" ::: "memory");
}
__device__ __forceinline__ void convert_layer(const Ctx& F, int L, int gw, int NGW) {
    LAS float* scr = (LAS float*)(F.lds + F.wave * 17408);
    const int lane = F.lane;
    constexpr int IT_GU = 2 * 32 * 176, IT_D = 2 * 88 * 32, IT_IN = 32 * 84, IT_OUT = 32 * 32, IT_MLA = 8 * 28;
    bf16* WGU = (bf16*)(F.ws + O_WGU); bf16* WD = (bf16*)(F.ws + O_WD); bf16* WIN = (bf16*)(F.ws + O_WIN); bf16* WOUT = (bf16*)(F.ws + O_WOUT); bf16* WMLA = (bf16*)(F.ws + O_WMLA);
    const int l = L;
    for (int it = gw; it < IT_GU + IT_D + IT_IN + IT_OUT + IT_MLA; it += NGW) {
        int r = it;
        if (r < IT_GU) { const int which = r / 5632, f = 2 * l + which, q = r % 5632, kb = q / 176, nb = q % 176, n0 = 64 * nb, pn = n0 >> 8, within = n0 & 255, isup = within >= 128, f0 = 128 * pn + (within & 127);
            const float* src = (which ? (isup ? F.kp->in[I_F2U] : F.kp->in[I_F2G]) : (isup ? F.kp->in[I_F1U] : F.kp->in[I_F1G])) + (size_t)l * D * DFF + (size_t)(64 * kb) * DFF + f0;
            const float* gain = (which ? F.kp->in[I_F2N] : F.kp->in[I_F1N]) + l * D + 64 * kb;
            cvt_tile(src, DFF, gain, 64, WGU + (size_t)f * 11264 * 2048 + (size_t)n0 * 2048 + 64 * kb, 2048, scr, lane); continue; }
        r -= IT_GU;
        if (r < IT_D) { const int which = r / 2816, f = 2 * l + which, q = r % 2816, kb = q / 32, nb = q % 32;
            const float* src = (which ? F.kp->in[I_F2D] : F.kp->in[I_F1D]) + (size_t)l * DFF * D + (size_t)(64 * kb) * D + 64 * nb;
            cvt_tile(src, D, nullptr, 64, WD + (size_t)f * 2048 * 5632 + (size_t)(64 * nb) * 5632 + 64 * kb, 5632, scr, lane); continue; }
        r -= IT_D;
        if (r < IT_IN) { const int q = r, kb = q / 84, nb = q % 84, n0 = 64 * nb; int valid = NIN - n0; valid = valid < 0 ? 0 : (valid > 64 ? 64 : valid);
            const float* src = F.kp->in[I_WIN] + (size_t)l * D * NIN + (size_t)(64 * kb) * NIN + n0;
            cvt_tile(src, NIN, F.kp->in[I_MIXN] + l * D + 64 * kb, valid, WIN + (size_t)l * NINP * D + (size_t)n0 * D + 64 * kb, D, scr, lane); continue; }
        r -= IT_IN;
        if (r < IT_OUT) { const int q = r, kb = q / 32, nb = q % 32;
            const float* src = F.kp->in[I_WOUT] + (size_t)l * D * D + (size_t)(64 * kb) * D + 64 * nb;
            cvt_tile(src, D, nullptr, 64, WOUT + (size_t)l * D * D + (size_t)(64 * nb) * D + 64 * kb, D, scr, lane); continue; }
        r -= IT_OUT;
        { const int q = r, kb = q / 28, nb = q % 28, n0 = 64 * nb, k0 = 64 * kb;
            const float* src; int srcN, valid;
            if (n0 < 768) { valid = k0 < 384 ? 64 : 0; src = F.kp->in[I_WQ] + (size_t)l * 384 * 768 + (size_t)k0 * 768 + n0; srcN = 768; }
            else { valid = k0 >= 384 ? 64 : 0; src = F.kp->in[I_WKV] + (size_t)l * 128 * 1024 + (size_t)(k0 - 384) * 1024 + (n0 - 768); srcN = 1024; }
            cvt_tile(src, srcN, nullptr, valid, WMLA + (size_t)l * MLAN * 512 + (size_t)n0 * 512 + k0, 512, scr, lane); }
    }
}
__device__ __forceinline__ void p0_prologue(const Ctx& F, int cvt_only) {
    const int gw = F.bid * NWAVES + F.wave, NGW = F.G * NWAVES, lane = F.lane;
    convert_layer(F, 0, gw, NGW);
    if (cvt_only) return;
    bf16* HL = (bf16*)(F.ws + O_H); bf16* HB = (bf16*)(F.ws + O_HB); float* SS = (float*)(F.ws + O_SS); bf16* Y = (bf16*)(F.ws + O_Y); f32x2* ROPE = (f32x2*)(F.ws + O_ROPE);
    for (int row = gw; row < MP; row += NGW) {
        const float* src = row < SEQ ? F.kp->in[I_X] + (size_t)row * D : F.kp->in[I_META] + (size_t)(row - SEQ) * D;
        float sq = 0.f;
#pragma unroll
        for (int j = 0; j < 8; ++j) { f32x4 v = (f32x4){0.f, 0.f, 0.f, 0.f}; if (row < T) v = *(const f32x4*)(src + 256 * j + 4 * lane);
            v2u w; w.x = cvtpk(v[0], v[1]); w.y = cvtpk(v[2], v[3]); *(v2u*)(HB + (size_t)row * D + 256 * j + 4 * lane) = w;
            v2u lw; lw.x = cvtpk(v[0] - pg8::bflo(w.x), v[1] - pg8::bfhi(w.x)); lw.y = cvtpk(v[2] - pg8::bflo(w.y), v[3] - pg8::bfhi(w.y)); *(v2u*)(HL + (size_t)row * D + 256 * j + 4 * lane) = lw;
            sq += (v[0] * v[0] + v[1] * v[1]) + (v[2] * v[2] + v[3] * v[3]); }
        sq = wave_sum(sq); if (lane == 0) __hip_atomic_fetch_add(SS + (size_t)row * 32, sq, __ATOMIC_RELAXED, __HIP_MEMORY_SCOPE_AGENT);
#ifdef PROBE_ZERO_Y
        if (true) {
#else
        if (row >= T) {
#endif
#pragma unroll
            for (int j = 0; j < 4; ++j) *(v4u*)(Y + (size_t)row * D + 512 * j + 8 * lane) = (v4u){0u, 0u, 0u, 0u}; }
#ifdef PROBE_ZERO_Y
        if (row < T && lane < 32) { const float inv = powf(10000.0f, -(float)lane / 32.0f); const float ang = (float)seq_of_row(row) * inv; float sn, cs; sincosf(ang, &sn, &cs); ROPE[row * 32 + lane] = (f32x2){cs, sn}; }
#else
        else if (lane < 32) { const float inv = powf(10000.0f, -(float)lane / 32.0f); const float ang = (float)seq_of_row(row) * inv; float sn, cs; sincosf(ang, &sn, &cs); ROPE[row * 32 + lane] = (f32x2){cs, sn}; }
#endif
    }
}

__device__ __forceinline__ void m1_unit(const Ctx& F, int l, int r0, int r1, int grp) {
    const int lane = F.lane, tid = F.tid;
    const float* U = (const float*)(F.ws + O_U);
    if (r0 < r1) { bf16* AM = (bf16*)(F.ws + O_AMLA); const float* qn = F.kp->in[I_QN] + l * 384; const float* kvn = F.kp->in[I_KVN] + l * 128;
      const float* gp = lane < 48 ? qn + 8 * lane : kvn + 8 * (lane - 48); const f32x4 g0 = *(const f32x4*)gp, g1 = *(const f32x4*)(gp + 4);
      f32x4 a4[4], b4[4];
#pragma unroll
      for (int i = 0; i < 4; ++i) { const int row = r0 + F.wave + 8 * i; const float* ur = U + (size_t)(row < r1 ? row : r0) * NINP + 8 * lane; a4[i] = *(const f32x4*)ur; b4[i] = *(const f32x4*)(ur + 4); }
#pragma unroll
      for (int i = 0; i < 4; ++i) { const int row = r0 + F.wave + 8 * i; const f32x4 a = a4[i], b = b4[i];
        const float sq = (a[0] * a[0] + a[1] * a[1]) + (a[2] * a[2] + a[3] * a[3]) + (b[0] * b[0] + b[1] * b[1]) + (b[2] * b[2] + b[3] * b[3]);
        const float sq_q = wave_sum(lane < 48 ? sq : 0.f), sq_kv = wave_sum(lane >= 48 ? sq : 0.f);
        const float rs = lane < 48 ? 1.0f / sqrtf(sq_q * (1.0f / 384.0f) + EPS) : 1.0f / sqrtf(sq_kv * (1.0f / 128.0f) + EPS);
        v4u w; w.x = pk2(a[0] * rs * g0[0], a[1] * rs * g0[1]); w.y = pk2(a[2] * rs * g0[2], a[3] * rs * g0[3]); w.z = pk2(b[0] * rs * g1[0], b[1] * rs * g1[1]); w.w = pk2(b[2] * rs * g1[2], b[3] * rs * g1[3]);
        if (row < r1) *(v4u*)(AM + (size_t)row * 512 + 8 * lane) = w; } }
    if (r0 < r1) { float* RQK = (float*)(F.ws + O_RQK); const f32x2* ROPE = (const f32x2*)(F.ws + O_ROPE);
      f32x2 cs[4][4]; float x1[4][4], x2[4][4];
#pragma unroll
      for (int i = 0; i < 4; ++i) { const int row = r0 + F.wave + 8 * i, rc = row < r1 ? row : r0;
#pragma unroll
        for (int j = 0; j < 4; ++j) { const int idx = lane + 64 * j, qk = idx >> 7, hh = (idx >> 5) & 3, i5 = idx & 31; cs[i][j] = ROPE[rc * 32 + i5];
            x1[i][j] = U[(size_t)rc * NINP + U_RET + qk * 256 + hh * 64 + i5]; x2[i][j] = U[(size_t)rc * NINP + U_RET + qk * 256 + hh * 64 + 32 + i5]; } }
#pragma unroll
      for (int i = 0; i < 4; ++i) { const int row = r0 + F.wave + 8 * i; if (row < r1) {
#pragma unroll
        for (int j = 0; j < 4; ++j) { const int idx = lane + 64 * j, qk = idx >> 7, hh = (idx >> 5) & 3, i5 = idx & 31; const float sc = qk ? 0.125f : 1.0f;
            RQK[(size_t)row * 512 + qk * 256 + hh * 64 + i5] = (x1[i][j] * cs[i][j].x - x2[i][j] * cs[i][j].y) * sc; RQK[(size_t)row * 512 + qk * 256 + hh * 64 + 32 + i5] = (x1[i][j] * cs[i][j].y + x2[i][j] * cs[i][j].x) * sc; } } } }
    if (r0 < r1) { float* XBC = (float*)(F.ws + O_XBC); float* DT = (float*)(F.ws + O_DT); float* LA = (float*)(F.ws + O_LA);
      const float* cw = F.kp->in[I_CONVW] + l * 4096; const float* cb = F.kp->in[I_CONVB] + l * 1024;
      int rw[4], p1[4], p2[4], p3[4]; float dtr[4];
#pragma unroll
      for (int i = 0; i < 4; ++i) { const int row = r0 + F.wave + 8 * i; rw[i] = row < r1 ? row : r0; p1[i] = prev_row(rw[i]); p2[i] = p1[i] >= 0 ? prev_row(p1[i]) : -1; p3[i] = p2[i] >= 0 ? prev_row(p2[i]) : -1;
          dtr[i] = U[(size_t)rw[i] * NINP + U_SSD + 1536 + (lane & 7)]; }
#pragma unroll 1
      for (int j = 0; j < 4; ++j) { const int ch = 256 * j + 4 * lane; const size_t uo = U_SSD + 512 + ch; const f32x4 z4 = (f32x4){0.f, 0.f, 0.f, 0.f};
          const f32x4 wb = *(const f32x4*)(cb + ch), w0 = *(const f32x4*)(cw + ch), w1 = *(const f32x4*)(cw + 1024 + ch), w2 = *(const f32x4*)(cw + 2048 + ch), w3 = *(const f32x4*)(cw + 3072 + ch);
          f32x4 x0[4], x1[4], x2[4], x3[4];
#pragma unroll
          for (int i = 0; i < 4; ++i) { x3[i] = *(const f32x4*)(U + (size_t)rw[i] * NINP + uo); x2[i] = p1[i] >= 0 ? *(const f32x4*)(U + (size_t)p1[i] * NINP + uo) : z4;
              x1[i] = p2[i] >= 0 ? *(const f32x4*)(U + (size_t)p2[i] * NINP + uo) : z4; x0[i] = p3[i] >= 0 ? *(const f32x4*)(U + (size_t)p3[i] * NINP + uo) : z4; }
#pragma unroll
          for (int i = 0; i < 4; ++i) { f32x4 o = wb + w0 * x0[i] + w1 * x1[i] + w2 * x2[i] + w3 * x3[i];
              o[0] = siluf_(o[0]); o[1] = siluf_(o[1]); o[2] = siluf_(o[2]); o[3] = siluf_(o[3]);
              if (r0 + F.wave + 8 * i < r1) *(f32x4*)(XBC + (size_t)rw[i] * 1024 + ch) = o; } }
#pragma unroll
      for (int i = 0; i < 4; ++i) if (lane < 8 && r0 + F.wave + 8 * i < r1) { const float dt = softplusf_(dtr[i] + F.kp->in[I_DTB][l * 8 + lane]); DT[rw[i] * 8 + lane] = dt; LA[rw[i] * 8 + lane] = -expf(F.kp->in[I_ALOG][l * 8 + lane]) * dt; } }
    if (grp >= 0) { LAS float* xl = (LAS float*)F.lds; const int hd = F.wave, col = lane & 31;
      float* RW = (float*)(F.ws + O_RW); const size_t AS = (size_t)MP * 512; float* RBON = (float*)(F.ws + O_RBON);
      const float* MU = F.kp->in[I_MU] + l * 1664; const float* W2 = F.kp->in[I_W2] + l * 32 * 512; const float* A2 = F.kp->in[I_A2] + l * 32 * 512; const float* G2 = F.kp->in[I_G2] + l * 64 * 512;
      const int r0 = 32 * grp;
      __syncthreads();
#pragma unroll
      for (int j = 0; j < 8; ++j) { const int idx = tid + 512 * j, tk = idx >> 7, cl = idx & 127, row = r0 + tk; float xs = 0.f;
          if (row < T) { const int pr = prev_row(row); const size_t uc = U_RWKV + 1536 + cl; const float x = U[(size_t)row * NINP + uc], xp = pr >= 0 ? U[(size_t)pr * NINP + uc] : 0.f; xs = x + (xp - x) * MU[1536 + cl];
              if (cl < 32) xs = tanhf(xs); else if (cl >= 64) xs = sigmoidf_(xs); }
          xl[tk * 132 + cl] = xs; }
      __syncthreads();
      float w0c[2], a0c[2], kkc[2], kac[2], rkc[2], muR[2], muK[2], muV[2];
#pragma unroll
      for (int ct = 0; ct < 2; ++ct) { const int ch = 64 * hd + 32 * ct + col; w0c[ct] = F.kp->in[I_W0][l * 512 + ch]; a0c[ct] = F.kp->in[I_A0][l * 512 + ch]; kkc[ct] = F.kp->in[I_KK][l * 512 + ch]; kac[ct] = F.kp->in[I_KA][l * 512 + ch]; rkc[ct] = F.kp->in[I_RK][l * 512 + ch];
          muR[ct] = MU[ch]; muK[ct] = MU[512 + ch]; muV[ct] = MU[1024 + ch]; }
      { constexpr int tb = 0;
          f32x16 aw[2], aa[2], ag[2];
#pragma unroll
          for (int ct = 0; ct < 2; ++ct) { aw[ct] = zero16(); aa[ct] = zero16(); ag[ct] = zero16(); }
          const LAS float* xa = xl + (32 * tb + col) * 132 + (lane >> 5); const int chb = 64 * hd + col, kh = lane >> 5;
#define M1_LORA(ACC, WM, XO, NB) do { _Pragma("unroll") for (int hb_ = 0; hb_ < (NB); ++hb_) { float bq_[16][2], xq_[16]; \
              _Pragma("unroll") for (int t_ = 0; t_ < 16; ++t_) { const float* wb_ = (WM) + 1024 * (16 * hb_ + t_); bq_[t_][0] = wb_[wvo]; bq_[t_][1] = wb_[wvo + 32]; xq_[t_] = xa[(XO) + 2 * (16 * hb_ + t_)]; } \
              _Pragma("unroll") for (int t_ = 0; t_ < 16; ++t_) { ACC[0] = __builtin_amdgcn_mfma_f32_32x32x2f32(xq_[t_], bq_[t_][0], ACC[0], 0, 0, 0); ACC[1] = __builtin_amdgcn_mfma_f32_32x32x2f32(xq_[t_], bq_[t_][1], ACC[1], 0, 0, 0); } } } while (0)
          const unsigned wvo = (unsigned)(kh * 512 + chb);
          M1_LORA(aw, W2, 0, 1); M1_LORA(aa, A2, 32, 1); M1_LORA(ag, G2, 64, 2);
#undef M1_LORA
#pragma unroll
          for (int rb = 0; rb < 16; rb += 4) {
              float uc[4][2][3], upv[4][2][3];
#pragma unroll
              for (int q = 0; q < 4; ++q) { const int row = r0 + 32 * tb + rreg(rb + q, lane), rc = row < T ? row : 0, pr = prev_row(rc);
#pragma unroll
                  for (int ct = 0; ct < 2; ++ct) { const float* ur = U + (size_t)rc * NINP + U_RWKV + chb + 32 * ct; const float* up = U + (size_t)(pr >= 0 ? pr : 0) * NINP + U_RWKV + chb + 32 * ct;
                      uc[q][ct][0] = ur[0]; uc[q][ct][1] = ur[512]; uc[q][ct][2] = ur[1024]; upv[q][ct][0] = pr >= 0 ? up[0] : 0.f; upv[q][ct][1] = pr >= 0 ? up[512] : 0.f; upv[q][ct][2] = pr >= 0 ? up[1024] : 0.f; } }
#pragma unroll
              for (int q = 0; q < 4; ++q) { const int reg = rb + q; const int row = r0 + 32 * tb + rreg(reg, lane); const bool ok = row < T;
                  float rr[2], k2[2], vv[2], kk[2], av[2], dec[2]; float nq = 0.f, bq = 0.f;
#pragma unroll
                  for (int ct = 0; ct < 2; ++ct) { float r = uc[q][ct][0], k = uc[q][ct][1], v = uc[q][ct][2];
                      r += (upv[q][ct][0] - r) * muR[ct]; k += (upv[q][ct][1] - k) * muK[ct]; v += (upv[q][ct][2] - v) * muV[ct];
                      float wr = w0c[ct] + aw[ct][reg]; wr = -softplusf_(-wr) - 0.5f; dec[ct] = expf(-expf(wr));
                      av[ct] = sigmoidf_(a0c[ct] + aa[ct][reg]);
                      kk[ct] = k * kkc[ct]; k2[ct] = k * (1.0f + (av[ct] - 1.0f) * kac[ct]); rr[ct] = r; vv[ct] = v;
                      nq += kk[ct] * kk[ct]; bq += r * k2[ct] * rkc[ct]; }
                  nq = sum32(nq, lane); bq = sum32(bq, lane);
                  const float inrm = 1.0f / fmaxf(sqrtf(nq), 1e-12f);
                  if (ok) {
#pragma unroll
                      for (int ct = 0; ct < 2; ++ct) { const size_t o = (size_t)row * 512 + chb + 32 * ct; const float kn = kk[ct] * inrm;
                          RW[o] = rr[ct]; RW[AS + o] = dec[ct]; RW[2 * AS + o] = k2[ct]; RW[3 * AS + o] = vv[ct]; RW[4 * AS + o] = -kn; RW[5 * AS + o] = kn * av[ct]; RW[6 * AS + o] = ag[ct][reg]; }
                      if (col == 0) RBON[row * 8 + hd] = bq; } } }
      } }
}
__device__ __forceinline__ void m1_phase(const Ctx& F, int l, int qi = 1) {
    unsigned* ctr = (unsigned*)(F.ws + O_CTL) + CW_QUEUE + 64 * (4 * l + qi);
    constexpr int NG = (T + 31) / 32, NR = (T + 31) / 32;
    for (;;) { const int u = queue_next(F, ctr); if (u >= NG + NR) break;
        if (u < NG) m1_unit(F, l, 0, 0, u); else { const int r0 = 32 * (u - NG); m1_unit(F, l, r0, r0 + 32 < T ? r0 + 32 : T, -1); } }
}
constexpr int RWC = 64, NRC = (T + RWC - 1) / RWC;
__device__ __forceinline__ void rwkv_chunk_unit(const Ctx& F, int c, int h) {
    LAS float* BH = (LAS float*)F.lds; LAS float* KH = BH + 4160; LAS float* NX = KH + 4160; LAS float* RTT = NX + 4160;
    LAS float* AP = RTT + 4160; LAS float* BZ = AP + 4352; LAS float* Pm = BZ + 4160; LAS float* Qm = Pm + 4160; LAS float* Ge = Qm + 4160; LAS float* segt = Ge + 64;
    const float* RW = (const float*)(F.ws + O_RW); const size_t AS = (size_t)MP * 512; float* MATS = (float*)(F.ws + O_MATS) + (size_t)(c * 8 + h) * 16384;
    int tid = F.tid, w = F.wave; asm volatile("" : "+v"(tid), "+s"(w));
    const int lane = tid & 63, seg = tid >> 6, k = tid & 63;
    __syncthreads();
    { float p[8];
#pragma unroll
      for (int i = 0; i < 8; ++i) { const int s = RWC * c + 8 * seg + i; const float wv = s < T ? RW[AS + (size_t)row_of_seq(s) * 512 + 64 * h + k] : 1.0f; p[i] = i ? p[i - 1] * wv : wv; }
      segt[seg * 64 + k] = p[7];
      __syncthreads();
      float pre = 1.0f, tot = 1.0f;
#pragma unroll
      for (int q = 0; q < 8; ++q) { const float t = segt[q * 64 + k]; if (q < seg) pre *= t; tot *= t; }
      if (seg == 0) Ge[k] = tot;
#pragma unroll
      for (int i = 0; i < 8; ++i) { const int il = 8 * seg + i, s = RWC * c + il; const float G = pre * p[i], Gm1 = i ? pre * p[i - 1] : pre;
          float nk = 0.f, r = 0.f, b = 0.f, kk = 0.f;
          if (s < T) { const size_t o = (size_t)row_of_seq(s) * 512 + 64 * h + k; r = RW[o]; kk = RW[2 * AS + o]; nk = RW[4 * AS + o]; b = RW[5 * AS + o]; }
          const float ig = 1.0f / G;
          NX[k * 65 + il] = nk * Gm1; RTT[k * 65 + il] = r * G; BH[il * 65 + k] = b * ig; KH[il * 65 + k] = kk * ig; } }
    __syncthreads();
    { const int prod = w >> 1; const LAS float* Lm = (prod & 1) ? KH : BH; const LAS float* Rm = (prod < 2) ? NX : RTT;
#pragma unroll
      for (int t = 0; t < 2; ++t) { const int tr = w & 1, tc = t; f32x16 acc = zero16();
          mma32(acc, Lm + 32 * tr * 65, 65, 1, Rm + 32 * tc, 65, 1, 64, lane);
#pragma unroll
          for (int r = 0; r < 16; ++r) { const int j = 32 * tr + rreg(r, lane), i = 32 * tc + (lane & 31); const float v = acc[r];
              if (prod == 0) AP[j * 68 + i] = j < i ? v : 0.f; else if (prod == 1) BZ[j * 65 + i] = j < i ? v : 0.f; else if (prod == 2) Pm[j * 65 + i] = j <= i ? v : 0.f; else Qm[j * 65 + i] = j <= i ? v : 0.f; } } }
    __syncthreads();
    if (w < 2) { LAS float* Yr = (w == 0 ? NX : BZ) + lane * 65;
        for (int ib = 0; ib < 4; ++ib) { float a[16];
#pragma unroll
            for (int ii = 0; ii < 16; ++ii) a[ii] = Yr[16 * ib + ii];
#pragma unroll 4
            for (int j = 0; j < 16 * ib; ++j) { const float y = Yr[j]; const LAS float* ap = AP + j * 68 + 16 * ib;
                const f32x4 a0 = *(const LAS f32x4*)ap, a1 = *(const LAS f32x4*)(ap + 4), a2 = *(const LAS f32x4*)(ap + 8), a3 = *(const LAS f32x4*)(ap + 12);
#pragma unroll
                for (int q = 0; q < 4; ++q) { a[q] += y * a0[q]; a[4 + q] += y * a1[q]; a[8 + q] += y * a2[q]; a[12 + q] += y * a3[q]; } }
#pragma unroll
            for (int ii = 1; ii < 16; ++ii)
#pragma unroll
                for (int jj = 0; jj < ii; ++jj) a[ii] += a[jj] * AP[(16 * ib + jj) * 68 + 16 * ib + ii];
#pragma unroll
            for (int ii = 0; ii < 16; ++ii) Yr[16 * ib + ii] = a[ii]; } }
    __syncthreads();
    { const int rb = w >> 1;
#pragma unroll
      for (int t = 0; t < 2; ++t) { const int cb = 2 * (w & 1) + t; f32x16 acc = zero16();
          mma32(acc, (rb < 2 ? NX : BZ) + 32 * (rb & 1) * 65, 65, 1, (cb < 2 ? BH : Pm) + 32 * (cb & 1), 65, 1, 64, lane);
          float* dst = MATS + (rb < 2 ? (cb < 2 ? 0 : 8192) : (cb < 2 ? 4096 : 12288));
#pragma unroll
          for (int r = 0; r < 16; ++r) { const int row = 32 * (rb & 1) + rreg(r, lane), col = 32 * (cb & 1) + (lane & 31); float v = acc[r];
              if (rb < 2 && cb < 2) v = (v + (row == col ? 1.0f : 0.0f)) * Ge[col]; else if (rb < 2) v += RTT[row * 65 + col]; else if (cb < 2) v = (v + KH[row * 65 + col]) * Ge[col]; else v += Qm[row * 65 + col];
              dst[row * 64 + col] = v; } } }
}
template <int SV = 0>
__device__ __forceinline__ void rwkv_state_scan(const Ctx& F, int h, int rg) {
    LAS float* Sx = (LAS float*)F.lds; LAS float* tmp = Sx + 1056; LAS float* ring = tmp + 1024;
    const float* RW = (const float*)(F.ws + O_RW); const size_t AS = (size_t)MP * 512; const float* MATS = (const float*)(F.ws + O_MATS); float* SST8 = (float*)(F.ws + (SV ? O_QKV : O_SSTATE));
    const float* ZERO = (const float*)((const bf16*)(F.ws + O_H) + (size_t)8300 * D);
    const int tid = F.tid, lane = F.lane, w = F.wave, fr = lane & 15, kq = lane >> 4, role = w >> 2, cbk = w & 3;
#define RW_DMA(cn) do { const int cc_ = (cn) < NRC ? (cn) : NRC - 1; const float* mp_ = MATS + (size_t)(cc_ * 8 + h) * 16384; LAS float* sl_ = ring + ((cn) % 3) * 9216; \
        _Pragma("unroll") for (int q_ = 0; q_ < 2; ++q_) { const int ch_ = w + 8 * q_; \
            __builtin_amdgcn_global_load_lds((const unsigned*)(mp_ + ch_ * 256 + lane * 4), (LAS unsigned*)(sl_ + ch_ * 256), 16, 0, 0); \
            __builtin_amdgcn_global_load_lds((const unsigned*)(mp_ + 4096 + ch_ * 256 + lane * 4), (LAS unsigned*)(sl_ + 4096 + ch_ * 256), 16, 0, 0); \
            const int j_ = 4 * ch_ + kq, s_ = RWC * cc_ + j_; const float* vp_ = s_ < T ? RW + 3 * AS + (size_t)row_of_seq(s_) * 512 + 64 * h + 16 * rg + fr : ZERO + fr; \
            __builtin_amdgcn_global_load_lds((const unsigned*)vp_, (LAS unsigned*)(sl_ + 8192 + ch_ * 64), 4, 0, 0); } } while (0)
    __syncthreads();
    for (int i = tid; i < 1056; i += NTHR) Sx[i] = 0.f;
    RW_DMA(0); RW_DMA(1);
    asm volatile("s_waitcnt vmcnt(0)" ::: "memory");
    __syncthreads();
    for (int c = 0; c < NRC; ++c) {
        if (SV != 1) RW_DMA(c + 2);
        { const int idx = 2 * tid, v = idx >> 6, kk = idx & 63; const f32x2 sv = (f32x2){Sx[v * 66 + kk], Sx[v * 66 + kk + 1]}; *(f32x2*)(SST8 + ((size_t)(c * 8 + h) * 64 + 16 * rg + v) * 64 + kk) = sv; }
        const LAS float* sl = ring + (c % 3) * 9216;
        float av[16], bv[16]; f32x4 acc = (f32x4){0.f, 0.f, 0.f, 0.f}, acc2 = acc;
        if (role == 0) { const LAS float* mb = sl + 16 * cbk + fr;
#pragma unroll
            for (int t = 0; t < 16; ++t) { av[t] = Sx[fr * 66 + 4 * t + kq]; bv[t] = mb[(4 * t + kq) * 64]; }
        } else { const LAS float* wb = sl + 4096 + 16 * cbk + fr; const LAS float* vt = sl + 8192 + fr;
#pragma unroll
            for (int t = 0; t < 16; ++t) { av[t] = vt[(4 * t + kq) * 16]; bv[t] = wb[(4 * t + kq) * 64]; } }
#pragma unroll
        for (int t = 0; t < (SV == 2 ? 2 : 16); t += 2) { acc = __builtin_amdgcn_mfma_f32_16x16x4f32(av[t], bv[t], acc, 0, 0, 0); acc2 = __builtin_amdgcn_mfma_f32_16x16x4f32(av[t + 1], bv[t + 1], acc2, 0, 0, 0); }
        acc = acc + acc2;
        if (role != 0) *(LAS f32x4*)(tmp + (cbk * 64 + lane) * 4) = acc;
        LBAR();
        if (role == 0) { acc = acc + *(const LAS f32x4*)(tmp + (cbk * 64 + lane) * 4);
#pragma unroll
            for (int r = 0; r < 4; ++r) Sx[(4 * kq + r) * 66 + 16 * cbk + fr] = acc[r]; }
        if (SV != 1) asm volatile("s_waitcnt vmcnt(8)" ::: "memory");
        LBAR();
    }
    asm volatile("s_waitcnt vmcnt(0)" ::: "memory");
#undef RW_DMA
}
__device__ __forceinline__ void rwkv_out_unit(const Ctx& F, int l, int c, int h) {
    LAS float* S_ = (LAS float*)F.lds; LAS float* E_ = S_ + 4160; LAS float* VT_ = E_ + 4096; LAS float* F_ = VT_ + 4096; LAS float* O_ = F_ + 4096;
    const float* RW = (const float*)(F.ws + O_RW); const size_t AS = (size_t)MP * 512; const float* MATS = (const float*)(F.ws + O_MATS) + (size_t)(c * 8 + h) * 16384;
    const float* SST8 = (const float*)(F.ws + O_SSTATE) + (size_t)(c * 8 + h) * 4096; const float* RBON = (const float*)(F.ws + O_RBON); bf16* Y = (bf16*)(F.ws + O_Y);
    int tid = F.tid, w = F.wave; asm volatile("" : "+v"(tid), "+s"(w)); const int lane = tid & 63;
    const f32x4 z4 = (f32x4){0.f, 0.f, 0.f, 0.f};
    f32x4 sv[2], ev[2], fv[2], tv[2];
#pragma unroll
    for (int q = 0; q < 2; ++q) { const int idx = tid + 512 * q, r = idx >> 4, c4 = idx & 15, s = RWC * c + r;
        sv[q] = *(const f32x4*)(SST8 + r * 64 + 4 * c4); ev[q] = *(const f32x4*)(MATS + 8192 + 4 * idx); fv[q] = *(const f32x4*)(MATS + 12288 + 4 * idx);
        tv[q] = s < T ? *(const f32x4*)(RW + 3 * AS + (size_t)row_of_seq(s) * 512 + 64 * h + 4 * c4) : z4; }
    const int li = tid >> 3, part = tid & 7, ls = RWC * c + li, lrow = ls < T ? row_of_seq(ls) : 0; const size_t lo = (size_t)lrow * 512 + 64 * h + 8 * part;
    f32x4 v0 = z4, v1 = z4, g0 = z4, g1 = z4; float bon = 0.f;
    if (ls < T) { v0 = *(const f32x4*)(RW + 3 * AS + lo); v1 = *(const f32x4*)(RW + 3 * AS + lo + 4); g0 = *(const f32x4*)(RW + 6 * AS + lo); g1 = *(const f32x4*)(RW + 6 * AS + lo + 4); bon = RBON[lrow * 8 + h]; }
    __syncthreads();
#pragma unroll
    for (int q = 0; q < 2; ++q) { const int idx = tid + 512 * q, r = idx >> 4, c4 = idx & 15;
        LAS float* d = S_ + r * 65 + 4 * c4; d[0] = sv[q][0]; d[1] = sv[q][1]; d[2] = sv[q][2]; d[3] = sv[q][3];
        *(LAS f32x4*)(E_ + 4 * idx) = ev[q]; *(LAS f32x4*)(F_ + 4 * idx) = fv[q]; *(LAS f32x4*)(VT_ + r * 64 + 4 * c4) = tv[q]; }
    LBAR();
    const int tr = (w >> 1) & 1, tc = w & 1; f32x16 acc = zero16();
    if (w < 4) mma32(acc, S_ + 32 * tr * 65, 65, 1, E_ + 32 * tc, 64, 1, 64, lane);
    else { mma32(acc, VT_ + 32 * tr, 1, 64, F_ + 32 * tc, 64, 1, 64, lane);
#pragma unroll
        for (int r = 0; r < 16; ++r) O_[(32 * tr + rreg(r, lane)) * 65 + 32 * tc + (lane & 31)] = acc[r]; }
    LBAR();
    if (w < 4) {
#pragma unroll
        for (int r = 0; r < 16; ++r) O_[(32 * tr + rreg(r, lane)) * 65 + 32 * tc + (lane & 31)] += acc[r]; }
    LBAR();
    { float x[8]; float sm = 0.f;
#pragma unroll
      for (int q = 0; q < 8; ++q) { x[q] = O_[(8 * part + q) * 65 + li]; sm += x[q]; }
      sm = sum8(sm);
      const float mu = sm * (1.0f / 64.0f); float vq = 0.f;
#pragma unroll
      for (int q = 0; q < 8; ++q) { const float d = x[q] - mu; vq += d * d; }
      vq = sum8(vq);
      const float rstd = 1.0f / sqrtf(vq * (1.0f / 64.0f) + 64e-5f);
      if (ls < T) { const float* lng = F.kp->in[I_LN] + l * 512 + 64 * h + 8 * part;
          float ov[8];
#pragma unroll
          for (int q = 0; q < 4; ++q) { ov[q] = ((x[q] - mu) * rstd * lng[q] + bon * v0[q]) * g0[q]; ov[4 + q] = ((x[4 + q] - mu) * rstd * lng[4 + q] + bon * v1[q]) * g1[q]; }
          v4u wv; wv.x = cvtpk(ov[0], ov[1]); wv.y = cvtpk(ov[2], ov[3]); wv.z = cvtpk(ov[4], ov[5]); wv.w = cvtpk(ov[6], ov[7]);
          *(v4u*)(Y + (size_t)lrow * D + 1536 + 64 * h + 8 * part) = wv; } }
}
__device__ __forceinline__ void ssd_states_unit(const Ctx& F, int c, int h) {
    LAS float* Bm = (LAS float*)F.lds; LAS float* XD = Bm + 16384; LAS float* csl = XD + 8192; LAS float* lal = csl + 128; LAS float* dtl = lal + 128;
    const float* XBC = (const float*)(F.ws + O_XBC); const float* DT = (const float*)(F.ws + O_DT); const float* LA = (const float*)(F.ws + O_LA);
    float* SST = (float*)(F.ws + O_SST); float* SDEC = (float*)(F.ws + O_SDEC);
    const int tid = F.tid, lane = F.lane, w = F.wave, g = h >> 2;
    __syncthreads();
    if (tid < 128) { const int row = crow(c, tid); lal[tid] = row >= 0 ? LA[row * 8 + h] : 0.f; dtl[tid] = row >= 0 ? DT[row * 8 + h] : 0.f; }
    __syncthreads();
    if (tid < 64) { const float e0 = lal[2 * tid], e1 = lal[2 * tid + 1]; float s = e0 + e1;
#pragma unroll
        for (int o = 1; o < 64; o <<= 1) { const float t = __shfl_up(s, o); if (tid >= o) s += t; }
        csl[2 * tid + 1] = s; csl[2 * tid] = s - e1; }
    __syncthreads();
    const float cs_end = csl[127];
#pragma unroll
    for (int k = 0; k < 8; ++k) { const int idx = tid + 512 * k, j = idx >> 5, c4 = idx & 31, row = crow(c, j);
        const f32x4 v = row >= 0 ? *(const f32x4*)(XBC + (size_t)row * 1024 + 512 + 128 * g + 4 * c4) : (f32x4){0.f, 0.f, 0.f, 0.f};
        *(LAS f32x4*)(Bm + j * 128 + 4 * c4) = v; }
#pragma unroll
    for (int k = 0; k < 4; ++k) { const int idx = tid + 512 * k, j = idx >> 4, c4 = idx & 15, row = crow(c, j);
        f32x4 v = row >= 0 ? *(const f32x4*)(XBC + (size_t)row * 1024 + 64 * h + 4 * c4) : (f32x4){0.f, 0.f, 0.f, 0.f};
        v = v * (dtl[j] * expf(cs_end - csl[j]));
        *(LAS f32x4*)(XD + j * 64 + 4 * c4) = v; }
    __syncthreads();
    const int tr = w >> 2, tc = w & 3;
    f32x16 acc = zero16();
    mma32(acc, XD + 32 * tr, 1, 64, Bm + 32 * tc, 128, 1, 128, lane);
    float* dst = SST + ((size_t)(c * 8 + h) * 64 + 32 * tr) * 128 + 32 * tc + (lane & 31);
#pragma unroll
    for (int r = 0; r < 16; ++r) dst[(size_t)rreg(r, lane) * 128] = acc[r];
    if (tid == 0) SDEC[(c * 8 + h) * 32] = expf(cs_end);
}
__device__ __forceinline__ float ret_logg(int h) { return logf(1.0f - exp2f(-5.0f - (float)h)); }
__device__ __forceinline__ void ret_states_unit(const Ctx& F, int c, int h) {
    LAS float* V = (LAS float*)F.lds; LAS float* KD = V + 16384;
    const float* U = (const float*)(F.ws + O_U); const float* RQK = (const float*)(F.ws + O_RQK); float* RST = (float*)(F.ws + O_RST);
    const int tid = F.tid, lane = F.lane, w = F.wave; const float lg = ret_logg(h);
    __syncthreads();
#pragma unroll
    for (int k = 0; k < 8; ++k) { const int idx = tid + 512 * k, j = idx >> 5, c4 = idx & 31, row = crow(c, j);
        const f32x4 v = row >= 0 ? *(const f32x4*)(U + (size_t)row * NINP + U_RET + 512 + 128 * h + 4 * c4) : (f32x4){0.f, 0.f, 0.f, 0.f};
        *(LAS f32x4*)(V + j * 128 + 4 * c4) = v; }
#pragma unroll
    for (int k = 0; k < 4; ++k) { const int idx = tid + 512 * k, j = idx >> 4, c4 = idx & 15, row = crow(c, j);
        f32x4 v = row >= 0 ? *(const f32x4*)(RQK + (size_t)row * 512 + 256 + 64 * h + 4 * c4) : (f32x4){0.f, 0.f, 0.f, 0.f};
        v = v * expf((float)(127 - j) * lg);
        *(LAS f32x4*)(KD + j * 64 + 4 * c4) = v; }
    __syncthreads();
    const int tr = w >> 1, tc = w & 1;
    f32x16 acc = zero16();
    mma32(acc, V + 32 * tr, 1, 128, KD + 32 * tc, 64, 1, 128, lane);
    float* dst = RST + ((size_t)(c * 4 + h) * 128 + 32 * tr) * 64 + 32 * tc + (lane & 31);
#pragma unroll
    for (int r = 0; r < 16; ++r) dst[(size_t)rreg(r, lane) * 64] = acc[r];
}

__device__ __forceinline__ void scan_job(float* base, size_t cstride, const float* dec, int decstride, float constdec) {
    float s = 0.f; float t[13], d[13];
#pragma unroll
    for (int i = 0; i < 13; ++i) { t[i] = base[(size_t)i * cstride]; d[i] = dec ? dec[i * decstride] : constdec; }
#pragma unroll
    for (int c0 = 0; c0 < NCH; c0 += 13) { float tn[13], dn[13];
        if (c0 + 13 < NCH) {
#pragma unroll
            for (int i = 0; i < 13; ++i) { tn[i] = base[(size_t)(c0 + 13 + i) * cstride]; dn[i] = dec ? dec[(c0 + 13 + i) * decstride] : constdec; } }
#pragma unroll
        for (int i = 0; i < 13; ++i) { base[(size_t)(c0 + i) * cstride] = s; s = d[i] * s + t[i]; }
#pragma unroll
        for (int i = 0; i < 13; ++i) { t[i] = tn[i]; d[i] = dn[i]; } }
}
__device__ __forceinline__ void rwkv_scan(const Ctx& F, int hb) {
    LAS float* st = (LAS float*)F.lds;
    float* RW = (float*)(F.ws + O_RW); const size_t AS = (size_t)MP * 512; float* OUT = RW + 7 * AS;
    const int tid = F.tid, lane = F.lane, rl = lane >> 3, ks = lane & 7, myrow = 8 * F.wave + rl;
    float S[8];
#pragma unroll
    for (int j = 0; j < 8; ++j) S[j] = 0.f;
    for (int s0 = 0; s0 < T; s0 += 32) {
        __syncthreads();
#pragma unroll
        for (int j = 0; j < 6; ++j) { const int idx = tid + 512 * j, stp = idx / 96, rem = idx % 96, arr = rem >> 4, c4 = rem & 15, s = s0 + stp;
            if (s < T) { const int row = row_of_seq(s); const int asel = arr == 0 ? 0 : (arr == 1 ? 1 : (arr == 2 ? 2 : (arr == 3 ? 4 : (arr == 4 ? 5 : 3))));
                *(LAS f32x4*)(st + stp * 384 + arr * 64 + 4 * c4) = *(const f32x4*)(RW + asel * AS + (size_t)row * 512 + 64 * hb + 4 * c4); } }
        __syncthreads();
        const int nst = (T - s0) < 32 ? (T - s0) : 32;
        for (int stp = 0; stp < nst; ++stp) { const LAS float* b = st + stp * 384 + 8 * ks;
            const f32x4 r0 = *(const LAS f32x4*)(b), r1 = *(const LAS f32x4*)(b + 4), w0 = *(const LAS f32x4*)(b + 64), w1 = *(const LAS f32x4*)(b + 68), k0 = *(const LAS f32x4*)(b + 128), k1 = *(const LAS f32x4*)(b + 132),
                        n0 = *(const LAS f32x4*)(b + 192), n1 = *(const LAS f32x4*)(b + 196), b0 = *(const LAS f32x4*)(b + 256), b1 = *(const LAS f32x4*)(b + 260);
            const float vv = st[stp * 384 + 320 + myrow];
            float sa = (S[0] * n0[0] + S[1] * n0[1]) + (S[2] * n0[2] + S[3] * n0[3]) + (S[4] * n1[0] + S[5] * n1[1]) + (S[6] * n1[2] + S[7] * n1[3]);
            sa += __shfl_xor(sa, 1); sa += __shfl_xor(sa, 2); sa += __shfl_xor(sa, 4);
            float o = 0.f;
#pragma unroll
            for (int j = 0; j < 4; ++j) { S[j] = S[j] * w0[j] + sa * b0[j] + vv * k0[j]; o += S[j] * r0[j]; S[4 + j] = S[4 + j] * w1[j] + sa * b1[j] + vv * k1[j]; o += S[4 + j] * r1[j]; }
            o += __shfl_xor(o, 1); o += __shfl_xor(o, 2); o += __shfl_xor(o, 4);
            if (ks == 0) OUT[(size_t)row_of_seq(s0 + stp) * 512 + 64 * hb + myrow] = o; }
    }
}
__device__ __forceinline__ void mla_prep2_unit(const Ctx& F, int l, int un) {
    const float* QKVb = (const float*)(F.ws + O_QKV); const float* U = (const float*)(F.ws + O_U);
    bf16* Q = (bf16*)(F.ws + O_Q); bf16* K = (bf16*)(F.ws + O_K); bf16* VT = (bf16*)(F.ws + O_VT);
    LAS bf16* Vl = (LAS bf16*)F.lds;
    const int lane = F.lane, tid = F.tid;
    const float* gq = F.kp->in[I_QKNQ] + l * 192; const float* gk = F.kp->in[I_QKNK] + l * 192;
    const float gq0 = gq[lane], gq1 = gq[64 + lane], gq2 = gq[128 + lane], gk0 = gk[lane], gk1 = gk[64 + lane], gk2 = gk[128 + lane];
    const float qs = 0.07216878364870322f * 1.4426950408889634f;
    __syncthreads();
#pragma unroll 1
    for (int ib = 0; ib < 8; ib += 4) {
        float xq[4][12], xk[4][8], xv[4][8], kpe[4]; f32x2 cs[4];
#pragma unroll
        for (int p = 0; p < 4; ++p) { const int s = 64 * un + 8 * F.wave + ib + p; const int row = s < T ? row_of_seq(s) : 0; const float* qk = QKVb + (size_t)row * MLAN;
            cs[p] = ((const f32x2*)(F.ws + O_ROPE))[row * 32 + (lane & 31)]; kpe[p] = U[(size_t)row * NINP + 512 + lane];
#pragma unroll
            for (int h = 0; h < 4; ++h) { xq[p][3 * h] = qk[192 * h + lane]; xq[p][3 * h + 1] = qk[192 * h + 64 + lane]; xq[p][3 * h + 2] = qk[192 * h + 128 + lane];
                xk[p][2 * h] = qk[768 + 256 * h + lane]; xk[p][2 * h + 1] = qk[768 + 256 * h + 64 + lane]; xv[p][2 * h] = qk[768 + 256 * h + 128 + lane]; xv[p][2 * h + 1] = qk[768 + 256 * h + 192 + lane]; } }
#pragma unroll
        for (int p = 0; p < 4; ++p) { const int sl = 8 * F.wave + ib + p, s = 64 * un + sl; const bool ok = s < T;
#pragma unroll
            for (int h = 0; h < 4; ++h) {
                { float x0 = xq[p][3 * h], x1 = xq[p][3 * h + 1], x2 = xq[p][3 * h + 2];
                  const float rs = 1.0f / sqrtf(wave_sum(x0 * x0 + x1 * x1 + x2 * x2) * (1.0f / 192.0f) + EPS);
                  x0 *= rs * gq0; x1 *= rs * gq1; x2 *= rs * gq2;
                  const float ot = xor32f(x2, lane); const float rr = lane < 32 ? x2 * cs[p].x - ot * cs[p].y : ot * cs[p].y + x2 * cs[p].x;
                  bf16* qd = Q + ((size_t)s * 4 + h) * 192; qd[lane] = (bf16)f2bf(x0 * qs); qd[64 + lane] = (bf16)f2bf(x1 * qs); qd[128 + lane] = (bf16)f2bf(rr * qs); }
                { float x0 = xk[p][2 * h], x1 = xk[p][2 * h + 1], x2 = kpe[p];
                  const float rs = 1.0f / sqrtf(wave_sum(x0 * x0 + x1 * x1 + x2 * x2) * (1.0f / 192.0f) + EPS);
                  x0 *= rs * gk0; x1 *= rs * gk1; x2 *= rs * gk2;
                  const float ot = xor32f(x2, lane); const float rr = lane < 32 ? x2 * cs[p].x - ot * cs[p].y : ot * cs[p].y + x2 * cs[p].x;
                  bf16* kd = K + ((size_t)s * 4 + h) * 192; kd[lane] = (bf16)f2bf(x0); kd[64 + lane] = (bf16)f2bf(x1); kd[128 + lane] = (bf16)f2bf(rr); }
                Vl[(h * 128 + lane) * 66 + sl] = ok ? (bf16)f2bf(xv[p][2 * h]) : (bf16)0; Vl[(h * 128 + 64 + lane) * 66 + sl] = ok ? (bf16)f2bf(xv[p][2 * h + 1]) : (bf16)0; } }
    }
    __syncthreads();
#pragma unroll
    for (int k = 0; k < 8; ++k) { const int idx = tid + 512 * k, r = idx >> 3, j = idx & 7; const LAS unsigned* src = (const LAS unsigned*)(Vl + r * 66 + 8 * j);
        v4u w; w.x = src[0]; w.y = src[1]; w.z = src[2]; w.w = src[3];
        *(v4u*)(VT + (size_t)r * TSEQ + 64 * un + 8 * j) = w; }
}
__device__ __forceinline__ void m3_phase(const Ctx& F, int l) {
    const int b2 = F.bid, NB = F.G;
    for (int job = b2; job < 192; job += NB) {
        if (job < 128) { if (!EN_SSD) continue; const int e = job * 512 + F.tid, h = e >> 13, rest = e & 8191; scan_job((float*)(F.ws + O_SST) + (size_t)h * 8192 + rest, (size_t)8 * 8192, (const float*)(F.ws + O_SDEC) + h * 32, 8 * 32, 0.f); }
        else { if (!EN_RET) continue; const int e = (job - 128) * 512 + F.tid, h = e >> 13, rest = e & 8191; scan_job((float*)(F.ws + O_RST) + (size_t)h * 8192 + rest, (size_t)4 * 8192, nullptr, 0, expf(128.0f * ret_logg(h))); }
    }
    if (EN_MLA) for (int un = NB - 1 - b2; un < (T + 63) / 64; un += NB) mla_prep2_unit(F, l, un);
}
template <int VAR = 0>
__device__ __forceinline__ void attn_unit(const Ctx& F, int hh, int qb, size_t yoff = O_Y) {
    LAS bf16* L0 = (LAS bf16*)F.lds;
    const bf16* Q = (const bf16*)(F.ws + O_Q); const bf16* K = (const bf16*)(F.ws + O_K); const bf16* VT = (const bf16*)(F.ws + O_VT); bf16* Y = (bf16*)(F.ws + yoff);
    int tid = F.tid, w = F.wave; asm volatile("" : "+v"(tid), "+s"(w));
    const int lane = tid & 63, h = lane >> 5, c = lane & 31, half = w >> 2, wq = w & 3;
    const int sq = 128 * qb + 32 * wq + c;
    bf16x8 qf[12];
#pragma unroll
    for (int ks = 0; ks < 12; ++ks) qf[ks] = *(const bf16x8*)(Q + ((size_t)sq * 4 + hh) * 192 + 16 * ks + 8 * h);
    f32x16 o[4];
#pragma unroll
    for (int t = 0; t < 4; ++t) o[t] = zero16();
    float m = -1e30f, lsum = 0.f;
    const int nst = qb + 1;
    v4u kr[6], vr[4];
    const unsigned kgo = (unsigned)(((tid >> 3) * 4 + hh) * 192 + 8 * (tid & 7)), klo = (unsigned)((tid >> 3) * 200 + 8 * (tid & 7));
    const unsigned vgo = (unsigned)((hh * 128 + (tid >> 2)) * TSEQ + 8 * (tid & 3)), vlo = (unsigned)(12800 + (tid >> 2) * 72 + 8 * (tid & 3));
#define AT_LOADK(st_) do { const bf16* kb_ = K + (size_t)(128 * (st_)) * 768; _Pragma("unroll") for (int j = 0; j < 6; ++j) kr[j] = *(const v4u*)(kb_ + kgo + (j / 3) * 49152 + 64 * (j % 3)); } while (0)
#define AT_LOADV(st_) do { const bf16* vb_ = VT + 128 * (st_); _Pragma("unroll") for (int j = 0; j < 4; ++j) vr[j] = *(const v4u*)(vb_ + vgo + (j >> 1) * 64 + 32 * (j & 1)); } while (0)
#define AT_STOREK() do { _Pragma("unroll") for (int j = 0; j < 6; ++j) *(LAS v4u*)(L0 + klo + (j / 3) * 22016 + 64 * (j % 3)) = kr[j]; } while (0)
#define AT_STOREV() do { _Pragma("unroll") for (int j = 0; j < 4; ++j) *(LAS v4u*)(L0 + vlo + (j >> 1) * 22016 + 32 * (j & 1)) = vr[j]; } while (0)
    __syncthreads();
    AT_LOADK(0); AT_LOADV(0); AT_STOREK(); AT_STOREV(); if (nst > 1) AT_LOADK(1);
    LBAR();
    const LAS bf16* Ks = L0 + half * 22016; const LAS bf16* Vs = Ks + 12800;
    for (int st = 0; st < nst; ++st) {
        const int kt = 2 * st + half;
        f32x16 sa[2];
#pragma unroll
        for (int t2 = 0; t2 < 2; ++t2) { sa[t2] = zero16();
#pragma unroll
            for (int ks = 0; ks < 12; ++ks) { const bf16x8 a = *(const LAS bf16x8*)(Ks + (32 * t2 + c) * 200 + 16 * ks + 8 * h); sa[t2] = __builtin_amdgcn_mfma_f32_32x32x16_bf16(a, qf[ks], sa[t2], 0, 0, 0); } }
        if (st == nst - 1) {
#pragma unroll
            for (int t2 = 0; t2 < 2; ++t2)
#pragma unroll
                for (int r = 0; r < 16; ++r) { const int key = 64 * kt + 32 * t2 + (r & 3) + 8 * (r >> 2) + 4 * h; if (key > sq) sa[t2][r] = -1e30f; } }
        float mx = -1e30f;
#pragma unroll
        for (int t2 = 0; t2 < 2; ++t2)
#pragma unroll
            for (int r = 0; r < 16; ++r) mx = fmaxf(mx, sa[t2][r]);
        mx = fmaxf(mx, __shfl_xor(mx, 32));
        if (__builtin_amdgcn_ballot_w64(mx > m) != 0ull) { const float mn = fmaxf(m, mx), alpha = __builtin_amdgcn_exp2f(m - mn); m = mn; lsum *= alpha;
#pragma unroll
            for (int t = 0; t < 4; ++t) o[t] = o[t] * alpha; }
        float rs = 0.f;
#pragma unroll
        for (int t2 = 0; t2 < 2; ++t2)
#pragma unroll
            for (int r = 0; r < 16; ++r) { const float pv = __builtin_amdgcn_exp2f(sa[t2][r] - m); sa[t2][r] = pv; rs += pv; }
        rs += __shfl_xor(rs, 32);
        lsum += rs;
        LBAR();
        if (st + 1 < nst) { AT_STOREK(); AT_LOADV(st + 1); }
#pragma unroll
        for (int t2 = 0; t2 < 2; ++t2)
#pragma unroll
            for (int s = 0; s < 2; ++s) { v4u pw; pw.x = cvtpk(sa[t2][8 * s], sa[t2][8 * s + 1]); pw.y = cvtpk(sa[t2][8 * s + 2], sa[t2][8 * s + 3]); pw.z = cvtpk(sa[t2][8 * s + 4], sa[t2][8 * s + 5]); pw.w = cvtpk(sa[t2][8 * s + 6], sa[t2][8 * s + 7]);
                const bf16x8 pf = __builtin_bit_cast(bf16x8, pw);
#pragma unroll
                for (int t = 0; t < 4; ++t) { const LAS bf16* vp = Vs + (32 * t + c) * 72 + 32 * t2 + 16 * s + 4 * h; const v2u lo = *(const LAS v2u*)vp, hi = *(const LAS v2u*)(vp + 8);
                    v4u vw; vw.x = lo.x; vw.y = lo.y; vw.z = hi.x; vw.w = hi.y;
                    o[t] = __builtin_amdgcn_mfma_f32_32x32x16_bf16(__builtin_bit_cast(bf16x8, vw), pf, o[t], 0, 0, 0); } }
        LBAR();
        if (st + 1 < nst) { AT_STOREV(); if (st + 2 < nst) AT_LOADK(st + 2); }
    }
#undef AT_LOADK
#undef AT_LOADV
#undef AT_STOREK
#undef AT_STOREV
    LAS float* MB = (LAS float*)F.lds + (wq * 64 + lane) * 67;
    if (half == 1) { MB[0] = m; MB[1] = lsum;
#pragma unroll
        for (int t = 0; t < 4; ++t)
#pragma unroll
            for (int r = 0; r < 16; ++r) MB[2 + 16 * t + r] = o[t][r]; }
    LBAR();
    if (half == 0) { const float m2 = MB[0], l2 = MB[1], mn = fmaxf(m, m2), a1 = __builtin_amdgcn_exp2f(m - mn), a2 = __builtin_amdgcn_exp2f(m2 - mn);
        const float inv = 1.0f / (lsum * a1 + l2 * a2);
        if (sq < T) { bf16* yr = Y + (size_t)row_of_seq(sq) * D + 128 * hh + 4 * h;
#pragma unroll
            for (int t = 0; t < 4; ++t)
#pragma unroll
                for (int rq = 0; rq < 4; ++rq) { float ov[4];
#pragma unroll
                    for (int i = 0; i < 4; ++i) ov[i] = (o[t][4 * rq + i] * a1 + MB[2 + 16 * t + 4 * rq + i] * a2) * inv;
                    v2u wv; wv.x = cvtpk(ov[0], ov[1]); wv.y = cvtpk(ov[2], ov[3]); *(v2u*)(yr + 32 * t + 8 * rq) = wv; } } }
}
__device__ __forceinline__ void ssd_out_unit(const Ctx& F, int l, int c, int h, int ih) {
    LAS float* CS_ = (LAS float*)F.lds; LAS float* BS_ = CS_ + 4352; LAS float* PS_ = BS_ + 8704; LAS float* SC_ = PS_ + 4352; LAS float* XD_ = SC_ + 8448; LAS float* csl = XD_ + 8448; LAS float* lal = csl + 128; LAS float* dtl = lal + 128;
    LAS float* Y_ = CS_;
    const float* XBC = (const float*)(F.ws + O_XBC); const float* DT = (const float*)(F.ws + O_DT); const float* LA = (const float*)(F.ws + O_LA); const float* U = (const float*)(F.ws + O_U);
    const float* SST = (const float*)(F.ws + O_SST); float* YZ = (float*)(F.ws + O_YZ);
    int tid = F.tid, w = F.wave; asm volatile("" : "+v"(tid), "+s"(w));
    const int lane = tid & 63, g = h >> 2;
    const f32x4 z4 = (f32x4){0.f, 0.f, 0.f, 0.f};
    float lav = 0.f, dtv = 0.f;
    if (tid < 128) { const int row = crow(c, tid); if (row >= 0) { lav = LA[row * 8 + h]; dtv = DT[row * 8 + h]; } }
    f32x4 xdv[4], csv[2][2], bsv[2][4], psv[2][2]; float xsv[8], zv[8];
#pragma unroll
    for (int k = 0; k < 4; ++k) { const int idx = tid + 512 * k, j = idx >> 4, c4 = idx & 15, row = crow(c, j); xdv[k] = row >= 0 ? *(const f32x4*)(XBC + (size_t)row * 1024 + 64 * h + 4 * c4) : z4; }
#pragma unroll
    for (int nh = 0; nh < 2; ++nh) {
#pragma unroll
        for (int k = 0; k < 2; ++k) { const int idx = tid + 512 * k, i = idx >> 4, c4 = idx & 15, row = crow(c, 64 * ih + i); csv[nh][k] = row >= 0 ? *(const f32x4*)(XBC + (size_t)row * 1024 + 768 + 128 * g + 64 * nh + 4 * c4) : z4; }
#pragma unroll
        for (int k = 0; k < 4; ++k) { const int idx = tid + 512 * k, j = idx >> 4, c4 = idx & 15, row = crow(c, j); bsv[nh][k] = row >= 0 ? *(const f32x4*)(XBC + (size_t)row * 1024 + 512 + 128 * g + 64 * nh + 4 * c4) : z4; }
#pragma unroll
        for (int k = 0; k < 2; ++k) { const int idx = tid + 512 * k, pp = idx >> 4, c4 = idx & 15; psv[nh][k] = *(const f32x4*)(SST + ((size_t)(c * 8 + h) * 64 + pp) * 128 + 64 * nh + 4 * c4); } }
#pragma unroll
    for (int k = 0; k < 8; ++k) { const int idx = tid + 512 * k, i = idx >> 6, pp = idx & 63, row = crow(c, 64 * ih + i); xsv[k] = 0.f; zv[k] = 0.f;
        if (row >= 0) { xsv[k] = XBC[(size_t)row * 1024 + 64 * h + pp]; zv[k] = U[(size_t)row * NINP + U_SSD + 64 * h + pp]; } }
    __syncthreads();
    if (tid < 128) { lal[tid] = lav; dtl[tid] = dtv; }
    LBAR();
    if (tid < 64) { const float e0 = lal[2 * tid], e1 = lal[2 * tid + 1]; float s = e0 + e1;
#pragma unroll
        for (int o = 1; o < 64; o <<= 1) { const float t = __shfl_up(s, o); if (tid >= o) s += t; }
        csl[2 * tid + 1] = s; csl[2 * tid] = s - e1; }
#pragma unroll
    for (int k = 0; k < 4; ++k) { const int idx = tid + 512 * k, j = idx >> 4, c4 = idx & 15; const f32x4 v = xdv[k] * dtl[j]; LAS float* d = XD_ + (4 * c4) * 132 + j; d[0] = v[0]; d[132] = v[1]; d[264] = v[2]; d[396] = v[3]; }
    f32x16 acc_s = zero16(), acc_y = zero16();
    const int tr = w >> 2, tc = w & 3, tr2 = (w >> 1) & 1, tc2 = w & 1;
#pragma unroll
    for (int nh = 0; nh < 2; ++nh) {
        if (nh) LBAR();
#pragma unroll
        for (int k = 0; k < 2; ++k) { const int idx = tid + 512 * k, i = idx >> 4, c4 = idx & 15; const f32x4 v = csv[nh][k]; *(LAS f32x4*)(CS_ + i * 68 + 4 * c4) = v; }
#pragma unroll
        for (int k = 0; k < 4; ++k) { const int idx = tid + 512 * k, j = idx >> 4, c4 = idx & 15; const f32x4 v = bsv[nh][k]; *(LAS f32x4*)(BS_ + j * 68 + 4 * c4) = v; }
#pragma unroll
        for (int k = 0; k < 2; ++k) { const int idx = tid + 512 * k, pp = idx >> 4, c4 = idx & 15; const f32x4 v = psv[nh][k]; *(LAS f32x4*)(PS_ + pp * 68 + 4 * c4) = v; }
        LBAR();
        mma32bf(acc_s, CS_ + 32 * tr * 68, 68, BS_ + 32 * tc * 68, 68, 64, lane);
        if (w < 4) mma32bf(acc_y, CS_ + 32 * tr2 * 68, 68, PS_ + 32 * tc2 * 68, 68, 64, lane);
    }
    if (w < 4) {
#pragma unroll
        for (int r = 0; r < 16; ++r) acc_y[r] *= expf(csl[64 * ih + 32 * tr2 + rreg(r, lane)]); }
#pragma unroll
    for (int r = 0; r < 16; ++r) { const int i = 32 * tr + rreg(r, lane), j = 32 * tc + (lane & 31), il = 64 * ih + i;
        SC_[i * 132 + j] = j <= il ? acc_s[r] * expf(csl[il] - csl[j]) : 0.f; }
    LBAR();
    if (w < 4) { mma32bf(acc_y, SC_ + 32 * tr2 * 132, 132, XD_ + 32 * tc2 * 132, 132, 128, lane);
#pragma unroll
        for (int r = 0; r < 16; ++r) Y_[(32 * tr2 + rreg(r, lane)) * 68 + 32 * tc2 + (lane & 31)] = acc_y[r]; }
    LBAR();
    const float Dh = F.kp->in[I_SSDD][l * 8 + h];
#pragma unroll
    for (int k = 0; k < 8; ++k) { const int idx = tid + 512 * k, i = idx >> 6, pp = idx & 63, row = crow(c, 64 * ih + i);
        if (row >= 0) YZ[(size_t)row * 512 + 64 * h + pp] = (Y_[i * 68 + pp] + Dh * xsv[k]) * siluf_(zv[k]); }
}
__device__ __forceinline__ void ret_out_unit(const Ctx& F, int l, int c, int h, int ih) {
    LAS float* Q_ = (LAS float*)F.lds; LAS float* KM_ = Q_ + 4352; LAS float* SC_ = KM_ + 8704; LAS float* VH_ = SC_ + 8448; LAS float* SP_ = KM_; LAS float* Y_ = SC_;
    const float* U = (const float*)(F.ws + O_U); const float* RQK = (const float*)(F.ws + O_RQK); const float* RST = (const float*)(F.ws + O_RST); bf16* Y = (bf16*)(F.ws + O_Y);
    int tid = F.tid, w = F.wave; asm volatile("" : "+v"(tid), "+s"(w));
    const int lane = tid & 63; const float lg = ret_logg(h);
    const f32x4 z4 = (f32x4){0.f, 0.f, 0.f, 0.f};
    f32x4 qv[2], kv[4], spv[4], vv[2][4], gv[4];
#pragma unroll
    for (int k = 0; k < 2; ++k) { const int idx = tid + 512 * k, i = idx >> 4, c4 = idx & 15, row = crow(c, 64 * ih + i); qv[k] = row >= 0 ? *(const f32x4*)(RQK + (size_t)row * 512 + 64 * h + 4 * c4) : z4; }
#pragma unroll
    for (int k = 0; k < 4; ++k) { const int idx = tid + 512 * k, j = idx >> 4, c4 = idx & 15, row = crow(c, j); kv[k] = row >= 0 ? *(const f32x4*)(RQK + (size_t)row * 512 + 256 + 64 * h + 4 * c4) : z4; }
#pragma unroll
    for (int k = 0; k < 4; ++k) { const int idx = tid + 512 * k, vx = idx >> 4, c4 = idx & 15; spv[k] = *(const f32x4*)(RST + ((size_t)(c * 4 + h) * 128 + vx) * 64 + 4 * c4); }
#pragma unroll
    for (int jh = 0; jh < 2; ++jh)
#pragma unroll
        for (int k = 0; k < 4; ++k) { const int idx = tid + 512 * k, j = idx >> 5, c4 = idx & 31, row = crow(c, 64 * jh + j); vv[jh][k] = (jh <= ih && row >= 0) ? *(const f32x4*)(U + (size_t)row * NINP + U_RET + 512 + 128 * h + 4 * c4) : z4; }
    const int li = tid >> 3, part = tid & 7, lrow = crow(c, 64 * ih + li);
#pragma unroll
    for (int k = 0; k < 4; ++k) gv[k] = lrow >= 0 ? *(const f32x4*)(U + (size_t)lrow * NINP + U_RET + 1024 + 128 * h + 16 * part + 4 * k) : z4;
    __syncthreads();
#pragma unroll
    for (int k = 0; k < 2; ++k) { const int idx = tid + 512 * k, i = idx >> 4, c4 = idx & 15; const f32x4 v = qv[k]; *(LAS f32x4*)(Q_ + i * 68 + 4 * c4) = v; }
#pragma unroll
    for (int k = 0; k < 4; ++k) { const int idx = tid + 512 * k, j = idx >> 4, c4 = idx & 15; const f32x4 v = kv[k]; *(LAS f32x4*)(KM_ + j * 68 + 4 * c4) = v; }
    LBAR();
    const int tr = w >> 2, tc = w & 3;
    f32x16 acc_s = zero16();
    mma32bf(acc_s, Q_ + 32 * tr * 68, 68, KM_ + 32 * tc * 68, 68, 64, lane);
    LBAR();
#pragma unroll
    for (int k = 0; k < 4; ++k) { const int idx = tid + 512 * k, vx = idx >> 4, c4 = idx & 15; const f32x4 v = spv[k]; *(LAS f32x4*)(SP_ + vx * 68 + 4 * c4) = v; }
#pragma unroll
    for (int r = 0; r < 16; ++r) { const int i = 32 * tr + rreg(r, lane), j = 32 * tc + (lane & 31), il = 64 * ih + i;
        SC_[i * 132 + j] = j <= il ? acc_s[r] * expf((float)(il - j) * lg) : 0.f; }
#pragma unroll
    for (int k = 0; k < 4; ++k) { const int idx = tid + 512 * k, j = idx >> 5, c4 = idx & 31; const f32x4 v = vv[0][k]; LAS float* d = VH_ + (4 * c4) * 68 + j; d[0] = v[0]; d[68] = v[1]; d[136] = v[2]; d[204] = v[3]; }
    LBAR();
    f32x16 acc_y = zero16();
    mma32bf(acc_y, Q_ + 32 * tr * 68, 68, SP_ + 32 * tc * 68, 68, 64, lane);
#pragma unroll
    for (int r = 0; r < 16; ++r) acc_y[r] *= expf((float)(64 * ih + 32 * tr + rreg(r, lane) + 1) * lg);
    mma32bf(acc_y, SC_ + 32 * tr * 132, 132, VH_ + 32 * tc * 68, 68, 64, lane);
    if (ih) { LBAR();
#pragma unroll
        for (int k = 0; k < 4; ++k) { const int idx = tid + 512 * k, j = idx >> 5, c4 = idx & 31; const f32x4 v = vv[1][k]; LAS float* d = VH_ + (4 * c4) * 68 + j; d[0] = v[0]; d[68] = v[1]; d[136] = v[2]; d[204] = v[3]; }
        LBAR();
        mma32bf(acc_y, SC_ + 32 * tr * 132 + 64, 132, VH_ + 32 * tc * 68, 68, 64, lane); }
    LBAR();
#pragma unroll
    for (int r = 0; r < 16; ++r) Y_[(32 * tr + rreg(r, lane)) * 132 + 32 * tc + (lane & 31)] = acc_y[r];
    LBAR();
    { const LAS float* yr = Y_ + li * 132 + 16 * part;
      float s = 0.f;
#pragma unroll
      for (int k = 0; k < 16; ++k) s += yr[k];
      s = sum8(s);
      const float mu = s * (1.0f / 128.0f); float q = 0.f;
#pragma unroll
      for (int k = 0; k < 16; ++k) { const float d = yr[k] - mu; q += d * d; }
      q = sum8(q);
      const float rstd = 1.0f / sqrtf(q * (1.0f / 128.0f) + EPS);
      if (lrow >= 0) { const float* ng = F.kp->in[I_RETN] + l * 512 + 128 * h + 16 * part; float ov[16];
#pragma unroll
          for (int k = 0; k < 16; ++k) ov[k] = (yr[k] - mu) * rstd * ng[k] * siluf_(gv[k >> 2][k & 3]);
          bf16* yd = Y + (size_t)lrow * D + 1024 + 128 * h + 16 * part;
          v4u w0, w1; w0.x = cvtpk(ov[0], ov[1]); w0.y = cvtpk(ov[2], ov[3]); w0.z = cvtpk(ov[4], ov[5]); w0.w = cvtpk(ov[6], ov[7]); w1.x = cvtpk(ov[8], ov[9]); w1.y = cvtpk(ov[10], ov[11]); w1.z = cvtpk(ov[12], ov[13]); w1.w = cvtpk(ov[14], ov[15]);
          *(v4u*)yd = w0; *(v4u*)(yd + 8) = w1; } }
}
__device__ __forceinline__ void m4_phase(const Ctx& F, int l, int qi = 0, int only = -1) {
    unsigned* ctr = (unsigned*)(F.ws + O_CTL) + CW_QUEUE + 64 * (4 * l + qi);
    constexpr int N_AT = 4 * NCH, N_CV = 128, N_SO = NCH * 16, N_RO = NCH * 8, N_WO = NRC * 8, N_ALL = N_AT + N_CV + N_SO + N_RO + N_WO;
    int u = queue_next(F, ctr);
    while (u < N_AT) { if (only < 0) attn_unit<0>(F, u & 3, (NCH - 1) - (u >> 2)); else if (only == 0) attn_unit<DUP_VAR>(F, u & 3, (NCH - 1) - (u >> 2), O_QKV); u = queue_next(F, ctr); }
    while (u < N_AT + N_CV) { if (l + 1 < DEPTH && only < 0) { __syncthreads(); convert_layer(F, l + 1, (u - N_AT) * NWAVES + F.wave, N_CV * NWAVES); }
        u = queue_next(F, ctr); }
    while (u < N_AT + N_CV + N_SO + N_RO) { int v = u - N_AT - N_CV;
        if (v < N_RO) { const int c = v >> 3, h = (v >> 1) & 3, ih = v & 1; if (!(c == 0 && ih == 0) && (only < 0 || only == 2)) ret_out_unit(F, l, c, h, ih); }
        else { v -= N_RO; const int c = v >> 4, h = (v >> 1) & 7, ih = v & 1; if (!(c == 0 && ih == 0) && (only < 0 || only == 1)) ssd_out_unit(F, l, c, h, ih); }
        u = queue_next(F, ctr); }
    if (u < N_ALL && only < 0) {
        if (F.tid == 0) { unsigned* sflag = (unsigned*)(F.ws + O_CTL) + CW_QUEUE + 64 * (16 + l); const unsigned nscan = F.G >= 64 ? 32u : (unsigned)F.G; unsigned sp = 0;
            while (__hip_atomic_load(sflag, __ATOMIC_RELAXED, __HIP_MEMORY_SCOPE_AGENT) < nscan) { __builtin_amdgcn_s_sleep(8); if (++sp > (1u << 22)) break; }
            __builtin_amdgcn_fence(__ATOMIC_ACQUIRE, "agent"); asm volatile("s_waitcnt vmcnt(0)" ::: "memory"); }
        __syncthreads(); }
    while (u < N_ALL) { const int v = u - (N_AT + N_CV + N_SO + N_RO); if (only < 0 || only == 3) rwkv_out_unit(F, l, v >> 3, v & 7); u = queue_next(F, ctr); }
}
__device__ __forceinline__ void m5_phase(const Ctx& F, int l) {
#ifdef PROBE_DUP
    { const bf16* Y = (const bf16*)(F.ws + O_Y); const bf16* Y2 = (const bf16*)(F.ws + O_YZ); unsigned cnt = 0;
      for (int row = F.bid * NWAVES + F.wave; row < T; row += F.G * NWAVES) for (int j = 0; j < 8; ++j) cnt += Y[(size_t)row * D + 64 * j + F.lane] != Y2[(size_t)row * D + 64 * j + F.lane];
      if (cnt) atomicAdd((unsigned*)(F.ws + O_CTL) + 8, cnt); }
#endif
#ifdef PROBE_COPY_U
    { const float* U = (const float*)(F.ws + O_U); bf16* Y = (bf16*)(F.ws + O_Y);
      for (int row = F.bid * NWAVES + F.wave; row < T; row += F.G * NWAVES)
        for (int j = 0; j < 4; ++j) { const float* ur = U + (size_t)(PROBE_COPY_META ? SEQ + (row & 15) : row) * NINP + PROBE_COPY_U + 512 * j + 8 * F.lane; const f32x4 a = *(const f32x4*)ur, b = *(const f32x4*)(ur + 4);
          v4u w; w.x = pk2(a[0], a[1]); w.y = pk2(a[2], a[3]); w.z = pk2(b[0], b[1]); w.w = pk2(b[2], b[3]); *(v4u*)(Y + (size_t)row * D + 512 * j + 8 * F.lane) = w; } }
#endif
    if (!EN_SSD) return;
    const float* YZ = (const float*)(F.ws + O_YZ); bf16* Y = (bf16*)(F.ws + O_Y); const float* ng = F.kp->in[I_SSDN] + l * 512 + 8 * F.lane;
    for (int row = F.bid * NWAVES + F.wave; row < T; row += F.G * NWAVES) { const float* yr = YZ + (size_t)row * 512 + 8 * F.lane; const f32x4 a = *(const f32x4*)yr, b = *(const f32x4*)(yr + 4);
        const float sq = wave_sum((a[0] * a[0] + a[1] * a[1]) + (a[2] * a[2] + a[3] * a[3]) + (b[0] * b[0] + b[1] * b[1]) + (b[2] * b[2] + b[3] * b[3]));
        const float rs = 1.0f / sqrtf(sq * (1.0f / 512.0f) + EPS); const f32x4 g0 = *(const f32x4*)ng, g1 = *(const f32x4*)(ng + 4);
        v4u w; w.x = pk2(a[0] * rs * g0[0], a[1] * rs * g0[1]); w.y = pk2(a[2] * rs * g0[2], a[3] * rs * g0[3]); w.z = pk2(b[0] * rs * g1[0], b[1] * rs * g1[1]); w.w = pk2(b[2] * rs * g1[2], b[3] * rs * g1[3]);
        *(v4u*)(Y + (size_t)row * D + 512 + 8 * F.lane) = w; }
}
template <int MODE  , int NT>
__device__ __forceinline__ void meta_gemm(const Ctx& F, const bf16* A16, int lda, const bf16* Bt, int ldb, int ntasks, int K, float* Cf, int ldc, const float* ss_in, float* ss_out, bf16* Ob, bf16* HL, float scale) {
    constexpr int NACC = MODE == 1 ? 2 * NT : NT;
    LAS float* red = (LAS float*)F.lds;
    int tid = F.tid, w = F.wave; asm volatile("" : "+v"(tid), "+s"(w));
    const int lane = tid & 63, g = lane >> 4, c = lane & 15, kper = K >> 3;
    for (int task = F.G - 1 - F.bid; task < ntasks; task += F.G) {
        const int n0 = MODE == 1 ? 256 * ((64 * task) >> 7) + ((64 * task) & 127) : 16 * NT * task;
        f32x4 acc[NACC];
#pragma unroll
        for (int q = 0; q < NACC; ++q) acc[q] = (f32x4){0.f, 0.f, 0.f, 0.f};
        const bf16* ap = A16 + (size_t)c * lda + w * kper + 8 * g; const bf16* bp = Bt + (size_t)(n0 + c) * ldb + w * kper + 8 * g;
#pragma unroll 4
        for (int kk = 0; kk < kper; kk += 32) { const bf16x8 a = *(const bf16x8*)(ap + kk);
#pragma unroll
            for (int t = 0; t < NT; ++t) { acc[t] = __builtin_amdgcn_mfma_f32_16x16x32_bf16(*(const bf16x8*)(bp + (size_t)(16 * t) * ldb + kk), a, acc[t], 0, 0, 0);
                if (MODE == 1) acc[NT + t] = __builtin_amdgcn_mfma_f32_16x16x32_bf16(*(const bf16x8*)(bp + (size_t)(128 + 16 * t) * ldb + kk), a, acc[NT + t], 0, 0, 0); } }
        __syncthreads();
#pragma unroll
        for (int q = 0; q < NACC; ++q) *(LAS f32x4*)(red + ((w * NACC + q) * 64 + lane) * 4) = acc[q];
        __syncthreads();
        if (w == 0) { const int row = SEQ + c; float rs = 1.0f;
            if (ss_in) { float s = 0.f;
#pragma unroll
                for (int q = 0; q < 8; ++q) { const f32x4 x = *(const f32x4*)(ss_in + (size_t)row * 32 + 4 * q); s += (x[0] + x[1]) + (x[2] + x[3]); }
                rs = __builtin_amdgcn_rsqf(s * (1.0f / 2048.0f) + EPS); }
            float sq = 0.f;
#pragma unroll
            for (int t = 0; t < NT; ++t) { f32x4 v = (f32x4){0.f, 0.f, 0.f, 0.f}, v2 = v;
#pragma unroll
                for (int ww = 0; ww < 8; ++ww) { v = v + *(const LAS f32x4*)(red + ((ww * NACC + t) * 64 + lane) * 4); if (MODE == 1) v2 = v2 + *(const LAS f32x4*)(red + ((ww * NACC + NT + t) * 64 + lane) * 4); }
                if (MODE == 0) *(f32x4*)(Cf + (size_t)row * ldc + 16 * NT * task + 16 * t + 4 * g) = v * rs;
                if (MODE == 3) { v2u wv; wv.x = pk2(v[0] * rs, v[1] * rs); wv.y = pk2(v[2] * rs, v[3] * rs); *(v2u*)(Ob + (size_t)row * ldc + 16 * NT * task + 16 * t + 4 * g) = wv; }
                if (MODE == 1) { float o[4];
#pragma unroll
                    for (int i = 0; i < 4; ++i) { const float gv = v[i] * rs, uv = v2[i] * rs; o[i] = gv * uv * __builtin_amdgcn_rcpf(1.0f + __expf(-gv)); }
                    v2u wv; wv.x = pk2(o[0], o[1]); wv.y = pk2(o[2], o[3]); *(v2u*)(Ob + (size_t)row * DFF + 64 * task + 16 * t + 4 * g) = wv; }
                if (MODE == 2) { const size_t off = (size_t)row * D + 64 * task + 16 * t + 4 * g; const v2u hi = *(const v2u*)(Ob + off), lo = *(const v2u*)(HL + off);
                    f32x4 h4 = (f32x4){pg8::bflo(hi.x) + pg8::bflo(lo.x), pg8::bfhi(hi.x) + pg8::bfhi(lo.x), pg8::bflo(hi.y) + pg8::bflo(lo.y), pg8::bfhi(hi.y) + pg8::bfhi(lo.y)}; h4 = h4 + v * scale;
                    v2u wv; wv.x = cvtpk(h4[0], h4[1]); wv.y = cvtpk(h4[2], h4[3]); v2u lv; lv.x = cvtpk(h4[0] - pg8::bflo(wv.x), h4[1] - pg8::bfhi(wv.x)); lv.y = cvtpk(h4[2] - pg8::bflo(wv.y), h4[3] - pg8::bfhi(wv.y));
                    *(v2u*)(Ob + off) = wv; *(v2u*)(HL + off) = lv; sq += (h4[0] * h4[0] + h4[1] * h4[1]) + (h4[2] * h4[2] + h4[3] * h4[3]); } }
            if (MODE == 2 && ss_out) { sq += __shfl_xor(sq, 16); sq += __shfl_xor(sq, 32); if (g == 0) __hip_atomic_fetch_add(ss_out + (size_t)row * 32 + task, sq, __ATOMIC_RELAXED, __HIP_MEMORY_SCOPE_AGENT); } }
    }    __syncthreads();
}
__device__ __forceinline__ void gemm_swiglu(const Ctx& F, int hl, int ssidx) {
    const bf16* A = (const bf16*)(F.ws + O_HB); const bf16* Bt = (const bf16*)(F.ws + O_WGU) + (size_t)hl * 11264 * 2048; const float* ss = (const float*)(F.ws + O_SS) + (size_t)ssidx * MP * 32;
    { pg8::Gemm g{A, Bt, SEQ, 11264, 2048, 2048, 2048, F.wave}; pg8::StaticOrder S; S.init(SEQ, 11264, F.G, F.bid);
      const int full = (S.nwg / F.G) * F.G, rem = S.nwg - full;
      const bool split = false && (2 * rem == F.G);
      if (split) S.lim = full;
      pg8::EpiSwiGLU E{(bf16*)(F.ws + O_ACT), DFF, ss, 1.0f / 2048.0f, EPS, 2};
      pg8::gemm_phase<pg8::EpiSwiGLU, pg8::StaticOrder, true, true, false>(F.lds, g, S, E);
      if (split) { pg8::StaticOrder S2; S2.init(SEQ, 11264, F.G, F.bid); S2.hmbase = full;
          pg8::EpiSwiGLU E2{(bf16*)(F.ws + O_ACT), DFF, ss, 1.0f / 2048.0f, EPS, 1};
          pg8::gemm_phase<pg8::EpiSwiGLU, pg8::StaticOrder, true, true, true>(F.lds, g, S2, E2); } }
    meta_gemm<1, 4>(F, A + (size_t)SEQ * 2048, 2048, Bt, 2048, DFF / 64, 2048, nullptr, 0, ss, nullptr, (bf16*)(F.ws + O_ACT), nullptr, 0.f);
}
__device__ __forceinline__ void gemm_residual(const Ctx& F, const bf16* A, const bf16* Bt, int K, int ssidx, bool to_out, float scale) {
    float* sso = ssidx >= 0 ? (float*)(F.ws + O_SS) + (size_t)ssidx * MP * 32 : nullptr;
    { pg8::Gemm g{A, Bt, SEQ, 2048, K, K, K, F.wave}; pg8::StaticOrder S; S.init(SEQ, 2048, F.G, F.bid);
      pg8::EpiResidual E{(bf16*)(F.ws + O_H), (bf16*)(F.ws + O_HB), sso, to_out ? F.kp->out : nullptr, SEQ, scale};
      pg8::gemm_phase<pg8::EpiResidual, pg8::StaticOrder, true, true>(F.lds, g, S, E); }
    meta_gemm<2, 4>(F, A + (size_t)SEQ * K, K, Bt, K, 32, K, nullptr, 0, nullptr, sso, (bf16*)(F.ws + O_HB), (bf16*)(F.ws + O_H), scale);
}
__device__ __forceinline__ void gemm_residual_dummy(const Ctx& F, const bf16* A, const bf16* Bt, int K) {
    { pg8::Gemm g{A, Bt, SEQ, 2048, K, K, K, F.wave}; pg8::StaticOrder S; S.init(SEQ, 2048, F.G, F.bid);
      pg8::EpiResidual E{(bf16*)(F.ws + O_RW), (bf16*)(F.ws + O_RW + (size_t)72 * 1024 * 1024), nullptr, nullptr, SEQ, 0.5f};
      pg8::gemm_phase<pg8::EpiResidual, pg8::StaticOrder, true, true>(F.lds, g, S, E); }
}
__device__ __forceinline__ void gemm_scalef32(const Ctx& F, const bf16* A, const bf16* Bt, int N, int K, float* C, int ssidx) {
    const float* ss = ssidx >= 0 ? (const float*)(F.ws + O_SS) + (size_t)ssidx * MP * 32 : nullptr;
    { pg8::Gemm g{A, Bt, SEQ, N, K, K, K, F.wave}; pg8::StaticOrder S; S.init(SEQ, N, F.G, F.bid);
      pg8::EpiScaleF32 E{C, N, ss, 1.0f / 2048.0f, EPS};
      pg8::gemm_phase<pg8::EpiScaleF32, pg8::StaticOrder, true, true>(F.lds, g, S, E); }
    meta_gemm<0, 4>(F, A + (size_t)SEQ * K, K, Bt, K, N / 64, K, C, N, ss, nullptr, nullptr, nullptr, 0.f);
}
__global__ void __launch_bounds__(NTHR, 2) hybrid_fwd(P p) {
    extern __shared__ __attribute__((aligned(16))) unsigned char lds_raw[];
    LAS unsigned char* lds = (LAS unsigned char*)lds_raw;
    const int wv = __builtin_amdgcn_readfirstlane((int)threadIdx.x >> 6);
    for (int u = threadIdx.x; u < (LDS_BYTES - LDSCTL_OFF) / 4; u += NTHR) ((LAS unsigned*)(lds + LDSCTL_OFF))[u] = 0u;
    __syncthreads();
    XcdBarrier bar = xcd_barrier_post((unsigned*)(p.ws + O_CTL) + CW_BAR, (volatile LAS unsigned*)(lds + LDSCTL_OFF), wv);
    const int lo = p.ph_lo, hi = p.ph_hi;
#ifdef TIME_MASK
    if (blockIdx.x == TIME_BLK && threadIdx.x == 0) { volatile LAS unsigned long long* tp_ = (volatile LAS unsigned long long*)(lds + LDSCTL_OFF + 1024); tp_[0] = wall_clock64(); tp_[1] = 0ull; }
#endif
#define IN(k) (lo <= (k) && (k) < hi)
#ifdef TIME_MASK
#ifndef TIME_PRE
#define TIME_PRE 0
#endif
#ifndef TIME_BLK
#define TIME_BLK 0
#endif
#define TMARK(kind, post) do { if (blockIdx.x == TIME_BLK && threadIdx.x == 0) { const unsigned long long now_ = wall_clock64(); volatile LAS unsigned long long* tp_ = (volatile LAS unsigned long long*)(lds + LDSCTL_OFF + 1024); \
    if ((((post) ? TIME_MASK : TIME_PRE) >> (kind)) & 1) tp_[1] += now_ - tp_[0]; if (post) tp_[0] = now_; } } while (0)
#define SEAM(k, kind) do { TMARK(kind, 0); if (IN(k) && IN((k) + 1)) xcd_barrier(bar, wv); TMARK(kind, 1); } while (0)
#else
#define TMARK(kind, post) do { } while (0)
#define SEAM(k, kind) do { if (IN(k) && IN((k) + 1)) xcd_barrier(bar, wv); } while (0)
#endif
#ifndef NO_P0
    if (IN(0)) { const Ctx F = ctx_make(lds, wv); p0_prologue(F, 0); }
#ifdef DUP_CVT
    if (IN(0)) { const Ctx F = ctx_make(lds, wv); p0_prologue(F, 1); }
#endif
#endif
    SEAM(0, 0);
    for (int hl = 0; hl < 8; ++hl) {
        const int l = hl >> 1, second = hl & 1, base = 1 + 11 * l + (second ? 9 : 0);
        if (IN(base)) { const Ctx F = ctx_make(lds, wv); gemm_swiglu(F, hl, 3 * l + (second ? 2 : 0)); }
#ifdef DUP_GU
        if (IN(base)) { const Ctx F = ctx_make(lds, wv); gemm_swiglu(F, hl, 3 * l + (second ? 2 : 0)); }
#endif
        SEAM(base, 1);
        if (IN(base + 1)) { const Ctx F = ctx_make(lds, wv);
            gemm_residual(F, (const bf16*)(F.ws + O_ACT), (const bf16*)(F.ws + O_WD) + (size_t)hl * 2048 * 5632, 5632, second ? (l < 3 ? 3 * (l + 1) : -1) : 3 * l + 1, hl == 7, 0.5f); }
#ifdef DUP_DOWN
        if (IN(base + 1)) { const Ctx F = ctx_make(lds, wv); if (DUP_DOWN == 1) gemm_residual_dummy(F, (const bf16*)(F.ws + O_ACT), (const bf16*)(F.ws + O_WD) + (size_t)hl * 2048 * 5632, 5632); else gemm_residual_dummy(F, (const bf16*)(F.ws + O_Y), (const bf16*)(F.ws + O_WOUT) + (size_t)l * D * D, 2048); }
#endif
        if (hl < 7) SEAM(base + 1, 2);
        if (!second) {
            const int mb = base + 2;
            if (IN(mb)) { const Ctx F = ctx_make(lds, wv); gemm_scalef32(F, (const bf16*)(F.ws + O_HB), (const bf16*)(F.ws + O_WIN) + (size_t)l * NINP * D, NINP, 2048, (float*)(F.ws + O_U), 3 * l + 1); }
#ifdef DUP_WIN
            if (IN(mb)) { const Ctx F = ctx_make(lds, wv); gemm_scalef32(F, (const bf16*)(F.ws + O_HB), (const bf16*)(F.ws + O_WIN) + (size_t)l * NINP * D, NINP, 2048, (float*)(F.ws + O_U), 3 * l + 1); }
#endif
            SEAM(mb, 3);
#ifndef NO_M1
            if (IN(mb + 1)) { const Ctx F = ctx_make(lds, wv); m1_phase(F, l); }
#ifdef DUP_M1
            if (IN(mb + 1)) { const Ctx F = ctx_make(lds, wv); m1_phase(F, l, 3); }
#endif
#endif
            SEAM(mb + 1, 4);
            if (IN(mb + 2)) {
                if (EN_MLA) { const Ctx F = ctx_make(lds, wv); gemm_scalef32(F, (const bf16*)(F.ws + O_AMLA), (const bf16*)(F.ws + O_WMLA) + (size_t)l * MLAN * 512, MLAN, 512, (float*)(F.ws + O_QKV), -1); }
#ifndef NO_M2
                { const Ctx F = ctx_make(lds, wv); unsigned* ctr = (unsigned*)(F.ws + O_CTL) + CW_QUEUE + 64 * (4 * l + 2);
                  for (;;) { int u = queue_next(F, ctr); if (u >= NRC * 8 + NCH * 8 + NCH * 4) break;
                      if (u < NRC * 8) { rwkv_chunk_unit(F, u >> 3, u & 7); continue; } u -= NRC * 8;
                      if (u < NCH * 8) { ssd_states_unit(F, u >> 3, u & 7); continue; } u -= NCH * 8;
                      ret_states_unit(F, u >> 2, u & 3); } }
#ifdef DUP_M2Q
                { const Ctx F = ctx_make(lds, wv); unsigned* ctr = (unsigned*)(F.ws + O_CTL) + CW_QUEUE + 64 * (4 * l + 3);
                  for (;;) { int u = queue_next(F, ctr); if (u >= NRC * 8 + NCH * 8 + NCH * 4) break;
                      if (u < NRC * 8) { rwkv_chunk_unit(F, u >> 3, u & 7); continue; } u -= NRC * 8;
                      if (u < NCH * 8) { ssd_states_unit(F, u >> 3, u & 7); continue; } u -= NCH * 8;
                      ret_states_unit(F, u >> 2, u & 3); } }
#endif
#endif
            }
            SEAM(mb + 2, 5);
#ifndef NO_M3
            if (IN(mb + 3)) { const Ctx F = ctx_make(lds, wv); m3_phase(F, l); }
#ifdef DUP_SCAN
            if (IN(mb + 3)) { const Ctx F = ctx_make(lds, wv); if (F.bid < 32) rwkv_state_scan<DUP_SCAN>(F, F.bid >> 2, F.bid & 3); }
#endif
#endif
            SEAM(mb + 3, 6);
#ifndef NO_M4
            if (IN(mb + 4)) { const Ctx F = ctx_make(lds, wv); const int nscan = F.G >= 64 ? 32 : F.G;
                if (F.bid < nscan) { for (int s = F.bid; s < 32; s += nscan) rwkv_state_scan<0>(F, s >> 2, s & 3);
                    asm volatile("s_waitcnt vmcnt(0)" ::: "memory"); __syncthreads();
                    if (F.tid == 0) { __builtin_amdgcn_fence(__ATOMIC_RELEASE, "agent"); asm volatile("s_waitcnt vmcnt(0)" ::: "memory"); __hip_atomic_fetch_add((unsigned*)(F.ws + O_CTL) + CW_QUEUE + 64 * (16 + l), 1u, __ATOMIC_RELAXED, __HIP_MEMORY_SCOPE_AGENT); } } }
            if (IN(mb + 4)) { const Ctx F = ctx_make(lds, wv); m4_phase(F, l); }
#ifdef DUP_M4
            if (IN(mb + 4)) { const Ctx F = ctx_make(lds, wv); m4_phase(F, l, 3, DUP_M4 - 1); }
#endif
#endif
            SEAM(mb + 4, 7);
#ifndef NO_M5
            if (IN(mb + 5)) { const Ctx F = ctx_make(lds, wv); m5_phase(F, l); }
#ifdef DUP_M5
            if (IN(mb + 5)) { const Ctx F = ctx_make(lds, wv); m5_phase(F, l); }
#endif
#endif
            SEAM(mb + 5, 8);
#ifdef DUP_BAR
            for (int q = 0; q < 8; ++q) xcd_barrier(bar, wv);
#endif
            if (IN(mb + 6)) { const Ctx F = ctx_make(lds, wv); gemm_residual(F, (const bf16*)(F.ws + O_Y), (const bf16*)(F.ws + O_WOUT) + (size_t)l * D * D, 2048, 3 * l + 2, false, 1.0f); }
            SEAM(mb + 6, 9);
        }
    }
#ifdef TIME_MASK
    TMARK(2, 0); TMARK(2, 1);
    if (blockIdx.x == TIME_BLK && threadIdx.x == 0) { volatile LAS unsigned long long* tp_ = (volatile LAS unsigned long long*)(lds + LDSCTL_OFF + 1024); const unsigned long long t0_ = tp_[0], d_ = tp_[1];
        while (wall_clock64() - t0_ < d_) __builtin_amdgcn_s_sleep(8); }
#endif
#ifdef PROBE_DUP
    xcd_barrier(bar, wv);
    { const Ctx F = ctx_make(lds, wv); const float v = (float)__hip_atomic_load((unsigned*)(F.ws + O_CTL) + 8, __ATOMIC_RELAXED, __HIP_MEMORY_SCOPE_AGENT); float* out = F.kp->out;
      for (size_t i = (size_t)F.bid * NTHR + F.tid; i < (size_t)SEQ * D; i += (size_t)F.G * NTHR) out[i] = v; }
#endif
#ifdef PROBE_ADD_META
    xcd_barrier(bar, wv);
    { const Ctx F = ctx_make(lds, wv); const float* H = (const float*)(F.ws + O_H); float* out = F.kp->out;
      for (int row = F.bid * NWAVES + F.wave; row < SEQ; row += F.G * NWAVES)
        for (int j = 0; j < 8; ++j) { const int c = 256 * j + 4 * F.lane; f32x4 v = *(f32x4*)(out + (size_t)row * D + c); v = v + *(const f32x4*)(H + (size_t)(SEQ + (row & 15)) * D + c); *(f32x4*)(out + (size_t)row * D + c) = v; } }
#endif
#undef IN
#undef SEAM
}

extern "C" void kernel_launch(void* const* d_in, const int* in_sizes, int n_in, void* d_out, int out_size, void* d_ws, size_t ws_size, hipStream_t stream) {
    static int grid = 0;
    if (grid == 0) {
        if (n_in != 36 || out_size != SEQ * D || ws_size < WS_END) { fprintf(stderr, "kernel_launch: expected 36 inputs, out %d, ws >= %zu; got n_in %d out %d ws %zu\n", SEQ * D, (size_t)WS_END, n_in, out_size, ws_size); grid = -1; return; }
        int dev = 0, cus = 0, per_cu = 0;
        if (hipGetDevice(&dev) != hipSuccess || hipDeviceGetAttribute(&cus, hipDeviceAttributeMultiprocessorCount, dev) != hipSuccess) { grid = -1; return; }
        if (hipFuncSetAttribute((const void*)hybrid_fwd, hipFuncAttributeMaxDynamicSharedMemorySize, LDS_BYTES) != hipSuccess) { fprintf(stderr, "kernel_launch: hipFuncSetAttribute failed\n"); grid = -1; return; }
        if (hipOccupancyMaxActiveBlocksPerMultiprocessor(&per_cu, (const void*)hybrid_fwd, NTHR, LDS_BYTES) != hipSuccess || per_cu < 1) fprintf(stderr, "kernel_launch: occupancy query reports %d\n", per_cu);
        (void)hipGetLastError();
        grid = cus;
    }
    if (grid < 0) return;
    if (hipMemsetAsync((char*)d_ws + O_CTL, 0, SZ_CTL, stream) != hipSuccess) { fprintf(stderr, "kernel_launch: memset failed\n"); return; }
    P a{};
    for (int i = 0; i < 36; ++i) a.in[i] = (const float*)d_in[i];
    a.out = (float*)d_out; a.ws = (unsigned char*)d_ws;
#if PER_PHASE_LAUNCH
    for (int ph = 0; ph < NPHASE; ++ph) { a.ph_lo = ph; a.ph_hi = ph + 1; hipLaunchKernelGGL(hybrid_fwd, dim3(grid), dim3(NTHR), LDS_BYTES, stream, a); }
#else
    a.ph_lo = 0; a.ph_hi = NPHASE;
    hipLaunchKernelGGL(hybrid_fwd, dim3(grid), dim3(NTHR), LDS_BYTES, stream, a);
#endif
    const hipError_t le = hipPeekAtLastError();
    if (le != hipSuccess) fprintf(stderr, "kernel_launch: launch failed: %s\n", hipGetErrorName(le));
}
```

```cpp
#include <hip/hip_runtime.h>
#include <cstdio>
#include <cstdint>

#define GAS __attribute__((address_space(1)))
#define LAS __attribute__((address_space(3)))
typedef unsigned short bf16;
typedef unsigned v4u __attribute__((ext_vector_type(4)));
typedef unsigned v2u __attribute__((ext_vector_type(2)));
typedef float f32x4 __attribute__((ext_vector_type(4)));
typedef float f32x2 __attribute__((ext_vector_type(2)));
typedef float f32x16 __attribute__((ext_vector_type(16)));
typedef short bf16x8 __attribute__((ext_vector_type(8)));

constexpr int D = 2048, SEQ = 8192, NMETA = 16, T = SEQ + NMETA, MP = 8448, DFF = 5632, DEPTH = 4;
constexpr int NIN = 5320, NINP = 5376, NCH = 65, TSEQ = 8320, MLAN = 1792;
constexpr int U_MLA = 0, U_SSD = 576, U_RET = 2120, U_RWKV = 3656;
constexpr float EPS = 1e-6f;
constexpr int NWAVES = 8, NTHR = 512;
#ifndef EN_MLA
#define EN_MLA 1
#endif
#ifndef EN_SSD
#define EN_SSD 1
#endif
#ifndef EN_RET
#define EN_RET 1
#endif
#ifndef EN_RWKV
#define EN_RWKV 1
#endif
#ifndef PROBE_NOSCAN
#define PROBE_NOSCAN 0
#endif
#ifndef PROBE_ATTCOPY
#define PROBE_ATTCOPY 0
#endif
#ifndef PROBE_COPY_META
#define PROBE_COPY_META 0
#endif
#ifndef DUP_VAR
#define DUP_VAR 0
#endif
#ifndef PER_PHASE_LAUNCH
#define PER_PHASE_LAUNCH 0
#endif
constexpr int NPHASE = 1 + 8 * 2 + 4 * 7;

constexpr size_t O_CTL = 0, SZ_CTL = 13107200;
constexpr int CW_BAR = 4096;
constexpr size_t O_SS = 65536;
constexpr size_t O_WGU = O_CTL + SZ_CTL,                 SZ_WGU = (size_t)8 * 2 * DFF * D * 2;
constexpr size_t O_WD = O_WGU + SZ_WGU,                  SZ_WD = (size_t)8 * D * DFF * 2;
constexpr size_t O_WIN = O_WD + SZ_WD,                   SZ_WIN = (size_t)4 * NINP * D * 2;
constexpr size_t O_WOUT = O_WIN + SZ_WIN,                SZ_WOUT = (size_t)4 * D * D * 2;
constexpr size_t O_WMLA = O_WOUT + SZ_WOUT,              SZ_WMLA = (size_t)4 * MLAN * 512 * 2;
constexpr size_t O_H = O_WMLA + SZ_WMLA,                 SZ_H = (size_t)MP * D * 4;
constexpr size_t O_HB = O_H + SZ_H,                      SZ_HB = (size_t)MP * D * 2;
constexpr size_t O_U = O_HB + SZ_HB,                     SZ_U = (size_t)MP * NINP * 4;
constexpr size_t O_ACT = O_U;
constexpr size_t O_AMLA = O_U + SZ_U,                    SZ_AMLA = (size_t)MP * 512 * 2;
constexpr size_t O_QKV = O_AMLA + SZ_AMLA,               SZ_QKV = (size_t)MP * MLAN * 4;
constexpr size_t O_Q = O_QKV + SZ_QKV,                   SZ_Q = (size_t)TSEQ * 768 * 2;
constexpr size_t O_K = O_Q + SZ_Q;
constexpr size_t O_VT = O_K + SZ_Q,                      SZ_VT = (size_t)4 * 128 * TSEQ * 2;
constexpr size_t O_Y = O_VT + SZ_VT,                     SZ_Y = (size_t)MP * D * 2;
constexpr size_t O_XBC = O_Y + SZ_Y,                     SZ_XBC = (size_t)MP * 1024 * 4;
constexpr size_t O_DT = O_XBC + SZ_XBC,                  SZ_DT = (size_t)MP * 8 * 4;
constexpr size_t O_LA = O_DT + SZ_DT;
constexpr size_t O_SST = O_LA + SZ_DT,                   SZ_SST = (size_t)NCH * 8 * 64 * 128 * 4;
constexpr size_t O_SDEC = O_SST + SZ_SST,                SZ_SDEC = (size_t)NCH * 8 * 128;
constexpr size_t O_YZ = O_SDEC + SZ_SDEC,                SZ_YZ = (size_t)MP * 512 * 4;
constexpr size_t O_RQK = O_YZ + SZ_YZ,                   SZ_RQK = (size_t)MP * 512 * 4;
constexpr size_t O_RST = O_RQK + SZ_RQK,                 SZ_RST = (size_t)NCH * 4 * 128 * 64 * 4;
constexpr size_t O_RW = O_RST + SZ_RST,                  SZ_RW1 = (size_t)MP * 512 * 4;
constexpr size_t O_RBON = O_RW + 8 * SZ_RW1,             SZ_RBON = (size_t)MP * 8 * 4;
constexpr size_t O_ROPE = O_RBON + SZ_RBON,              SZ_ROPE = (size_t)MP * 32 * 8;
constexpr size_t O_MATS = O_ROPE + SZ_ROPE,             SZ_MATS = (size_t)129 * 8 * 16384 * 4;
constexpr size_t O_SSTATE = O_RW + 7 * SZ_RW1;
constexpr size_t WS_END = O_MATS + SZ_MATS;
static_assert((size_t)129 * 8 * 4096 * 4 <= SZ_RW1, "sstate");
static_assert(WS_END <= 1424122240ull, "d_ws map too large");
static_assert(O_SS + (size_t)12 * MP * 32 * 4 <= SZ_CTL, "ctl map");
static_assert((size_t)MP * DFF * 2 <= SZ_U, "act overlays u");

constexpr int RING_BYTES = 131072;
constexpr int LDSCTL_OFF = 143360;
constexpr int LDS_BYTES = 147456;

#define LDS_WAIT() asm volatile("s_waitcnt lgkmcnt(0)" ::: "memory")
#define LBAR() do { asm volatile("s_waitcnt lgkmcnt(0)" ::: "memory"); __builtin_amdgcn_s_barrier(); asm volatile("" ::: "memory"); } while (0)
constexpr int CW_QUEUE = 8192;
#define VM_WAIT() asm volatile("s_waitcnt vmcnt(0)" ::: "memory")
__device__ __forceinline__ unsigned f2bf(float f) { unsigned u = __builtin_bit_cast(unsigned, f); return (u + 0x7fffu + ((u >> 16) & 1u)) >> 16; }
__device__ __forceinline__ unsigned pk2(float lo, float hi) { return f2bf(lo) | (f2bf(hi) << 16); }
typedef __bf16 bf16x2_t __attribute__((ext_vector_type(2)));
__device__ __forceinline__ unsigned cvtpk(float lo, float hi) { const f32x2 v = {lo, hi}; return __builtin_bit_cast(unsigned, __builtin_convertvector(v, bf16x2_t)); }
__device__ __forceinline__ int lane_id() { unsigned ones = ~0u; asm volatile("" : "+s"(ones)); return (int)__builtin_amdgcn_mbcnt_hi(ones, __builtin_amdgcn_mbcnt_lo(ones, 0u)); }
template <int CTRL> __device__ __forceinline__ float dpp_(float v) { return __builtin_bit_cast(float, __builtin_amdgcn_update_dpp(0, __builtin_bit_cast(int, v), CTRL, 0xF, 0xF, true)); }
__device__ __forceinline__ float rdlane(float v, int l) { return __builtin_bit_cast(float, __builtin_amdgcn_readlane(__builtin_bit_cast(int, v), l)); }
__device__ __forceinline__ float sum4(float v) { v += dpp_<0xB1>(v); v += dpp_<0x4E>(v); return v; }
__device__ __forceinline__ float sum8(float v) { v = sum4(v); v += dpp_<0x141>(v); return v; }
__device__ __forceinline__ float sum16(float v) { v = sum8(v); v += dpp_<0x140>(v); return v; }
__device__ __forceinline__ float wave_sum(float v) { v = sum16(v); return (rdlane(v, 0) + rdlane(v, 16)) + (rdlane(v, 32) + rdlane(v, 48)); }
__device__ __forceinline__ float sum32(float v, int lane) { v = sum16(v); const float lo = rdlane(v, 0) + rdlane(v, 16), hi = rdlane(v, 32) + rdlane(v, 48); return (lane & 32) ? hi : lo; }
__device__ __forceinline__ float xor32f(float v, int lane) {
    const unsigned x = __builtin_bit_cast(unsigned, v); const auto r = __builtin_amdgcn_permlane32_swap(x, x, false, false);
    return __builtin_bit_cast(float, (lane & 32) ? r[0] : r[1]); }
__device__ __forceinline__ float sigmoidf_(float x) { return 1.0f / (1.0f + __expf(-x)); }
__device__ __forceinline__ float siluf_(float x) { return x / (1.0f + __expf(-x)); }
__device__ __forceinline__ float softplusf_(float x) { return x > 20.f ? x : log1pf(expf(x)); }
struct UB { const bf16* p;
    __device__ __forceinline__ float operator[](size_t i) const { return __builtin_bit_cast(float, (unsigned)p[i] << 16); }
    __device__ __forceinline__ UB operator+(size_t o) const { return UB{p + o}; } };
__device__ __forceinline__ f32x4 ldu4(const UB u) { const v2u w = *(const v2u*)u.p;
    return (f32x4){__builtin_bit_cast(float, w.x << 16), __builtin_bit_cast(float, w.x & 0xffff0000u), __builtin_bit_cast(float, w.y << 16), __builtin_bit_cast(float, w.y & 0xffff0000u)}; }
__device__ __forceinline__ int row_of_seq(int s) { return s < NMETA ? SEQ + s : s - NMETA; }
__device__ __forceinline__ int seq_of_row(int r) { return r >= SEQ ? r - SEQ : r + NMETA; }
__device__ __forceinline__ int prev_row(int r) { return r == SEQ ? -1 : (r == 0 ? T - 1 : r - 1); }
__device__ __forceinline__ int crow(int c, int p) { return c == 0 ? (p >= 112 ? SEQ + p - 112 : -1) : 128 * (c - 1) + p; }
namespace pg8 {
#define PG8_LAS __attribute__((address_space(3)))
typedef unsigned short bf16_t;
typedef short bf16x8 __attribute__((ext_vector_type(8)));
typedef float f32x4 __attribute__((ext_vector_type(4)));
typedef unsigned u32x4 __attribute__((ext_vector_type(4)));
constexpr int BM = 256, BK = 64, HALF = 128, HTB = HALF * BK * 2  , STAGE_BYTES = 8 * HTB, NXCD = 8, WGM = 8;

__host__ __device__ __forceinline__ int lds_byte(int r, int c) { const int st = (r >> 4) * 2 + (c >> 5), rr = r & 15, cc = c & 31, ob = rr * 64 + cc * 2; return st * 1024 + (ob ^ (((ob >> 9) & 1) << 5)); }
__host__ __device__ __forceinline__ void stage_rc(int b, int& R, int& C) { const int st = b / 1024, sb = b % 1024, swz = sb ^ (((sb >> 9) & 1) << 5); R = (st >> 1) * 16 + swz / 64; C = (st & 1) * 32 + (swz % 64) / 2; }
__host__ __device__ __forceinline__ int perm32(int rho) { const int n = rho >> 4, i = rho & 15; return 8 * (i >> 2) + 4 * n + (i & 3); }

struct Unit { int pm, pn, ah; };
struct Gemm { const bf16_t* A; const bf16_t* Bt; int M, N, K, lda, ldb, wv; };

struct StaticOrder {
    int nM, nN, nwg, G, c, lim, hmbase;
    __host__ __device__ void init(int M, int N, int G_, int c_) { nM = M / BM; nN = N / BM; nwg = nM * nN; G = G_; c = c_; lim = nwg; hmbase = -1; }
    __host__ __device__ bool next(int i, Unit& u) const {
        long L; u.ah = 0;
        if (hmbase >= 0) { if (i > 0) return false; L = hmbase + (c >> 1); u.ah = c & 1; if (L >= nwg) return false; }
        else { L = (long)i * G + c; if (L >= lim) return false; }
        int wgid = (int)L; { const int q = nwg / NXCD, r = nwg % NXCD, xcd = wgid % NXCD, off = wgid / NXCD; wgid = (xcd < r ? xcd * (q + 1) : r * (q + 1) + (xcd - r) * q) + off; }
        const int nig = WGM * nN, gid = wgid / nig, fm = gid * WGM, gsz = (nM - fm) < WGM ? (nM - fm) : WGM;
        u.pm = fm + ((wgid % nig) % gsz); u.pn = (wgid % nig) / gsz; return true;
    }
    __device__ __forceinline__ void a_ready(const Unit&) const {}
    __device__ __forceinline__ void done(const Unit&) const {}
};

__device__ __forceinline__ unsigned cvt_pk_bf16(float lo, float hi) { unsigned r; asm volatile("v_cvt_pk_bf16_f32 %0, %1, %2" : "=v"(r) : "v"(lo), "v"(hi)); return r; }

template <class Epi, class Sched, bool ALIGN_EPI = false, bool SP2 = false, bool HM = false>
__device__ __forceinline__ void gemm_phase(PG8_LAS unsigned char* lds, const Gemm g, const Sched& S, const Epi& E) {
    int tid = g.wv * 64 + lane_id(); asm volatile("" : "+v"(tid)); const int wid = g.wv, lane = tid & 63, wr = wid >> 2, wc = wid & 3, fr = lane & 15, fq = lane >> 4;
    const int K = g.K, nt = K / BK;
    unsigned voffA[2], voffB[2];
#pragma unroll
    for (int i = 0; i < 2; ++i) { int R, C; stage_rc(tid * 16 + i * 8192, R, C); const int Rb = Epi::PERM ? ((R & ~31) + perm32(R & 31)) : R;
        voffA[i] = (unsigned)(R * g.lda + C) * 2u; voffB[i] = (unsigned)(Rb * g.ldb + C) * 2u; }
    const size_t kstep = (size_t)(BK * 2);
    const size_t hA = (size_t)HALF * g.lda * 2, hB = (size_t)HALF * g.ldb * 2;
    const size_t tA = 2 * hA, tB = 2 * hB;
    const unsigned ldsw = (unsigned)wid * 1024u;
    const int aoff = lds_byte(wr * 64 + fr, fq * 8), boff = lds_byte(wc * 32 + fr, fq * 8);
#define PG8_SA(b, h) (((b) * 2 + (h)) * HTB)
#define PG8_SB(b, h) ((4 + (b) * 2 + (h)) * HTB)
#define PG8_STAGE(bufoff, gbase, voff) do { _Pragma("unroll") for (int _i = 0; _i < 2; ++_i) \
        __builtin_amdgcn_global_load_lds((const unsigned*)((const char*)(gbase) + (voff)[_i]), (PG8_LAS unsigned*)(lds + (bufoff) + ldsw + _i * 8192), 16, 0, 0); } while (0)
#define PG8_LDA(dst, b, h) do { _Pragma("unroll") for (int m = 0; m < 4; ++m) _Pragma("unroll") for (int k = 0; k < 2; ++k) dst[m][k] = *(const PG8_LAS bf16x8*)(lds + PG8_SA(b, h) + aoff + m * 2048 + k * 1024); } while (0)
#define PG8_LDB(dst, b, h) do { _Pragma("unroll") for (int n = 0; n < 2; ++n) _Pragma("unroll") for (int k = 0; k < 2; ++k) dst[n][k] = *(const PG8_LAS bf16x8*)(lds + PG8_SB(b, h) + boff + n * 2048 + k * 1024); } while (0)
#define PG8_MMA(ai, bj, At, Bt) do { __builtin_amdgcn_s_setprio(1); _Pragma("unroll") for (int m = 0; m < 4; ++m) _Pragma("unroll") for (int n = 0; n < 2; ++n) _Pragma("unroll") for (int k = 0; k < 2; ++k) \
        acc[ai][bj][m][n] = __builtin_amdgcn_mfma_f32_16x16x32_bf16(Bt[n][k], At[m][k], acc[ai][bj][m][n], 0, 0, 0); __builtin_amdgcn_s_setprio(0); } while (0)
#define PG8_WAIT_V(n) asm volatile("s_waitcnt vmcnt(" #n ")" ::: "memory")
#define PG8_WAIT_L(n) asm volatile("s_waitcnt lgkmcnt(" #n ")" ::: "memory")
#define PG8_BAR __builtin_amdgcn_s_barrier()
#define PG8_SCHED __builtin_amdgcn_sched_barrier(0)
    Unit cur, nxt; int ui = 0;
    if (!S.next(0, cur)) return;
    f32x4 acc[2][2][4][2];
#pragma unroll
    for (int a = 0; a < 2; ++a)
#pragma unroll
        for (int b = 0; b < 2; ++b)
#pragma unroll
            for (int m = 0; m < 4; ++m)
#pragma unroll
                for (int n = 0; n < 2; ++n) acc[a][b][m][n] = (f32x4){0.f, 0.f, 0.f, 0.f};
    bf16x8 At[4][2], B0[2][2], B1[2][2];
    const char* cA = (const char*)g.A + (size_t)cur.pm * tA + (size_t)cur.ah * hA; const char* cB = (const char*)g.Bt + (size_t)cur.pn * tB;
    S.a_ready(cur);
    if constexpr (SP2) {
        PG8_STAGE(PG8_SB(0, 0), cB, voffB); PG8_STAGE(PG8_SB(0, 1), cB + hB, voffB); PG8_STAGE(PG8_SA(0, 0), cA, voffA); PG8_STAGE(PG8_SA(0, 1), cA + hA, voffA);
        if (wr == 1) PG8_BAR;
        PG8_WAIT_V(2); PG8_BAR;
        PG8_STAGE(PG8_SB(1, 0), cB + kstep, voffB); PG8_STAGE(PG8_SA(1, 0), cA + kstep, voffA); PG8_STAGE(PG8_SB(1, 1), cB + hB + kstep, voffB);
        PG8_WAIT_V(6); PG8_BAR;
    } else {
        PG8_STAGE(PG8_SB(0, 0), cB, voffB); PG8_STAGE(PG8_SA(0, 0), cA, voffA); PG8_STAGE(PG8_SB(0, 1), cB + hB, voffB); PG8_STAGE(PG8_SA(0, 1), cA + hA, voffA);
        if (wr == 1) PG8_BAR;
        PG8_WAIT_V(4); PG8_BAR;
        PG8_STAGE(PG8_SB(1, 0), cB + kstep, voffB); PG8_STAGE(PG8_SA(1, 0), cA + kstep, voffA); PG8_STAGE(PG8_SB(1, 1), cB + hB + kstep, voffB);
        PG8_WAIT_V(6); PG8_BAR;
    }
    for (;;) {
        const bool has_next = S.next(ui + 1, nxt);
        const char* nA = has_next ? (const char*)g.A + (size_t)nxt.pm * tA + (size_t)nxt.ah * hA : cA; const char* nB = has_next ? (const char*)g.Bt + (size_t)nxt.pn * tB : cB;
        for (int t = 0; t < nt; t += 2) {
            const bool last = (t == nt - 2);
            const char* a1 = cA + (size_t)(t + 1) * kstep;
            const char* a2 = last ? nA : cA + (size_t)(t + 2) * kstep; const char* b2 = last ? nB : cB + (size_t)(t + 2) * kstep;
            const char* a3 = a2 + kstep; const char* b3 = b2 + kstep;
            if (last && has_next) S.a_ready(nxt);
            if constexpr (SP2) {
            PG8_LDB(B0, 0, 0); PG8_LDB(B1, 0, 1); PG8_SCHED; PG8_LDA(At, 0, 0); PG8_STAGE(PG8_SA(1, 1), a1 + hA, voffA);
            PG8_WAIT_V(8); PG8_WAIT_L(0); PG8_BAR; PG8_MMA(0, 0, At, B0); PG8_MMA(0, 1, At, B1); PG8_BAR; PG8_SCHED;
            if constexpr (!HM) PG8_LDA(At, 0, 1); PG8_STAGE(PG8_SB(0, 0), b2, voffB); PG8_STAGE(PG8_SB(0, 1), b2 + hB, voffB); PG8_STAGE(PG8_SA(0, 0), a2, voffA);
            PG8_WAIT_V(8); PG8_WAIT_L(0); PG8_BAR; if constexpr (!HM) { PG8_MMA(1, 0, At, B0); PG8_MMA(1, 1, At, B1); } PG8_BAR; PG8_SCHED;
            PG8_LDB(B0, 1, 0); PG8_LDB(B1, 1, 1); PG8_SCHED; PG8_LDA(At, 1, 0); PG8_STAGE(PG8_SA(0, 1), a2 + hA, voffA);
            PG8_WAIT_V(8); PG8_WAIT_L(0); PG8_BAR; PG8_MMA(0, 0, At, B0); PG8_MMA(0, 1, At, B1); PG8_BAR; PG8_SCHED;
            if constexpr (!HM) PG8_LDA(At, 1, 1); PG8_STAGE(PG8_SB(1, 0), b3, voffB); PG8_STAGE(PG8_SB(1, 1), b3 + hB, voffB); PG8_STAGE(PG8_SA(1, 0), a3, voffA);
            PG8_WAIT_V(8); PG8_WAIT_L(0); PG8_BAR; if constexpr (!HM) { PG8_MMA(1, 0, At, B0); PG8_MMA(1, 1, At, B1); } PG8_BAR; PG8_SCHED;
            } else {
            PG8_LDB(B0, 0, 0); PG8_SCHED; PG8_LDA(At, 0, 0); PG8_STAGE(PG8_SA(1, 1), a1 + hA, voffA);
            PG8_WAIT_L(8); PG8_BAR; PG8_WAIT_L(0); PG8_MMA(0, 0, At, B0); PG8_BAR; PG8_SCHED;
            PG8_LDB(B1, 0, 1); PG8_STAGE(PG8_SB(0, 0), b2, voffB);
            PG8_BAR; PG8_WAIT_L(0); PG8_MMA(0, 1, At, B1); PG8_BAR;
            PG8_LDA(At, 0, 1); PG8_STAGE(PG8_SA(0, 0), a2, voffA);
            PG8_BAR; PG8_WAIT_L(0); PG8_MMA(1, 0, At, B0); PG8_BAR; PG8_SCHED;
            PG8_STAGE(PG8_SB(0, 1), b2 + hB, voffB);
            PG8_WAIT_V(6); PG8_BAR; PG8_MMA(1, 1, At, B1); PG8_BAR;
            PG8_LDB(B0, 1, 0); PG8_SCHED; PG8_LDA(At, 1, 0); PG8_STAGE(PG8_SA(0, 1), a2 + hA, voffA);
            PG8_WAIT_L(8); PG8_BAR; PG8_WAIT_L(0); PG8_MMA(0, 0, At, B0); PG8_BAR; PG8_SCHED;
            PG8_LDB(B1, 1, 1); PG8_STAGE(PG8_SB(1, 0), b3, voffB);
            PG8_BAR; PG8_WAIT_L(0); PG8_MMA(0, 1, At, B1); PG8_BAR;
            PG8_LDA(At, 1, 1); PG8_STAGE(PG8_SA(1, 0), a3, voffA);
            PG8_BAR; PG8_WAIT_L(0); PG8_MMA(1, 0, At, B0); PG8_BAR; PG8_SCHED;
            PG8_STAGE(PG8_SB(1, 1), b3 + hB, voffB);
            PG8_WAIT_V(6); PG8_BAR; PG8_MMA(1, 1, At, B1); PG8_BAR;
            }
        }
        if constexpr (ALIGN_EPI) { if (wr == 0) PG8_BAR; }
        if constexpr (!Epi::AFTER_DRAIN) { E(acc, cur, wr, wc, fr, fq); S.done(cur); }
        if (!has_next) break;
#pragma unroll
        for (int a = 0; a < 2; ++a)
#pragma unroll
            for (int b = 0; b < 2; ++b)
#pragma unroll
                for (int m = 0; m < 4; ++m)
#pragma unroll
                    for (int n = 0; n < 2; ++n) acc[a][b][m][n] = (f32x4){0.f, 0.f, 0.f, 0.f};
        cur = nxt; cA = nA; cB = nB; ++ui;
        if constexpr (ALIGN_EPI) { if (wr == 1) PG8_BAR; }
    }
    PG8_WAIT_V(0);
    if constexpr (!ALIGN_EPI) { if (wr == 0) PG8_BAR; }
    PG8_BAR;
    if constexpr (Epi::AFTER_DRAIN) { E.fused(acc, cur, wr, wc, fr, fq, lds, wid, lane); S.done(cur); }
#undef PG8_SA
#undef PG8_SB
#undef PG8_STAGE
#undef PG8_LDA
#undef PG8_LDB
#undef PG8_MMA
#undef PG8_WAIT_V
#undef PG8_WAIT_L
#undef PG8_BAR
#undef PG8_SCHED
}

__device__ __forceinline__ float row_ss(const float* ss, int row, int fq) {
    const f32x4 a = *(const f32x4*)(ss + (size_t)row * 32 + 8 * fq), b = *(const f32x4*)(ss + (size_t)row * 32 + 8 * fq + 4);
    float s = ((a[0] + a[1]) + (a[2] + a[3])) + ((b[0] + b[1]) + (b[2] + b[3]));
    s += __shfl_xor(s, 16); s += __shfl_xor(s, 32); return s;
}
struct EpiScaleF32 {
    static constexpr bool PERM = false, AFTER_DRAIN = false;
    float* C; int ldc; const float* ss; float inv_d, eps;
    __device__ __forceinline__ void operator()(const f32x4 (&acc)[2][2][4][2], const Unit& u, int wr, int wc, int fr, int fq) const {
        const int row0 = u.pm * BM + wr * 64 + fr, col0 = u.pn * BM + wc * 32 + 4 * fq;
#pragma unroll
        for (int ai = 0; ai < 2; ++ai)
#pragma unroll
            for (int m = 0; m < 4; ++m) { const int row = row0 + ai * HALF + m * 16; float* rowp = C + (size_t)row * ldc + col0;
                const float rs = ss ? __builtin_amdgcn_rsqf(row_ss(ss, row, fq) * inv_d + eps) : 1.0f;
#pragma unroll
                for (int bj = 0; bj < 2; ++bj)
#pragma unroll
                    for (int n = 0; n < 2; ++n) *(f32x4*)(rowp + bj * HALF + n * 16) = acc[ai][bj][m][n] * rs; }
    }
};
struct EpiScaleBf16 {
    static constexpr bool PERM = true, AFTER_DRAIN = false;
    bf16_t* O; int ldo; const float* ss; float inv_d, eps;
    __device__ __forceinline__ void operator()(const f32x4 (&acc)[2][2][4][2], const Unit& u, int wr, int wc, int fr, int fq) const {
        const int row0 = u.pm * BM + wr * 64 + fr, col0 = u.pn * BM + wc * 32 + 8 * fq;
#pragma unroll
        for (int ai = 0; ai < 2; ++ai)
#pragma unroll
            for (int m = 0; m < 4; ++m) { const int row = row0 + ai * HALF + m * 16; const float rs = __builtin_amdgcn_rsqf(row_ss(ss, row, fq) * inv_d + eps);
#pragma unroll
                for (int bj = 0; bj < 2; ++bj) { const f32x4 v0 = acc[ai][bj][m][0] * rs, v1 = acc[ai][bj][m][1] * rs;
                    u32x4 w; w.x = cvt_pk_bf16(v0[0], v0[1]); w.y = cvt_pk_bf16(v0[2], v0[3]); w.z = cvt_pk_bf16(v1[0], v1[1]); w.w = cvt_pk_bf16(v1[2], v1[3]);
                    *(u32x4*)(O + (size_t)row * ldo + col0 + bj * HALF) = w; } }
    }
};
struct EpiSwiGLU {
    static constexpr bool PERM = true, AFTER_DRAIN = false;
    bf16_t* O; int ldo; const float* ss; float inv_d, eps; int nai;
    __device__ __forceinline__ void operator()(const f32x4 (&acc)[2][2][4][2], const Unit& u, int wr, int wc, int fr, int fq) const {
        const int row0 = u.pm * BM + u.ah * HALF + wr * 64 + fr, col0 = u.pn * HALF + wc * 32 + 8 * fq;
#pragma unroll
        for (int ai = 0; ai < 2; ++ai) { if (ai >= nai) break;
#pragma unroll
            for (int m = 0; m < 4; ++m) { const int row = row0 + ai * HALF + m * 16;
                const float rs = __builtin_amdgcn_rsqf(row_ss(ss, row, fq) * inv_d + eps);
                float o[8];
#pragma unroll
                for (int n = 0; n < 2; ++n)
#pragma unroll
                    for (int j = 0; j < 4; ++j) { const float gv = acc[ai][0][m][n][j] * rs, uv = acc[ai][1][m][n][j] * rs; o[n * 4 + j] = gv * uv * __builtin_amdgcn_rcpf(1.0f + __expf(-gv)); }
                u32x4 w; w.x = cvt_pk_bf16(o[0], o[1]); w.y = cvt_pk_bf16(o[2], o[3]); w.z = cvt_pk_bf16(o[4], o[5]); w.w = cvt_pk_bf16(o[6], o[7]);
                *(u32x4*)(O + (size_t)row * ldo + col0) = w; } }
    }
};
__device__ __forceinline__ float bflo(unsigned w) { return __builtin_bit_cast(float, w << 16); }
__device__ __forceinline__ float bfhi(unsigned w) { return __builtin_bit_cast(float, w & 0xffff0000u); }
struct EpiResidual {
    static constexpr bool PERM = true, AFTER_DRAIN = false;
    bf16_t* HL; bf16_t* HB; float* ss_out; float* out; int out_rows; float scale;
    __device__ __forceinline__ void operator()(const f32x4 (&acc)[2][2][4][2], const Unit& u, int wr, int wc, int fr, int fq) const {
        const int row0 = u.pm * BM + wr * 64 + fr, col0 = u.pn * BM + wc * 32 + 8 * fq;
#pragma unroll
        for (int ai = 0; ai < 2; ++ai)
#pragma unroll
            for (int m = 0; m < 4; ++m) { const int row = row0 + ai * HALF + m * 16; float sq = 0.f;
#pragma unroll
                for (int bj = 0; bj < 2; ++bj) { const size_t off = (size_t)row * 2048 + col0 + bj * HALF;
                    const u32x4 hi = *(const u32x4*)(HB + off), lo = *(const u32x4*)(HL + off);
                    f32x4 h0 = (f32x4){bflo(hi.x) + bflo(lo.x), bfhi(hi.x) + bfhi(lo.x), bflo(hi.y) + bflo(lo.y), bfhi(hi.y) + bfhi(lo.y)};
                    f32x4 h1 = (f32x4){bflo(hi.z) + bflo(lo.z), bfhi(hi.z) + bfhi(lo.z), bflo(hi.w) + bflo(lo.w), bfhi(hi.w) + bfhi(lo.w)};
                    h0 = h0 + acc[ai][bj][m][0] * scale; h1 = h1 + acc[ai][bj][m][1] * scale;
                    if (out && row < out_rows) { *(f32x4*)(out + off) = h0; *(f32x4*)(out + off + 4) = h1; }
                    u32x4 w; w.x = cvt_pk_bf16(h0[0], h0[1]); w.y = cvt_pk_bf16(h0[2], h0[3]); w.z = cvt_pk_bf16(h1[0], h1[1]); w.w = cvt_pk_bf16(h1[2], h1[3]);
                    u32x4 l2; l2.x = cvt_pk_bf16(h0[0] - bflo(w.x), h0[1] - bfhi(w.x)); l2.y = cvt_pk_bf16(h0[2] - bflo(w.y), h0[3] - bfhi(w.y)); l2.z = cvt_pk_bf16(h1[0] - bflo(w.z), h1[1] - bfhi(w.z)); l2.w = cvt_pk_bf16(h1[2] - bflo(w.w), h1[3] - bfhi(w.w));
                    *(u32x4*)(HB + off) = w; *(u32x4*)(HL + off) = l2;
                    sq += (h0[0] * h0[0] + h0[1] * h0[1]) + (h0[2] * h0[2] + h0[3] * h0[3]) + (h1[0] * h1[0] + h1[1] * h1[1]) + (h1[2] * h1[2] + h1[3] * h1[3]); }
                sq += __shfl_xor(sq, 16); sq += __shfl_xor(sq, 32);
                if (fq == 0 && ss_out) __hip_atomic_fetch_add(ss_out + (size_t)row * 32 + u.pn * 4 + wc, sq, __ATOMIC_RELAXED, __HIP_MEMORY_SCOPE_AGENT); }
    }
};
}
#define XB_TMO      128
#define XB_XCNT(j)  (256  + 64 * (j))
#define XB_XSUB(j)  (1280 + 64 * (j))
#define XB_XGEN(j)  (2304 + 64 * (j))
#define XB_TOP      3328
#define XB_TOPGEN   3392
#define XCD_BAR_WORDS 3456
#define XB_SPIN_CAP (1u << 18)

__device__ __forceinline__ unsigned xb_ld(unsigned* p)              { return __hip_atomic_load(p, __ATOMIC_RELAXED, __HIP_MEMORY_SCOPE_AGENT); }
__device__ __forceinline__ unsigned xb_add(unsigned* p, unsigned v) { return __hip_atomic_fetch_add(p, v, __ATOMIC_RELAXED, __HIP_MEMORY_SCOPE_AGENT); }
__device__ __forceinline__ unsigned xb_xcc_id() { return (unsigned)__builtin_amdgcn_s_getreg((3 << 11) | 20) & 0xFu; }
#define XB_SPIN(cond, bar) do { unsigned _sp = 0; while (cond) { __builtin_amdgcn_s_sleep(1); \
    if ((++_sp & 255u) == 0u) { if (xb_ld(&(bar)[XB_TMO])) break; if (_sp > XB_SPIN_CAP) { atomicAdd(&(bar)[XB_TMO], 1u); break; } } } } while (0)

struct XcdBarrier {
    unsigned* bar; unsigned x;
    volatile LAS unsigned* st;
};

__device__ __forceinline__ XcdBarrier xcd_barrier_post(unsigned* bar, volatile LAS unsigned* st, int wv) {
    XcdBarrier b; b.bar = bar; b.x = xb_xcc_id(); b.st = st;
    if ((wv == 0 && lane_id() == 0)) (void)xb_add(&bar[XB_XCNT(b.x)], 1u);
    return b;
}
__device__ __forceinline__ void xcd_barrier_complete(unsigned* bar, unsigned x, unsigned& nloc, unsigned& nx) {
    const unsigned G = gridDim.x * gridDim.y * gridDim.z;
    unsigned sum, cnt, mine, sp = 0u;
    for (;;) {
        sum = 0u; cnt = 0u; mine = 0u;
#pragma unroll
        for (unsigned j = 0; j < 16; ++j) { const unsigned c = xb_ld(&bar[XB_XCNT(j)]); sum += c; cnt += (c > 0u) ? 1u : 0u; mine = (j == x) ? c : mine; }
        if (sum == G) break;
        __builtin_amdgcn_s_sleep(1);
        if ((++sp & 255u) == 0u) { if (xb_ld(&bar[XB_TMO])) break; if (sp > XB_SPIN_CAP) { atomicAdd(&bar[XB_TMO], 1u); break; } }
    }
    nloc = mine > 0u ? mine : 1u; nx = cnt > 0u ? cnt : 1u;
}

__device__ __forceinline__ void xcd_barrier(const XcdBarrier& b, int wv) {
    asm volatile("s_waitcnt vmcnt(0)" ::: "memory");
    __syncthreads();
    if ((wv == 0 && lane_id() == 0)) {
        unsigned* bar = b.bar;
        __builtin_amdgcn_s_waitcnt(0);
        unsigned nloc = b.st[0], nx = b.st[1];
        if (nloc == 0u) { xcd_barrier_complete(bar, b.x, nloc, nx); b.st[0] = nloc; b.st[1] = nx; }
        const unsigned old = xb_add(&bar[XB_XSUB(b.x)], 1u);
        const unsigned gen = old / nloc;
        if (old + 1u == (gen + 1u) * nloc) {
            __builtin_amdgcn_fence(__ATOMIC_RELEASE, "agent");
            asm volatile("s_waitcnt vmcnt(0)" ::: "memory");
            const unsigned og = xb_add(&bar[XB_TOP], 1u);
            const unsigned tg = og / nx;
            if (og + 1u == (tg + 1u) * nx) xb_add(&bar[XB_TOPGEN], 1u);
            else XB_SPIN(xb_ld(&bar[XB_TOPGEN]) == tg, bar);
            __builtin_amdgcn_fence(__ATOMIC_ACQUIRE, "agent");
            xb_add(&bar[XB_XGEN(b.x)], 1u);
            asm volatile("s_waitcnt vmcnt(0)" ::: "memory");
        } else {
            XB_SPIN(xb_ld(&bar[XB_XGEN(b.x)]) == gen, bar);
            __builtin_amdgcn_fence(__ATOMIC_ACQUIRE, "agent");
            asm volatile("s_waitcnt vmcnt(0)" ::: "memory");
        }
    }
    __syncthreads();
}

struct P { const float* in[36]; float* out; unsigned char* ws; int ph_lo, ph_hi; };
enum { I_X = 0, I_META, I_F1N, I_F1G, I_F1U, I_F1D, I_MIXN, I_WIN, I_WOUT, I_QN, I_WQ, I_KVN, I_WKV, I_QKNQ, I_QKNK, I_CONVW, I_CONVB, I_DTB, I_ALOG, I_SSDD, I_SSDN, I_RETN,
       I_MU, I_W0, I_W2, I_A0, I_A2, I_G2, I_KK, I_KA, I_RK, I_LN, I_F2N, I_F2G, I_F2U, I_F2D };
#define CAS __attribute__((address_space(4)))
typedef const CAS P* KPtr;
struct Ctx { LAS unsigned char* lds; unsigned char* ws; KPtr kp; int tid, lane, wave, G, bid; };
__device__ __forceinline__ Ctx ctx_make(LAS unsigned char* lds, int wv) {
    Ctx F; KPtr kp = (KPtr)__builtin_amdgcn_kernarg_segment_ptr(); asm volatile("" : "+s"(kp)); int t = wv * 64 + lane_id(); asm volatile("" : "+v"(t));
    F.lds = lds; F.kp = kp; F.ws = kp->ws; F.tid = t; F.lane = t & 63; F.wave = __builtin_amdgcn_readfirstlane(t >> 6); F.G = gridDim.x; F.bid = blockIdx.x; return F;
}


__device__ __forceinline__ int queue_next(const Ctx& F, unsigned* ctr) {
    volatile LAS unsigned* slot = (volatile LAS unsigned*)(F.lds + LDSCTL_OFF + 64);
    __syncthreads();
    if (F.tid == 0) *slot = __hip_atomic_fetch_add(ctr, 1u, __ATOMIC_RELAXED, __HIP_MEMORY_SCOPE_AGENT);
    __syncthreads();
    return (int)*slot;
}
__device__ __forceinline__ f32x16 zero16() { f32x16 z;
#pragma unroll
    for (int i = 0; i < 16; ++i) z[i] = 0.f; return z; }
__device__ __forceinline__ void mma32(f32x16& acc, const LAS float* Ap, int sAi, int sAk, const LAS float* Bp, int sBk, int sBj, int K, int lane) {
    const int r = lane & 31, hh = lane >> 5;
    const LAS float* a = Ap + r * sAi + hh * sAk; const LAS float* b = Bp + hh * sBk + r * sBj;
#pragma unroll 4
    for (int k = 0; k < K; k += 2) acc = __builtin_amdgcn_mfma_f32_32x32x2f32(a[k * sAk], b[k * sBk], acc, 0, 0, 0);
}
__device__ __forceinline__ void mma32bf(f32x16& acc, const LAS float* Ap, int sAi, const LAS float* Bp, int sBj, int K, int lane) {
    const int r = lane & 31, hh = lane >> 5; const LAS float* a = Ap + r * sAi + 8 * hh; const LAS float* b = Bp + r * sBj + 8 * hh;
#pragma unroll 2
    for (int k = 0; k < K; k += 16) { const f32x4 a0 = *(const LAS f32x4*)(a + k), a1 = *(const LAS f32x4*)(a + k + 4), b0 = *(const LAS f32x4*)(b + k), b1 = *(const LAS f32x4*)(b + k + 4);
        v4u aw, bw; aw.x = cvtpk(a0[0], a0[1]); aw.y = cvtpk(a0[2], a0[3]); aw.z = cvtpk(a1[0], a1[1]); aw.w = cvtpk(a1[2], a1[3]); bw.x = cvtpk(b0[0], b0[1]); bw.y = cvtpk(b0[2], b0[3]); bw.z = cvtpk(b1[0], b1[1]); bw.w = cvtpk(b1[2], b1[3]);
        acc = __builtin_amdgcn_mfma_f32_32x32x16_bf16(__builtin_bit_cast(bf16x8, aw), __builtin_bit_cast(bf16x8, bw), acc, 0, 0, 0); }
}
__device__ __forceinline__ int rreg(int reg, int lane) { return (reg & 3) + 8 * (reg >> 2) + 4 * (lane >> 5); }

__device__ __forceinline__ void cvt_tile(const float* src, int srcN, const float* gain, int valid, bf16* dst, int ldd, LAS float* scr, int lane) {
    const int c4 = lane & 15, r0 = lane >> 4;
    f32x4 v[16];
#pragma unroll
    for (int i = 0; i < 16; ++i) v[i] = (4 * c4 < valid) ? *(const f32x4*)(src + (size_t)(r0 + 4 * i) * srcN + 4 * c4) : (f32x4){0.f, 0.f, 0.f, 0.f};
#pragma unroll
    for (int i = 0; i < 16; ++i) { const int kk = r0 + 4 * i; const float gk = gain ? gain[kk] : 1.0f; LAS float* d = scr + kk * 65 + 4 * c4; d[0] = v[i][0] * gk; d[1] = v[i][1] * gk; d[2] = v[i][2] * gk; d[3] = v[i][3] * gk; }
    LDS_WAIT(); asm volatile("" ::: "memory");
    const int c8 = lane & 7;
#pragma unroll
    for (int j = 0; j < 8; ++j) { const int n = (lane >> 3) + 8 * j; const LAS float* s = scr + (8 * c8) * 65 + n;
        v4u o; o.x = pk2(s[0], s[65]); o.y = pk2(s[130], s[195]); o.z = pk2(s[260], s[325]); o.w = pk2(s[390], s[455]);
        *(v4u*)(dst + (size_t)n * ldd + 8 * c8) = o; }
    LDS_WAIT(); asm volatile("" ::: "memory");
}
__device__ __forceinline__ void convert_layer(const Ctx& F, int L, int gw, int NGW) {
    LAS float* scr = (LAS float*)(F.lds + F.wave * 17408);
    const int lane = F.lane;
    constexpr int IT_GU = 2 * 32 * 176, IT_D = 2 * 88 * 32, IT_IN = 32 * 84, IT_OUT = 32 * 32, IT_MLA = 8 * 28;
    bf16* WGU = (bf16*)(F.ws + O_WGU); bf16* WD = (bf16*)(F.ws + O_WD); bf16* WIN = (bf16*)(F.ws + O_WIN); bf16* WOUT = (bf16*)(F.ws + O_WOUT); bf16* WMLA = (bf16*)(F.ws + O_WMLA);
    const int l = L;
    for (int it = gw; it < IT_GU + IT_D + IT_IN + IT_OUT + IT_MLA; it += NGW) {
        int r = it;
        if (r < IT_GU) { const int which = r / 5632, f = 2 * l + which, q = r % 5632, kb = q / 176, nb = q % 176, n0 = 64 * nb, pn = n0 >> 8, within = n0 & 255, isup = within >= 128, f0 = 128 * pn + (within & 127);
            const float* src = (which ? (isup ? F.kp->in[I_F2U] : F.kp->in[I_F2G]) : (isup ? F.kp->in[I_F1U] : F.kp->in[I_F1G])) + (size_t)l * D * DFF + (size_t)(64 * kb) * DFF + f0;
            const float* gain = (which ? F.kp->in[I_F2N] : F.kp->in[I_F1N]) + l * D + 64 * kb;
            cvt_tile(src, DFF, gain, 64, WGU + (size_t)f * 11264 * 2048 + (size_t)n0 * 2048 + 64 * kb, 2048, scr, lane); continue; }
        r -= IT_GU;
        if (r < IT_D) { const int which = r / 2816, f = 2 * l + which, q = r % 2816, kb = q / 32, nb = q % 32;
            const float* src = (which ? F.kp->in[I_F2D] : F.kp->in[I_F1D]) + (size_t)l * DFF * D + (size_t)(64 * kb) * D + 64 * nb;
            cvt_tile(src, D, nullptr, 64, WD + (size_t)f * 2048 * 5632 + (size_t)(64 * nb) * 5632 + 64 * kb, 5632, scr, lane); continue; }
        r -= IT_D;
        if (r < IT_IN) { const int q = r, kb = q / 84, nb = q % 84, n0 = 64 * nb; int valid = NIN - n0; valid = valid < 0 ? 0 : (valid > 64 ? 64 : valid);
            const float* src = F.kp->in[I_WIN] + (size_t)l * D * NIN + (size_t)(64 * kb) * NIN + n0;
            cvt_tile(src, NIN, F.kp->in[I_MIXN] + l * D + 64 * kb, valid, WIN + (size_t)l * NINP * D + (size_t)n0 * D + 64 * kb, D, scr, lane); continue; }
        r -= IT_IN;
        if (r < IT_OUT) { const int q = r, kb = q / 32, nb = q % 32;
            const float* src = F.kp->in[I_WOUT] + (size_t)l * D * D + (size_t)(64 * kb) * D + 64 * nb;
            cvt_tile(src, D, nullptr, 64, WOUT + (size_t)l * D * D + (size_t)(64 * nb) * D + 64 * kb, D, scr, lane); continue; }
        r -= IT_OUT;
        { const int q = r, kb = q / 28, nb = q % 28, n0 = 64 * nb, k0 = 64 * kb;
            const float* src; int srcN, valid;
            if (n0 < 768) { valid = k0 < 384 ? 64 : 0; src = F.kp->in[I_WQ] + (size_t)l * 384 * 768 + (size_t)k0 * 768 + n0; srcN = 768; }
            else { valid = k0 >= 384 ? 64 : 0; src = F.kp->in[I_WKV] + (size_t)l * 128 * 1024 + (size_t)(k0 - 384) * 1024 + (n0 - 768); srcN = 1024; }
            cvt_tile(src, srcN, nullptr, valid, WMLA + (size_t)l * MLAN * 512 + (size_t)n0 * 512 + k0, 512, scr, lane); }
    }
}
__device__ __forceinline__ void p0_prologue(const Ctx& F, int cvt_only) {
    const int gw = F.bid * NWAVES + F.wave, NGW = F.G * NWAVES, lane = F.lane;
    convert_layer(F, 0, gw, NGW);
    if (cvt_only) return;
    bf16* HL = (bf16*)(F.ws + O_H); bf16* HB = (bf16*)(F.ws + O_HB); float* SS = (float*)(F.ws + O_SS); bf16* Y = (bf16*)(F.ws + O_Y); f32x2* ROPE = (f32x2*)(F.ws + O_ROPE);
    for (int row = gw; row < MP; row += NGW) {
        const float* src = row < SEQ ? F.kp->in[I_X] + (size_t)row * D : F.kp->in[I_META] + (size_t)(row - SEQ) * D;
        float sq = 0.f;
#pragma unroll
        for (int j = 0; j < 8; ++j) { f32x4 v = (f32x4){0.f, 0.f, 0.f, 0.f}; if (row < T) v = *(const f32x4*)(src + 256 * j + 4 * lane);
            v2u w; w.x = cvtpk(v[0], v[1]); w.y = cvtpk(v[2], v[3]); *(v2u*)(HB + (size_t)row * D + 256 * j + 4 * lane) = w;
            v2u lw; lw.x = cvtpk(v[0] - pg8::bflo(w.x), v[1] - pg8::bfhi(w.x)); lw.y = cvtpk(v[2] - pg8::bflo(w.y), v[3] - pg8::bfhi(w.y)); *(v2u*)(HL + (size_t)row * D + 256 * j + 4 * lane) = lw;
            sq += (v[0] * v[0] + v[1] * v[1]) + (v[2] * v[2] + v[3] * v[3]); }
        sq = wave_sum(sq); if (lane == 0) __hip_atomic_fetch_add(SS + (size_t)row * 32, sq, __ATOMIC_RELAXED, __HIP_MEMORY_SCOPE_AGENT);
#ifdef PROBE_ZERO_Y
        if (true) {
#else
        if (row >= T) {
#endif
#pragma unroll
            for (int j = 0; j < 4; ++j) *(v4u*)(Y + (size_t)row * D + 512 * j + 8 * lane) = (v4u){0u, 0u, 0u, 0u}; }
#ifdef PROBE_ZERO_Y
        if (row < T && lane < 32) { const float inv = powf(10000.0f, -(float)lane / 32.0f); const float ang = (float)seq_of_row(row) * inv; float sn, cs; sincosf(ang, &sn, &cs); ROPE[row * 32 + lane] = (f32x2){cs, sn}; }
#else
        else if (lane < 32) { const float inv = powf(10000.0f, -(float)lane / 32.0f); const float ang = (float)seq_of_row(row) * inv; float sn, cs; sincosf(ang, &sn, &cs); ROPE[row * 32 + lane] = (f32x2){cs, sn}; }
#endif
    }
}

__device__ __forceinline__ void m1_unit(const Ctx& F, int l, int r0, int r1, int grp) {
    const int lane = F.lane, tid = F.tid;
    const float* U = (const float*)(F.ws + O_U);
    if (r0 < r1) { bf16* AM = (bf16*)(F.ws + O_AMLA); const float* qn = F.kp->in[I_QN] + l * 384; const float* kvn = F.kp->in[I_KVN] + l * 128;
      const float* gp = lane < 48 ? qn + 8 * lane : kvn + 8 * (lane - 48); const f32x4 g0 = *(const f32x4*)gp, g1 = *(const f32x4*)(gp + 4);
      f32x4 a4[4], b4[4];
#pragma unroll
      for (int i = 0; i < 4; ++i) { const int row = r0 + F.wave + 8 * i; const float* ur = U + (size_t)(row < r1 ? row : r0) * NINP + 8 * lane; a4[i] = *(const f32x4*)ur; b4[i] = *(const f32x4*)(ur + 4); }
#pragma unroll
      for (int i = 0; i < 4; ++i) { const int row = r0 + F.wave + 8 * i; const f32x4 a = a4[i], b = b4[i];
        const float sq = (a[0] * a[0] + a[1] * a[1]) + (a[2] * a[2] + a[3] * a[3]) + (b[0] * b[0] + b[1] * b[1]) + (b[2] * b[2] + b[3] * b[3]);
        const float sq_q = wave_sum(lane < 48 ? sq : 0.f), sq_kv = wave_sum(lane >= 48 ? sq : 0.f);
        const float rs = lane < 48 ? 1.0f / sqrtf(sq_q * (1.0f / 384.0f) + EPS) : 1.0f / sqrtf(sq_kv * (1.0f / 128.0f) + EPS);
        v4u w; w.x = pk2(a[0] * rs * g0[0], a[1] * rs * g0[1]); w.y = pk2(a[2] * rs * g0[2], a[3] * rs * g0[3]); w.z = pk2(b[0] * rs * g1[0], b[1] * rs * g1[1]); w.w = pk2(b[2] * rs * g1[2], b[3] * rs * g1[3]);
        if (row < r1) *(v4u*)(AM + (size_t)row * 512 + 8 * lane) = w; } }
    if (r0 < r1) { float* RQK = (float*)(F.ws + O_RQK); const f32x2* ROPE = (const f32x2*)(F.ws + O_ROPE);
      f32x2 cs[4][4]; float x1[4][4], x2[4][4];
#pragma unroll
      for (int i = 0; i < 4; ++i) { const int row = r0 + F.wave + 8 * i, rc = row < r1 ? row : r0;
#pragma unroll
        for (int j = 0; j < 4; ++j) { const int idx = lane + 64 * j, qk = idx >> 7, hh = (idx >> 5) & 3, i5 = idx & 31; cs[i][j] = ROPE[rc * 32 + i5];
            x1[i][j] = U[(size_t)rc * NINP + U_RET + qk * 256 + hh * 64 + i5]; x2[i][j] = U[(size_t)rc * NINP + U_RET + qk * 256 + hh * 64 + 32 + i5]; } }
#pragma unroll
      for (int i = 0; i < 4; ++i) { const int row = r0 + F.wave + 8 * i; if (row < r1) {
#pragma unroll
        for (int j = 0; j < 4; ++j) { const int idx = lane + 64 * j, qk = idx >> 7, hh = (idx >> 5) & 3, i5 = idx & 31; const float sc = qk ? 0.125f : 1.0f;
            RQK[(size_t)row * 512 + qk * 256 + hh * 64 + i5] = (x1[i][j] * cs[i][j].x - x2[i][j] * cs[i][j].y) * sc; RQK[(size_t)row * 512 + qk * 256 + hh * 64 + 32 + i5] = (x1[i][j] * cs[i][j].y + x2[i][j] * cs[i][j].x) * sc; } } } }
    if (r0 < r1) { float* XBC = (float*)(F.ws + O_XBC); float* DT = (float*)(F.ws + O_DT); float* LA = (float*)(F.ws + O_LA);
      const float* cw = F.kp->in[I_CONVW] + l * 4096; const float* cb = F.kp->in[I_CONVB] + l * 1024;
      int rw[4], p1[4], p2[4], p3[4]; float dtr[4];
#pragma unroll
      for (int i = 0; i < 4; ++i) { const int row = r0 + F.wave + 8 * i; rw[i] = row < r1 ? row : r0; p1[i] = prev_row(rw[i]); p2[i] = p1[i] >= 0 ? prev_row(p1[i]) : -1; p3[i] = p2[i] >= 0 ? prev_row(p2[i]) : -1;
          dtr[i] = U[(size_t)rw[i] * NINP + U_SSD + 1536 + (lane & 7)]; }
#pragma unroll 1
      for (int j = 0; j < 4; ++j) { const int ch = 256 * j + 4 * lane; const size_t uo = U_SSD + 512 + ch; const f32x4 z4 = (f32x4){0.f, 0.f, 0.f, 0.f};
          const f32x4 wb = *(const f32x4*)(cb + ch), w0 = *(const f32x4*)(cw + ch), w1 = *(const f32x4*)(cw + 1024 + ch), w2 = *(const f32x4*)(cw + 2048 + ch), w3 = *(const f32x4*)(cw + 3072 + ch);
          f32x4 x0[4], x1[4], x2[4], x3[4];
#pragma unroll
          for (int i = 0; i < 4; ++i) { x3[i] = *(const f32x4*)(U + (size_t)rw[i] * NINP + uo); x2[i] = p1[i] >= 0 ? *(const f32x4*)(U + (size_t)p1[i] * NINP + uo) : z4;
              x1[i] = p2[i] >= 0 ? *(const f32x4*)(U + (size_t)p2[i] * NINP + uo) : z4; x0[i] = p3[i] >= 0 ? *(const f32x4*)(U + (size_t)p3[i] * NINP + uo) : z4; }
#pragma unroll
          for (int i = 0; i < 4; ++i) { f32x4 o = wb + w0 * x0[i] + w1 * x1[i] + w2 * x2[i] + w3 * x3[i];
              o[0] = siluf_(o[0]); o[1] = siluf_(o[1]); o[2] = siluf_(o[2]); o[3] = siluf_(o[3]);
              if (r0 + F.wave + 8 * i < r1) *(f32x4*)(XBC + (size_t)rw[i] * 1024 + ch) = o; } }
#pragma unroll
      for (int i = 0; i < 4; ++i) if (lane < 8 && r0 + F.wave + 8 * i < r1) { const float dt = softplusf_(dtr[i] + F.kp->in[I_DTB][l * 8 + lane]); DT[rw[i] * 8 + lane] = dt; LA[rw[i] * 8 + lane] = -expf(F.kp->in[I_ALOG][l * 8 + lane]) * dt; } }
    if (grp >= 0) { LAS float* xl = (LAS float*)F.lds; const int hd = F.wave, col = lane & 31;
      float* RW = (float*)(F.ws + O_RW); const size_t AS = (size_t)MP * 512; float* RBON = (float*)(F.ws + O_RBON);
      const float* MU = F.kp->in[I_MU] + l * 1664; const float* W2 = F.kp->in[I_W2] + l * 32 * 512; const float* A2 = F.kp->in[I_A2] + l * 32 * 512; const float* G2 = F.kp->in[I_G2] + l * 64 * 512;
      const int r0 = 32 * grp;
      __syncthreads();
#pragma unroll
      for (int j = 0; j < 8; ++j) { const int idx = tid + 512 * j, tk = idx >> 7, cl = idx & 127, row = r0 + tk; float xs = 0.f;
          if (row < T) { const int pr = prev_row(row); const size_t uc = U_RWKV + 1536 + cl; const float x = U[(size_t)row * NINP + uc], xp = pr >= 0 ? U[(size_t)pr * NINP + uc] : 0.f; xs = x + (xp - x) * MU[1536 + cl];
              if (cl < 32) xs = tanhf(xs); else if (cl >= 64) xs = sigmoidf_(xs); }
          xl[tk * 132 + cl] = xs; }
      __syncthreads();
      float w0c[2], a0c[2], kkc[2], kac[2], rkc[2], muR[2], muK[2], muV[2];
#pragma unroll
      for (int ct = 0; ct < 2; ++ct) { const int ch = 64 * hd + 32 * ct + col; w0c[ct] = F.kp->in[I_W0][l * 512 + ch]; a0c[ct] = F.kp->in[I_A0][l * 512 + ch]; kkc[ct] = F.kp->in[I_KK][l * 512 + ch]; kac[ct] = F.kp->in[I_KA][l * 512 + ch]; rkc[ct] = F.kp->in[I_RK][l * 512 + ch];
          muR[ct] = MU[ch]; muK[ct] = MU[512 + ch]; muV[ct] = MU[1024 + ch]; }
      { constexpr int tb = 0;
          f32x16 aw[2], aa[2], ag[2];
#pragma unroll
          for (int ct = 0; ct < 2; ++ct) { aw[ct] = zero16(); aa[ct] = zero16(); ag[ct] = zero16(); }
          const LAS float* xa = xl + (32 * tb + col) * 132 + (lane >> 5); const int chb = 64 * hd + col, kh = lane >> 5;
#define M1_LORA(ACC, WM, XO, NB) do { _Pragma("unroll") for (int hb_ = 0; hb_ < (NB); ++hb_) { float bq_[16][2], xq_[16]; \
              _Pragma("unroll") for (int t_ = 0; t_ < 16; ++t_) { const float* wb_ = (WM) + 1024 * (16 * hb_ + t_); bq_[t_][0] = wb_[wvo]; bq_[t_][1] = wb_[wvo + 32]; xq_[t_] = xa[(XO) + 2 * (16 * hb_ + t_)]; } \
              _Pragma("unroll") for (int t_ = 0; t_ < 16; ++t_) { ACC[0] = __builtin_amdgcn_mfma_f32_32x32x2f32(xq_[t_], bq_[t_][0], ACC[0], 0, 0, 0); ACC[1] = __builtin_amdgcn_mfma_f32_32x32x2f32(xq_[t_], bq_[t_][1], ACC[1], 0, 0, 0); } } } while (0)
          const unsigned wvo = (unsigned)(kh * 512 + chb);
          M1_LORA(aw, W2, 0, 1); M1_LORA(aa, A2, 32, 1); M1_LORA(ag, G2, 64, 2);
#undef M1_LORA
#pragma unroll
          for (int rb = 0; rb < 16; rb += 4) {
              float uc[4][2][3], upv[4][2][3];
#pragma unroll
              for (int q = 0; q < 4; ++q) { const int row = r0 + 32 * tb + rreg(rb + q, lane), rc = row < T ? row : 0, pr = prev_row(rc);
#pragma unroll
                  for (int ct = 0; ct < 2; ++ct) { const float* ur = U + (size_t)rc * NINP + U_RWKV + chb + 32 * ct; const float* up = U + (size_t)(pr >= 0 ? pr : 0) * NINP + U_RWKV + chb + 32 * ct;
                      uc[q][ct][0] = ur[0]; uc[q][ct][1] = ur[512]; uc[q][ct][2] = ur[1024]; upv[q][ct][0] = pr >= 0 ? up[0] : 0.f; upv[q][ct][1] = pr >= 0 ? up[512] : 0.f; upv[q][ct][2] = pr >= 0 ? up[1024] : 0.f; } }
#pragma unroll
              for (int q = 0; q < 4; ++q) { const int reg = rb + q; const int row = r0 + 32 * tb + rreg(reg, lane); const bool ok = row < T;
                  float rr[2], k2[2], vv[2], kk[2], av[2], dec[2]; float nq = 0.f, bq = 0.f;
#pragma unroll
                  for (int ct = 0; ct < 2; ++ct) { float r = uc[q][ct][0], k = uc[q][ct][1], v = uc[q][ct][2];
                      r += (upv[q][ct][0] - r) * muR[ct]; k += (upv[q][ct][1] - k) * muK[ct]; v += (upv[q][ct][2] - v) * muV[ct];
                      float wr = w0c[ct] + aw[ct][reg]; wr = -softplusf_(-wr) - 0.5f; dec[ct] = expf(-expf(wr));
                      av[ct] = sigmoidf_(a0c[ct] + aa[ct][reg]);
                      kk[ct] = k * kkc[ct]; k2[ct] = k * (1.0f + (av[ct] - 1.0f) * kac[ct]); rr[ct] = r; vv[ct] = v;
                      nq += kk[ct] * kk[ct]; bq += r * k2[ct] * rkc[ct]; }
                  nq = sum32(nq, lane); bq = sum32(bq, lane);
                  const float inrm = 1.0f / fmaxf(sqrtf(nq), 1e-12f);
                  if (ok) {
#pragma unroll
                      for (int ct = 0; ct < 2; ++ct) { const size_t o = (size_t)row * 512 + chb + 32 * ct; const float kn = kk[ct] * inrm;
                          RW[o] = rr[ct]; RW[AS + o] = dec[ct]; RW[2 * AS + o] = k2[ct]; RW[3 * AS + o] = vv[ct]; RW[4 * AS + o] = -kn; RW[5 * AS + o] = kn * av[ct]; RW[6 * AS + o] = ag[ct][reg]; }
                      if (col == 0) RBON[row * 8 + hd] = bq; } } }
      } }
}
__device__ __forceinline__ void m1_phase(const Ctx& F, int l, int qi = 1) {
    unsigned* ctr = (unsigned*)(F.ws + O_CTL) + CW_QUEUE + 64 * (4 * l + qi);
    constexpr int NG = (T + 31) / 32, NR = (T + 31) / 32;
    for (;;) { const int u = queue_next(F, ctr); if (u >= NG + NR) break;
        if (u < NG) m1_unit(F, l, 0, 0, u); else { const int r0 = 32 * (u - NG); m1_unit(F, l, r0, r0 + 32 < T ? r0 + 32 : T, -1); } }
}
constexpr int RWC = 64, NRC = (T + RWC - 1) / RWC;
__device__ __forceinline__ void rwkv_chunk_unit(const Ctx& F, int c, int h) {
    LAS float* BH = (LAS float*)F.lds; LAS float* KH = BH + 4160; LAS float* NX = KH + 4160; LAS float* RTT = NX + 4160;
    LAS float* AP = RTT + 4160; LAS float* BZ = AP + 4352; LAS float* Pm = BZ + 4160; LAS float* Qm = Pm + 4160; LAS float* Ge = Qm + 4160; LAS float* segt = Ge + 64;
    const float* RW = (const float*)(F.ws + O_RW); const size_t AS = (size_t)MP * 512; float* MATS = (float*)(F.ws + O_MATS) + (size_t)(c * 8 + h) * 16384;
    int tid = F.tid, w = F.wave; asm volatile("" : "+v"(tid), "+s"(w));
    const int lane = tid & 63, seg = tid >> 6, k = tid & 63;
    __syncthreads();
    { float p[8];
#pragma unroll
      for (int i = 0; i < 8; ++i) { const int s = RWC * c + 8 * seg + i; const float wv = s < T ? RW[AS + (size_t)row_of_seq(s) * 512 + 64 * h + k] : 1.0f; p[i] = i ? p[i - 1] * wv : wv; }
      segt[seg * 64 + k] = p[7];
      __syncthreads();
      float pre = 1.0f, tot = 1.0f;
#pragma unroll
      for (int q = 0; q < 8; ++q) { const float t = segt[q * 64 + k]; if (q < seg) pre *= t; tot *= t; }
      if (seg == 0) Ge[k] = tot;
#pragma unroll
      for (int i = 0; i < 8; ++i) { const int il = 8 * seg + i, s = RWC * c + il; const float G = pre * p[i], Gm1 = i ? pre * p[i - 1] : pre;
          float nk = 0.f, r = 0.f, b = 0.f, kk = 0.f;
          if (s < T) { const size_t o = (size_t)row_of_seq(s) * 512 + 64 * h + k; r = RW[o]; kk = RW[2 * AS + o]; nk = RW[4 * AS + o]; b = RW[5 * AS + o]; }
          const float ig = 1.0f / G;
          NX[k * 65 + il] = nk * Gm1; RTT[k * 65 + il] = r * G; BH[il * 65 + k] = b * ig; KH[il * 65 + k] = kk * ig; } }
    __syncthreads();
#define RW_PROD_TILE(PROD, TR, TC) do { const int prod_ = (PROD), tr_ = (TR), tc_ = (TC); f32x16 acc = zero16(); \
        if (tr_ <= tc_) mma32(acc, ((prod_ & 1) ? KH : BH) + 32 * tr_ * 65, 65, 1, ((prod_ < 2) ? NX : RTT) + 32 * tc_, 65, 1, 64, lane); \
        _Pragma("unroll") for (int r = 0; r < 16; ++r) { const int j = 32 * tr_ + rreg(r, lane), i = 32 * tc_ + (lane & 31); const float v = acc[r]; \
            if (prod_ == 0) AP[j * 68 + i] = j < i ? v : 0.f; else if (prod_ == 1) BZ[j * 65 + i] = j < i ? v : 0.f; else if (prod_ == 2) Pm[j * 65 + i] = j <= i ? v : 0.f; else Qm[j * 65 + i] = j <= i ? v : 0.f; } } while (0)
    RW_PROD_TILE(w >> 2, (w >> 1) & 1, w & 1);
    __syncthreads();
    if (w >= 6) { RW_PROD_TILE(3, w - 6, 0); RW_PROD_TILE(3, w - 6, 1); }
    else if (w >= 2) { RW_PROD_TILE(2, (w - 2) >> 1, (w - 2) & 1); }
    else { LAS float* Yr = (w == 0 ? NX : BZ) + lane * 65;
        for (int ib = 0; ib < 4; ++ib) { float a[16];
#pragma unroll
            for (int ii = 0; ii < 16; ++ii) a[ii] = Yr[16 * ib + ii];
#pragma unroll 4
            for (int j = 0; j < 16 * ib; ++j) { const float y = Yr[j]; const LAS float* ap = AP + j * 68 + 16 * ib;
                const f32x4 a0 = *(const LAS f32x4*)ap, a1 = *(const LAS f32x4*)(ap + 4), a2 = *(const LAS f32x4*)(ap + 8), a3 = *(const LAS f32x4*)(ap + 12);
#pragma unroll
                for (int q = 0; q < 4; ++q) { a[q] += y * a0[q]; a[4 + q] += y * a1[q]; a[8 + q] += y * a2[q]; a[12 + q] += y * a3[q]; } }
#pragma unroll
            for (int ii = 1; ii < 16; ++ii)
#pragma unroll
                for (int jj = 0; jj < ii; ++jj) a[ii] += a[jj] * AP[(16 * ib + jj) * 68 + 16 * ib + ii];
#pragma unroll
            for (int ii = 0; ii < 16; ++ii) Yr[16 * ib + ii] = a[ii]; } }
#undef RW_PROD_TILE
    __syncthreads();
    { const int rb = w >> 1;
#pragma unroll
      for (int t = 0; t < 2; ++t) { const int cb = 2 * (w & 1) + t; f32x16 acc = zero16();
          mma32(acc, (rb < 2 ? NX : BZ) + 32 * (rb & 1) * 65, 65, 1, (cb < 2 ? BH : Pm) + 32 * (cb & 1), 65, 1, 64, lane);
          float* dst = MATS + (rb < 2 ? (cb < 2 ? 0 : 8192) : (cb < 2 ? 4096 : 12288));
#pragma unroll
          for (int r = 0; r < 16; ++r) { const int row = 32 * (rb & 1) + rreg(r, lane), col = 32 * (cb & 1) + (lane & 31); float v = acc[r];
              if (rb < 2 && cb < 2) v = (v + (row == col ? 1.0f : 0.0f)) * Ge[col]; else if (rb < 2) v += RTT[row * 65 + col]; else if (cb < 2) v = (v + KH[row * 65 + col]) * Ge[col]; else v += Qm[row * 65 + col];
              dst[row * 64 + col] = v; } } }
}
template <int SV = 0>
__device__ __forceinline__ void rwkv_state_scan(const Ctx& F, int h, int rg) {
    LAS float* Sx = (LAS float*)F.lds; LAS float* tmp = Sx + 1056; LAS float* ring = tmp + 1024;
    const float* RW = (const float*)(F.ws + O_RW); const size_t AS = (size_t)MP * 512; const float* MATS = (const float*)(F.ws + O_MATS); float* SST8 = (float*)(F.ws + (SV ? O_QKV : O_SSTATE));
    const float* ZERO = (const float*)((const bf16*)(F.ws + O_H) + (size_t)8300 * D);
    const int tid = F.tid, lane = F.lane, w = F.wave, fr = lane & 15, kq = lane >> 4, role = w >> 2, cbk = w & 3;
#define RW_DMA(cn) do { const int cc_ = (cn) < NRC ? (cn) : NRC - 1; const float* mp_ = MATS + (size_t)(cc_ * 8 + h) * 16384; LAS float* sl_ = ring + ((cn) % 3) * 9216; \
        _Pragma("unroll") for (int q_ = 0; q_ < 2; ++q_) { const int ch_ = w + 8 * q_; \
            __builtin_amdgcn_global_load_lds((const unsigned*)(mp_ + ch_ * 256 + lane * 4), (LAS unsigned*)(sl_ + ch_ * 256), 16, 0, 0); \
            __builtin_amdgcn_global_load_lds((const unsigned*)(mp_ + 4096 + ch_ * 256 + lane * 4), (LAS unsigned*)(sl_ + 4096 + ch_ * 256), 16, 0, 0); \
            const int j_ = 4 * ch_ + kq, s_ = RWC * cc_ + j_; const float* vp_ = s_ < T ? RW + 3 * AS + (size_t)row_of_seq(s_) * 512 + 64 * h + 16 * rg + fr : ZERO + fr; \
            __builtin_amdgcn_global_load_lds((const unsigned*)vp_, (LAS unsigned*)(sl_ + 8192 + ch_ * 64), 4, 0, 0); } } while (0)
    __syncthreads();
    for (int i = tid; i < 1056; i += NTHR) Sx[i] = 0.f;
    RW_DMA(0); RW_DMA(1);
    asm volatile("s_waitcnt vmcnt(0)" ::: "memory");
    __syncthreads();
    for (int c = 0; c < NRC; ++c) {
        if (SV != 1) RW_DMA(c + 2);
        { const int idx = 2 * tid, v = idx >> 6, kk = idx & 63; const f32x2 sv = (f32x2){Sx[v * 66 + kk], Sx[v * 66 + kk + 1]}; *(f32x2*)(SST8 + ((size_t)(c * 8 + h) * 64 + 16 * rg + v) * 64 + kk) = sv; }
        const LAS float* sl = ring + (c % 3) * 9216;
        float av[16], bv[16]; f32x4 acc = (f32x4){0.f, 0.f, 0.f, 0.f}, acc2 = acc;
        if (role == 0) { const LAS float* mb = sl + 16 * cbk + fr;
#pragma unroll
            for (int t = 0; t < 16; ++t) { av[t] = Sx[fr * 66 + 4 * t + kq]; bv[t] = mb[(4 * t + kq) * 64]; }
        } else { const LAS float* wb = sl + 4096 + 16 * cbk + fr; const LAS float* vt = sl + 8192 + fr;
#pragma unroll
            for (int t = 0; t < 16; ++t) { av[t] = vt[(4 * t + kq) * 16]; bv[t] = wb[(4 * t + kq) * 64]; } }
#pragma unroll
        for (int t = 0; t < (SV == 2 ? 2 : 16); t += 2) { acc = __builtin_amdgcn_mfma_f32_16x16x4f32(av[t], bv[t], acc, 0, 0, 0); acc2 = __builtin_amdgcn_mfma_f32_16x16x4f32(av[t + 1], bv[t + 1], acc2, 0, 0, 0); }
        acc = acc + acc2;
        if (role != 0) *(LAS f32x4*)(tmp + (cbk * 64 + lane) * 4) = acc;
        LBAR();
        if (role == 0) { acc = acc + *(const LAS f32x4*)(tmp + (cbk * 64 + lane) * 4);
#pragma unroll
            for (int r = 0; r < 4; ++r) Sx[(4 * kq + r) * 66 + 16 * cbk + fr] = acc[r]; }
        if (SV != 1) asm volatile("s_waitcnt vmcnt(8)" ::: "memory");
        LBAR();
    }
    asm volatile("s_waitcnt vmcnt(0)" ::: "memory");
#undef RW_DMA
}
__device__ __forceinline__ void rwkv_out_unit(const Ctx& F, int l, int c, int h) {
    LAS float* S_ = (LAS float*)F.lds; LAS float* E_ = S_ + 4160; LAS float* VT_ = E_ + 4096; LAS float* F_ = VT_ + 4096; LAS float* O_ = F_ + 4096;
    const float* RW = (const float*)(F.ws + O_RW); const size_t AS = (size_t)MP * 512; const float* MATS = (const float*)(F.ws + O_MATS) + (size_t)(c * 8 + h) * 16384;
    const float* SST8 = (const float*)(F.ws + O_SSTATE) + (size_t)(c * 8 + h) * 4096; const float* RBON = (const float*)(F.ws + O_RBON); bf16* Y = (bf16*)(F.ws + O_Y);
    int tid = F.tid, w = F.wave; asm volatile("" : "+v"(tid), "+s"(w)); const int lane = tid & 63;
    const f32x4 z4 = (f32x4){0.f, 0.f, 0.f, 0.f};
    f32x4 sv[2], ev[2], fv[2], tv[2];
#pragma unroll
    for (int q = 0; q < 2; ++q) { const int idx = tid + 512 * q, r = idx >> 4, c4 = idx & 15, s = RWC * c + r;
        sv[q] = *(const f32x4*)(SST8 + r * 64 + 4 * c4); ev[q] = *(const f32x4*)(MATS + 8192 + 4 * idx); fv[q] = *(const f32x4*)(MATS + 12288 + 4 * idx);
        tv[q] = s < T ? *(const f32x4*)(RW + 3 * AS + (size_t)row_of_seq(s) * 512 + 64 * h + 4 * c4) : z4; }
    const int li = tid >> 3, part = tid & 7, ls = RWC * c + li, lrow = ls < T ? row_of_seq(ls) : 0; const size_t lo = (size_t)lrow * 512 + 64 * h + 8 * part;
    f32x4 v0 = z4, v1 = z4, g0 = z4, g1 = z4; float bon = 0.f;
    if (ls < T) { v0 = *(const f32x4*)(RW + 3 * AS + lo); v1 = *(const f32x4*)(RW + 3 * AS + lo + 4); g0 = *(const f32x4*)(RW + 6 * AS + lo); g1 = *(const f32x4*)(RW + 6 * AS + lo + 4); bon = RBON[lrow * 8 + h]; }
    __syncthreads();
#pragma unroll
    for (int q = 0; q < 2; ++q) { const int idx = tid + 512 * q, r = idx >> 4, c4 = idx & 15;
        LAS float* d = S_ + r * 65 + 4 * c4; d[0] = sv[q][0]; d[1] = sv[q][1]; d[2] = sv[q][2]; d[3] = sv[q][3];
        *(LAS f32x4*)(E_ + 4 * idx) = ev[q]; *(LAS f32x4*)(F_ + 4 * idx) = fv[q]; *(LAS f32x4*)(VT_ + r * 64 + 4 * c4) = tv[q]; }
    LBAR();
    const int tr = (w >> 1) & 1, tc = w & 1; f32x16 acc = zero16();
    if (w < 4) mma32(acc, S_ + 32 * tr * 65, 65, 1, E_ + 32 * tc, 64, 1, 64, lane);
    else { mma32(acc, VT_ + 32 * tr, 1, 64, F_ + 32 * tc, 64, 1, 64, lane);
#pragma unroll
        for (int r = 0; r < 16; ++r) O_[(32 * tr + rreg(r, lane)) * 65 + 32 * tc + (lane & 31)] = acc[r]; }
    LBAR();
    if (w < 4) {
#pragma unroll
        for (int r = 0; r < 16; ++r) O_[(32 * tr + rreg(r, lane)) * 65 + 32 * tc + (lane & 31)] += acc[r]; }
    LBAR();
    { float x[8]; float sm = 0.f;
#pragma unroll
      for (int q = 0; q < 8; ++q) { x[q] = O_[(8 * part + q) * 65 + li]; sm += x[q]; }
      sm = sum8(sm);
      const float mu = sm * (1.0f / 64.0f); float vq = 0.f;
#pragma unroll
      for (int q = 0; q < 8; ++q) { const float d = x[q] - mu; vq += d * d; }
      vq = sum8(vq);
      const float rstd = 1.0f / sqrtf(vq * (1.0f / 64.0f) + 64e-5f);
      if (ls < T) { const float* lng = F.kp->in[I_LN] + l * 512 + 64 * h + 8 * part;
          float ov[8];
#pragma unroll
          for (int q = 0; q < 4; ++q) { ov[q] = ((x[q] - mu) * rstd * lng[q] + bon * v0[q]) * g0[q]; ov[4 + q] = ((x[4 + q] - mu) * rstd * lng[4 + q] + bon * v1[q]) * g1[q]; }
          v4u wv; wv.x = cvtpk(ov[0], ov[1]); wv.y = cvtpk(ov[2], ov[3]); wv.z = cvtpk(ov[4], ov[5]); wv.w = cvtpk(ov[6], ov[7]);
          *(v4u*)(Y + (size_t)lrow * D + 1536 + 64 * h + 8 * part) = wv; } }
}
__device__ __forceinline__ void ssd_states_unit(const Ctx& F, int c, int h) {
    LAS float* Bm = (LAS float*)F.lds; LAS float* XD = Bm + 16384; LAS float* csl = XD + 8192; LAS float* lal = csl + 128; LAS float* dtl = lal + 128;
    const float* XBC = (const float*)(F.ws + O_XBC); const float* DT = (const float*)(F.ws + O_DT); const float* LA = (const float*)(F.ws + O_LA);
    float* SST = (float*)(F.ws + O_SST); float* SDEC = (float*)(F.ws + O_SDEC);
    const int tid = F.tid, lane = F.lane, w = F.wave, g = h >> 2;
    __syncthreads();
    if (tid < 128) { const int row = crow(c, tid); lal[tid] = row >= 0 ? LA[row * 8 + h] : 0.f; dtl[tid] = row >= 0 ? DT[row * 8 + h] : 0.f; }
    __syncthreads();
    if (tid < 64) { const float e0 = lal[2 * tid], e1 = lal[2 * tid + 1]; float s = e0 + e1;
#pragma unroll
        for (int o = 1; o < 64; o <<= 1) { const float t = __shfl_up(s, o); if (tid >= o) s += t; }
        csl[2 * tid + 1] = s; csl[2 * tid] = s - e1; }
    __syncthreads();
    const float cs_end = csl[127];
#pragma unroll
    for (int k = 0; k < 8; ++k) { const int idx = tid + 512 * k, j = idx >> 5, c4 = idx & 31, row = crow(c, j);
        const f32x4 v = row >= 0 ? *(const f32x4*)(XBC + (size_t)row * 1024 + 512 + 128 * g + 4 * c4) : (f32x4){0.f, 0.f, 0.f, 0.f};
        *(LAS f32x4*)(Bm + j * 128 + 4 * c4) = v; }
#pragma unroll
    for (int k = 0; k < 4; ++k) { const int idx = tid + 512 * k, j = idx >> 4, c4 = idx & 15, row = crow(c, j);
        f32x4 v = row >= 0 ? *(const f32x4*)(XBC + (size_t)row * 1024 + 64 * h + 4 * c4) : (f32x4){0.f, 0.f, 0.f, 0.f};
        v = v * (dtl[j] * expf(cs_end - csl[j]));
        *(LAS f32x4*)(XD + j * 64 + 4 * c4) = v; }
    __syncthreads();
    const int tr = w >> 2, tc = w & 3;
    f32x16 acc = zero16();
    mma32(acc, XD + 32 * tr, 1, 64, Bm + 32 * tc, 128, 1, 128, lane);
    float* dst = SST + ((size_t)(c * 8 + h) * 64 + 32 * tr) * 128 + 32 * tc + (lane & 31);
#pragma unroll
    for (int r = 0; r < 16; ++r) dst[(size_t)rreg(r, lane) * 128] = acc[r];
    if (tid == 0) SDEC[(c * 8 + h) * 32] = expf(cs_end);
}
__device__ __forceinline__ float ret_logg(int h) { return logf(1.0f - exp2f(-5.0f - (float)h)); }
__device__ __forceinline__ void ret_states_unit(const Ctx& F, int c, int h) {
    LAS float* V = (LAS float*)F.lds; LAS float* KD = V + 16384;
    const float* U = (const float*)(F.ws + O_U); const float* RQK = (const float*)(F.ws + O_RQK); float* RST = (float*)(F.ws + O_RST);
    const int tid = F.tid, lane = F.lane, w = F.wave; const float lg = ret_logg(h);
    __syncthreads();
#pragma unroll
    for (int k = 0; k < 8; ++k) { const int idx = tid + 512 * k, j = idx >> 5, c4 = idx & 31, row = crow(c, j);
        const f32x4 v = row >= 0 ? *(const f32x4*)(U + (size_t)row * NINP + U_RET + 512 + 128 * h + 4 * c4) : (f32x4){0.f, 0.f, 0.f, 0.f};
        *(LAS f32x4*)(V + j * 128 + 4 * c4) = v; }
#pragma unroll
    for (int k = 0; k < 4; ++k) { const int idx = tid + 512 * k, j = idx >> 4, c4 = idx & 15, row = crow(c, j);
        f32x4 v = row >= 0 ? *(const f32x4*)(RQK + (size_t)row * 512 + 256 + 64 * h + 4 * c4) : (f32x4){0.f, 0.f, 0.f, 0.f};
        v = v * expf((float)(127 - j) * lg);
        *(LAS f32x4*)(KD + j * 64 + 4 * c4) = v; }
    __syncthreads();
    const int tr = w >> 1, tc = w & 1;
    f32x16 acc = zero16();
    mma32(acc, V + 32 * tr, 1, 128, KD + 32 * tc, 64, 1, 128, lane);
    float* dst = RST + ((size_t)(c * 4 + h) * 128 + 32 * tr) * 64 + 32 * tc + (lane & 31);
#pragma unroll
    for (int r = 0; r < 16; ++r) dst[(size_t)rreg(r, lane) * 64] = acc[r];
}

__device__ __forceinline__ void scan_job(float* base, size_t cstride, const float* dec, int decstride, float constdec) {
    float s = 0.f; float t[13], d[13];
#pragma unroll
    for (int i = 0; i < 13; ++i) { t[i] = base[(size_t)i * cstride]; d[i] = dec ? dec[i * decstride] : constdec; }
#pragma unroll
    for (int c0 = 0; c0 < NCH; c0 += 13) { float tn[13], dn[13];
        if (c0 + 13 < NCH) {
#pragma unroll
            for (int i = 0; i < 13; ++i) { tn[i] = base[(size_t)(c0 + 13 + i) * cstride]; dn[i] = dec ? dec[(c0 + 13 + i) * decstride] : constdec; } }
#pragma unroll
        for (int i = 0; i < 13; ++i) { base[(size_t)(c0 + i) * cstride] = s; s = d[i] * s + t[i]; }
#pragma unroll
        for (int i = 0; i < 13; ++i) { t[i] = tn[i]; d[i] = dn[i]; } }
}
__device__ __forceinline__ void rwkv_scan(const Ctx& F, int hb) {
    LAS float* st = (LAS float*)F.lds;
    float* RW = (float*)(F.ws + O_RW); const size_t AS = (size_t)MP * 512; float* OUT = RW + 7 * AS;
    const int tid = F.tid, lane = F.lane, rl = lane >> 3, ks = lane & 7, myrow = 8 * F.wave + rl;
    float S[8];
#pragma unroll
    for (int j = 0; j < 8; ++j) S[j] = 0.f;
    for (int s0 = 0; s0 < T; s0 += 32) {
        __syncthreads();
#pragma unroll
        for (int j = 0; j < 6; ++j) { const int idx = tid + 512 * j, stp = idx / 96, rem = idx % 96, arr = rem >> 4, c4 = rem & 15, s = s0 + stp;
            if (s < T) { const int row = row_of_seq(s); const int asel = arr == 0 ? 0 : (arr == 1 ? 1 : (arr == 2 ? 2 : (arr == 3 ? 4 : (arr == 4 ? 5 : 3))));
                *(LAS f32x4*)(st + stp * 384 + arr * 64 + 4 * c4) = *(const f32x4*)(RW + asel * AS + (size_t)row * 512 + 64 * hb + 4 * c4); } }
        __syncthreads();
        const int nst = (T - s0) < 32 ? (T - s0) : 32;
        for (int stp = 0; stp < nst; ++stp) { const LAS float* b = st + stp * 384 + 8 * ks;
            const f32x4 r0 = *(const LAS f32x4*)(b), r1 = *(const LAS f32x4*)(b + 4), w0 = *(const LAS f32x4*)(b + 64), w1 = *(const LAS f32x4*)(b + 68), k0 = *(const LAS f32x4*)(b + 128), k1 = *(const LAS f32x4*)(b + 132),
                        n0 = *(const LAS f32x4*)(b + 192), n1 = *(const LAS f32x4*)(b + 196), b0 = *(const LAS f32x4*)(b + 256), b1 = *(const LAS f32x4*)(b + 260);
            const float vv = st[stp * 384 + 320 + myrow];
            float sa = (S[0] * n0[0] + S[1] * n0[1]) + (S[2] * n0[2] + S[3] * n0[3]) + (S[4] * n1[0] + S[5] * n1[1]) + (S[6] * n1[2] + S[7] * n1[3]);
            sa += __shfl_xor(sa, 1); sa += __shfl_xor(sa, 2); sa += __shfl_xor(sa, 4);
            float o = 0.f;
#pragma unroll
            for (int j = 0; j < 4; ++j) { S[j] = S[j] * w0[j] + sa * b0[j] + vv * k0[j]; o += S[j] * r0[j]; S[4 + j] = S[4 + j] * w1[j] + sa * b1[j] + vv * k1[j]; o += S[4 + j] * r1[j]; }
            o += __shfl_xor(o, 1); o += __shfl_xor(o, 2); o += __shfl_xor(o, 4);
            if (ks == 0) OUT[(size_t)row_of_seq(s0 + stp) * 512 + 64 * hb + myrow] = o; }
    }
}
__device__ __forceinline__ void mla_prep2_unit(const Ctx& F, int l, int un) {
    const float* QKVb = (const float*)(F.ws + O_QKV); const float* U = (const float*)(F.ws + O_U);
    bf16* Q = (bf16*)(F.ws + O_Q); bf16* K = (bf16*)(F.ws + O_K); bf16* VT = (bf16*)(F.ws + O_VT);
    LAS bf16* Vl = (LAS bf16*)F.lds;
    const int lane = F.lane, tid = F.tid;
    const float* gq = F.kp->in[I_QKNQ] + l * 192; const float* gk = F.kp->in[I_QKNK] + l * 192;
    const float gq0 = gq[lane], gq1 = gq[64 + lane], gq2 = gq[128 + lane], gk0 = gk[lane], gk1 = gk[64 + lane], gk2 = gk[128 + lane];
    const float qs = 0.07216878364870322f * 1.4426950408889634f;
    __syncthreads();
#pragma unroll 1
    for (int ib = 0; ib < 8; ib += 4) {
        float xq[4][12], xk[4][8], xv[4][8], kpe[4]; f32x2 cs[4];
#pragma unroll
        for (int p = 0; p < 4; ++p) { const int s = 64 * un + 8 * F.wave + ib + p; const int row = s < T ? row_of_seq(s) : 0; const float* qk = QKVb + (size_t)row * MLAN;
            cs[p] = ((const f32x2*)(F.ws + O_ROPE))[row * 32 + (lane & 31)]; kpe[p] = U[(size_t)row * NINP + 512 + lane];
#pragma unroll
            for (int h = 0; h < 4; ++h) { xq[p][3 * h] = qk[192 * h + lane]; xq[p][3 * h + 1] = qk[192 * h + 64 + lane]; xq[p][3 * h + 2] = qk[192 * h + 128 + lane];
                xk[p][2 * h] = qk[768 + 256 * h + lane]; xk[p][2 * h + 1] = qk[768 + 256 * h + 64 + lane]; xv[p][2 * h] = qk[768 + 256 * h + 128 + lane]; xv[p][2 * h + 1] = qk[768 + 256 * h + 192 + lane]; } }
#pragma unroll
        for (int p = 0; p < 4; ++p) { const int sl = 8 * F.wave + ib + p, s = 64 * un + sl; const bool ok = s < T;
#pragma unroll
            for (int h = 0; h < 4; ++h) {
                { float x0 = xq[p][3 * h], x1 = xq[p][3 * h + 1], x2 = xq[p][3 * h + 2];
                  const float rs = 1.0f / sqrtf(wave_sum(x0 * x0 + x1 * x1 + x2 * x2) * (1.0f / 192.0f) + EPS);
                  x0 *= rs * gq0; x1 *= rs * gq1; x2 *= rs * gq2;
                  const float ot = xor32f(x2, lane); const float rr = lane < 32 ? x2 * cs[p].x - ot * cs[p].y : ot * cs[p].y + x2 * cs[p].x;
                  bf16* qd = Q + ((size_t)s * 4 + h) * 192; qd[lane] = (bf16)f2bf(x0 * qs); qd[64 + lane] = (bf16)f2bf(x1 * qs); qd[128 + lane] = (bf16)f2bf(rr * qs); }
                { float x0 = xk[p][2 * h], x1 = xk[p][2 * h + 1], x2 = kpe[p];
                  const float rs = 1.0f / sqrtf(wave_sum(x0 * x0 + x1 * x1 + x2 * x2) * (1.0f / 192.0f) + EPS);
                  x0 *= rs * gk0; x1 *= rs * gk1; x2 *= rs * gk2;
                  const float ot = xor32f(x2, lane); const float rr = lane < 32 ? x2 * cs[p].x - ot * cs[p].y : ot * cs[p].y + x2 * cs[p].x;
                  bf16* kd = K + ((size_t)s * 4 + h) * 192; kd[lane] = (bf16)f2bf(x0); kd[64 + lane] = (bf16)f2bf(x1); kd[128 + lane] = (bf16)f2bf(rr); }
                Vl[(h * 128 + lane) * 66 + sl] = ok ? (bf16)f2bf(xv[p][2 * h]) : (bf16)0; Vl[(h * 128 + 64 + lane) * 66 + sl] = ok ? (bf16)f2bf(xv[p][2 * h + 1]) : (bf16)0; } }
    }
    __syncthreads();
#pragma unroll
    for (int k = 0; k < 8; ++k) { const int idx = tid + 512 * k, r = idx >> 3, j = idx & 7; const LAS unsigned* src = (const LAS unsigned*)(Vl + r * 66 + 8 * j);
        v4u w; w.x = src[0]; w.y = src[1]; w.z = src[2]; w.w = src[3];
        *(v4u*)(VT + (size_t)r * TSEQ + 64 * un + 8 * j) = w; }
}
__device__ __forceinline__ void m3_phase(const Ctx& F, int l) {
    const int b2 = F.bid, NB = F.G;
    for (int job = b2; job < 192; job += NB) {
        if (job < 128) { if (!EN_SSD) continue; const int e = job * 512 + F.tid, h = e >> 13, rest = e & 8191; scan_job((float*)(F.ws + O_SST) + (size_t)h * 8192 + rest, (size_t)8 * 8192, (const float*)(F.ws + O_SDEC) + h * 32, 8 * 32, 0.f); }
        else { if (!EN_RET) continue; const int e = (job - 128) * 512 + F.tid, h = e >> 13, rest = e & 8191; scan_job((float*)(F.ws + O_RST) + (size_t)h * 8192 + rest, (size_t)4 * 8192, nullptr, 0, expf(128.0f * ret_logg(h))); }
    }
    if (EN_MLA) for (int un = NB - 1 - b2; un < (T + 63) / 64; un += NB) mla_prep2_unit(F, l, un);
}
template <int VAR = 0>
__device__ __forceinline__ void attn_unit(const Ctx& F, int hh, int qb, size_t yoff = O_Y) {
    LAS bf16* L0 = (LAS bf16*)F.lds;
    const bf16* Q = (const bf16*)(F.ws + O_Q); const bf16* K = (const bf16*)(F.ws + O_K); const bf16* VT = (const bf16*)(F.ws + O_VT); bf16* Y = (bf16*)(F.ws + yoff);
    int tid = F.tid, w = F.wave; asm volatile("" : "+v"(tid), "+s"(w));
    const int lane = tid & 63, h = lane >> 5, c = lane & 31, half = w >> 2, wq = w & 3;
    const int sq = 128 * qb + 32 * wq + c;
    bf16x8 qf[12];
#pragma unroll
    for (int ks = 0; ks < 12; ++ks) qf[ks] = *(const bf16x8*)(Q + ((size_t)sq * 4 + hh) * 192 + 16 * ks + 8 * h);
    f32x16 o[4];
#pragma unroll
    for (int t = 0; t < 4; ++t) o[t] = zero16();
    float m = -1e30f, lsum = 0.f;
    const int nst = qb + 1;
    v4u kr[6], vr[4];
    const unsigned kgo = (unsigned)(((tid >> 3) * 4 + hh) * 192 + 8 * (tid & 7)), klo = (unsigned)((tid >> 3) * 200 + 8 * (tid & 7));
    const unsigned vgo = (unsigned)((hh * 128 + (tid >> 2)) * TSEQ + 8 * (tid & 3)), vlo = (unsigned)(12800 + (tid >> 2) * 72 + 8 * (tid & 3));
#define AT_LOADK(st_) do { const bf16* kb_ = K + (size_t)(128 * (st_)) * 768; _Pragma("unroll") for (int j = 0; j < 6; ++j) kr[j] = *(const v4u*)(kb_ + kgo + (j / 3) * 49152 + 64 * (j % 3)); } while (0)
#define AT_LOADV(st_) do { const bf16* vb_ = VT + 128 * (st_); _Pragma("unroll") for (int j = 0; j < 4; ++j) vr[j] = *(const v4u*)(vb_ + vgo + (j >> 1) * 64 + 32 * (j & 1)); } while (0)
#define AT_STOREK() do { _Pragma("unroll") for (int j = 0; j < 6; ++j) *(LAS v4u*)(L0 + klo + (j / 3) * 22016 + 64 * (j % 3)) = kr[j]; } while (0)
#define AT_STOREV() do { _Pragma("unroll") for (int j = 0; j < 4; ++j) *(LAS v4u*)(L0 + vlo + (j >> 1) * 22016 + 32 * (j & 1)) = vr[j]; } while (0)
    __syncthreads();
    AT_LOADK(0); AT_LOADV(0); AT_STOREK(); AT_STOREV(); if (nst > 1) AT_LOADK(1);
    LBAR();
    const LAS bf16* Ks = L0 + half * 22016; const LAS bf16* Vs = Ks + 12800;
    for (int st = 0; st < nst; ++st) {
        const int kt = 2 * st + half;
        f32x16 sa[2];
#pragma unroll
        for (int t2 = 0; t2 < 2; ++t2) { sa[t2] = zero16();
#pragma unroll
            for (int ks = 0; ks < 12; ++ks) { const bf16x8 a = *(const LAS bf16x8*)(Ks + (32 * t2 + c) * 200 + 16 * ks + 8 * h); sa[t2] = __builtin_amdgcn_mfma_f32_32x32x16_bf16(a, qf[ks], sa[t2], 0, 0, 0); } }
        if (st == nst - 1) {
#pragma unroll
            for (int t2 = 0; t2 < 2; ++t2)
#pragma unroll
                for (int r = 0; r < 16; ++r) { const int key = 64 * kt + 32 * t2 + (r & 3) + 8 * (r >> 2) + 4 * h; if (key > sq) sa[t2][r] = -1e30f; } }
        float mx = -1e30f;
#pragma unroll
        for (int t2 = 0; t2 < 2; ++t2)
#pragma unroll
            for (int r = 0; r < 16; ++r) mx = fmaxf(mx, sa[t2][r]);
        mx = fmaxf(mx, __shfl_xor(mx, 32));
        if (__builtin_amdgcn_ballot_w64(mx > m) != 0ull) { const float mn = fmaxf(m, mx), alpha = __builtin_amdgcn_exp2f(m - mn); m = mn; lsum *= alpha;
#pragma unroll
            for (int t = 0; t < 4; ++t) o[t] = o[t] * alpha; }
        float rs = 0.f;
#pragma unroll
        for (int t2 = 0; t2 < 2; ++t2)
#pragma unroll
            for (int r = 0; r < 16; ++r) { const float pv = __builtin_amdgcn_exp2f(sa[t2][r] - m); sa[t2][r] = pv; rs += pv; }
        rs += __shfl_xor(rs, 32);
        lsum += rs;
        LBAR();
        if (st + 1 < nst) { AT_STOREK(); AT_LOADV(st + 1); }
#pragma unroll
        for (int t2 = 0; t2 < 2; ++t2)
#pragma unroll
            for (int s = 0; s < 2; ++s) { v4u pw; pw.x = cvtpk(sa[t2][8 * s], sa[t2][8 * s + 1]); pw.y = cvtpk(sa[t2][8 * s + 2], sa[t2][8 * s + 3]); pw.z = cvtpk(sa[t2][8 * s + 4], sa[t2][8 * s + 5]); pw.w = cvtpk(sa[t2][8 * s + 6], sa[t2][8 * s + 7]);
                const bf16x8 pf = __builtin_bit_cast(bf16x8, pw);
#pragma unroll
                for (int t = 0; t < 4; ++t) { const LAS bf16* vp = Vs + (32 * t + c) * 72 + 32 * t2 + 16 * s + 4 * h; const v2u lo = *(const LAS v2u*)vp, hi = *(const LAS v2u*)(vp + 8);
                    v4u vw; vw.x = lo.x; vw.y = lo.y; vw.z = hi.x; vw.w = hi.y;
                    o[t] = __builtin_amdgcn_mfma_f32_32x32x16_bf16(__builtin_bit_cast(bf16x8, vw), pf, o[t], 0, 0, 0); } }
        LBAR();
        if (st + 1 < nst) { AT_STOREV(); if (st + 2 < nst) AT_LOADK(st + 2); }
    }
#undef AT_LOADK
#undef AT_LOADV
#undef AT_STOREK
#undef AT_STOREV
    LAS float* MB = (LAS float*)F.lds + (wq * 64 + lane) * 67;
    if (half == 1) { MB[0] = m; MB[1] = lsum;
#pragma unroll
        for (int t = 0; t < 4; ++t)
#pragma unroll
            for (int r = 0; r < 16; ++r) MB[2 + 16 * t + r] = o[t][r]; }
    LBAR();
    if (half == 0) { const float m2 = MB[0], l2 = MB[1], mn = fmaxf(m, m2), a1 = __builtin_amdgcn_exp2f(m - mn), a2 = __builtin_amdgcn_exp2f(m2 - mn);
        const float inv = 1.0f / (lsum * a1 + l2 * a2);
        if (sq < T) { bf16* yr = Y + (size_t)row_of_seq(sq) * D + 128 * hh + 4 * h;
#pragma unroll
            for (int t = 0; t < 4; ++t)
#pragma unroll
                for (int rq = 0; rq < 4; ++rq) { float ov[4];
#pragma unroll
                    for (int i = 0; i < 4; ++i) ov[i] = (o[t][4 * rq + i] * a1 + MB[2 + 16 * t + 4 * rq + i] * a2) * inv;
                    v2u wv; wv.x = cvtpk(ov[0], ov[1]); wv.y = cvtpk(ov[2], ov[3]); *(v2u*)(yr + 32 * t + 8 * rq) = wv; } } }
}
__device__ __forceinline__ void ssd_out_unit(const Ctx& F, int l, int c, int h, int ih) {
    LAS float* CS_ = (LAS float*)F.lds; LAS float* BS_ = CS_ + 4352; LAS float* PS_ = BS_ + 8704; LAS float* SC_ = PS_ + 4352; LAS float* XD_ = SC_ + 8448; LAS float* csl = XD_ + 8448; LAS float* lal = csl + 128; LAS float* dtl = lal + 128;
    LAS float* Y_ = CS_;
    const float* XBC = (const float*)(F.ws + O_XBC); const float* DT = (const float*)(F.ws + O_DT); const float* LA = (const float*)(F.ws + O_LA); const float* U = (const float*)(F.ws + O_U);
    const float* SST = (const float*)(F.ws + O_SST); float* YZ = (float*)(F.ws + O_YZ);
    int tid = F.tid, w = F.wave; asm volatile("" : "+v"(tid), "+s"(w));
    const int lane = tid & 63, g = h >> 2;
    const f32x4 z4 = (f32x4){0.f, 0.f, 0.f, 0.f};
    float lav = 0.f, dtv = 0.f;
    if (tid < 128) { const int row = crow(c, tid); if (row >= 0) { lav = LA[row * 8 + h]; dtv = DT[row * 8 + h]; } }
    f32x4 xdv[4], csv[2][2], bsv[2][4], psv[2][2]; float xsv[8], zv[8];
#pragma unroll
    for (int k = 0; k < 4; ++k) { const int idx = tid + 512 * k, j = idx >> 4, c4 = idx & 15, row = crow(c, j); xdv[k] = row >= 0 ? *(const f32x4*)(XBC + (size_t)row * 1024 + 64 * h + 4 * c4) : z4; }
#pragma unroll
    for (int nh = 0; nh < 2; ++nh) {
#pragma unroll
        for (int k = 0; k < 2; ++k) { const int idx = tid + 512 * k, i = idx >> 4, c4 = idx & 15, row = crow(c, 64 * ih + i); csv[nh][k] = row >= 0 ? *(const f32x4*)(XBC + (size_t)row * 1024 + 768 + 128 * g + 64 * nh + 4 * c4) : z4; }
#pragma unroll
        for (int k = 0; k < 4; ++k) { const int idx = tid + 512 * k, j = idx >> 4, c4 = idx & 15, row = crow(c, j); bsv[nh][k] = row >= 0 ? *(const f32x4*)(XBC + (size_t)row * 1024 + 512 + 128 * g + 64 * nh + 4 * c4) : z4; }
#pragma unroll
        for (int k = 0; k < 2; ++k) { const int idx = tid + 512 * k, pp = idx >> 4, c4 = idx & 15; psv[nh][k] = *(const f32x4*)(SST + ((size_t)(c * 8 + h) * 64 + pp) * 128 + 64 * nh + 4 * c4); } }
#pragma unroll
    for (int k = 0; k < 8; ++k) { const int idx = tid + 512 * k, i = idx >> 6, pp = idx & 63, row = crow(c, 64 * ih + i); xsv[k] = 0.f; zv[k] = 0.f;
        if (row >= 0) { xsv[k] = XBC[(size_t)row * 1024 + 64 * h + pp]; zv[k] = U[(size_t)row * NINP + U_SSD + 64 * h + pp]; } }
    __syncthreads();
    if (tid < 128) { lal[tid] = lav; dtl[tid] = dtv; }
    LBAR();
    if (tid < 64) { const float e0 = lal[2 * tid], e1 = lal[2 * tid + 1]; float s = e0 + e1;
#pragma unroll
        for (int o = 1; o < 64; o <<= 1) { const float t = __shfl_up(s, o); if (tid >= o) s += t; }
        csl[2 * tid + 1] = s; csl[2 * tid] = s - e1; }
#pragma unroll
    for (int k = 0; k < 4; ++k) { const int idx = tid + 512 * k, j = idx >> 4, c4 = idx & 15; const f32x4 v = xdv[k] * dtl[j]; LAS float* d = XD_ + (4 * c4) * 132 + j; d[0] = v[0]; d[132] = v[1]; d[264] = v[2]; d[396] = v[3]; }
    f32x16 acc_s = zero16(), acc_y = zero16();
    const int tr = w >> 2, tc = w & 3, tr2 = (w >> 1) & 1, tc2 = w & 1;
#pragma unroll
    for (int nh = 0; nh < 2; ++nh) {
        if (nh) LBAR();
#pragma unroll
        for (int k = 0; k < 2; ++k) { const int idx = tid + 512 * k, i = idx >> 4, c4 = idx & 15; const f32x4 v = csv[nh][k]; *(LAS f32x4*)(CS_ + i * 68 + 4 * c4) = v; }
#pragma unroll
        for (int k = 0; k < 4; ++k) { const int idx = tid + 512 * k, j = idx >> 4, c4 = idx & 15; const f32x4 v = bsv[nh][k]; *(LAS f32x4*)(BS_ + j * 68 + 4 * c4) = v; }
#pragma unroll
        for (int k = 0; k < 2; ++k) { const int idx = tid + 512 * k, pp = idx >> 4, c4 = idx & 15; const f32x4 v = psv[nh][k]; *(LAS f32x4*)(PS_ + pp * 68 + 4 * c4) = v; }
        LBAR();
        mma32bf(acc_s, CS_ + 32 * tr * 68, 68, BS_ + 32 * tc * 68, 68, 64, lane);
        if (w < 4) mma32bf(acc_y, CS_ + 32 * tr2 * 68, 68, PS_ + 32 * tc2 * 68, 68, 64, lane);
    }
    if (w < 4) {
#pragma unroll
        for (int r = 0; r < 16; ++r) acc_y[r] *= expf(csl[64 * ih + 32 * tr2 + rreg(r, lane)]); }
#pragma unroll
    for (int r = 0; r < 16; ++r) { const int i = 32 * tr + rreg(r, lane), j = 32 * tc + (lane & 31), il = 64 * ih + i;
        SC_[i * 132 + j] = j <= il ? acc_s[r] * expf(csl[il] - csl[j]) : 0.f; }
    LBAR();
    if (w < 4) { mma32bf(acc_y, SC_ + 32 * tr2 * 132, 132, XD_ + 32 * tc2 * 132, 132, 128, lane);
#pragma unroll
        for (int r = 0; r < 16; ++r) Y_[(32 * tr2 + rreg(r, lane)) * 68 + 32 * tc2 + (lane & 31)] = acc_y[r]; }
    LBAR();
    const float Dh = F.kp->in[I_SSDD][l * 8 + h];
#pragma unroll
    for (int k = 0; k < 8; ++k) { const int idx = tid + 512 * k, i = idx >> 6, pp = idx & 63, row = crow(c, 64 * ih + i);
        if (row >= 0) YZ[(size_t)row * 512 + 64 * h + pp] = (Y_[i * 68 + pp] + Dh * xsv[k]) * siluf_(zv[k]); }
}
__device__ __forceinline__ void ret_out_unit(const Ctx& F, int l, int c, int h, int ih) {
    LAS float* Q_ = (LAS float*)F.lds; LAS float* KM_ = Q_ + 4352; LAS float* SC_ = KM_ + 8704; LAS float* VH_ = SC_ + 8448; LAS float* SP_ = KM_; LAS float* Y_ = SC_;
    const float* U = (const float*)(F.ws + O_U); const float* RQK = (const float*)(F.ws + O_RQK); const float* RST = (const float*)(F.ws + O_RST); bf16* Y = (bf16*)(F.ws + O_Y);
    int tid = F.tid, w = F.wave; asm volatile("" : "+v"(tid), "+s"(w));
    const int lane = tid & 63; const float lg = ret_logg(h);
    const f32x4 z4 = (f32x4){0.f, 0.f, 0.f, 0.f};
    f32x4 qv[2], kv[4], spv[4], vv[2][4], gv[4];
#pragma unroll
    for (int k = 0; k < 2; ++k) { const int idx = tid + 512 * k, i = idx >> 4, c4 = idx & 15, row = crow(c, 64 * ih + i); qv[k] = row >= 0 ? *(const f32x4*)(RQK + (size_t)row * 512 + 64 * h + 4 * c4) : z4; }
#pragma unroll
    for (int k = 0; k < 4; ++k) { const int idx = tid + 512 * k, j = idx >> 4, c4 = idx & 15, row = crow(c, j); kv[k] = row >= 0 ? *(const f32x4*)(RQK + (size_t)row * 512 + 256 + 64 * h + 4 * c4) : z4; }
#pragma unroll
    for (int k = 0; k < 4; ++k) { const int idx = tid + 512 * k, vx = idx >> 4, c4 = idx & 15; spv[k] = *(const f32x4*)(RST + ((size_t)(c * 4 + h) * 128 + vx) * 64 + 4 * c4); }
#pragma unroll
    for (int jh = 0; jh < 2; ++jh)
#pragma unroll
        for (int k = 0; k < 4; ++k) { const int idx = tid + 512 * k, j = idx >> 5, c4 = idx & 31, row = crow(c, 64 * jh + j); vv[jh][k] = (jh <= ih && row >= 0) ? *(const f32x4*)(U + (size_t)row * NINP + U_RET + 512 + 128 * h + 4 * c4) : z4; }
    const int li = tid >> 3, part = tid & 7, lrow = crow(c, 64 * ih + li);
#pragma unroll
    for (int k = 0; k < 4; ++k) gv[k] = lrow >= 0 ? *(const f32x4*)(U + (size_t)lrow * NINP + U_RET + 1024 + 128 * h + 16 * part + 4 * k) : z4;
    __syncthreads();
#pragma unroll
    for (int k = 0; k < 2; ++k) { const int idx = tid + 512 * k, i = idx >> 4, c4 = idx & 15; const f32x4 v = qv[k]; *(LAS f32x4*)(Q_ + i * 68 + 4 * c4) = v; }
#pragma unroll
    for (int k = 0; k < 4; ++k) { const int idx = tid + 512 * k, j = idx >> 4, c4 = idx & 15; const f32x4 v = kv[k]; *(LAS f32x4*)(KM_ + j * 68 + 4 * c4) = v; }
    LBAR();
    const int tr = w >> 2, tc = w & 3;
    f32x16 acc_s = zero16();
    mma32bf(acc_s, Q_ + 32 * tr * 68, 68, KM_ + 32 * tc * 68, 68, 64, lane);
    LBAR();
#pragma unroll
    for (int k = 0; k < 4; ++k) { const int idx = tid + 512 * k, vx = idx >> 4, c4 = idx & 15; const f32x4 v = spv[k]; *(LAS f32x4*)(SP_ + vx * 68 + 4 * c4) = v; }
#pragma unroll
    for (int r = 0; r < 16; ++r) { const int i = 32 * tr + rreg(r, lane), j = 32 * tc + (lane & 31), il = 64 * ih + i;
        SC_[i * 132 + j] = j <= il ? acc_s[r] * expf((float)(il - j) * lg) : 0.f; }
#pragma unroll
    for (int k = 0; k < 4; ++k) { const int idx = tid + 512 * k, j = idx >> 5, c4 = idx & 31; const f32x4 v = vv[0][k]; LAS float* d = VH_ + (4 * c4) * 68 + j; d[0] = v[0]; d[68] = v[1]; d[136] = v[2]; d[204] = v[3]; }
    LBAR();
    f32x16 acc_y = zero16();
    mma32bf(acc_y, Q_ + 32 * tr * 68, 68, SP_ + 32 * tc * 68, 68, 64, lane);
#pragma unroll
    for (int r = 0; r < 16; ++r) acc_y[r] *= expf((float)(64 * ih + 32 * tr + rreg(r, lane) + 1) * lg);
    mma32bf(acc_y, SC_ + 32 * tr * 132, 132, VH_ + 32 * tc * 68, 68, 64, lane);
    if (ih) { LBAR();
#pragma unroll
        for (int k = 0; k < 4; ++k) { const int idx = tid + 512 * k, j = idx >> 5, c4 = idx & 31; const f32x4 v = vv[1][k]; LAS float* d = VH_ + (4 * c4) * 68 + j; d[0] = v[0]; d[68] = v[1]; d[136] = v[2]; d[204] = v[3]; }
        LBAR();
        mma32bf(acc_y, SC_ + 32 * tr * 132 + 64, 132, VH_ + 32 * tc * 68, 68, 64, lane); }
    LBAR();
#pragma unroll
    for (int r = 0; r < 16; ++r) Y_[(32 * tr + rreg(r, lane)) * 132 + 32 * tc + (lane & 31)] = acc_y[r];
    LBAR();
    { const LAS float* yr = Y_ + li * 132 + 16 * part;
      float s = 0.f;
#pragma unroll
      for (int k = 0; k < 16; ++k) s += yr[k];
      s = sum8(s);
      const float mu = s * (1.0f / 128.0f); float q = 0.f;
#pragma unroll
      for (int k = 0; k < 16; ++k) { const float d = yr[k] - mu; q += d * d; }
      q = sum8(q);
      const float rstd = 1.0f / sqrtf(q * (1.0f / 128.0f) + EPS);
      if (lrow >= 0) { const float* ng = F.kp->in[I_RETN] + l * 512 + 128 * h + 16 * part; float ov[16];
#pragma unroll
          for (int k = 0; k < 16; ++k) ov[k] = (yr[k] - mu) * rstd * ng[k] * siluf_(gv[k >> 2][k & 3]);
          bf16* yd = Y + (size_t)lrow * D + 1024 + 128 * h + 16 * part;
          v4u w0, w1; w0.x = cvtpk(ov[0], ov[1]); w0.y = cvtpk(ov[2], ov[3]); w0.z = cvtpk(ov[4], ov[5]); w0.w = cvtpk(ov[6], ov[7]); w1.x = cvtpk(ov[8], ov[9]); w1.y = cvtpk(ov[10], ov[11]); w1.z = cvtpk(ov[12], ov[13]); w1.w = cvtpk(ov[14], ov[15]);
          *(v4u*)yd = w0; *(v4u*)(yd + 8) = w1; } }
}
__device__ __forceinline__ void m4_phase(const Ctx& F, int l, int qi = 0, int only = -1) {
    unsigned* ctr = (unsigned*)(F.ws + O_CTL) + CW_QUEUE + 64 * (4 * l + qi);
    constexpr int N_AT = 4 * NCH, N_CV = 128, N_SO = NCH * 16, N_RO = NCH * 8, N_WO = NRC * 8, N_ALL = N_AT + N_CV + N_SO + N_RO + N_WO;
    int u = queue_next(F, ctr);
    while (u < N_AT) { if (only < 0) attn_unit<0>(F, u & 3, (NCH - 1) - (u >> 2)); else if (only == 0) attn_unit<DUP_VAR>(F, u & 3, (NCH - 1) - (u >> 2), O_QKV); u = queue_next(F, ctr); }
    while (u < N_AT + N_CV) { if (l + 1 < DEPTH && only < 0) { __syncthreads(); convert_layer(F, l + 1, (u - N_AT) * NWAVES + F.wave, N_CV * NWAVES); }
        u = queue_next(F, ctr); }
    while (u < N_AT + N_CV + N_SO + N_RO) { int v = u - N_AT - N_CV;
        if (v < N_RO) { const int c = v >> 3, h = (v >> 1) & 3, ih = v & 1; if (!(c == 0 && ih == 0) && (only < 0 || only == 2)) ret_out_unit(F, l, c, h, ih); }
        else { v -= N_RO; const int c = v >> 4, h = (v >> 1) & 7, ih = v & 1; if (!(c == 0 && ih == 0) && (only < 0 || only == 1)) ssd_out_unit(F, l, c, h, ih); }
        u = queue_next(F, ctr); }
    if (u < N_ALL && only < 0) {
        if (F.tid == 0) { unsigned* sflag = (unsigned*)(F.ws + O_CTL) + CW_QUEUE + 64 * (16 + l); const unsigned nscan = F.G >= 64 ? 32u : (unsigned)F.G; unsigned sp = 0;
            while (__hip_atomic_load(sflag, __ATOMIC_RELAXED, __HIP_MEMORY_SCOPE_AGENT) < nscan) { __builtin_amdgcn_s_sleep(8); if (++sp > (1u << 22)) break; }
            __builtin_amdgcn_fence(__ATOMIC_ACQUIRE, "agent"); asm volatile("s_waitcnt vmcnt(0)" ::: "memory"); }
        __syncthreads(); }
    while (u < N_ALL) { const int v = u - (N_AT + N_CV + N_SO + N_RO); if (only < 0 || only == 3) rwkv_out_unit(F, l, v >> 3, v & 7); u = queue_next(F, ctr); }
}
__device__ __forceinline__ void m5_phase(const Ctx& F, int l) {
#ifdef PROBE_DUP
    { const bf16* Y = (const bf16*)(F.ws + O_Y); const bf16* Y2 = (const bf16*)(F.ws + O_YZ); unsigned cnt = 0;
      for (int row = F.bid * NWAVES + F.wave; row < T; row += F.G * NWAVES) for (int j = 0; j < 8; ++j) cnt += Y[(size_t)row * D + 64 * j + F.lane] != Y2[(size_t)row * D + 64 * j + F.lane];
      if (cnt) atomicAdd((unsigned*)(F.ws + O_CTL) + 8, cnt); }
#endif
#ifdef PROBE_COPY_U
    { const float* U = (const float*)(F.ws + O_U); bf16* Y = (bf16*)(F.ws + O_Y);
      for (int row = F.bid * NWAVES + F.wave; row < T; row += F.G * NWAVES)
        for (int j = 0; j < 4; ++j) { const float* ur = U + (size_t)(PROBE_COPY_META ? SEQ + (row & 15) : row) * NINP + PROBE_COPY_U + 512 * j + 8 * F.lane; const f32x4 a = *(const f32x4*)ur, b = *(const f32x4*)(ur + 4);
          v4u w; w.x = pk2(a[0], a[1]); w.y = pk2(a[2], a[3]); w.z = pk2(b[0], b[1]); w.w = pk2(b[2], b[3]); *(v4u*)(Y + (size_t)row * D + 512 * j + 8 * F.lane) = w; } }
#endif
    if (!EN_SSD) return;
    const float* YZ = (const float*)(F.ws + O_YZ); bf16* Y = (bf16*)(F.ws + O_Y); const float* ng = F.kp->in[I_SSDN] + l * 512 + 8 * F.lane;
    for (int row = F.bid * NWAVES + F.wave; row < T; row += F.G * NWAVES) { const float* yr = YZ + (size_t)row * 512 + 8 * F.lane; const f32x4 a = *(const f32x4*)yr, b = *(const f32x4*)(yr + 4);
        const float sq = wave_sum((a[0] * a[0] + a[1] * a[1]) + (a[2] * a[2] + a[3] * a[3]) + (b[0] * b[0] + b[1] * b[1]) + (b[2] * b[2] + b[3] * b[3]));
        const float rs = 1.0f / sqrtf(sq * (1.0f / 512.0f) + EPS); const f32x4 g0 = *(const f32x4*)ng, g1 = *(const f32x4*)(ng + 4);
        v4u w; w.x = pk2(a[0] * rs * g0[0], a[1] * rs * g0[1]); w.y = pk2(a[2] * rs * g0[2], a[3] * rs * g0[3]); w.z = pk2(b[0] * rs * g1[0], b[1] * rs * g1[1]); w.w = pk2(b[2] * rs * g1[2], b[3] * rs * g1[3]);
        *(v4u*)(Y + (size_t)row * D + 512 + 8 * F.lane) = w; }
}
template <int MODE  , int NT>
__device__ __forceinline__ void meta_gemm(const Ctx& F, const bf16* A16, int lda, const bf16* Bt, int ldb, int ntasks, int K, float* Cf, int ldc, const float* ss_in, float* ss_out, bf16* Ob, bf16* HL, float scale) {
    constexpr int NACC = MODE == 1 ? 2 * NT : NT;
    LAS float* red = (LAS float*)F.lds;
    int tid = F.tid, w = F.wave; asm volatile("" : "+v"(tid), "+s"(w));
    const int lane = tid & 63, g = lane >> 4, c = lane & 15, kper = K >> 3;
    for (int task = F.G - 1 - F.bid; task < ntasks; task += F.G) {
        const int n0 = MODE == 1 ? 256 * ((64 * task) >> 7) + ((64 * task) & 127) : 16 * NT * task;
        f32x4 acc[NACC];
#pragma unroll
        for (int q = 0; q < NACC; ++q) acc[q] = (f32x4){0.f, 0.f, 0.f, 0.f};
        const bf16* ap = A16 + (size_t)c * lda + w * kper + 8 * g; const bf16* bp = Bt + (size_t)(n0 + c) * ldb + w * kper + 8 * g;
#pragma unroll 4
        for (int kk = 0; kk < kper; kk += 32) { const bf16x8 a = *(const bf16x8*)(ap + kk);
#pragma unroll
            for (int t = 0; t < NT; ++t) { acc[t] = __builtin_amdgcn_mfma_f32_16x16x32_bf16(*(const bf16x8*)(bp + (size_t)(16 * t) * ldb + kk), a, acc[t], 0, 0, 0);
                if (MODE == 1) acc[NT + t] = __builtin_amdgcn_mfma_f32_16x16x32_bf16(*(const bf16x8*)(bp + (size_t)(128 + 16 * t) * ldb + kk), a, acc[NT + t], 0, 0, 0); } }
        __syncthreads();
#pragma unroll
        for (int q = 0; q < NACC; ++q) *(LAS f32x4*)(red + ((w * NACC + q) * 64 + lane) * 4) = acc[q];
        __syncthreads();
        if (w == 0) { const int row = SEQ + c; float rs = 1.0f;
            if (ss_in) { float s = 0.f;
#pragma unroll
                for (int q = 0; q < 8; ++q) { const f32x4 x = *(const f32x4*)(ss_in + (size_t)row * 32 + 4 * q); s += (x[0] + x[1]) + (x[2] + x[3]); }
                rs = __builtin_amdgcn_rsqf(s * (1.0f / 2048.0f) + EPS); }
            float sq = 0.f;
#pragma unroll
            for (int t = 0; t < NT; ++t) { f32x4 v = (f32x4){0.f, 0.f, 0.f, 0.f}, v2 = v;
#pragma unroll
                for (int ww = 0; ww < 8; ++ww) { v = v + *(const LAS f32x4*)(red + ((ww * NACC + t) * 64 + lane) * 4); if (MODE == 1) v2 = v2 + *(const LAS f32x4*)(red + ((ww * NACC + NT + t) * 64 + lane) * 4); }
                if (MODE == 0) *(f32x4*)(Cf + (size_t)row * ldc + 16 * NT * task + 16 * t + 4 * g) = v * rs;
                if (MODE == 3) { v2u wv; wv.x = pk2(v[0] * rs, v[1] * rs); wv.y = pk2(v[2] * rs, v[3] * rs); *(v2u*)(Ob + (size_t)row * ldc + 16 * NT * task + 16 * t + 4 * g) = wv; }
                if (MODE == 1) { float o[4];
#pragma unroll
                    for (int i = 0; i < 4; ++i) { const float gv = v[i] * rs, uv = v2[i] * rs; o[i] = gv * uv * __builtin_amdgcn_rcpf(1.0f + __expf(-gv)); }
                    v2u wv; wv.x = pk2(o[0], o[1]); wv.y = pk2(o[2], o[3]); *(v2u*)(Ob + (size_t)row * DFF + 64 * task + 16 * t + 4 * g) = wv; }
                if (MODE == 2) { const size_t off = (size_t)row * D + 64 * task + 16 * t + 4 * g; const v2u hi = *(const v2u*)(Ob + off), lo = *(const v2u*)(HL + off);
                    f32x4 h4 = (f32x4){pg8::bflo(hi.x) + pg8::bflo(lo.x), pg8::bfhi(hi.x) + pg8::bfhi(lo.x), pg8::bflo(hi.y) + pg8::bflo(lo.y), pg8::bfhi(hi.y) + pg8::bfhi(lo.y)}; h4 = h4 + v * scale;
                    v2u wv; wv.x = cvtpk(h4[0], h4[1]); wv.y = cvtpk(h4[2], h4[3]); v2u lv; lv.x = cvtpk(h4[0] - pg8::bflo(wv.x), h4[1] - pg8::bfhi(wv.x)); lv.y = cvtpk(h4[2] - pg8::bflo(wv.y), h4[3] - pg8::bfhi(wv.y));
                    *(v2u*)(Ob + off) = wv; *(v2u*)(HL + off) = lv; sq += (h4[0] * h4[0] + h4[1] * h4[1]) + (h4[2] * h4[2] + h4[3] * h4[3]); } }
            if (MODE == 2 && ss_out) { sq += __shfl_xor(sq, 16); sq += __shfl_xor(sq, 32); if (g == 0) __hip_atomic_fetch_add(ss_out + (size_t)row * 32 + task, sq, __ATOMIC_RELAXED, __HIP_MEMORY_SCOPE_AGENT); } }
    }    __syncthreads();
}
__device__ __forceinline__ void gemm_swiglu(const Ctx& F, int hl, int ssidx) {
    const bf16* A = (const bf16*)(F.ws + O_HB); const bf16* Bt = (const bf16*)(F.ws + O_WGU) + (size_t)hl * 11264 * 2048; const float* ss = (const float*)(F.ws + O_SS) + (size_t)ssidx * MP * 32;
    { pg8::Gemm g{A, Bt, SEQ, 11264, 2048, 2048, 2048, F.wave}; pg8::StaticOrder S; S.init(SEQ, 11264, F.G, F.bid);
      const int full = (S.nwg / F.G) * F.G, rem = S.nwg - full;
      const bool split = false && (2 * rem == F.G);
      if (split) S.lim = full;
      pg8::EpiSwiGLU E{(bf16*)(F.ws + O_ACT), DFF, ss, 1.0f / 2048.0f, EPS, 2};
      pg8::gemm_phase<pg8::EpiSwiGLU, pg8::StaticOrder, true, true, false>(F.lds, g, S, E);
      if (split) { pg8::StaticOrder S2; S2.init(SEQ, 11264, F.G, F.bid); S2.hmbase = full;
          pg8::EpiSwiGLU E2{(bf16*)(F.ws + O_ACT), DFF, ss, 1.0f / 2048.0f, EPS, 1};
          pg8::gemm_phase<pg8::EpiSwiGLU, pg8::StaticOrder, true, true, true>(F.lds, g, S2, E2); } }
    meta_gemm<1, 4>(F, A + (size_t)SEQ * 2048, 2048, Bt, 2048, DFF / 64, 2048, nullptr, 0, ss, nullptr, (bf16*)(F.ws + O_ACT), nullptr, 0.f);
}
__device__ __forceinline__ void gemm_residual(const Ctx& F, const bf16* A, const bf16* Bt, int K, int ssidx, bool to_out, float scale) {
    float* sso = ssidx >= 0 ? (float*)(F.ws + O_SS) + (size_t)ssidx * MP * 32 : nullptr;
    { pg8::Gemm g{A, Bt, SEQ, 2048, K, K, K, F.wave}; pg8::StaticOrder S; S.init(SEQ, 2048, F.G, F.bid);
      pg8::EpiResidual E{(bf16*)(F.ws + O_H), (bf16*)(F.ws + O_HB), sso, to_out ? F.kp->out : nullptr, SEQ, scale};
      pg8::gemm_phase<pg8::EpiResidual, pg8::StaticOrder, true, true>(F.lds, g, S, E); }
    meta_gemm<2, 4>(F, A + (size_t)SEQ * K, K, Bt, K, 32, K, nullptr, 0, nullptr, sso, (bf16*)(F.ws + O_HB), (bf16*)(F.ws + O_H), scale);
}
__device__ __forceinline__ void gemm_residual_dummy(const Ctx& F, const bf16* A, const bf16* Bt, int K) {
    { pg8::Gemm g{A, Bt, SEQ, 2048, K, K, K, F.wave}; pg8::StaticOrder S; S.init(SEQ, 2048, F.G, F.bid);
      pg8::EpiResidual E{(bf16*)(F.ws + O_RW), (bf16*)(F.ws + O_RW + (size_t)72 * 1024 * 1024), nullptr, nullptr, SEQ, 0.5f};
      pg8::gemm_phase<pg8::EpiResidual, pg8::StaticOrder, true, true>(F.lds, g, S, E); }
}
__device__ __forceinline__ void gemm_scalef32(const Ctx& F, const bf16* A, const bf16* Bt, int N, int K, float* C, int ssidx) {
    const float* ss = ssidx >= 0 ? (const float*)(F.ws + O_SS) + (size_t)ssidx * MP * 32 : nullptr;
    { pg8::Gemm g{A, Bt, SEQ, N, K, K, K, F.wave}; pg8::StaticOrder S; S.init(SEQ, N, F.G, F.bid);
      pg8::EpiScaleF32 E{C, N, ss, 1.0f / 2048.0f, EPS};
      pg8::gemm_phase<pg8::EpiScaleF32, pg8::StaticOrder, true, true>(F.lds, g, S, E); }
    meta_gemm<0, 4>(F, A + (size_t)SEQ * K, K, Bt, K, N / 64, K, C, N, ss, nullptr, nullptr, nullptr, 0.f);
}
__global__ void __launch_bounds__(NTHR, 2) hybrid_fwd(P p) {
    extern __shared__ __attribute__((aligned(16))) unsigned char lds_raw[];
    LAS unsigned char* lds = (LAS unsigned char*)lds_raw;
    const int wv = __builtin_amdgcn_readfirstlane((int)threadIdx.x >> 6);
    for (int u = threadIdx.x; u < (LDS_BYTES - LDSCTL_OFF) / 4; u += NTHR) ((LAS unsigned*)(lds + LDSCTL_OFF))[u] = 0u;
    __syncthreads();
    XcdBarrier bar = xcd_barrier_post((unsigned*)(p.ws + O_CTL) + CW_BAR, (volatile LAS unsigned*)(lds + LDSCTL_OFF), wv);
    const int lo = p.ph_lo, hi = p.ph_hi;
#ifdef TIME_MASK
    if (blockIdx.x == TIME_BLK && threadIdx.x == 0) { volatile LAS unsigned long long* tp_ = (volatile LAS unsigned long long*)(lds + LDSCTL_OFF + 1024); tp_[0] = wall_clock64(); tp_[1] = 0ull; }
#endif
#define IN(k) (lo <= (k) && (k) < hi)
#ifdef TIME_MASK
#ifndef TIME_PRE
#define TIME_PRE 0
#endif
#ifndef TIME_BLK
#define TIME_BLK 0
#endif
#define TMARK(kind, post) do { if (blockIdx.x == TIME_BLK && threadIdx.x == 0) { const unsigned long long now_ = wall_clock64(); volatile LAS unsigned long long* tp_ = (volatile LAS unsigned long long*)(lds + LDSCTL_OFF + 1024); \
    if ((((post) ? TIME_MASK : TIME_PRE) >> (kind)) & 1) tp_[1] += now_ - tp_[0]; if (post) tp_[0] = now_; } } while (0)
#define SEAM(k, kind) do { TMARK(kind, 0); if (IN(k) && IN((k) + 1)) xcd_barrier(bar, wv); TMARK(kind, 1); } while (0)
#else
#define TMARK(kind, post) do { } while (0)
#define SEAM(k, kind) do { if (IN(k) && IN((k) + 1)) xcd_barrier(bar, wv); } while (0)
#endif
#ifndef NO_P0
    if (IN(0)) { const Ctx F = ctx_make(lds, wv); p0_prologue(F, 0); }
#ifdef DUP_CVT
    if (IN(0)) { const Ctx F = ctx_make(lds, wv); p0_prologue(F, 1); }
#endif
#endif
    SEAM(0, 0);
    for (int hl = 0; hl < 8; ++hl) {
        const int l = hl >> 1, second = hl & 1, base = 1 + 11 * l + (second ? 9 : 0);
        if (IN(base)) { const Ctx F = ctx_make(lds, wv); gemm_swiglu(F, hl, 3 * l + (second ? 2 : 0)); }
#ifdef DUP_GU
        if (IN(base)) { const Ctx F = ctx_make(lds, wv); gemm_swiglu(F, hl, 3 * l + (second ? 2 : 0)); }
#endif
        SEAM(base, 1);
        if (IN(base + 1)) { const Ctx F = ctx_make(lds, wv);
            gemm_residual(F, (const bf16*)(F.ws + O_ACT), (const bf16*)(F.ws + O_WD) + (size_t)hl * 2048 * 5632, 5632, second ? (l < 3 ? 3 * (l + 1) : -1) : 3 * l + 1, hl == 7, 0.5f); }
#ifdef DUP_DOWN
        if (IN(base + 1)) { const Ctx F = ctx_make(lds, wv); if (DUP_DOWN == 1) gemm_residual_dummy(F, (const bf16*)(F.ws + O_ACT), (const bf16*)(F.ws + O_WD) + (size_t)hl * 2048 * 5632, 5632); else gemm_residual_dummy(F, (const bf16*)(F.ws + O_Y), (const bf16*)(F.ws + O_WOUT) + (size_t)l * D * D, 2048); }
#endif
        if (hl < 7) SEAM(base + 1, 2);
        if (!second) {
            const int mb = base + 2;
            if (IN(mb)) { const Ctx F = ctx_make(lds, wv); gemm_scalef32(F, (const bf16*)(F.ws + O_HB), (const bf16*)(F.ws + O_WIN) + (size_t)l * NINP * D, NINP, 2048, (float*)(F.ws + O_U), 3 * l + 1); }
#ifdef DUP_WIN
            if (IN(mb)) { const Ctx F = ctx_make(lds, wv); gemm_scalef32(F, (const bf16*)(F.ws + O_HB), (const bf16*)(F.ws + O_WIN) + (size_t)l * NINP * D, NINP, 2048, (float*)(F.ws + O_U), 3 * l + 1); }
#endif
            SEAM(mb, 3);
#ifndef NO_M1
            if (IN(mb + 1)) { const Ctx F = ctx_make(lds, wv); m1_phase(F, l); }
#ifdef DUP_M1
            if (IN(mb + 1)) { const Ctx F = ctx_make(lds, wv); m1_phase(F, l, 3); }
#endif
#endif
            SEAM(mb + 1, 4);
            if (IN(mb + 2)) {
                if (EN_MLA) { const Ctx F = ctx_make(lds, wv); gemm_scalef32(F, (const bf16*)(F.ws + O_AMLA), (const bf16*)(F.ws + O_WMLA) + (size_t)l * MLAN * 512, MLAN, 512, (float*)(F.ws + O_QKV), -1); }
#ifndef NO_M2
                { const Ctx F = ctx_make(lds, wv); unsigned* ctr = (unsigned*)(F.ws + O_CTL) + CW_QUEUE + 64 * (4 * l + 2);
                  for (;;) { int u = queue_next(F, ctr); if (u >= NRC * 8 + NCH * 8 + NCH * 4) break;
                      if (u < NRC * 8) { rwkv_chunk_unit(F, u >> 3, u & 7); continue; } u -= NRC * 8;
                      if (u < NCH * 8) { ssd_states_unit(F, u >> 3, u & 7); continue; } u -= NCH * 8;
                      ret_states_unit(F, u >> 2, u & 3); } }
#ifdef DUP_M2Q
                { const Ctx F = ctx_make(lds, wv); unsigned* ctr = (unsigned*)(F.ws + O_CTL) + CW_QUEUE + 64 * (4 * l + 3);
                  for (;;) { int u = queue_next(F, ctr); if (u >= NRC * 8 + NCH * 8 + NCH * 4) break;
                      if (u < NRC * 8) { rwkv_chunk_unit(F, u >> 3, u & 7); continue; } u -= NRC * 8;
                      if (u < NCH * 8) { ssd_states_unit(F, u >> 3, u & 7); continue; } u -= NCH * 8;
                      ret_states_unit(F, u >> 2, u & 3); } }
#endif
#endif
            }
            SEAM(mb + 2, 5);
#ifndef NO_M3
            if (IN(mb + 3)) { const Ctx F = ctx_make(lds, wv); m3_phase(F, l); }
#ifdef DUP_SCAN
            if (IN(mb + 3)) { const Ctx F = ctx_make(lds, wv); if (F.bid < 32) rwkv_state_scan<DUP_SCAN>(F, F.bid >> 2, F.bid & 3); }
#endif
#endif
            SEAM(mb + 3, 6);
#ifndef NO_M4
            if (IN(mb + 4)) { const Ctx F = ctx_make(lds, wv); const int nscan = F.G >= 64 ? 32 : F.G;
                if (F.bid < nscan) { for (int s = F.bid; s < 32; s += nscan) rwkv_state_scan<0>(F, s >> 2, s & 3);
                    asm volatile("s_waitcnt vmcnt(0)" ::: "memory"); __syncthreads();
                    if (F.tid == 0) { __builtin_amdgcn_fence(__ATOMIC_RELEASE, "agent"); asm volatile("s_waitcnt vmcnt(0)" ::: "memory"); __hip_atomic_fetch_add((unsigned*)(F.ws + O_CTL) + CW_QUEUE + 64 * (16 + l), 1u, __ATOMIC_RELAXED, __HIP_MEMORY_SCOPE_AGENT); } } }
            if (IN(mb + 4)) { const Ctx F = ctx_make(lds, wv); m4_phase(F, l); }
#ifdef DUP_M4
            if (IN(mb + 4)) { const Ctx F = ctx_make(lds, wv); m4_phase(F, l, 3, DUP_M4 - 1); }
#endif
#endif
            SEAM(mb + 4, 7);
#ifndef NO_M5
            if (IN(mb + 5)) { const Ctx F = ctx_make(lds, wv); m5_phase(F, l); }
#ifdef DUP_M5
            if (IN(mb + 5)) { const Ctx F = ctx_make(lds, wv); m5_phase(F, l); }
#endif
#endif
            SEAM(mb + 5, 8);
#ifdef DUP_BAR
            for (int q = 0; q < 8; ++q) xcd_barrier(bar, wv);
#endif
            if (IN(mb + 6)) { const Ctx F = ctx_make(lds, wv); gemm_residual(F, (const bf16*)(F.ws + O_Y), (const bf16*)(F.ws + O_WOUT) + (size_t)l * D * D, 2048, 3 * l + 2, false, 1.0f); }
            SEAM(mb + 6, 9);
        }
    }
#ifdef TIME_MASK
    TMARK(2, 0); TMARK(2, 1);
    if (blockIdx.x == TIME_BLK && threadIdx.x == 0) { volatile LAS unsigned long long* tp_ = (volatile LAS unsigned long long*)(lds + LDSCTL_OFF + 1024); const unsigned long long t0_ = tp_[0], d_ = tp_[1];
        while (wall_clock64() - t0_ < d_) __builtin_amdgcn_s_sleep(8); }
#endif
#ifdef PROBE_DUP
    xcd_barrier(bar, wv);
    { const Ctx F = ctx_make(lds, wv); const float v = (float)__hip_atomic_load((unsigned*)(F.ws + O_CTL) + 8, __ATOMIC_RELAXED, __HIP_MEMORY_SCOPE_AGENT); float* out = F.kp->out;
      for (size_t i = (size_t)F.bid * NTHR + F.tid; i < (size_t)SEQ * D; i += (size_t)F.G * NTHR) out[i] = v; }
#endif
#ifdef PROBE_ADD_META
    xcd_barrier(bar, wv);
    { const Ctx F = ctx_make(lds, wv); const float* H = (const float*)(F.ws + O_H); float* out = F.kp->out;
      for (int row = F.bid * NWAVES + F.wave; row < SEQ; row += F.G * NWAVES)
        for (int j = 0; j < 8; ++j) { const int c = 256 * j + 4 * F.lane; f32x4 v = *(f32x4*)(out + (size_t)row * D + c); v = v + *(const f32x4*)(H + (size_t)(SEQ + (row & 15)) * D + c); *(f32x4*)(out + (size_t)row * D + c) = v; } }
#endif
#undef IN
#undef SEAM
}

extern "C" void kernel_launch(void* const* d_in, const int* in_sizes, int n_in, void* d_out, int out_size, void* d_ws, size_t ws_size, hipStream_t stream) {
    static int grid = 0;
    if (grid == 0) {
        if (n_in != 36 || out_size != SEQ * D || ws_size < WS_END) { fprintf(stderr, "kernel_launch: expected 36 inputs, out %d, ws >= %zu; got n_in %d out %d ws %zu\n", SEQ * D, (size_t)WS_END, n_in, out_size, ws_size); grid = -1; return; }
        int dev = 0, cus = 0, per_cu = 0;
        if (hipGetDevice(&dev) != hipSuccess || hipDeviceGetAttribute(&cus, hipDeviceAttributeMultiprocessorCount, dev) != hipSuccess) { grid = -1; return; }
        if (hipFuncSetAttribute((const void*)hybrid_fwd, hipFuncAttributeMaxDynamicSharedMemorySize, LDS_BYTES) != hipSuccess) { fprintf(stderr, "kernel_launch: hipFuncSetAttribute failed\n"); grid = -1; return; }
        if (hipOccupancyMaxActiveBlocksPerMultiprocessor(&per_cu, (const void*)hybrid_fwd, NTHR, LDS_BYTES) != hipSuccess || per_cu < 1) fprintf(stderr, "kernel_launch: occupancy query reports %d\n", per_cu);
        (void)hipGetLastError();
        grid = cus;
    }
    if (grid < 0) return;
    if (hipMemsetAsync((char*)d_ws + O_CTL, 0, SZ_CTL, stream) != hipSuccess) { fprintf(stderr, "kernel_launch: memset failed\n"); return; }
    P a{};
    for (int i = 0; i < 36; ++i) a.in[i] = (const float*)d_in[i];
    a.out = (float*)d_out; a.ws = (unsigned char*)d_ws;
#if PER_PHASE_LAUNCH
    for (int ph = 0; ph < NPHASE; ++ph) { a.ph_lo = ph; a.ph_hi = ph + 1; hipLaunchKernelGGL(hybrid_fwd, dim3(grid), dim3(NTHR), LDS_BYTES, stream, a); }
#else
    a.ph_lo = 0; a.ph_hi = NPHASE;
    hipLaunchKernelGGL(hybrid_fwd, dim3(grid), dim3(NTHR), LDS_BYTES, stream, a);
#endif
    const hipError_t le = hipPeekAtLastError();
    if (le != hipSuccess) fprintf(stderr, "kernel_launch: launch failed: %s\n", hipGetErrorName(le));
}
```

```cpp
#include <hip/hip_runtime.h>
#include <cstdio>
#include <cstdint>

#define GAS __attribute__((address_space(1)))
#define LAS __attribute__((address_space(3)))
typedef unsigned short bf16;
typedef unsigned v4u __attribute__((ext_vector_type(4)));
typedef unsigned v2u __attribute__((ext_vector_type(2)));
typedef float f32x4 __attribute__((ext_vector_type(4)));
typedef float f32x2 __attribute__((ext_vector_type(2)));
typedef float f32x16 __attribute__((ext_vector_type(16)));
typedef short bf16x8 __attribute__((ext_vector_type(8)));

constexpr int D = 2048, SEQ = 8192, NMETA = 16, T = SEQ + NMETA, MP = 8448, DFF = 5632, DEPTH = 4;
constexpr int NIN = 5320, NINP = 5376, NCH = 65, TSEQ = 8320, MLAN = 1792;
constexpr int U_MLA = 0, U_SSD = 576, U_RET = 2120, U_RWKV = 3656;
constexpr float EPS = 1e-6f;
constexpr int NWAVES = 8, NTHR = 512;
#ifndef EN_MLA
#define EN_MLA 1
#endif
#ifndef EN_SSD
#define EN_SSD 1
#endif
#ifndef EN_RET
#define EN_RET 1
#endif
#ifndef EN_RWKV
#define EN_RWKV 1
#endif
#ifndef PROBE_NOSCAN
#define PROBE_NOSCAN 0
#endif
#ifndef PROBE_ATTCOPY
#define PROBE_ATTCOPY 0
#endif
#ifndef PROBE_COPY_META
#define PROBE_COPY_META 0
#endif
#ifndef DUP_VAR
#define DUP_VAR 0
#endif
#ifndef PER_PHASE_LAUNCH
#define PER_PHASE_LAUNCH 0
#endif
constexpr int NPHASE = 1 + 8 * 2 + 4 * 7;

constexpr size_t O_CTL = 0, SZ_CTL = 13107200;
constexpr int CW_BAR = 4096;
constexpr size_t O_SS = 65536;
constexpr size_t O_WGU = O_CTL + SZ_CTL,                 SZ_WGU = (size_t)8 * 2 * DFF * D * 2;
constexpr size_t O_WD = O_WGU + SZ_WGU,                  SZ_WD = (size_t)8 * D * DFF * 2;
constexpr size_t O_WIN = O_WD + SZ_WD,                   SZ_WIN = (size_t)4 * NINP * D * 2;
constexpr size_t O_WOUT = O_WIN + SZ_WIN,                SZ_WOUT = (size_t)4 * D * D * 2;
constexpr size_t O_WMLA = O_WOUT + SZ_WOUT,              SZ_WMLA = (size_t)4 * MLAN * 512 * 2;
constexpr size_t O_H = O_WMLA + SZ_WMLA,                 SZ_H = (size_t)MP * D * 4;
constexpr size_t O_HB = O_H + SZ_H,                      SZ_HB = (size_t)MP * D * 2;
constexpr size_t O_U = O_HB + SZ_HB,                     SZ_U = (size_t)MP * NINP * 4;
constexpr size_t O_ACT = O_U;
constexpr size_t O_AMLA = O_U + SZ_U,                    SZ_AMLA = (size_t)MP * 512 * 2;
constexpr size_t O_QKV = O_AMLA + SZ_AMLA,               SZ_QKV = (size_t)MP * MLAN * 4;
constexpr size_t O_Q = O_QKV + SZ_QKV,                   SZ_Q = (size_t)TSEQ * 768 * 2;
constexpr size_t O_K = O_Q + SZ_Q;
constexpr size_t O_VT = O_K + SZ_Q,                      SZ_VT = (size_t)4 * 128 * TSEQ * 2;
constexpr size_t O_Y = O_VT + SZ_VT,                     SZ_Y = (size_t)MP * D * 2;
constexpr size_t O_XBC = O_Y + SZ_Y,                     SZ_XBC = (size_t)MP * 1024 * 4;
constexpr size_t O_DT = O_XBC + SZ_XBC,                  SZ_DT = (size_t)MP * 8 * 4;
constexpr size_t O_LA = O_DT + SZ_DT;
constexpr size_t O_SST = O_LA + SZ_DT,                   SZ_SST = (size_t)NCH * 8 * 64 * 128 * 4;
constexpr size_t O_SDEC = O_SST + SZ_SST,                SZ_SDEC = (size_t)NCH * 8 * 128;
constexpr size_t O_YZ = O_SDEC + SZ_SDEC,                SZ_YZ = (size_t)MP * 512 * 4;
constexpr size_t O_RQK = O_YZ + SZ_YZ,                   SZ_RQK = (size_t)MP * 512 * 4;
constexpr size_t O_RST = O_RQK + SZ_RQK,                 SZ_RST = (size_t)NCH * 4 * 128 * 64 * 4;
constexpr size_t O_RW = O_RST + SZ_RST,                  SZ_RW1 = (size_t)MP * 512 * 4;
constexpr size_t O_RBON = O_RW + 8 * SZ_RW1,             SZ_RBON = (size_t)MP * 8 * 4;
constexpr size_t O_ROPE = O_RBON + SZ_RBON,              SZ_ROPE = (size_t)MP * 32 * 8;
constexpr size_t O_MATS = O_ROPE + SZ_ROPE,             SZ_MATS = (size_t)129 * 8 * 16384 * 4;
constexpr size_t O_SSTATE = O_RW + 7 * SZ_RW1;
constexpr size_t WS_END = O_MATS + SZ_MATS;
static_assert((size_t)129 * 8 * 4096 * 4 <= SZ_RW1, "sstate");
static_assert(WS_END <= 1424122240ull, "d_ws map too large");
static_assert(O_SS + (size_t)12 * MP * 32 * 4 <= SZ_CTL, "ctl map");
static_assert((size_t)MP * DFF * 2 <= SZ_U, "act overlays u");

constexpr int RING_BYTES = 131072;
constexpr int LDSCTL_OFF = 143360;
constexpr int LDS_BYTES = 147456;

#define LDS_WAIT() asm volatile("s_waitcnt lgkmcnt(0)" ::: "memory")
#define LBAR() do { asm volatile("s_waitcnt lgkmcnt(0)" ::: "memory"); __builtin_amdgcn_s_barrier(); asm volatile("" ::: "memory"); } while (0)
constexpr int CW_QUEUE = 8192;
#define VM_WAIT() asm volatile("s_waitcnt vmcnt(0)" ::: "memory")
__device__ __forceinline__ unsigned f2bf(float f) { unsigned u = __builtin_bit_cast(unsigned, f); return (u + 0x7fffu + ((u >> 16) & 1u)) >> 16; }
__device__ __forceinline__ unsigned pk2(float lo, float hi) { return f2bf(lo) | (f2bf(hi) << 16); }
typedef __bf16 bf16x2_t __attribute__((ext_vector_type(2)));
__device__ __forceinline__ unsigned cvtpk(float lo, float hi) { const f32x2 v = {lo, hi}; return __builtin_bit_cast(unsigned, __builtin_convertvector(v, bf16x2_t)); }
__device__ __forceinline__ int lane_id() { unsigned ones = ~0u; asm volatile("" : "+s"(ones)); return (int)__builtin_amdgcn_mbcnt_hi(ones, __builtin_amdgcn_mbcnt_lo(ones, 0u)); }
template <int CTRL> __device__ __forceinline__ float dpp_(float v) { return __builtin_bit_cast(float, __builtin_amdgcn_update_dpp(0, __builtin_bit_cast(int, v), CTRL, 0xF, 0xF, true)); }
__device__ __forceinline__ float rdlane(float v, int l) { return __builtin_bit_cast(float, __builtin_amdgcn_readlane(__builtin_bit_cast(int, v), l)); }
__device__ __forceinline__ float sum4(float v) { v += dpp_<0xB1>(v); v += dpp_<0x4E>(v); return v; }
__device__ __forceinline__ float sum8(float v) { v = sum4(v); v += dpp_<0x141>(v); return v; }
__device__ __forceinline__ float sum16(float v) { v = sum8(v); v += dpp_<0x140>(v); return v; }
__device__ __forceinline__ float wave_sum(float v) { v = sum16(v); return (rdlane(v, 0) + rdlane(v, 16)) + (rdlane(v, 32) + rdlane(v, 48)); }
__device__ __forceinline__ float sum32(float v, int lane) { v = sum16(v); const float lo = rdlane(v, 0) + rdlane(v, 16), hi = rdlane(v, 32) + rdlane(v, 48); return (lane & 32) ? hi : lo; }
__device__ __forceinline__ float xor32f(float v, int lane) {
    const unsigned x = __builtin_bit_cast(unsigned, v); const auto r = __builtin_amdgcn_permlane32_swap(x, x, false, false);
    return __builtin_bit_cast(float, (lane & 32) ? r[0] : r[1]); }
__device__ __forceinline__ float sigmoidf_(float x) { return 1.0f / (1.0f + __expf(-x)); }
__device__ __forceinline__ float siluf_(float x) { return x / (1.0f + __expf(-x)); }
__device__ __forceinline__ float softplusf_(float x) { return x > 20.f ? x : log1pf(expf(x)); }
struct UB { const bf16* p;
    __device__ __forceinline__ float operator[](size_t i) const { return __builtin_bit_cast(float, (unsigned)p[i] << 16); }
    __device__ __forceinline__ UB operator+(size_t o) const { return UB{p + o}; } };
__device__ __forceinline__ f32x4 ldu4(const UB u) { const v2u w = *(const v2u*)u.p;
    return (f32x4){__builtin_bit_cast(float, w.x << 16), __builtin_bit_cast(float, w.x & 0xffff0000u), __builtin_bit_cast(float, w.y << 16), __builtin_bit_cast(float, w.y & 0xffff0000u)}; }
__device__ __forceinline__ int row_of_seq(int s) { return s < NMETA ? SEQ + s : s - NMETA; }
__device__ __forceinline__ int seq_of_row(int r) { return r >= SEQ ? r - SEQ : r + NMETA; }
__device__ __forceinline__ int prev_row(int r) { return r == SEQ ? -1 : (r == 0 ? T - 1 : r - 1); }
__device__ __forceinline__ int crow(int c, int p) { return c == 0 ? (p >= 112 ? SEQ + p - 112 : -1) : 128 * (c - 1) + p; }
namespace pg8 {
#define PG8_LAS __attribute__((address_space(3)))
typedef unsigned short bf16_t;
typedef short bf16x8 __attribute__((ext_vector_type(8)));
typedef float f32x4 __attribute__((ext_vector_type(4)));
typedef unsigned u32x4 __attribute__((ext_vector_type(4)));
constexpr int BM = 256, BK = 64, HALF = 128, HTB = HALF * BK * 2  , STAGE_BYTES = 8 * HTB, NXCD = 8, WGM = 8;

__host__ __device__ __forceinline__ int lds_byte(int r, int c) { const int st = (r >> 4) * 2 + (c >> 5), rr = r & 15, cc = c & 31, ob = rr * 64 + cc * 2; return st * 1024 + (ob ^ (((ob >> 9) & 1) << 5)); }
__host__ __device__ __forceinline__ void stage_rc(int b, int& R, int& C) { const int st = b / 1024, sb = b % 1024, swz = sb ^ (((sb >> 9) & 1) << 5); R = (st >> 1) * 16 + swz / 64; C = (st & 1) * 32 + (swz % 64) / 2; }
__host__ __device__ __forceinline__ int perm32(int rho) { const int n = rho >> 4, i = rho & 15; return 8 * (i >> 2) + 4 * n + (i & 3); }

struct Unit { int pm, pn, ah; };
struct Gemm { const bf16_t* A; const bf16_t* Bt; int M, N, K, lda, ldb, wv; };

struct StaticOrder {
    int nM, nN, nwg, G, c, lim, hmbase;
    __host__ __device__ void init(int M, int N, int G_, int c_) { nM = M / BM; nN = N / BM; nwg = nM * nN; G = G_; c = c_; lim = nwg; hmbase = -1; }
    __host__ __device__ bool next(int i, Unit& u) const {
        long L; u.ah = 0;
        if (hmbase >= 0) { if (i > 0) return false; L = hmbase + (c >> 1); u.ah = c & 1; if (L >= nwg) return false; }
        else { L = (long)i * G + c; if (L >= lim) return false; }
        int wgid = (int)L; { const int q = nwg / NXCD, r = nwg % NXCD, xcd = wgid % NXCD, off = wgid / NXCD; wgid = (xcd < r ? xcd * (q + 1) : r * (q + 1) + (xcd - r) * q) + off; }
        const int nig = WGM * nN, gid = wgid / nig, fm = gid * WGM, gsz = (nM - fm) < WGM ? (nM - fm) : WGM;
        u.pm = fm + ((wgid % nig) % gsz); u.pn = (wgid % nig) / gsz; return true;
    }
    __device__ __forceinline__ void a_ready(const Unit&) const {}
    __device__ __forceinline__ void done(const Unit&) const {}
};

__device__ __forceinline__ unsigned cvt_pk_bf16(float lo, float hi) { unsigned r; asm volatile("v_cvt_pk_bf16_f32 %0, %1, %2" : "=v"(r) : "v"(lo), "v"(hi)); return r; }

template <class Epi, class Sched, bool ALIGN_EPI = false, bool SP2 = false, bool HM = false>
__device__ __forceinline__ void gemm_phase(PG8_LAS unsigned char* lds, const Gemm g, const Sched& S, const Epi& E) {
    int tid = g.wv * 64 + lane_id(); asm volatile("" : "+v"(tid)); const int wid = g.wv, lane = tid & 63, wr = wid >> 2, wc = wid & 3, fr = lane & 15, fq = lane >> 4;
    const int K = g.K, nt = K / BK;
    unsigned voffA[2], voffB[2];
#pragma unroll
    for (int i = 0; i < 2; ++i) { int R, C; stage_rc(tid * 16 + i * 8192, R, C); const int Rb = Epi::PERM ? ((R & ~31) + perm32(R & 31)) : R;
        voffA[i] = (unsigned)(R * g.lda + C) * 2u; voffB[i] = (unsigned)(Rb * g.ldb + C) * 2u; }
    const size_t kstep = (size_t)(BK * 2);
    const size_t hA = (size_t)HALF * g.lda * 2, hB = (size_t)HALF * g.ldb * 2;
    const size_t tA = 2 * hA, tB = 2 * hB;
    const unsigned ldsw = (unsigned)wid * 1024u;
    const int aoff = lds_byte(wr * 64 + fr, fq * 8), boff = lds_byte(wc * 32 + fr, fq * 8);
#define PG8_SA(b, h) (((b) * 2 + (h)) * HTB)
#define PG8_SB(b, h) ((4 + (b) * 2 + (h)) * HTB)
#define PG8_STAGE(bufoff, gbase, voff) do { _Pragma("unroll") for (int _i = 0; _i < 2; ++_i) \
        __builtin_amdgcn_global_load_lds((const unsigned*)((const char*)(gbase) + (voff)[_i]), (PG8_LAS unsigned*)(lds + (bufoff) + ldsw + _i * 8192), 16, 0, 0); } while (0)
#define PG8_LDA(dst, b, h) do { _Pragma("unroll") for (int m = 0; m < 4; ++m) _Pragma("unroll") for (int k = 0; k < 2; ++k) dst[m][k] = *(const PG8_LAS bf16x8*)(lds + PG8_SA(b, h) + aoff + m * 2048 + k * 1024); } while (0)
#define PG8_LDB(dst, b, h) do { _Pragma("unroll") for (int n = 0; n < 2; ++n) _Pragma("unroll") for (int k = 0; k < 2; ++k) dst[n][k] = *(const PG8_LAS bf16x8*)(lds + PG8_SB(b, h) + boff + n * 2048 + k * 1024); } while (0)
#define PG8_MMA(ai, bj, At, Bt) do { __builtin_amdgcn_s_setprio(1); _Pragma("unroll") for (int m = 0; m < 4; ++m) _Pragma("unroll") for (int n = 0; n < 2; ++n) _Pragma("unroll") for (int k = 0; k < 2; ++k) \
        acc[ai][bj][m][n] = __builtin_amdgcn_mfma_f32_16x16x32_bf16(Bt[n][k], At[m][k], acc[ai][bj][m][n], 0, 0, 0); __builtin_amdgcn_s_setprio(0); } while (0)
#define PG8_WAIT_V(n) asm volatile("s_waitcnt vmcnt(" #n ")" ::: "memory")
#define PG8_WAIT_L(n) asm volatile("s_waitcnt lgkmcnt(" #n ")" ::: "memory")
#define PG8_BAR __builtin_amdgcn_s_barrier()
#define PG8_SCHED __builtin_amdgcn_sched_barrier(0)
    Unit cur, nxt; int ui = 0;
    if (!S.next(0, cur)) return;
    f32x4 acc[2][2][4][2];
#pragma unroll
    for (int a = 0; a < 2; ++a)
#pragma unroll
        for (int b = 0; b < 2; ++b)
#pragma unroll
            for (int m = 0; m < 4; ++m)
#pragma unroll
                for (int n = 0; n < 2; ++n) acc[a][b][m][n] = (f32x4){0.f, 0.f, 0.f, 0.f};
    bf16x8 At[4][2], B0[2][2], B1[2][2];
    const char* cA = (const char*)g.A + (size_t)cur.pm * tA + (size_t)cur.ah * hA; const char* cB = (const char*)g.Bt + (size_t)cur.pn * tB;
    S.a_ready(cur);
    if constexpr (SP2) {
        PG8_STAGE(PG8_SB(0, 0), cB, voffB); PG8_STAGE(PG8_SB(0, 1), cB + hB, voffB); PG8_STAGE(PG8_SA(0, 0), cA, voffA); PG8_STAGE(PG8_SA(0, 1), cA + hA, voffA);
        if (wr == 1) PG8_BAR;
        PG8_WAIT_V(2); PG8_BAR;
        PG8_STAGE(PG8_SB(1, 0), cB + kstep, voffB); PG8_STAGE(PG8_SA(1, 0), cA + kstep, voffA); PG8_STAGE(PG8_SB(1, 1), cB + hB + kstep, voffB);
        PG8_WAIT_V(6); PG8_BAR;
    } else {
        PG8_STAGE(PG8_SB(0, 0), cB, voffB); PG8_STAGE(PG8_SA(0, 0), cA, voffA); PG8_STAGE(PG8_SB(0, 1), cB + hB, voffB); PG8_STAGE(PG8_SA(0, 1), cA + hA, voffA);
        if (wr == 1) PG8_BAR;
        PG8_WAIT_V(4); PG8_BAR;
        PG8_STAGE(PG8_SB(1, 0), cB + kstep, voffB); PG8_STAGE(PG8_SA(1, 0), cA + kstep, voffA); PG8_STAGE(PG8_SB(1, 1), cB + hB + kstep, voffB);
        PG8_WAIT_V(6); PG8_BAR;
    }
    for (;;) {
        const bool has_next = S.next(ui + 1, nxt);
        const char* nA = has_next ? (const char*)g.A + (size_t)nxt.pm * tA + (size_t)nxt.ah * hA : cA; const char* nB = has_next ? (const char*)g.Bt + (size_t)nxt.pn * tB : cB;
        for (int t = 0; t < nt; t += 2) {
            const bool last = (t == nt - 2);
            const char* a1 = cA + (size_t)(t + 1) * kstep;
            const char* a2 = last ? nA : cA + (size_t)(t + 2) * kstep; const char* b2 = last ? nB : cB + (size_t)(t + 2) * kstep;
            const char* a3 = a2 + kstep; const char* b3 = b2 + kstep;
            if (last && has_next) S.a_ready(nxt);
            if constexpr (SP2) {
            PG8_LDB(B0, 0, 0); PG8_LDB(B1, 0, 1); PG8_SCHED; PG8_LDA(At, 0, 0); PG8_STAGE(PG8_SA(1, 1), a1 + hA, voffA);
            PG8_WAIT_V(8); PG8_WAIT_L(0); PG8_BAR; PG8_MMA(0, 0, At, B0); PG8_MMA(0, 1, At, B1); PG8_BAR; PG8_SCHED;
            if constexpr (!HM) PG8_LDA(At, 0, 1); PG8_STAGE(PG8_SB(0, 0), b2, voffB); PG8_STAGE(PG8_SB(0, 1), b2 + hB, voffB); PG8_STAGE(PG8_SA(0, 0), a2, voffA);
            PG8_WAIT_V(8); PG8_WAIT_L(0); PG8_BAR; if constexpr (!HM) { PG8_MMA(1, 0, At, B0); PG8_MMA(1, 1, At, B1); } PG8_BAR; PG8_SCHED;
            PG8_LDB(B0, 1, 0); PG8_LDB(B1, 1, 1); PG8_SCHED; PG8_LDA(At, 1, 0); PG8_STAGE(PG8_SA(0, 1), a2 + hA, voffA);
            PG8_WAIT_V(8); PG8_WAIT_L(0); PG8_BAR; PG8_MMA(0, 0, At, B0); PG8_MMA(0, 1, At, B1); PG8_BAR; PG8_SCHED;
            if constexpr (!HM) PG8_LDA(At, 1, 1); PG8_STAGE(PG8_SB(1, 0), b3, voffB); PG8_STAGE(PG8_SB(1, 1), b3 + hB, voffB); PG8_STAGE(PG8_SA(1, 0), a3, voffA);
            PG8_WAIT_V(8); PG8_WAIT_L(0); PG8_BAR; if constexpr (!HM) { PG8_MMA(1, 0, At, B0); PG8_MMA(1, 1, At, B1); } PG8_BAR; PG8_SCHED;
            } else {
            PG8_LDB(B0, 0, 0); PG8_SCHED; PG8_LDA(At, 0, 0); PG8_STAGE(PG8_SA(1, 1), a1 + hA, voffA);
            PG8_WAIT_L(8); PG8_BAR; PG8_WAIT_L(0); PG8_MMA(0, 0, At, B0); PG8_BAR; PG8_SCHED;
            PG8_LDB(B1, 0, 1); PG8_STAGE(PG8_SB(0, 0), b2, voffB);
            PG8_BAR; PG8_WAIT_L(0); PG8_MMA(0, 1, At, B1); PG8_BAR;
            PG8_LDA(At, 0, 1); PG8_STAGE(PG8_SA(0, 0), a2, voffA);
            PG8_BAR; PG8_WAIT_L(0); PG8_MMA(1, 0, At, B0); PG8_BAR; PG8_SCHED;
            PG8_STAGE(PG8_SB(0, 1), b2 + hB, voffB);
            PG8_WAIT_V(6); PG8_BAR; PG8_MMA(1, 1, At, B1); PG8_BAR;
            PG8_LDB(B0, 1, 0); PG8_SCHED; PG8_LDA(At, 1, 0); PG8_STAGE(PG8_SA(0, 1), a2 + hA, voffA);
            PG8_WAIT_L(8); PG8_BAR; PG8_WAIT_L(0); PG8_MMA(0, 0, At, B0); PG8_BAR; PG8_SCHED;
            PG8_LDB(B1, 1, 1); PG8_STAGE(PG8_SB(1, 0), b3, voffB);
            PG8_BAR; PG8_WAIT_L(0); PG8_MMA(0, 1, At, B1); PG8_BAR;
            PG8_LDA(At, 1, 1); PG8_STAGE(PG8_SA(1, 0), a3, voffA);
            PG8_BAR; PG8_WAIT_L(0); PG8_MMA(1, 0, At, B0); PG8_BAR; PG8_SCHED;
            PG8_STAGE(PG8_SB(1, 1), b3 + hB, voffB);
            PG8_WAIT_V(6); PG8_BAR; PG8_MMA(1, 1, At, B1); PG8_BAR;
            }
        }
        if constexpr (ALIGN_EPI) { if (wr == 0) PG8_BAR; }
        if constexpr (!Epi::AFTER_DRAIN) { E(acc, cur, wr, wc, fr, fq); S.done(cur); }
        if (!has_next) break;
#pragma unroll
        for (int a = 0; a < 2; ++a)
#pragma unroll
            for (int b = 0; b < 2; ++b)
#pragma unroll
                for (int m = 0; m < 4; ++m)
#pragma unroll
                    for (int n = 0; n < 2; ++n) acc[a][b][m][n] = (f32x4){0.f, 0.f, 0.f, 0.f};
        cur = nxt; cA = nA; cB = nB; ++ui;
        if constexpr (ALIGN_EPI) { if (wr == 1) PG8_BAR; }
    }
    PG8_WAIT_V(0);
    if constexpr (!ALIGN_EPI) { if (wr == 0) PG8_BAR; }
    PG8_BAR;
    if constexpr (Epi::AFTER_DRAIN) { E.fused(acc, cur, wr, wc, fr, fq, lds, wid, lane); S.done(cur); }
#undef PG8_SA
#undef PG8_SB
#undef PG8_STAGE
#undef PG8_LDA
#undef PG8_LDB
#undef PG8_MMA
#undef PG8_WAIT_V
#undef PG8_WAIT_L
#undef PG8_BAR
#undef PG8_SCHED
}

__device__ __forceinline__ float row_ss(const float* ss, int row, int fq) {
    const f32x4 a = *(const f32x4*)(ss + (size_t)row * 32 + 8 * fq), b = *(const f32x4*)(ss + (size_t)row * 32 + 8 * fq + 4);
    float s = ((a[0] + a[1]) + (a[2] + a[3])) + ((b[0] + b[1]) + (b[2] + b[3]));
    s += __shfl_xor(s, 16); s += __shfl_xor(s, 32); return s;
}
struct EpiScaleF32 {
    static constexpr bool PERM = false, AFTER_DRAIN = false;
    float* C; int ldc; const float* ss; float inv_d, eps;
    __device__ __forceinline__ void operator()(const f32x4 (&acc)[2][2][4][2], const Unit& u, int wr, int wc, int fr, int fq) const {
        const int row0 = u.pm * BM + wr * 64 + fr, col0 = u.pn * BM + wc * 32 + 4 * fq;
#pragma unroll
        for (int ai = 0; ai < 2; ++ai)
#pragma unroll
            for (int m = 0; m < 4; ++m) { const int row = row0 + ai * HALF + m * 16; float* rowp = C + (size_t)row * ldc + col0;
                const float rs = ss ? __builtin_amdgcn_rsqf(row_ss(ss, row, fq) * inv_d + eps) : 1.0f;
#pragma unroll
                for (int bj = 0; bj < 2; ++bj)
#pragma unroll
                    for (int n = 0; n < 2; ++n) *(f32x4*)(rowp + bj * HALF + n * 16) = acc[ai][bj][m][n] * rs; }
    }
};
struct EpiScaleBf16 {
    static constexpr bool PERM = true, AFTER_DRAIN = false;
    bf16_t* O; int ldo; const float* ss; float inv_d, eps;
    __device__ __forceinline__ void operator()(const f32x4 (&acc)[2][2][4][2], const Unit& u, int wr, int wc, int fr, int fq) const {
        const int row0 = u.pm * BM + wr * 64 + fr, col0 = u.pn * BM + wc * 32 + 8 * fq;
#pragma unroll
        for (int ai = 0; ai < 2; ++ai)
#pragma unroll
            for (int m = 0; m < 4; ++m) { const int row = row0 + ai * HALF + m * 16; const float rs = __builtin_amdgcn_rsqf(row_ss(ss, row, fq) * inv_d + eps);
#pragma unroll
                for (int bj = 0; bj < 2; ++bj) { const f32x4 v0 = acc[ai][bj][m][0] * rs, v1 = acc[ai][bj][m][1] * rs;
                    u32x4 w; w.x = cvt_pk_bf16(v0[0], v0[1]); w.y = cvt_pk_bf16(v0[2], v0[3]); w.z = cvt_pk_bf16(v1[0], v1[1]); w.w = cvt_pk_bf16(v1[2], v1[3]);
                    *(u32x4*)(O + (size_t)row * ldo + col0 + bj * HALF) = w; } }
    }
};
struct EpiSwiGLU {
    static constexpr bool PERM = true, AFTER_DRAIN = false;
    bf16_t* O; int ldo; const float* ss; float inv_d, eps; int nai;
    __device__ __forceinline__ void operator()(const f32x4 (&acc)[2][2][4][2], const Unit& u, int wr, int wc, int fr, int fq) const {
        const int row0 = u.pm * BM + u.ah * HALF + wr * 64 + fr, col0 = u.pn * HALF + wc * 32 + 8 * fq;
#pragma unroll
        for (int ai = 0; ai < 2; ++ai) { if (ai >= nai) break;
#pragma unroll
            for (int m = 0; m < 4; ++m) { const int row = row0 + ai * HALF + m * 16;
                const float rs = __builtin_amdgcn_rsqf(row_ss(ss, row, fq) * inv_d + eps);
                float o[8];
#pragma unroll
                for (int n = 0; n < 2; ++n)
#pragma unroll
                    for (int j = 0; j < 4; ++j) { const float gv = acc[ai][0][m][n][j] * rs, uv = acc[ai][1][m][n][j] * rs; o[n * 4 + j] = gv * uv * __builtin_amdgcn_rcpf(1.0f + __expf(-gv)); }
                u32x4 w; w.x = cvt_pk_bf16(o[0], o[1]); w.y = cvt_pk_bf16(o[2], o[3]); w.z = cvt_pk_bf16(o[4], o[5]); w.w = cvt_pk_bf16(o[6], o[7]);
                *(u32x4*)(O + (size_t)row * ldo + col0) = w; } }
    }
};
__device__ __forceinline__ float bflo(unsigned w) { return __builtin_bit_cast(float, w << 16); }
__device__ __forceinline__ float bfhi(unsigned w) { return __builtin_bit_cast(float, w & 0xffff0000u); }
struct EpiResidual {
    static constexpr bool PERM = true, AFTER_DRAIN = false;
    bf16_t* HL; bf16_t* HB; float* ss_out; float* out; int out_rows; float scale;
    __device__ __forceinline__ void operator()(const f32x4 (&acc)[2][2][4][2], const Unit& u, int wr, int wc, int fr, int fq) const {
        const int row0 = u.pm * BM + wr * 64 + fr, col0 = u.pn * BM + wc * 32 + 8 * fq;
#pragma unroll
        for (int ai = 0; ai < 2; ++ai)
#pragma unroll
            for (int m = 0; m < 4; ++m) { const int row = row0 + ai * HALF + m * 16; float sq = 0.f;
#pragma unroll
                for (int bj = 0; bj < 2; ++bj) { const size_t off = (size_t)row * 2048 + col0 + bj * HALF;
                    const u32x4 hi = *(const u32x4*)(HB + off), lo = *(const u32x4*)(HL + off);
                    f32x4 h0 = (f32x4){bflo(hi.x) + bflo(lo.x), bfhi(hi.x) + bfhi(lo.x), bflo(hi.y) + bflo(lo.y), bfhi(hi.y) + bfhi(lo.y)};
                    f32x4 h1 = (f32x4){bflo(hi.z) + bflo(lo.z), bfhi(hi.z) + bfhi(lo.z), bflo(hi.w) + bflo(lo.w), bfhi(hi.w) + bfhi(lo.w)};
                    h0 = h0 + acc[ai][bj][m][0] * scale; h1 = h1 + acc[ai][bj][m][1] * scale;
                    if (out && row < out_rows) { *(f32x4*)(out + off) = h0; *(f32x4*)(out + off + 4) = h1; }
                    u32x4 w; w.x = cvt_pk_bf16(h0[0], h0[1]); w.y = cvt_pk_bf16(h0[2], h0[3]); w.z = cvt_pk_bf16(h1[0], h1[1]); w.w = cvt_pk_bf16(h1[2], h1[3]);
                    u32x4 l2; l2.x = cvt_pk_bf16(h0[0] - bflo(w.x), h0[1] - bfhi(w.x)); l2.y = cvt_pk_bf16(h0[2] - bflo(w.y), h0[3] - bfhi(w.y)); l2.z = cvt_pk_bf16(h1[0] - bflo(w.z), h1[1] - bfhi(w.z)); l2.w = cvt_pk_bf16(h1[2] - bflo(w.w), h1[3] - bfhi(w.w));
                    *(u32x4*)(HB + off) = w; *(u32x4*)(HL + off) = l2;
                    sq += (h0[0] * h0[0] + h0[1] * h0[1]) + (h0[2] * h0[2] + h0[3] * h0[3]) + (h1[0] * h1[0] + h1[1] * h1[1]) + (h1[2] * h1[2] + h1[3] * h1[3]); }
                sq += __shfl_xor(sq, 16); sq += __shfl_xor(sq, 32);
                if (fq == 0 && ss_out) __hip_atomic_fetch_add(ss_out + (size_t)row * 32 + u.pn * 4 + wc, sq, __ATOMIC_RELAXED, __HIP_MEMORY_SCOPE_AGENT); }
    }
};
}
#define XB_TMO      128
#define XB_XCNT(j)  (256  + 64 * (j))
#define XB_XSUB(j)  (1280 + 64 * (j))
#define XB_XGEN(j)  (2304 + 64 * (j))
#define XB_TOP      3328
#define XB_TOPGEN   3392
#define XCD_BAR_WORDS 3456
#define XB_SPIN_CAP (1u << 18)

__device__ __forceinline__ unsigned xb_ld(unsigned* p)              { return __hip_atomic_load(p, __ATOMIC_RELAXED, __HIP_MEMORY_SCOPE_AGENT); }
__device__ __forceinline__ unsigned xb_add(unsigned* p, unsigned v) { return __hip_atomic_fetch_add(p, v, __ATOMIC_RELAXED, __HIP_MEMORY_SCOPE_AGENT); }
__device__ __forceinline__ unsigned xb_xcc_id() { return (unsigned)__builtin_amdgcn_s_getreg((3 << 11) | 20) & 0xFu; }
#define XB_SPIN(cond, bar) do { unsigned _sp = 0; while (cond) { __builtin_amdgcn_s_sleep(1); \
    if ((++_sp & 255u) == 0u) { if (xb_ld(&(bar)[XB_TMO])) break; if (_sp > XB_SPIN_CAP) { atomicAdd(&(bar)[XB_TMO], 1u); break; } } } } while (0)

struct XcdBarrier {
    unsigned* bar; unsigned x;
    volatile LAS unsigned* st;
};

__device__ __forceinline__ XcdBarrier xcd_barrier_post(unsigned* bar, volatile LAS unsigned* st, int wv) {
    XcdBarrier b; b.bar = bar; b.x = xb_xcc_id(); b.st = st;
    if ((wv == 0 && lane_id() == 0)) (void)xb_add(&bar[XB_XCNT(b.x)], 1u);
    return b;
}
__device__ __forceinline__ void xcd_barrier_complete(unsigned* bar, unsigned x, unsigned& nloc, unsigned& nx) {
    const unsigned G = gridDim.x * gridDim.y * gridDim.z;
    unsigned sum, cnt, mine, sp = 0u;
    for (;;) {
        sum = 0u; cnt = 0u; mine = 0u;
#pragma unroll
        for (unsigned j = 0; j < 16; ++j) { const unsigned c = xb_ld(&bar[XB_XCNT(j)]); sum += c; cnt += (c > 0u) ? 1u : 0u; mine = (j == x) ? c : mine; }
        if (sum == G) break;
        __builtin_amdgcn_s_sleep(1);
        if ((++sp & 255u) == 0u) { if (xb_ld(&bar[XB_TMO])) break; if (sp > XB_SPIN_CAP) { atomicAdd(&bar[XB_TMO], 1u); break; } }
    }
    nloc = mine > 0u ? mine : 1u; nx = cnt > 0u ? cnt : 1u;
}

__device__ __forceinline__ void xcd_barrier(const XcdBarrier& b, int wv) {
    asm volatile("s_waitcnt vmcnt(0)" ::: "memory");
    __syncthreads();
    if ((wv == 0 && lane_id() == 0)) {
        unsigned* bar = b.bar;
        __builtin_amdgcn_s_waitcnt(0);
        unsigned nloc = b.st[0], nx = b.st[1];
        if (nloc == 0u) { xcd_barrier_complete(bar, b.x, nloc, nx); b.st[0] = nloc; b.st[1] = nx; }
        const unsigned old = xb_add(&bar[XB_XSUB(b.x)], 1u);
        const unsigned gen = old / nloc;
        if (old + 1u == (gen + 1u) * nloc) {
            __builtin_amdgcn_fence(__ATOMIC_RELEASE, "agent");
            asm volatile("s_waitcnt vmcnt(0)" ::: "memory");
            const unsigned og = xb_add(&bar[XB_TOP], 1u);
            const unsigned tg = og / nx;
            if (og + 1u == (tg + 1u) * nx) xb_add(&bar[XB_TOPGEN], 1u);
            else XB_SPIN(xb_ld(&bar[XB_TOPGEN]) == tg, bar);
            __builtin_amdgcn_fence(__ATOMIC_ACQUIRE, "agent");
            xb_add(&bar[XB_XGEN(b.x)], 1u);
            asm volatile("s_waitcnt vmcnt(0)" ::: "memory");
        } else {
            XB_SPIN(xb_ld(&bar[XB_XGEN(b.x)]) == gen, bar);
            __builtin_amdgcn_fence(__ATOMIC_ACQUIRE, "agent");
            asm volatile("s_waitcnt vmcnt(0)" ::: "memory");
        }
    }
    __syncthreads();
}

struct P { const float* in[36]; float* out; unsigned char* ws; int ph_lo, ph_hi; };
enum { I_X = 0, I_META, I_F1N, I_F1G, I_F1U, I_F1D, I_MIXN, I_WIN, I_WOUT, I_QN, I_WQ, I_KVN, I_WKV, I_QKNQ, I_QKNK, I_CONVW, I_CONVB, I_DTB, I_ALOG, I_SSDD, I_SSDN, I_RETN,
       I_MU, I_W0, I_W2, I_A0, I_A2, I_G2, I_KK, I_KA, I_RK, I_LN, I_F2N, I_F2G, I_F2U, I_F2D };
#define CAS __attribute__((address_space(4)))
typedef const CAS P* KPtr;
struct Ctx { LAS unsigned char* lds; unsigned char* ws; KPtr kp; int tid, lane, wave, G, bid; };
__device__ __forceinline__ Ctx ctx_make(LAS unsigned char* lds, int wv) {
    Ctx F; KPtr kp = (KPtr)__builtin_amdgcn_kernarg_segment_ptr(); asm volatile("" : "+s"(kp)); int t = wv * 64 + lane_id(); asm volatile("" : "+v"(t));
    F.lds = lds; F.kp = kp; F.ws = kp->ws; F.tid = t; F.lane = t & 63; F.wave = __builtin_amdgcn_readfirstlane(t >> 6); F.G = gridDim.x; F.bid = blockIdx.x; return F;
}


__device__ __forceinline__ int queue_next(const Ctx& F, unsigned* ctr) {
    volatile LAS unsigned* slot = (volatile LAS unsigned*)(F.lds + LDSCTL_OFF + 64);
    __syncthreads();
    if (F.tid == 0) *slot = __hip_atomic_fetch_add(ctr, 1u, __ATOMIC_RELAXED, __HIP_MEMORY_SCOPE_AGENT);
    __syncthreads();
    return (int)*slot;
}
__device__ __forceinline__ f32x16 zero16() { f32x16 z;
#pragma unroll
    for (int i = 0; i < 16; ++i) z[i] = 0.f; return z; }
__device__ __forceinline__ void mma32(f32x16& acc, const LAS float* Ap, int sAi, int sAk, const LAS float* Bp, int sBk, int sBj, int K, int lane) {
    const int r = lane & 31, hh = lane >> 5;
    const LAS float* a = Ap + r * sAi + hh * sAk; const LAS float* b = Bp + hh * sBk + r * sBj;
#pragma unroll 4
    for (int k = 0; k < K; k += 2) acc = __builtin_amdgcn_mfma_f32_32x32x2f32(a[k * sAk], b[k * sBk], acc, 0, 0, 0);
}
__device__ __forceinline__ void mma32bf(f32x16& acc, const LAS float* Ap, int sAi, const LAS float* Bp, int sBj, int K, int lane) {
    const int r = lane & 31, hh = lane >> 5; const LAS float* a = Ap + r * sAi + 8 * hh; const LAS float* b = Bp + r * sBj + 8 * hh;
#pragma unroll 2
    for (int k = 0; k < K; k += 16) { const f32x4 a0 = *(const LAS f32x4*)(a + k), a1 = *(const LAS f32x4*)(a + k + 4), b0 = *(const LAS f32x4*)(b + k), b1 = *(const LAS f32x4*)(b + k + 4);
        v4u aw, bw; aw.x = cvtpk(a0[0], a0[1]); aw.y = cvtpk(a0[2], a0[3]); aw.z = cvtpk(a1[0], a1[1]); aw.w = cvtpk(a1[2], a1[3]); bw.x = cvtpk(b0[0], b0[1]); bw.y = cvtpk(b0[2], b0[3]); bw.z = cvtpk(b1[0], b1[1]); bw.w = cvtpk(b1[2], b1[3]);
        acc = __builtin_amdgcn_mfma_f32_32x32x16_bf16(__builtin_bit_cast(bf16x8, aw), __builtin_bit_cast(bf16x8, bw), acc, 0, 0, 0); }
}
__device__ __forceinline__ int rreg(int reg, int lane) { return (reg & 3) + 8 * (reg >> 2) + 4 * (lane >> 5); }

__device__ __forceinline__ void cvt_tile(const float* src, int srcN, const float* gain, int valid, bf16* dst, int ldd, LAS float* scr, int lane) {
    const int c4 = lane & 15, r0 = lane >> 4;
    f32x4 v[16];
#pragma unroll
    for (int i = 0; i < 16; ++i) v[i] = (4 * c4 < valid) ? *(const f32x4*)(src + (size_t)(r0 + 4 * i) * srcN + 4 * c4) : (f32x4){0.f, 0.f, 0.f, 0.f};
#pragma unroll
    for (int i = 0; i < 16; ++i) { const int kk = r0 + 4 * i; const float gk = gain ? gain[kk] : 1.0f; LAS float* d = scr + kk * 65 + 4 * c4; d[0] = v[i][0] * gk; d[1] = v[i][1] * gk; d[2] = v[i][2] * gk; d[3] = v[i][3] * gk; }
    LDS_WAIT(); asm volatile("" ::: "memory");
    const int c8 = lane & 7;
#pragma unroll
    for (int j = 0; j < 8; ++j) { const int n = (lane >> 3) + 8 * j; const LAS float* s = scr + (8 * c8) * 65 + n;
        v4u o; o.x = pk2(s[0], s[65]); o.y = pk2(s[130], s[195]); o.z = pk2(s[260], s[325]); o.w = pk2(s[390], s[455]);
        *(v4u*)(dst + (size_t)n * ldd + 8 * c8) = o; }
    LDS_WAIT(); asm volatile("" ::: "memory");
}
__device__ __forceinline__ void convert_layer(const Ctx& F, int L, int gw, int NGW) {
    LAS float* scr = (LAS float*)(F.lds + F.wave * 17408);
    const int lane = F.lane;
    constexpr int IT_GU = 2 * 32 * 176, IT_D = 2 * 88 * 32, IT_IN = 32 * 84, IT_OUT = 32 * 32, IT_MLA = 8 * 28;
    bf16* WGU = (bf16*)(F.ws + O_WGU); bf16* WD = (bf16*)(F.ws + O_WD); bf16* WIN = (bf16*)(F.ws + O_WIN); bf16* WOUT = (bf16*)(F.ws + O_WOUT); bf16* WMLA = (bf16*)(F.ws + O_WMLA);
    const int l = L;
    for (int it = gw; it < IT_GU + IT_D + IT_IN + IT_OUT + IT_MLA; it += NGW) {
        int r = it;
        if (r < IT_GU) { const int which = r / 5632, f = 2 * l + which, q = r % 5632, kb = q / 176, nb = q % 176, n0 = 64 * nb, pn = n0 >> 8, within = n0 & 255, isup = within >= 128, f0 = 128 * pn + (within & 127);
            const float* src = (which ? (isup ? F.kp->in[I_F2U] : F.kp->in[I_F2G]) : (isup ? F.kp->in[I_F1U] : F.kp->in[I_F1G])) + (size_t)l * D * DFF + (size_t)(64 * kb) * DFF + f0;
            const float* gain = (which ? F.kp->in[I_F2N] : F.kp->in[I_F1N]) + l * D + 64 * kb;
            cvt_tile(src, DFF, gain, 64, WGU + (size_t)f * 11264 * 2048 + (size_t)n0 * 2048 + 64 * kb, 2048, scr, lane); continue; }
        r -= IT_GU;
        if (r < IT_D) { const int which = r / 2816, f = 2 * l + which, q = r % 2816, kb = q / 32, nb = q % 32;
            const float* src = (which ? F.kp->in[I_F2D] : F.kp->in[I_F1D]) + (size_t)l * DFF * D + (size_t)(64 * kb) * D + 64 * nb;
            cvt_tile(src, D, nullptr, 64, WD + (size_t)f * 2048 * 5632 + (size_t)(64 * nb) * 5632 + 64 * kb, 5632, scr, lane); continue; }
        r -= IT_D;
        if (r < IT_IN) { const int q = r, kb = q / 84, nb = q % 84, n0 = 64 * nb; int valid = NIN - n0; valid = valid < 0 ? 0 : (valid > 64 ? 64 : valid);
            const float* src = F.kp->in[I_WIN] + (size_t)l * D * NIN + (size_t)(64 * kb) * NIN + n0;
            cvt_tile(src, NIN, F.kp->in[I_MIXN] + l * D + 64 * kb, valid, WIN + (size_t)l * NINP * D + (size_t)n0 * D + 64 * kb, D, scr, lane); continue; }
        r -= IT_IN;
        if (r < IT_OUT) { const int q = r, kb = q / 32, nb = q % 32;
            const float* src = F.kp->in[I_WOUT] + (size_t)l * D * D + (size_t)(64 * kb) * D + 64 * nb;
            cvt_tile(src, D, nullptr, 64, WOUT + (size_t)l * D * D + (size_t)(64 * nb) * D + 64 * kb, D, scr, lane); continue; }
        r -= IT_OUT;
        { const int q = r, kb = q / 28, nb = q % 28, n0 = 64 * nb, k0 = 64 * kb;
            const float* src; int srcN, valid;
            if (n0 < 768) { valid = k0 < 384 ? 64 : 0; src = F.kp->in[I_WQ] + (size_t)l * 384 * 768 + (size_t)k0 * 768 + n0; srcN = 768; }
            else { valid = k0 >= 384 ? 64 : 0; src = F.kp->in[I_WKV] + (size_t)l * 128 * 1024 + (size_t)(k0 - 384) * 1024 + (n0 - 768); srcN = 1024; }
            cvt_tile(src, srcN, nullptr, valid, WMLA + (size_t)l * MLAN * 512 + (size_t)n0 * 512 + k0, 512, scr, lane); }
    }
}
__device__ __forceinline__ void p0_prologue(const Ctx& F, int cvt_only) {
    const int gw = F.bid * NWAVES + F.wave, NGW = F.G * NWAVES, lane = F.lane;
    convert_layer(F, 0, gw, NGW);
    if (cvt_only) return;
    bf16* HL = (bf16*)(F.ws + O_H); bf16* HB = (bf16*)(F.ws + O_HB); float* SS = (float*)(F.ws + O_SS); bf16* Y = (bf16*)(F.ws + O_Y); f32x2* ROPE = (f32x2*)(F.ws + O_ROPE);
    for (int row = gw; row < MP; row += NGW) {
        const float* src = row < SEQ ? F.kp->in[I_X] + (size_t)row * D : F.kp->in[I_META] + (size_t)(row - SEQ) * D;
        float sq = 0.f;
#pragma unroll
        for (int j = 0; j < 8; ++j) { f32x4 v = (f32x4){0.f, 0.f, 0.f, 0.f}; if (row < T) v = *(const f32x4*)(src + 256 * j + 4 * lane);
            v2u w; w.x = cvtpk(v[0], v[1]); w.y = cvtpk(v[2], v[3]); *(v2u*)(HB + (size_t)row * D + 256 * j + 4 * lane) = w;
            v2u lw; lw.x = cvtpk(v[0] - pg8::bflo(w.x), v[1] - pg8::bfhi(w.x)); lw.y = cvtpk(v[2] - pg8::bflo(w.y), v[3] - pg8::bfhi(w.y)); *(v2u*)(HL + (size_t)row * D + 256 * j + 4 * lane) = lw;
            sq += (v[0] * v[0] + v[1] * v[1]) + (v[2] * v[2] + v[3] * v[3]); }
        sq = wave_sum(sq); if (lane == 0) __hip_atomic_fetch_add(SS + (size_t)row * 32, sq, __ATOMIC_RELAXED, __HIP_MEMORY_SCOPE_AGENT);
#ifdef PROBE_ZERO_Y
        if (true) {
#else
        if (row >= T) {
#endif
#pragma unroll
            for (int j = 0; j < 4; ++j) *(v4u*)(Y + (size_t)row * D + 512 * j + 8 * lane) = (v4u){0u, 0u, 0u, 0u}; }
#ifdef PROBE_ZERO_Y
        if (row < T && lane < 32) { const float inv = powf(10000.0f, -(float)lane / 32.0f); const float ang = (float)seq_of_row(row) * inv; float sn, cs; sincosf(ang, &sn, &cs); ROPE[row * 32 + lane] = (f32x2){cs, sn}; }
#else
        else if (lane < 32) { const float inv = powf(10000.0f, -(float)lane / 32.0f); const float ang = (float)seq_of_row(row) * inv; float sn, cs; sincosf(ang, &sn, &cs); ROPE[row * 32 + lane] = (f32x2){cs, sn}; }
#endif
    }
}

__device__ __forceinline__ void m1_unit(const Ctx& F, int l, int r0, int r1, int grp) {
    const int lane = F.lane, tid = F.tid;
    const float* U = (const float*)(F.ws + O_U);
    if (r0 < r1) { bf16* AM = (bf16*)(F.ws + O_AMLA); const float* qn = F.kp->in[I_QN] + l * 384; const float* kvn = F.kp->in[I_KVN] + l * 128;
      const float* gp = lane < 48 ? qn + 8 * lane : kvn + 8 * (lane - 48); const f32x4 g0 = *(const f32x4*)gp, g1 = *(const f32x4*)(gp + 4);
      f32x4 a4[4], b4[4];
#pragma unroll
      for (int i = 0; i < 4; ++i) { const int row = r0 + F.wave + 8 * i; const float* ur = U + (size_t)(row < r1 ? row : r0) * NINP + 8 * lane; a4[i] = *(const f32x4*)ur; b4[i] = *(const f32x4*)(ur + 4); }
#pragma unroll
      for (int i = 0; i < 4; ++i) { const int row = r0 + F.wave + 8 * i; const f32x4 a = a4[i], b = b4[i];
        const float sq = (a[0] * a[0] + a[1] * a[1]) + (a[2] * a[2] + a[3] * a[3]) + (b[0] * b[0] + b[1] * b[1]) + (b[2] * b[2] + b[3] * b[3]);
        const float sq_q = wave_sum(lane < 48 ? sq : 0.f), sq_kv = wave_sum(lane >= 48 ? sq : 0.f);
        const float rs = lane < 48 ? 1.0f / sqrtf(sq_q * (1.0f / 384.0f) + EPS) : 1.0f / sqrtf(sq_kv * (1.0f / 128.0f) + EPS);
        v4u w; w.x = pk2(a[0] * rs * g0[0], a[1] * rs * g0[1]); w.y = pk2(a[2] * rs * g0[2], a[3] * rs * g0[3]); w.z = pk2(b[0] * rs * g1[0], b[1] * rs * g1[1]); w.w = pk2(b[2] * rs * g1[2], b[3] * rs * g1[3]);
        if (row < r1) *(v4u*)(AM + (size_t)row * 512 + 8 * lane) = w; } }
    if (r0 < r1) { float* RQK = (float*)(F.ws + O_RQK); const f32x2* ROPE = (const f32x2*)(F.ws + O_ROPE);
      f32x2 cs[4][4]; float x1[4][4], x2[4][4];
#pragma unroll
      for (int i = 0; i < 4; ++i) { const int row = r0 + F.wave + 8 * i, rc = row < r1 ? row : r0;
#pragma unroll
        for (int j = 0; j < 4; ++j) { const int idx = lane + 64 * j, qk = idx >> 7, hh = (idx >> 5) & 3, i5 = idx & 31; cs[i][j] = ROPE[rc * 32 + i5];
            x1[i][j] = U[(size_t)rc * NINP + U_RET + qk * 256 + hh * 64 + i5]; x2[i][j] = U[(size_t)rc * NINP + U_RET + qk * 256 + hh * 64 + 32 + i5]; } }
#pragma unroll
      for (int i = 0; i < 4; ++i) { const int row = r0 + F.wave + 8 * i; if (row < r1) {
#pragma unroll
        for (int j = 0; j < 4; ++j) { const int idx = lane + 64 * j, qk = idx >> 7, hh = (idx >> 5) & 3, i5 = idx & 31; const float sc = qk ? 0.125f : 1.0f;
            RQK[(size_t)row * 512 + qk * 256 + hh * 64 + i5] = (x1[i][j] * cs[i][j].x - x2[i][j] * cs[i][j].y) * sc; RQK[(size_t)row * 512 + qk * 256 + hh * 64 + 32 + i5] = (x1[i][j] * cs[i][j].y + x2[i][j] * cs[i][j].x) * sc; } } } }
    if (r0 < r1) { float* XBC = (float*)(F.ws + O_XBC); float* DT = (float*)(F.ws + O_DT); float* LA = (float*)(F.ws + O_LA);
      const float* cw = F.kp->in[I_CONVW] + l * 4096; const float* cb = F.kp->in[I_CONVB] + l * 1024;
      int rw[4], p1[4], p2[4], p3[4]; float dtr[4];
#pragma unroll
      for (int i = 0; i < 4; ++i) { const int row = r0 + F.wave + 8 * i; rw[i] = row < r1 ? row : r0; p1[i] = prev_row(rw[i]); p2[i] = p1[i] >= 0 ? prev_row(p1[i]) : -1; p3[i] = p2[i] >= 0 ? prev_row(p2[i]) : -1;
          dtr[i] = U[(size_t)rw[i] * NINP + U_SSD + 1536 + (lane & 7)]; }
#pragma unroll 1
      for (int j = 0; j < 4; ++j) { const int ch = 256 * j + 4 * lane; const size_t uo = U_SSD + 512 + ch; const f32x4 z4 = (f32x4){0.f, 0.f, 0.f, 0.f};
          const f32x4 wb = *(const f32x4*)(cb + ch), w0 = *(const f32x4*)(cw + ch), w1 = *(const f32x4*)(cw + 1024 + ch), w2 = *(const f32x4*)(cw + 2048 + ch), w3 = *(const f32x4*)(cw + 3072 + ch);
          f32x4 x0[4], x1[4], x2[4], x3[4];
#pragma unroll
          for (int i = 0; i < 4; ++i) { x3[i] = *(const f32x4*)(U + (size_t)rw[i] * NINP + uo); x2[i] = p1[i] >= 0 ? *(const f32x4*)(U + (size_t)p1[i] * NINP + uo) : z4;
              x1[i] = p2[i] >= 0 ? *(const f32x4*)(U + (size_t)p2[i] * NINP + uo) : z4; x0[i] = p3[i] >= 0 ? *(const f32x4*)(U + (size_t)p3[i] * NINP + uo) : z4; }
#pragma unroll
          for (int i = 0; i < 4; ++i) { f32x4 o = wb + w0 * x0[i] + w1 * x1[i] + w2 * x2[i] + w3 * x3[i];
              o[0] = siluf_(o[0]); o[1] = siluf_(o[1]); o[2] = siluf_(o[2]); o[3] = siluf_(o[3]);
              if (r0 + F.wave + 8 * i < r1) *(f32x4*)(XBC + (size_t)rw[i] * 1024 + ch) = o; } }
#pragma unroll
      for (int i = 0; i < 4; ++i) if (lane < 8 && r0 + F.wave + 8 * i < r1) { const float dt = softplusf_(dtr[i] + F.kp->in[I_DTB][l * 8 + lane]); DT[rw[i] * 8 + lane] = dt; LA[rw[i] * 8 + lane] = -expf(F.kp->in[I_ALOG][l * 8 + lane]) * dt; } }
    if (grp >= 0) { LAS float* xl = (LAS float*)F.lds; const int hd = F.wave, col = lane & 31;
      float* RW = (float*)(F.ws + O_RW); const size_t AS = (size_t)MP * 512; float* RBON = (float*)(F.ws + O_RBON);
      const float* MU = F.kp->in[I_MU] + l * 1664; const float* W2 = F.kp->in[I_W2] + l * 32 * 512; const float* A2 = F.kp->in[I_A2] + l * 32 * 512; const float* G2 = F.kp->in[I_G2] + l * 64 * 512;
      const int r0 = 32 * grp;
      __syncthreads();
#pragma unroll
      for (int j = 0; j < 8; ++j) { const int idx = tid + 512 * j, tk = idx >> 7, cl = idx & 127, row = r0 + tk; float xs = 0.f;
          if (row < T) { const int pr = prev_row(row); const size_t uc = U_RWKV + 1536 + cl; const float x = U[(size_t)row * NINP + uc], xp = pr >= 0 ? U[(size_t)pr * NINP + uc] : 0.f; xs = x + (xp - x) * MU[1536 + cl];
              if (cl < 32) xs = tanhf(xs); else if (cl >= 64) xs = sigmoidf_(xs); }
          xl[tk * 132 + cl] = xs; }
      __syncthreads();
      float w0c[2], a0c[2], kkc[2], kac[2], rkc[2], muR[2], muK[2], muV[2];
#pragma unroll
      for (int ct = 0; ct < 2; ++ct) { const int ch = 64 * hd + 32 * ct + col; w0c[ct] = F.kp->in[I_W0][l * 512 + ch]; a0c[ct] = F.kp->in[I_A0][l * 512 + ch]; kkc[ct] = F.kp->in[I_KK][l * 512 + ch]; kac[ct] = F.kp->in[I_KA][l * 512 + ch]; rkc[ct] = F.kp->in[I_RK][l * 512 + ch];
          muR[ct] = MU[ch]; muK[ct] = MU[512 + ch]; muV[ct] = MU[1024 + ch]; }
      { constexpr int tb = 0;
          f32x16 aw[2], aa[2], ag[2];
#pragma unroll
          for (int ct = 0; ct < 2; ++ct) { aw[ct] = zero16(); aa[ct] = zero16(); ag[ct] = zero16(); }
          const LAS float* xa = xl + (32 * tb + col) * 132 + (lane >> 5); const int chb = 64 * hd + col, kh = lane >> 5;
#define M1_LORA(ACC, WM, XO, NB) do { _Pragma("unroll") for (int hb_ = 0; hb_ < (NB); ++hb_) { float bq_[16][2], xq_[16]; \
              _Pragma("unroll") for (int t_ = 0; t_ < 16; ++t_) { const float* wb_ = (WM) + 1024 * (16 * hb_ + t_); bq_[t_][0] = wb_[wvo]; bq_[t_][1] = wb_[wvo + 32]; xq_[t_] = xa[(XO) + 2 * (16 * hb_ + t_)]; } \
              _Pragma("unroll") for (int t_ = 0; t_ < 16; ++t_) { ACC[0] = __builtin_amdgcn_mfma_f32_32x32x2f32(xq_[t_], bq_[t_][0], ACC[0], 0, 0, 0); ACC[1] = __builtin_amdgcn_mfma_f32_32x32x2f32(xq_[t_], bq_[t_][1], ACC[1], 0, 0, 0); } } } while (0)
          const unsigned wvo = (unsigned)(kh * 512 + chb);
          M1_LORA(aw, W2, 0, 1); M1_LORA(aa, A2, 32, 1); M1_LORA(ag, G2, 64, 2);
#undef M1_LORA
#pragma unroll
          for (int rb = 0; rb < 16; rb += 4) {
              float uc[4][2][3], upv[4][2][3];
#pragma unroll
              for (int q = 0; q < 4; ++q) { const int row = r0 + 32 * tb + rreg(rb + q, lane), rc = row < T ? row : 0, pr = prev_row(rc);
#pragma unroll
                  for (int ct = 0; ct < 2; ++ct) { const float* ur = U + (size_t)rc * NINP + U_RWKV + chb + 32 * ct; const float* up = U + (size_t)(pr >= 0 ? pr : 0) * NINP + U_RWKV + chb + 32 * ct;
                      uc[q][ct][0] = ur[0]; uc[q][ct][1] = ur[512]; uc[q][ct][2] = ur[1024]; upv[q][ct][0] = pr >= 0 ? up[0] : 0.f; upv[q][ct][1] = pr >= 0 ? up[512] : 0.f; upv[q][ct][2] = pr >= 0 ? up[1024] : 0.f; } }
#pragma unroll
              for (int q = 0; q < 4; ++q) { const int reg = rb + q; const int row = r0 + 32 * tb + rreg(reg, lane); const bool ok = row < T;
                  float rr[2], k2[2], vv[2], kk[2], av[2], dec[2]; float nq = 0.f, bq = 0.f;
#pragma unroll
                  for (int ct = 0; ct < 2; ++ct) { float r = uc[q][ct][0], k = uc[q][ct][1], v = uc[q][ct][2];
                      r += (upv[q][ct][0] - r) * muR[ct]; k += (upv[q][ct][1] - k) * muK[ct]; v += (upv[q][ct][2] - v) * muV[ct];
                      float wr = w0c[ct] + aw[ct][reg]; wr = -softplusf_(-wr) - 0.5f; dec[ct] = expf(-expf(wr));
                      av[ct] = sigmoidf_(a0c[ct] + aa[ct][reg]);
                      kk[ct] = k * kkc[ct]; k2[ct] = k * (1.0f + (av[ct] - 1.0f) * kac[ct]); rr[ct] = r; vv[ct] = v;
                      nq += kk[ct] * kk[ct]; bq += r * k2[ct] * rkc[ct]; }
                  nq = sum32(nq, lane); bq = sum32(bq, lane);
                  const float inrm = 1.0f / fmaxf(sqrtf(nq), 1e-12f);
                  if (ok) {
#pragma unroll
                      for (int ct = 0; ct < 2; ++ct) { const size_t o = (size_t)row * 512 + chb + 32 * ct; const float kn = kk[ct] * inrm;
                          RW[o] = rr[ct]; RW[AS + o] = dec[ct]; RW[2 * AS + o] = k2[ct]; RW[3 * AS + o] = vv[ct]; RW[4 * AS + o] = -kn; RW[5 * AS + o] = kn * av[ct]; RW[6 * AS + o] = ag[ct][reg]; }
                      if (col == 0) RBON[row * 8 + hd] = bq; } } }
      } }
}
__device__ __forceinline__ void m1_phase(const Ctx& F, int l, int qi = 1) {
    unsigned* ctr = (unsigned*)(F.ws + O_CTL) + CW_QUEUE + 64 * (4 * l + qi);
    constexpr int NG = (T + 31) / 32, NR = (T + 31) / 32;
    for (;;) { const int u = queue_next(F, ctr); if (u >= NG + NR) break;
        if (u < NG) m1_unit(F, l, 0, 0, u); else { const int r0 = 32 * (u - NG); m1_unit(F, l, r0, r0 + 32 < T ? r0 + 32 : T, -1); } }
}
constexpr int RWC = 64, NRC = (T + RWC - 1) / RWC;
__device__ __forceinline__ void rwkv_chunk_unit(const Ctx& F, int c, int h) {
    LAS float* BH = (LAS float*)F.lds; LAS float* KH = BH + 4160; LAS float* NX = KH + 4160; LAS float* RTT = NX + 4160;
    LAS float* AP = RTT + 4160; LAS float* BZ = AP + 4352; LAS float* Pm = BZ + 4160; LAS float* Qm = Pm + 4160; LAS float* Ge = Qm + 4160; LAS float* segt = Ge + 64;
    const float* RW = (const float*)(F.ws + O_RW); const size_t AS = (size_t)MP * 512; float* MATS = (float*)(F.ws + O_MATS) + (size_t)(c * 8 + h) * 16384;
    int tid = F.tid, w = F.wave; asm volatile("" : "+v"(tid), "+s"(w));
    const int lane = tid & 63, seg = tid >> 6, k = tid & 63;
    __syncthreads();
    { float p[8];
#pragma unroll
      for (int i = 0; i < 8; ++i) { const int s = RWC * c + 8 * seg + i; const float wv = s < T ? RW[AS + (size_t)row_of_seq(s) * 512 + 64 * h + k] : 1.0f; p[i] = wv; }
      float nkv[8], rv[8], bv[8], kkv[8];
#pragma unroll
      for (int i = 0; i < 8; ++i) { const int s = RWC * c + 8 * seg + i; nkv[i] = 0.f; rv[i] = 0.f; bv[i] = 0.f; kkv[i] = 0.f;
          if (s < T) { const size_t o = (size_t)row_of_seq(s) * 512 + 64 * h + k; rv[i] = RW[o]; kkv[i] = RW[2 * AS + o]; nkv[i] = RW[4 * AS + o]; bv[i] = RW[5 * AS + o]; } }
#pragma unroll
      for (int i = 1; i < 8; ++i) p[i] *= p[i - 1];
      segt[seg * 64 + k] = p[7];
      __syncthreads();
      float pre = 1.0f, tot = 1.0f;
#pragma unroll
      for (int q = 0; q < 8; ++q) { const float t = segt[q * 64 + k]; if (q < seg) pre *= t; tot *= t; }
      if (seg == 0) Ge[k] = tot;
#pragma unroll
      for (int i = 0; i < 8; ++i) { const int il = 8 * seg + i, s = RWC * c + il; const float G = pre * p[i], Gm1 = i ? pre * p[i - 1] : pre;
          const float nk = nkv[i], r = rv[i], b = bv[i], kk = kkv[i];
          const float ig = 1.0f / G;
          NX[k * 65 + il] = nk * Gm1; RTT[k * 65 + il] = r * G; BH[il * 65 + k] = b * ig; KH[il * 65 + k] = kk * ig; } }
    __syncthreads();
#define RW_PROD_TILE(PROD, TR, TC) do { const int prod_ = (PROD), tr_ = (TR), tc_ = (TC); f32x16 acc = zero16(); \
        if (tr_ <= tc_) mma32(acc, ((prod_ & 1) ? KH : BH) + 32 * tr_ * 65, 65, 1, ((prod_ < 2) ? NX : RTT) + 32 * tc_, 65, 1, 64, lane); \
        _Pragma("unroll") for (int r = 0; r < 16; ++r) { const int j = 32 * tr_ + rreg(r, lane), i = 32 * tc_ + (lane & 31); const float v = acc[r]; \
            if (prod_ == 0) AP[j * 68 + i] = j < i ? v : 0.f; else if (prod_ == 1) BZ[j * 65 + i] = j < i ? v : 0.f; else if (prod_ == 2) Pm[j * 65 + i] = j <= i ? v : 0.f; else Qm[j * 65 + i] = j <= i ? v : 0.f; } } while (0)
    RW_PROD_TILE(w >> 2, (w >> 1) & 1, w & 1);
    __syncthreads();
    if (w >= 6) { RW_PROD_TILE(3, w - 6, 0); RW_PROD_TILE(3, w - 6, 1); }
    else if (w >= 2) { RW_PROD_TILE(2, (w - 2) >> 1, (w - 2) & 1); }
    else { LAS float* Yr = (w == 0 ? NX : BZ) + lane * 65;
        for (int ib = 0; ib < 4; ++ib) { float a[16];
#pragma unroll
            for (int ii = 0; ii < 16; ++ii) a[ii] = Yr[16 * ib + ii];
#pragma unroll 4
            for (int j = 0; j < 16 * ib; ++j) { const float y = Yr[j]; const LAS float* ap = AP + j * 68 + 16 * ib;
                const f32x4 a0 = *(const LAS f32x4*)ap, a1 = *(const LAS f32x4*)(ap + 4), a2 = *(const LAS f32x4*)(ap + 8), a3 = *(const LAS f32x4*)(ap + 12);
#pragma unroll
                for (int q = 0; q < 4; ++q) { a[q] += y * a0[q]; a[4 + q] += y * a1[q]; a[8 + q] += y * a2[q]; a[12 + q] += y * a3[q]; } }
#pragma unroll
            for (int ii = 1; ii < 16; ++ii)
#pragma unroll
                for (int jj = 0; jj < ii; ++jj) a[ii] += a[jj] * AP[(16 * ib + jj) * 68 + 16 * ib + ii];
#pragma unroll
            for (int ii = 0; ii < 16; ++ii) Yr[16 * ib + ii] = a[ii]; } }
#undef RW_PROD_TILE
    __syncthreads();
    { const int rb = w >> 1;
#pragma unroll
      for (int t = 0; t < 2; ++t) { const int cb = 2 * (w & 1) + t; f32x16 acc = zero16();
          mma32(acc, (rb < 2 ? NX : BZ) + 32 * (rb & 1) * 65, 65, 1, (cb < 2 ? BH : Pm) + 32 * (cb & 1), 65, 1, 64, lane);
          float* dst = MATS + (rb < 2 ? (cb < 2 ? 0 : 8192) : (cb < 2 ? 4096 : 12288));
#pragma unroll
          for (int r = 0; r < 16; ++r) { const int row = 32 * (rb & 1) + rreg(r, lane), col = 32 * (cb & 1) + (lane & 31); float v = acc[r];
              if (rb < 2 && cb < 2) v = (v + (row == col ? 1.0f : 0.0f)) * Ge[col]; else if (rb < 2) v += RTT[row * 65 + col]; else if (cb < 2) v = (v + KH[row * 65 + col]) * Ge[col]; else v += Qm[row * 65 + col];
              dst[row * 64 + col] = v; } } }
}
template <int SV = 0>
__device__ __forceinline__ void rwkv_state_scan(const Ctx& F, int h, int rg) {
    LAS float* Sx = (LAS float*)F.lds; LAS float* tmp = Sx + 1056; LAS float* ring = tmp + 1024;
    const float* RW = (const float*)(F.ws + O_RW); const size_t AS = (size_t)MP * 512; const float* MATS = (const float*)(F.ws + O_MATS); float* SST8 = (float*)(F.ws + (SV ? O_QKV : O_SSTATE));
    const float* ZERO = (const float*)((const bf16*)(F.ws + O_H) + (size_t)8300 * D);
    const int tid = F.tid, lane = F.lane, w = F.wave, fr = lane & 15, kq = lane >> 4, role = w >> 2, cbk = w & 3;
#define RW_DMA(cn) do { const int cc_ = (cn) < NRC ? (cn) : NRC - 1; const float* mp_ = MATS + (size_t)(cc_ * 8 + h) * 16384; LAS float* sl_ = ring + ((cn) % 3) * 9216; \
        _Pragma("unroll") for (int q_ = 0; q_ < 2; ++q_) { const int ch_ = w + 8 * q_; \
            __builtin_amdgcn_global_load_lds((const unsigned*)(mp_ + ch_ * 256 + lane * 4), (LAS unsigned*)(sl_ + ch_ * 256), 16, 0, 0); \
            __builtin_amdgcn_global_load_lds((const unsigned*)(mp_ + 4096 + ch_ * 256 + lane * 4), (LAS unsigned*)(sl_ + 4096 + ch_ * 256), 16, 0, 0); \
            const int j_ = 4 * ch_ + kq, s_ = RWC * cc_ + j_; const float* vp_ = s_ < T ? RW + 3 * AS + (size_t)row_of_seq(s_) * 512 + 64 * h + 16 * rg + fr : ZERO + fr; \
            __builtin_amdgcn_global_load_lds((const unsigned*)vp_, (LAS unsigned*)(sl_ + 8192 + ch_ * 64), 4, 0, 0); } } while (0)
    __syncthreads();
    for (int i = tid; i < 1056; i += NTHR) Sx[i] = 0.f;
    RW_DMA(0); RW_DMA(1);
    asm volatile("s_waitcnt vmcnt(0)" ::: "memory");
    __syncthreads();
    for (int c = 0; c < NRC; ++c) {
        if (SV != 1) RW_DMA(c + 2);
        { const int idx = 2 * tid, v = idx >> 6, kk = idx & 63; const f32x2 sv = (f32x2){Sx[v * 66 + kk], Sx[v * 66 + kk + 1]}; *(f32x2*)(SST8 + ((size_t)(c * 8 + h) * 64 + 16 * rg + v) * 64 + kk) = sv; }
        const LAS float* sl = ring + (c % 3) * 9216;
        float av[16], bv[16]; f32x4 acc = (f32x4){0.f, 0.f, 0.f, 0.f}, acc2 = acc;
        if (role == 0) { const LAS float* mb = sl + 16 * cbk + fr;
#pragma unroll
            for (int t = 0; t < 16; ++t) { av[t] = Sx[fr * 66 + 4 * t + kq]; bv[t] = mb[(4 * t + kq) * 64]; }
        } else { const LAS float* wb = sl + 4096 + 16 * cbk + fr; const LAS float* vt = sl + 8192 + fr;
#pragma unroll
            for (int t = 0; t < 16; ++t) { av[t] = vt[(4 * t + kq) * 16]; bv[t] = wb[(4 * t + kq) * 64]; } }
#pragma unroll
        for (int t = 0; t < (SV == 2 ? 2 : 16); t += 2) { acc = __builtin_amdgcn_mfma_f32_16x16x4f32(av[t], bv[t], acc, 0, 0, 0); acc2 = __builtin_amdgcn_mfma_f32_16x16x4f32(av[t + 1], bv[t + 1], acc2, 0, 0, 0); }
        acc = acc + acc2;
        if (role != 0) *(LAS f32x4*)(tmp + (cbk * 64 + lane) * 4) = acc;
        LBAR();
        if (role == 0) { acc = acc + *(const LAS f32x4*)(tmp + (cbk * 64 + lane) * 4);
#pragma unroll
            for (int r = 0; r < 4; ++r) Sx[(4 * kq + r) * 66 + 16 * cbk + fr] = acc[r]; }
        if (SV != 1) asm volatile("s_waitcnt vmcnt(8)" ::: "memory");
        LBAR();
    }
    asm volatile("s_waitcnt vmcnt(0)" ::: "memory");
#undef RW_DMA
}
__device__ __forceinline__ void rwkv_out_unit(const Ctx& F, int l, int c, int h) {
    LAS float* S_ = (LAS float*)F.lds; LAS float* E_ = S_ + 4160; LAS float* VT_ = E_ + 4096; LAS float* F_ = VT_ + 4096; LAS float* O_ = F_ + 4096;
    const float* RW = (const float*)(F.ws + O_RW); const size_t AS = (size_t)MP * 512; const float* MATS = (const float*)(F.ws + O_MATS) + (size_t)(c * 8 + h) * 16384;
    const float* SST8 = (const float*)(F.ws + O_SSTATE) + (size_t)(c * 8 + h) * 4096; const float* RBON = (const float*)(F.ws + O_RBON); bf16* Y = (bf16*)(F.ws + O_Y);
    int tid = F.tid, w = F.wave; asm volatile("" : "+v"(tid), "+s"(w)); const int lane = tid & 63;
    const f32x4 z4 = (f32x4){0.f, 0.f, 0.f, 0.f};
    f32x4 sv[2], ev[2], fv[2], tv[2];
#pragma unroll
    for (int q = 0; q < 2; ++q) { const int idx = tid + 512 * q, r = idx >> 4, c4 = idx & 15, s = RWC * c + r;
        sv[q] = *(const f32x4*)(SST8 + r * 64 + 4 * c4); ev[q] = *(const f32x4*)(MATS + 8192 + 4 * idx); fv[q] = *(const f32x4*)(MATS + 12288 + 4 * idx);
        tv[q] = s < T ? *(const f32x4*)(RW + 3 * AS + (size_t)row_of_seq(s) * 512 + 64 * h + 4 * c4) : z4; }
    const int li = tid >> 3, part = tid & 7, ls = RWC * c + li, lrow = ls < T ? row_of_seq(ls) : 0; const size_t lo = (size_t)lrow * 512 + 64 * h + 8 * part;
    f32x4 v0 = z4, v1 = z4, g0 = z4, g1 = z4; float bon = 0.f;
    if (ls < T) { v0 = *(const f32x4*)(RW + 3 * AS + lo); v1 = *(const f32x4*)(RW + 3 * AS + lo + 4); g0 = *(const f32x4*)(RW + 6 * AS + lo); g1 = *(const f32x4*)(RW + 6 * AS + lo + 4); bon = RBON[lrow * 8 + h]; }
    __syncthreads();
#pragma unroll
    for (int q = 0; q < 2; ++q) { const int idx = tid + 512 * q, r = idx >> 4, c4 = idx & 15;
        LAS float* d = S_ + r * 65 + 4 * c4; d[0] = sv[q][0]; d[1] = sv[q][1]; d[2] = sv[q][2]; d[3] = sv[q][3];
        *(LAS f32x4*)(E_ + 4 * idx) = ev[q]; *(LAS f32x4*)(F_ + 4 * idx) = fv[q]; *(LAS f32x4*)(VT_ + r * 64 + 4 * c4) = tv[q]; }
    LBAR();
    const int tr = (w >> 1) & 1, tc = w & 1; f32x16 acc = zero16();
    if (w < 4) mma32(acc, S_ + 32 * tr * 65, 65, 1, E_ + 32 * tc, 64, 1, 64, lane);
    else { mma32(acc, VT_ + 32 * tr, 1, 64, F_ + 32 * tc, 64, 1, 64, lane);
#pragma unroll
        for (int r = 0; r < 16; ++r) O_[(32 * tr + rreg(r, lane)) * 65 + 32 * tc + (lane & 31)] = acc[r]; }
    LBAR();
    if (w < 4) {
#pragma unroll
        for (int r = 0; r < 16; ++r) O_[(32 * tr + rreg(r, lane)) * 65 + 32 * tc + (lane & 31)] += acc[r]; }
    LBAR();
    { float x[8]; float sm = 0.f;
#pragma unroll
      for (int q = 0; q < 8; ++q) { x[q] = O_[(8 * part + q) * 65 + li]; sm += x[q]; }
      sm = sum8(sm);
      const float mu = sm * (1.0f / 64.0f); float vq = 0.f;
#pragma unroll
      for (int q = 0; q < 8; ++q) { const float d = x[q] - mu; vq += d * d; }
      vq = sum8(vq);
      const float rstd = 1.0f / sqrtf(vq * (1.0f / 64.0f) + 64e-5f);
      if (ls < T) { const float* lng = F.kp->in[I_LN] + l * 512 + 64 * h + 8 * part;
          float ov[8];
#pragma unroll
          for (int q = 0; q < 4; ++q) { ov[q] = ((x[q] - mu) * rstd * lng[q] + bon * v0[q]) * g0[q]; ov[4 + q] = ((x[4 + q] - mu) * rstd * lng[4 + q] + bon * v1[q]) * g1[q]; }
          v4u wv; wv.x = cvtpk(ov[0], ov[1]); wv.y = cvtpk(ov[2], ov[3]); wv.z = cvtpk(ov[4], ov[5]); wv.w = cvtpk(ov[6], ov[7]);
          *(v4u*)(Y + (size_t)lrow * D + 1536 + 64 * h + 8 * part) = wv; } }
}
__device__ __forceinline__ void ssd_states_unit(const Ctx& F, int c, int h) {
    LAS float* Bm = (LAS float*)F.lds; LAS float* XD = Bm + 16384; LAS float* csl = XD + 8192; LAS float* lal = csl + 128; LAS float* dtl = lal + 128;
    const float* XBC = (const float*)(F.ws + O_XBC); const float* DT = (const float*)(F.ws + O_DT); const float* LA = (const float*)(F.ws + O_LA);
    float* SST = (float*)(F.ws + O_SST); float* SDEC = (float*)(F.ws + O_SDEC);
    const int tid = F.tid, lane = F.lane, w = F.wave, g = h >> 2;
    __syncthreads();
    if (tid < 128) { const int row = crow(c, tid); lal[tid] = row >= 0 ? LA[row * 8 + h] : 0.f; dtl[tid] = row >= 0 ? DT[row * 8 + h] : 0.f; }
    __syncthreads();
    if (tid < 64) { const float e0 = lal[2 * tid], e1 = lal[2 * tid + 1]; float s = e0 + e1;
#pragma unroll
        for (int o = 1; o < 64; o <<= 1) { const float t = __shfl_up(s, o); if (tid >= o) s += t; }
        csl[2 * tid + 1] = s; csl[2 * tid] = s - e1; }
    __syncthreads();
    const float cs_end = csl[127];
#pragma unroll
    for (int k = 0; k < 8; ++k) { const int idx = tid + 512 * k, j = idx >> 5, c4 = idx & 31, row = crow(c, j);
        const f32x4 v = row >= 0 ? *(const f32x4*)(XBC + (size_t)row * 1024 + 512 + 128 * g + 4 * c4) : (f32x4){0.f, 0.f, 0.f, 0.f};
        *(LAS f32x4*)(Bm + j * 128 + 4 * c4) = v; }
#pragma unroll
    for (int k = 0; k < 4; ++k) { const int idx = tid + 512 * k, j = idx >> 4, c4 = idx & 15, row = crow(c, j);
        f32x4 v = row >= 0 ? *(const f32x4*)(XBC + (size_t)row * 1024 + 64 * h + 4 * c4) : (f32x4){0.f, 0.f, 0.f, 0.f};
        v = v * (dtl[j] * expf(cs_end - csl[j]));
        *(LAS f32x4*)(XD + j * 64 + 4 * c4) = v; }
    __syncthreads();
    const int tr = w >> 2, tc = w & 3;
    f32x16 acc = zero16();
    mma32(acc, XD + 32 * tr, 1, 64, Bm + 32 * tc, 128, 1, 128, lane);
    float* dst = SST + ((size_t)(c * 8 + h) * 64 + 32 * tr) * 128 + 32 * tc + (lane & 31);
#pragma unroll
    for (int r = 0; r < 16; ++r) dst[(size_t)rreg(r, lane) * 128] = acc[r];
    if (tid == 0) SDEC[(c * 8 + h) * 32] = expf(cs_end);
}
__device__ __forceinline__ float ret_logg(int h) { return logf(1.0f - exp2f(-5.0f - (float)h)); }
__device__ __forceinline__ void ret_states_unit(const Ctx& F, int c, int h) {
    LAS float* V = (LAS float*)F.lds; LAS float* KD = V + 16384;
    const float* U = (const float*)(F.ws + O_U); const float* RQK = (const float*)(F.ws + O_RQK); float* RST = (float*)(F.ws + O_RST);
    const int tid = F.tid, lane = F.lane, w = F.wave; const float lg = ret_logg(h);
    __syncthreads();
#pragma unroll
    for (int k = 0; k < 8; ++k) { const int idx = tid + 512 * k, j = idx >> 5, c4 = idx & 31, row = crow(c, j);
        const f32x4 v = row >= 0 ? *(const f32x4*)(U + (size_t)row * NINP + U_RET + 512 + 128 * h + 4 * c4) : (f32x4){0.f, 0.f, 0.f, 0.f};
        *(LAS f32x4*)(V + j * 128 + 4 * c4) = v; }
#pragma unroll
    for (int k = 0; k < 4; ++k) { const int idx = tid + 512 * k, j = idx >> 4, c4 = idx & 15, row = crow(c, j);
        f32x4 v = row >= 0 ? *(const f32x4*)(RQK + (size_t)row * 512 + 256 + 64 * h + 4 * c4) : (f32x4){0.f, 0.f, 0.f, 0.f};
        v = v * expf((float)(127 - j) * lg);
        *(LAS f32x4*)(KD + j * 64 + 4 * c4) = v; }
    __syncthreads();
    const int tr = w >> 1, tc = w & 1;
    f32x16 acc = zero16();
    mma32(acc, V + 32 * tr, 1, 128, KD + 32 * tc, 64, 1, 128, lane);
    float* dst = RST + ((size_t)(c * 4 + h) * 128 + 32 * tr) * 64 + 32 * tc + (lane & 31);
#pragma unroll
    for (int r = 0; r < 16; ++r) dst[(size_t)rreg(r, lane) * 64] = acc[r];
}

__device__ __forceinline__ void scan_job(float* base, size_t cstride, const float* dec, int decstride, float constdec) {
    float s = 0.f; float t[13], d[13];
#pragma unroll
    for (int i = 0; i < 13; ++i) { t[i] = base[(size_t)i * cstride]; d[i] = dec ? dec[i * decstride] : constdec; }
#pragma unroll
    for (int c0 = 0; c0 < NCH; c0 += 13) { float tn[13], dn[13];
        if (c0 + 13 < NCH) {
#pragma unroll
            for (int i = 0; i < 13; ++i) { tn[i] = base[(size_t)(c0 + 13 + i) * cstride]; dn[i] = dec ? dec[(c0 + 13 + i) * decstride] : constdec; } }
#pragma unroll
        for (int i = 0; i < 13; ++i) { base[(size_t)(c0 + i) * cstride] = s; s = d[i] * s + t[i]; }
#pragma unroll
        for (int i = 0; i < 13; ++i) { t[i] = tn[i]; d[i] = dn[i]; } }
}
__device__ __forceinline__ void rwkv_scan(const Ctx& F, int hb) {
    LAS float* st = (LAS float*)F.lds;
    float* RW = (float*)(F.ws + O_RW); const size_t AS = (size_t)MP * 512; float* OUT = RW + 7 * AS;
    const int tid = F.tid, lane = F.lane, rl = lane >> 3, ks = lane & 7, myrow = 8 * F.wave + rl;
    float S[8];
#pragma unroll
    for (int j = 0; j < 8; ++j) S[j] = 0.f;
    for (int s0 = 0; s0 < T; s0 += 32) {
        __syncthreads();
#pragma unroll
        for (int j = 0; j < 6; ++j) { const int idx = tid + 512 * j, stp = idx / 96, rem = idx % 96, arr = rem >> 4, c4 = rem & 15, s = s0 + stp;
            if (s < T) { const int row = row_of_seq(s); const int asel = arr == 0 ? 0 : (arr == 1 ? 1 : (arr == 2 ? 2 : (arr == 3 ? 4 : (arr == 4 ? 5 : 3))));
                *(LAS f32x4*)(st + stp * 384 + arr * 64 + 4 * c4) = *(const f32x4*)(RW + asel * AS + (size_t)row * 512 + 64 * hb + 4 * c4); } }
        __syncthreads();
        const int nst = (T - s0) < 32 ? (T - s0) : 32;
        for (int stp = 0; stp < nst; ++stp) { const LAS float* b = st + stp * 384 + 8 * ks;
            const f32x4 r0 = *(const LAS f32x4*)(b), r1 = *(const LAS f32x4*)(b + 4), w0 = *(const LAS f32x4*)(b + 64), w1 = *(const LAS f32x4*)(b + 68), k0 = *(const LAS f32x4*)(b + 128), k1 = *(const LAS f32x4*)(b + 132),
                        n0 = *(const LAS f32x4*)(b + 192), n1 = *(const LAS f32x4*)(b + 196), b0 = *(const LAS f32x4*)(b + 256), b1 = *(const LAS f32x4*)(b + 260);
            const float vv = st[stp * 384 + 320 + myrow];
            float sa = (S[0] * n0[0] + S[1] * n0[1]) + (S[2] * n0[2] + S[3] * n0[3]) + (S[4] * n1[0] + S[5] * n1[1]) + (S[6] * n1[2] + S[7] * n1[3]);
            sa += __shfl_xor(sa, 1); sa += __shfl_xor(sa, 2); sa += __shfl_xor(sa, 4);
            float o = 0.f;
#pragma unroll
            for (int j = 0; j < 4; ++j) { S[j] = S[j] * w0[j] + sa * b0[j] + vv * k0[j]; o += S[j] * r0[j]; S[4 + j] = S[4 + j] * w1[j] + sa * b1[j] + vv * k1[j]; o += S[4 + j] * r1[j]; }
            o += __shfl_xor(o, 1); o += __shfl_xor(o, 2); o += __shfl_xor(o, 4);
            if (ks == 0) OUT[(size_t)row_of_seq(s0 + stp) * 512 + 64 * hb + myrow] = o; }
    }
}
__device__ __forceinline__ void mla_prep2_unit(const Ctx& F, int l, int un) {
    const float* QKVb = (const float*)(F.ws + O_QKV); const float* U = (const float*)(F.ws + O_U);
    bf16* Q = (bf16*)(F.ws + O_Q); bf16* K = (bf16*)(F.ws + O_K); bf16* VT = (bf16*)(F.ws + O_VT);
    LAS bf16* Vl = (LAS bf16*)F.lds;
    const int lane = F.lane, tid = F.tid;
    const float* gq = F.kp->in[I_QKNQ] + l * 192; const float* gk = F.kp->in[I_QKNK] + l * 192;
    const float gq0 = gq[lane], gq1 = gq[64 + lane], gq2 = gq[128 + lane], gk0 = gk[lane], gk1 = gk[64 + lane], gk2 = gk[128 + lane];
    const float qs = 0.07216878364870322f * 1.4426950408889634f;
    __syncthreads();
#pragma unroll 1
    for (int ib = 0; ib < 8; ib += 4) {
        float xq[4][12], xk[4][8], xv[4][8], kpe[4]; f32x2 cs[4];
#pragma unroll
        for (int p = 0; p < 4; ++p) { const int s = 64 * un + 8 * F.wave + ib + p; const int row = s < T ? row_of_seq(s) : 0; const float* qk = QKVb + (size_t)row * MLAN;
            cs[p] = ((const f32x2*)(F.ws + O_ROPE))[row * 32 + (lane & 31)]; kpe[p] = U[(size_t)row * NINP + 512 + lane];
#pragma unroll
            for (int h = 0; h < 4; ++h) { xq[p][3 * h] = qk[192 * h + lane]; xq[p][3 * h + 1] = qk[192 * h + 64 + lane]; xq[p][3 * h + 2] = qk[192 * h + 128 + lane];
                xk[p][2 * h] = qk[768 + 256 * h + lane]; xk[p][2 * h + 1] = qk[768 + 256 * h + 64 + lane]; xv[p][2 * h] = qk[768 + 256 * h + 128 + lane]; xv[p][2 * h + 1] = qk[768 + 256 * h + 192 + lane]; } }
#pragma unroll
        for (int p = 0; p < 4; ++p) { const int sl = 8 * F.wave + ib + p, s = 64 * un + sl; const bool ok = s < T;
#pragma unroll
            for (int h = 0; h < 4; ++h) {
                { float x0 = xq[p][3 * h], x1 = xq[p][3 * h + 1], x2 = xq[p][3 * h + 2];
                  const float rs = 1.0f / sqrtf(wave_sum(x0 * x0 + x1 * x1 + x2 * x2) * (1.0f / 192.0f) + EPS);
                  x0 *= rs * gq0; x1 *= rs * gq1; x2 *= rs * gq2;
                  const float ot = xor32f(x2, lane); const float rr = lane < 32 ? x2 * cs[p].x - ot * cs[p].y : ot * cs[p].y + x2 * cs[p].x;
                  bf16* qd = Q + ((size_t)s * 4 + h) * 192; qd[lane] = (bf16)f2bf(x0 * qs); qd[64 + lane] = (bf16)f2bf(x1 * qs); qd[128 + lane] = (bf16)f2bf(rr * qs); }
                { float x0 = xk[p][2 * h], x1 = xk[p][2 * h + 1], x2 = kpe[p];
                  const float rs = 1.0f / sqrtf(wave_sum(x0 * x0 + x1 * x1 + x2 * x2) * (1.0f / 192.0f) + EPS);
                  x0 *= rs * gk0; x1 *= rs * gk1; x2 *= rs * gk2;
                  const float ot = xor32f(x2, lane); const float rr = lane < 32 ? x2 * cs[p].x - ot * cs[p].y : ot * cs[p].y + x2 * cs[p].x;
                  bf16* kd = K + ((size_t)s * 4 + h) * 192; kd[lane] = (bf16)f2bf(x0); kd[64 + lane] = (bf16)f2bf(x1); kd[128 + lane] = (bf16)f2bf(rr); }
                Vl[(h * 128 + lane) * 66 + sl] = ok ? (bf16)f2bf(xv[p][2 * h]) : (bf16)0; Vl[(h * 128 + 64 + lane) * 66 + sl] = ok ? (bf16)f2bf(xv[p][2 * h + 1]) : (bf16)0; } }
    }
    __syncthreads();
#pragma unroll
    for (int k = 0; k < 8; ++k) { const int idx = tid + 512 * k, r = idx >> 3, j = idx & 7; const LAS unsigned* src = (const LAS unsigned*)(Vl + r * 66 + 8 * j);
        v4u w; w.x = src[0]; w.y = src[1]; w.z = src[2]; w.w = src[3];
        *(v4u*)(VT + (size_t)r * TSEQ + 64 * un + 8 * j) = w; }
}
__device__ __forceinline__ void m3_phase(const Ctx& F, int l) {
    const int b2 = F.bid, NB = F.G;
    for (int job = b2; job < 192; job += NB) {
        if (job < 128) { if (!EN_SSD) continue; const int e = job * 512 + F.tid, h = e >> 13, rest = e & 8191; scan_job((float*)(F.ws + O_SST) + (size_t)h * 8192 + rest, (size_t)8 * 8192, (const float*)(F.ws + O_SDEC) + h * 32, 8 * 32, 0.f); }
        else { if (!EN_RET) continue; const int e = (job - 128) * 512 + F.tid, h = e >> 13, rest = e & 8191; scan_job((float*)(F.ws + O_RST) + (size_t)h * 8192 + rest, (size_t)4 * 8192, nullptr, 0, expf(128.0f * ret_logg(h))); }
    }
    if (EN_MLA) for (int un = NB - 1 - b2; un < (T + 63) / 64; un += NB) mla_prep2_unit(F, l, un);
}
template <int VAR = 0>
__device__ __forceinline__ void attn_unit(const Ctx& F, int hh, int qb, size_t yoff = O_Y) {
    LAS bf16* L0 = (LAS bf16*)F.lds;
    const bf16* Q = (const bf16*)(F.ws + O_Q); const bf16* K = (const bf16*)(F.ws + O_K); const bf16* VT = (const bf16*)(F.ws + O_VT); bf16* Y = (bf16*)(F.ws + yoff);
    int tid = F.tid, w = F.wave; asm volatile("" : "+v"(tid), "+s"(w));
    const int lane = tid & 63, h = lane >> 5, c = lane & 31, half = w >> 2, wq = w & 3;
    const int sq = 128 * qb + 32 * wq + c;
    bf16x8 qf[12];
#pragma unroll
    for (int ks = 0; ks < 12; ++ks) qf[ks] = *(const bf16x8*)(Q + ((size_t)sq * 4 + hh) * 192 + 16 * ks + 8 * h);
    f32x16 o[4];
#pragma unroll
    for (int t = 0; t < 4; ++t) o[t] = zero16();
    float m = -1e30f, lsum = 0.f;
    const int nst = qb + 1;
    v4u kr[6], vr[4];
    const unsigned kgo = (unsigned)(((tid >> 3) * 4 + hh) * 192 + 8 * (tid & 7)), klo = (unsigned)((tid >> 3) * 200 + 8 * (tid & 7));
    const unsigned vgo = (unsigned)((hh * 128 + (tid >> 2)) * TSEQ + 8 * (tid & 3)), vlo = (unsigned)(12800 + (tid >> 2) * 72 + 8 * (tid & 3));
#define AT_LOADK(st_) do { const bf16* kb_ = K + (size_t)(128 * (st_)) * 768; _Pragma("unroll") for (int j = 0; j < 6; ++j) kr[j] = *(const v4u*)(kb_ + kgo + (j / 3) * 49152 + 64 * (j % 3)); } while (0)
#define AT_LOADV(st_) do { const bf16* vb_ = VT + 128 * (st_); _Pragma("unroll") for (int j = 0; j < 4; ++j) vr[j] = *(const v4u*)(vb_ + vgo + (j >> 1) * 64 + 32 * (j & 1)); } while (0)
#define AT_STOREK() do { _Pragma("unroll") for (int j = 0; j < 6; ++j) *(LAS v4u*)(L0 + klo + (j / 3) * 22016 + 64 * (j % 3)) = kr[j]; } while (0)
#define AT_STOREV() do { _Pragma("unroll") for (int j = 0; j < 4; ++j) *(LAS v4u*)(L0 + vlo + (j >> 1) * 22016 + 32 * (j & 1)) = vr[j]; } while (0)
    __syncthreads();
    AT_LOADK(0); AT_LOADV(0); AT_STOREK(); AT_STOREV(); if (nst > 1) AT_LOADK(1);
    LBAR();
    const LAS bf16* Ks = L0 + half * 22016; const LAS bf16* Vs = Ks + 12800;
    for (int st = 0; st < nst; ++st) {
        const int kt = 2 * st + half;
        f32x16 sa[2];
#pragma unroll
        for (int t2 = 0; t2 < 2; ++t2) { sa[t2] = zero16();
#pragma unroll
            for (int ks = 0; ks < 12; ++ks) { const bf16x8 a = *(const LAS bf16x8*)(Ks + (32 * t2 + c) * 200 + 16 * ks + 8 * h); sa[t2] = __builtin_amdgcn_mfma_f32_32x32x16_bf16(a, qf[ks], sa[t2], 0, 0, 0); } }
        if (st == nst - 1) {
#pragma unroll
            for (int t2 = 0; t2 < 2; ++t2)
#pragma unroll
                for (int r = 0; r < 16; ++r) { const int key = 64 * kt + 32 * t2 + (r & 3) + 8 * (r >> 2) + 4 * h; if (key > sq) sa[t2][r] = -1e30f; } }
        float mx = -1e30f;
#pragma unroll
        for (int t2 = 0; t2 < 2; ++t2)
#pragma unroll
            for (int r = 0; r < 16; ++r) mx = fmaxf(mx, sa[t2][r]);
        mx = fmaxf(mx, __shfl_xor(mx, 32));
        if (__builtin_amdgcn_ballot_w64(mx > m) != 0ull) { const float mn = fmaxf(m, mx), alpha = __builtin_amdgcn_exp2f(m - mn); m = mn; lsum *= alpha;
#pragma unroll
            for (int t = 0; t < 4; ++t) o[t] = o[t] * alpha; }
        float rs = 0.f;
#pragma unroll
        for (int t2 = 0; t2 < 2; ++t2)
#pragma unroll
            for (int r = 0; r < 16; ++r) { const float pv = __builtin_amdgcn_exp2f(sa[t2][r] - m); sa[t2][r] = pv; rs += pv; }
        rs += __shfl_xor(rs, 32);
        lsum += rs;
        LBAR();
        if (st + 1 < nst) { AT_STOREK(); AT_LOADV(st + 1); }
#pragma unroll
        for (int t2 = 0; t2 < 2; ++t2)
#pragma unroll
            for (int s = 0; s < 2; ++s) { v4u pw; pw.x = cvtpk(sa[t2][8 * s], sa[t2][8 * s + 1]); pw.y = cvtpk(sa[t2][8 * s + 2], sa[t2][8 * s + 3]); pw.z = cvtpk(sa[t2][8 * s + 4], sa[t2][8 * s + 5]); pw.w = cvtpk(sa[t2][8 * s + 6], sa[t2][8 * s + 7]);
                const bf16x8 pf = __builtin_bit_cast(bf16x8, pw);
#pragma unroll
                for (int t = 0; t < 4; ++t) { const LAS bf16* vp = Vs + (32 * t + c) * 72 + 32 * t2 + 16 * s + 4 * h; const v2u lo = *(const LAS v2u*)vp, hi = *(const LAS v2u*)(vp + 8);
                    v4u vw; vw.x = lo.x; vw.y = lo.y; vw.z = hi.x; vw.w = hi.y;
                    o[t] = __builtin_amdgcn_mfma_f32_32x32x16_bf16(__builtin_bit_cast(bf16x8, vw), pf, o[t], 0, 0, 0); } }
        LBAR();
        if (st + 1 < nst) { AT_STOREV(); if (st + 2 < nst) AT_LOADK(st + 2); }
    }
#undef AT_LOADK
#undef AT_LOADV
#undef AT_STOREK
#undef AT_STOREV
    LAS float* MB = (LAS float*)F.lds + (wq * 64 + lane) * 67;
    if (half == 1) { MB[0] = m; MB[1] = lsum;
#pragma unroll
        for (int t = 0; t < 4; ++t)
#pragma unroll
            for (int r = 0; r < 16; ++r) MB[2 + 16 * t + r] = o[t][r]; }
    LBAR();
    if (half == 0) { const float m2 = MB[0], l2 = MB[1], mn = fmaxf(m, m2), a1 = __builtin_amdgcn_exp2f(m - mn), a2 = __builtin_amdgcn_exp2f(m2 - mn);
        const float inv = 1.0f / (lsum * a1 + l2 * a2);
        if (sq < T) { bf16* yr = Y + (size_t)row_of_seq(sq) * D + 128 * hh + 4 * h;
#pragma unroll
            for (int t = 0; t < 4; ++t)
#pragma unroll
                for (int rq = 0; rq < 4; ++rq) { float ov[4];
#pragma unroll
                    for (int i = 0; i < 4; ++i) ov[i] = (o[t][4 * rq + i] * a1 + MB[2 + 16 * t + 4 * rq + i] * a2) * inv;
                    v2u wv; wv.x = cvtpk(ov[0], ov[1]); wv.y = cvtpk(ov[2], ov[3]); *(v2u*)(yr + 32 * t + 8 * rq) = wv; } } }
}
__device__ __forceinline__ void ssd_out_unit(const Ctx& F, int l, int c, int h, int ih) {
    LAS float* CS_ = (LAS float*)F.lds; LAS float* BS_ = CS_ + 4352; LAS float* PS_ = BS_ + 8704; LAS float* SC_ = PS_ + 4352; LAS float* XD_ = SC_ + 8448; LAS float* csl = XD_ + 8448; LAS float* lal = csl + 128; LAS float* dtl = lal + 128;
    LAS float* Y_ = CS_;
    const float* XBC = (const float*)(F.ws + O_XBC); const float* DT = (const float*)(F.ws + O_DT); const float* LA = (const float*)(F.ws + O_LA); const float* U = (const float*)(F.ws + O_U);
    const float* SST = (const float*)(F.ws + O_SST); float* YZ = (float*)(F.ws + O_YZ);
    int tid = F.tid, w = F.wave; asm volatile("" : "+v"(tid), "+s"(w));
    const int lane = tid & 63, g = h >> 2;
    const f32x4 z4 = (f32x4){0.f, 0.f, 0.f, 0.f};
    float lav = 0.f, dtv = 0.f;
    if (tid < 128) { const int row = crow(c, tid); if (row >= 0) { lav = LA[row * 8 + h]; dtv = DT[row * 8 + h]; } }
    f32x4 xdv[4], csv[2][2], bsv[2][4], psv[2][2]; float xsv[8], zv[8];
#pragma unroll
    for (int k = 0; k < 4; ++k) { const int idx = tid + 512 * k, j = idx >> 4, c4 = idx & 15, row = crow(c, j); xdv[k] = row >= 0 ? *(const f32x4*)(XBC + (size_t)row * 1024 + 64 * h + 4 * c4) : z4; }
#pragma unroll
    for (int nh = 0; nh < 2; ++nh) {
#pragma unroll
        for (int k = 0; k < 2; ++k) { const int idx = tid + 512 * k, i = idx >> 4, c4 = idx & 15, row = crow(c, 64 * ih + i); csv[nh][k] = row >= 0 ? *(const f32x4*)(XBC + (size_t)row * 1024 + 768 + 128 * g + 64 * nh + 4 * c4) : z4; }
#pragma unroll
        for (int k = 0; k < 4; ++k) { const int idx = tid + 512 * k, j = idx >> 4, c4 = idx & 15, row = crow(c, j); bsv[nh][k] = row >= 0 ? *(const f32x4*)(XBC + (size_t)row * 1024 + 512 + 128 * g + 64 * nh + 4 * c4) : z4; }
#pragma unroll
        for (int k = 0; k < 2; ++k) { const int idx = tid + 512 * k, pp = idx >> 4, c4 = idx & 15; psv[nh][k] = *(const f32x4*)(SST + ((size_t)(c * 8 + h) * 64 + pp) * 128 + 64 * nh + 4 * c4); } }
#pragma unroll
    for (int k = 0; k < 8; ++k) { const int idx = tid + 512 * k, i = idx >> 6, pp = idx & 63, row = crow(c, 64 * ih + i); xsv[k] = 0.f; zv[k] = 0.f;
        if (row >= 0) { xsv[k] = XBC[(size_t)row * 1024 + 64 * h + pp]; zv[k] = U[(size_t)row * NINP + U_SSD + 64 * h + pp]; } }
    __syncthreads();
    if (tid < 128) { lal[tid] = lav; dtl[tid] = dtv; }
    LBAR();
    if (tid < 64) { const float e0 = lal[2 * tid], e1 = lal[2 * tid + 1]; float s = e0 + e1;
#pragma unroll
        for (int o = 1; o < 64; o <<= 1) { const float t = __shfl_up(s, o); if (tid >= o) s += t; }
        csl[2 * tid + 1] = s; csl[2 * tid] = s - e1; }
#pragma unroll
    for (int k = 0; k < 4; ++k) { const int idx = tid + 512 * k, j = idx >> 4, c4 = idx & 15; const f32x4 v = xdv[k] * dtl[j]; LAS float* d = XD_ + (4 * c4) * 132 + j; d[0] = v[0]; d[132] = v[1]; d[264] = v[2]; d[396] = v[3]; }
    f32x16 acc_s = zero16(), acc_y = zero16();
    const int tr = w >> 2, tc = w & 3, tr2 = (w >> 1) & 1, tc2 = w & 1;
#pragma unroll
    for (int nh = 0; nh < 2; ++nh) {
        if (nh) LBAR();
#pragma unroll
        for (int k = 0; k < 2; ++k) { const int idx = tid + 512 * k, i = idx >> 4, c4 = idx & 15; const f32x4 v = csv[nh][k]; *(LAS f32x4*)(CS_ + i * 68 + 4 * c4) = v; }
#pragma unroll
        for (int k = 0; k < 4; ++k) { const int idx = tid + 512 * k, j = idx >> 4, c4 = idx & 15; const f32x4 v = bsv[nh][k]; *(LAS f32x4*)(BS_ + j * 68 + 4 * c4) = v; }
#pragma unroll
        for (int k = 0; k < 2; ++k) { const int idx = tid + 512 * k, pp = idx >> 4, c4 = idx & 15; const f32x4 v = psv[nh][k]; *(LAS f32x4*)(PS_ + pp * 68 + 4 * c4) = v; }
        LBAR();
        mma32bf(acc_s, CS_ + 32 * tr * 68, 68, BS_ + 32 * tc * 68, 68, 64, lane);
        if (w < 4) mma32bf(acc_y, CS_ + 32 * tr2 * 68, 68, PS_ + 32 * tc2 * 68, 68, 64, lane);
    }
    if (w < 4) {
#pragma unroll
        for (int r = 0; r < 16; ++r) acc_y[r] *= expf(csl[64 * ih + 32 * tr2 + rreg(r, lane)]); }
#pragma unroll
    for (int r = 0; r < 16; ++r) { const int i = 32 * tr + rreg(r, lane), j = 32 * tc + (lane & 31), il = 64 * ih + i;
        SC_[i * 132 + j] = j <= il ? acc_s[r] * expf(csl[il] - csl[j]) : 0.f; }
    LBAR();
    if (w < 4) { mma32bf(acc_y, SC_ + 32 * tr2 * 132, 132, XD_ + 32 * tc2 * 132, 132, 128, lane);
#pragma unroll
        for (int r = 0; r < 16; ++r) Y_[(32 * tr2 + rreg(r, lane)) * 68 + 32 * tc2 + (lane & 31)] = acc_y[r]; }
    LBAR();
    const float Dh = F.kp->in[I_SSDD][l * 8 + h];
#pragma unroll
    for (int k = 0; k < 8; ++k) { const int idx = tid + 512 * k, i = idx >> 6, pp = idx & 63, row = crow(c, 64 * ih + i);
        if (row >= 0) YZ[(size_t)row * 512 + 64 * h + pp] = (Y_[i * 68 + pp] + Dh * xsv[k]) * siluf_(zv[k]); }
}
__device__ __forceinline__ void ret_out_unit(const Ctx& F, int l, int c, int h, int ih) {
    LAS float* Q_ = (LAS float*)F.lds; LAS float* KM_ = Q_ + 4352; LAS float* SC_ = KM_ + 8704; LAS float* VH_ = SC_ + 8448; LAS float* SP_ = KM_; LAS float* Y_ = SC_;
    const float* U = (const float*)(F.ws + O_U); const float* RQK = (const float*)(F.ws + O_RQK); const float* RST = (const float*)(F.ws + O_RST); bf16* Y = (bf16*)(F.ws + O_Y);
    int tid = F.tid, w = F.wave; asm volatile("" : "+v"(tid), "+s"(w));
    const int lane = tid & 63; const float lg = ret_logg(h);
    const f32x4 z4 = (f32x4){0.f, 0.f, 0.f, 0.f};
    f32x4 qv[2], kv[4], spv[4], vv[2][4], gv[4];
#pragma unroll
    for (int k = 0; k < 2; ++k) { const int idx = tid + 512 * k, i = idx >> 4, c4 = idx & 15, row = crow(c, 64 * ih + i); qv[k] = row >= 0 ? *(const f32x4*)(RQK + (size_t)row * 512 + 64 * h + 4 * c4) : z4; }
#pragma unroll
    for (int k = 0; k < 4; ++k) { const int idx = tid + 512 * k, j = idx >> 4, c4 = idx & 15, row = crow(c, j); kv[k] = row >= 0 ? *(const f32x4*)(RQK + (size_t)row * 512 + 256 + 64 * h + 4 * c4) : z4; }
#pragma unroll
    for (int k = 0; k < 4; ++k) { const int idx = tid + 512 * k, vx = idx >> 4, c4 = idx & 15; spv[k] = *(const f32x4*)(RST + ((size_t)(c * 4 + h) * 128 + vx) * 64 + 4 * c4); }
#pragma unroll
    for (int jh = 0; jh < 2; ++jh)
#pragma unroll
        for (int k = 0; k < 4; ++k) { const int idx = tid + 512 * k, j = idx >> 5, c4 = idx & 31, row = crow(c, 64 * jh + j); vv[jh][k] = (jh <= ih && row >= 0) ? *(const f32x4*)(U + (size_t)row * NINP + U_RET + 512 + 128 * h + 4 * c4) : z4; }
    const int li = tid >> 3, part = tid & 7, lrow = crow(c, 64 * ih + li);
#pragma unroll
    for (int k = 0; k < 4; ++k) gv[k] = lrow >= 0 ? *(const f32x4*)(U + (size_t)lrow * NINP + U_RET + 1024 + 128 * h + 16 * part + 4 * k) : z4;
    __syncthreads();
#pragma unroll
    for (int k = 0; k < 2; ++k) { const int idx = tid + 512 * k, i = idx >> 4, c4 = idx & 15; const f32x4 v = qv[k]; *(LAS f32x4*)(Q_ + i * 68 + 4 * c4) = v; }
#pragma unroll
    for (int k = 0; k < 4; ++k) { const int idx = tid + 512 * k, j = idx >> 4, c4 = idx & 15; const f32x4 v = kv[k]; *(LAS f32x4*)(KM_ + j * 68 + 4 * c4) = v; }
    LBAR();
    const int tr = w >> 2, tc = w & 3;
    f32x16 acc_s = zero16();
    mma32bf(acc_s, Q_ + 32 * tr * 68, 68, KM_ + 32 * tc * 68, 68, 64, lane);
    LBAR();
#pragma unroll
    for (int k = 0; k < 4; ++k) { const int idx = tid + 512 * k, vx = idx >> 4, c4 = idx & 15; const f32x4 v = spv[k]; *(LAS f32x4*)(SP_ + vx * 68 + 4 * c4) = v; }
#pragma unroll
    for (int r = 0; r < 16; ++r) { const int i = 32 * tr + rreg(r, lane), j = 32 * tc + (lane & 31), il = 64 * ih + i;
        SC_[i * 132 + j] = j <= il ? acc_s[r] * expf((float)(il - j) * lg) : 0.f; }
#pragma unroll
    for (int k = 0; k < 4; ++k) { const int idx = tid + 512 * k, j = idx >> 5, c4 = idx & 31; const f32x4 v = vv[0][k]; LAS float* d = VH_ + (4 * c4) * 68 + j; d[0] = v[0]; d[68] = v[1]; d[136] = v[2]; d[204] = v[3]; }
    LBAR();
    f32x16 acc_y = zero16();
    mma32bf(acc_y, Q_ + 32 * tr * 68, 68, SP_ + 32 * tc * 68, 68, 64, lane);
#pragma unroll
    for (int r = 0; r < 16; ++r) acc_y[r] *= expf((float)(64 * ih + 32 * tr + rreg(r, lane) + 1) * lg);
    mma32bf(acc_y, SC_ + 32 * tr * 132, 132, VH_ + 32 * tc * 68, 68, 64, lane);
    if (ih) { LBAR();
#pragma unroll
        for (int k = 0; k < 4; ++k) { const int idx = tid + 512 * k, j = idx >> 5, c4 = idx & 31; const f32x4 v = vv[1][k]; LAS float* d = VH_ + (4 * c4) * 68 + j; d[0] = v[0]; d[68] = v[1]; d[136] = v[2]; d[204] = v[3]; }
        LBAR();
        mma32bf(acc_y, SC_ + 32 * tr * 132 + 64, 132, VH_ + 32 * tc * 68, 68, 64, lane); }
    LBAR();
#pragma unroll
    for (int r = 0; r < 16; ++r) Y_[(32 * tr + rreg(r, lane)) * 132 + 32 * tc + (lane & 31)] = acc_y[r];
    LBAR();
    { const LAS float* yr = Y_ + li * 132 + 16 * part;
      float s = 0.f;
#pragma unroll
      for (int k = 0; k < 16; ++k) s += yr[k];
      s = sum8(s);
      const float mu = s * (1.0f / 128.0f); float q = 0.f;
#pragma unroll
      for (int k = 0; k < 16; ++k) { const float d = yr[k] - mu; q += d * d; }
      q = sum8(q);
      const float rstd = 1.0f / sqrtf(q * (1.0f / 128.0f) + EPS);
      if (lrow >= 0) { const float* ng = F.kp->in[I_RETN] + l * 512 + 128 * h + 16 * part; float ov[16];
#pragma unroll
          for (int k = 0; k < 16; ++k) ov[k] = (yr[k] - mu) * rstd * ng[k] * siluf_(gv[k >> 2][k & 3]);
          bf16* yd = Y + (size_t)lrow * D + 1024 + 128 * h + 16 * part;
          v4u w0, w1; w0.x = cvtpk(ov[0], ov[1]); w0.y = cvtpk(ov[2], ov[3]); w0.z = cvtpk(ov[4], ov[5]); w0.w = cvtpk(ov[6], ov[7]); w1.x = cvtpk(ov[8], ov[9]); w1.y = cvtpk(ov[10], ov[11]); w1.z = cvtpk(ov[12], ov[13]); w1.w = cvtpk(ov[14], ov[15]);
          *(v4u*)yd = w0; *(v4u*)(yd + 8) = w1; } }
}
__device__ __forceinline__ void m4_phase(const Ctx& F, int l, int qi = 0, int only = -1) {
    unsigned* ctr = (unsigned*)(F.ws + O_CTL) + CW_QUEUE + 64 * (4 * l + qi);
    constexpr int N_AT = 4 * NCH, N_CV = 128, N_SO = NCH * 16, N_RO = NCH * 8, N_WO = NRC * 8, N_ALL = N_AT + N_CV + N_SO + N_RO + N_WO;
    int u = queue_next(F, ctr);
    while (u < N_AT) { if (only < 0) attn_unit<0>(F, u & 3, (NCH - 1) - (u >> 2)); else if (only == 0) attn_unit<DUP_VAR>(F, u & 3, (NCH - 1) - (u >> 2), O_QKV); u = queue_next(F, ctr); }
    while (u < N_AT + N_CV) { if (l + 1 < DEPTH && only < 0) { __syncthreads(); convert_layer(F, l + 1, (u - N_AT) * NWAVES + F.wave, N_CV * NWAVES); }
        u = queue_next(F, ctr); }
    while (u < N_AT + N_CV + N_SO + N_RO) { int v = u - N_AT - N_CV;
        if (v < N_RO) { const int c = v >> 3, h = (v >> 1) & 3, ih = v & 1; if (!(c == 0 && ih == 0) && (only < 0 || only == 2)) ret_out_unit(F, l, c, h, ih); }
        else { v -= N_RO; const int c = v >> 4, h = (v >> 1) & 7, ih = v & 1; if (!(c == 0 && ih == 0) && (only < 0 || only == 1)) ssd_out_unit(F, l, c, h, ih); }
        u = queue_next(F, ctr); }
    if (u < N_ALL && only < 0) {
        if (F.tid == 0) { unsigned* sflag = (unsigned*)(F.ws + O_CTL) + CW_QUEUE + 64 * (16 + l); const unsigned nscan = F.G >= 64 ? 32u : (unsigned)F.G; unsigned sp = 0;
            while (__hip_atomic_load(sflag, __ATOMIC_RELAXED, __HIP_MEMORY_SCOPE_AGENT) < nscan) { __builtin_amdgcn_s_sleep(8); if (++sp > (1u << 22)) break; }
            __builtin_amdgcn_fence(__ATOMIC_ACQUIRE, "agent"); asm volatile("s_waitcnt vmcnt(0)" ::: "memory"); }
        __syncthreads(); }
    while (u < N_ALL) { const int v = u - (N_AT + N_CV + N_SO + N_RO); if (only < 0 || only == 3) rwkv_out_unit(F, l, v >> 3, v & 7); u = queue_next(F, ctr); }
}
__device__ __forceinline__ void m5_phase(const Ctx& F, int l) {
#ifdef PROBE_DUP
    { const bf16* Y = (const bf16*)(F.ws + O_Y); const bf16* Y2 = (const bf16*)(F.ws + O_YZ); unsigned cnt = 0;
      for (int row = F.bid * NWAVES + F.wave; row < T; row += F.G * NWAVES) for (int j = 0; j < 8; ++j) cnt += Y[(size_t)row * D + 64 * j + F.lane] != Y2[(size_t)row * D + 64 * j + F.lane];
      if (cnt) atomicAdd((unsigned*)(F.ws + O_CTL) + 8, cnt); }
#endif
#ifdef PROBE_COPY_U
    { const float* U = (const float*)(F.ws + O_U); bf16* Y = (bf16*)(F.ws + O_Y);
      for (int row = F.bid * NWAVES + F.wave; row < T; row += F.G * NWAVES)
        for (int j = 0; j < 4; ++j) { const float* ur = U + (size_t)(PROBE_COPY_META ? SEQ + (row & 15) : row) * NINP + PROBE_COPY_U + 512 * j + 8 * F.lane; const f32x4 a = *(const f32x4*)ur, b = *(const f32x4*)(ur + 4);
          v4u w; w.x = pk2(a[0], a[1]); w.y = pk2(a[2], a[3]); w.z = pk2(b[0], b[1]); w.w = pk2(b[2], b[3]); *(v4u*)(Y + (size_t)row * D + 512 * j + 8 * F.lane) = w; } }
#endif
    if (!EN_SSD) return;
    const float* YZ = (const float*)(F.ws + O_YZ); bf16* Y = (bf16*)(F.ws + O_Y); const float* ng = F.kp->in[I_SSDN] + l * 512 + 8 * F.lane;
    for (int row = F.bid * NWAVES + F.wave; row < T; row += F.G * NWAVES) { const float* yr = YZ + (size_t)row * 512 + 8 * F.lane; const f32x4 a = *(const f32x4*)yr, b = *(const f32x4*)(yr + 4);
        const float sq = wave_sum((a[0] * a[0] + a[1] * a[1]) + (a[2] * a[2] + a[3] * a[3]) + (b[0] * b[0] + b[1] * b[1]) + (b[2] * b[2] + b[3] * b[3]));
        const float rs = 1.0f / sqrtf(sq * (1.0f / 512.0f) + EPS); const f32x4 g0 = *(const f32x4*)ng, g1 = *(const f32x4*)(ng + 4);
        v4u w; w.x = pk2(a[0] * rs * g0[0], a[1] * rs * g0[1]); w.y = pk2(a[2] * rs * g0[2], a[3] * rs * g0[3]); w.z = pk2(b[0] * rs * g1[0], b[1] * rs * g1[1]); w.w = pk2(b[2] * rs * g1[2], b[3] * rs * g1[3]);
        *(v4u*)(Y + (size_t)row * D + 512 + 8 * F.lane) = w; }
}
template <int MODE  , int NT>
__device__ __forceinline__ void meta_gemm(const Ctx& F, const bf16* A16, int lda, const bf16* Bt, int ldb, int ntasks, int K, float* Cf, int ldc, const float* ss_in, float* ss_out, bf16* Ob, bf16* HL, float scale) {
    constexpr int NACC = MODE == 1 ? 2 * NT : NT;
    LAS float* red = (LAS float*)F.lds;
    int tid = F.tid, w = F.wave; asm volatile("" : "+v"(tid), "+s"(w));
    const int lane = tid & 63, g = lane >> 4, c = lane & 15, kper = K >> 3;
    for (int task = F.G - 1 - F.bid; task < ntasks; task += F.G) {
        const int n0 = MODE == 1 ? 256 * ((64 * task) >> 7) + ((64 * task) & 127) : 16 * NT * task;
        f32x4 acc[NACC];
#pragma unroll
        for (int q = 0; q < NACC; ++q) acc[q] = (f32x4){0.f, 0.f, 0.f, 0.f};
        const bf16* ap = A16 + (size_t)c * lda + w * kper + 8 * g; const bf16* bp = Bt + (size_t)(n0 + c) * ldb + w * kper + 8 * g;
#pragma unroll 4
        for (int kk = 0; kk < kper; kk += 32) { const bf16x8 a = *(const bf16x8*)(ap + kk);
#pragma unroll
            for (int t = 0; t < NT; ++t) { acc[t] = __builtin_amdgcn_mfma_f32_16x16x32_bf16(*(const bf16x8*)(bp + (size_t)(16 * t) * ldb + kk), a, acc[t], 0, 0, 0);
                if (MODE == 1) acc[NT + t] = __builtin_amdgcn_mfma_f32_16x16x32_bf16(*(const bf16x8*)(bp + (size_t)(128 + 16 * t) * ldb + kk), a, acc[NT + t], 0, 0, 0); } }
        __syncthreads();
#pragma unroll
        for (int q = 0; q < NACC; ++q) *(LAS f32x4*)(red + ((w * NACC + q) * 64 + lane) * 4) = acc[q];
        __syncthreads();
        if (w == 0) { const int row = SEQ + c; float rs = 1.0f;
            if (ss_in) { float s = 0.f;
#pragma unroll
                for (int q = 0; q < 8; ++q) { const f32x4 x = *(const f32x4*)(ss_in + (size_t)row * 32 + 4 * q); s += (x[0] + x[1]) + (x[2] + x[3]); }
                rs = __builtin_amdgcn_rsqf(s * (1.0f / 2048.0f) + EPS); }
            float sq = 0.f;
#pragma unroll
            for (int t = 0; t < NT; ++t) { f32x4 v = (f32x4){0.f, 0.f, 0.f, 0.f}, v2 = v;
#pragma unroll
                for (int ww = 0; ww < 8; ++ww) { v = v + *(const LAS f32x4*)(red + ((ww * NACC + t) * 64 + lane) * 4); if (MODE == 1) v2 = v2 + *(const LAS f32x4*)(red + ((ww * NACC + NT + t) * 64 + lane) * 4); }
                if (MODE == 0) *(f32x4*)(Cf + (size_t)row * ldc + 16 * NT * task + 16 * t + 4 * g) = v * rs;
                if (MODE == 3) { v2u wv; wv.x = pk2(v[0] * rs, v[1] * rs); wv.y = pk2(v[2] * rs, v[3] * rs); *(v2u*)(Ob + (size_t)row * ldc + 16 * NT * task + 16 * t + 4 * g) = wv; }
                if (MODE == 1) { float o[4];
#pragma unroll
                    for (int i = 0; i < 4; ++i) { const float gv = v[i] * rs, uv = v2[i] * rs; o[i] = gv * uv * __builtin_amdgcn_rcpf(1.0f + __expf(-gv)); }
                    v2u wv; wv.x = pk2(o[0], o[1]); wv.y = pk2(o[2], o[3]); *(v2u*)(Ob + (size_t)row * DFF + 64 * task + 16 * t + 4 * g) = wv; }
                if (MODE == 2) { const size_t off = (size_t)row * D + 64 * task + 16 * t + 4 * g; const v2u hi = *(const v2u*)(Ob + off), lo = *(const v2u*)(HL + off);
                    f32x4 h4 = (f32x4){pg8::bflo(hi.x) + pg8::bflo(lo.x), pg8::bfhi(hi.x) + pg8::bfhi(lo.x), pg8::bflo(hi.y) + pg8::bflo(lo.y), pg8::bfhi(hi.y) + pg8::bfhi(lo.y)}; h4 = h4 + v * scale;
                    v2u wv; wv.x = cvtpk(h4[0], h4[1]); wv.y = cvtpk(h4[2], h4[3]); v2u lv; lv.x = cvtpk(h4[0] - pg8::bflo(wv.x), h4[1] - pg8::bfhi(wv.x)); lv.y = cvtpk(h4[2] - pg8::bflo(wv.y), h4[3] - pg8::bfhi(wv.y));
                    *(v2u*)(Ob + off) = wv; *(v2u*)(HL + off) = lv; sq += (h4[0] * h4[0] + h4[1] * h4[1]) + (h4[2] * h4[2] + h4[3] * h4[3]); } }
            if (MODE == 2 && ss_out) { sq += __shfl_xor(sq, 16); sq += __shfl_xor(sq, 32); if (g == 0) __hip_atomic_fetch_add(ss_out + (size_t)row * 32 + task, sq, __ATOMIC_RELAXED, __HIP_MEMORY_SCOPE_AGENT); } }
    }    __syncthreads();
}
__device__ __forceinline__ void gemm_swiglu(const Ctx& F, int hl, int ssidx) {
    const bf16* A = (const bf16*)(F.ws + O_HB); const bf16* Bt = (const bf16*)(F.ws + O_WGU) + (size_t)hl * 11264 * 2048; const float* ss = (const float*)(F.ws + O_SS) + (size_t)ssidx * MP * 32;
    { pg8::Gemm g{A, Bt, SEQ, 11264, 2048, 2048, 2048, F.wave}; pg8::StaticOrder S; S.init(SEQ, 11264, F.G, F.bid);
      const int full = (S.nwg / F.G) * F.G, rem = S.nwg - full;
      const bool split = false && (2 * rem == F.G);
      if (split) S.lim = full;
      pg8::EpiSwiGLU E{(bf16*)(F.ws + O_ACT), DFF, ss, 1.0f / 2048.0f, EPS, 2};
      pg8::gemm_phase<pg8::EpiSwiGLU, pg8::StaticOrder, true, true, false>(F.lds, g, S, E);
      if (split) { pg8::StaticOrder S2; S2.init(SEQ, 11264, F.G, F.bid); S2.hmbase = full;
          pg8::EpiSwiGLU E2{(bf16*)(F.ws + O_ACT), DFF, ss, 1.0f / 2048.0f, EPS, 1};
          pg8::gemm_phase<pg8::EpiSwiGLU, pg8::StaticOrder, true, true, true>(F.lds, g, S2, E2); } }
    meta_gemm<1, 4>(F, A + (size_t)SEQ * 2048, 2048, Bt, 2048, DFF / 64, 2048, nullptr, 0, ss, nullptr, (bf16*)(F.ws + O_ACT), nullptr, 0.f);
}
__device__ __forceinline__ void gemm_residual(const Ctx& F, const bf16* A, const bf16* Bt, int K, int ssidx, bool to_out, float scale) {
    float* sso = ssidx >= 0 ? (float*)(F.ws + O_SS) + (size_t)ssidx * MP * 32 : nullptr;
    { pg8::Gemm g{A, Bt, SEQ, 2048, K, K, K, F.wave}; pg8::StaticOrder S; S.init(SEQ, 2048, F.G, F.bid);
      pg8::EpiResidual E{(bf16*)(F.ws + O_H), (bf16*)(F.ws + O_HB), sso, to_out ? F.kp->out : nullptr, SEQ, scale};
      pg8::gemm_phase<pg8::EpiResidual, pg8::StaticOrder, true, true>(F.lds, g, S, E); }
    meta_gemm<2, 4>(F, A + (size_t)SEQ * K, K, Bt, K, 32, K, nullptr, 0, nullptr, sso, (bf16*)(F.ws + O_HB), (bf16*)(F.ws + O_H), scale);
}
__device__ __forceinline__ void gemm_residual_dummy(const Ctx& F, const bf16* A, const bf16* Bt, int K) {
    { pg8::Gemm g{A, Bt, SEQ, 2048, K, K, K, F.wave}; pg8::StaticOrder S; S.init(SEQ, 2048, F.G, F.bid);
      pg8::EpiResidual E{(bf16*)(F.ws + O_RW), (bf16*)(F.ws + O_RW + (size_t)72 * 1024 * 1024), nullptr, nullptr, SEQ, 0.5f};
      pg8::gemm_phase<pg8::EpiResidual, pg8::StaticOrder, true, true>(F.lds, g, S, E); }
}
__device__ __forceinline__ void gemm_scalef32(const Ctx& F, const bf16* A, const bf16* Bt, int N, int K, float* C, int ssidx) {
    const float* ss = ssidx >= 0 ? (const float*)(F.ws + O_SS) + (size_t)ssidx * MP * 32 : nullptr;
    { pg8::Gemm g{A, Bt, SEQ, N, K, K, K, F.wave}; pg8::StaticOrder S; S.init(SEQ, N, F.G, F.bid);
      pg8::EpiScaleF32 E{C, N, ss, 1.0f / 2048.0f, EPS};
      pg8::gemm_phase<pg8::EpiScaleF32, pg8::StaticOrder, true, true>(F.lds, g, S, E); }
    meta_gemm<0, 4>(F, A + (size_t)SEQ * K, K, Bt, K, N / 64, K, C, N, ss, nullptr, nullptr, nullptr, 0.f);
}
__global__ void __launch_bounds__(NTHR, 2) hybrid_fwd(P p) {
    extern __shared__ __attribute__((aligned(16))) unsigned char lds_raw[];
    LAS unsigned char* lds = (LAS unsigned char*)lds_raw;
    const int wv = __builtin_amdgcn_readfirstlane((int)threadIdx.x >> 6);
    for (int u = threadIdx.x; u < (LDS_BYTES - LDSCTL_OFF) / 4; u += NTHR) ((LAS unsigned*)(lds + LDSCTL_OFF))[u] = 0u;
    __syncthreads();
    XcdBarrier bar = xcd_barrier_post((unsigned*)(p.ws + O_CTL) + CW_BAR, (volatile LAS unsigned*)(lds + LDSCTL_OFF), wv);
    const int lo = p.ph_lo, hi = p.ph_hi;
#ifdef TIME_MASK
    if (blockIdx.x == TIME_BLK && threadIdx.x == 0) { volatile LAS unsigned long long* tp_ = (volatile LAS unsigned long long*)(lds + LDSCTL_OFF + 1024); tp_[0] = wall_clock64(); tp_[1] = 0ull; }
#endif
#define IN(k) (lo <= (k) && (k) < hi)
#ifdef TIME_MASK
#ifndef TIME_PRE
#define TIME_PRE 0
#endif
#ifndef TIME_BLK
#define TIME_BLK 0
#endif
#define TMARK(kind, post) do { if (blockIdx.x == TIME_BLK && threadIdx.x == 0) { const unsigned long long now_ = wall_clock64(); volatile LAS unsigned long long* tp_ = (volatile LAS unsigned long long*)(lds + LDSCTL_OFF + 1024); \
    if ((((post) ? TIME_MASK : TIME_PRE) >> (kind)) & 1) tp_[1] += now_ - tp_[0]; if (post) tp_[0] = now_; } } while (0)
#define SEAM(k, kind) do { TMARK(kind, 0); if (IN(k) && IN((k) + 1)) xcd_barrier(bar, wv); TMARK(kind, 1); } while (0)
#else
#define TMARK(kind, post) do { } while (0)
#define SEAM(k, kind) do { if (IN(k) && IN((k) + 1)) xcd_barrier(bar, wv); } while (0)
#endif
#ifndef NO_P0
    if (IN(0)) { const Ctx F = ctx_make(lds, wv); p0_prologue(F, 0); }
#ifdef DUP_CVT
    if (IN(0)) { const Ctx F = ctx_make(lds, wv); p0_prologue(F, 1); }
#endif
#endif
    SEAM(0, 0);
    for (int hl = 0; hl < 8; ++hl) {
        const int l = hl >> 1, second = hl & 1, base = 1 + 11 * l + (second ? 9 : 0);
        if (IN(base)) { const Ctx F = ctx_make(lds, wv); gemm_swiglu(F, hl, 3 * l + (second ? 2 : 0)); }
#ifdef DUP_GU
        if (IN(base)) { const Ctx F = ctx_make(lds, wv); gemm_swiglu(F, hl, 3 * l + (second ? 2 : 0)); }
#endif
        SEAM(base, 1);
        if (IN(base + 1)) { const Ctx F = ctx_make(lds, wv);
            gemm_residual(F, (const bf16*)(F.ws + O_ACT), (const bf16*)(F.ws + O_WD) + (size_t)hl * 2048 * 5632, 5632, second ? (l < 3 ? 3 * (l + 1) : -1) : 3 * l + 1, hl == 7, 0.5f); }
#ifdef DUP_DOWN
        if (IN(base + 1)) { const Ctx F = ctx_make(lds, wv); if (DUP_DOWN == 1) gemm_residual_dummy(F, (const bf16*)(F.ws + O_ACT), (const bf16*)(F.ws + O_WD) + (size_t)hl * 2048 * 5632, 5632); else gemm_residual_dummy(F, (const bf16*)(F.ws + O_Y), (const bf16*)(F.ws + O_WOUT) + (size_t)l * D * D, 2048); }
#endif
        if (hl < 7) SEAM(base + 1, 2);
        if (!second) {
            const int mb = base + 2;
            if (IN(mb)) { const Ctx F = ctx_make(lds, wv); gemm_scalef32(F, (const bf16*)(F.ws + O_HB), (const bf16*)(F.ws + O_WIN) + (size_t)l * NINP * D, NINP, 2048, (float*)(F.ws + O_U), 3 * l + 1); }
#ifdef DUP_WIN
            if (IN(mb)) { const Ctx F = ctx_make(lds, wv); gemm_scalef32(F, (const bf16*)(F.ws + O_HB), (const bf16*)(F.ws + O_WIN) + (size_t)l * NINP * D, NINP, 2048, (float*)(F.ws + O_U), 3 * l + 1); }
#endif
            SEAM(mb, 3);
#ifndef NO_M1
            if (IN(mb + 1)) { const Ctx F = ctx_make(lds, wv); m1_phase(F, l); }
#ifdef DUP_M1
            if (IN(mb + 1)) { const Ctx F = ctx_make(lds, wv); m1_phase(F, l, 3); }
#endif
#endif
            SEAM(mb + 1, 4);
            if (IN(mb + 2)) {
                if (EN_MLA) { const Ctx F = ctx_make(lds, wv); gemm_scalef32(F, (const bf16*)(F.ws + O_AMLA), (const bf16*)(F.ws + O_WMLA) + (size_t)l * MLAN * 512, MLAN, 512, (float*)(F.ws + O_QKV), -1); }
#ifndef NO_M2
                { const Ctx F = ctx_make(lds, wv); unsigned* ctr = (unsigned*)(F.ws + O_CTL) + CW_QUEUE + 64 * (4 * l + 2);
                  for (;;) { int u = queue_next(F, ctr); if (u >= NRC * 8 + NCH * 8 + NCH * 4) break;
                      if (u < NRC * 8) { rwkv_chunk_unit(F, u >> 3, u & 7); continue; } u -= NRC * 8;
                      if (u < NCH * 8) { ssd_states_unit(F, u >> 3, u & 7); continue; } u -= NCH * 8;
                      ret_states_unit(F, u >> 2, u & 3); } }
#ifdef DUP_M2Q
                { const Ctx F = ctx_make(lds, wv); unsigned* ctr = (unsigned*)(F.ws + O_CTL) + CW_QUEUE + 64 * (4 * l + 3);
                  for (;;) { int u = queue_next(F, ctr); if (u >= NRC * 8 + NCH * 8 + NCH * 4) break;
                      if (u < NRC * 8) { rwkv_chunk_unit(F, u >> 3, u & 7); continue; } u -= NRC * 8;
                      if (u < NCH * 8) { ssd_states_unit(F, u >> 3, u & 7); continue; } u -= NCH * 8;
                      ret_states_unit(F, u >> 2, u & 3); } }
#endif
#endif
            }
            SEAM(mb + 2, 5);
#ifndef NO_M3
            if (IN(mb + 3)) { const Ctx F = ctx_make(lds, wv); m3_phase(F, l); }
#ifdef DUP_SCAN
            if (IN(mb + 3)) { const Ctx F = ctx_make(lds, wv); if (F.bid < 32) rwkv_state_scan<DUP_SCAN>(F, F.bid >> 2, F.bid & 3); }
#endif
#endif
            SEAM(mb + 3, 6);
#ifndef NO_M4
            if (IN(mb + 4)) { const Ctx F = ctx_make(lds, wv); const int nscan = F.G >= 64 ? 32 : F.G;
                if (F.bid < nscan) { for (int s = F.bid; s < 32; s += nscan) rwkv_state_scan<0>(F, s >> 2, s & 3);
                    asm volatile("s_waitcnt vmcnt(0)" ::: "memory"); __syncthreads();
                    if (F.tid == 0) { __builtin_amdgcn_fence(__ATOMIC_RELEASE, "agent"); asm volatile("s_waitcnt vmcnt(0)" ::: "memory"); __hip_atomic_fetch_add((unsigned*)(F.ws + O_CTL) + CW_QUEUE + 64 * (16 + l), 1u, __ATOMIC_RELAXED, __HIP_MEMORY_SCOPE_AGENT); } } }
            if (IN(mb + 4)) { const Ctx F = ctx_make(lds, wv); m4_phase(F, l); }
#ifdef DUP_M4
            if (IN(mb + 4)) { const Ctx F = ctx_make(lds, wv); m4_phase(F, l, 3, DUP_M4 - 1); }
#endif
#endif
            SEAM(mb + 4, 7);
#ifndef NO_M5
            if (IN(mb + 5)) { const Ctx F = ctx_make(lds, wv); m5_phase(F, l); }
#ifdef DUP_M5
            if (IN(mb + 5)) { const Ctx F = ctx_make(lds, wv); m5_phase(F, l); }
#endif
#endif
            SEAM(mb + 5, 8);
#ifdef DUP_BAR
            for (int q = 0; q < 8; ++q) xcd_barrier(bar, wv);
#endif
            if (IN(mb + 6)) { const Ctx F = ctx_make(lds, wv); gemm_residual(F, (const bf16*)(F.ws + O_Y), (const bf16*)(F.ws + O_WOUT) + (size_t)l * D * D, 2048, 3 * l + 2, false, 1.0f); }
            SEAM(mb + 6, 9);
        }
    }
#ifdef TIME_MASK
    TMARK(2, 0); TMARK(2, 1);
    if (blockIdx.x == TIME_BLK && threadIdx.x == 0) { volatile LAS unsigned long long* tp_ = (volatile LAS unsigned long long*)(lds + LDSCTL_OFF + 1024); const unsigned long long t0_ = tp_[0], d_ = tp_[1];
        while (wall_clock64() - t0_ < d_) __builtin_amdgcn_s_sleep(8); }
#endif
#ifdef PROBE_DUP
    xcd_barrier(bar, wv);
    { const Ctx F = ctx_make(lds, wv); const float v = (float)__hip_atomic_load((unsigned*)(F.ws + O_CTL) + 8, __ATOMIC_RELAXED, __HIP_MEMORY_SCOPE_AGENT); float* out = F.kp->out;
      for (size_t i = (size_t)F.bid * NTHR + F.tid; i < (size_t)SEQ * D; i += (size_t)F.G * NTHR) out[i] = v; }
#endif
#ifdef PROBE_ADD_META
    xcd_barrier(bar, wv);
    { const Ctx F = ctx_make(lds, wv); const float* H = (const float*)(F.ws + O_H); float* out = F.kp->out;
      for (int row = F.bid * NWAVES + F.wave; row < SEQ; row += F.G * NWAVES)
        for (int j = 0; j < 8; ++j) { const int c = 256 * j + 4 * F.lane; f32x4 v = *(f32x4*)(out + (size_t)row * D + c); v = v + *(const f32x4*)(H + (size_t)(SEQ + (row & 15)) * D + c); *(f32x4*)(out + (size_t)row * D + c) = v; } }
#endif
#undef IN
#undef SEAM
}

extern "C" void kernel_launch(void* const* d_in, const int* in_sizes, int n_in, void* d_out, int out_size, void* d_ws, size_t ws_size, hipStream_t stream) {
    static int grid = 0;
    if (grid == 0) {
        if (n_in != 36 || out_size != SEQ * D || ws_size < WS_END) { fprintf(stderr, "kernel_launch: expected 36 inputs, out %d, ws >= %zu; got n_in %d out %d ws %zu\n", SEQ * D, (size_t)WS_END, n_in, out_size, ws_size); grid = -1; return; }
        int dev = 0, cus = 0, per_cu = 0;
        if (hipGetDevice(&dev) != hipSuccess || hipDeviceGetAttribute(&cus, hipDeviceAttributeMultiprocessorCount, dev) != hipSuccess) { grid = -1; return; }
        if (hipFuncSetAttribute((const void*)hybrid_fwd, hipFuncAttributeMaxDynamicSharedMemorySize, LDS_BYTES) != hipSuccess) { fprintf(stderr, "kernel_launch: hipFuncSetAttribute failed\n"); grid = -1; return; }
        if (hipOccupancyMaxActiveBlocksPerMultiprocessor(&per_cu, (const void*)hybrid_fwd, NTHR, LDS_BYTES) != hipSuccess || per_cu < 1) fprintf(stderr, "kernel_launch: occupancy query reports %d\n", per_cu);
        (void)hipGetLastError();
        grid = cus;
    }
    if (grid < 0) return;
    if (hipMemsetAsync((char*)d_ws + O_CTL, 0, SZ_CTL, stream) != hipSuccess) { fprintf(stderr, "kernel_launch: memset failed\n"); return; }
    P a{};
    for (int i = 0; i < 36; ++i) a.in[i] = (const float*)d_in[i];
    a.out = (float*)d_out; a.ws = (unsigned char*)d_ws;
#if PER_PHASE_LAUNCH
    for (int ph = 0; ph < NPHASE; ++ph) { a.ph_lo = ph; a.ph_hi = ph + 1; hipLaunchKernelGGL(hybrid_fwd, dim3(grid), dim3(NTHR), LDS_BYTES, stream, a); }
#else
    a.ph_lo = 0; a.ph_hi = NPHASE;
    hipLaunchKernelGGL(hybrid_fwd, dim3(grid), dim3(NTHR), LDS_BYTES, stream, a);
#endif
    const hipError_t le = hipPeekAtLastError();
    if (le != hipSuccess) fprintf(stderr, "kernel_launch: launch failed: %s\n", hipGetErrorName(le));
}
```

```cpp
#include <hip/hip_runtime.h>
#include <cstdio>
#include <cstdint>

#define GAS __attribute__((address_space(1)))
#define LAS __attribute__((address_space(3)))
typedef unsigned short bf16;
typedef unsigned v4u __attribute__((ext_vector_type(4)));
typedef unsigned v2u __attribute__((ext_vector_type(2)));
typedef float f32x4 __attribute__((ext_vector_type(4)));
typedef float f32x2 __attribute__((ext_vector_type(2)));
typedef float f32x16 __attribute__((ext_vector_type(16)));
typedef short bf16x8 __attribute__((ext_vector_type(8)));

constexpr int D = 2048, SEQ = 8192, NMETA = 16, T = SEQ + NMETA, MP = 8448, DFF = 5632, DEPTH = 4;
constexpr int NIN = 5320, NINP = 5376, NCH = 65, TSEQ = 8320, MLAN = 1792;
constexpr int U_MLA = 0, U_SSD = 576, U_RET = 2120, U_RWKV = 3656;
constexpr float EPS = 1e-6f;
constexpr int NWAVES = 8, NTHR = 512;
#ifndef EN_MLA
#define EN_MLA 1
#endif
#ifndef EN_SSD
#define EN_SSD 1
#endif
#ifndef EN_RET
#define EN_RET 1
#endif
#ifndef EN_RWKV
#define EN_RWKV 1
#endif
#ifndef PROBE_NOSCAN
#define PROBE_NOSCAN 0
#endif
#ifndef PROBE_ATTCOPY
#define PROBE_ATTCOPY 0
#endif
#ifndef PROBE_COPY_META
#define PROBE_COPY_META 0
#endif
#ifndef DUP_VAR
#define DUP_VAR 0
#endif
#ifndef PER_PHASE_LAUNCH
#define PER_PHASE_LAUNCH 0
#endif
constexpr int NPHASE = 1 + 8 * 2 + 4 * 7;

constexpr size_t O_CTL = 0, SZ_CTL = 13107200;
constexpr int CW_BAR = 4096;
constexpr size_t O_SS = 65536;
constexpr size_t O_WGU = O_CTL + SZ_CTL,                 SZ_WGU = (size_t)8 * 2 * DFF * D * 2;
constexpr size_t O_WD = O_WGU + SZ_WGU,                  SZ_WD = (size_t)8 * D * DFF * 2;
constexpr size_t O_WIN = O_WD + SZ_WD,                   SZ_WIN = (size_t)4 * NINP * D * 2;
constexpr size_t O_WOUT = O_WIN + SZ_WIN,                SZ_WOUT = (size_t)4 * D * D * 2;
constexpr size_t O_WMLA = O_WOUT + SZ_WOUT,              SZ_WMLA = (size_t)4 * MLAN * 512 * 2;
constexpr size_t O_H = O_WMLA + SZ_WMLA,                 SZ_H = (size_t)MP * D * 4;
constexpr size_t O_HB = O_H + SZ_H,                      SZ_HB = (size_t)MP * D * 2;
constexpr size_t O_U = O_HB + SZ_HB,                     SZ_U = (size_t)MP * NINP * 4;
constexpr size_t O_ACT = O_U;
constexpr size_t O_AMLA = O_U + SZ_U,                    SZ_AMLA = (size_t)MP * 512 * 2;
constexpr size_t O_QKV = O_AMLA + SZ_AMLA,               SZ_QKV = (size_t)MP * MLAN * 4;
constexpr size_t O_Q = O_QKV + SZ_QKV,                   SZ_Q = (size_t)TSEQ * 768 * 2;
constexpr size_t O_K = O_Q + SZ_Q;
constexpr size_t O_VT = O_K + SZ_Q,                      SZ_VT = (size_t)4 * 128 * TSEQ * 2;
constexpr size_t O_Y = O_VT + SZ_VT,                     SZ_Y = (size_t)MP * D * 2;
constexpr size_t O_XBC = O_Y + SZ_Y,                     SZ_XBC = (size_t)MP * 1024 * 4;
constexpr size_t O_DT = O_XBC + SZ_XBC,                  SZ_DT = (size_t)MP * 8 * 4;
constexpr size_t O_LA = O_DT + SZ_DT;
constexpr size_t O_SST = O_LA + SZ_DT,                   SZ_SST = (size_t)NCH * 8 * 64 * 128 * 4;
constexpr size_t O_SDEC = O_SST + SZ_SST,                SZ_SDEC = (size_t)NCH * 8 * 128;
constexpr size_t O_YZ = O_SDEC + SZ_SDEC,                SZ_YZ = (size_t)MP * 512 * 4;
constexpr size_t O_RQK = O_YZ + SZ_YZ,                   SZ_RQK = (size_t)MP * 512 * 4;
constexpr size_t O_RST = O_RQK + SZ_RQK,                 SZ_RST = (size_t)NCH * 4 * 128 * 64 * 4;
constexpr size_t O_RW = O_RST + SZ_RST,                  SZ_RW1 = (size_t)MP * 512 * 4;
constexpr size_t O_RBON = O_RW + 8 * SZ_RW1,             SZ_RBON = (size_t)MP * 8 * 4;
constexpr size_t O_ROPE = O_RBON + SZ_RBON,              SZ_ROPE = (size_t)MP * 32 * 8;
constexpr size_t O_MATS = O_ROPE + SZ_ROPE,             SZ_MATS = (size_t)129 * 8 * 16384 * 4;
constexpr size_t O_SSTATE = O_RW + 7 * SZ_RW1;
constexpr size_t WS_END = O_MATS + SZ_MATS;
static_assert((size_t)129 * 8 * 4096 * 4 <= SZ_RW1, "sstate");
static_assert(WS_END <= 1424122240ull, "d_ws map too large");
static_assert(O_SS + (size_t)12 * MP * 32 * 4 <= SZ_CTL, "ctl map");
static_assert((size_t)MP * DFF * 2 <= SZ_U, "act overlays u");

constexpr int RING_BYTES = 131072;
constexpr int LDSCTL_OFF = 143360;
constexpr int LDS_BYTES = 147456;

#define LDS_WAIT() asm volatile("s_waitcnt lgkmcnt(0)" ::: "memory")
#define LBAR() do { asm volatile("s_waitcnt lgkmcnt(0)" ::: "memory"); __builtin_amdgcn_s_barrier(); asm volatile("" ::: "memory"); } while (0)
constexpr int CW_QUEUE = 8192;
#define VM_WAIT() asm volatile("s_waitcnt vmcnt(0)" ::: "memory")
__device__ __forceinline__ unsigned f2bf(float f) { unsigned u = __builtin_bit_cast(unsigned, f); return (u + 0x7fffu + ((u >> 16) & 1u)) >> 16; }
__device__ __forceinline__ unsigned pk2(float lo, float hi) { return f2bf(lo) | (f2bf(hi) << 16); }
typedef __bf16 bf16x2_t __attribute__((ext_vector_type(2)));
__device__ __forceinline__ unsigned cvtpk(float lo, float hi) { const f32x2 v = {lo, hi}; return __builtin_bit_cast(unsigned, __builtin_convertvector(v, bf16x2_t)); }
__device__ __forceinline__ int lane_id() { unsigned ones = ~0u; asm volatile("" : "+s"(ones)); return (int)__builtin_amdgcn_mbcnt_hi(ones, __builtin_amdgcn_mbcnt_lo(ones, 0u)); }
template <int CTRL> __device__ __forceinline__ float dpp_(float v) { return __builtin_bit_cast(float, __builtin_amdgcn_update_dpp(0, __builtin_bit_cast(int, v), CTRL, 0xF, 0xF, true)); }
__device__ __forceinline__ float rdlane(float v, int l) { return __builtin_bit_cast(float, __builtin_amdgcn_readlane(__builtin_bit_cast(int, v), l)); }
__device__ __forceinline__ float sum4(float v) { v += dpp_<0xB1>(v); v += dpp_<0x4E>(v); return v; }
__device__ __forceinline__ float sum8(float v) { v = sum4(v); v += dpp_<0x141>(v); return v; }
__device__ __forceinline__ float sum16(float v) { v = sum8(v); v += dpp_<0x140>(v); return v; }
__device__ __forceinline__ float wave_sum(float v) { v = sum16(v); return (rdlane(v, 0) + rdlane(v, 16)) + (rdlane(v, 32) + rdlane(v, 48)); }
__device__ __forceinline__ float sum32(float v, int lane) { v = sum16(v); const float lo = rdlane(v, 0) + rdlane(v, 16), hi = rdlane(v, 32) + rdlane(v, 48); return (lane & 32) ? hi : lo; }
__device__ __forceinline__ float xor32f(float v, int lane) {
    const unsigned x = __builtin_bit_cast(unsigned, v); const auto r = __builtin_amdgcn_permlane32_swap(x, x, false, false);
    return __builtin_bit_cast(float, (lane & 32) ? r[0] : r[1]); }
__device__ __forceinline__ float sigmoidf_(float x) { return 1.0f / (1.0f + __expf(-x)); }
__device__ __forceinline__ float siluf_(float x) { return x / (1.0f + __expf(-x)); }
__device__ __forceinline__ float softplusf_(float x) { return x > 20.f ? x : log1pf(expf(x)); }
struct UB { const bf16* p;
    __device__ __forceinline__ float operator[](size_t i) const { return __builtin_bit_cast(float, (unsigned)p[i] << 16); }
    __device__ __forceinline__ UB operator+(size_t o) const { return UB{p + o}; } };
__device__ __forceinline__ f32x4 ldu4(const UB u) { const v2u w = *(const v2u*)u.p;
    return (f32x4){__builtin_bit_cast(float, w.x << 16), __builtin_bit_cast(float, w.x & 0xffff0000u), __builtin_bit_cast(float, w.y << 16), __builtin_bit_cast(float, w.y & 0xffff0000u)}; }
__device__ __forceinline__ int row_of_seq(int s) { return s < NMETA ? SEQ + s : s - NMETA; }
__device__ __forceinline__ int seq_of_row(int r) { return r >= SEQ ? r - SEQ : r + NMETA; }
__device__ __forceinline__ int prev_row(int r) { return r == SEQ ? -1 : (r == 0 ? T - 1 : r - 1); }
__device__ __forceinline__ int crow(int c, int p) { return c == 0 ? (p >= 112 ? SEQ + p - 112 : -1) : 128 * (c - 1) + p; }
namespace pg8 {
#define PG8_LAS __attribute__((address_space(3)))
typedef unsigned short bf16_t;
typedef short bf16x8 __attribute__((ext_vector_type(8)));
typedef float f32x4 __attribute__((ext_vector_type(4)));
typedef unsigned u32x4 __attribute__((ext_vector_type(4)));
constexpr int BM = 256, BK = 64, HALF = 128, HTB = HALF * BK * 2  , STAGE_BYTES = 8 * HTB, NXCD = 8, WGM = 8;

__host__ __device__ __forceinline__ int lds_byte(int r, int c) { const int st = (r >> 4) * 2 + (c >> 5), rr = r & 15, cc = c & 31, ob = rr * 64 + cc * 2; return st * 1024 + (ob ^ (((ob >> 9) & 1) << 5)); }
__host__ __device__ __forceinline__ void stage_rc(int b, int& R, int& C) { const int st = b / 1024, sb = b % 1024, swz = sb ^ (((sb >> 9) & 1) << 5); R = (st >> 1) * 16 + swz / 64; C = (st & 1) * 32 + (swz % 64) / 2; }
__host__ __device__ __forceinline__ int perm32(int rho) { const int n = rho >> 4, i = rho & 15; return 8 * (i >> 2) + 4 * n + (i & 3); }

struct Unit { int pm, pn, ah; };
struct Gemm { const bf16_t* A; const bf16_t* Bt; int M, N, K, lda, ldb, wv; };

struct StaticOrder {
    int nM, nN, nwg, G, c, lim, hmbase;
    __host__ __device__ void init(int M, int N, int G_, int c_) { nM = M / BM; nN = N / BM; nwg = nM * nN; G = G_; c = c_; lim = nwg; hmbase = -1; }
    __host__ __device__ bool next(int i, Unit& u) const {
        long L; u.ah = 0;
        if (hmbase >= 0) { if (i > 0) return false; L = hmbase + (c >> 1); u.ah = c & 1; if (L >= nwg) return false; }
        else { L = (long)i * G + c; if (L >= lim) return false; }
        int wgid = (int)L; { const int q = nwg / NXCD, r = nwg % NXCD, xcd = wgid % NXCD, off = wgid / NXCD; wgid = (xcd < r ? xcd * (q + 1) : r * (q + 1) + (xcd - r) * q) + off; }
        const int nig = WGM * nN, gid = wgid / nig, fm = gid * WGM, gsz = (nM - fm) < WGM ? (nM - fm) : WGM;
        u.pm = fm + ((wgid % nig) % gsz); u.pn = (wgid % nig) / gsz; return true;
    }
    __device__ __forceinline__ void a_ready(const Unit&) const {}
    __device__ __forceinline__ void done(const Unit&) const {}
};

__device__ __forceinline__ unsigned cvt_pk_bf16(float lo, float hi) { unsigned r; asm volatile("v_cvt_pk_bf16_f32 %0, %1, %2" : "=v"(r) : "v"(lo), "v"(hi)); return r; }

template <class Epi, class Sched, bool ALIGN_EPI = false, bool SP2 = false, bool HM = false>
__device__ __forceinline__ void gemm_phase(PG8_LAS unsigned char* lds, const Gemm g, const Sched& S, const Epi& E) {
    int tid = g.wv * 64 + lane_id(); asm volatile("" : "+v"(tid)); const int wid = g.wv, lane = tid & 63, wr = wid >> 2, wc = wid & 3, fr = lane & 15, fq = lane >> 4;
    const int K = g.K, nt = K / BK;
    unsigned voffA[2], voffB[2];
#pragma unroll
    for (int i = 0; i < 2; ++i) { int R, C; stage_rc(tid * 16 + i * 8192, R, C); const int Rb = Epi::PERM ? ((R & ~31) + perm32(R & 31)) : R;
        voffA[i] = (unsigned)(R * g.lda + C) * 2u; voffB[i] = (unsigned)(Rb * g.ldb + C) * 2u; }
    const size_t kstep = (size_t)(BK * 2);
    const size_t hA = (size_t)HALF * g.lda * 2, hB = (size_t)HALF * g.ldb * 2;
    const size_t tA = 2 * hA, tB = 2 * hB;
    const unsigned ldsw = (unsigned)wid * 1024u;
    const int aoff = lds_byte(wr * 64 + fr, fq * 8), boff = lds_byte(wc * 32 + fr, fq * 8);
#define PG8_SA(b, h) (((b) * 2 + (h)) * HTB)
#define PG8_SB(b, h) ((4 + (b) * 2 + (h)) * HTB)
#define PG8_STAGE(bufoff, gbase, voff) do { _Pragma("unroll") for (int _i = 0; _i < 2; ++_i) \
        __builtin_amdgcn_global_load_lds((const unsigned*)((const char*)(gbase) + (voff)[_i]), (PG8_LAS unsigned*)(lds + (bufoff) + ldsw + _i * 8192), 16, 0, 0); } while (0)
#define PG8_LDA(dst, b, h) do { _Pragma("unroll") for (int m = 0; m < 4; ++m) _Pragma("unroll") for (int k = 0; k < 2; ++k) dst[m][k] = *(const PG8_LAS bf16x8*)(lds + PG8_SA(b, h) + aoff + m * 2048 + k * 1024); } while (0)
#define PG8_LDB(dst, b, h) do { _Pragma("unroll") for (int n = 0; n < 2; ++n) _Pragma("unroll") for (int k = 0; k < 2; ++k) dst[n][k] = *(const PG8_LAS bf16x8*)(lds + PG8_SB(b, h) + boff + n * 2048 + k * 1024); } while (0)
#define PG8_MMA(ai, bj, At, Bt) do { __builtin_amdgcn_s_setprio(1); _Pragma("unroll") for (int m = 0; m < 4; ++m) _Pragma("unroll") for (int n = 0; n < 2; ++n) _Pragma("unroll") for (int k = 0; k < 2; ++k) \
        acc[ai][bj][m][n] = __builtin_amdgcn_mfma_f32_16x16x32_bf16(Bt[n][k], At[m][k], acc[ai][bj][m][n], 0, 0, 0); __builtin_amdgcn_s_setprio(0); } while (0)
#define PG8_WAIT_V(n) asm volatile("s_waitcnt vmcnt(" #n ")" ::: "memory")
#define PG8_WAIT_L(n) asm volatile("s_waitcnt lgkmcnt(" #n ")" ::: "memory")
#define PG8_BAR __builtin_amdgcn_s_barrier()
#define PG8_SCHED __builtin_amdgcn_sched_barrier(0)
    Unit cur, nxt; int ui = 0;
    if (!S.next(0, cur)) return;
    f32x4 acc[2][2][4][2];
#pragma unroll
    for (int a = 0; a < 2; ++a)
#pragma unroll
        for (int b = 0; b < 2; ++b)
#pragma unroll
            for (int m = 0; m < 4; ++m)
#pragma unroll
                for (int n = 0; n < 2; ++n) acc[a][b][m][n] = (f32x4){0.f, 0.f, 0.f, 0.f};
    bf16x8 At[4][2], B0[2][2], B1[2][2];
    const char* cA = (const char*)g.A + (size_t)cur.pm * tA + (size_t)cur.ah * hA; const char* cB = (const char*)g.Bt + (size_t)cur.pn * tB;
    S.a_ready(cur);
    if constexpr (SP2) {
        PG8_STAGE(PG8_SB(0, 0), cB, voffB); PG8_STAGE(PG8_SB(0, 1), cB + hB, voffB); PG8_STAGE(PG8_SA(0, 0), cA, voffA); PG8_STAGE(PG8_SA(0, 1), cA + hA, voffA);
        if (wr == 1) PG8_BAR;
        PG8_WAIT_V(2); PG8_BAR;
        PG8_STAGE(PG8_SB(1, 0), cB + kstep, voffB); PG8_STAGE(PG8_SA(1, 0), cA + kstep, voffA); PG8_STAGE(PG8_SB(1, 1), cB + hB + kstep, voffB);
        PG8_WAIT_V(6); PG8_BAR;
    } else {
        PG8_STAGE(PG8_SB(0, 0), cB, voffB); PG8_STAGE(PG8_SA(0, 0), cA, voffA); PG8_STAGE(PG8_SB(0, 1), cB + hB, voffB); PG8_STAGE(PG8_SA(0, 1), cA + hA, voffA);
        if (wr == 1) PG8_BAR;
        PG8_WAIT_V(4); PG8_BAR;
        PG8_STAGE(PG8_SB(1, 0), cB + kstep, voffB); PG8_STAGE(PG8_SA(1, 0), cA + kstep, voffA); PG8_STAGE(PG8_SB(1, 1), cB + hB + kstep, voffB);
        PG8_WAIT_V(6); PG8_BAR;
    }
    for (;;) {
        const bool has_next = S.next(ui + 1, nxt);
        const char* nA = has_next ? (const char*)g.A + (size_t)nxt.pm * tA + (size_t)nxt.ah * hA : cA; const char* nB = has_next ? (const char*)g.Bt + (size_t)nxt.pn * tB : cB;
        for (int t = 0; t < nt; t += 2) {
            const bool last = (t == nt - 2);
            const char* a1 = cA + (size_t)(t + 1) * kstep;
            const char* a2 = last ? nA : cA + (size_t)(t + 2) * kstep; const char* b2 = last ? nB : cB + (size_t)(t + 2) * kstep;
            const char* a3 = a2 + kstep; const char* b3 = b2 + kstep;
            if (last && has_next) S.a_ready(nxt);
            if constexpr (SP2) {
            PG8_LDB(B0, 0, 0); PG8_LDB(B1, 0, 1); PG8_SCHED; PG8_LDA(At, 0, 0); PG8_STAGE(PG8_SA(1, 1), a1 + hA, voffA);
            PG8_WAIT_V(8); PG8_WAIT_L(0); PG8_BAR; PG8_MMA(0, 0, At, B0); PG8_MMA(0, 1, At, B1); PG8_BAR; PG8_SCHED;
            if constexpr (!HM) PG8_LDA(At, 0, 1); PG8_STAGE(PG8_SB(0, 0), b2, voffB); PG8_STAGE(PG8_SB(0, 1), b2 + hB, voffB); PG8_STAGE(PG8_SA(0, 0), a2, voffA);
            PG8_WAIT_V(8); PG8_WAIT_L(0); PG8_BAR; if constexpr (!HM) { PG8_MMA(1, 0, At, B0); PG8_MMA(1, 1, At, B1); } PG8_BAR; PG8_SCHED;
            PG8_LDB(B0, 1, 0); PG8_LDB(B1, 1, 1); PG8_SCHED; PG8_LDA(At, 1, 0); PG8_STAGE(PG8_SA(0, 1), a2 + hA, voffA);
            PG8_WAIT_V(8); PG8_WAIT_L(0); PG8_BAR; PG8_MMA(0, 0, At, B0); PG8_MMA(0, 1, At, B1); PG8_BAR; PG8_SCHED;
            if constexpr (!HM) PG8_LDA(At, 1, 1); PG8_STAGE(PG8_SB(1, 0), b3, voffB); PG8_STAGE(PG8_SB(1, 1), b3 + hB, voffB); PG8_STAGE(PG8_SA(1, 0), a3, voffA);
            PG8_WAIT_V(8); PG8_WAIT_L(0); PG8_BAR; if constexpr (!HM) { PG8_MMA(1, 0, At, B0); PG8_MMA(1, 1, At, B1); } PG8_BAR; PG8_SCHED;
            } else {
            PG8_LDB(B0, 0, 0); PG8_SCHED; PG8_LDA(At, 0, 0); PG8_STAGE(PG8_SA(1, 1), a1 + hA, voffA);
            PG8_WAIT_L(8); PG8_BAR; PG8_WAIT_L(0); PG8_MMA(0, 0, At, B0); PG8_BAR; PG8_SCHED;
            PG8_LDB(B1, 0, 1); PG8_STAGE(PG8_SB(0, 0), b2, voffB);
            PG8_BAR; PG8_WAIT_L(0); PG8_MMA(0, 1, At, B1); PG8_BAR;
            PG8_LDA(At, 0, 1); PG8_STAGE(PG8_SA(0, 0), a2, voffA);
            PG8_BAR; PG8_WAIT_L(0); PG8_MMA(1, 0, At, B0); PG8_BAR; PG8_SCHED;
            PG8_STAGE(PG8_SB(0, 1), b2 + hB, voffB);
            PG8_WAIT_V(6); PG8_BAR; PG8_MMA(1, 1, At, B1); PG8_BAR;
            PG8_LDB(B0, 1, 0); PG8_SCHED; PG8_LDA(At, 1, 0); PG8_STAGE(PG8_SA(0, 1), a2 + hA, voffA);
            PG8_WAIT_L(8); PG8_BAR; PG8_WAIT_L(0); PG8_MMA(0, 0, At, B0); PG8_BAR; PG8_SCHED;
            PG8_LDB(B1, 1, 1); PG8_STAGE(PG8_SB(1, 0), b3, voffB);
            PG8_BAR; PG8_WAIT_L(0); PG8_MMA(0, 1, At, B1); PG8_BAR;
            PG8_LDA(At, 1, 1); PG8_STAGE(PG8_SA(1, 0), a3, voffA);
            PG8_BAR; PG8_WAIT_L(0); PG8_MMA(1, 0, At, B0); PG8_BAR; PG8_SCHED;
            PG8_STAGE(PG8_SB(1, 1), b3 + hB, voffB);
            PG8_WAIT_V(6); PG8_BAR; PG8_MMA(1, 1, At, B1); PG8_BAR;
            }
        }
        if constexpr (ALIGN_EPI) { if (wr == 0) PG8_BAR; }
        if constexpr (!Epi::AFTER_DRAIN) { E(acc, cur, wr, wc, fr, fq); S.done(cur); }
        if (!has_next) break;
#pragma unroll
        for (int a = 0; a < 2; ++a)
#pragma unroll
            for (int b = 0; b < 2; ++b)
#pragma unroll
                for (int m = 0; m < 4; ++m)
#pragma unroll
                    for (int n = 0; n < 2; ++n) acc[a][b][m][n] = (f32x4){0.f, 0.f, 0.f, 0.f};
        cur = nxt; cA = nA; cB = nB; ++ui;
        if constexpr (ALIGN_EPI) { if (wr == 1) PG8_BAR; }
    }
    PG8_WAIT_V(0);
    if constexpr (!ALIGN_EPI) { if (wr == 0) PG8_BAR; }
    PG8_BAR;
    if constexpr (Epi::AFTER_DRAIN) { E.fused(acc, cur, wr, wc, fr, fq, lds, wid, lane); S.done(cur); }
#undef PG8_SA
#undef PG8_SB
#undef PG8_STAGE
#undef PG8_LDA
#undef PG8_LDB
#undef PG8_MMA
#undef PG8_WAIT_V
#undef PG8_WAIT_L
#undef PG8_BAR
#undef PG8_SCHED
}

__device__ __forceinline__ float row_ss(const float* ss, int row, int fq) {
    const f32x4 a = *(const f32x4*)(ss + (size_t)row * 32 + 8 * fq), b = *(const f32x4*)(ss + (size_t)row * 32 + 8 * fq + 4);
    float s = ((a[0] + a[1]) + (a[2] + a[3])) + ((b[0] + b[1]) + (b[2] + b[3]));
    s += __shfl_xor(s, 16); s += __shfl_xor(s, 32); return s;
}
struct EpiScaleF32 {
    static constexpr bool PERM = false, AFTER_DRAIN = false;
    float* C; int ldc; const float* ss; float inv_d, eps;
    __device__ __forceinline__ void operator()(const f32x4 (&acc)[2][2][4][2], const Unit& u, int wr, int wc, int fr, int fq) const {
        const int row0 = u.pm * BM + wr * 64 + fr, col0 = u.pn * BM + wc * 32 + 4 * fq;
#pragma unroll
        for (int ai = 0; ai < 2; ++ai)
#pragma unroll
            for (int m = 0; m < 4; ++m) { const int row = row0 + ai * HALF + m * 16; float* rowp = C + (size_t)row * ldc + col0;
                const float rs = ss ? __builtin_amdgcn_rsqf(row_ss(ss, row, fq) * inv_d + eps) : 1.0f;
#pragma unroll
                for (int bj = 0; bj < 2; ++bj)
#pragma unroll
                    for (int n = 0; n < 2; ++n) *(f32x4*)(rowp + bj * HALF + n * 16) = acc[ai][bj][m][n] * rs; }
    }
};
struct EpiScaleBf16 {
    static constexpr bool PERM = true, AFTER_DRAIN = false;
    bf16_t* O; int ldo; const float* ss; float inv_d, eps;
    __device__ __forceinline__ void operator()(const f32x4 (&acc)[2][2][4][2], const Unit& u, int wr, int wc, int fr, int fq) const {
        const int row0 = u.pm * BM + wr * 64 + fr, col0 = u.pn * BM + wc * 32 + 8 * fq;
#pragma unroll
        for (int ai = 0; ai < 2; ++ai)
#pragma unroll
            for (int m = 0; m < 4; ++m) { const int row = row0 + ai * HALF + m * 16; const float rs = __builtin_amdgcn_rsqf(row_ss(ss, row, fq) * inv_d + eps);
#pragma unroll
                for (int bj = 0; bj < 2; ++bj) { const f32x4 v0 = acc[ai][bj][m][0] * rs, v1 = acc[ai][bj][m][1] * rs;
                    u32x4 w; w.x = cvt_pk_bf16(v0[0], v0[1]); w.y = cvt_pk_bf16(v0[2], v0[3]); w.z = cvt_pk_bf16(v1[0], v1[1]); w.w = cvt_pk_bf16(v1[2], v1[3]);
                    *(u32x4*)(O + (size_t)row * ldo + col0 + bj * HALF) = w; } }
    }
};
struct EpiSwiGLU {
    static constexpr bool PERM = true, AFTER_DRAIN = false;
    bf16_t* O; int ldo; const float* ss; float inv_d, eps; int nai;
    __device__ __forceinline__ void operator()(const f32x4 (&acc)[2][2][4][2], const Unit& u, int wr, int wc, int fr, int fq) const {
        const int row0 = u.pm * BM + u.ah * HALF + wr * 64 + fr, col0 = u.pn * HALF + wc * 32 + 8 * fq;
#pragma unroll
        for (int ai = 0; ai < 2; ++ai) { if (ai >= nai) break;
#pragma unroll
            for (int m = 0; m < 4; ++m) { const int row = row0 + ai * HALF + m * 16;
                const float rs = __builtin_amdgcn_rsqf(row_ss(ss, row, fq) * inv_d + eps);
                float o[8];
#pragma unroll
                for (int n = 0; n < 2; ++n)
#pragma unroll
                    for (int j = 0; j < 4; ++j) { const float gv = acc[ai][0][m][n][j] * rs, uv = acc[ai][1][m][n][j] * rs; o[n * 4 + j] = gv * uv * __builtin_amdgcn_rcpf(1.0f + __expf(-gv)); }
                u32x4 w; w.x = cvt_pk_bf16(o[0], o[1]); w.y = cvt_pk_bf16(o[2], o[3]); w.z = cvt_pk_bf16(o[4], o[5]); w.w = cvt_pk_bf16(o[6], o[7]);
                *(u32x4*)(O + (size_t)row * ldo + col0) = w; } }
    }
};
__device__ __forceinline__ float bflo(unsigned w) { return __builtin_bit_cast(float, w << 16); }
__device__ __forceinline__ float bfhi(unsigned w) { return __builtin_bit_cast(float, w & 0xffff0000u); }
struct EpiResidual {
    static constexpr bool PERM = true, AFTER_DRAIN = false;
    bf16_t* HL; bf16_t* HB; float* ss_out; float* out; int out_rows; float scale;
    __device__ __forceinline__ void operator()(const f32x4 (&acc)[2][2][4][2], const Unit& u, int wr, int wc, int fr, int fq) const {
        const int row0 = u.pm * BM + wr * 64 + fr, col0 = u.pn * BM + wc * 32 + 8 * fq;
#pragma unroll
        for (int ai = 0; ai < 2; ++ai)
#pragma unroll
            for (int m = 0; m < 4; ++m) { const int row = row0 + ai * HALF + m * 16; float sq = 0.f;
#pragma unroll
                for (int bj = 0; bj < 2; ++bj) { const size_t off = (size_t)row * 2048 + col0 + bj * HALF;
                    const u32x4 hi = *(const u32x4*)(HB + off), lo = *(const u32x4*)(HL + off);
                    f32x4 h0 = (f32x4){bflo(hi.x) + bflo(lo.x), bfhi(hi.x) + bfhi(lo.x), bflo(hi.y) + bflo(lo.y), bfhi(hi.y) + bfhi(lo.y)};
                    f32x4 h1 = (f32x4){bflo(hi.z) + bflo(lo.z), bfhi(hi.z) + bfhi(lo.z), bflo(hi.w) + bflo(lo.w), bfhi(hi.w) + bfhi(lo.w)};
                    h0 = h0 + acc[ai][bj][m][0] * scale; h1 = h1 + acc[ai][bj][m][1] * scale;
                    if (out && row < out_rows) { *(f32x4*)(out + off) = h0; *(f32x4*)(out + off + 4) = h1; }
                    u32x4 w; w.x = cvt_pk_bf16(h0[0], h0[1]); w.y = cvt_pk_bf16(h0[2], h0[3]); w.z = cvt_pk_bf16(h1[0], h1[1]); w.w = cvt_pk_bf16(h1[2], h1[3]);
                    u32x4 l2; l2.x = cvt_pk_bf16(h0[0] - bflo(w.x), h0[1] - bfhi(w.x)); l2.y = cvt_pk_bf16(h0[2] - bflo(w.y), h0[3] - bfhi(w.y)); l2.z = cvt_pk_bf16(h1[0] - bflo(w.z), h1[1] - bfhi(w.z)); l2.w = cvt_pk_bf16(h1[2] - bflo(w.w), h1[3] - bfhi(w.w));
                    *(u32x4*)(HB + off) = w; *(u32x4*)(HL + off) = l2;
                    sq += (h0[0] * h0[0] + h0[1] * h0[1]) + (h0[2] * h0[2] + h0[3] * h0[3]) + (h1[0] * h1[0] + h1[1] * h1[1]) + (h1[2] * h1[2] + h1[3] * h1[3]); }
                sq += __shfl_xor(sq, 16); sq += __shfl_xor(sq, 32);
                if (fq == 0 && ss_out) __hip_atomic_fetch_add(ss_out + (size_t)row * 32 + u.pn * 4 + wc, sq, __ATOMIC_RELAXED, __HIP_MEMORY_SCOPE_AGENT); }
    }
};
}
#define XB_TMO      128
#define XB_XCNT(j)  (256  + 64 * (j))
#define XB_XSUB(j)  (1280 + 64 * (j))
#define XB_XGEN(j)  (2304 + 64 * (j))
#define XB_TOP      3328
#define XB_TOPGEN   3392
#define XCD_BAR_WORDS 3456
#define XB_SPIN_CAP (1u << 18)

__device__ __forceinline__ unsigned xb_ld(unsigned* p)              { return __hip_atomic_load(p, __ATOMIC_RELAXED, __HIP_MEMORY_SCOPE_AGENT); }
__device__ __forceinline__ unsigned xb_add(unsigned* p, unsigned v) { return __hip_atomic_fetch_add(p, v, __ATOMIC_RELAXED, __HIP_MEMORY_SCOPE_AGENT); }
__device__ __forceinline__ unsigned xb_xcc_id() { return (unsigned)__builtin_amdgcn_s_getreg((3 << 11) | 20) & 0xFu; }
#define XB_SPIN(cond, bar) do { unsigned _sp = 0; while (cond) { __builtin_amdgcn_s_sleep(1); \
    if ((++_sp & 255u) == 0u) { if (xb_ld(&(bar)[XB_TMO])) break; if (_sp > XB_SPIN_CAP) { atomicAdd(&(bar)[XB_TMO], 1u); break; } } } } while (0)

struct XcdBarrier {
    unsigned* bar; unsigned x;
    volatile LAS unsigned* st;
};

__device__ __forceinline__ XcdBarrier xcd_barrier_post(unsigned* bar, volatile LAS unsigned* st, int wv) {
    XcdBarrier b; b.bar = bar; b.x = xb_xcc_id(); b.st = st;
    if ((wv == 0 && lane_id() == 0)) (void)xb_add(&bar[XB_XCNT(b.x)], 1u);
    return b;
}
__device__ __forceinline__ void xcd_barrier_complete(unsigned* bar, unsigned x, unsigned& nloc, unsigned& nx) {
    const unsigned G = gridDim.x * gridDim.y * gridDim.z;
    unsigned sum, cnt, mine, sp = 0u;
    for (;;) {
        sum = 0u; cnt = 0u; mine = 0u;
#pragma unroll
        for (unsigned j = 0; j < 16; ++j) { const unsigned c = xb_ld(&bar[XB_XCNT(j)]); sum += c; cnt += (c > 0u) ? 1u : 0u; mine = (j == x) ? c : mine; }
        if (sum == G) break;
        __builtin_amdgcn_s_sleep(1);
        if ((++sp & 255u) == 0u) { if (xb_ld(&bar[XB_TMO])) break; if (sp > XB_SPIN_CAP) { atomicAdd(&bar[XB_TMO], 1u); break; } }
    }
    nloc = mine > 0u ? mine : 1u; nx = cnt > 0u ? cnt : 1u;
}

__device__ __forceinline__ void xcd_barrier(const XcdBarrier& b, int wv) {
    asm volatile("s_waitcnt vmcnt(0)" ::: "memory");
    __syncthreads();
    if ((wv == 0 && lane_id() == 0)) {
        unsigned* bar = b.bar;
        __builtin_amdgcn_s_waitcnt(0);
        unsigned nloc = b.st[0], nx = b.st[1];
        if (nloc == 0u) { xcd_barrier_complete(bar, b.x, nloc, nx); b.st[0] = nloc; b.st[1] = nx; }
        const unsigned old = xb_add(&bar[XB_XSUB(b.x)], 1u);
        const unsigned gen = old / nloc;
        if (old + 1u == (gen + 1u) * nloc) {
            __builtin_amdgcn_fence(__ATOMIC_RELEASE, "agent");
            asm volatile("s_waitcnt vmcnt(0)" ::: "memory");
            const unsigned og = xb_add(&bar[XB_TOP], 1u);
            const unsigned tg = og / nx;
            if (og + 1u == (tg + 1u) * nx) xb_add(&bar[XB_TOPGEN], 1u);
            else XB_SPIN(xb_ld(&bar[XB_TOPGEN]) == tg, bar);
            __builtin_amdgcn_fence(__ATOMIC_ACQUIRE, "agent");
            xb_add(&bar[XB_XGEN(b.x)], 1u);
            asm volatile("s_waitcnt vmcnt(0)" ::: "memory");
        } else {
            XB_SPIN(xb_ld(&bar[XB_XGEN(b.x)]) == gen, bar);
            __builtin_amdgcn_fence(__ATOMIC_ACQUIRE, "agent");
            asm volatile("s_waitcnt vmcnt(0)" ::: "memory");
        }
    }
    __syncthreads();
}

struct P { const float* in[36]; float* out; unsigned char* ws; int ph_lo, ph_hi; };
enum { I_X = 0, I_META, I_F1N, I_F1G, I_F1U, I_F1D, I_MIXN, I_WIN, I_WOUT, I_QN, I_WQ, I_KVN, I_WKV, I_QKNQ, I_QKNK, I_CONVW, I_CONVB, I_DTB, I_ALOG, I_SSDD, I_SSDN, I_RETN,
       I_MU, I_W0, I_W2, I_A0, I_A2, I_G2, I_KK, I_KA, I_RK, I_LN, I_F2N, I_F2G, I_F2U, I_F2D };
#define CAS __attribute__((address_space(4)))
typedef const CAS P* KPtr;
struct Ctx { LAS unsigned char* lds; unsigned char* ws; KPtr kp; int tid, lane, wave, G, bid; };
__device__ __forceinline__ Ctx ctx_make(LAS unsigned char* lds, int wv) {
    Ctx F; KPtr kp = (KPtr)__builtin_amdgcn_kernarg_segment_ptr(); asm volatile("" : "+s"(kp)); int t = wv * 64 + lane_id(); asm volatile("" : "+v"(t));
    F.lds = lds; F.kp = kp; F.ws = kp->ws; F.tid = t; F.lane = t & 63; F.wave = __builtin_amdgcn_readfirstlane(t >> 6); F.G = gridDim.x; F.bid = blockIdx.x; return F;
}


__device__ __forceinline__ int queue_next(const Ctx& F, unsigned* ctr) {
    volatile LAS unsigned* slot = (volatile LAS unsigned*)(F.lds + LDSCTL_OFF + 64);
    __syncthreads();
    if (F.tid == 0) *slot = __hip_atomic_fetch_add(ctr, 1u, __ATOMIC_RELAXED, __HIP_MEMORY_SCOPE_AGENT);
    __syncthreads();
    return (int)*slot;
}
__device__ __forceinline__ f32x16 zero16() { f32x16 z;
#pragma unroll
    for (int i = 0; i < 16; ++i) z[i] = 0.f; return z; }
__device__ __forceinline__ void mma32(f32x16& acc, const LAS float* Ap, int sAi, int sAk, const LAS float* Bp, int sBk, int sBj, int K, int lane) {
    const int r = lane & 31, hh = lane >> 5;
    const LAS float* a = Ap + r * sAi + hh * sAk; const LAS float* b = Bp + hh * sBk + r * sBj;
#pragma unroll 4
    for (int k = 0; k < K; k += 2) acc = __builtin_amdgcn_mfma_f32_32x32x2f32(a[k * sAk], b[k * sBk], acc, 0, 0, 0);
}
__device__ __forceinline__ void mma32bf(f32x16& acc, const LAS float* Ap, int sAi, const LAS float* Bp, int sBj, int K, int lane) {
    const int r = lane & 31, hh = lane >> 5; const LAS float* a = Ap + r * sAi + 8 * hh; const LAS float* b = Bp + r * sBj + 8 * hh;
#pragma unroll 2
    for (int k = 0; k < K; k += 16) { const f32x4 a0 = *(const LAS f32x4*)(a + k), a1 = *(const LAS f32x4*)(a + k + 4), b0 = *(const LAS f32x4*)(b + k), b1 = *(const LAS f32x4*)(b + k + 4);
        v4u aw, bw; aw.x = cvtpk(a0[0], a0[1]); aw.y = cvtpk(a0[2], a0[3]); aw.z = cvtpk(a1[0], a1[1]); aw.w = cvtpk(a1[2], a1[3]); bw.x = cvtpk(b0[0], b0[1]); bw.y = cvtpk(b0[2], b0[3]); bw.z = cvtpk(b1[0], b1[1]); bw.w = cvtpk(b1[2], b1[3]);
        acc = __builtin_amdgcn_mfma_f32_32x32x16_bf16(__builtin_bit_cast(bf16x8, aw), __builtin_bit_cast(bf16x8, bw), acc, 0, 0, 0); }
}
__device__ __forceinline__ int rreg(int reg, int lane) { return (reg & 3) + 8 * (reg >> 2) + 4 * (lane >> 5); }

__device__ __forceinline__ void cvt_tile(const float* src, int srcN, const float* gain, int valid, bf16* dst, int ldd, LAS float* scr, int lane) {
    const int c4 = lane & 15, r0 = lane >> 4;
    f32x4 v[16];
#pragma unroll
    for (int i = 0; i < 16; ++i) v[i] = (4 * c4 < valid) ? *(const f32x4*)(src + (size_t)(r0 + 4 * i) * srcN + 4 * c4) : (f32x4){0.f, 0.f, 0.f, 0.f};
#pragma unroll
    for (int i = 0; i < 16; ++i) { const int kk = r0 + 4 * i; const float gk = gain ? gain[kk] : 1.0f; LAS float* d = scr + kk * 65 + 4 * c4; d[0] = v[i][0] * gk; d[1] = v[i][1] * gk; d[2] = v[i][2] * gk; d[3] = v[i][3] * gk; }
    LDS_WAIT(); asm volatile("" ::: "memory");
    const int c8 = lane & 7;
#pragma unroll
    for (int j = 0; j < 8; ++j) { const int n = (lane >> 3) + 8 * j; const LAS float* s = scr + (8 * c8) * 65 + n;
        v4u o; o.x = pk2(s[0], s[65]); o.y = pk2(s[130], s[195]); o.z = pk2(s[260], s[325]); o.w = pk2(s[390], s[455]);
        *(v4u*)(dst + (size_t)n * ldd + 8 * c8) = o; }
    LDS_WAIT(); asm volatile("" ::: "memory");
}
__device__ __forceinline__ void convert_layer(const Ctx& F, int L, int gw, int NGW) {
    LAS float* scr = (LAS float*)(F.lds + F.wave * 17408);
    const int lane = F.lane;
    constexpr int IT_GU = 2 * 32 * 176, IT_D = 2 * 88 * 32, IT_IN = 32 * 84, IT_OUT = 32 * 32, IT_MLA = 8 * 28;
    bf16* WGU = (bf16*)(F.ws + O_WGU); bf16* WD = (bf16*)(F.ws + O_WD); bf16* WIN = (bf16*)(F.ws + O_WIN); bf16* WOUT = (bf16*)(F.ws + O_WOUT); bf16* WMLA = (bf16*)(F.ws + O_WMLA);
    const int l = L;
    for (int it = gw; it < IT_GU + IT_D + IT_IN + IT_OUT + IT_MLA; it += NGW) {
        int r = it;
        if (r < IT_GU) { const int which = r / 5632, f = 2 * l + which, q = r % 5632, kb = q / 176, nb = q % 176, n0 = 64 * nb, pn = n0 >> 8, within = n0 & 255, isup = within >= 128, f0 = 128 * pn + (within & 127);
            const float* src = (which ? (isup ? F.kp->in[I_F2U] : F.kp->in[I_F2G]) : (isup ? F.kp->in[I_F1U] : F.kp->in[I_F1G])) + (size_t)l * D * DFF + (size_t)(64 * kb) * DFF + f0;
            const float* gain = (which ? F.kp->in[I_F2N] : F.kp->in[I_F1N]) + l * D + 64 * kb;
            cvt_tile(src, DFF, gain, 64, WGU + (size_t)f * 11264 * 2048 + (size_t)n0 * 2048 + 64 * kb, 2048, scr, lane); continue; }
        r -= IT_GU;
        if (r < IT_D) { const int which = r / 2816, f = 2 * l + which, q = r % 2816, kb = q / 32, nb = q % 32;
            const float* src = (which ? F.kp->in[I_F2D] : F.kp->in[I_F1D]) + (size_t)l * DFF * D + (size_t)(64 * kb) * D + 64 * nb;
            cvt_tile(src, D, nullptr, 64, WD + (size_t)f * 2048 * 5632 + (size_t)(64 * nb) * 5632 + 64 * kb, 5632, scr, lane); continue; }
        r -= IT_D;
        if (r < IT_IN) { const int q = r, kb = q / 84, nb = q % 84, n0 = 64 * nb; int valid = NIN - n0; valid = valid < 0 ? 0 : (valid > 64 ? 64 : valid);
            const float* src = F.kp->in[I_WIN] + (size_t)l * D * NIN + (size_t)(64 * kb) * NIN + n0;
            cvt_tile(src, NIN, F.kp->in[I_MIXN] + l * D + 64 * kb, valid, WIN + (size_t)l * NINP * D + (size_t)n0 * D + 64 * kb, D, scr, lane); continue; }
        r -= IT_IN;
        if (r < IT_OUT) { const int q = r, kb = q / 32, nb = q % 32;
            const float* src = F.kp->in[I_WOUT] + (size_t)l * D * D + (size_t)(64 * kb) * D + 64 * nb;
            cvt_tile(src, D, nullptr, 64, WOUT + (size_t)l * D * D + (size_t)(64 * nb) * D + 64 * kb, D, scr, lane); continue; }
        r -= IT_OUT;
        { const int q = r, kb = q / 28, nb = q % 28, n0 = 64 * nb, k0 = 64 * kb;
            const float* src; int srcN, valid;
            if (n0 < 768) { valid = k0 < 384 ? 64 : 0; src = F.kp->in[I_WQ] + (size_t)l * 384 * 768 + (size_t)k0 * 768 + n0; srcN = 768; }
            else { valid = k0 >= 384 ? 64 : 0; src = F.kp->in[I_WKV] + (size_t)l * 128 * 1024 + (size_t)(k0 - 384) * 1024 + (n0 - 768); srcN = 1024; }
            cvt_tile(src, srcN, nullptr, valid, WMLA + (size_t)l * MLAN * 512 + (size_t)n0 * 512 + k0, 512, scr, lane); }
    }
}
__device__ __forceinline__ void p0_prologue(const Ctx& F, int cvt_only) {
    const int gw = F.bid * NWAVES + F.wave, NGW = F.G * NWAVES, lane = F.lane;
    convert_layer(F, 0, gw, NGW);
    if (cvt_only) return;
    bf16* HL = (bf16*)(F.ws + O_H); bf16* HB = (bf16*)(F.ws + O_HB); float* SS = (float*)(F.ws + O_SS); bf16* Y = (bf16*)(F.ws + O_Y); f32x2* ROPE = (f32x2*)(F.ws + O_ROPE);
    for (int row = gw; row < MP; row += NGW) {
        const float* src = row < SEQ ? F.kp->in[I_X] + (size_t)row * D : F.kp->in[I_META] + (size_t)(row - SEQ) * D;
        float sq = 0.f;
#pragma unroll
        for (int j = 0; j < 8; ++j) { f32x4 v = (f32x4){0.f, 0.f, 0.f, 0.f}; if (row < T) v = *(const f32x4*)(src + 256 * j + 4 * lane);
            v2u w; w.x = cvtpk(v[0], v[1]); w.y = cvtpk(v[2], v[3]); *(v2u*)(HB + (size_t)row * D + 256 * j + 4 * lane) = w;
            v2u lw; lw.x = cvtpk(v[0] - pg8::bflo(w.x), v[1] - pg8::bfhi(w.x)); lw.y = cvtpk(v[2] - pg8::bflo(w.y), v[3] - pg8::bfhi(w.y)); *(v2u*)(HL + (size_t)row * D + 256 * j + 4 * lane) = lw;
            sq += (v[0] * v[0] + v[1] * v[1]) + (v[2] * v[2] + v[3] * v[3]); }
        sq = wave_sum(sq); if (lane == 0) __hip_atomic_fetch_add(SS + (size_t)row * 32, sq, __ATOMIC_RELAXED, __HIP_MEMORY_SCOPE_AGENT);
#ifdef PROBE_ZERO_Y
        if (true) {
#else
        if (row >= T) {
#endif
#pragma unroll
            for (int j = 0; j < 4; ++j) *(v4u*)(Y + (size_t)row * D + 512 * j + 8 * lane) = (v4u){0u, 0u, 0u, 0u}; }
#ifdef PROBE_ZERO_Y
        if (row < T && lane < 32) { const float inv = powf(10000.0f, -(float)lane / 32.0f); const float ang = (float)seq_of_row(row) * inv; float sn, cs; sincosf(ang, &sn, &cs); ROPE[row * 32 + lane] = (f32x2){cs, sn}; }
#else
        else if (lane < 32) { const float inv = powf(10000.0f, -(float)lane / 32.0f); const float ang = (float)seq_of_row(row) * inv; float sn, cs; sincosf(ang, &sn, &cs); ROPE[row * 32 + lane] = (f32x2){cs, sn}; }
#endif
    }
}

__device__ __forceinline__ void m1_unit(const Ctx& F, int l, int r0, int r1, int grp) {
    const int lane = F.lane, tid = F.tid;
    const float* U = (const float*)(F.ws + O_U);
    if (r0 < r1) { bf16* AM = (bf16*)(F.ws + O_AMLA); const float* qn = F.kp->in[I_QN] + l * 384; const float* kvn = F.kp->in[I_KVN] + l * 128;
      const float* gp = lane < 48 ? qn + 8 * lane : kvn + 8 * (lane - 48); const f32x4 g0 = *(const f32x4*)gp, g1 = *(const f32x4*)(gp + 4);
      f32x4 a4[4], b4[4];
#pragma unroll
      for (int i = 0; i < 4; ++i) { const int row = r0 + F.wave + 8 * i; const float* ur = U + (size_t)(row < r1 ? row : r0) * NINP + 8 * lane; a4[i] = *(const f32x4*)ur; b4[i] = *(const f32x4*)(ur + 4); }
#pragma unroll
      for (int i = 0; i < 4; ++i) { const int row = r0 + F.wave + 8 * i; const f32x4 a = a4[i], b = b4[i];
        const float sq = (a[0] * a[0] + a[1] * a[1]) + (a[2] * a[2] + a[3] * a[3]) + (b[0] * b[0] + b[1] * b[1]) + (b[2] * b[2] + b[3] * b[3]);
        const float sq_q = wave_sum(lane < 48 ? sq : 0.f), sq_kv = wave_sum(lane >= 48 ? sq : 0.f);
        const float rs = lane < 48 ? 1.0f / sqrtf(sq_q * (1.0f / 384.0f) + EPS) : 1.0f / sqrtf(sq_kv * (1.0f / 128.0f) + EPS);
        v4u w; w.x = pk2(a[0] * rs * g0[0], a[1] * rs * g0[1]); w.y = pk2(a[2] * rs * g0[2], a[3] * rs * g0[3]); w.z = pk2(b[0] * rs * g1[0], b[1] * rs * g1[1]); w.w = pk2(b[2] * rs * g1[2], b[3] * rs * g1[3]);
        if (row < r1) *(v4u*)(AM + (size_t)row * 512 + 8 * lane) = w; } }
    if (r0 < r1) { float* RQK = (float*)(F.ws + O_RQK); const f32x2* ROPE = (const f32x2*)(F.ws + O_ROPE);
      f32x2 cs[4][4]; float x1[4][4], x2[4][4];
#pragma unroll
      for (int i = 0; i < 4; ++i) { const int row = r0 + F.wave + 8 * i, rc = row < r1 ? row : r0;
#pragma unroll
        for (int j = 0; j < 4; ++j) { const int idx = lane + 64 * j, qk = idx >> 7, hh = (idx >> 5) & 3, i5 = idx & 31; cs[i][j] = ROPE[rc * 32 + i5];
            x1[i][j] = U[(size_t)rc * NINP + U_RET + qk * 256 + hh * 64 + i5]; x2[i][j] = U[(size_t)rc * NINP + U_RET + qk * 256 + hh * 64 + 32 + i5]; } }
#pragma unroll
      for (int i = 0; i < 4; ++i) { const int row = r0 + F.wave + 8 * i; if (row < r1) {
#pragma unroll
        for (int j = 0; j < 4; ++j) { const int idx = lane + 64 * j, qk = idx >> 7, hh = (idx >> 5) & 3, i5 = idx & 31; const float sc = qk ? 0.125f : 1.0f;
            RQK[(size_t)row * 512 + qk * 256 + hh * 64 + i5] = (x1[i][j] * cs[i][j].x - x2[i][j] * cs[i][j].y) * sc; RQK[(size_t)row * 512 + qk * 256 + hh * 64 + 32 + i5] = (x1[i][j] * cs[i][j].y + x2[i][j] * cs[i][j].x) * sc; } } } }
    if (r0 < r1) { float* XBC = (float*)(F.ws + O_XBC); float* DT = (float*)(F.ws + O_DT); float* LA = (float*)(F.ws + O_LA);
      const float* cw = F.kp->in[I_CONVW] + l * 4096; const float* cb = F.kp->in[I_CONVB] + l * 1024;
      int rw[4], p1[4], p2[4], p3[4]; float dtr[4];
#pragma unroll
      for (int i = 0; i < 4; ++i) { const int row = r0 + F.wave + 8 * i; rw[i] = row < r1 ? row : r0; p1[i] = prev_row(rw[i]); p2[i] = p1[i] >= 0 ? prev_row(p1[i]) : -1; p3[i] = p2[i] >= 0 ? prev_row(p2[i]) : -1;
          dtr[i] = U[(size_t)rw[i] * NINP + U_SSD + 1536 + (lane & 7)]; }
#pragma unroll 1
      for (int j = 0; j < 4; ++j) { const int ch = 256 * j + 4 * lane; const size_t uo = U_SSD + 512 + ch; const f32x4 z4 = (f32x4){0.f, 0.f, 0.f, 0.f};
          const f32x4 wb = *(const f32x4*)(cb + ch), w0 = *(const f32x4*)(cw + ch), w1 = *(const f32x4*)(cw + 1024 + ch), w2 = *(const f32x4*)(cw + 2048 + ch), w3 = *(const f32x4*)(cw + 3072 + ch);
          f32x4 x0[4], x1[4], x2[4], x3[4];
#pragma unroll
          for (int i = 0; i < 4; ++i) { x3[i] = *(const f32x4*)(U + (size_t)rw[i] * NINP + uo); x2[i] = p1[i] >= 0 ? *(const f32x4*)(U + (size_t)p1[i] * NINP + uo) : z4;
              x1[i] = p2[i] >= 0 ? *(const f32x4*)(U + (size_t)p2[i] * NINP + uo) : z4; x0[i] = p3[i] >= 0 ? *(const f32x4*)(U + (size_t)p3[i] * NINP + uo) : z4; }
#pragma unroll
          for (int i = 0; i < 4; ++i) { f32x4 o = wb + w0 * x0[i] + w1 * x1[i] + w2 * x2[i] + w3 * x3[i];
              o[0] = siluf_(o[0]); o[1] = siluf_(o[1]); o[2] = siluf_(o[2]); o[3] = siluf_(o[3]);
              if (r0 + F.wave + 8 * i < r1) *(f32x4*)(XBC + (size_t)rw[i] * 1024 + ch) = o; } }
#pragma unroll
      for (int i = 0; i < 4; ++i) if (lane < 8 && r0 + F.wave + 8 * i < r1) { const float dt = softplusf_(dtr[i] + F.kp->in[I_DTB][l * 8 + lane]); DT[rw[i] * 8 + lane] = dt; LA[rw[i] * 8 + lane] = -expf(F.kp->in[I_ALOG][l * 8 + lane]) * dt; } }
    if (grp >= 0) { LAS float* xl = (LAS float*)F.lds; const int hd = F.wave, col = lane & 31;
      float* RW = (float*)(F.ws + O_RW); const size_t AS = (size_t)MP * 512; float* RBON = (float*)(F.ws + O_RBON);
      const float* MU = F.kp->in[I_MU] + l * 1664; const float* W2 = F.kp->in[I_W2] + l * 32 * 512; const float* A2 = F.kp->in[I_A2] + l * 32 * 512; const float* G2 = F.kp->in[I_G2] + l * 64 * 512;
      const int r0 = 32 * grp;
      __syncthreads();
#pragma unroll
      for (int j = 0; j < 8; ++j) { const int idx = tid + 512 * j, tk = idx >> 7, cl = idx & 127, row = r0 + tk; float xs = 0.f;
          if (row < T) { const int pr = prev_row(row); const size_t uc = U_RWKV + 1536 + cl; const float x = U[(size_t)row * NINP + uc], xp = pr >= 0 ? U[(size_t)pr * NINP + uc] : 0.f; xs = x + (xp - x) * MU[1536 + cl];
              if (cl < 32) xs = tanhf(xs); else if (cl >= 64) xs = sigmoidf_(xs); }
          xl[tk * 132 + cl] = xs; }
      __syncthreads();
      float w0c[2], a0c[2], kkc[2], kac[2], rkc[2], muR[2], muK[2], muV[2];
#pragma unroll
      for (int ct = 0; ct < 2; ++ct) { const int ch = 64 * hd + 32 * ct + col; w0c[ct] = F.kp->in[I_W0][l * 512 + ch]; a0c[ct] = F.kp->in[I_A0][l * 512 + ch]; kkc[ct] = F.kp->in[I_KK][l * 512 + ch]; kac[ct] = F.kp->in[I_KA][l * 512 + ch]; rkc[ct] = F.kp->in[I_RK][l * 512 + ch];
          muR[ct] = MU[ch]; muK[ct] = MU[512 + ch]; muV[ct] = MU[1024 + ch]; }
      { constexpr int tb = 0;
          f32x16 aw[2], aa[2], ag[2];
#pragma unroll
          for (int ct = 0; ct < 2; ++ct) { aw[ct] = zero16(); aa[ct] = zero16(); ag[ct] = zero16(); }
          const LAS float* xa = xl + (32 * tb + col) * 132 + (lane >> 5); const int chb = 64 * hd + col, kh = lane >> 5;
#define M1_LORA(ACC, WM, XO, NB) do { _Pragma("unroll") for (int hb_ = 0; hb_ < (NB); ++hb_) { float bq_[16][2], xq_[16]; \
              _Pragma("unroll") for (int t_ = 0; t_ < 16; ++t_) { const float* wb_ = (WM) + 1024 * (16 * hb_ + t_); bq_[t_][0] = wb_[wvo]; bq_[t_][1] = wb_[wvo + 32]; xq_[t_] = xa[(XO) + 2 * (16 * hb_ + t_)]; } \
              _Pragma("unroll") for (int t_ = 0; t_ < 16; ++t_) { ACC[0] = __builtin_amdgcn_mfma_f32_32x32x2f32(xq_[t_], bq_[t_][0], ACC[0], 0, 0, 0); ACC[1] = __builtin_amdgcn_mfma_f32_32x32x2f32(xq_[t_], bq_[t_][1], ACC[1], 0, 0, 0); } } } while (0)
          const unsigned wvo = (unsigned)(kh * 512 + chb);
          M1_LORA(aw, W2, 0, 1); M1_LORA(aa, A2, 32, 1); M1_LORA(ag, G2, 64, 2);
#undef M1_LORA
#pragma unroll
          for (int rb = 0; rb < 16; rb += 4) {
              float uc[4][2][3], upv[4][2][3];
#pragma unroll
              for (int q = 0; q < 4; ++q) { const int row = r0 + 32 * tb + rreg(rb + q, lane), rc = row < T ? row : 0, pr = prev_row(rc);
#pragma unroll
                  for (int ct = 0; ct < 2; ++ct) { const float* ur = U + (size_t)rc * NINP + U_RWKV + chb + 32 * ct; const float* up = U + (size_t)(pr >= 0 ? pr : 0) * NINP + U_RWKV + chb + 32 * ct;
                      uc[q][ct][0] = ur[0]; uc[q][ct][1] = ur[512]; uc[q][ct][2] = ur[1024]; upv[q][ct][0] = pr >= 0 ? up[0] : 0.f; upv[q][ct][1] = pr >= 0 ? up[512] : 0.f; upv[q][ct][2] = pr >= 0 ? up[1024] : 0.f; } }
#pragma unroll
              for (int q = 0; q < 4; ++q) { const int reg = rb + q; const int row = r0 + 32 * tb + rreg(reg, lane); const bool ok = row < T;
                  float rr[2], k2[2], vv[2], kk[2], av[2], dec[2]; float nq = 0.f, bq = 0.f;
#pragma unroll
                  for (int ct = 0; ct < 2; ++ct) { float r = uc[q][ct][0], k = uc[q][ct][1], v = uc[q][ct][2];
                      r += (upv[q][ct][0] - r) * muR[ct]; k += (upv[q][ct][1] - k) * muK[ct]; v += (upv[q][ct][2] - v) * muV[ct];
                      float wr = w0c[ct] + aw[ct][reg]; wr = -softplusf_(-wr) - 0.5f; dec[ct] = expf(-expf(wr));
                      av[ct] = sigmoidf_(a0c[ct] + aa[ct][reg]);
                      kk[ct] = k * kkc[ct]; k2[ct] = k * (1.0f + (av[ct] - 1.0f) * kac[ct]); rr[ct] = r; vv[ct] = v;
                      nq += kk[ct] * kk[ct]; bq += r * k2[ct] * rkc[ct]; }
                  nq = sum32(nq, lane); bq = sum32(bq, lane);
                  const float inrm = 1.0f / fmaxf(sqrtf(nq), 1e-12f);
                  if (ok) {
#pragma unroll
                      for (int ct = 0; ct < 2; ++ct) { const size_t o = (size_t)row * 512 + chb + 32 * ct; const float kn = kk[ct] * inrm;
                          RW[o] = rr[ct]; RW[AS + o] = dec[ct]; RW[2 * AS + o] = k2[ct]; RW[3 * AS + o] = vv[ct]; RW[4 * AS + o] = -kn; RW[5 * AS + o] = kn * av[ct]; RW[6 * AS + o] = ag[ct][reg]; }
                      if (col == 0) RBON[row * 8 + hd] = bq; } } }
      } }
}
__device__ __forceinline__ void m1_phase(const Ctx& F, int l, int qi = 1) {
    unsigned* ctr = (unsigned*)(F.ws + O_CTL) + CW_QUEUE + 64 * (4 * l + qi);
    constexpr int NG = (T + 31) / 32, NR = (T + 31) / 32;
    for (;;) { const int u = queue_next(F, ctr); if (u >= NG + NR) break;
        if (u < NG) m1_unit(F, l, 0, 0, u); else { const int r0 = 32 * (u - NG); m1_unit(F, l, r0, r0 + 32 < T ? r0 + 32 : T, -1); } }
}
constexpr int RWC = 64, NRC = (T + RWC - 1) / RWC;
__device__ __forceinline__ void rwkv_chunk_unit(const Ctx& F, int c, int h) {
    LAS float* BH = (LAS float*)F.lds; LAS float* KH = BH + 4160; LAS float* NX = KH + 4160; LAS float* RTT = NX + 4160;
    LAS float* AP = RTT + 4160; LAS float* BZ = AP + 4352; LAS float* Pm = BZ + 4160; LAS float* Qm = Pm + 4160; LAS float* Ge = Qm + 4160; LAS float* segt = Ge + 64;
    const float* RW = (const float*)(F.ws + O_RW); const size_t AS = (size_t)MP * 512; float* MATS = (float*)(F.ws + O_MATS) + (size_t)(c * 8 + h) * 16384;
    int tid = F.tid, w = F.wave; asm volatile("" : "+v"(tid), "+s"(w));
    const int lane = tid & 63, seg = tid >> 6, k = tid & 63;
    __syncthreads();
    { float p[8];
#pragma unroll
      for (int i = 0; i < 8; ++i) { const int s = RWC * c + 8 * seg + i; const float wv = s < T ? RW[AS + (size_t)row_of_seq(s) * 512 + 64 * h + k] : 1.0f; p[i] = wv; }
      float nkv[8], rv[8], bv[8], kkv[8];
#pragma unroll
      for (int i = 0; i < 8; ++i) { const int s = RWC * c + 8 * seg + i; nkv[i] = 0.f; rv[i] = 0.f; bv[i] = 0.f; kkv[i] = 0.f;
          if (s < T) { const size_t o = (size_t)row_of_seq(s) * 512 + 64 * h + k; rv[i] = RW[o]; kkv[i] = RW[2 * AS + o]; nkv[i] = RW[4 * AS + o]; bv[i] = RW[5 * AS + o]; } }
#pragma unroll
      for (int i = 1; i < 8; ++i) p[i] *= p[i - 1];
      segt[seg * 64 + k] = p[7];
      __syncthreads();
      float pre = 1.0f, tot = 1.0f;
#pragma unroll
      for (int q = 0; q < 8; ++q) { const float t = segt[q * 64 + k]; if (q < seg) pre *= t; tot *= t; }
      if (seg == 0) Ge[k] = tot;
#pragma unroll
      for (int i = 0; i < 8; ++i) { const int il = 8 * seg + i, s = RWC * c + il; const float G = pre * p[i], Gm1 = i ? pre * p[i - 1] : pre;
          const float nk = nkv[i], r = rv[i], b = bv[i], kk = kkv[i];
          const float ig = 1.0f / G;
          NX[k * 65 + il] = nk * Gm1; RTT[k * 65 + il] = r * G; BH[il * 65 + k] = b * ig; KH[il * 65 + k] = kk * ig; } }
    __syncthreads();
#define RW_PROD_TILE(PROD, TR, TC) do { const int prod_ = (PROD), tr_ = (TR), tc_ = (TC); f32x16 acc = zero16(); \
        if (tr_ <= tc_) mma32(acc, ((prod_ & 1) ? KH : BH) + 32 * tr_ * 65, 65, 1, ((prod_ < 2) ? NX : RTT) + 32 * tc_, 65, 1, 64, lane); \
        _Pragma("unroll") for (int r = 0; r < 16; ++r) { const int j = 32 * tr_ + rreg(r, lane), i = 32 * tc_ + (lane & 31); const float v = acc[r]; \
            if (prod_ == 0) AP[j * 68 + i] = j < i ? v : 0.f; else if (prod_ == 1) BZ[j * 65 + i] = j < i ? v : 0.f; else if (prod_ == 2) Pm[j * 65 + i] = j <= i ? v : 0.f; else Qm[j * 65 + i] = j <= i ? v : 0.f; } } while (0)
    RW_PROD_TILE(w >> 2, (w >> 1) & 1, w & 1);
    __syncthreads();
    if (w >= 6) { RW_PROD_TILE(3, w - 6, 0); RW_PROD_TILE(3, w - 6, 1); }
    else if (w >= 2) { RW_PROD_TILE(2, (w - 2) >> 1, (w - 2) & 1); }
    else { LAS float* Yr = (w == 0 ? NX : BZ) + lane * 65;
        for (int ib = 0; ib < 4; ++ib) { float a[16];
#pragma unroll
            for (int ii = 0; ii < 16; ++ii) a[ii] = Yr[16 * ib + ii];
#pragma unroll 4
            for (int j = 0; j < 16 * ib; ++j) { const float y = Yr[j]; const LAS float* ap = AP + j * 68 + 16 * ib;
                const f32x4 a0 = *(const LAS f32x4*)ap, a1 = *(const LAS f32x4*)(ap + 4), a2 = *(const LAS f32x4*)(ap + 8), a3 = *(const LAS f32x4*)(ap + 12);
#pragma unroll
                for (int q = 0; q < 4; ++q) { a[q] += y * a0[q]; a[4 + q] += y * a1[q]; a[8 + q] += y * a2[q]; a[12 + q] += y * a3[q]; } }
#pragma unroll
            for (int ii = 1; ii < 16; ++ii)
#pragma unroll
                for (int jj = 0; jj < ii; ++jj) a[ii] += a[jj] * AP[(16 * ib + jj) * 68 + 16 * ib + ii];
#pragma unroll
            for (int ii = 0; ii < 16; ++ii) Yr[16 * ib + ii] = a[ii]; } }
#undef RW_PROD_TILE
    __syncthreads();
    { const int rb = w >> 1;
#pragma unroll
      for (int t = 0; t < 2; ++t) { const int cb = 2 * (w & 1) + t; f32x16 acc = zero16();
          mma32(acc, (rb < 2 ? NX : BZ) + 32 * (rb & 1) * 65, 65, 1, (cb < 2 ? BH : Pm) + 32 * (cb & 1), 65, 1, 64, lane);
          float* dst = MATS + (rb < 2 ? (cb < 2 ? 0 : 8192) : (cb < 2 ? 4096 : 12288));
#pragma unroll
          for (int r = 0; r < 16; ++r) { const int row = 32 * (rb & 1) + rreg(r, lane), col = 32 * (cb & 1) + (lane & 31); float v = acc[r];
              if (rb < 2 && cb < 2) v = (v + (row == col ? 1.0f : 0.0f)) * Ge[col]; else if (rb < 2) v += RTT[row * 65 + col]; else if (cb < 2) v = (v + KH[row * 65 + col]) * Ge[col]; else v += Qm[row * 65 + col];
              dst[row * 64 + col] = v; } } }
}
template <int SV = 0>
__device__ __forceinline__ void rwkv_state_scan(const Ctx& F, int h, int rg) {
    LAS float* Sx = (LAS float*)F.lds; LAS float* tmp = Sx + 1056; LAS float* ring = tmp + 1024;
    const float* RW = (const float*)(F.ws + O_RW); const size_t AS = (size_t)MP * 512; const float* MATS = (const float*)(F.ws + O_MATS); float* SST8 = (float*)(F.ws + (SV ? O_QKV : O_SSTATE));
    const float* ZERO = (const float*)((const bf16*)(F.ws + O_H) + (size_t)8300 * D);
    const int tid = F.tid, lane = F.lane, w = F.wave, fr = lane & 15, kq = lane >> 4, role = w >> 2, cbk = w & 3;
#define RW_DMA(cn) do { const int cc_ = (cn) < NRC ? (cn) : NRC - 1; const float* mp_ = MATS + (size_t)(cc_ * 8 + h) * 16384; LAS float* sl_ = ring + ((cn) % 3) * 9216; \
        _Pragma("unroll") for (int q_ = 0; q_ < 2; ++q_) { const int ch_ = w + 8 * q_; \
            __builtin_amdgcn_global_load_lds((const unsigned*)(mp_ + ch_ * 256 + lane * 4), (LAS unsigned*)(sl_ + ch_ * 256), 16, 0, 0); \
            __builtin_amdgcn_global_load_lds((const unsigned*)(mp_ + 4096 + ch_ * 256 + lane * 4), (LAS unsigned*)(sl_ + 4096 + ch_ * 256), 16, 0, 0); \
            const int j_ = 4 * ch_ + kq, s_ = RWC * cc_ + j_; const float* vp_ = s_ < T ? RW + 3 * AS + (size_t)row_of_seq(s_) * 512 + 64 * h + 16 * rg + fr : ZERO + fr; \
            __builtin_amdgcn_global_load_lds((const unsigned*)vp_, (LAS unsigned*)(sl_ + 8192 + ch_ * 64), 4, 0, 0); } } while (0)
    __syncthreads();
    for (int i = tid; i < 1056; i += NTHR) Sx[i] = 0.f;
    RW_DMA(0); RW_DMA(1);
    asm volatile("s_waitcnt vmcnt(0)" ::: "memory");
    __syncthreads();
    for (int c = 0; c < NRC; ++c) {
        if (SV != 1) RW_DMA(c + 2);
        { const int idx = 2 * tid, v = idx >> 6, kk = idx & 63; const f32x2 sv = (f32x2){Sx[v * 66 + kk], Sx[v * 66 + kk + 1]}; *(f32x2*)(SST8 + ((size_t)(c * 8 + h) * 64 + 16 * rg + v) * 64 + kk) = sv; }
        const LAS float* sl = ring + (c % 3) * 9216;
        float av[16], bv[16]; f32x4 acc = (f32x4){0.f, 0.f, 0.f, 0.f}, acc2 = acc;
        if (role == 0) { const LAS float* mb = sl + 16 * cbk + fr;
#pragma unroll
            for (int t = 0; t < 16; ++t) { av[t] = Sx[fr * 66 + 4 * t + kq]; bv[t] = mb[(4 * t + kq) * 64]; }
        } else { const LAS float* wb = sl + 4096 + 16 * cbk + fr; const LAS float* vt = sl + 8192 + fr;
#pragma unroll
            for (int t = 0; t < 16; ++t) { av[t] = vt[(4 * t + kq) * 16]; bv[t] = wb[(4 * t + kq) * 64]; } }
#pragma unroll
        for (int t = 0; t < (SV == 2 ? 2 : 16); t += 2) { acc = __builtin_amdgcn_mfma_f32_16x16x4f32(av[t], bv[t], acc, 0, 0, 0); acc2 = __builtin_amdgcn_mfma_f32_16x16x4f32(av[t + 1], bv[t + 1], acc2, 0, 0, 0); }
        acc = acc + acc2;
        if (role != 0) *(LAS f32x4*)(tmp + (cbk * 64 + lane) * 4) = acc;
        LBAR();
        if (role == 0) { acc = acc + *(const LAS f32x4*)(tmp + (cbk * 64 + lane) * 4);
#pragma unroll
            for (int r = 0; r < 4; ++r) Sx[(4 * kq + r) * 66 + 16 * cbk + fr] = acc[r]; }
        if (SV != 1) asm volatile("s_waitcnt vmcnt(8)" ::: "memory");
        LBAR();
    }
    asm volatile("s_waitcnt vmcnt(0)" ::: "memory");
#undef RW_DMA
}
__device__ __forceinline__ void rwkv_out_unit(const Ctx& F, int l, int c, int h) {
    LAS float* S_ = (LAS float*)F.lds; LAS float* E_ = S_ + 4160; LAS float* VT_ = E_ + 4096; LAS float* F_ = VT_ + 4096; LAS float* O_ = F_ + 4096;
    const float* RW = (const float*)(F.ws + O_RW); const size_t AS = (size_t)MP * 512; const float* MATS = (const float*)(F.ws + O_MATS) + (size_t)(c * 8 + h) * 16384;
    const float* SST8 = (const float*)(F.ws + O_SSTATE) + (size_t)(c * 8 + h) * 4096; const float* RBON = (const float*)(F.ws + O_RBON); bf16* Y = (bf16*)(F.ws + O_Y);
    int tid = F.tid, w = F.wave; asm volatile("" : "+v"(tid), "+s"(w)); const int lane = tid & 63;
    const f32x4 z4 = (f32x4){0.f, 0.f, 0.f, 0.f};
    f32x4 sv[2], ev[2], fv[2], tv[2];
#pragma unroll
    for (int q = 0; q < 2; ++q) { const int idx = tid + 512 * q, r = idx >> 4, c4 = idx & 15, s = RWC * c + r;
        sv[q] = *(const f32x4*)(SST8 + r * 64 + 4 * c4); ev[q] = *(const f32x4*)(MATS + 8192 + 4 * idx); fv[q] = *(const f32x4*)(MATS + 12288 + 4 * idx);
        tv[q] = s < T ? *(const f32x4*)(RW + 3 * AS + (size_t)row_of_seq(s) * 512 + 64 * h + 4 * c4) : z4; }
    const int li = tid >> 3, part = tid & 7, ls = RWC * c + li, lrow = ls < T ? row_of_seq(ls) : 0; const size_t lo = (size_t)lrow * 512 + 64 * h + 8 * part;
    f32x4 v0 = z4, v1 = z4, g0 = z4, g1 = z4; float bon = 0.f;
    if (ls < T) { v0 = *(const f32x4*)(RW + 3 * AS + lo); v1 = *(const f32x4*)(RW + 3 * AS + lo + 4); g0 = *(const f32x4*)(RW + 6 * AS + lo); g1 = *(const f32x4*)(RW + 6 * AS + lo + 4); bon = RBON[lrow * 8 + h]; }
    __syncthreads();
#pragma unroll
    for (int q = 0; q < 2; ++q) { const int idx = tid + 512 * q, r = idx >> 4, c4 = idx & 15;
        LAS float* d = S_ + r * 65 + 4 * c4; d[0] = sv[q][0]; d[1] = sv[q][1]; d[2] = sv[q][2]; d[3] = sv[q][3];
        *(LAS f32x4*)(E_ + 4 * idx) = ev[q]; *(LAS f32x4*)(F_ + 4 * idx) = fv[q]; *(LAS f32x4*)(VT_ + r * 64 + 4 * c4) = tv[q]; }
    LBAR();
    const int tr = (w >> 1) & 1, tc = w & 1; f32x16 acc = zero16();
    if (w < 4) mma32(acc, S_ + 32 * tr * 65, 65, 1, E_ + 32 * tc, 64, 1, 64, lane);
    else { mma32(acc, VT_ + 32 * tr, 1, 64, F_ + 32 * tc, 64, 1, 64, lane);
#pragma unroll
        for (int r = 0; r < 16; ++r) O_[(32 * tr + rreg(r, lane)) * 65 + 32 * tc + (lane & 31)] = acc[r]; }
    LBAR();
    if (w < 4) {
#pragma unroll
        for (int r = 0; r < 16; ++r) O_[(32 * tr + rreg(r, lane)) * 65 + 32 * tc + (lane & 31)] += acc[r]; }
    LBAR();
    { float x[8]; float sm = 0.f;
#pragma unroll
      for (int q = 0; q < 8; ++q) { x[q] = O_[(8 * part + q) * 65 + li]; sm += x[q]; }
      sm = sum8(sm);
      const float mu = sm * (1.0f / 64.0f); float vq = 0.f;
#pragma unroll
      for (int q = 0; q < 8; ++q) { const float d = x[q] - mu; vq += d * d; }
      vq = sum8(vq);
      const float rstd = 1.0f / sqrtf(vq * (1.0f / 64.0f) + 64e-5f);
      if (ls < T) { const float* lng = F.kp->in[I_LN] + l * 512 + 64 * h + 8 * part;
          float ov[8];
#pragma unroll
          for (int q = 0; q < 4; ++q) { ov[q] = ((x[q] - mu) * rstd * lng[q] + bon * v0[q]) * g0[q]; ov[4 + q] = ((x[4 + q] - mu) * rstd * lng[4 + q] + bon * v1[q]) * g1[q]; }
          v4u wv; wv.x = cvtpk(ov[0], ov[1]); wv.y = cvtpk(ov[2], ov[3]); wv.z = cvtpk(ov[4], ov[5]); wv.w = cvtpk(ov[6], ov[7]);
          *(v4u*)(Y + (size_t)lrow * D + 1536 + 64 * h + 8 * part) = wv; } }
}
__device__ __forceinline__ void ssd_states_unit(const Ctx& F, int c, int h) {
    LAS float* Bm = (LAS float*)F.lds; LAS float* XD = Bm + 16384; LAS float* csl = XD + 8192; LAS float* lal = csl + 128; LAS float* dtl = lal + 128;
    const float* XBC = (const float*)(F.ws + O_XBC); const float* DT = (const float*)(F.ws + O_DT); const float* LA = (const float*)(F.ws + O_LA);
    float* SST = (float*)(F.ws + O_SST); float* SDEC = (float*)(F.ws + O_SDEC);
    const int tid = F.tid, lane = F.lane, w = F.wave, g = h >> 2;
    __syncthreads();
    if (tid < 128) { const int row = crow(c, tid); lal[tid] = row >= 0 ? LA[row * 8 + h] : 0.f; dtl[tid] = row >= 0 ? DT[row * 8 + h] : 0.f; }
    __syncthreads();
    if (tid < 64) { const float e0 = lal[2 * tid], e1 = lal[2 * tid + 1]; float s = e0 + e1;
#pragma unroll
        for (int o = 1; o < 64; o <<= 1) { const float t = __shfl_up(s, o); if (tid >= o) s += t; }
        csl[2 * tid + 1] = s; csl[2 * tid] = s - e1; }
    __syncthreads();
    const float cs_end = csl[127];
#pragma unroll
    for (int k = 0; k < 8; ++k) { const int idx = tid + 512 * k, j = idx >> 5, c4 = idx & 31, row = crow(c, j);
        const f32x4 v = row >= 0 ? *(const f32x4*)(XBC + (size_t)row * 1024 + 512 + 128 * g + 4 * c4) : (f32x4){0.f, 0.f, 0.f, 0.f};
        *(LAS f32x4*)(Bm + j * 128 + 4 * c4) = v; }
#pragma unroll
    for (int k = 0; k < 4; ++k) { const int idx = tid + 512 * k, j = idx >> 4, c4 = idx & 15, row = crow(c, j);
        f32x4 v = row >= 0 ? *(const f32x4*)(XBC + (size_t)row * 1024 + 64 * h + 4 * c4) : (f32x4){0.f, 0.f, 0.f, 0.f};
        v = v * (dtl[j] * expf(cs_end - csl[j]));
        *(LAS f32x4*)(XD + j * 64 + 4 * c4) = v; }
    __syncthreads();
    const int tr = w >> 2, tc = w & 3;
    f32x16 acc = zero16();
    mma32(acc, XD + 32 * tr, 1, 64, Bm + 32 * tc, 128, 1, 128, lane);
    float* dst = SST + ((size_t)(c * 8 + h) * 64 + 32 * tr) * 128 + 32 * tc + (lane & 31);
#pragma unroll
    for (int r = 0; r < 16; ++r) dst[(size_t)rreg(r, lane) * 128] = acc[r];
    if (tid == 0) SDEC[(c * 8 + h) * 32] = expf(cs_end);
}
__device__ __forceinline__ float ret_logg(int h) { return logf(1.0f - exp2f(-5.0f - (float)h)); }
__device__ __forceinline__ void ret_states_unit(const Ctx& F, int c, int h) {
    LAS float* V = (LAS float*)F.lds; LAS float* KD = V + 16384;
    const float* U = (const float*)(F.ws + O_U); const float* RQK = (const float*)(F.ws + O_RQK); float* RST = (float*)(F.ws + O_RST);
    const int tid = F.tid, lane = F.lane, w = F.wave; const float lg = ret_logg(h);
    __syncthreads();
#pragma unroll
    for (int k = 0; k < 8; ++k) { const int idx = tid + 512 * k, j = idx >> 5, c4 = idx & 31, row = crow(c, j);
        const f32x4 v = row >= 0 ? *(const f32x4*)(U + (size_t)row * NINP + U_RET + 512 + 128 * h + 4 * c4) : (f32x4){0.f, 0.f, 0.f, 0.f};
        *(LAS f32x4*)(V + j * 128 + 4 * c4) = v; }
#pragma unroll
    for (int k = 0; k < 4; ++k) { const int idx = tid + 512 * k, j = idx >> 4, c4 = idx & 15, row = crow(c, j);
        f32x4 v = row >= 0 ? *(const f32x4*)(RQK + (size_t)row * 512 + 256 + 64 * h + 4 * c4) : (f32x4){0.f, 0.f, 0.f, 0.f};
        v = v * expf((float)(127 - j) * lg);
        *(LAS f32x4*)(KD + j * 64 + 4 * c4) = v; }
    __syncthreads();
    const int tr = w >> 1, tc = w & 1;
    f32x16 acc = zero16();
    mma32(acc, V + 32 * tr, 1, 128, KD + 32 * tc, 64, 1, 128, lane);
    float* dst = RST + ((size_t)(c * 4 + h) * 128 + 32 * tr) * 64 + 32 * tc + (lane & 31);
#pragma unroll
    for (int r = 0; r < 16; ++r) dst[(size_t)rreg(r, lane) * 64] = acc[r];
}

__device__ __forceinline__ void scan_job(float* base, size_t cstride, const float* dec, int decstride, float constdec) {
    float s = 0.f; float t[13], d[13];
#pragma unroll
    for (int i = 0; i < 13; ++i) { t[i] = base[(size_t)i * cstride]; d[i] = dec ? dec[i * decstride] : constdec; }
#pragma unroll
    for (int c0 = 0; c0 < NCH; c0 += 13) { float tn[13], dn[13];
        if (c0 + 13 < NCH) {
#pragma unroll
            for (int i = 0; i < 13; ++i) { tn[i] = base[(size_t)(c0 + 13 + i) * cstride]; dn[i] = dec ? dec[(c0 + 13 + i) * decstride] : constdec; } }
#pragma unroll
        for (int i = 0; i < 13; ++i) { base[(size_t)(c0 + i) * cstride] = s; s = d[i] * s + t[i]; }
#pragma unroll
        for (int i = 0; i < 13; ++i) { t[i] = tn[i]; d[i] = dn[i]; } }
}
__device__ __forceinline__ void rwkv_scan(const Ctx& F, int hb) {
    LAS float* st = (LAS float*)F.lds;
    float* RW = (float*)(F.ws + O_RW); const size_t AS = (size_t)MP * 512; float* OUT = RW + 7 * AS;
    const int tid = F.tid, lane = F.lane, rl = lane >> 3, ks = lane & 7, myrow = 8 * F.wave + rl;
    float S[8];
#pragma unroll
    for (int j = 0; j < 8; ++j) S[j] = 0.f;
    for (int s0 = 0; s0 < T; s0 += 32) {
        __syncthreads();
#pragma unroll
        for (int j = 0; j < 6; ++j) { const int idx = tid + 512 * j, stp = idx / 96, rem = idx % 96, arr = rem >> 4, c4 = rem & 15, s = s0 + stp;
            if (s < T) { const int row = row_of_seq(s); const int asel = arr == 0 ? 0 : (arr == 1 ? 1 : (arr == 2 ? 2 : (arr == 3 ? 4 : (arr == 4 ? 5 : 3))));
                *(LAS f32x4*)(st + stp * 384 + arr * 64 + 4 * c4) = *(const f32x4*)(RW + asel * AS + (size_t)row * 512 + 64 * hb + 4 * c4); } }
        __syncthreads();
        const int nst = (T - s0) < 32 ? (T - s0) : 32;
        for (int stp = 0; stp < nst; ++stp) { const LAS float* b = st + stp * 384 + 8 * ks;
            const f32x4 r0 = *(const LAS f32x4*)(b), r1 = *(const LAS f32x4*)(b + 4), w0 = *(const LAS f32x4*)(b + 64), w1 = *(const LAS f32x4*)(b + 68), k0 = *(const LAS f32x4*)(b + 128), k1 = *(const LAS f32x4*)(b + 132),
                        n0 = *(const LAS f32x4*)(b + 192), n1 = *(const LAS f32x4*)(b + 196), b0 = *(const LAS f32x4*)(b + 256), b1 = *(const LAS f32x4*)(b + 260);
            const float vv = st[stp * 384 + 320 + myrow];
            float sa = (S[0] * n0[0] + S[1] * n0[1]) + (S[2] * n0[2] + S[3] * n0[3]) + (S[4] * n1[0] + S[5] * n1[1]) + (S[6] * n1[2] + S[7] * n1[3]);
            sa += __shfl_xor(sa, 1); sa += __shfl_xor(sa, 2); sa += __shfl_xor(sa, 4);
            float o = 0.f;
#pragma unroll
            for (int j = 0; j < 4; ++j) { S[j] = S[j] * w0[j] + sa * b0[j] + vv * k0[j]; o += S[j] * r0[j]; S[4 + j] = S[4 + j] * w1[j] + sa * b1[j] + vv * k1[j]; o += S[4 + j] * r1[j]; }
            o += __shfl_xor(o, 1); o += __shfl_xor(o, 2); o += __shfl_xor(o, 4);
            if (ks == 0) OUT[(size_t)row_of_seq(s0 + stp) * 512 + 64 * hb + myrow] = o; }
    }
}
__device__ __forceinline__ void mla_prep2_unit(const Ctx& F, int l, int un) {
    const float* QKVb = (const float*)(F.ws + O_QKV); const float* U = (const float*)(F.ws + O_U);
    bf16* Q = (bf16*)(F.ws + O_Q); bf16* K = (bf16*)(F.ws + O_K); bf16* VT = (bf16*)(F.ws + O_VT);
    LAS bf16* Vl = (LAS bf16*)F.lds;
    const int lane = F.lane, tid = F.tid;
    const float* gq = F.kp->in[I_QKNQ] + l * 192; const float* gk = F.kp->in[I_QKNK] + l * 192;
    const float gq0 = gq[lane], gq1 = gq[64 + lane], gq2 = gq[128 + lane], gk0 = gk[lane], gk1 = gk[64 + lane], gk2 = gk[128 + lane];
    const float qs = 0.07216878364870322f * 1.4426950408889634f;
    __syncthreads();
#pragma unroll 1
    for (int ib = 0; ib < 8; ib += 4) {
        float xq[4][12], xk[4][8], xv[4][8], kpe[4]; f32x2 cs[4];
#pragma unroll
        for (int p = 0; p < 4; ++p) { const int s = 64 * un + 8 * F.wave + ib + p; const int row = s < T ? row_of_seq(s) : 0; const float* qk = QKVb + (size_t)row * MLAN;
            cs[p] = ((const f32x2*)(F.ws + O_ROPE))[row * 32 + (lane & 31)]; kpe[p] = U[(size_t)row * NINP + 512 + lane];
#pragma unroll
            for (int h = 0; h < 4; ++h) { xq[p][3 * h] = qk[192 * h + lane]; xq[p][3 * h + 1] = qk[192 * h + 64 + lane]; xq[p][3 * h + 2] = qk[192 * h + 128 + lane];
                xk[p][2 * h] = qk[768 + 256 * h + lane]; xk[p][2 * h + 1] = qk[768 + 256 * h + 64 + lane]; xv[p][2 * h] = qk[768 + 256 * h + 128 + lane]; xv[p][2 * h + 1] = qk[768 + 256 * h + 192 + lane]; } }
#pragma unroll
        for (int p = 0; p < 4; ++p) { const int sl = 8 * F.wave + ib + p, s = 64 * un + sl; const bool ok = s < T;
#pragma unroll
            for (int h = 0; h < 4; ++h) {
                { float x0 = xq[p][3 * h], x1 = xq[p][3 * h + 1], x2 = xq[p][3 * h + 2];
                  const float rs = 1.0f / sqrtf(wave_sum(x0 * x0 + x1 * x1 + x2 * x2) * (1.0f / 192.0f) + EPS);
                  x0 *= rs * gq0; x1 *= rs * gq1; x2 *= rs * gq2;
                  const float ot = xor32f(x2, lane); const float rr = lane < 32 ? x2 * cs[p].x - ot * cs[p].y : ot * cs[p].y + x2 * cs[p].x;
                  bf16* qd = Q + ((size_t)s * 4 + h) * 192; qd[lane] = (bf16)f2bf(x0 * qs); qd[64 + lane] = (bf16)f2bf(x1 * qs); qd[128 + lane] = (bf16)f2bf(rr * qs); }
                { float x0 = xk[p][2 * h], x1 = xk[p][2 * h + 1], x2 = kpe[p];
                  const float rs = 1.0f / sqrtf(wave_sum(x0 * x0 + x1 * x1 + x2 * x2) * (1.0f / 192.0f) + EPS);
                  x0 *= rs * gk0; x1 *= rs * gk1; x2 *= rs * gk2;
                  const float ot = xor32f(x2, lane); const float rr = lane < 32 ? x2 * cs[p].x - ot * cs[p].y : ot * cs[p].y + x2 * cs[p].x;
                  bf16* kd = K + ((size_t)s * 4 + h) * 192; kd[lane] = (bf16)f2bf(x0); kd[64 + lane] = (bf16)f2bf(x1); kd[128 + lane] = (bf16)f2bf(rr); }
                Vl[(h * 128 + lane) * 66 + sl] = ok ? (bf16)f2bf(xv[p][2 * h]) : (bf16)0; Vl[(h * 128 + 64 + lane) * 66 + sl] = ok ? (bf16)f2bf(xv[p][2 * h + 1]) : (bf16)0; } }
    }
    __syncthreads();
#pragma unroll
    for (int k = 0; k < 8; ++k) { const int idx = tid + 512 * k, r = idx >> 3, j = idx & 7; const LAS unsigned* src = (const LAS unsigned*)(Vl + r * 66 + 8 * j);
        v4u w; w.x = src[0]; w.y = src[1]; w.z = src[2]; w.w = src[3];
        *(v4u*)(VT + (size_t)r * TSEQ + 64 * un + 8 * j) = w; }
}
__device__ __forceinline__ void m3_phase(const Ctx& F, int l) {
    const int b2 = F.bid, NB = F.G;
    for (int job = b2; job < 192; job += NB) {
        if (job < 128) { if (!EN_SSD) continue; const int e = job * 512 + F.tid, h = e >> 13, rest = e & 8191; scan_job((float*)(F.ws + O_SST) + (size_t)h * 8192 + rest, (size_t)8 * 8192, (const float*)(F.ws + O_SDEC) + h * 32, 8 * 32, 0.f); }
        else { if (!EN_RET) continue; const int e = (job - 128) * 512 + F.tid, h = e >> 13, rest = e & 8191; scan_job((float*)(F.ws + O_RST) + (size_t)h * 8192 + rest, (size_t)4 * 8192, nullptr, 0, expf(128.0f * ret_logg(h))); }
    }
    if (EN_MLA) for (int un = NB - 1 - b2; un < (T + 63) / 64; un += NB) mla_prep2_unit(F, l, un);
}
template <int VAR = 0>
__device__ __forceinline__ void attn_unit(const Ctx& F, int hh, int qb, size_t yoff = O_Y) {
    LAS bf16* L0 = (LAS bf16*)F.lds;
    const bf16* Q = (const bf16*)(F.ws + O_Q); const bf16* K = (const bf16*)(F.ws + O_K); const bf16* VT = (const bf16*)(F.ws + O_VT); bf16* Y = (bf16*)(F.ws + yoff);
    int tid = F.tid, w = F.wave; asm volatile("" : "+v"(tid), "+s"(w));
    const int lane = tid & 63, h = lane >> 5, c = lane & 31, half = w >> 2, wq = w & 3;
    const int sq = 128 * qb + 32 * wq + c;
    bf16x8 qf[12];
#pragma unroll
    for (int ks = 0; ks < 12; ++ks) qf[ks] = *(const bf16x8*)(Q + ((size_t)sq * 4 + hh) * 192 + 16 * ks + 8 * h);
    f32x16 o[4];
#pragma unroll
    for (int t = 0; t < 4; ++t) o[t] = zero16();
    float m = -1e30f, lsum = 0.f;
    const int nst = qb + 1;
    v4u kr[6], vr[4];
    const unsigned kgo = (unsigned)(((tid >> 3) * 4 + hh) * 192 + 8 * (tid & 7)), klo = (unsigned)((tid >> 3) * 200 + 8 * (tid & 7));
    const unsigned vgo = (unsigned)((hh * 128 + (tid >> 2)) * TSEQ + 8 * (tid & 3)), vlo = (unsigned)(12800 + (tid >> 2) * 68 + 8 * (tid & 3));
#define AT_LOADK(st_) do { const bf16* kb_ = K + (size_t)(128 * (st_)) * 768; _Pragma("unroll") for (int j = 0; j < 6; ++j) kr[j] = *(const v4u*)(kb_ + kgo + (j / 3) * 49152 + 64 * (j % 3)); } while (0)
#define AT_LOADV(st_) do { const bf16* vb_ = VT + 128 * (st_); _Pragma("unroll") for (int j = 0; j < 4; ++j) vr[j] = *(const v4u*)(vb_ + vgo + (j >> 1) * 64 + 32 * (j & 1)); } while (0)
#define AT_STOREK() do { _Pragma("unroll") for (int j = 0; j < 6; ++j) *(LAS v4u*)(L0 + klo + (j / 3) * 22016 + 64 * (j % 3)) = kr[j]; } while (0)
#define AT_STOREV() do { _Pragma("unroll") for (int j = 0; j < 4; ++j) { LAS bf16* vd_ = L0 + vlo + (j >> 1) * 22016 + 32 * (j & 1); *(LAS v2u*)vd_ = (v2u){vr[j].x, vr[j].y}; *(LAS v2u*)(vd_ + 4) = (v2u){vr[j].z, vr[j].w}; } } while (0)
    __syncthreads();
    AT_LOADK(0); AT_LOADV(0); AT_STOREK(); AT_STOREV(); if (nst > 1) AT_LOADK(1);
    LBAR();
    const LAS bf16* Ks = L0 + half * 22016; const LAS bf16* Vs = Ks + 12800;
    for (int st = 0; st < nst; ++st) {
        const int kt = 2 * st + half;
        f32x16 sa[2];
#pragma unroll
        for (int t2 = 0; t2 < 2; ++t2) { sa[t2] = zero16();
#pragma unroll
            for (int ks = 0; ks < 12; ++ks) { const bf16x8 a = *(const LAS bf16x8*)(Ks + (32 * t2 + c) * 200 + 16 * ks + 8 * h); sa[t2] = __builtin_amdgcn_mfma_f32_32x32x16_bf16(a, qf[ks], sa[t2], 0, 0, 0); } }
        if (st == nst - 1) {
#pragma unroll
            for (int t2 = 0; t2 < 2; ++t2)
#pragma unroll
                for (int r = 0; r < 16; ++r) { const int key = 64 * kt + 32 * t2 + (r & 3) + 8 * (r >> 2) + 4 * h; if (key > sq) sa[t2][r] = -1e30f; } }
        float mx = -1e30f;
#pragma unroll
        for (int t2 = 0; t2 < 2; ++t2)
#pragma unroll
            for (int r = 0; r < 16; ++r) mx = fmaxf(mx, sa[t2][r]);
        mx = fmaxf(mx, __shfl_xor(mx, 32));
        if (__builtin_amdgcn_ballot_w64(mx > m) != 0ull) { const float mn = fmaxf(m, mx), alpha = __builtin_amdgcn_exp2f(m - mn); m = mn; lsum *= alpha;
#pragma unroll
            for (int t = 0; t < 4; ++t) o[t] = o[t] * alpha; }
        float rs = 0.f;
#pragma unroll
        for (int t2 = 0; t2 < 2; ++t2)
#pragma unroll
            for (int r = 0; r < 16; ++r) { const float pv = __builtin_amdgcn_exp2f(sa[t2][r] - m); sa[t2][r] = pv; rs += pv; }
        rs += __shfl_xor(rs, 32);
        lsum += rs;
        LBAR();
        if (st + 1 < nst) { AT_STOREK(); AT_LOADV(st + 1); }
#pragma unroll
        for (int t2 = 0; t2 < 2; ++t2)
#pragma unroll
            for (int s = 0; s < 2; ++s) { v4u pw; pw.x = cvtpk(sa[t2][8 * s], sa[t2][8 * s + 1]); pw.y = cvtpk(sa[t2][8 * s + 2], sa[t2][8 * s + 3]); pw.z = cvtpk(sa[t2][8 * s + 4], sa[t2][8 * s + 5]); pw.w = cvtpk(sa[t2][8 * s + 6], sa[t2][8 * s + 7]);
                const bf16x8 pf = __builtin_bit_cast(bf16x8, pw);
#pragma unroll
                for (int t = 0; t < 4; ++t) { const LAS bf16* vp = Vs + (32 * t + c) * 68 + 32 * t2 + 16 * s + 4 * h; const v2u lo = *(const LAS v2u*)vp, hi = *(const LAS v2u*)(vp + 8);
                    v4u vw; vw.x = lo.x; vw.y = lo.y; vw.z = hi.x; vw.w = hi.y;
                    o[t] = __builtin_amdgcn_mfma_f32_32x32x16_bf16(__builtin_bit_cast(bf16x8, vw), pf, o[t], 0, 0, 0); } }
        LBAR();
        if (st + 1 < nst) { AT_STOREV(); if (st + 2 < nst) AT_LOADK(st + 2); }
    }
#undef AT_LOADK
#undef AT_LOADV
#undef AT_STOREK
#undef AT_STOREV
    LAS float* MB = (LAS float*)F.lds + (wq * 64 + lane) * 67;
    if (half == 1) { MB[0] = m; MB[1] = lsum;
#pragma unroll
        for (int t = 0; t < 4; ++t)
#pragma unroll
            for (int r = 0; r < 16; ++r) MB[2 + 16 * t + r] = o[t][r]; }
    LBAR();
    if (half == 0) { const float m2 = MB[0], l2 = MB[1], mn = fmaxf(m, m2), a1 = __builtin_amdgcn_exp2f(m - mn), a2 = __builtin_amdgcn_exp2f(m2 - mn);
        const float inv = 1.0f / (lsum * a1 + l2 * a2);
        if (sq < T) { bf16* yr = Y + (size_t)row_of_seq(sq) * D + 128 * hh + 4 * h;
#pragma unroll
            for (int t = 0; t < 4; ++t)
#pragma unroll
                for (int rq = 0; rq < 4; ++rq) { float ov[4];
#pragma unroll
                    for (int i = 0; i < 4; ++i) ov[i] = (o[t][4 * rq + i] * a1 + MB[2 + 16 * t + 4 * rq + i] * a2) * inv;
                    v2u wv; wv.x = cvtpk(ov[0], ov[1]); wv.y = cvtpk(ov[2], ov[3]); *(v2u*)(yr + 32 * t + 8 * rq) = wv; } } }
}
__device__ __forceinline__ void ssd_out_unit(const Ctx& F, int l, int c, int h, int ih) {
    LAS float* CS_ = (LAS float*)F.lds; LAS float* BS_ = CS_ + 4352; LAS float* PS_ = BS_ + 8704; LAS float* SC_ = PS_ + 4352; LAS float* XD_ = SC_ + 8448; LAS float* csl = XD_ + 8448; LAS float* lal = csl + 128; LAS float* dtl = lal + 128;
    LAS float* Y_ = CS_;
    const float* XBC = (const float*)(F.ws + O_XBC); const float* DT = (const float*)(F.ws + O_DT); const float* LA = (const float*)(F.ws + O_LA); const float* U = (const float*)(F.ws + O_U);
    const float* SST = (const float*)(F.ws + O_SST); float* YZ = (float*)(F.ws + O_YZ);
    int tid = F.tid, w = F.wave; asm volatile("" : "+v"(tid), "+s"(w));
    const int lane = tid & 63, g = h >> 2;
    const f32x4 z4 = (f32x4){0.f, 0.f, 0.f, 0.f};
    float lav = 0.f, dtv = 0.f;
    if (tid < 128) { const int row = crow(c, tid); if (row >= 0) { lav = LA[row * 8 + h]; dtv = DT[row * 8 + h]; } }
    f32x4 xdv[4], csv[2][2], bsv[2][4], psv[2][2]; float xsv[8], zv[8];
#pragma unroll
    for (int k = 0; k < 4; ++k) { const int idx = tid + 512 * k, j = idx >> 4, c4 = idx & 15, row = crow(c, j); xdv[k] = row >= 0 ? *(const f32x4*)(XBC + (size_t)row * 1024 + 64 * h + 4 * c4) : z4; }
#pragma unroll
    for (int nh = 0; nh < 2; ++nh) {
#pragma unroll
        for (int k = 0; k < 2; ++k) { const int idx = tid + 512 * k, i = idx >> 4, c4 = idx & 15, row = crow(c, 64 * ih + i); csv[nh][k] = row >= 0 ? *(const f32x4*)(XBC + (size_t)row * 1024 + 768 + 128 * g + 64 * nh + 4 * c4) : z4; }
#pragma unroll
        for (int k = 0; k < 4; ++k) { const int idx = tid + 512 * k, j = idx >> 4, c4 = idx & 15, row = crow(c, j); bsv[nh][k] = row >= 0 ? *(const f32x4*)(XBC + (size_t)row * 1024 + 512 + 128 * g + 64 * nh + 4 * c4) : z4; }
#pragma unroll
        for (int k = 0; k < 2; ++k) { const int idx = tid + 512 * k, pp = idx >> 4, c4 = idx & 15; psv[nh][k] = *(const f32x4*)(SST + ((size_t)(c * 8 + h) * 64 + pp) * 128 + 64 * nh + 4 * c4); } }
#pragma unroll
    for (int k = 0; k < 8; ++k) { const int idx = tid + 512 * k, i = idx >> 6, pp = idx & 63, row = crow(c, 64 * ih + i); xsv[k] = 0.f; zv[k] = 0.f;
        if (row >= 0) { xsv[k] = XBC[(size_t)row * 1024 + 64 * h + pp]; zv[k] = U[(size_t)row * NINP + U_SSD + 64 * h + pp]; } }
    __syncthreads();
    if (tid < 128) { lal[tid] = lav; dtl[tid] = dtv; }
    LBAR();
    if (tid < 64) { const float e0 = lal[2 * tid], e1 = lal[2 * tid + 1]; float s = e0 + e1;
#pragma unroll
        for (int o = 1; o < 64; o <<= 1) { const float t = __shfl_up(s, o); if (tid >= o) s += t; }
        csl[2 * tid + 1] = s; csl[2 * tid] = s - e1; }
#pragma unroll
    for (int k = 0; k < 4; ++k) { const int idx = tid + 512 * k, j = idx >> 4, c4 = idx & 15; const f32x4 v = xdv[k] * dtl[j]; LAS float* d = XD_ + (4 * c4) * 132 + j; d[0] = v[0]; d[132] = v[1]; d[264] = v[2]; d[396] = v[3]; }
    f32x16 acc_s = zero16(), acc_y = zero16();
    const int tr = w >> 2, tc = w & 3, tr2 = (w >> 1) & 1, tc2 = w & 1;
#pragma unroll
    for (int nh = 0; nh < 2; ++nh) {
        if (nh) LBAR();
#pragma unroll
        for (int k = 0; k < 2; ++k) { const int idx = tid + 512 * k, i = idx >> 4, c4 = idx & 15; const f32x4 v = csv[nh][k]; *(LAS f32x4*)(CS_ + i * 68 + 4 * c4) = v; }
#pragma unroll
        for (int k = 0; k < 4; ++k) { const int idx = tid + 512 * k, j = idx >> 4, c4 = idx & 15; const f32x4 v = bsv[nh][k]; *(LAS f32x4*)(BS_ + j * 68 + 4 * c4) = v; }
#pragma unroll
        for (int k = 0; k < 2; ++k) { const int idx = tid + 512 * k, pp = idx >> 4, c4 = idx & 15; const f32x4 v = psv[nh][k]; *(LAS f32x4*)(PS_ + pp * 68 + 4 * c4) = v; }
        LBAR();
        mma32bf(acc_s, CS_ + 32 * tr * 68, 68, BS_ + 32 * tc * 68, 68, 64, lane);
        if (w < 4) mma32bf(acc_y, CS_ + 32 * tr2 * 68, 68, PS_ + 32 * tc2 * 68, 68, 64, lane);
    }
    if (w < 4) {
#pragma unroll
        for (int r = 0; r < 16; ++r) acc_y[r] *= expf(csl[64 * ih + 32 * tr2 + rreg(r, lane)]); }
#pragma unroll
    for (int r = 0; r < 16; ++r) { const int i = 32 * tr + rreg(r, lane), j = 32 * tc + (lane & 31), il = 64 * ih + i;
        SC_[i * 132 + j] = j <= il ? acc_s[r] * expf(csl[il] - csl[j]) : 0.f; }
    LBAR();
    if (w < 4) { mma32bf(acc_y, SC_ + 32 * tr2 * 132, 132, XD_ + 32 * tc2 * 132, 132, 128, lane);
#pragma unroll
        for (int r = 0; r < 16; ++r) Y_[(32 * tr2 + rreg(r, lane)) * 68 + 32 * tc2 + (lane & 31)] = acc_y[r]; }
    LBAR();
    const float Dh = F.kp->in[I_SSDD][l * 8 + h];
#pragma unroll
    for (int k = 0; k < 8; ++k) { const int idx = tid + 512 * k, i = idx >> 6, pp = idx & 63, row = crow(c, 64 * ih + i);
        if (row >= 0) YZ[(size_t)row * 512 + 64 * h + pp] = (Y_[i * 68 + pp] + Dh * xsv[k]) * siluf_(zv[k]); }
}
__device__ __forceinline__ void ret_out_unit(const Ctx& F, int l, int c, int h, int ih) {
    LAS float* Q_ = (LAS float*)F.lds; LAS float* KM_ = Q_ + 4352; LAS float* SC_ = KM_ + 8704; LAS float* VH_ = SC_ + 8448; LAS float* SP_ = KM_; LAS float* Y_ = SC_;
    const float* U = (const float*)(F.ws + O_U); const float* RQK = (const float*)(F.ws + O_RQK); const float* RST = (const float*)(F.ws + O_RST); bf16* Y = (bf16*)(F.ws + O_Y);
    int tid = F.tid, w = F.wave; asm volatile("" : "+v"(tid), "+s"(w));
    const int lane = tid & 63; const float lg = ret_logg(h);
    const f32x4 z4 = (f32x4){0.f, 0.f, 0.f, 0.f};
    f32x4 qv[2], kv[4], spv[4], vv[2][4], gv[4];
#pragma unroll
    for (int k = 0; k < 2; ++k) { const int idx = tid + 512 * k, i = idx >> 4, c4 = idx & 15, row = crow(c, 64 * ih + i); qv[k] = row >= 0 ? *(const f32x4*)(RQK + (size_t)row * 512 + 64 * h + 4 * c4) : z4; }
#pragma unroll
    for (int k = 0; k < 4; ++k) { const int idx = tid + 512 * k, j = idx >> 4, c4 = idx & 15, row = crow(c, j); kv[k] = row >= 0 ? *(const f32x4*)(RQK + (size_t)row * 512 + 256 + 64 * h + 4 * c4) : z4; }
#pragma unroll
    for (int k = 0; k < 4; ++k) { const int idx = tid + 512 * k, vx = idx >> 4, c4 = idx & 15; spv[k] = *(const f32x4*)(RST + ((size_t)(c * 4 + h) * 128 + vx) * 64 + 4 * c4); }
#pragma unroll
    for (int jh = 0; jh < 2; ++jh)
#pragma unroll
        for (int k = 0; k < 4; ++k) { const int idx = tid + 512 * k, j = idx >> 5, c4 = idx & 31, row = crow(c, 64 * jh + j); vv[jh][k] = (jh <= ih && row >= 0) ? *(const f32x4*)(U + (size_t)row * NINP + U_RET + 512 + 128 * h + 4 * c4) : z4; }
    const int li = tid >> 3, part = tid & 7, lrow = crow(c, 64 * ih + li);
#pragma unroll
    for (int k = 0; k < 4; ++k) gv[k] = lrow >= 0 ? *(const f32x4*)(U + (size_t)lrow * NINP + U_RET + 1024 + 128 * h + 16 * part + 4 * k) : z4;
    __syncthreads();
#pragma unroll
    for (int k = 0; k < 2; ++k) { const int idx = tid + 512 * k, i = idx >> 4, c4 = idx & 15; const f32x4 v = qv[k]; *(LAS f32x4*)(Q_ + i * 68 + 4 * c4) = v; }
#pragma unroll
    for (int k = 0; k < 4; ++k) { const int idx = tid + 512 * k, j = idx >> 4, c4 = idx & 15; const f32x4 v = kv[k]; *(LAS f32x4*)(KM_ + j * 68 + 4 * c4) = v; }
    LBAR();
    const int tr = w >> 2, tc = w & 3;
    f32x16 acc_s = zero16();
    mma32bf(acc_s, Q_ + 32 * tr * 68, 68, KM_ + 32 * tc * 68, 68, 64, lane);
    LBAR();
#pragma unroll
    for (int k = 0; k < 4; ++k) { const int idx = tid + 512 * k, vx = idx >> 4, c4 = idx & 15; const f32x4 v = spv[k]; *(LAS f32x4*)(SP_ + vx * 68 + 4 * c4) = v; }
#pragma unroll
    for (int r = 0; r < 16; ++r) { const int i = 32 * tr + rreg(r, lane), j = 32 * tc + (lane & 31), il = 64 * ih + i;
        SC_[i * 132 + j] = j <= il ? acc_s[r] * expf((float)(il - j) * lg) : 0.f; }
#pragma unroll
    for (int k = 0; k < 4; ++k) { const int idx = tid + 512 * k, j = idx >> 5, c4 = idx & 31; const f32x4 v = vv[0][k]; LAS float* d = VH_ + (4 * c4) * 68 + j; d[0] = v[0]; d[68] = v[1]; d[136] = v[2]; d[204] = v[3]; }
    LBAR();
    f32x16 acc_y = zero16();
    mma32bf(acc_y, Q_ + 32 * tr * 68, 68, SP_ + 32 * tc * 68, 68, 64, lane);
#pragma unroll
    for (int r = 0; r < 16; ++r) acc_y[r] *= expf((float)(64 * ih + 32 * tr + rreg(r, lane) + 1) * lg);
    mma32bf(acc_y, SC_ + 32 * tr * 132, 132, VH_ + 32 * tc * 68, 68, 64, lane);
    if (ih) { LBAR();
#pragma unroll
        for (int k = 0; k < 4; ++k) { const int idx = tid + 512 * k, j = idx >> 5, c4 = idx & 31; const f32x4 v = vv[1][k]; LAS float* d = VH_ + (4 * c4) * 68 + j; d[0] = v[0]; d[68] = v[1]; d[136] = v[2]; d[204] = v[3]; }
        LBAR();
        mma32bf(acc_y, SC_ + 32 * tr * 132 + 64, 132, VH_ + 32 * tc * 68, 68, 64, lane); }
    LBAR();
#pragma unroll
    for (int r = 0; r < 16; ++r) Y_[(32 * tr + rreg(r, lane)) * 132 + 32 * tc + (lane & 31)] = acc_y[r];
    LBAR();
    { const LAS float* yr = Y_ + li * 132 + 16 * part;
      float s = 0.f;
#pragma unroll
      for (int k = 0; k < 16; ++k) s += yr[k];
      s = sum8(s);
      const float mu = s * (1.0f / 128.0f); float q = 0.f;
#pragma unroll
      for (int k = 0; k < 16; ++k) { const float d = yr[k] - mu; q += d * d; }
      q = sum8(q);
      const float rstd = 1.0f / sqrtf(q * (1.0f / 128.0f) + EPS);
      if (lrow >= 0) { const float* ng = F.kp->in[I_RETN] + l * 512 + 128 * h + 16 * part; float ov[16];
#pragma unroll
          for (int k = 0; k < 16; ++k) ov[k] = (yr[k] - mu) * rstd * ng[k] * siluf_(gv[k >> 2][k & 3]);
          bf16* yd = Y + (size_t)lrow * D + 1024 + 128 * h + 16 * part;
          v4u w0, w1; w0.x = cvtpk(ov[0], ov[1]); w0.y = cvtpk(ov[2], ov[3]); w0.z = cvtpk(ov[4], ov[5]); w0.w = cvtpk(ov[6], ov[7]); w1.x = cvtpk(ov[8], ov[9]); w1.y = cvtpk(ov[10], ov[11]); w1.z = cvtpk(ov[12], ov[13]); w1.w = cvtpk(ov[14], ov[15]);
          *(v4u*)yd = w0; *(v4u*)(yd + 8) = w1; } }
}
__device__ __forceinline__ void m4_phase(const Ctx& F, int l, int qi = 0, int only = -1) {
    unsigned* ctr = (unsigned*)(F.ws + O_CTL) + CW_QUEUE + 64 * (4 * l + qi);
    constexpr int N_AT = 4 * NCH, N_CV = 128, N_SO = NCH * 16, N_RO = NCH * 8, N_WO = NRC * 8, N_ALL = N_AT + N_CV + N_SO + N_RO + N_WO;
    int u = queue_next(F, ctr);
    while (u < N_AT) { if (only < 0) attn_unit<0>(F, u & 3, (NCH - 1) - (u >> 2)); else if (only == 0) attn_unit<DUP_VAR>(F, u & 3, (NCH - 1) - (u >> 2), O_QKV); u = queue_next(F, ctr); }
    while (u < N_AT + N_CV) { if (l + 1 < DEPTH && only < 0) { __syncthreads(); convert_layer(F, l + 1, (u - N_AT) * NWAVES + F.wave, N_CV * NWAVES); }
        u = queue_next(F, ctr); }
    while (u < N_AT + N_CV + N_SO + N_RO) { int v = u - N_AT - N_CV;
        if (v < N_RO) { const int c = v >> 3, h = (v >> 1) & 3, ih = v & 1; if (!(c == 0 && ih == 0) && (only < 0 || only == 2)) ret_out_unit(F, l, c, h, ih); }
        else { v -= N_RO; const int c = v >> 4, h = (v >> 1) & 7, ih = v & 1; if (!(c == 0 && ih == 0) && (only < 0 || only == 1)) ssd_out_unit(F, l, c, h, ih); }
        u = queue_next(F, ctr); }
    if (u < N_ALL && only < 0) {
        if (F.tid == 0) { unsigned* sflag = (unsigned*)(F.ws + O_CTL) + CW_QUEUE + 64 * (16 + l); const unsigned nscan = F.G >= 64 ? 32u : (unsigned)F.G; unsigned sp = 0;
            while (__hip_atomic_load(sflag, __ATOMIC_RELAXED, __HIP_MEMORY_SCOPE_AGENT) < nscan) { __builtin_amdgcn_s_sleep(8); if (++sp > (1u << 22)) break; }
            __builtin_amdgcn_fence(__ATOMIC_ACQUIRE, "agent"); asm volatile("s_waitcnt vmcnt(0)" ::: "memory"); }
        __syncthreads(); }
    while (u < N_ALL) { const int v = u - (N_AT + N_CV + N_SO + N_RO); if (only < 0 || only == 3) rwkv_out_unit(F, l, v >> 3, v & 7); u = queue_next(F, ctr); }
}
__device__ __forceinline__ void m5_phase(const Ctx& F, int l) {
#ifdef PROBE_DUP
    { const bf16* Y = (const bf16*)(F.ws + O_Y); const bf16* Y2 = (const bf16*)(F.ws + O_YZ); unsigned cnt = 0;
      for (int row = F.bid * NWAVES + F.wave; row < T; row += F.G * NWAVES) for (int j = 0; j < 8; ++j) cnt += Y[(size_t)row * D + 64 * j + F.lane] != Y2[(size_t)row * D + 64 * j + F.lane];
      if (cnt) atomicAdd((unsigned*)(F.ws + O_CTL) + 8, cnt); }
#endif
#ifdef PROBE_COPY_U
    { const float* U = (const float*)(F.ws + O_U); bf16* Y = (bf16*)(F.ws + O_Y);
      for (int row = F.bid * NWAVES + F.wave; row < T; row += F.G * NWAVES)
        for (int j = 0; j < 4; ++j) { const float* ur = U + (size_t)(PROBE_COPY_META ? SEQ + (row & 15) : row) * NINP + PROBE_COPY_U + 512 * j + 8 * F.lane; const f32x4 a = *(const f32x4*)ur, b = *(const f32x4*)(ur + 4);
          v4u w; w.x = pk2(a[0], a[1]); w.y = pk2(a[2], a[3]); w.z = pk2(b[0], b[1]); w.w = pk2(b[2], b[3]); *(v4u*)(Y + (size_t)row * D + 512 * j + 8 * F.lane) = w; } }
#endif
    if (!EN_SSD) return;
    const float* YZ = (const float*)(F.ws + O_YZ); bf16* Y = (bf16*)(F.ws + O_Y); const float* ng = F.kp->in[I_SSDN] + l * 512 + 8 * F.lane;
    for (int row = F.bid * NWAVES + F.wave; row < T; row += F.G * NWAVES) { const float* yr = YZ + (size_t)row * 512 + 8 * F.lane; const f32x4 a = *(const f32x4*)yr, b = *(const f32x4*)(yr + 4);
        const float sq = wave_sum((a[0] * a[0] + a[1] * a[1]) + (a[2] * a[2] + a[3] * a[3]) + (b[0] * b[0] + b[1] * b[1]) + (b[2] * b[2] + b[3] * b[3]));
        const float rs = 1.0f / sqrtf(sq * (1.0f / 512.0f) + EPS); const f32x4 g0 = *(const f32x4*)ng, g1 = *(const f32x4*)(ng + 4);
        v4u w; w.x = pk2(a[0] * rs * g0[0], a[1] * rs * g0[1]); w.y = pk2(a[2] * rs * g0[2], a[3] * rs * g0[3]); w.z = pk2(b[0] * rs * g1[0], b[1] * rs * g1[1]); w.w = pk2(b[2] * rs * g1[2], b[3] * rs * g1[3]);
        *(v4u*)(Y + (size_t)row * D + 512 + 8 * F.lane) = w; }
}
template <int MODE  , int NT>
__device__ __forceinline__ void meta_gemm(const Ctx& F, const bf16* A16, int lda, const bf16* Bt, int ldb, int ntasks, int K, float* Cf, int ldc, const float* ss_in, float* ss_out, bf16* Ob, bf16* HL, float scale) {
    constexpr int NACC = MODE == 1 ? 2 * NT : NT;
    LAS float* red = (LAS float*)F.lds;
    int tid = F.tid, w = F.wave; asm volatile("" : "+v"(tid), "+s"(w));
    const int lane = tid & 63, g = lane >> 4, c = lane & 15, kper = K >> 3;
    for (int task = F.G - 1 - F.bid; task < ntasks; task += F.G) {
        const int n0 = MODE == 1 ? 256 * ((64 * task) >> 7) + ((64 * task) & 127) : 16 * NT * task;
        f32x4 acc[NACC];
#pragma unroll
        for (int q = 0; q < NACC; ++q) acc[q] = (f32x4){0.f, 0.f, 0.f, 0.f};
        const bf16* ap = A16 + (size_t)c * lda + w * kper + 8 * g; const bf16* bp = Bt + (size_t)(n0 + c) * ldb + w * kper + 8 * g;
#pragma unroll 4
        for (int kk = 0; kk < kper; kk += 32) { const bf16x8 a = *(const bf16x8*)(ap + kk);
#pragma unroll
            for (int t = 0; t < NT; ++t) { acc[t] = __builtin_amdgcn_mfma_f32_16x16x32_bf16(*(const bf16x8*)(bp + (size_t)(16 * t) * ldb + kk), a, acc[t], 0, 0, 0);
                if (MODE == 1) acc[NT + t] = __builtin_amdgcn_mfma_f32_16x16x32_bf16(*(const bf16x8*)(bp + (size_t)(128 + 16 * t) * ldb + kk), a, acc[NT + t], 0, 0, 0); } }
        __syncthreads();
#pragma unroll
        for (int q = 0; q < NACC; ++q) *(LAS f32x4*)(red + ((w * NACC + q) * 64 + lane) * 4) = acc[q];
        __syncthreads();
        if (w == 0) { const int row = SEQ + c; float rs = 1.0f;
            if (ss_in) { float s = 0.f;
#pragma unroll
                for (int q = 0; q < 8; ++q) { const f32x4 x = *(const f32x4*)(ss_in + (size_t)row * 32 + 4 * q); s += (x[0] + x[1]) + (x[2] + x[3]); }
                rs = __builtin_amdgcn_rsqf(s * (1.0f / 2048.0f) + EPS); }
            float sq = 0.f;
#pragma unroll
            for (int t = 0; t < NT; ++t) { f32x4 v = (f32x4){0.f, 0.f, 0.f, 0.f}, v2 = v;
#pragma unroll
                for (int ww = 0; ww < 8; ++ww) { v = v + *(const LAS f32x4*)(red + ((ww * NACC + t) * 64 + lane) * 4); if (MODE == 1) v2 = v2 + *(const LAS f32x4*)(red + ((ww * NACC + NT + t) * 64 + lane) * 4); }
                if (MODE == 0) *(f32x4*)(Cf + (size_t)row * ldc + 16 * NT * task + 16 * t + 4 * g) = v * rs;
                if (MODE == 3) { v2u wv; wv.x = pk2(v[0] * rs, v[1] * rs); wv.y = pk2(v[2] * rs, v[3] * rs); *(v2u*)(Ob + (size_t)row * ldc + 16 * NT * task + 16 * t + 4 * g) = wv; }
                if (MODE == 1) { float o[4];
#pragma unroll
                    for (int i = 0; i < 4; ++i) { const float gv = v[i] * rs, uv = v2[i] * rs; o[i] = gv * uv * __builtin_amdgcn_rcpf(1.0f + __expf(-gv)); }
                    v2u wv; wv.x = pk2(o[0], o[1]); wv.y = pk2(o[2], o[3]); *(v2u*)(Ob + (size_t)row * DFF + 64 * task + 16 * t + 4 * g) = wv; }
                if (MODE == 2) { const size_t off = (size_t)row * D + 64 * task + 16 * t + 4 * g; const v2u hi = *(const v2u*)(Ob + off), lo = *(const v2u*)(HL + off);
                    f32x4 h4 = (f32x4){pg8::bflo(hi.x) + pg8::bflo(lo.x), pg8::bfhi(hi.x) + pg8::bfhi(lo.x), pg8::bflo(hi.y) + pg8::bflo(lo.y), pg8::bfhi(hi.y) + pg8::bfhi(lo.y)}; h4 = h4 + v * scale;
                    v2u wv; wv.x = cvtpk(h4[0], h4[1]); wv.y = cvtpk(h4[2], h4[3]); v2u lv; lv.x = cvtpk(h4[0] - pg8::bflo(wv.x), h4[1] - pg8::bfhi(wv.x)); lv.y = cvtpk(h4[2] - pg8::bflo(wv.y), h4[3] - pg8::bfhi(wv.y));
                    *(v2u*)(Ob + off) = wv; *(v2u*)(HL + off) = lv; sq += (h4[0] * h4[0] + h4[1] * h4[1]) + (h4[2] * h4[2] + h4[3] * h4[3]); } }
            if (MODE == 2 && ss_out) { sq += __shfl_xor(sq, 16); sq += __shfl_xor(sq, 32); if (g == 0) __hip_atomic_fetch_add(ss_out + (size_t)row * 32 + task, sq, __ATOMIC_RELAXED, __HIP_MEMORY_SCOPE_AGENT); } }
    }    __syncthreads();
}
__device__ __forceinline__ void gemm_swiglu(const Ctx& F, int hl, int ssidx) {
    const bf16* A = (const bf16*)(F.ws + O_HB); const bf16* Bt = (const bf16*)(F.ws + O_WGU) + (size_t)hl * 11264 * 2048; const float* ss = (const float*)(F.ws + O_SS) + (size_t)ssidx * MP * 32;
    { pg8::Gemm g{A, Bt, SEQ, 11264, 2048, 2048, 2048, F.wave}; pg8::StaticOrder S; S.init(SEQ, 11264, F.G, F.bid);
      const int full = (S.nwg / F.G) * F.G, rem = S.nwg - full;
      const bool split = false && (2 * rem == F.G);
      if (split) S.lim = full;
      pg8::EpiSwiGLU E{(bf16*)(F.ws + O_ACT), DFF, ss, 1.0f / 2048.0f, EPS, 2};
      pg8::gemm_phase<pg8::EpiSwiGLU, pg8::StaticOrder, true, true, false>(F.lds, g, S, E);
      if (split) { pg8::StaticOrder S2; S2.init(SEQ, 11264, F.G, F.bid); S2.hmbase = full;
          pg8::EpiSwiGLU E2{(bf16*)(F.ws + O_ACT), DFF, ss, 1.0f / 2048.0f, EPS, 1};
          pg8::gemm_phase<pg8::EpiSwiGLU, pg8::StaticOrder, true, true, true>(F.lds, g, S2, E2); } }
    meta_gemm<1, 4>(F, A + (size_t)SEQ * 2048, 2048, Bt, 2048, DFF / 64, 2048, nullptr, 0, ss, nullptr, (bf16*)(F.ws + O_ACT), nullptr, 0.f);
}
__device__ __forceinline__ void gemm_residual(const Ctx& F, const bf16* A, const bf16* Bt, int K, int ssidx, bool to_out, float scale) {
    float* sso = ssidx >= 0 ? (float*)(F.ws + O_SS) + (size_t)ssidx * MP * 32 : nullptr;
    { pg8::Gemm g{A, Bt, SEQ, 2048, K, K, K, F.wave}; pg8::StaticOrder S; S.init(SEQ, 2048, F.G, F.bid);
      pg8::EpiResidual E{(bf16*)(F.ws + O_H), (bf16*)(F.ws + O_HB), sso, to_out ? F.kp->out : nullptr, SEQ, scale};
      pg8::gemm_phase<pg8::EpiResidual, pg8::StaticOrder, true, true>(F.lds, g, S, E); }
    meta_gemm<2, 4>(F, A + (size_t)SEQ * K, K, Bt, K, 32, K, nullptr, 0, nullptr, sso, (bf16*)(F.ws + O_HB), (bf16*)(F.ws + O_H), scale);
}
__device__ __forceinline__ void gemm_residual_dummy(const Ctx& F, const bf16* A, const bf16* Bt, int K) {
    { pg8::Gemm g{A, Bt, SEQ, 2048, K, K, K, F.wave}; pg8::StaticOrder S; S.init(SEQ, 2048, F.G, F.bid);
      pg8::EpiResidual E{(bf16*)(F.ws + O_RW), (bf16*)(F.ws + O_RW + (size_t)72 * 1024 * 1024), nullptr, nullptr, SEQ, 0.5f};
      pg8::gemm_phase<pg8::EpiResidual, pg8::StaticOrder, true, true>(F.lds, g, S, E); }
}
__device__ __forceinline__ void gemm_scalef32(const Ctx& F, const bf16* A, const bf16* Bt, int N, int K, float* C, int ssidx) {
    const float* ss = ssidx >= 0 ? (const float*)(F.ws + O_SS) + (size_t)ssidx * MP * 32 : nullptr;
    { pg8::Gemm g{A, Bt, SEQ, N, K, K, K, F.wave}; pg8::StaticOrder S; S.init(SEQ, N, F.G, F.bid);
      pg8::EpiScaleF32 E{C, N, ss, 1.0f / 2048.0f, EPS};
      pg8::gemm_phase<pg8::EpiScaleF32, pg8::StaticOrder, true, true>(F.lds, g, S, E); }
    meta_gemm<0, 4>(F, A + (size_t)SEQ * K, K, Bt, K, N / 64, K, C, N, ss, nullptr, nullptr, nullptr, 0.f);
}
__global__ void __launch_bounds__(NTHR, 2) hybrid_fwd(P p) {
    extern __shared__ __attribute__((aligned(16))) unsigned char lds_raw[];
    LAS unsigned char* lds = (LAS unsigned char*)lds_raw;
    const int wv = __builtin_amdgcn_readfirstlane((int)threadIdx.x >> 6);
    for (int u = threadIdx.x; u < (LDS_BYTES - LDSCTL_OFF) / 4; u += NTHR) ((LAS unsigned*)(lds + LDSCTL_OFF))[u] = 0u;
    __syncthreads();
    XcdBarrier bar = xcd_barrier_post((unsigned*)(p.ws + O_CTL) + CW_BAR, (volatile LAS unsigned*)(lds + LDSCTL_OFF), wv);
    const int lo = p.ph_lo, hi = p.ph_hi;
#ifdef TIME_MASK
    if (blockIdx.x == TIME_BLK && threadIdx.x == 0) { volatile LAS unsigned long long* tp_ = (volatile LAS unsigned long long*)(lds + LDSCTL_OFF + 1024); tp_[0] = wall_clock64(); tp_[1] = 0ull; }
#endif
#define IN(k) (lo <= (k) && (k) < hi)
#ifdef TIME_MASK
#ifndef TIME_PRE
#define TIME_PRE 0
#endif
#ifndef TIME_BLK
#define TIME_BLK 0
#endif
#define TMARK(kind, post) do { if (blockIdx.x == TIME_BLK && threadIdx.x == 0) { const unsigned long long now_ = wall_clock64(); volatile LAS unsigned long long* tp_ = (volatile LAS unsigned long long*)(lds + LDSCTL_OFF + 1024); \
    if ((((post) ? TIME_MASK : TIME_PRE) >> (kind)) & 1) tp_[1] += now_ - tp_[0]; if (post) tp_[0] = now_; } } while (0)
#define SEAM(k, kind) do { TMARK(kind, 0); if (IN(k) && IN((k) + 1)) xcd_barrier(bar, wv); TMARK(kind, 1); } while (0)
#else
#define TMARK(kind, post) do { } while (0)
#define SEAM(k, kind) do { if (IN(k) && IN((k) + 1)) xcd_barrier(bar, wv); } while (0)
#endif
#ifndef NO_P0
    if (IN(0)) { const Ctx F = ctx_make(lds, wv); p0_prologue(F, 0); }
#ifdef DUP_CVT
    if (IN(0)) { const Ctx F = ctx_make(lds, wv); p0_prologue(F, 1); }
#endif
#endif
    SEAM(0, 0);
    for (int hl = 0; hl < 8; ++hl) {
        const int l = hl >> 1, second = hl & 1, base = 1 + 11 * l + (second ? 9 : 0);
        if (IN(base)) { const Ctx F = ctx_make(lds, wv); gemm_swiglu(F, hl, 3 * l + (second ? 2 : 0)); }
#ifdef DUP_GU
        if (IN(base)) { const Ctx F = ctx_make(lds, wv); gemm_swiglu(F, hl, 3 * l + (second ? 2 : 0)); }
#endif
        SEAM(base, 1);
        if (IN(base + 1)) { const Ctx F = ctx_make(lds, wv);
            gemm_residual(F, (const bf16*)(F.ws + O_ACT), (const bf16*)(F.ws + O_WD) + (size_t)hl * 2048 * 5632, 5632, second ? (l < 3 ? 3 * (l + 1) : -1) : 3 * l + 1, hl == 7, 0.5f); }
#ifdef DUP_DOWN
        if (IN(base + 1)) { const Ctx F = ctx_make(lds, wv); if (DUP_DOWN == 1) gemm_residual_dummy(F, (const bf16*)(F.ws + O_ACT), (const bf16*)(F.ws + O_WD) + (size_t)hl * 2048 * 5632, 5632); else gemm_residual_dummy(F, (const bf16*)(F.ws + O_Y), (const bf16*)(F.ws + O_WOUT) + (size_t)l * D * D, 2048); }
#endif
        if (hl < 7) SEAM(base + 1, 2);
        if (!second) {
            const int mb = base + 2;
            if (IN(mb)) { const Ctx F = ctx_make(lds, wv); gemm_scalef32(F, (const bf16*)(F.ws + O_HB), (const bf16*)(F.ws + O_WIN) + (size_t)l * NINP * D, NINP, 2048, (float*)(F.ws + O_U), 3 * l + 1); }
#ifdef DUP_WIN
            if (IN(mb)) { const Ctx F = ctx_make(lds, wv); gemm_scalef32(F, (const bf16*)(F.ws + O_HB), (const bf16*)(F.ws + O_WIN) + (size_t)l * NINP * D, NINP, 2048, (float*)(F.ws + O_U), 3 * l + 1); }
#endif
            SEAM(mb, 3);
#ifndef NO_M1
            if (IN(mb + 1)) { const Ctx F = ctx_make(lds, wv); m1_phase(F, l); }
#ifdef DUP_M1
            if (IN(mb + 1)) { const Ctx F = ctx_make(lds, wv); m1_phase(F, l, 3); }
#endif
#endif
            SEAM(mb + 1, 4);
            if (IN(mb + 2)) {
                if (EN_MLA) { const Ctx F = ctx_make(lds, wv); gemm_scalef32(F, (const bf16*)(F.ws + O_AMLA), (const bf16*)(F.ws + O_WMLA) + (size_t)l * MLAN * 512, MLAN, 512, (float*)(F.ws + O_QKV), -1); }
#ifndef NO_M2
                { const Ctx F = ctx_make(lds, wv); unsigned* ctr = (unsigned*)(F.ws + O_CTL) + CW_QUEUE + 64 * (4 * l + 2);
                  for (;;) { int u = queue_next(F, ctr); if (u >= NRC * 8 + NCH * 8 + NCH * 4) break;
                      if (u < NRC * 8) { rwkv_chunk_unit(F, u >> 3, u & 7); continue; } u -= NRC * 8;
                      if (u < NCH * 8) { ssd_states_unit(F, u >> 3, u & 7); continue; } u -= NCH * 8;
                      ret_states_unit(F, u >> 2, u & 3); } }
#ifdef DUP_M2Q
                { const Ctx F = ctx_make(lds, wv); unsigned* ctr = (unsigned*)(F.ws + O_CTL) + CW_QUEUE + 64 * (4 * l + 3);
                  for (;;) { int u = queue_next(F, ctr); if (u >= NRC * 8 + NCH * 8 + NCH * 4) break;
                      if (u < NRC * 8) { rwkv_chunk_unit(F, u >> 3, u & 7); continue; } u -= NRC * 8;
                      if (u < NCH * 8) { ssd_states_unit(F, u >> 3, u & 7); continue; } u -= NCH * 8;
                      ret_states_unit(F, u >> 2, u & 3); } }
#endif
#endif
            }
            SEAM(mb + 2, 5);
#ifndef NO_M3
            if (IN(mb + 3)) { const Ctx F = ctx_make(lds, wv); m3_phase(F, l); }
#ifdef DUP_SCAN
            if (IN(mb + 3)) { const Ctx F = ctx_make(lds, wv); if (F.bid < 32) rwkv_state_scan<DUP_SCAN>(F, F.bid >> 2, F.bid & 3); }
#endif
#endif
            SEAM(mb + 3, 6);
#ifndef NO_M4
            if (IN(mb + 4)) { const Ctx F = ctx_make(lds, wv); const int nscan = F.G >= 64 ? 32 : F.G;
                if (F.bid < nscan) { for (int s = F.bid; s < 32; s += nscan) rwkv_state_scan<0>(F, s >> 2, s & 3);
                    asm volatile("s_waitcnt vmcnt(0)" ::: "memory"); __syncthreads();
                    if (F.tid == 0) { __builtin_amdgcn_fence(__ATOMIC_RELEASE, "agent"); asm volatile("s_waitcnt vmcnt(0)" ::: "memory"); __hip_atomic_fetch_add((unsigned*)(F.ws + O_CTL) + CW_QUEUE + 64 * (16 + l), 1u, __ATOMIC_RELAXED, __HIP_MEMORY_SCOPE_AGENT); } } }
            if (IN(mb + 4)) { const Ctx F = ctx_make(lds, wv); m4_phase(F, l); }
#ifdef DUP_M4
            if (IN(mb + 4)) { const Ctx F = ctx_make(lds, wv); m4_phase(F, l, 3, DUP_M4 - 1); }
#endif
#endif
            SEAM(mb + 4, 7);
#ifndef NO_M5
            if (IN(mb + 5)) { const Ctx F = ctx_make(lds, wv); m5_phase(F, l); }
#ifdef DUP_M5
            if (IN(mb + 5)) { const Ctx F = ctx_make(lds, wv); m5_phase(F, l); }
#endif
#endif
            SEAM(mb + 5, 8);
#ifdef DUP_BAR
            for (int q = 0; q < 8; ++q) xcd_barrier(bar, wv);
#endif
            if (IN(mb + 6)) { const Ctx F = ctx_make(lds, wv); gemm_residual(F, (const bf16*)(F.ws + O_Y), (const bf16*)(F.ws + O_WOUT) + (size_t)l * D * D, 2048, 3 * l + 2, false, 1.0f); }
            SEAM(mb + 6, 9);
        }
    }
#ifdef TIME_MASK
    TMARK(2, 0); TMARK(2, 1);
    if (blockIdx.x == TIME_BLK && threadIdx.x == 0) { volatile LAS unsigned long long* tp_ = (volatile LAS unsigned long long*)(lds + LDSCTL_OFF + 1024); const unsigned long long t0_ = tp_[0], d_ = tp_[1];
        while (wall_clock64() - t0_ < d_) __builtin_amdgcn_s_sleep(8); }
#endif
#ifdef PROBE_DUP
    xcd_barrier(bar, wv);
    { const Ctx F = ctx_make(lds, wv); const float v = (float)__hip_atomic_load((unsigned*)(F.ws + O_CTL) + 8, __ATOMIC_RELAXED, __HIP_MEMORY_SCOPE_AGENT); float* out = F.kp->out;
      for (size_t i = (size_t)F.bid * NTHR + F.tid; i < (size_t)SEQ * D; i += (size_t)F.G * NTHR) out[i] = v; }
#endif
#ifdef PROBE_ADD_META
    xcd_barrier(bar, wv);
    { const Ctx F = ctx_make(lds, wv); const float* H = (const float*)(F.ws + O_H); float* out = F.kp->out;
      for (int row = F.bid * NWAVES + F.wave; row < SEQ; row += F.G * NWAVES)
        for (int j = 0; j < 8; ++j) { const int c = 256 * j + 4 * F.lane; f32x4 v = *(f32x4*)(out + (size_t)row * D + c); v = v + *(const f32x4*)(H + (size_t)(SEQ + (row & 15)) * D + c); *(f32x4*)(out + (size_t)row * D + c) = v; } }
#endif
#undef IN
#undef SEAM
}

extern "C" void kernel_launch(void* const* d_in, const int* in_sizes, int n_in, void* d_out, int out_size, void* d_ws, size_t ws_size, hipStream_t stream) {
    static int grid = 0;
    if (grid == 0) {
        if (n_in != 36 || out_size != SEQ * D || ws_size < WS_END) { fprintf(stderr, "kernel_launch: expected 36 inputs, out %d, ws >= %zu; got n_in %d out %d ws %zu\n", SEQ * D, (size_t)WS_END, n_in, out_size, ws_size); grid = -1; return; }
        int dev = 0, cus = 0, per_cu = 0;
        if (hipGetDevice(&dev) != hipSuccess || hipDeviceGetAttribute(&cus, hipDeviceAttributeMultiprocessorCount, dev) != hipSuccess) { grid = -1; return; }
        if (hipFuncSetAttribute((const void*)hybrid_fwd, hipFuncAttributeMaxDynamicSharedMemorySize, LDS_BYTES) != hipSuccess) { fprintf(stderr, "kernel_launch: hipFuncSetAttribute failed\n"); grid = -1; return; }
        if (hipOccupancyMaxActiveBlocksPerMultiprocessor(&per_cu, (const void*)hybrid_fwd, NTHR, LDS_BYTES) != hipSuccess || per_cu < 1) fprintf(stderr, "kernel_launch: occupancy query reports %d\n", per_cu);
        (void)hipGetLastError();
        grid = cus;
    }
    if (grid < 0) return;
    if (hipMemsetAsync((char*)d_ws + O_CTL, 0, SZ_CTL, stream) != hipSuccess) { fprintf(stderr, "kernel_launch: memset failed\n"); return; }
    P a{};
    for (int i = 0; i < 36; ++i) a.in[i] = (const float*)d_in[i];
    a.out = (float*)d_out; a.ws = (unsigned char*)d_ws;
#if PER_PHASE_LAUNCH
    for (int ph = 0; ph < NPHASE; ++ph) { a.ph_lo = ph; a.ph_hi = ph + 1; hipLaunchKernelGGL(hybrid_fwd, dim3(grid), dim3(NTHR), LDS_BYTES, stream, a); }
#else
    a.ph_lo = 0; a.ph_hi = NPHASE;
    hipLaunchKernelGGL(hybrid_fwd, dim3(grid), dim3(NTHR), LDS_BYTES, stream, a);
#endif
    const hipError_t le = hipPeekAtLastError();
    if (le != hipSuccess) fprintf(stderr, "kernel_launch: launch failed: %s\n", hipGetErrorName(le));
}
```

```cpp
#include <hip/hip_runtime.h>
#include <cstdio>
#include <cstdint>

#define GAS __attribute__((address_space(1)))
#define LAS __attribute__((address_space(3)))
typedef unsigned short bf16;
typedef unsigned v4u __attribute__((ext_vector_type(4)));
typedef unsigned v2u __attribute__((ext_vector_type(2)));
typedef float f32x4 __attribute__((ext_vector_type(4)));
typedef float f32x2 __attribute__((ext_vector_type(2)));
typedef float f32x16 __attribute__((ext_vector_type(16)));
typedef short bf16x8 __attribute__((ext_vector_type(8)));

constexpr int D = 2048, SEQ = 8192, NMETA = 16, T = SEQ + NMETA, MP = 8448, DFF = 5632, DEPTH = 4;
constexpr int NIN = 5320, NINP = 5376, NCH = 65, TSEQ = 8320, MLAN = 1792;
constexpr int U_MLA = 0, U_SSD = 576, U_RET = 2120, U_RWKV = 3656;
constexpr float EPS = 1e-6f;
constexpr int NWAVES = 8, NTHR = 512;
#ifndef EN_MLA
#define EN_MLA 1
#endif
#ifndef EN_SSD
#define EN_SSD 1
#endif
#ifndef EN_RET
#define EN_RET 1
#endif
#ifndef EN_RWKV
#define EN_RWKV 1
#endif
#ifndef PROBE_NOSCAN
#define PROBE_NOSCAN 0
#endif
#ifndef PROBE_ATTCOPY
#define PROBE_ATTCOPY 0
#endif
#ifndef PROBE_COPY_META
#define PROBE_COPY_META 0
#endif
#ifndef DUP_VAR
#define DUP_VAR 0
#endif
#ifndef PER_PHASE_LAUNCH
#define PER_PHASE_LAUNCH 0
#endif
constexpr int NPHASE = 1 + 8 * 2 + 4 * 7;

constexpr size_t O_CTL = 0, SZ_CTL = 13107200;
constexpr int CW_BAR = 4096;
constexpr size_t O_SS = 65536;
constexpr size_t O_WGU = O_CTL + SZ_CTL,                 SZ_WGU = (size_t)8 * 2 * DFF * D * 2;
constexpr size_t O_WD = O_WGU + SZ_WGU,                  SZ_WD = (size_t)8 * D * DFF * 2;
constexpr size_t O_WIN = O_WD + SZ_WD,                   SZ_WIN = (size_t)4 * NINP * D * 2;
constexpr size_t O_WOUT = O_WIN + SZ_WIN,                SZ_WOUT = (size_t)4 * D * D * 2;
constexpr size_t O_WMLA = O_WOUT + SZ_WOUT,              SZ_WMLA = (size_t)4 * MLAN * 512 * 2;
constexpr size_t O_H = O_WMLA + SZ_WMLA,                 SZ_H = (size_t)MP * D * 4;
constexpr size_t O_HB = O_H + SZ_H,                      SZ_HB = (size_t)MP * D * 2;
constexpr size_t O_U = O_HB + SZ_HB,                     SZ_U = (size_t)MP * NINP * 4;
constexpr size_t O_ACT = O_U;
constexpr size_t O_AMLA = O_U + SZ_U,                    SZ_AMLA = (size_t)MP * 512 * 2;
constexpr size_t O_QKV = O_AMLA + SZ_AMLA,               SZ_QKV = (size_t)MP * MLAN * 4;
constexpr size_t O_Q = O_QKV + SZ_QKV,                   SZ_Q = (size_t)TSEQ * 768 * 2;
constexpr size_t O_K = O_Q + SZ_Q;
constexpr size_t O_VT = O_K + SZ_Q,                      SZ_VT = (size_t)4 * 128 * TSEQ * 2;
constexpr size_t O_Y = O_VT + SZ_VT,                     SZ_Y = (size_t)MP * D * 2;
constexpr size_t O_XBC = O_Y + SZ_Y,                     SZ_XBC = (size_t)MP * 1024 * 4;
constexpr size_t O_DT = O_XBC + SZ_XBC,                  SZ_DT = (size_t)MP * 8 * 4;
constexpr size_t O_LA = O_DT + SZ_DT;
constexpr size_t O_SST = O_LA + SZ_DT,                   SZ_SST = (size_t)NCH * 8 * 64 * 128 * 4;
constexpr size_t O_SDEC = O_SST + SZ_SST,                SZ_SDEC = (size_t)NCH * 8 * 128;
constexpr size_t O_YZ = O_SDEC + SZ_SDEC,                SZ_YZ = (size_t)MP * 512 * 4;
constexpr size_t O_RQK = O_YZ + SZ_YZ,                   SZ_RQK = (size_t)MP * 512 * 4;
constexpr size_t O_RST = O_RQK + SZ_RQK,                 SZ_RST = (size_t)NCH * 4 * 128 * 64 * 4;
constexpr size_t O_RW = O_RST + SZ_RST,                  SZ_RW1 = (size_t)MP * 512 * 4;
constexpr size_t O_RBON = O_RW + 8 * SZ_RW1,             SZ_RBON = (size_t)MP * 8 * 4;
constexpr size_t O_ROPE = O_RBON + SZ_RBON,              SZ_ROPE = (size_t)MP * 32 * 8;
constexpr size_t O_MATS = O_ROPE + SZ_ROPE,             SZ_MATS = (size_t)129 * 8 * 16384 * 4;
constexpr size_t O_SSTATE = O_RW + 7 * SZ_RW1;
constexpr size_t WS_END = O_MATS + SZ_MATS;
static_assert((size_t)129 * 8 * 4096 * 4 <= SZ_RW1, "sstate");
static_assert(WS_END <= 1424122240ull, "d_ws map too large");
static_assert(O_SS + (size_t)12 * MP * 32 * 4 <= SZ_CTL, "ctl map");
static_assert((size_t)MP * DFF * 2 <= SZ_U, "act overlays u");

constexpr int RING_BYTES = 131072;
constexpr int LDSCTL_OFF = 143360;
constexpr int LDS_BYTES = 147456;

#define LDS_WAIT() asm volatile("s_waitcnt lgkmcnt(0)" ::: "memory")
#define LBAR() do { asm volatile("s_waitcnt lgkmcnt(0)" ::: "memory"); __builtin_amdgcn_s_barrier(); asm volatile("" ::: "memory"); } while (0)
constexpr int CW_QUEUE = 8192;
#define VM_WAIT() asm volatile("s_waitcnt vmcnt(0)" ::: "memory")
__device__ __forceinline__ unsigned f2bf(float f) { unsigned u = __builtin_bit_cast(unsigned, f); return (u + 0x7fffu + ((u >> 16) & 1u)) >> 16; }
__device__ __forceinline__ unsigned pk2(float lo, float hi) { return f2bf(lo) | (f2bf(hi) << 16); }
typedef __bf16 bf16x2_t __attribute__((ext_vector_type(2)));
__device__ __forceinline__ unsigned cvtpk(float lo, float hi) { const f32x2 v = {lo, hi}; return __builtin_bit_cast(unsigned, __builtin_convertvector(v, bf16x2_t)); }
__device__ __forceinline__ int lane_id() { unsigned ones = ~0u; asm volatile("" : "+s"(ones)); return (int)__builtin_amdgcn_mbcnt_hi(ones, __builtin_amdgcn_mbcnt_lo(ones, 0u)); }
template <int CTRL> __device__ __forceinline__ float dpp_(float v) { return __builtin_bit_cast(float, __builtin_amdgcn_update_dpp(0, __builtin_bit_cast(int, v), CTRL, 0xF, 0xF, true)); }
__device__ __forceinline__ float rdlane(float v, int l) { return __builtin_bit_cast(float, __builtin_amdgcn_readlane(__builtin_bit_cast(int, v), l)); }
__device__ __forceinline__ float sum4(float v) { v += dpp_<0xB1>(v); v += dpp_<0x4E>(v); return v; }
__device__ __forceinline__ float sum8(float v) { v = sum4(v); v += dpp_<0x141>(v); return v; }
__device__ __forceinline__ float sum16(float v) { v = sum8(v); v += dpp_<0x140>(v); return v; }
__device__ __forceinline__ float wave_sum(float v) { v = sum16(v); return (rdlane(v, 0) + rdlane(v, 16)) + (rdlane(v, 32) + rdlane(v, 48)); }
__device__ __forceinline__ float sum32(float v, int lane) { v = sum16(v); const float lo = rdlane(v, 0) + rdlane(v, 16), hi = rdlane(v, 32) + rdlane(v, 48); return (lane & 32) ? hi : lo; }
__device__ __forceinline__ float xor32f(float v, int lane) {
    const unsigned x = __builtin_bit_cast(unsigned, v); const auto r = __builtin_amdgcn_permlane32_swap(x, x, false, false);
    return __builtin_bit_cast(float, (lane & 32) ? r[0] : r[1]); }
__device__ __forceinline__ float sigmoidf_(float x) { return 1.0f / (1.0f + __expf(-x)); }
__device__ __forceinline__ float siluf_(float x) { return x / (1.0f + __expf(-x)); }
__device__ __forceinline__ float softplusf_(float x) { return x > 20.f ? x : log1pf(expf(x)); }
struct UB { const bf16* p;
    __device__ __forceinline__ float operator[](size_t i) const { return __builtin_bit_cast(float, (unsigned)p[i] << 16); }
    __device__ __forceinline__ UB operator+(size_t o) const { return UB{p + o}; } };
__device__ __forceinline__ f32x4 ldu4(const UB u) { const v2u w = *(const v2u*)u.p;
    return (f32x4){__builtin_bit_cast(float, w.x << 16), __builtin_bit_cast(float, w.x & 0xffff0000u), __builtin_bit_cast(float, w.y << 16), __builtin_bit_cast(float, w.y & 0xffff0000u)}; }
__device__ __forceinline__ int row_of_seq(int s) { return s < NMETA ? SEQ + s : s - NMETA; }
__device__ __forceinline__ int seq_of_row(int r) { return r >= SEQ ? r - SEQ : r + NMETA; }
__device__ __forceinline__ int prev_row(int r) { return r == SEQ ? -1 : (r == 0 ? T - 1 : r - 1); }
__device__ __forceinline__ int crow(int c, int p) { return c == 0 ? (p >= 112 ? SEQ + p - 112 : -1) : 128 * (c - 1) + p; }
namespace pg8 {
#define PG8_LAS __attribute__((address_space(3)))
typedef unsigned short bf16_t;
typedef short bf16x8 __attribute__((ext_vector_type(8)));
typedef float f32x4 __attribute__((ext_vector_type(4)));
typedef unsigned u32x4 __attribute__((ext_vector_type(4)));
constexpr int BM = 256, BK = 64, HALF = 128, HTB = HALF * BK * 2  , STAGE_BYTES = 8 * HTB, NXCD = 8, WGM = 8;

__host__ __device__ __forceinline__ int lds_byte(int r, int c) { const int st = (r >> 4) * 2 + (c >> 5), rr = r & 15, cc = c & 31, ob = rr * 64 + cc * 2; return st * 1024 + (ob ^ (((ob >> 9) & 1) << 5)); }
__host__ __device__ __forceinline__ void stage_rc(int b, int& R, int& C) { const int st = b / 1024, sb = b % 1024, swz = sb ^ (((sb >> 9) & 1) << 5); R = (st >> 1) * 16 + swz / 64; C = (st & 1) * 32 + (swz % 64) / 2; }
__host__ __device__ __forceinline__ int perm32(int rho) { const int n = rho >> 4, i = rho & 15; return 8 * (i >> 2) + 4 * n + (i & 3); }

struct Unit { int pm, pn, ah; };
struct Gemm { const bf16_t* A; const bf16_t* Bt; int M, N, K, lda, ldb, wv; };

struct StaticOrder {
    int nM, nN, nwg, G, c, lim, hmbase;
    __host__ __device__ void init(int M, int N, int G_, int c_) { nM = M / BM; nN = N / BM; nwg = nM * nN; G = G_; c = c_; lim = nwg; hmbase = -1; }
    __host__ __device__ bool next(int i, Unit& u) const {
        long L; u.ah = 0;
        if (hmbase >= 0) { if (i > 0) return false; L = hmbase + (c >> 1); u.ah = c & 1; if (L >= nwg) return false; }
        else { L = (long)i * G + c; if (L >= lim) return false; }
        int wgid = (int)L; { const int q = nwg / NXCD, r = nwg % NXCD, xcd = wgid % NXCD, off = wgid / NXCD; wgid = (xcd < r ? xcd * (q + 1) : r * (q + 1) + (xcd - r) * q) + off; }
        const int nig = WGM * nN, gid = wgid / nig, fm = gid * WGM, gsz = (nM - fm) < WGM ? (nM - fm) : WGM;
        u.pm = fm + ((wgid % nig) % gsz); u.pn = (wgid % nig) / gsz; return true;
    }
    __device__ __forceinline__ void a_ready(const Unit&) const {}
    __device__ __forceinline__ void done(const Unit&) const {}
};

__device__ __forceinline__ unsigned cvt_pk_bf16(float lo, float hi) { unsigned r; asm volatile("v_cvt_pk_bf16_f32 %0, %1, %2" : "=v"(r) : "v"(lo), "v"(hi)); return r; }

template <class Epi, class Sched, bool ALIGN_EPI = false, bool SP2 = false, bool HM = false>
__device__ __forceinline__ void gemm_phase(PG8_LAS unsigned char* lds, const Gemm g, const Sched& S, const Epi& E) {
    int tid = g.wv * 64 + lane_id(); asm volatile("" : "+v"(tid)); const int wid = g.wv, lane = tid & 63, wr = wid >> 2, wc = wid & 3, fr = lane & 15, fq = lane >> 4;
    const int K = g.K, nt = K / BK;
    unsigned voffA[2], voffB[2];
#pragma unroll
    for (int i = 0; i < 2; ++i) { int R, C; stage_rc(tid * 16 + i * 8192, R, C); const int Rb = Epi::PERM ? ((R & ~31) + perm32(R & 31)) : R;
        voffA[i] = (unsigned)(R * g.lda + C) * 2u; voffB[i] = (unsigned)(Rb * g.ldb + C) * 2u; }
    const size_t kstep = (size_t)(BK * 2);
    const size_t hA = (size_t)HALF * g.lda * 2, hB = (size_t)HALF * g.ldb * 2;
    const size_t tA = 2 * hA, tB = 2 * hB;
    const unsigned ldsw = (unsigned)wid * 1024u;
    const int aoff = lds_byte(wr * 64 + fr, fq * 8), boff = lds_byte(wc * 32 + fr, fq * 8);
#define PG8_SA(b, h) (((b) * 2 + (h)) * HTB)
#define PG8_SB(b, h) ((4 + (b) * 2 + (h)) * HTB)
#define PG8_STAGE(bufoff, gbase, voff) do { _Pragma("unroll") for (int _i = 0; _i < 2; ++_i) \
        __builtin_amdgcn_global_load_lds((const unsigned*)((const char*)(gbase) + (voff)[_i]), (PG8_LAS unsigned*)(lds + (bufoff) + ldsw + _i * 8192), 16, 0, 0); } while (0)
#define PG8_LDA(dst, b, h) do { _Pragma("unroll") for (int m = 0; m < 4; ++m) _Pragma("unroll") for (int k = 0; k < 2; ++k) dst[m][k] = *(const PG8_LAS bf16x8*)(lds + PG8_SA(b, h) + aoff + m * 2048 + k * 1024); } while (0)
#define PG8_LDB(dst, b, h) do { _Pragma("unroll") for (int n = 0; n < 2; ++n) _Pragma("unroll") for (int k = 0; k < 2; ++k) dst[n][k] = *(const PG8_LAS bf16x8*)(lds + PG8_SB(b, h) + boff + n * 2048 + k * 1024); } while (0)
#define PG8_MMA(ai, bj, At, Bt) do { __builtin_amdgcn_s_setprio(1); _Pragma("unroll") for (int m = 0; m < 4; ++m) _Pragma("unroll") for (int n = 0; n < 2; ++n) _Pragma("unroll") for (int k = 0; k < 2; ++k) \
        acc[ai][bj][m][n] = __builtin_amdgcn_mfma_f32_16x16x32_bf16(Bt[n][k], At[m][k], acc[ai][bj][m][n], 0, 0, 0); __builtin_amdgcn_s_setprio(0); } while (0)
#define PG8_WAIT_V(n) asm volatile("s_waitcnt vmcnt(" #n ")" ::: "memory")
#define PG8_WAIT_L(n) asm volatile("s_waitcnt lgkmcnt(" #n ")" ::: "memory")
#define PG8_BAR __builtin_amdgcn_s_barrier()
#define PG8_SCHED __builtin_amdgcn_sched_barrier(0)
    Unit cur, nxt; int ui = 0;
    if (!S.next(0, cur)) return;
    f32x4 acc[2][2][4][2];
#pragma unroll
    for (int a = 0; a < 2; ++a)
#pragma unroll
        for (int b = 0; b < 2; ++b)
#pragma unroll
            for (int m = 0; m < 4; ++m)
#pragma unroll
                for (int n = 0; n < 2; ++n) acc[a][b][m][n] = (f32x4){0.f, 0.f, 0.f, 0.f};
    bf16x8 At[4][2], B0[2][2], B1[2][2];
    const char* cA = (const char*)g.A + (size_t)cur.pm * tA + (size_t)cur.ah * hA; const char* cB = (const char*)g.Bt + (size_t)cur.pn * tB;
    S.a_ready(cur);
    if constexpr (SP2) {
        PG8_STAGE(PG8_SB(0, 0), cB, voffB); PG8_STAGE(PG8_SB(0, 1), cB + hB, voffB); PG8_STAGE(PG8_SA(0, 0), cA, voffA); PG8_STAGE(PG8_SA(0, 1), cA + hA, voffA);
        if (wr == 1) PG8_BAR;
        PG8_WAIT_V(2); PG8_BAR;
        PG8_STAGE(PG8_SB(1, 0), cB + kstep, voffB); PG8_STAGE(PG8_SA(1, 0), cA + kstep, voffA); PG8_STAGE(PG8_SB(1, 1), cB + hB + kstep, voffB);
        PG8_WAIT_V(6); PG8_BAR;
    } else {
        PG8_STAGE(PG8_SB(0, 0), cB, voffB); PG8_STAGE(PG8_SA(0, 0), cA, voffA); PG8_STAGE(PG8_SB(0, 1), cB + hB, voffB); PG8_STAGE(PG8_SA(0, 1), cA + hA, voffA);
        if (wr == 1) PG8_BAR;
        PG8_WAIT_V(4); PG8_BAR;
        PG8_STAGE(PG8_SB(1, 0), cB + kstep, voffB); PG8_STAGE(PG8_SA(1, 0), cA + kstep, voffA); PG8_STAGE(PG8_SB(1, 1), cB + hB + kstep, voffB);
        PG8_WAIT_V(6); PG8_BAR;
    }
    for (;;) {
        const bool has_next = S.next(ui + 1, nxt);
        const char* nA = has_next ? (const char*)g.A + (size_t)nxt.pm * tA + (size_t)nxt.ah * hA : cA; const char* nB = has_next ? (const char*)g.Bt + (size_t)nxt.pn * tB : cB;
        for (int t = 0; t < nt; t += 2) {
            const bool last = (t == nt - 2);
            const char* a1 = cA + (size_t)(t + 1) * kstep;
            const char* a2 = last ? nA : cA + (size_t)(t + 2) * kstep; const char* b2 = last ? nB : cB + (size_t)(t + 2) * kstep;
            const char* a3 = a2 + kstep; const char* b3 = b2 + kstep;
            if (last && has_next) S.a_ready(nxt);
            if constexpr (SP2) {
            PG8_LDB(B0, 0, 0); PG8_LDB(B1, 0, 1); PG8_SCHED; PG8_LDA(At, 0, 0); PG8_STAGE(PG8_SA(1, 1), a1 + hA, voffA);
            PG8_WAIT_V(8); PG8_WAIT_L(0); PG8_BAR; PG8_MMA(0, 0, At, B0); PG8_MMA(0, 1, At, B1); PG8_BAR; PG8_SCHED;
            if constexpr (!HM) PG8_LDA(At, 0, 1); PG8_STAGE(PG8_SB(0, 0), b2, voffB); PG8_STAGE(PG8_SB(0, 1), b2 + hB, voffB); PG8_STAGE(PG8_SA(0, 0), a2, voffA);
            PG8_WAIT_V(8); PG8_WAIT_L(0); PG8_BAR; if constexpr (!HM) { PG8_MMA(1, 0, At, B0); PG8_MMA(1, 1, At, B1); } PG8_BAR; PG8_SCHED;
            PG8_LDB(B0, 1, 0); PG8_LDB(B1, 1, 1); PG8_SCHED; PG8_LDA(At, 1, 0); PG8_STAGE(PG8_SA(0, 1), a2 + hA, voffA);
            PG8_WAIT_V(8); PG8_WAIT_L(0); PG8_BAR; PG8_MMA(0, 0, At, B0); PG8_MMA(0, 1, At, B1); PG8_BAR; PG8_SCHED;
            if constexpr (!HM) PG8_LDA(At, 1, 1); PG8_STAGE(PG8_SB(1, 0), b3, voffB); PG8_STAGE(PG8_SB(1, 1), b3 + hB, voffB); PG8_STAGE(PG8_SA(1, 0), a3, voffA);
            PG8_WAIT_V(8); PG8_WAIT_L(0); PG8_BAR; if constexpr (!HM) { PG8_MMA(1, 0, At, B0); PG8_MMA(1, 1, At, B1); } PG8_BAR; PG8_SCHED;
            } else {
            PG8_LDB(B0, 0, 0); PG8_SCHED; PG8_LDA(At, 0, 0); PG8_STAGE(PG8_SA(1, 1), a1 + hA, voffA);
            PG8_WAIT_L(8); PG8_BAR; PG8_WAIT_L(0); PG8_MMA(0, 0, At, B0); PG8_BAR; PG8_SCHED;
            PG8_LDB(B1, 0, 1); PG8_STAGE(PG8_SB(0, 0), b2, voffB);
            PG8_BAR; PG8_WAIT_L(0); PG8_MMA(0, 1, At, B1); PG8_BAR;
            PG8_LDA(At, 0, 1); PG8_STAGE(PG8_SA(0, 0), a2, voffA);
            PG8_BAR; PG8_WAIT_L(0); PG8_MMA(1, 0, At, B0); PG8_BAR; PG8_SCHED;
            PG8_STAGE(PG8_SB(0, 1), b2 + hB, voffB);
            PG8_WAIT_V(6); PG8_BAR; PG8_MMA(1, 1, At, B1); PG8_BAR;
            PG8_LDB(B0, 1, 0); PG8_SCHED; PG8_LDA(At, 1, 0); PG8_STAGE(PG8_SA(0, 1), a2 + hA, voffA);
            PG8_WAIT_L(8); PG8_BAR; PG8_WAIT_L(0); PG8_MMA(0, 0, At, B0); PG8_BAR; PG8_SCHED;
            PG8_LDB(B1, 1, 1); PG8_STAGE(PG8_SB(1, 0), b3, voffB);
            PG8_BAR; PG8_WAIT_L(0); PG8_MMA(0, 1, At, B1); PG8_BAR;
            PG8_LDA(At, 1, 1); PG8_STAGE(PG8_SA(1, 0), a3, voffA);
            PG8_BAR; PG8_WAIT_L(0); PG8_MMA(1, 0, At, B0); PG8_BAR; PG8_SCHED;
            PG8_STAGE(PG8_SB(1, 1), b3 + hB, voffB);
            PG8_WAIT_V(6); PG8_BAR; PG8_MMA(1, 1, At, B1); PG8_BAR;
            }
        }
        if constexpr (ALIGN_EPI) { if (wr == 0) PG8_BAR; }
        if constexpr (!Epi::AFTER_DRAIN) { E(acc, cur, wr, wc, fr, fq); S.done(cur); }
        if (!has_next) break;
#pragma unroll
        for (int a = 0; a < 2; ++a)
#pragma unroll
            for (int b = 0; b < 2; ++b)
#pragma unroll
                for (int m = 0; m < 4; ++m)
#pragma unroll
                    for (int n = 0; n < 2; ++n) acc[a][b][m][n] = (f32x4){0.f, 0.f, 0.f, 0.f};
        cur = nxt; cA = nA; cB = nB; ++ui;
        if constexpr (ALIGN_EPI) { if (wr == 1) PG8_BAR; }
    }
    PG8_WAIT_V(0);
    if constexpr (!ALIGN_EPI) { if (wr == 0) PG8_BAR; }
    PG8_BAR;
    if constexpr (Epi::AFTER_DRAIN) { E.fused(acc, cur, wr, wc, fr, fq, lds, wid, lane); S.done(cur); }
#undef PG8_SA
#undef PG8_SB
#undef PG8_STAGE
#undef PG8_LDA
#undef PG8_LDB
#undef PG8_MMA
#undef PG8_WAIT_V
#undef PG8_WAIT_L
#undef PG8_BAR
#undef PG8_SCHED
}

__device__ __forceinline__ float row_ss(const float* ss, int row, int fq) {
    const f32x4 a = *(const f32x4*)(ss + (size_t)row * 32 + 8 * fq), b = *(const f32x4*)(ss + (size_t)row * 32 + 8 * fq + 4);
    float s = ((a[0] + a[1]) + (a[2] + a[3])) + ((b[0] + b[1]) + (b[2] + b[3]));
    s += __shfl_xor(s, 16); s += __shfl_xor(s, 32); return s;
}
struct EpiScaleF32 {
    static constexpr bool PERM = false, AFTER_DRAIN = false;
    float* C; int ldc; const float* ss; float inv_d, eps;
    __device__ __forceinline__ void operator()(const f32x4 (&acc)[2][2][4][2], const Unit& u, int wr, int wc, int fr, int fq) const {
        const int row0 = u.pm * BM + wr * 64 + fr, col0 = u.pn * BM + wc * 32 + 4 * fq;
#pragma unroll
        for (int ai = 0; ai < 2; ++ai)
#pragma unroll
            for (int m = 0; m < 4; ++m) { const int row = row0 + ai * HALF + m * 16; float* rowp = C + (size_t)row * ldc + col0;
                const float rs = ss ? __builtin_amdgcn_rsqf(row_ss(ss, row, fq) * inv_d + eps) : 1.0f;
#pragma unroll
                for (int bj = 0; bj < 2; ++bj)
#pragma unroll
                    for (int n = 0; n < 2; ++n) *(f32x4*)(rowp + bj * HALF + n * 16) = acc[ai][bj][m][n] * rs; }
    }
};
struct EpiScaleBf16 {
    static constexpr bool PERM = true, AFTER_DRAIN = false;
    bf16_t* O; int ldo; const float* ss; float inv_d, eps;
    __device__ __forceinline__ void operator()(const f32x4 (&acc)[2][2][4][2], const Unit& u, int wr, int wc, int fr, int fq) const {
        const int row0 = u.pm * BM + wr * 64 + fr, col0 = u.pn * BM + wc * 32 + 8 * fq;
#pragma unroll
        for (int ai = 0; ai < 2; ++ai)
#pragma unroll
            for (int m = 0; m < 4; ++m) { const int row = row0 + ai * HALF + m * 16; const float rs = __builtin_amdgcn_rsqf(row_ss(ss, row, fq) * inv_d + eps);
#pragma unroll
                for (int bj = 0; bj < 2; ++bj) { const f32x4 v0 = acc[ai][bj][m][0] * rs, v1 = acc[ai][bj][m][1] * rs;
                    u32x4 w; w.x = cvt_pk_bf16(v0[0], v0[1]); w.y = cvt_pk_bf16(v0[2], v0[3]); w.z = cvt_pk_bf16(v1[0], v1[1]); w.w = cvt_pk_bf16(v1[2], v1[3]);
                    *(u32x4*)(O + (size_t)row * ldo + col0 + bj * HALF) = w; } }
    }
};
struct EpiSwiGLU {
    static constexpr bool PERM = true, AFTER_DRAIN = false;
    bf16_t* O; int ldo; const float* ss; float inv_d, eps; int nai;
    __device__ __forceinline__ void operator()(const f32x4 (&acc)[2][2][4][2], const Unit& u, int wr, int wc, int fr, int fq) const {
        const int row0 = u.pm * BM + u.ah * HALF + wr * 64 + fr, col0 = u.pn * HALF + wc * 32 + 8 * fq;
#pragma unroll
        for (int ai = 0; ai < 2; ++ai) { if (ai >= nai) break;
#pragma unroll
            for (int m = 0; m < 4; ++m) { const int row = row0 + ai * HALF + m * 16;
                const float rs = __builtin_amdgcn_rsqf(row_ss(ss, row, fq) * inv_d + eps);
                float o[8];
#pragma unroll
                for (int n = 0; n < 2; ++n)
#pragma unroll
                    for (int j = 0; j < 4; ++j) { const float gv = acc[ai][0][m][n][j] * rs, uv = acc[ai][1][m][n][j] * rs; o[n * 4 + j] = gv * uv * __builtin_amdgcn_rcpf(1.0f + __expf(-gv)); }
                u32x4 w; w.x = cvt_pk_bf16(o[0], o[1]); w.y = cvt_pk_bf16(o[2], o[3]); w.z = cvt_pk_bf16(o[4], o[5]); w.w = cvt_pk_bf16(o[6], o[7]);
                *(u32x4*)(O + (size_t)row * ldo + col0) = w; } }
    }
};
__device__ __forceinline__ float bflo(unsigned w) { return __builtin_bit_cast(float, w << 16); }
__device__ __forceinline__ float bfhi(unsigned w) { return __builtin_bit_cast(float, w & 0xffff0000u); }
struct EpiResidual {
    static constexpr bool PERM = true, AFTER_DRAIN = false;
    bf16_t* HL; bf16_t* HB; float* ss_out; float* out; int out_rows; float scale;
    __device__ __forceinline__ void operator()(const f32x4 (&acc)[2][2][4][2], const Unit& u, int wr, int wc, int fr, int fq) const {
        const int row0 = u.pm * BM + wr * 64 + fr, col0 = u.pn * BM + wc * 32 + 8 * fq;
#pragma unroll
        for (int ai = 0; ai < 2; ++ai)
#pragma unroll
            for (int m = 0; m < 4; ++m) { const int row = row0 + ai * HALF + m * 16; float sq = 0.f;
#pragma unroll
                for (int bj = 0; bj < 2; ++bj) { const size_t off = (size_t)row * 2048 + col0 + bj * HALF;
                    const u32x4 hi = *(const u32x4*)(HB + off), lo = *(const u32x4*)(HL + off);
                    f32x4 h0 = (f32x4){bflo(hi.x) + bflo(lo.x), bfhi(hi.x) + bfhi(lo.x), bflo(hi.y) + bflo(lo.y), bfhi(hi.y) + bfhi(lo.y)};
                    f32x4 h1 = (f32x4){bflo(hi.z) + bflo(lo.z), bfhi(hi.z) + bfhi(lo.z), bflo(hi.w) + bflo(lo.w), bfhi(hi.w) + bfhi(lo.w)};
                    h0 = h0 + acc[ai][bj][m][0] * scale; h1 = h1 + acc[ai][bj][m][1] * scale;
                    if (out && row < out_rows) { *(f32x4*)(out + off) = h0; *(f32x4*)(out + off + 4) = h1; }
                    u32x4 w; w.x = cvt_pk_bf16(h0[0], h0[1]); w.y = cvt_pk_bf16(h0[2], h0[3]); w.z = cvt_pk_bf16(h1[0], h1[1]); w.w = cvt_pk_bf16(h1[2], h1[3]);
                    u32x4 l2; l2.x = cvt_pk_bf16(h0[0] - bflo(w.x), h0[1] - bfhi(w.x)); l2.y = cvt_pk_bf16(h0[2] - bflo(w.y), h0[3] - bfhi(w.y)); l2.z = cvt_pk_bf16(h1[0] - bflo(w.z), h1[1] - bfhi(w.z)); l2.w = cvt_pk_bf16(h1[2] - bflo(w.w), h1[3] - bfhi(w.w));
                    *(u32x4*)(HB + off) = w; *(u32x4*)(HL + off) = l2;
                    sq += (h0[0] * h0[0] + h0[1] * h0[1]) + (h0[2] * h0[2] + h0[3] * h0[3]) + (h1[0] * h1[0] + h1[1] * h1[1]) + (h1[2] * h1[2] + h1[3] * h1[3]); }
                sq += __shfl_xor(sq, 16); sq += __shfl_xor(sq, 32);
                if (fq == 0 && ss_out) __hip_atomic_fetch_add(ss_out + (size_t)row * 32 + u.pn * 4 + wc, sq, __ATOMIC_RELAXED, __HIP_MEMORY_SCOPE_AGENT); }
    }
};
}
#define XB_TMO      128
#define XB_XCNT(j)  (256  + 64 * (j))
#define XB_XSUB(j)  (1280 + 64 * (j))
#define XB_XGEN(j)  (2304 + 64 * (j))
#define XB_TOP      3328
#define XB_TOPGEN   3392
#define XCD_BAR_WORDS 3456
#define XB_SPIN_CAP (1u << 18)

__device__ __forceinline__ unsigned xb_ld(unsigned* p)              { return __hip_atomic_load(p, __ATOMIC_RELAXED, __HIP_MEMORY_SCOPE_AGENT); }
__device__ __forceinline__ unsigned xb_add(unsigned* p, unsigned v) { return __hip_atomic_fetch_add(p, v, __ATOMIC_RELAXED, __HIP_MEMORY_SCOPE_AGENT); }
__device__ __forceinline__ unsigned xb_xcc_id() { return (unsigned)__builtin_amdgcn_s_getreg((3 << 11) | 20) & 0xFu; }
#define XB_SPIN(cond, bar) do { unsigned _sp = 0; while (cond) { __builtin_amdgcn_s_sleep(1); \
    if ((++_sp & 255u) == 0u) { if (xb_ld(&(bar)[XB_TMO])) break; if (_sp > XB_SPIN_CAP) { atomicAdd(&(bar)[XB_TMO], 1u); break; } } } } while (0)

struct XcdBarrier {
    unsigned* bar; unsigned x;
    volatile LAS unsigned* st;
};

__device__ __forceinline__ XcdBarrier xcd_barrier_post(unsigned* bar, volatile LAS unsigned* st, int wv) {
    XcdBarrier b; b.bar = bar; b.x = xb_xcc_id(); b.st = st;
    if ((wv == 0 && lane_id() == 0)) (void)xb_add(&bar[XB_XCNT(b.x)], 1u);
    return b;
}
__device__ __forceinline__ void xcd_barrier_complete(unsigned* bar, unsigned x, unsigned& nloc, unsigned& nx) {
    const unsigned G = gridDim.x * gridDim.y * gridDim.z;
    unsigned sum, cnt, mine, sp = 0u;
    for (;;) {
        sum = 0u; cnt = 0u; mine = 0u;
#pragma unroll
        for (unsigned j = 0; j < 16; ++j) { const unsigned c = xb_ld(&bar[XB_XCNT(j)]); sum += c; cnt += (c > 0u) ? 1u : 0u; mine = (j == x) ? c : mine; }
        if (sum == G) break;
        __builtin_amdgcn_s_sleep(1);
        if ((++sp & 255u) == 0u) { if (xb_ld(&bar[XB_TMO])) break; if (sp > XB_SPIN_CAP) { atomicAdd(&bar[XB_TMO], 1u); break; } }
    }
    nloc = mine > 0u ? mine : 1u; nx = cnt > 0u ? cnt : 1u;
}

__device__ __forceinline__ void xcd_barrier(const XcdBarrier& b, int wv) {
    asm volatile("s_waitcnt vmcnt(0)" ::: "memory");
    __syncthreads();
    if ((wv == 0 && lane_id() == 0)) {
        unsigned* bar = b.bar;
        __builtin_amdgcn_s_waitcnt(0);
        unsigned nloc = b.st[0], nx = b.st[1];
        if (nloc == 0u) { xcd_barrier_complete(bar, b.x, nloc, nx); b.st[0] = nloc; b.st[1] = nx; }
        const unsigned old = xb_add(&bar[XB_XSUB(b.x)], 1u);
        const unsigned gen = old / nloc;
        if (old + 1u == (gen + 1u) * nloc) {
            __builtin_amdgcn_fence(__ATOMIC_RELEASE, "agent");
            asm volatile("s_waitcnt vmcnt(0)" ::: "memory");
            const unsigned og = xb_add(&bar[XB_TOP], 1u);
            const unsigned tg = og / nx;
            if (og + 1u == (tg + 1u) * nx) xb_add(&bar[XB_TOPGEN], 1u);
            else XB_SPIN(xb_ld(&bar[XB_TOPGEN]) == tg, bar);
            __builtin_amdgcn_fence(__ATOMIC_ACQUIRE, "agent");
            xb_add(&bar[XB_XGEN(b.x)], 1u);
            asm volatile("s_waitcnt vmcnt(0)" ::: "memory");
        } else {
            XB_SPIN(xb_ld(&bar[XB_XGEN(b.x)]) == gen, bar);
            __builtin_amdgcn_fence(__ATOMIC_ACQUIRE, "agent");
            asm volatile("s_waitcnt vmcnt(0)" ::: "memory");
        }
    }
    __syncthreads();
}

struct P { const float* in[36]; float* out; unsigned char* ws; int ph_lo, ph_hi; };
enum { I_X = 0, I_META, I_F1N, I_F1G, I_F1U, I_F1D, I_MIXN, I_WIN, I_WOUT, I_QN, I_WQ, I_KVN, I_WKV, I_QKNQ, I_QKNK, I_CONVW, I_CONVB, I_DTB, I_ALOG, I_SSDD, I_SSDN, I_RETN,
       I_MU, I_W0, I_W2, I_A0, I_A2, I_G2, I_KK, I_KA, I_RK, I_LN, I_F2N, I_F2G, I_F2U, I_F2D };
#define CAS __attribute__((address_space(4)))
typedef const CAS P* KPtr;
struct Ctx { LAS unsigned char* lds; unsigned char* ws; KPtr kp; int tid, lane, wave, G, bid; };
__device__ __forceinline__ Ctx ctx_make(LAS unsigned char* lds, int wv) {
    Ctx F; KPtr kp = (KPtr)__builtin_amdgcn_kernarg_segment_ptr(); asm volatile("" : "+s"(kp)); int t = wv * 64 + lane_id(); asm volatile("" : "+v"(t));
    F.lds = lds; F.kp = kp; F.ws = kp->ws; F.tid = t; F.lane = t & 63; F.wave = __builtin_amdgcn_readfirstlane(t >> 6); F.G = gridDim.x; F.bid = blockIdx.x; return F;
}


__device__ __forceinline__ int queue_next(const Ctx& F, unsigned* ctr) {
    volatile LAS unsigned* slot = (volatile LAS unsigned*)(F.lds + LDSCTL_OFF + 64);
    __syncthreads();
    if (F.tid == 0) *slot = __hip_atomic_fetch_add(ctr, 1u, __ATOMIC_RELAXED, __HIP_MEMORY_SCOPE_AGENT);
    __syncthreads();
    return (int)*slot;
}
__device__ __forceinline__ f32x16 zero16() { f32x16 z;
#pragma unroll
    for (int i = 0; i < 16; ++i) z[i] = 0.f; return z; }
__device__ __forceinline__ void mma32(f32x16& acc, const LAS float* Ap, int sAi, int sAk, const LAS float* Bp, int sBk, int sBj, int K, int lane) {
    const int r = lane & 31, hh = lane >> 5;
    const LAS float* a = Ap + r * sAi + hh * sAk; const LAS float* b = Bp + hh * sBk + r * sBj;
#pragma unroll 4
    for (int k = 0; k < K; k += 2) acc = __builtin_amdgcn_mfma_f32_32x32x2f32(a[k * sAk], b[k * sBk], acc, 0, 0, 0);
}
__device__ __forceinline__ void mma32bf(f32x16& acc, const LAS float* Ap, int sAi, const LAS float* Bp, int sBj, int K, int lane) {
    const int r = lane & 31, hh = lane >> 5; const LAS float* a = Ap + r * sAi + 8 * hh; const LAS float* b = Bp + r * sBj + 8 * hh;
#pragma unroll 2
    for (int k = 0; k < K; k += 16) { const f32x4 a0 = *(const LAS f32x4*)(a + k), a1 = *(const LAS f32x4*)(a + k + 4), b0 = *(const LAS f32x4*)(b + k), b1 = *(const LAS f32x4*)(b + k + 4);
        v4u aw, bw; aw.x = cvtpk(a0[0], a0[1]); aw.y = cvtpk(a0[2], a0[3]); aw.z = cvtpk(a1[0], a1[1]); aw.w = cvtpk(a1[2], a1[3]); bw.x = cvtpk(b0[0], b0[1]); bw.y = cvtpk(b0[2], b0[3]); bw.z = cvtpk(b1[0], b1[1]); bw.w = cvtpk(b1[2], b1[3]);
        acc = __builtin_amdgcn_mfma_f32_32x32x16_bf16(__builtin_bit_cast(bf16x8, aw), __builtin_bit_cast(bf16x8, bw), acc, 0, 0, 0); }
}
__device__ __forceinline__ int rreg(int reg, int lane) { return (reg & 3) + 8 * (reg >> 2) + 4 * (lane >> 5); }

__device__ __forceinline__ void cvt_tile(const float* src, int srcN, const float* gain, int valid, bf16* dst, int ldd, LAS float* scr, int lane) {
    const int c4 = lane & 15, r0 = lane >> 4;
    f32x4 v[16];
#pragma unroll
    for (int i = 0; i < 16; ++i) v[i] = (4 * c4 < valid) ? *(const f32x4*)(src + (size_t)(r0 + 4 * i) * srcN + 4 * c4) : (f32x4){0.f, 0.f, 0.f, 0.f};
#pragma unroll
    for (int i = 0; i < 16; ++i) { const int kk = r0 + 4 * i; const float gk = gain ? gain[kk] : 1.0f; LAS float* d = scr + kk * 65 + 4 * c4; d[0] = v[i][0] * gk; d[1] = v[i][1] * gk; d[2] = v[i][2] * gk; d[3] = v[i][3] * gk; }
    LDS_WAIT(); asm volatile("" ::: "memory");
    const int c8 = lane & 7;
#pragma unroll
    for (int j = 0; j < 8; ++j) { const int n = (lane >> 3) + 8 * j; const LAS float* s = scr + (8 * c8) * 65 + n;
        v4u o; o.x = pk2(s[0], s[65]); o.y = pk2(s[130], s[195]); o.z = pk2(s[260], s[325]); o.w = pk2(s[390], s[455]);
        *(v4u*)(dst + (size_t)n * ldd + 8 * c8) = o; }
    LDS_WAIT(); asm volatile("" ::: "memory");
}
constexpr int IT_GU = 2 * 32 * 176, IT_D = 2 * 88 * 32, IT_IN = 32 * 84, IT_OUT = 32 * 32, IT_MLA = 8 * 28, IT_ALL = IT_GU + IT_D + IT_IN + IT_OUT + IT_MLA;
__device__ __forceinline__ void convert_range(const Ctx& F, int L, int it0, int it1, int gw, int NGW) {
    LAS float* scr = (LAS float*)(F.lds + F.wave * 17408);
    const int lane = F.lane;
    bf16* WGU = (bf16*)(F.ws + O_WGU); bf16* WD = (bf16*)(F.ws + O_WD); bf16* WIN = (bf16*)(F.ws + O_WIN); bf16* WOUT = (bf16*)(F.ws + O_WOUT); bf16* WMLA = (bf16*)(F.ws + O_WMLA);
    const int l = L;
    for (int it = it0 + gw; it < it1; it += NGW) {
        int r = it;
        if (r < IT_GU) { const int which = r / 5632, f = 2 * l + which, q = r % 5632, kb = q / 176, nb = q % 176, n0 = 64 * nb, pn = n0 >> 8, within = n0 & 255, isup = within >= 128, f0 = 128 * pn + (within & 127);
            const float* src = (which ? (isup ? F.kp->in[I_F2U] : F.kp->in[I_F2G]) : (isup ? F.kp->in[I_F1U] : F.kp->in[I_F1G])) + (size_t)l * D * DFF + (size_t)(64 * kb) * DFF + f0;
            const float* gain = (which ? F.kp->in[I_F2N] : F.kp->in[I_F1N]) + l * D + 64 * kb;
            cvt_tile(src, DFF, gain, 64, WGU + (size_t)f * 11264 * 2048 + (size_t)n0 * 2048 + 64 * kb, 2048, scr, lane); continue; }
        r -= IT_GU;
        if (r < IT_D) { const int which = r / 2816, f = 2 * l + which, q = r % 2816, kb = q / 32, nb = q % 32;
            const float* src = (which ? F.kp->in[I_F2D] : F.kp->in[I_F1D]) + (size_t)l * DFF * D + (size_t)(64 * kb) * D + 64 * nb;
            cvt_tile(src, D, nullptr, 64, WD + (size_t)f * 2048 * 5632 + (size_t)(64 * nb) * 5632 + 64 * kb, 5632, scr, lane); continue; }
        r -= IT_D;
        if (r < IT_IN) { const int q = r, kb = q / 84, nb = q % 84, n0 = 64 * nb; int valid = NIN - n0; valid = valid < 0 ? 0 : (valid > 64 ? 64 : valid);
            const float* src = F.kp->in[I_WIN] + (size_t)l * D * NIN + (size_t)(64 * kb) * NIN + n0;
            cvt_tile(src, NIN, F.kp->in[I_MIXN] + l * D + 64 * kb, valid, WIN + (size_t)l * NINP * D + (size_t)n0 * D + 64 * kb, D, scr, lane); continue; }
        r -= IT_IN;
        if (r < IT_OUT) { const int q = r, kb = q / 32, nb = q % 32;
            const float* src = F.kp->in[I_WOUT] + (size_t)l * D * D + (size_t)(64 * kb) * D + 64 * nb;
            cvt_tile(src, D, nullptr, 64, WOUT + (size_t)l * D * D + (size_t)(64 * nb) * D + 64 * kb, D, scr, lane); continue; }
        r -= IT_OUT;
        { const int q = r, kb = q / 28, nb = q % 28, n0 = 64 * nb, k0 = 64 * kb;
            const float* src; int srcN, valid;
            if (n0 < 768) { valid = k0 < 384 ? 64 : 0; src = F.kp->in[I_WQ] + (size_t)l * 384 * 768 + (size_t)k0 * 768 + n0; srcN = 768; }
            else { valid = k0 >= 384 ? 64 : 0; src = F.kp->in[I_WKV] + (size_t)l * 128 * 1024 + (size_t)(k0 - 384) * 1024 + (n0 - 768); srcN = 1024; }
            cvt_tile(src, srcN, nullptr, valid, WMLA + (size_t)l * MLAN * 512 + (size_t)n0 * 512 + k0, 512, scr, lane); }
    }
}
__device__ __forceinline__ void convert_layer(const Ctx& F, int L, int gw, int NGW) { convert_range(F, L, 0, IT_ALL, gw, NGW); }
__device__ __forceinline__ void cv_tail0(const Ctx& F, int it0, int it1, int first_idle) {
    if (F.G != 256 || F.bid < first_idle) return;
    __syncthreads();
    convert_range(F, 0, it0, it1, (F.bid - first_idle) * NWAVES + F.wave, (F.G - first_idle) * NWAVES);
    __syncthreads();
}
__device__ __forceinline__ void p0_prologue(const Ctx& F, int cvt_only) {
    const int gw = F.bid * NWAVES + F.wave, NGW = F.G * NWAVES, lane = F.lane;
    if (F.G == 256) { convert_range(F, 0, 0, IT_GU / 2, gw, NGW); convert_range(F, 0, IT_GU, IT_ALL, gw, NGW); }
    else convert_layer(F, 0, gw, NGW);
    if (cvt_only) return;
    bf16* HL = (bf16*)(F.ws + O_H); bf16* HB = (bf16*)(F.ws + O_HB); float* SS = (float*)(F.ws + O_SS); bf16* Y = (bf16*)(F.ws + O_Y); f32x2* ROPE = (f32x2*)(F.ws + O_ROPE);
    for (int row = gw; row < MP; row += NGW) {
        const float* src = row < SEQ ? F.kp->in[I_X] + (size_t)row * D : F.kp->in[I_META] + (size_t)(row - SEQ) * D;
        float sq = 0.f;
#pragma unroll
        for (int j = 0; j < 8; ++j) { f32x4 v = (f32x4){0.f, 0.f, 0.f, 0.f}; if (row < T) v = *(const f32x4*)(src + 256 * j + 4 * lane);
            v2u w; w.x = cvtpk(v[0], v[1]); w.y = cvtpk(v[2], v[3]); *(v2u*)(HB + (size_t)row * D + 256 * j + 4 * lane) = w;
            v2u lw; lw.x = cvtpk(v[0] - pg8::bflo(w.x), v[1] - pg8::bfhi(w.x)); lw.y = cvtpk(v[2] - pg8::bflo(w.y), v[3] - pg8::bfhi(w.y)); *(v2u*)(HL + (size_t)row * D + 256 * j + 4 * lane) = lw;
            sq += (v[0] * v[0] + v[1] * v[1]) + (v[2] * v[2] + v[3] * v[3]); }
        sq = wave_sum(sq); if (lane == 0) __hip_atomic_fetch_add(SS + (size_t)row * 32, sq, __ATOMIC_RELAXED, __HIP_MEMORY_SCOPE_AGENT);
#ifdef PROBE_ZERO_Y
        if (true) {
#else
        if (row >= T) {
#endif
#pragma unroll
            for (int j = 0; j < 4; ++j) *(v4u*)(Y + (size_t)row * D + 512 * j + 8 * lane) = (v4u){0u, 0u, 0u, 0u}; }
#ifdef PROBE_ZERO_Y
        if (row < T && lane < 32) { const float inv = powf(10000.0f, -(float)lane / 32.0f); const float ang = (float)seq_of_row(row) * inv; float sn, cs; sincosf(ang, &sn, &cs); ROPE[row * 32 + lane] = (f32x2){cs, sn}; }
#else
        else if (lane < 32) { const float inv = powf(10000.0f, -(float)lane / 32.0f); const float ang = (float)seq_of_row(row) * inv; float sn, cs; sincosf(ang, &sn, &cs); ROPE[row * 32 + lane] = (f32x2){cs, sn}; }
#endif
    }
}

__device__ __forceinline__ void m1_unit(const Ctx& F, int l, int r0, int r1, int grp) {
    const int lane = F.lane, tid = F.tid;
    const float* U = (const float*)(F.ws + O_U);
    if (r0 < r1) { bf16* AM = (bf16*)(F.ws + O_AMLA); const float* qn = F.kp->in[I_QN] + l * 384; const float* kvn = F.kp->in[I_KVN] + l * 128;
      const float* gp = lane < 48 ? qn + 8 * lane : kvn + 8 * (lane - 48); const f32x4 g0 = *(const f32x4*)gp, g1 = *(const f32x4*)(gp + 4);
      f32x4 a4[4], b4[4];
#pragma unroll
      for (int i = 0; i < 4; ++i) { const int row = r0 + F.wave + 8 * i; const float* ur = U + (size_t)(row < r1 ? row : r0) * NINP + 8 * lane; a4[i] = *(const f32x4*)ur; b4[i] = *(const f32x4*)(ur + 4); }
#pragma unroll
      for (int i = 0; i < 4; ++i) { const int row = r0 + F.wave + 8 * i; const f32x4 a = a4[i], b = b4[i];
        const float sq = (a[0] * a[0] + a[1] * a[1]) + (a[2] * a[2] + a[3] * a[3]) + (b[0] * b[0] + b[1] * b[1]) + (b[2] * b[2] + b[3] * b[3]);
        const float sq_q = wave_sum(lane < 48 ? sq : 0.f), sq_kv = wave_sum(lane >= 48 ? sq : 0.f);
        const float rs = lane < 48 ? 1.0f / sqrtf(sq_q * (1.0f / 384.0f) + EPS) : 1.0f / sqrtf(sq_kv * (1.0f / 128.0f) + EPS);
        v4u w; w.x = pk2(a[0] * rs * g0[0], a[1] * rs * g0[1]); w.y = pk2(a[2] * rs * g0[2], a[3] * rs * g0[3]); w.z = pk2(b[0] * rs * g1[0], b[1] * rs * g1[1]); w.w = pk2(b[2] * rs * g1[2], b[3] * rs * g1[3]);
        if (row < r1) *(v4u*)(AM + (size_t)row * 512 + 8 * lane) = w; } }
    if (r0 < r1) { float* RQK = (float*)(F.ws + O_RQK); const f32x2* ROPE = (const f32x2*)(F.ws + O_ROPE);
      f32x2 cs[4][4]; float x1[4][4], x2[4][4];
#pragma unroll
      for (int i = 0; i < 4; ++i) { const int row = r0 + F.wave + 8 * i, rc = row < r1 ? row : r0;
#pragma unroll
        for (int j = 0; j < 4; ++j) { const int idx = lane + 64 * j, qk = idx >> 7, hh = (idx >> 5) & 3, i5 = idx & 31; cs[i][j] = ROPE[rc * 32 + i5];
            x1[i][j] = U[(size_t)rc * NINP + U_RET + qk * 256 + hh * 64 + i5]; x2[i][j] = U[(size_t)rc * NINP + U_RET + qk * 256 + hh * 64 + 32 + i5]; } }
#pragma unroll
      for (int i = 0; i < 4; ++i) { const int row = r0 + F.wave + 8 * i; if (row < r1) {
#pragma unroll
        for (int j = 0; j < 4; ++j) { const int idx = lane + 64 * j, qk = idx >> 7, hh = (idx >> 5) & 3, i5 = idx & 31; const float sc = qk ? 0.125f : 1.0f;
            RQK[(size_t)row * 512 + qk * 256 + hh * 64 + i5] = (x1[i][j] * cs[i][j].x - x2[i][j] * cs[i][j].y) * sc; RQK[(size_t)row * 512 + qk * 256 + hh * 64 + 32 + i5] = (x1[i][j] * cs[i][j].y + x2[i][j] * cs[i][j].x) * sc; } } } }
    if (r0 < r1) { float* XBC = (float*)(F.ws + O_XBC); float* DT = (float*)(F.ws + O_DT); float* LA = (float*)(F.ws + O_LA);
      const float* cw = F.kp->in[I_CONVW] + l * 4096; const float* cb = F.kp->in[I_CONVB] + l * 1024;
      int rw[4], p1[4], p2[4], p3[4]; float dtr[4];
#pragma unroll
      for (int i = 0; i < 4; ++i) { const int row = r0 + F.wave + 8 * i; rw[i] = row < r1 ? row : r0; p1[i] = prev_row(rw[i]); p2[i] = p1[i] >= 0 ? prev_row(p1[i]) : -1; p3[i] = p2[i] >= 0 ? prev_row(p2[i]) : -1;
          dtr[i] = U[(size_t)rw[i] * NINP + U_SSD + 1536 + (lane & 7)]; }
#pragma unroll 1
      for (int j = 0; j < 4; ++j) { const int ch = 256 * j + 4 * lane; const size_t uo = U_SSD + 512 + ch; const f32x4 z4 = (f32x4){0.f, 0.f, 0.f, 0.f};
          const f32x4 wb = *(const f32x4*)(cb + ch), w0 = *(const f32x4*)(cw + ch), w1 = *(const f32x4*)(cw + 1024 + ch), w2 = *(const f32x4*)(cw + 2048 + ch), w3 = *(const f32x4*)(cw + 3072 + ch);
          f32x4 x0[4], x1[4], x2[4], x3[4];
#pragma unroll
          for (int i = 0; i < 4; ++i) { x3[i] = *(const f32x4*)(U + (size_t)rw[i] * NINP + uo); x2[i] = p1[i] >= 0 ? *(const f32x4*)(U + (size_t)p1[i] * NINP + uo) : z4;
              x1[i] = p2[i] >= 0 ? *(const f32x4*)(U + (size_t)p2[i] * NINP + uo) : z4; x0[i] = p3[i] >= 0 ? *(const f32x4*)(U + (size_t)p3[i] * NINP + uo) : z4; }
#pragma unroll
          for (int i = 0; i < 4; ++i) { f32x4 o = wb + w0 * x0[i] + w1 * x1[i] + w2 * x2[i] + w3 * x3[i];
              o[0] = siluf_(o[0]); o[1] = siluf_(o[1]); o[2] = siluf_(o[2]); o[3] = siluf_(o[3]);
              if (r0 + F.wave + 8 * i < r1) *(f32x4*)(XBC + (size_t)rw[i] * 1024 + ch) = o; } }
#pragma unroll
      for (int i = 0; i < 4; ++i) if (lane < 8 && r0 + F.wave + 8 * i < r1) { const float dt = softplusf_(dtr[i] + F.kp->in[I_DTB][l * 8 + lane]); DT[rw[i] * 8 + lane] = dt; LA[rw[i] * 8 + lane] = -expf(F.kp->in[I_ALOG][l * 8 + lane]) * dt; } }
    if (grp >= 0) { LAS float* xl = (LAS float*)F.lds; const int hd = F.wave, col = lane & 31;
      float* RW = (float*)(F.ws + O_RW); const size_t AS = (size_t)MP * 512; float* RBON = (float*)(F.ws + O_RBON);
      const float* MU = F.kp->in[I_MU] + l * 1664; const float* W2 = F.kp->in[I_W2] + l * 32 * 512; const float* A2 = F.kp->in[I_A2] + l * 32 * 512; const float* G2 = F.kp->in[I_G2] + l * 64 * 512;
      const int r0 = 32 * grp;
      __syncthreads();
#pragma unroll
      for (int j = 0; j < 8; ++j) { const int idx = tid + 512 * j, tk = idx >> 7, cl = idx & 127, row = r0 + tk; float xs = 0.f;
          if (row < T) { const int pr = prev_row(row); const size_t uc = U_RWKV + 1536 + cl; const float x = U[(size_t)row * NINP + uc], xp = pr >= 0 ? U[(size_t)pr * NINP + uc] : 0.f; xs = x + (xp - x) * MU[1536 + cl];
              if (cl < 32) xs = tanhf(xs); else if (cl >= 64) xs = sigmoidf_(xs); }
          xl[tk * 132 + cl] = xs; }
      __syncthreads();
      float w0c[2], a0c[2], kkc[2], kac[2], rkc[2], muR[2], muK[2], muV[2];
#pragma unroll
      for (int ct = 0; ct < 2; ++ct) { const int ch = 64 * hd + 32 * ct + col; w0c[ct] = F.kp->in[I_W0][l * 512 + ch]; a0c[ct] = F.kp->in[I_A0][l * 512 + ch]; kkc[ct] = F.kp->in[I_KK][l * 512 + ch]; kac[ct] = F.kp->in[I_KA][l * 512 + ch]; rkc[ct] = F.kp->in[I_RK][l * 512 + ch];
          muR[ct] = MU[ch]; muK[ct] = MU[512 + ch]; muV[ct] = MU[1024 + ch]; }
      { constexpr int tb = 0;
          f32x16 aw[2], aa[2], ag[2];
#pragma unroll
          for (int ct = 0; ct < 2; ++ct) { aw[ct] = zero16(); aa[ct] = zero16(); ag[ct] = zero16(); }
          const LAS float* xa = xl + (32 * tb + col) * 132 + (lane >> 5); const int chb = 64 * hd + col, kh = lane >> 5;
#define M1_LORA(ACC, WM, XO, NB) do { _Pragma("unroll") for (int hb_ = 0; hb_ < (NB); ++hb_) { float bq_[16][2], xq_[16]; \
              _Pragma("unroll") for (int t_ = 0; t_ < 16; ++t_) { const float* wb_ = (WM) + 1024 * (16 * hb_ + t_); bq_[t_][0] = wb_[wvo]; bq_[t_][1] = wb_[wvo + 32]; xq_[t_] = xa[(XO) + 2 * (16 * hb_ + t_)]; } \
              _Pragma("unroll") for (int t_ = 0; t_ < 16; ++t_) { ACC[0] = __builtin_amdgcn_mfma_f32_32x32x2f32(xq_[t_], bq_[t_][0], ACC[0], 0, 0, 0); ACC[1] = __builtin_amdgcn_mfma_f32_32x32x2f32(xq_[t_], bq_[t_][1], ACC[1], 0, 0, 0); } } } while (0)
          const unsigned wvo = (unsigned)(kh * 512 + chb);
          M1_LORA(aw, W2, 0, 1); M1_LORA(aa, A2, 32, 1); M1_LORA(ag, G2, 64, 2);
#undef M1_LORA
#pragma unroll
          for (int rb = 0; rb < 16; rb += 4) {
              float uc[4][2][3], upv[4][2][3];
#pragma unroll
              for (int q = 0; q < 4; ++q) { const int row = r0 + 32 * tb + rreg(rb + q, lane), rc = row < T ? row : 0, pr = prev_row(rc);
#pragma unroll
                  for (int ct = 0; ct < 2; ++ct) { const float* ur = U + (size_t)rc * NINP + U_RWKV + chb + 32 * ct; const float* up = U + (size_t)(pr >= 0 ? pr : 0) * NINP + U_RWKV + chb + 32 * ct;
                      uc[q][ct][0] = ur[0]; uc[q][ct][1] = ur[512]; uc[q][ct][2] = ur[1024]; upv[q][ct][0] = pr >= 0 ? up[0] : 0.f; upv[q][ct][1] = pr >= 0 ? up[512] : 0.f; upv[q][ct][2] = pr >= 0 ? up[1024] : 0.f; } }
#pragma unroll
              for (int q = 0; q < 4; ++q) { const int reg = rb + q; const int row = r0 + 32 * tb + rreg(reg, lane); const bool ok = row < T;
                  float rr[2], k2[2], vv[2], kk[2], av[2], dec[2]; float nq = 0.f, bq = 0.f;
#pragma unroll
                  for (int ct = 0; ct < 2; ++ct) { float r = uc[q][ct][0], k = uc[q][ct][1], v = uc[q][ct][2];
                      r += (upv[q][ct][0] - r) * muR[ct]; k += (upv[q][ct][1] - k) * muK[ct]; v += (upv[q][ct][2] - v) * muV[ct];
                      float wr = w0c[ct] + aw[ct][reg]; wr = -softplusf_(-wr) - 0.5f; dec[ct] = expf(-expf(wr));
                      av[ct] = sigmoidf_(a0c[ct] + aa[ct][reg]);
                      kk[ct] = k * kkc[ct]; k2[ct] = k * (1.0f + (av[ct] - 1.0f) * kac[ct]); rr[ct] = r; vv[ct] = v;
                      nq += kk[ct] * kk[ct]; bq += r * k2[ct] * rkc[ct]; }
                  nq = sum32(nq, lane); bq = sum32(bq, lane);
                  const float inrm = 1.0f / fmaxf(sqrtf(nq), 1e-12f);
                  if (ok) {
#pragma unroll
                      for (int ct = 0; ct < 2; ++ct) { const size_t o = (size_t)row * 512 + chb + 32 * ct; const float kn = kk[ct] * inrm;
                          RW[o] = rr[ct]; RW[AS + o] = dec[ct]; RW[2 * AS + o] = k2[ct]; RW[3 * AS + o] = vv[ct]; RW[4 * AS + o] = -kn; RW[5 * AS + o] = kn * av[ct]; RW[6 * AS + o] = ag[ct][reg]; }
                      if (col == 0) RBON[row * 8 + hd] = bq; } } }
      } }
}
__device__ __forceinline__ void m1_phase(const Ctx& F, int l, int qi = 1) {
    unsigned* ctr = (unsigned*)(F.ws + O_CTL) + CW_QUEUE + 64 * (4 * l + qi);
    constexpr int NG = (T + 31) / 32, NR = (T + 31) / 32;
    for (;;) { const int u = queue_next(F, ctr); if (u >= NG + NR) break;
        if (u < NG) m1_unit(F, l, 0, 0, u); else { const int r0 = 32 * (u - NG); m1_unit(F, l, r0, r0 + 32 < T ? r0 + 32 : T, -1); } }
}
constexpr int RWC = 64, NRC = (T + RWC - 1) / RWC;
__device__ __forceinline__ void rwkv_chunk_unit(const Ctx& F, int c, int h) {
    LAS float* BH = (LAS float*)F.lds; LAS float* KH = BH + 4160; LAS float* NX = KH + 4160; LAS float* RTT = NX + 4160;
    LAS float* AP = RTT + 4160; LAS float* BZ = AP + 4352; LAS float* Pm = BZ + 4160; LAS float* Qm = Pm + 4160; LAS float* Ge = Qm + 4160; LAS float* segt = Ge + 64;
    const float* RW = (const float*)(F.ws + O_RW); const size_t AS = (size_t)MP * 512; float* MATS = (float*)(F.ws + O_MATS) + (size_t)(c * 8 + h) * 16384;
    int tid = F.tid, w = F.wave; asm volatile("" : "+v"(tid), "+s"(w));
    const int lane = tid & 63, seg = tid >> 6, k = tid & 63;
    __syncthreads();
    { float p[8];
#pragma unroll
      for (int i = 0; i < 8; ++i) { const int s = RWC * c + 8 * seg + i; const float wv = s < T ? RW[AS + (size_t)row_of_seq(s) * 512 + 64 * h + k] : 1.0f; p[i] = wv; }
      float nkv[8], rv[8], bv[8], kkv[8];
#pragma unroll
      for (int i = 0; i < 8; ++i) { const int s = RWC * c + 8 * seg + i; nkv[i] = 0.f; rv[i] = 0.f; bv[i] = 0.f; kkv[i] = 0.f;
          if (s < T) { const size_t o = (size_t)row_of_seq(s) * 512 + 64 * h + k; rv[i] = RW[o]; kkv[i] = RW[2 * AS + o]; nkv[i] = RW[4 * AS + o]; bv[i] = RW[5 * AS + o]; } }
#pragma unroll
      for (int i = 1; i < 8; ++i) p[i] *= p[i - 1];
      segt[seg * 64 + k] = p[7];
      __syncthreads();
      float pre = 1.0f, tot = 1.0f;
#pragma unroll
      for (int q = 0; q < 8; ++q) { const float t = segt[q * 64 + k]; if (q < seg) pre *= t; tot *= t; }
      if (seg == 0) Ge[k] = tot;
#pragma unroll
      for (int i = 0; i < 8; ++i) { const int il = 8 * seg + i, s = RWC * c + il; const float G = pre * p[i], Gm1 = i ? pre * p[i - 1] : pre;
          const float nk = nkv[i], r = rv[i], b = bv[i], kk = kkv[i];
          const float ig = 1.0f / G;
          NX[k * 65 + il] = nk * Gm1; RTT[k * 65 + il] = r * G; BH[il * 65 + k] = b * ig; KH[il * 65 + k] = kk * ig; } }
    __syncthreads();
#define RW_PROD_TILE(PROD, TR, TC) do { const int prod_ = (PROD), tr_ = (TR), tc_ = (TC); f32x16 acc = zero16(); \
        if (tr_ <= tc_) mma32(acc, ((prod_ & 1) ? KH : BH) + 32 * tr_ * 65, 65, 1, ((prod_ < 2) ? NX : RTT) + 32 * tc_, 65, 1, 64, lane); \
        _Pragma("unroll") for (int r = 0; r < 16; ++r) { const int j = 32 * tr_ + rreg(r, lane), i = 32 * tc_ + (lane & 31); const float v = acc[r]; \
            if (prod_ == 0) AP[j * 68 + i] = j < i ? v : 0.f; else if (prod_ == 1) BZ[j * 65 + i] = j < i ? v : 0.f; else if (prod_ == 2) Pm[j * 65 + i] = j <= i ? v : 0.f; else Qm[j * 65 + i] = j <= i ? v : 0.f; } } while (0)
    RW_PROD_TILE(w >> 2, (w >> 1) & 1, w & 1);
    __syncthreads();
    if (w >= 6) { RW_PROD_TILE(3, w - 6, 0); RW_PROD_TILE(3, w - 6, 1); }
    else if (w >= 2) { RW_PROD_TILE(2, (w - 2) >> 1, (w - 2) & 1); }
    else { LAS float* Yr = (w == 0 ? NX : BZ) + lane * 65;
        for (int ib = 0; ib < 4; ++ib) { float a[16];
#pragma unroll
            for (int ii = 0; ii < 16; ++ii) a[ii] = Yr[16 * ib + ii];
#pragma unroll 4
            for (int j = 0; j < 16 * ib; ++j) { const float y = Yr[j]; const LAS float* ap = AP + j * 68 + 16 * ib;
                const f32x4 a0 = *(const LAS f32x4*)ap, a1 = *(const LAS f32x4*)(ap + 4), a2 = *(const LAS f32x4*)(ap + 8), a3 = *(const LAS f32x4*)(ap + 12);
#pragma unroll
                for (int q = 0; q < 4; ++q) { a[q] += y * a0[q]; a[4 + q] += y * a1[q]; a[8 + q] += y * a2[q]; a[12 + q] += y * a3[q]; } }
#pragma unroll
            for (int ii = 1; ii < 16; ++ii)
#pragma unroll
                for (int jj = 0; jj < ii; ++jj) a[ii] += a[jj] * AP[(16 * ib + jj) * 68 + 16 * ib + ii];
#pragma unroll
            for (int ii = 0; ii < 16; ++ii) Yr[16 * ib + ii] = a[ii]; } }
#undef RW_PROD_TILE
    __syncthreads();
    { const int rb = w >> 1;
#pragma unroll
      for (int t = 0; t < 2; ++t) { const int cb = 2 * (w & 1) + t; f32x16 acc = zero16();
          mma32(acc, (rb < 2 ? NX : BZ) + 32 * (rb & 1) * 65, 65, 1, (cb < 2 ? BH : Pm) + 32 * (cb & 1), 65, 1, 64, lane);
          float* dst = MATS + (rb < 2 ? (cb < 2 ? 0 : 8192) : (cb < 2 ? 4096 : 12288));
#pragma unroll
          for (int r = 0; r < 16; ++r) { const int row = 32 * (rb & 1) + rreg(r, lane), col = 32 * (cb & 1) + (lane & 31); float v = acc[r];
              if (rb < 2 && cb < 2) v = (v + (row == col ? 1.0f : 0.0f)) * Ge[col]; else if (rb < 2) v += RTT[row * 65 + col]; else if (cb < 2) v = (v + KH[row * 65 + col]) * Ge[col]; else v += Qm[row * 65 + col];
              dst[row * 64 + col] = v; } } }
}
template <int SV = 0>
__device__ __forceinline__ void rwkv_state_scan(const Ctx& F, int h, int rg) {
    LAS float* Sx = (LAS float*)F.lds; LAS float* tmp = Sx + 1056; LAS float* ring = tmp + 1024;
    const float* RW = (const float*)(F.ws + O_RW); const size_t AS = (size_t)MP * 512; const float* MATS = (const float*)(F.ws + O_MATS); float* SST8 = (float*)(F.ws + (SV ? O_QKV : O_SSTATE));
    const float* ZERO = (const float*)((const bf16*)(F.ws + O_H) + (size_t)8300 * D);
    const int tid = F.tid, lane = F.lane, w = F.wave, fr = lane & 15, kq = lane >> 4, role = w >> 2, cbk = w & 3;
#define RW_DMA(cn) do { const int cc_ = (cn) < NRC ? (cn) : NRC - 1; const float* mp_ = MATS + (size_t)(cc_ * 8 + h) * 16384; LAS float* sl_ = ring + ((cn) % 3) * 9216; \
        _Pragma("unroll") for (int q_ = 0; q_ < 2; ++q_) { const int ch_ = w + 8 * q_; \
            __builtin_amdgcn_global_load_lds((const unsigned*)(mp_ + ch_ * 256 + lane * 4), (LAS unsigned*)(sl_ + ch_ * 256), 16, 0, 0); \
            __builtin_amdgcn_global_load_lds((const unsigned*)(mp_ + 4096 + ch_ * 256 + lane * 4), (LAS unsigned*)(sl_ + 4096 + ch_ * 256), 16, 0, 0); \
            const int j_ = 4 * ch_ + kq, s_ = RWC * cc_ + j_; const float* vp_ = s_ < T ? RW + 3 * AS + (size_t)row_of_seq(s_) * 512 + 64 * h + 16 * rg + fr : ZERO + fr; \
            __builtin_amdgcn_global_load_lds((const unsigned*)vp_, (LAS unsigned*)(sl_ + 8192 + ch_ * 64), 4, 0, 0); } } while (0)
    __syncthreads();
    for (int i = tid; i < 1056; i += NTHR) Sx[i] = 0.f;
    RW_DMA(0); RW_DMA(1);
    asm volatile("s_waitcnt vmcnt(0)" ::: "memory");
    __syncthreads();
    for (int c = 0; c < NRC; ++c) {
        if (SV != 1) RW_DMA(c + 2);
        { const int idx = 2 * tid, v = idx >> 6, kk = idx & 63; const f32x2 sv = (f32x2){Sx[v * 66 + kk], Sx[v * 66 + kk + 1]}; *(f32x2*)(SST8 + ((size_t)(c * 8 + h) * 64 + 16 * rg + v) * 64 + kk) = sv; }
        const LAS float* sl = ring + (c % 3) * 9216;
        float av[16], bv[16]; f32x4 acc = (f32x4){0.f, 0.f, 0.f, 0.f}, acc2 = acc;
        if (role == 0) { const LAS float* mb = sl + 16 * cbk + fr;
#pragma unroll
            for (int t = 0; t < 16; ++t) { av[t] = Sx[fr * 66 + 4 * t + kq]; bv[t] = mb[(4 * t + kq) * 64]; }
        } else { const LAS float* wb = sl + 4096 + 16 * cbk + fr; const LAS float* vt = sl + 8192 + fr;
#pragma unroll
            for (int t = 0; t < 16; ++t) { av[t] = vt[(4 * t + kq) * 16]; bv[t] = wb[(4 * t + kq) * 64]; } }
#pragma unroll
        for (int t = 0; t < (SV == 2 ? 2 : 16); t += 2) { acc = __builtin_amdgcn_mfma_f32_16x16x4f32(av[t], bv[t], acc, 0, 0, 0); acc2 = __builtin_amdgcn_mfma_f32_16x16x4f32(av[t + 1], bv[t + 1], acc2, 0, 0, 0); }
        acc = acc + acc2;
        if (role != 0) *(LAS f32x4*)(tmp + (cbk * 64 + lane) * 4) = acc;
        LBAR();
        if (role == 0) { acc = acc + *(const LAS f32x4*)(tmp + (cbk * 64 + lane) * 4);
#pragma unroll
            for (int r = 0; r < 4; ++r) Sx[(4 * kq + r) * 66 + 16 * cbk + fr] = acc[r]; }
        if (SV != 1) asm volatile("s_waitcnt vmcnt(8)" ::: "memory");
        LBAR();
    }
    asm volatile("s_waitcnt vmcnt(0)" ::: "memory");
#undef RW_DMA
}
__device__ __forceinline__ void rwkv_out_unit(const Ctx& F, int l, int c, int h) {
    LAS float* S_ = (LAS float*)F.lds; LAS float* E_ = S_ + 4160; LAS float* VT_ = E_ + 4096; LAS float* F_ = VT_ + 4096; LAS float* O_ = F_ + 4096;
    const float* RW = (const float*)(F.ws + O_RW); const size_t AS = (size_t)MP * 512; const float* MATS = (const float*)(F.ws + O_MATS) + (size_t)(c * 8 + h) * 16384;
    const float* SST8 = (const float*)(F.ws + O_SSTATE) + (size_t)(c * 8 + h) * 4096; const float* RBON = (const float*)(F.ws + O_RBON); bf16* Y = (bf16*)(F.ws + O_Y);
    int tid = F.tid, w = F.wave; asm volatile("" : "+v"(tid), "+s"(w)); const int lane = tid & 63;
    const f32x4 z4 = (f32x4){0.f, 0.f, 0.f, 0.f};
    f32x4 sv[2], ev[2], fv[2], tv[2];
#pragma unroll
    for (int q = 0; q < 2; ++q) { const int idx = tid + 512 * q, r = idx >> 4, c4 = idx & 15, s = RWC * c + r;
        sv[q] = *(const f32x4*)(SST8 + r * 64 + 4 * c4); ev[q] = *(const f32x4*)(MATS + 8192 + 4 * idx); fv[q] = *(const f32x4*)(MATS + 12288 + 4 * idx);
        tv[q] = s < T ? *(const f32x4*)(RW + 3 * AS + (size_t)row_of_seq(s) * 512 + 64 * h + 4 * c4) : z4; }
    const int li = tid >> 3, part = tid & 7, ls = RWC * c + li, lrow = ls < T ? row_of_seq(ls) : 0; const size_t lo = (size_t)lrow * 512 + 64 * h + 8 * part;
    f32x4 v0 = z4, v1 = z4, g0 = z4, g1 = z4; float bon = 0.f;
    if (ls < T) { v0 = *(const f32x4*)(RW + 3 * AS + lo); v1 = *(const f32x4*)(RW + 3 * AS + lo + 4); g0 = *(const f32x4*)(RW + 6 * AS + lo); g1 = *(const f32x4*)(RW + 6 * AS + lo + 4); bon = RBON[lrow * 8 + h]; }
    __syncthreads();
#pragma unroll
    for (int q = 0; q < 2; ++q) { const int idx = tid + 512 * q, r = idx >> 4, c4 = idx & 15;
        LAS float* d = S_ + r * 65 + 4 * c4; d[0] = sv[q][0]; d[1] = sv[q][1]; d[2] = sv[q][2]; d[3] = sv[q][3];
        *(LAS f32x4*)(E_ + 4 * idx) = ev[q]; *(LAS f32x4*)(F_ + 4 * idx) = fv[q]; *(LAS f32x4*)(VT_ + r * 64 + 4 * c4) = tv[q]; }
    LBAR();
    const int tr = (w >> 1) & 1, tc = w & 1; f32x16 acc = zero16();
    if (w < 4) mma32(acc, S_ + 32 * tr * 65, 65, 1, E_ + 32 * tc, 64, 1, 64, lane);
    else { mma32(acc, VT_ + 32 * tr, 1, 64, F_ + 32 * tc, 64, 1, 64, lane);
#pragma unroll
        for (int r = 0; r < 16; ++r) O_[(32 * tr + rreg(r, lane)) * 65 + 32 * tc + (lane & 31)] = acc[r]; }
    LBAR();
    if (w < 4) {
#pragma unroll
        for (int r = 0; r < 16; ++r) O_[(32 * tr + rreg(r, lane)) * 65 + 32 * tc + (lane & 31)] += acc[r]; }
    LBAR();
    { float x[8]; float sm = 0.f;
#pragma unroll
      for (int q = 0; q < 8; ++q) { x[q] = O_[(8 * part + q) * 65 + li]; sm += x[q]; }
      sm = sum8(sm);
      const float mu = sm * (1.0f / 64.0f); float vq = 0.f;
#pragma unroll
      for (int q = 0; q < 8; ++q) { const float d = x[q] - mu; vq += d * d; }
      vq = sum8(vq);
      const float rstd = 1.0f / sqrtf(vq * (1.0f / 64.0f) + 64e-5f);
      if (ls < T) { const float* lng = F.kp->in[I_LN] + l * 512 + 64 * h + 8 * part;
          float ov[8];
#pragma unroll
          for (int q = 0; q < 4; ++q) { ov[q] = ((x[q] - mu) * rstd * lng[q] + bon * v0[q]) * g0[q]; ov[4 + q] = ((x[4 + q] - mu) * rstd * lng[4 + q] + bon * v1[q]) * g1[q]; }
          v4u wv; wv.x = cvtpk(ov[0], ov[1]); wv.y = cvtpk(ov[2], ov[3]); wv.z = cvtpk(ov[4], ov[5]); wv.w = cvtpk(ov[6], ov[7]);
          *(v4u*)(Y + (size_t)lrow * D + 1536 + 64 * h + 8 * part) = wv; } }
}
__device__ __forceinline__ void ssd_states_unit(const Ctx& F, int c, int h) {
    LAS float* Bm = (LAS float*)F.lds; LAS float* XD = Bm + 16384; LAS float* csl = XD + 8192; LAS float* lal = csl + 128; LAS float* dtl = lal + 128;
    const float* XBC = (const float*)(F.ws + O_XBC); const float* DT = (const float*)(F.ws + O_DT); const float* LA = (const float*)(F.ws + O_LA);
    float* SST = (float*)(F.ws + O_SST); float* SDEC = (float*)(F.ws + O_SDEC);
    const int tid = F.tid, lane = F.lane, w = F.wave, g = h >> 2;
    __syncthreads();
    if (tid < 128) { const int row = crow(c, tid); lal[tid] = row >= 0 ? LA[row * 8 + h] : 0.f; dtl[tid] = row >= 0 ? DT[row * 8 + h] : 0.f; }
    __syncthreads();
    if (tid < 64) { const float e0 = lal[2 * tid], e1 = lal[2 * tid + 1]; float s = e0 + e1;
#pragma unroll
        for (int o = 1; o < 64; o <<= 1) { const float t = __shfl_up(s, o); if (tid >= o) s += t; }
        csl[2 * tid + 1] = s; csl[2 * tid] = s - e1; }
    __syncthreads();
    const float cs_end = csl[127];
#pragma unroll
    for (int k = 0; k < 8; ++k) { const int idx = tid + 512 * k, j = idx >> 5, c4 = idx & 31, row = crow(c, j);
        const f32x4 v = row >= 0 ? *(const f32x4*)(XBC + (size_t)row * 1024 + 512 + 128 * g + 4 * c4) : (f32x4){0.f, 0.f, 0.f, 0.f};
        *(LAS f32x4*)(Bm + j * 128 + 4 * c4) = v; }
#pragma unroll
    for (int k = 0; k < 4; ++k) { const int idx = tid + 512 * k, j = idx >> 4, c4 = idx & 15, row = crow(c, j);
        f32x4 v = row >= 0 ? *(const f32x4*)(XBC + (size_t)row * 1024 + 64 * h + 4 * c4) : (f32x4){0.f, 0.f, 0.f, 0.f};
        v = v * (dtl[j] * expf(cs_end - csl[j]));
        *(LAS f32x4*)(XD + j * 64 + 4 * c4) = v; }
    __syncthreads();
    const int tr = w >> 2, tc = w & 3;
    f32x16 acc = zero16();
    mma32(acc, XD + 32 * tr, 1, 64, Bm + 32 * tc, 128, 1, 128, lane);
    float* dst = SST + ((size_t)(c * 8 + h) * 64 + 32 * tr) * 128 + 32 * tc + (lane & 31);
#pragma unroll
    for (int r = 0; r < 16; ++r) dst[(size_t)rreg(r, lane) * 128] = acc[r];
    if (tid == 0) SDEC[(c * 8 + h) * 32] = expf(cs_end);
}
__device__ __forceinline__ float ret_logg(int h) { return logf(1.0f - exp2f(-5.0f - (float)h)); }
__device__ __forceinline__ void ret_states_unit(const Ctx& F, int c, int h) {
    LAS float* V = (LAS float*)F.lds; LAS float* KD = V + 16384;
    const float* U = (const float*)(F.ws + O_U); const float* RQK = (const float*)(F.ws + O_RQK); float* RST = (float*)(F.ws + O_RST);
    const int tid = F.tid, lane = F.lane, w = F.wave; const float lg = ret_logg(h);
    __syncthreads();
#pragma unroll
    for (int k = 0; k < 8; ++k) { const int idx = tid + 512 * k, j = idx >> 5, c4 = idx & 31, row = crow(c, j);
        const f32x4 v = row >= 0 ? *(const f32x4*)(U + (size_t)row * NINP + U_RET + 512 + 128 * h + 4 * c4) : (f32x4){0.f, 0.f, 0.f, 0.f};
        *(LAS f32x4*)(V + j * 128 + 4 * c4) = v; }
#pragma unroll
    for (int k = 0; k < 4; ++k) { const int idx = tid + 512 * k, j = idx >> 4, c4 = idx & 15, row = crow(c, j);
        f32x4 v = row >= 0 ? *(const f32x4*)(RQK + (size_t)row * 512 + 256 + 64 * h + 4 * c4) : (f32x4){0.f, 0.f, 0.f, 0.f};
        v = v * expf((float)(127 - j) * lg);
        *(LAS f32x4*)(KD + j * 64 + 4 * c4) = v; }
    __syncthreads();
    const int tr = w >> 1, tc = w & 1;
    f32x16 acc = zero16();
    mma32(acc, V + 32 * tr, 1, 128, KD + 32 * tc, 64, 1, 128, lane);
    float* dst = RST + ((size_t)(c * 4 + h) * 128 + 32 * tr) * 64 + 32 * tc + (lane & 31);
#pragma unroll
    for (int r = 0; r < 16; ++r) dst[(size_t)rreg(r, lane) * 64] = acc[r];
}

__device__ __forceinline__ void scan_job(float* base, size_t cstride, const float* dec, int decstride, float constdec) {
    float s = 0.f; float t[13], d[13];
#pragma unroll
    for (int i = 0; i < 13; ++i) { t[i] = base[(size_t)i * cstride]; d[i] = dec ? dec[i * decstride] : constdec; }
#pragma unroll
    for (int c0 = 0; c0 < NCH; c0 += 13) { float tn[13], dn[13];
        if (c0 + 13 < NCH) {
#pragma unroll
            for (int i = 0; i < 13; ++i) { tn[i] = base[(size_t)(c0 + 13 + i) * cstride]; dn[i] = dec ? dec[(c0 + 13 + i) * decstride] : constdec; } }
#pragma unroll
        for (int i = 0; i < 13; ++i) { base[(size_t)(c0 + i) * cstride] = s; s = d[i] * s + t[i]; }
#pragma unroll
        for (int i = 0; i < 13; ++i) { t[i] = tn[i]; d[i] = dn[i]; } }
}
__device__ __forceinline__ void rwkv_scan(const Ctx& F, int hb) {
    LAS float* st = (LAS float*)F.lds;
    float* RW = (float*)(F.ws + O_RW); const size_t AS = (size_t)MP * 512; float* OUT = RW + 7 * AS;
    const int tid = F.tid, lane = F.lane, rl = lane >> 3, ks = lane & 7, myrow = 8 * F.wave + rl;
    float S[8];
#pragma unroll
    for (int j = 0; j < 8; ++j) S[j] = 0.f;
    for (int s0 = 0; s0 < T; s0 += 32) {
        __syncthreads();
#pragma unroll
        for (int j = 0; j < 6; ++j) { const int idx = tid + 512 * j, stp = idx / 96, rem = idx % 96, arr = rem >> 4, c4 = rem & 15, s = s0 + stp;
            if (s < T) { const int row = row_of_seq(s); const int asel = arr == 0 ? 0 : (arr == 1 ? 1 : (arr == 2 ? 2 : (arr == 3 ? 4 : (arr == 4 ? 5 : 3))));
                *(LAS f32x4*)(st + stp * 384 + arr * 64 + 4 * c4) = *(const f32x4*)(RW + asel * AS + (size_t)row * 512 + 64 * hb + 4 * c4); } }
        __syncthreads();
        const int nst = (T - s0) < 32 ? (T - s0) : 32;
        for (int stp = 0; stp < nst; ++stp) { const LAS float* b = st + stp * 384 + 8 * ks;
            const f32x4 r0 = *(const LAS f32x4*)(b), r1 = *(const LAS f32x4*)(b + 4), w0 = *(const LAS f32x4*)(b + 64), w1 = *(const LAS f32x4*)(b + 68), k0 = *(const LAS f32x4*)(b + 128), k1 = *(const LAS f32x4*)(b + 132),
                        n0 = *(const LAS f32x4*)(b + 192), n1 = *(const LAS f32x4*)(b + 196), b0 = *(const LAS f32x4*)(b + 256), b1 = *(const LAS f32x4*)(b + 260);
            const float vv = st[stp * 384 + 320 + myrow];
            float sa = (S[0] * n0[0] + S[1] * n0[1]) + (S[2] * n0[2] + S[3] * n0[3]) + (S[4] * n1[0] + S[5] * n1[1]) + (S[6] * n1[2] + S[7] * n1[3]);
            sa += __shfl_xor(sa, 1); sa += __shfl_xor(sa, 2); sa += __shfl_xor(sa, 4);
            float o = 0.f;
#pragma unroll
            for (int j = 0; j < 4; ++j) { S[j] = S[j] * w0[j] + sa * b0[j] + vv * k0[j]; o += S[j] * r0[j]; S[4 + j] = S[4 + j] * w1[j] + sa * b1[j] + vv * k1[j]; o += S[4 + j] * r1[j]; }
            o += __shfl_xor(o, 1); o += __shfl_xor(o, 2); o += __shfl_xor(o, 4);
            if (ks == 0) OUT[(size_t)row_of_seq(s0 + stp) * 512 + 64 * hb + myrow] = o; }
    }
}
__device__ __forceinline__ void mla_prep2_unit(const Ctx& F, int l, int un) {
    const float* QKVb = (const float*)(F.ws + O_QKV); const float* U = (const float*)(F.ws + O_U);
    bf16* Q = (bf16*)(F.ws + O_Q); bf16* K = (bf16*)(F.ws + O_K); bf16* VT = (bf16*)(F.ws + O_VT);
    LAS bf16* Vl = (LAS bf16*)F.lds;
    const int lane = F.lane, tid = F.tid;
    const float* gq = F.kp->in[I_QKNQ] + l * 192; const float* gk = F.kp->in[I_QKNK] + l * 192;
    const float gq0 = gq[lane], gq1 = gq[64 + lane], gq2 = gq[128 + lane], gk0 = gk[lane], gk1 = gk[64 + lane], gk2 = gk[128 + lane];
    const float qs = 0.07216878364870322f * 1.4426950408889634f;
    __syncthreads();
#pragma unroll 1
    for (int ib = 0; ib < 8; ib += 4) {
        float xq[4][12], xk[4][8], xv[4][8], kpe[4]; f32x2 cs[4];
#pragma unroll
        for (int p = 0; p < 4; ++p) { const int s = 64 * un + 8 * F.wave + ib + p; const int row = s < T ? row_of_seq(s) : 0; const float* qk = QKVb + (size_t)row * MLAN;
            cs[p] = ((const f32x2*)(F.ws + O_ROPE))[row * 32 + (lane & 31)]; kpe[p] = U[(size_t)row * NINP + 512 + lane];
#pragma unroll
            for (int h = 0; h < 4; ++h) { xq[p][3 * h] = qk[192 * h + lane]; xq[p][3 * h + 1] = qk[192 * h + 64 + lane]; xq[p][3 * h + 2] = qk[192 * h + 128 + lane];
                xk[p][2 * h] = qk[768 + 256 * h + lane]; xk[p][2 * h + 1] = qk[768 + 256 * h + 64 + lane]; xv[p][2 * h] = qk[768 + 256 * h + 128 + lane]; xv[p][2 * h + 1] = qk[768 + 256 * h + 192 + lane]; } }
#pragma unroll
        for (int p = 0; p < 4; ++p) { const int sl = 8 * F.wave + ib + p, s = 64 * un + sl; const bool ok = s < T;
#pragma unroll
            for (int h = 0; h < 4; ++h) {
                { float x0 = xq[p][3 * h], x1 = xq[p][3 * h + 1], x2 = xq[p][3 * h + 2];
                  const float rs = 1.0f / sqrtf(wave_sum(x0 * x0 + x1 * x1 + x2 * x2) * (1.0f / 192.0f) + EPS);
                  x0 *= rs * gq0; x1 *= rs * gq1; x2 *= rs * gq2;
                  const float ot = xor32f(x2, lane); const float rr = lane < 32 ? x2 * cs[p].x - ot * cs[p].y : ot * cs[p].y + x2 * cs[p].x;
                  bf16* qd = Q + ((size_t)s * 4 + h) * 192; qd[lane] = (bf16)f2bf(x0 * qs); qd[64 + lane] = (bf16)f2bf(x1 * qs); qd[128 + lane] = (bf16)f2bf(rr * qs); }
                { float x0 = xk[p][2 * h], x1 = xk[p][2 * h + 1], x2 = kpe[p];
                  const float rs = 1.0f / sqrtf(wave_sum(x0 * x0 + x1 * x1 + x2 * x2) * (1.0f / 192.0f) + EPS);
                  x0 *= rs * gk0; x1 *= rs * gk1; x2 *= rs * gk2;
                  const float ot = xor32f(x2, lane); const float rr = lane < 32 ? x2 * cs[p].x - ot * cs[p].y : ot * cs[p].y + x2 * cs[p].x;
                  bf16* kd = K + ((size_t)s * 4 + h) * 192; kd[lane] = (bf16)f2bf(x0); kd[64 + lane] = (bf16)f2bf(x1); kd[128 + lane] = (bf16)f2bf(rr); }
                Vl[(h * 128 + lane) * 66 + sl] = ok ? (bf16)f2bf(xv[p][2 * h]) : (bf16)0; Vl[(h * 128 + 64 + lane) * 66 + sl] = ok ? (bf16)f2bf(xv[p][2 * h + 1]) : (bf16)0; } }
    }
    __syncthreads();
#pragma unroll
    for (int k = 0; k < 8; ++k) { const int idx = tid + 512 * k, r = idx >> 3, j = idx & 7; const LAS unsigned* src = (const LAS unsigned*)(Vl + r * 66 + 8 * j);
        v4u w; w.x = src[0]; w.y = src[1]; w.z = src[2]; w.w = src[3];
        *(v4u*)(VT + (size_t)r * TSEQ + 64 * un + 8 * j) = w; }
}
__device__ __forceinline__ void m3_phase(const Ctx& F, int l) {
    const int b2 = F.bid, NB = F.G;
    for (int job = b2; job < 192; job += NB) {
        if (job < 128) { if (!EN_SSD) continue; const int e = job * 512 + F.tid, h = e >> 13, rest = e & 8191; scan_job((float*)(F.ws + O_SST) + (size_t)h * 8192 + rest, (size_t)8 * 8192, (const float*)(F.ws + O_SDEC) + h * 32, 8 * 32, 0.f); }
        else { if (!EN_RET) continue; const int e = (job - 128) * 512 + F.tid, h = e >> 13, rest = e & 8191; scan_job((float*)(F.ws + O_RST) + (size_t)h * 8192 + rest, (size_t)4 * 8192, nullptr, 0, expf(128.0f * ret_logg(h))); }
    }
    if (EN_MLA) for (int un = NB - 1 - b2; un < (T + 63) / 64; un += NB) mla_prep2_unit(F, l, un);
}
template <int VAR = 0>
__device__ __forceinline__ void attn_unit(const Ctx& F, int hh, int qb, size_t yoff = O_Y) {
    LAS bf16* L0 = (LAS bf16*)F.lds;
    const bf16* Q = (const bf16*)(F.ws + O_Q); const bf16* K = (const bf16*)(F.ws + O_K); const bf16* VT = (const bf16*)(F.ws + O_VT); bf16* Y = (bf16*)(F.ws + yoff);
    int tid = F.tid, w = F.wave; asm volatile("" : "+v"(tid), "+s"(w));
    const int lane = tid & 63, h = lane >> 5, c = lane & 31, half = w >> 2, wq = w & 3;
    const int sq = 128 * qb + 32 * wq + c;
    bf16x8 qf[12];
#pragma unroll
    for (int ks = 0; ks < 12; ++ks) qf[ks] = *(const bf16x8*)(Q + ((size_t)sq * 4 + hh) * 192 + 16 * ks + 8 * h);
    f32x16 o[4];
#pragma unroll
    for (int t = 0; t < 4; ++t) o[t] = zero16();
    float m = -1e30f, lsum = 0.f;
    const int nst = qb + 1;
    v4u kr[6], vr[4];
    const unsigned kgo = (unsigned)(((tid >> 3) * 4 + hh) * 192 + 8 * (tid & 7)), klo = (unsigned)((tid >> 3) * 200 + 8 * (tid & 7));
    const unsigned vgo = (unsigned)((hh * 128 + (tid >> 2)) * TSEQ + 8 * (tid & 3)), vlo = (unsigned)(12800 + (tid >> 2) * 68 + 8 * (tid & 3));
#define AT_LOADK(st_) do { const bf16* kb_ = K + (size_t)(128 * (st_)) * 768; _Pragma("unroll") for (int j = 0; j < 6; ++j) kr[j] = *(const v4u*)(kb_ + kgo + (j / 3) * 49152 + 64 * (j % 3)); } while (0)
#define AT_LOADV(st_) do { const bf16* vb_ = VT + 128 * (st_); _Pragma("unroll") for (int j = 0; j < 4; ++j) vr[j] = *(const v4u*)(vb_ + vgo + (j >> 1) * 64 + 32 * (j & 1)); } while (0)
#define AT_STOREK() do { _Pragma("unroll") for (int j = 0; j < 6; ++j) *(LAS v4u*)(L0 + klo + (j / 3) * 22016 + 64 * (j % 3)) = kr[j]; } while (0)
#define AT_STOREV() do { _Pragma("unroll") for (int j = 0; j < 4; ++j) { LAS bf16* vd_ = L0 + vlo + (j >> 1) * 22016 + 32 * (j & 1); *(LAS v2u*)vd_ = (v2u){vr[j].x, vr[j].y}; *(LAS v2u*)(vd_ + 4) = (v2u){vr[j].z, vr[j].w}; } } while (0)
    __syncthreads();
    AT_LOADK(0); AT_LOADV(0); AT_STOREK(); AT_STOREV(); if (nst > 1) AT_LOADK(1);
    LBAR();
    const LAS bf16* Ks = L0 + half * 22016; const LAS bf16* Vs = Ks + 12800;
    for (int st = 0; st < nst; ++st) {
        const int kt = 2 * st + half;
        f32x16 sa[2];
#pragma unroll
        for (int t2 = 0; t2 < 2; ++t2) { sa[t2] = zero16();
#pragma unroll
            for (int ks = 0; ks < 12; ++ks) { const bf16x8 a = *(const LAS bf16x8*)(Ks + (32 * t2 + c) * 200 + 16 * ks + 8 * h); sa[t2] = __builtin_amdgcn_mfma_f32_32x32x16_bf16(a, qf[ks], sa[t2], 0, 0, 0); } }
        if (st == nst - 1) {
#pragma unroll
            for (int t2 = 0; t2 < 2; ++t2)
#pragma unroll
                for (int r = 0; r < 16; ++r) { const int key = 64 * kt + 32 * t2 + (r & 3) + 8 * (r >> 2) + 4 * h; if (key > sq) sa[t2][r] = -1e30f; } }
        float mx = -1e30f;
#pragma unroll
        for (int t2 = 0; t2 < 2; ++t2)
#pragma unroll
            for (int r = 0; r < 16; ++r) mx = fmaxf(mx, sa[t2][r]);
        mx = fmaxf(mx, __shfl_xor(mx, 32));
        if (__builtin_amdgcn_ballot_w64(mx > m) != 0ull) { const float mn = fmaxf(m, mx), alpha = __builtin_amdgcn_exp2f(m - mn); m = mn; lsum *= alpha;
#pragma unroll
            for (int t = 0; t < 4; ++t) o[t] = o[t] * alpha; }
        float rs = 0.f;
#pragma unroll
        for (int t2 = 0; t2 < 2; ++t2)
#pragma unroll
            for (int r = 0; r < 16; ++r) { const float pv = __builtin_amdgcn_exp2f(sa[t2][r] - m); sa[t2][r] = pv; rs += pv; }
        rs += __shfl_xor(rs, 32);
        lsum += rs;
        LBAR();
        if (st + 1 < nst) { AT_STOREK(); AT_LOADV(st + 1); }
#pragma unroll
        for (int t2 = 0; t2 < 2; ++t2)
#pragma unroll
            for (int s = 0; s < 2; ++s) { v4u pw; pw.x = cvtpk(sa[t2][8 * s], sa[t2][8 * s + 1]); pw.y = cvtpk(sa[t2][8 * s + 2], sa[t2][8 * s + 3]); pw.z = cvtpk(sa[t2][8 * s + 4], sa[t2][8 * s + 5]); pw.w = cvtpk(sa[t2][8 * s + 6], sa[t2][8 * s + 7]);
                const bf16x8 pf = __builtin_bit_cast(bf16x8, pw);
#pragma unroll
                for (int t = 0; t < 4; ++t) { const LAS bf16* vp = Vs + (32 * t + c) * 68 + 32 * t2 + 16 * s + 4 * h; const v2u lo = *(const LAS v2u*)vp, hi = *(const LAS v2u*)(vp + 8);
                    v4u vw; vw.x = lo.x; vw.y = lo.y; vw.z = hi.x; vw.w = hi.y;
                    o[t] = __builtin_amdgcn_mfma_f32_32x32x16_bf16(__builtin_bit_cast(bf16x8, vw), pf, o[t], 0, 0, 0); } }
        LBAR();
        if (st + 1 < nst) { AT_STOREV(); if (st + 2 < nst) AT_LOADK(st + 2); }
    }
#undef AT_LOADK
#undef AT_LOADV
#undef AT_STOREK
#undef AT_STOREV
    LAS float* MB = (LAS float*)F.lds + (wq * 64 + lane) * 67;
    if (half == 1) { MB[0] = m; MB[1] = lsum;
#pragma unroll
        for (int t = 0; t < 4; ++t)
#pragma unroll
            for (int r = 0; r < 16; ++r) MB[2 + 16 * t + r] = o[t][r]; }
    LBAR();
    if (half == 0) { const float m2 = MB[0], l2 = MB[1], mn = fmaxf(m, m2), a1 = __builtin_amdgcn_exp2f(m - mn), a2 = __builtin_amdgcn_exp2f(m2 - mn);
        const float inv = 1.0f / (lsum * a1 + l2 * a2);
        if (sq < T) { bf16* yr = Y + (size_t)row_of_seq(sq) * D + 128 * hh + 4 * h;
#pragma unroll
            for (int t = 0; t < 4; ++t)
#pragma unroll
                for (int rq = 0; rq < 4; ++rq) { float ov[4];
#pragma unroll
                    for (int i = 0; i < 4; ++i) ov[i] = (o[t][4 * rq + i] * a1 + MB[2 + 16 * t + 4 * rq + i] * a2) * inv;
                    v2u wv; wv.x = cvtpk(ov[0], ov[1]); wv.y = cvtpk(ov[2], ov[3]); *(v2u*)(yr + 32 * t + 8 * rq) = wv; } } }
}
__device__ __forceinline__ void ssd_out_unit(const Ctx& F, int l, int c, int h, int ih) {
    LAS float* CS_ = (LAS float*)F.lds; LAS float* BS_ = CS_ + 4352; LAS float* PS_ = BS_ + 8704; LAS float* SC_ = PS_ + 4352; LAS float* XD_ = SC_ + 8448; LAS float* csl = XD_ + 8448; LAS float* lal = csl + 128; LAS float* dtl = lal + 128;
    LAS float* Y_ = CS_;
    const float* XBC = (const float*)(F.ws + O_XBC); const float* DT = (const float*)(F.ws + O_DT); const float* LA = (const float*)(F.ws + O_LA); const float* U = (const float*)(F.ws + O_U);
    const float* SST = (const float*)(F.ws + O_SST); float* YZ = (float*)(F.ws + O_YZ);
    int tid = F.tid, w = F.wave; asm volatile("" : "+v"(tid), "+s"(w));
    const int lane = tid & 63, g = h >> 2;
    const f32x4 z4 = (f32x4){0.f, 0.f, 0.f, 0.f};
    float lav = 0.f, dtv = 0.f;
    if (tid < 128) { const int row = crow(c, tid); if (row >= 0) { lav = LA[row * 8 + h]; dtv = DT[row * 8 + h]; } }
    f32x4 xdv[4], csv[2][2], bsv[2][4], psv[2][2]; float xsv[8], zv[8];
#pragma unroll
    for (int k = 0; k < 4; ++k) { const int idx = tid + 512 * k, j = idx >> 4, c4 = idx & 15, row = crow(c, j); xdv[k] = row >= 0 ? *(const f32x4*)(XBC + (size_t)row * 1024 + 64 * h + 4 * c4) : z4; }
#pragma unroll
    for (int nh = 0; nh < 2; ++nh) {
#pragma unroll
        for (int k = 0; k < 2; ++k) { const int idx = tid + 512 * k, i = idx >> 4, c4 = idx & 15, row = crow(c, 64 * ih + i); csv[nh][k] = row >= 0 ? *(const f32x4*)(XBC + (size_t)row * 1024 + 768 + 128 * g + 64 * nh + 4 * c4) : z4; }
#pragma unroll
        for (int k = 0; k < 4; ++k) { const int idx = tid + 512 * k, j = idx >> 4, c4 = idx & 15, row = crow(c, j); bsv[nh][k] = row >= 0 ? *(const f32x4*)(XBC + (size_t)row * 1024 + 512 + 128 * g + 64 * nh + 4 * c4) : z4; }
#pragma unroll
        for (int k = 0; k < 2; ++k) { const int idx = tid + 512 * k, pp = idx >> 4, c4 = idx & 15; psv[nh][k] = *(const f32x4*)(SST + ((size_t)(c * 8 + h) * 64 + pp) * 128 + 64 * nh + 4 * c4); } }
#pragma unroll
    for (int k = 0; k < 8; ++k) { const int idx = tid + 512 * k, i = idx >> 6, pp = idx & 63, row = crow(c, 64 * ih + i); xsv[k] = 0.f; zv[k] = 0.f;
        if (row >= 0) { xsv[k] = XBC[(size_t)row * 1024 + 64 * h + pp]; zv[k] = U[(size_t)row * NINP + U_SSD + 64 * h + pp]; } }
    __syncthreads();
    if (tid < 128) { lal[tid] = lav; dtl[tid] = dtv; }
    LBAR();
    if (tid < 64) { const float e0 = lal[2 * tid], e1 = lal[2 * tid + 1]; float s = e0 + e1;
#pragma unroll
        for (int o = 1; o < 64; o <<= 1) { const float t = __shfl_up(s, o); if (tid >= o) s += t; }
        csl[2 * tid + 1] = s; csl[2 * tid] = s - e1; }
#pragma unroll
    for (int k = 0; k < 4; ++k) { const int idx = tid + 512 * k, j = idx >> 4, c4 = idx & 15; const f32x4 v = xdv[k] * dtl[j]; LAS float* d = XD_ + (4 * c4) * 132 + j; d[0] = v[0]; d[132] = v[1]; d[264] = v[2]; d[396] = v[3]; }
    f32x16 acc_s = zero16(), acc_y = zero16();
    const int tr = w >> 2, tc = w & 3, tr2 = (w >> 1) & 1, tc2 = w & 1;
#pragma unroll
    for (int nh = 0; nh < 2; ++nh) {
        if (nh) LBAR();
#pragma unroll
        for (int k = 0; k < 2; ++k) { const int idx = tid + 512 * k, i = idx >> 4, c4 = idx & 15; const f32x4 v = csv[nh][k]; *(LAS f32x4*)(CS_ + i * 68 + 4 * c4) = v; }
#pragma unroll
        for (int k = 0; k < 4; ++k) { const int idx = tid + 512 * k, j = idx >> 4, c4 = idx & 15; const f32x4 v = bsv[nh][k]; *(LAS f32x4*)(BS_ + j * 68 + 4 * c4) = v; }
#pragma unroll
        for (int k = 0; k < 2; ++k) { const int idx = tid + 512 * k, pp = idx >> 4, c4 = idx & 15; const f32x4 v = psv[nh][k]; *(LAS f32x4*)(PS_ + pp * 68 + 4 * c4) = v; }
        LBAR();
        mma32bf(acc_s, CS_ + 32 * tr * 68, 68, BS_ + 32 * tc * 68, 68, 64, lane);
        if (w < 4) mma32bf(acc_y, CS_ + 32 * tr2 * 68, 68, PS_ + 32 * tc2 * 68, 68, 64, lane);
    }
    if (w < 4) {
#pragma unroll
        for (int r = 0; r < 16; ++r) acc_y[r] *= expf(csl[64 * ih + 32 * tr2 + rreg(r, lane)]); }
#pragma unroll
    for (int r = 0; r < 16; ++r) { const int i = 32 * tr + rreg(r, lane), j = 32 * tc + (lane & 31), il = 64 * ih + i;
        SC_[i * 132 + j] = j <= il ? acc_s[r] * expf(csl[il] - csl[j]) : 0.f; }
    LBAR();
    if (w < 4) { mma32bf(acc_y, SC_ + 32 * tr2 * 132, 132, XD_ + 32 * tc2 * 132, 132, 128, lane);
#pragma unroll
        for (int r = 0; r < 16; ++r) Y_[(32 * tr2 + rreg(r, lane)) * 68 + 32 * tc2 + (lane & 31)] = acc_y[r]; }
    LBAR();
    const float Dh = F.kp->in[I_SSDD][l * 8 + h];
#pragma unroll
    for (int k = 0; k < 8; ++k) { const int idx = tid + 512 * k, i = idx >> 6, pp = idx & 63, row = crow(c, 64 * ih + i);
        if (row >= 0) YZ[(size_t)row * 512 + 64 * h + pp] = (Y_[i * 68 + pp] + Dh * xsv[k]) * siluf_(zv[k]); }
}
__device__ __forceinline__ void ret_out_unit(const Ctx& F, int l, int c, int h, int ih) {
    LAS float* Q_ = (LAS float*)F.lds; LAS float* KM_ = Q_ + 4352; LAS float* SC_ = KM_ + 8704; LAS float* VH_ = SC_ + 8448; LAS float* SP_ = KM_; LAS float* Y_ = SC_;
    const float* U = (const float*)(F.ws + O_U); const float* RQK = (const float*)(F.ws + O_RQK); const float* RST = (const float*)(F.ws + O_RST); bf16* Y = (bf16*)(F.ws + O_Y);
    int tid = F.tid, w = F.wave; asm volatile("" : "+v"(tid), "+s"(w));
    const int lane = tid & 63; const float lg = ret_logg(h);
    const f32x4 z4 = (f32x4){0.f, 0.f, 0.f, 0.f};
    f32x4 qv[2], kv[4], spv[4], vv[2][4], gv[4];
#pragma unroll
    for (int k = 0; k < 2; ++k) { const int idx = tid + 512 * k, i = idx >> 4, c4 = idx & 15, row = crow(c, 64 * ih + i); qv[k] = row >= 0 ? *(const f32x4*)(RQK + (size_t)row * 512 + 64 * h + 4 * c4) : z4; }
#pragma unroll
    for (int k = 0; k < 4; ++k) { const int idx = tid + 512 * k, j = idx >> 4, c4 = idx & 15, row = crow(c, j); kv[k] = row >= 0 ? *(const f32x4*)(RQK + (size_t)row * 512 + 256 + 64 * h + 4 * c4) : z4; }
#pragma unroll
    for (int k = 0; k < 4; ++k) { const int idx = tid + 512 * k, vx = idx >> 4, c4 = idx & 15; spv[k] = *(const f32x4*)(RST + ((size_t)(c * 4 + h) * 128 + vx) * 64 + 4 * c4); }
#pragma unroll
    for (int jh = 0; jh < 2; ++jh)
#pragma unroll
        for (int k = 0; k < 4; ++k) { const int idx = tid + 512 * k, j = idx >> 5, c4 = idx & 31, row = crow(c, 64 * jh + j); vv[jh][k] = (jh <= ih && row >= 0) ? *(const f32x4*)(U + (size_t)row * NINP + U_RET + 512 + 128 * h + 4 * c4) : z4; }
    const int li = tid >> 3, part = tid & 7, lrow = crow(c, 64 * ih + li);
#pragma unroll
    for (int k = 0; k < 4; ++k) gv[k] = lrow >= 0 ? *(const f32x4*)(U + (size_t)lrow * NINP + U_RET + 1024 + 128 * h + 16 * part + 4 * k) : z4;
    __syncthreads();
#pragma unroll
    for (int k = 0; k < 2; ++k) { const int idx = tid + 512 * k, i = idx >> 4, c4 = idx & 15; const f32x4 v = qv[k]; *(LAS f32x4*)(Q_ + i * 68 + 4 * c4) = v; }
#pragma unroll
    for (int k = 0; k < 4; ++k) { const int idx = tid + 512 * k, j = idx >> 4, c4 = idx & 15; const f32x4 v = kv[k]; *(LAS f32x4*)(KM_ + j * 68 + 4 * c4) = v; }
    LBAR();
    const int tr = w >> 2, tc = w & 3;
    f32x16 acc_s = zero16();
    mma32bf(acc_s, Q_ + 32 * tr * 68, 68, KM_ + 32 * tc * 68, 68, 64, lane);
    LBAR();
#pragma unroll
    for (int k = 0; k < 4; ++k) { const int idx = tid + 512 * k, vx = idx >> 4, c4 = idx & 15; const f32x4 v = spv[k]; *(LAS f32x4*)(SP_ + vx * 68 + 4 * c4) = v; }
#pragma unroll
    for (int r = 0; r < 16; ++r) { const int i = 32 * tr + rreg(r, lane), j = 32 * tc + (lane & 31), il = 64 * ih + i;
        SC_[i * 132 + j] = j <= il ? acc_s[r] * expf((float)(il - j) * lg) : 0.f; }
#pragma unroll
    for (int k = 0; k < 4; ++k) { const int idx = tid + 512 * k, j = idx >> 5, c4 = idx & 31; const f32x4 v = vv[0][k]; LAS float* d = VH_ + (4 * c4) * 68 + j; d[0] = v[0]; d[68] = v[1]; d[136] = v[2]; d[204] = v[3]; }
    LBAR();
    f32x16 acc_y = zero16();
    mma32bf(acc_y, Q_ + 32 * tr * 68, 68, SP_ + 32 * tc * 68, 68, 64, lane);
#pragma unroll
    for (int r = 0; r < 16; ++r) acc_y[r] *= expf((float)(64 * ih + 32 * tr + rreg(r, lane) + 1) * lg);
    mma32bf(acc_y, SC_ + 32 * tr * 132, 132, VH_ + 32 * tc * 68, 68, 64, lane);
    if (ih) { LBAR();
#pragma unroll
        for (int k = 0; k < 4; ++k) { const int idx = tid + 512 * k, j = idx >> 5, c4 = idx & 31; const f32x4 v = vv[1][k]; LAS float* d = VH_ + (4 * c4) * 68 + j; d[0] = v[0]; d[68] = v[1]; d[136] = v[2]; d[204] = v[3]; }
        LBAR();
        mma32bf(acc_y, SC_ + 32 * tr * 132 + 64, 132, VH_ + 32 * tc * 68, 68, 64, lane); }
    LBAR();
#pragma unroll
    for (int r = 0; r < 16; ++r) Y_[(32 * tr + rreg(r, lane)) * 132 + 32 * tc + (lane & 31)] = acc_y[r];
    LBAR();
    { const LAS float* yr = Y_ + li * 132 + 16 * part;
      float s = 0.f;
#pragma unroll
      for (int k = 0; k < 16; ++k) s += yr[k];
      s = sum8(s);
      const float mu = s * (1.0f / 128.0f); float q = 0.f;
#pragma unroll
      for (int k = 0; k < 16; ++k) { const float d = yr[k] - mu; q += d * d; }
      q = sum8(q);
      const float rstd = 1.0f / sqrtf(q * (1.0f / 128.0f) + EPS);
      if (lrow >= 0) { const float* ng = F.kp->in[I_RETN] + l * 512 + 128 * h + 16 * part; float ov[16];
#pragma unroll
          for (int k = 0; k < 16; ++k) ov[k] = (yr[k] - mu) * rstd * ng[k] * siluf_(gv[k >> 2][k & 3]);
          bf16* yd = Y + (size_t)lrow * D + 1024 + 128 * h + 16 * part;
          v4u w0, w1; w0.x = cvtpk(ov[0], ov[1]); w0.y = cvtpk(ov[2], ov[3]); w0.z = cvtpk(ov[4], ov[5]); w0.w = cvtpk(ov[6], ov[7]); w1.x = cvtpk(ov[8], ov[9]); w1.y = cvtpk(ov[10], ov[11]); w1.z = cvtpk(ov[12], ov[13]); w1.w = cvtpk(ov[14], ov[15]);
          *(v4u*)yd = w0; *(v4u*)(yd + 8) = w1; } }
}
__device__ __forceinline__ void m4_phase(const Ctx& F, int l, int qi = 0, int only = -1) {
    unsigned* ctr = (unsigned*)(F.ws + O_CTL) + CW_QUEUE + 64 * (4 * l + qi);
    constexpr int N_AT = 4 * NCH, N_CV = 128, N_SO = NCH * 16, N_RO = NCH * 8, N_WO = NRC * 8, N_ALL = N_AT + N_CV + N_SO + N_RO + N_WO;
    int u = queue_next(F, ctr);
    while (u < N_AT) { if (only < 0) attn_unit<0>(F, u & 3, (NCH - 1) - (u >> 2)); else if (only == 0) attn_unit<DUP_VAR>(F, u & 3, (NCH - 1) - (u >> 2), O_QKV); u = queue_next(F, ctr); }
    while (u < N_AT + N_CV) { if (l + 1 < DEPTH && only < 0) { __syncthreads(); convert_layer(F, l + 1, (u - N_AT) * NWAVES + F.wave, N_CV * NWAVES); }
        u = queue_next(F, ctr); }
    while (u < N_AT + N_CV + N_SO + N_RO) { int v = u - N_AT - N_CV;
        if (v < N_RO) { const int c = v >> 3, h = (v >> 1) & 3, ih = v & 1; if (!(c == 0 && ih == 0) && (only < 0 || only == 2)) ret_out_unit(F, l, c, h, ih); }
        else { v -= N_RO; const int c = v >> 4, h = (v >> 1) & 7, ih = v & 1; if (!(c == 0 && ih == 0) && (only < 0 || only == 1)) ssd_out_unit(F, l, c, h, ih); }
        u = queue_next(F, ctr); }
    if (u < N_ALL && only < 0) {
        if (F.tid == 0) { unsigned* sflag = (unsigned*)(F.ws + O_CTL) + CW_QUEUE + 64 * (16 + l); const unsigned nscan = F.G >= 64 ? 32u : (unsigned)F.G; unsigned sp = 0;
            while (__hip_atomic_load(sflag, __ATOMIC_RELAXED, __HIP_MEMORY_SCOPE_AGENT) < nscan) { __builtin_amdgcn_s_sleep(8); if (++sp > (1u << 22)) break; }
            __builtin_amdgcn_fence(__ATOMIC_ACQUIRE, "agent"); asm volatile("s_waitcnt vmcnt(0)" ::: "memory"); }
        __syncthreads(); }
    while (u < N_ALL) { const int v = u - (N_AT + N_CV + N_SO + N_RO); if (only < 0 || only == 3) rwkv_out_unit(F, l, v >> 3, v & 7); u = queue_next(F, ctr); }
}
__device__ __forceinline__ void m5_phase(const Ctx& F, int l) {
#ifdef PROBE_DUP
    { const bf16* Y = (const bf16*)(F.ws + O_Y); const bf16* Y2 = (const bf16*)(F.ws + O_YZ); unsigned cnt = 0;
      for (int row = F.bid * NWAVES + F.wave; row < T; row += F.G * NWAVES) for (int j = 0; j < 8; ++j) cnt += Y[(size_t)row * D + 64 * j + F.lane] != Y2[(size_t)row * D + 64 * j + F.lane];
      if (cnt) atomicAdd((unsigned*)(F.ws + O_CTL) + 8, cnt); }
#endif
#ifdef PROBE_COPY_U
    { const float* U = (const float*)(F.ws + O_U); bf16* Y = (bf16*)(F.ws + O_Y);
      for (int row = F.bid * NWAVES + F.wave; row < T; row += F.G * NWAVES)
        for (int j = 0; j < 4; ++j) { const float* ur = U + (size_t)(PROBE_COPY_META ? SEQ + (row & 15) : row) * NINP + PROBE_COPY_U + 512 * j + 8 * F.lane; const f32x4 a = *(const f32x4*)ur, b = *(const f32x4*)(ur + 4);
          v4u w; w.x = pk2(a[0], a[1]); w.y = pk2(a[2], a[3]); w.z = pk2(b[0], b[1]); w.w = pk2(b[2], b[3]); *(v4u*)(Y + (size_t)row * D + 512 * j + 8 * F.lane) = w; } }
#endif
    if (!EN_SSD) return;
    const float* YZ = (const float*)(F.ws + O_YZ); bf16* Y = (bf16*)(F.ws + O_Y); const float* ng = F.kp->in[I_SSDN] + l * 512 + 8 * F.lane;
    for (int row = F.bid * NWAVES + F.wave; row < T; row += F.G * NWAVES) { const float* yr = YZ + (size_t)row * 512 + 8 * F.lane; const f32x4 a = *(const f32x4*)yr, b = *(const f32x4*)(yr + 4);
        const float sq = wave_sum((a[0] * a[0] + a[1] * a[1]) + (a[2] * a[2] + a[3] * a[3]) + (b[0] * b[0] + b[1] * b[1]) + (b[2] * b[2] + b[3] * b[3]));
        const float rs = 1.0f / sqrtf(sq * (1.0f / 512.0f) + EPS); const f32x4 g0 = *(const f32x4*)ng, g1 = *(const f32x4*)(ng + 4);
        v4u w; w.x = pk2(a[0] * rs * g0[0], a[1] * rs * g0[1]); w.y = pk2(a[2] * rs * g0[2], a[3] * rs * g0[3]); w.z = pk2(b[0] * rs * g1[0], b[1] * rs * g1[1]); w.w = pk2(b[2] * rs * g1[2], b[3] * rs * g1[3]);
        *(v4u*)(Y + (size_t)row * D + 512 + 8 * F.lane) = w; }
}
template <int MODE  , int NT>
__device__ __forceinline__ void meta_gemm(const Ctx& F, const bf16* A16, int lda, const bf16* Bt, int ldb, int ntasks, int K, float* Cf, int ldc, const float* ss_in, float* ss_out, bf16* Ob, bf16* HL, float scale) {
    constexpr int NACC = MODE == 1 ? 2 * NT : NT;
    LAS float* red = (LAS float*)F.lds;
    int tid = F.tid, w = F.wave; asm volatile("" : "+v"(tid), "+s"(w));
    const int lane = tid & 63, g = lane >> 4, c = lane & 15, kper = K >> 3;
    for (int task = F.G - 1 - F.bid; task < ntasks; task += F.G) {
        const int n0 = MODE == 1 ? 256 * ((64 * task) >> 7) + ((64 * task) & 127) : 16 * NT * task;
        f32x4 acc[NACC];
#pragma unroll
        for (int q = 0; q < NACC; ++q) acc[q] = (f32x4){0.f, 0.f, 0.f, 0.f};
        const bf16* ap = A16 + (size_t)c * lda + w * kper + 8 * g; const bf16* bp = Bt + (size_t)(n0 + c) * ldb + w * kper + 8 * g;
#pragma unroll 4
        for (int kk = 0; kk < kper; kk += 32) { const bf16x8 a = *(const bf16x8*)(ap + kk);
#pragma unroll
            for (int t = 0; t < NT; ++t) { acc[t] = __builtin_amdgcn_mfma_f32_16x16x32_bf16(*(const bf16x8*)(bp + (size_t)(16 * t) * ldb + kk), a, acc[t], 0, 0, 0);
                if (MODE == 1) acc[NT + t] = __builtin_amdgcn_mfma_f32_16x16x32_bf16(*(const bf16x8*)(bp + (size_t)(128 + 16 * t) * ldb + kk), a, acc[NT + t], 0, 0, 0); } }
        __syncthreads();
#pragma unroll
        for (int q = 0; q < NACC; ++q) *(LAS f32x4*)(red + ((w * NACC + q) * 64 + lane) * 4) = acc[q];
        __syncthreads();
        if (w == 0) { const int row = SEQ + c; float rs = 1.0f;
            if (ss_in) { float s = 0.f;
#pragma unroll
                for (int q = 0; q < 8; ++q) { const f32x4 x = *(const f32x4*)(ss_in + (size_t)row * 32 + 4 * q); s += (x[0] + x[1]) + (x[2] + x[3]); }
                rs = __builtin_amdgcn_rsqf(s * (1.0f / 2048.0f) + EPS); }
            float sq = 0.f;
#pragma unroll
            for (int t = 0; t < NT; ++t) { f32x4 v = (f32x4){0.f, 0.f, 0.f, 0.f}, v2 = v;
#pragma unroll
                for (int ww = 0; ww < 8; ++ww) { v = v + *(const LAS f32x4*)(red + ((ww * NACC + t) * 64 + lane) * 4); if (MODE == 1) v2 = v2 + *(const LAS f32x4*)(red + ((ww * NACC + NT + t) * 64 + lane) * 4); }
                if (MODE == 0) *(f32x4*)(Cf + (size_t)row * ldc + 16 * NT * task + 16 * t + 4 * g) = v * rs;
                if (MODE == 3) { v2u wv; wv.x = pk2(v[0] * rs, v[1] * rs); wv.y = pk2(v[2] * rs, v[3] * rs); *(v2u*)(Ob + (size_t)row * ldc + 16 * NT * task + 16 * t + 4 * g) = wv; }
                if (MODE == 1) { float o[4];
#pragma unroll
                    for (int i = 0; i < 4; ++i) { const float gv = v[i] * rs, uv = v2[i] * rs; o[i] = gv * uv * __builtin_amdgcn_rcpf(1.0f + __expf(-gv)); }
                    v2u wv; wv.x = pk2(o[0], o[1]); wv.y = pk2(o[2], o[3]); *(v2u*)(Ob + (size_t)row * DFF + 64 * task + 16 * t + 4 * g) = wv; }
                if (MODE == 2) { const size_t off = (size_t)row * D + 64 * task + 16 * t + 4 * g; const v2u hi = *(const v2u*)(Ob + off), lo = *(const v2u*)(HL + off);
                    f32x4 h4 = (f32x4){pg8::bflo(hi.x) + pg8::bflo(lo.x), pg8::bfhi(hi.x) + pg8::bfhi(lo.x), pg8::bflo(hi.y) + pg8::bflo(lo.y), pg8::bfhi(hi.y) + pg8::bfhi(lo.y)}; h4 = h4 + v * scale;
                    v2u wv; wv.x = cvtpk(h4[0], h4[1]); wv.y = cvtpk(h4[2], h4[3]); v2u lv; lv.x = cvtpk(h4[0] - pg8::bflo(wv.x), h4[1] - pg8::bfhi(wv.x)); lv.y = cvtpk(h4[2] - pg8::bflo(wv.y), h4[3] - pg8::bfhi(wv.y));
                    *(v2u*)(Ob + off) = wv; *(v2u*)(HL + off) = lv; sq += (h4[0] * h4[0] + h4[1] * h4[1]) + (h4[2] * h4[2] + h4[3] * h4[3]); } }
            if (MODE == 2 && ss_out) { sq += __shfl_xor(sq, 16); sq += __shfl_xor(sq, 32); if (g == 0) __hip_atomic_fetch_add(ss_out + (size_t)row * 32 + task, sq, __ATOMIC_RELAXED, __HIP_MEMORY_SCOPE_AGENT); } }
    }    __syncthreads();
}
__device__ __forceinline__ void gemm_swiglu(const Ctx& F, int hl, int ssidx) {
    const bf16* A = (const bf16*)(F.ws + O_HB); const bf16* Bt = (const bf16*)(F.ws + O_WGU) + (size_t)hl * 11264 * 2048; const float* ss = (const float*)(F.ws + O_SS) + (size_t)ssidx * MP * 32;
    { pg8::Gemm g{A, Bt, SEQ, 11264, 2048, 2048, 2048, F.wave}; pg8::StaticOrder S; S.init(SEQ, 11264, F.G, F.bid);
      const int full = (S.nwg / F.G) * F.G, rem = S.nwg - full;
      const bool split = false && (2 * rem == F.G);
      if (split) S.lim = full;
      pg8::EpiSwiGLU E{(bf16*)(F.ws + O_ACT), DFF, ss, 1.0f / 2048.0f, EPS, 2};
      pg8::gemm_phase<pg8::EpiSwiGLU, pg8::StaticOrder, true, true, false>(F.lds, g, S, E);
      if (split) { pg8::StaticOrder S2; S2.init(SEQ, 11264, F.G, F.bid); S2.hmbase = full;
          pg8::EpiSwiGLU E2{(bf16*)(F.ws + O_ACT), DFF, ss, 1.0f / 2048.0f, EPS, 1};
          pg8::gemm_phase<pg8::EpiSwiGLU, pg8::StaticOrder, true, true, true>(F.lds, g, S2, E2); } }
    meta_gemm<1, 4>(F, A + (size_t)SEQ * 2048, 2048, Bt, 2048, DFF / 64, 2048, nullptr, 0, ss, nullptr, (bf16*)(F.ws + O_ACT), nullptr, 0.f);
}
__device__ __forceinline__ void gemm_residual(const Ctx& F, const bf16* A, const bf16* Bt, int K, int ssidx, bool to_out, float scale) {
    float* sso = ssidx >= 0 ? (float*)(F.ws + O_SS) + (size_t)ssidx * MP * 32 : nullptr;
    { pg8::Gemm g{A, Bt, SEQ, 2048, K, K, K, F.wave}; pg8::StaticOrder S; S.init(SEQ, 2048, F.G, F.bid);
      pg8::EpiResidual E{(bf16*)(F.ws + O_H), (bf16*)(F.ws + O_HB), sso, to_out ? F.kp->out : nullptr, SEQ, scale};
      pg8::gemm_phase<pg8::EpiResidual, pg8::StaticOrder, true, true>(F.lds, g, S, E); }
    meta_gemm<2, 4>(F, A + (size_t)SEQ * K, K, Bt, K, 32, K, nullptr, 0, nullptr, sso, (bf16*)(F.ws + O_HB), (bf16*)(F.ws + O_H), scale);
}
__device__ __forceinline__ void gemm_residual_dummy(const Ctx& F, const bf16* A, const bf16* Bt, int K) {
    { pg8::Gemm g{A, Bt, SEQ, 2048, K, K, K, F.wave}; pg8::StaticOrder S; S.init(SEQ, 2048, F.G, F.bid);
      pg8::EpiResidual E{(bf16*)(F.ws + O_RW), (bf16*)(F.ws + O_RW + (size_t)72 * 1024 * 1024), nullptr, nullptr, SEQ, 0.5f};
      pg8::gemm_phase<pg8::EpiResidual, pg8::StaticOrder, true, true>(F.lds, g, S, E); }
}
__device__ __forceinline__ void gemm_scalef32(const Ctx& F, const bf16* A, const bf16* Bt, int N, int K, float* C, int ssidx) {
    const float* ss = ssidx >= 0 ? (const float*)(F.ws + O_SS) + (size_t)ssidx * MP * 32 : nullptr;
    { pg8::Gemm g{A, Bt, SEQ, N, K, K, K, F.wave}; pg8::StaticOrder S; S.init(SEQ, N, F.G, F.bid);
      pg8::EpiScaleF32 E{C, N, ss, 1.0f / 2048.0f, EPS};
      pg8::gemm_phase<pg8::EpiScaleF32, pg8::StaticOrder, true, true>(F.lds, g, S, E); }
    meta_gemm<0, 4>(F, A + (size_t)SEQ * K, K, Bt, K, N / 64, K, C, N, ss, nullptr, nullptr, nullptr, 0.f);
}
__global__ void __launch_bounds__(NTHR, 2) hybrid_fwd(P p) {
    extern __shared__ __attribute__((aligned(16))) unsigned char lds_raw[];
    LAS unsigned char* lds = (LAS unsigned char*)lds_raw;
    const int wv = __builtin_amdgcn_readfirstlane((int)threadIdx.x >> 6);
    for (int u = threadIdx.x; u < (LDS_BYTES - LDSCTL_OFF) / 4; u += NTHR) ((LAS unsigned*)(lds + LDSCTL_OFF))[u] = 0u;
    __syncthreads();
    XcdBarrier bar = xcd_barrier_post((unsigned*)(p.ws + O_CTL) + CW_BAR, (volatile LAS unsigned*)(lds + LDSCTL_OFF), wv);
    const int lo = p.ph_lo, hi = p.ph_hi;
#ifdef TIME_MASK
    if (blockIdx.x == TIME_BLK && threadIdx.x == 0) { volatile LAS unsigned long long* tp_ = (volatile LAS unsigned long long*)(lds + LDSCTL_OFF + 1024); tp_[0] = wall_clock64(); tp_[1] = 0ull; }
#endif
#define IN(k) (lo <= (k) && (k) < hi)
#ifdef TIME_MASK
#ifndef TIME_PRE
#define TIME_PRE 0
#endif
#ifndef TIME_BLK
#define TIME_BLK 0
#endif
#define TMARK(kind, post) do { if (blockIdx.x == TIME_BLK && threadIdx.x == 0) { const unsigned long long now_ = wall_clock64(); volatile LAS unsigned long long* tp_ = (volatile LAS unsigned long long*)(lds + LDSCTL_OFF + 1024); \
    if ((((post) ? TIME_MASK : TIME_PRE) >> (kind)) & 1) tp_[1] += now_ - tp_[0]; if (post) tp_[0] = now_; } } while (0)
#define SEAM(k, kind) do { TMARK(kind, 0); if (IN(k) && IN((k) + 1)) xcd_barrier(bar, wv); TMARK(kind, 1); } while (0)
#else
#define TMARK(kind, post) do { } while (0)
#define SEAM(k, kind) do { if (IN(k) && IN((k) + 1)) xcd_barrier(bar, wv); } while (0)
#endif
#ifndef NO_P0
    if (IN(0)) { const Ctx F = ctx_make(lds, wv); p0_prologue(F, 0); }
#ifdef DUP_CVT
    if (IN(0)) { const Ctx F = ctx_make(lds, wv); p0_prologue(F, 1); }
#endif
#endif
    SEAM(0, 0);
    for (int hl = 0; hl < 8; ++hl) {
        const int l = hl >> 1, second = hl & 1, base = 1 + 11 * l + (second ? 9 : 0);
        if (IN(base)) { const Ctx F = ctx_make(lds, wv); gemm_swiglu(F, hl, 3 * l + (second ? 2 : 0)); }
#ifdef DUP_GU
        if (IN(base)) { const Ctx F = ctx_make(lds, wv); gemm_swiglu(F, hl, 3 * l + (second ? 2 : 0)); }
#endif
        SEAM(base, 1);
        if (IN(base + 1)) { const Ctx F = ctx_make(lds, wv);
            gemm_residual(F, (const bf16*)(F.ws + O_ACT), (const bf16*)(F.ws + O_WD) + (size_t)hl * 2048 * 5632, 5632, second ? (l < 3 ? 3 * (l + 1) : -1) : 3 * l + 1, hl == 7, 0.5f); }
#ifdef DUP_DOWN
        if (IN(base + 1)) { const Ctx F = ctx_make(lds, wv); if (DUP_DOWN == 1) gemm_residual_dummy(F, (const bf16*)(F.ws + O_ACT), (const bf16*)(F.ws + O_WD) + (size_t)hl * 2048 * 5632, 5632); else gemm_residual_dummy(F, (const bf16*)(F.ws + O_Y), (const bf16*)(F.ws + O_WOUT) + (size_t)l * D * D, 2048); }
#endif
        if (hl < 7) SEAM(base + 1, 2);
        if (!second) {
            const int mb = base + 2;
            if (IN(mb)) { const Ctx F = ctx_make(lds, wv); gemm_scalef32(F, (const bf16*)(F.ws + O_HB), (const bf16*)(F.ws + O_WIN) + (size_t)l * NINP * D, NINP, 2048, (float*)(F.ws + O_U), 3 * l + 1); }
            if (IN(mb) && l == 0) { const Ctx F = ctx_make(lds, wv); cv_tail0(F, IT_GU / 2, IT_GU, (32 * 21) % F.G); }
#ifdef DUP_WIN
            if (IN(mb)) { const Ctx F = ctx_make(lds, wv); gemm_scalef32(F, (const bf16*)(F.ws + O_HB), (const bf16*)(F.ws + O_WIN) + (size_t)l * NINP * D, NINP, 2048, (float*)(F.ws + O_U), 3 * l + 1); }
#endif
            SEAM(mb, 3);
#ifndef NO_M1
            if (IN(mb + 1)) { const Ctx F = ctx_make(lds, wv); m1_phase(F, l); }
#ifdef DUP_M1
            if (IN(mb + 1)) { const Ctx F = ctx_make(lds, wv); m1_phase(F, l, 3); }
#endif
#endif
            SEAM(mb + 1, 4);
            if (IN(mb + 2)) {
                if (EN_MLA) { const Ctx F = ctx_make(lds, wv); gemm_scalef32(F, (const bf16*)(F.ws + O_AMLA), (const bf16*)(F.ws + O_WMLA) + (size_t)l * MLAN * 512, MLAN, 512, (float*)(F.ws + O_QKV), -1); }
#ifndef NO_M2
                { const Ctx F = ctx_make(lds, wv); unsigned* ctr = (unsigned*)(F.ws + O_CTL) + CW_QUEUE + 64 * (4 * l + 2);
                  for (;;) { int u = queue_next(F, ctr); if (u >= NRC * 8 + NCH * 8 + NCH * 4) break;
                      if (u < NRC * 8) { rwkv_chunk_unit(F, u >> 3, u & 7); continue; } u -= NRC * 8;
                      if (u < NCH * 8) { ssd_states_unit(F, u >> 3, u & 7); continue; } u -= NCH * 8;
                      ret_states_unit(F, u >> 2, u & 3); } }
#ifdef DUP_M2Q
                { const Ctx F = ctx_make(lds, wv); unsigned* ctr = (unsigned*)(F.ws + O_CTL) + CW_QUEUE + 64 * (4 * l + 3);
                  for (;;) { int u = queue_next(F, ctr); if (u >= NRC * 8 + NCH * 8 + NCH * 4) break;
                      if (u < NRC * 8) { rwkv_chunk_unit(F, u >> 3, u & 7); continue; } u -= NRC * 8;
                      if (u < NCH * 8) { ssd_states_unit(F, u >> 3, u & 7); continue; } u -= NCH * 8;
                      ret_states_unit(F, u >> 2, u & 3); } }
#endif
#endif
            }
            SEAM(mb + 2, 5);
#ifndef NO_M3
            if (IN(mb + 3)) { const Ctx F = ctx_make(lds, wv); m3_phase(F, l); }
#ifdef DUP_SCAN
            if (IN(mb + 3)) { const Ctx F = ctx_make(lds, wv); if (F.bid < 32) rwkv_state_scan<DUP_SCAN>(F, F.bid >> 2, F.bid & 3); }
#endif
#endif
            SEAM(mb + 3, 6);
#ifndef NO_M4
            if (IN(mb + 4)) { const Ctx F = ctx_make(lds, wv); const int nscan = F.G >= 64 ? 32 : F.G;
                if (F.bid < nscan) { for (int s = F.bid; s < 32; s += nscan) rwkv_state_scan<0>(F, s >> 2, s & 3);
                    asm volatile("s_waitcnt vmcnt(0)" ::: "memory"); __syncthreads();
                    if (F.tid == 0) { __builtin_amdgcn_fence(__ATOMIC_RELEASE, "agent"); asm volatile("s_waitcnt vmcnt(0)" ::: "memory"); __hip_atomic_fetch_add((unsigned*)(F.ws + O_CTL) + CW_QUEUE + 64 * (16 + l), 1u, __ATOMIC_RELAXED, __HIP_MEMORY_SCOPE_AGENT); } } }
            if (IN(mb + 4)) { const Ctx F = ctx_make(lds, wv); m4_phase(F, l); }
#ifdef DUP_M4
            if (IN(mb + 4)) { const Ctx F = ctx_make(lds, wv); m4_phase(F, l, 3, DUP_M4 - 1); }
#endif
#endif
            SEAM(mb + 4, 7);
#ifndef NO_M5
            if (IN(mb + 5)) { const Ctx F = ctx_make(lds, wv); m5_phase(F, l); }
#ifdef DUP_M5
            if (IN(mb + 5)) { const Ctx F = ctx_make(lds, wv); m5_phase(F, l); }
#endif
#endif
            SEAM(mb + 5, 8);
#ifdef DUP_BAR
            for (int q = 0; q < 8; ++q) xcd_barrier(bar, wv);
#endif
            if (IN(mb + 6)) { const Ctx F = ctx_make(lds, wv); gemm_residual(F, (const bf16*)(F.ws + O_Y), (const bf16*)(F.ws + O_WOUT) + (size_t)l * D * D, 2048, 3 * l + 2, false, 1.0f); }
            SEAM(mb + 6, 9);
        }
    }
#ifdef TIME_MASK
    TMARK(2, 0); TMARK(2, 1);
    if (blockIdx.x == TIME_BLK && threadIdx.x == 0) { volatile LAS unsigned long long* tp_ = (volatile LAS unsigned long long*)(lds + LDSCTL_OFF + 1024); const unsigned long long t0_ = tp_[0], d_ = tp_[1];
        while (wall_clock64() - t0_ < d_) __builtin_amdgcn_s_sleep(8); }
#endif
#ifdef PROBE_DUP
    xcd_barrier(bar, wv);
    { const Ctx F = ctx_make(lds, wv); const float v = (float)__hip_atomic_load((unsigned*)(F.ws + O_CTL) + 8, __ATOMIC_RELAXED, __HIP_MEMORY_SCOPE_AGENT); float* out = F.kp->out;
      for (size_t i = (size_t)F.bid * NTHR + F.tid; i < (size_t)SEQ * D; i += (size_t)F.G * NTHR) out[i] = v; }
#endif
#ifdef PROBE_ADD_META
    xcd_barrier(bar, wv);
    { const Ctx F = ctx_make(lds, wv); const float* H = (const float*)(F.ws + O_H); float* out = F.kp->out;
      for (int row = F.bid * NWAVES + F.wave; row < SEQ; row += F.G * NWAVES)
        for (int j = 0; j < 8; ++j) { const int c = 256 * j + 4 * F.lane; f32x4 v = *(f32x4*)(out + (size_t)row * D + c); v = v + *(const f32x4*)(H + (size_t)(SEQ + (row & 15)) * D + c); *(f32x4*)(out + (size_t)row * D + c) = v; } }
#endif
#undef IN
#undef SEAM
}

extern "C" void kernel_launch(void* const* d_in, const int* in_sizes, int n_in, void* d_out, int out_size, void* d_ws, size_t ws_size, hipStream_t stream) {
    static int grid = 0;
    if (grid == 0) {
        if (n_in != 36 || out_size != SEQ * D || ws_size < WS_END) { fprintf(stderr, "kernel_launch: expected 36 inputs, out %d, ws >= %zu; got n_in %d out %d ws %zu\n", SEQ * D, (size_t)WS_END, n_in, out_size, ws_size); grid = -1; return; }
        int dev = 0, cus = 0, per_cu = 0;
        if (hipGetDevice(&dev) != hipSuccess || hipDeviceGetAttribute(&cus, hipDeviceAttributeMultiprocessorCount, dev) != hipSuccess) { grid = -1; return; }
        if (hipFuncSetAttribute((const void*)hybrid_fwd, hipFuncAttributeMaxDynamicSharedMemorySize, LDS_BYTES) != hipSuccess) { fprintf(stderr, "kernel_launch: hipFuncSetAttribute failed\n"); grid = -1; return; }
        if (hipOccupancyMaxActiveBlocksPerMultiprocessor(&per_cu, (const void*)hybrid_fwd, NTHR, LDS_BYTES) != hipSuccess || per_cu < 1) fprintf(stderr, "kernel_launch: occupancy query reports %d\n", per_cu);
        (void)hipGetLastError();
        grid = cus;
    }
    if (grid < 0) return;
    if (hipMemsetAsync((char*)d_ws + O_CTL, 0, SZ_CTL, stream) != hipSuccess) { fprintf(stderr, "kernel_launch: memset failed\n"); return; }
    P a{};
    for (int i = 0; i < 36; ++i) a.in[i] = (const float*)d_in[i];
    a.out = (float*)d_out; a.ws = (unsigned char*)d_ws;
#if PER_PHASE_LAUNCH
    for (int ph = 0; ph < NPHASE; ++ph) { a.ph_lo = ph; a.ph_hi = ph + 1; hipLaunchKernelGGL(hybrid_fwd, dim3(grid), dim3(NTHR), LDS_BYTES, stream, a); }
#else
    a.ph_lo = 0; a.ph_hi = NPHASE;
    hipLaunchKernelGGL(hybrid_fwd, dim3(grid), dim3(NTHR), LDS_BYTES, stream, a);
#endif
    const hipError_t le = hipPeekAtLastError();
    if (le != hipSuccess) fprintf(stderr, "kernel_launch: launch failed: %s\n", hipGetErrorName(le));
}
```

```cpp
#include <hip/hip_runtime.h>
#include <cstdio>
#include <cstdint>

#define GAS __attribute__((address_space(1)))
#define LAS __attribute__((address_space(3)))
typedef unsigned short bf16;
typedef unsigned v4u __attribute__((ext_vector_type(4)));
typedef unsigned v2u __attribute__((ext_vector_type(2)));
typedef float f32x4 __attribute__((ext_vector_type(4)));
typedef float f32x2 __attribute__((ext_vector_type(2)));
typedef float f32x16 __attribute__((ext_vector_type(16)));
typedef short bf16x8 __attribute__((ext_vector_type(8)));

constexpr int D = 2048, SEQ = 8192, NMETA = 16, T = SEQ + NMETA, MP = 8448, DFF = 5632, DEPTH = 4;
constexpr int NIN = 5320, NINP = 5376, NCH = 65, TSEQ = 8320, MLAN = 1792;
constexpr int U_MLA = 0, U_SSD = 576, U_RET = 2120, U_RWKV = 3656;
constexpr float EPS = 1e-6f;
constexpr int NWAVES = 8, NTHR = 512;
#ifndef EN_MLA
#define EN_MLA 1
#endif
#ifndef EN_SSD
#define EN_SSD 1
#endif
#ifndef EN_RET
#define EN_RET 1
#endif
#ifndef EN_RWKV
#define EN_RWKV 1
#endif
#ifndef PROBE_NOSCAN
#define PROBE_NOSCAN 0
#endif
#ifndef PROBE_ATTCOPY
#define PROBE_ATTCOPY 0
#endif
#ifndef PROBE_COPY_META
#define PROBE_COPY_META 0
#endif
#ifndef DUP_VAR
#define DUP_VAR 0
#endif
#ifndef PER_PHASE_LAUNCH
#define PER_PHASE_LAUNCH 0
#endif
constexpr int NPHASE = 1 + 8 * 2 + 4 * 7;

constexpr size_t O_CTL = 0, SZ_CTL = 13107200;
constexpr int CW_BAR = 4096;
constexpr size_t O_SS = 65536;
constexpr size_t O_WGU = O_CTL + SZ_CTL,                 SZ_WGU = (size_t)8 * 2 * DFF * D * 2;
constexpr size_t O_WD = O_WGU + SZ_WGU,                  SZ_WD = (size_t)8 * D * DFF * 2;
constexpr size_t O_WIN = O_WD + SZ_WD,                   SZ_WIN = (size_t)4 * NINP * D * 2;
constexpr size_t O_WOUT = O_WIN + SZ_WIN,                SZ_WOUT = (size_t)4 * D * D * 2;
constexpr size_t O_WMLA = O_WOUT + SZ_WOUT,              SZ_WMLA = (size_t)4 * MLAN * 512 * 2;
constexpr size_t O_H = O_WMLA + SZ_WMLA,                 SZ_H = (size_t)MP * D * 4;
constexpr size_t O_HB = O_H + SZ_H,                      SZ_HB = (size_t)MP * D * 2;
constexpr size_t O_U = O_HB + SZ_HB,                     SZ_U = (size_t)MP * NINP * 4;
constexpr size_t O_ACT = O_U;
constexpr size_t O_AMLA = O_U + SZ_U,                    SZ_AMLA = (size_t)MP * 512 * 2;
constexpr size_t O_QKV = O_AMLA + SZ_AMLA,               SZ_QKV = (size_t)MP * MLAN * 4;
constexpr size_t O_Q = O_QKV + SZ_QKV,                   SZ_Q = (size_t)TSEQ * 768 * 2;
constexpr size_t O_K = O_Q + SZ_Q;
constexpr size_t O_VT = O_K + SZ_Q,                      SZ_VT = (size_t)4 * 128 * TSEQ * 2;
constexpr size_t O_Y = O_VT + SZ_VT,                     SZ_Y = (size_t)MP * D * 2;
constexpr size_t O_XBC = O_Y + SZ_Y,                     SZ_XBC = (size_t)MP * 1024 * 4;
constexpr size_t O_DT = O_XBC + SZ_XBC,                  SZ_DT = (size_t)MP * 8 * 4;
constexpr size_t O_LA = O_DT + SZ_DT;
constexpr size_t O_SST = O_LA + SZ_DT,                   SZ_SST = (size_t)NCH * 8 * 64 * 128 * 4;
constexpr size_t O_SDEC = O_SST + SZ_SST,                SZ_SDEC = (size_t)NCH * 8 * 128;
constexpr size_t O_YZ = O_SDEC + SZ_SDEC,                SZ_YZ = (size_t)MP * 512 * 4;
constexpr size_t O_RQK = O_YZ + SZ_YZ,                   SZ_RQK = (size_t)MP * 512 * 4;
constexpr size_t O_RST = O_RQK + SZ_RQK,                 SZ_RST = (size_t)NCH * 4 * 128 * 64 * 4;
constexpr size_t O_RW = O_RST + SZ_RST,                  SZ_RW1 = (size_t)MP * 512 * 4;
constexpr size_t O_RBON = O_RW + 8 * SZ_RW1,             SZ_RBON = (size_t)MP * 8 * 4;
constexpr size_t O_ROPE = O_RBON + SZ_RBON,              SZ_ROPE = (size_t)MP * 32 * 8;
constexpr size_t O_MATS = O_ROPE + SZ_ROPE,             SZ_MATS = (size_t)129 * 8 * 16384 * 4;
constexpr size_t O_SSTATE = O_RW + 7 * SZ_RW1;
constexpr size_t WS_END = O_MATS + SZ_MATS;
static_assert((size_t)129 * 8 * 4096 * 4 <= SZ_RW1, "sstate");
static_assert(WS_END <= 1424122240ull, "d_ws map too large");
static_assert(O_SS + (size_t)12 * MP * 32 * 4 <= SZ_CTL, "ctl map");
static_assert((size_t)MP * DFF * 2 <= SZ_U, "act overlays u");

constexpr int RING_BYTES = 131072;
constexpr int LDSCTL_OFF = 143360;
constexpr int LDS_BYTES = 147456;

#define LDS_WAIT() asm volatile("s_waitcnt lgkmcnt(0)" ::: "memory")
#define LBAR() do { asm volatile("s_waitcnt lgkmcnt(0)" ::: "memory"); __builtin_amdgcn_s_barrier(); asm volatile("" ::: "memory"); } while (0)
constexpr int CW_QUEUE = 8192;
#define VM_WAIT() asm volatile("s_waitcnt vmcnt(0)" ::: "memory")
__device__ __forceinline__ unsigned f2bf(float f) { unsigned u = __builtin_bit_cast(unsigned, f); return (u + 0x7fffu + ((u >> 16) & 1u)) >> 16; }
__device__ __forceinline__ unsigned pk2(float lo, float hi) { return f2bf(lo) | (f2bf(hi) << 16); }
typedef __bf16 bf16x2_t __attribute__((ext_vector_type(2)));
__device__ __forceinline__ unsigned cvtpk(float lo, float hi) { const f32x2 v = {lo, hi}; return __builtin_bit_cast(unsigned, __builtin_convertvector(v, bf16x2_t)); }
__device__ __forceinline__ int lane_id() { unsigned ones = ~0u; asm volatile("" : "+s"(ones)); return (int)__builtin_amdgcn_mbcnt_hi(ones, __builtin_amdgcn_mbcnt_lo(ones, 0u)); }
template <int CTRL> __device__ __forceinline__ float dpp_(float v) { return __builtin_bit_cast(float, __builtin_amdgcn_update_dpp(0, __builtin_bit_cast(int, v), CTRL, 0xF, 0xF, true)); }
__device__ __forceinline__ float rdlane(float v, int l) { return __builtin_bit_cast(float, __builtin_amdgcn_readlane(__builtin_bit_cast(int, v), l)); }
__device__ __forceinline__ float sum4(float v) { v += dpp_<0xB1>(v); v += dpp_<0x4E>(v); return v; }
__device__ __forceinline__ float sum8(float v) { v = sum4(v); v += dpp_<0x141>(v); return v; }
__device__ __forceinline__ float sum16(float v) { v = sum8(v); v += dpp_<0x140>(v); return v; }
__device__ __forceinline__ float wave_sum(float v) { v = sum16(v); return (rdlane(v, 0) + rdlane(v, 16)) + (rdlane(v, 32) + rdlane(v, 48)); }
__device__ __forceinline__ float sum32(float v, int lane) { v = sum16(v); const float lo = rdlane(v, 0) + rdlane(v, 16), hi = rdlane(v, 32) + rdlane(v, 48); return (lane & 32) ? hi : lo; }
__device__ __forceinline__ float xor32f(float v, int lane) {
    const unsigned x = __builtin_bit_cast(unsigned, v); const auto r = __builtin_amdgcn_permlane32_swap(x, x, false, false);
    return __builtin_bit_cast(float, (lane & 32) ? r[0] : r[1]); }
__device__ __forceinline__ float sigmoidf_(float x) { return 1.0f / (1.0f + __expf(-x)); }
__device__ __forceinline__ float siluf_(float x) { return x / (1.0f + __expf(-x)); }
__device__ __forceinline__ float softplusf_(float x) { const float e = __expf(x);
    return x > 20.f ? x : (e < 0.0625f ? e * (1.0f - e * (0.5f - e * (0.33333334f - 0.25f * e))) : __logf(1.0f + e)); }
struct UB { const bf16* p;
    __device__ __forceinline__ float operator[](size_t i) const { return __builtin_bit_cast(float, (unsigned)p[i] << 16); }
    __device__ __forceinline__ UB operator+(size_t o) const { return UB{p + o}; } };
__device__ __forceinline__ f32x4 ldu4(const UB u) { const v2u w = *(const v2u*)u.p;
    return (f32x4){__builtin_bit_cast(float, w.x << 16), __builtin_bit_cast(float, w.x & 0xffff0000u), __builtin_bit_cast(float, w.y << 16), __builtin_bit_cast(float, w.y & 0xffff0000u)}; }
__device__ __forceinline__ int row_of_seq(int s) { return s < NMETA ? SEQ + s : s - NMETA; }
__device__ __forceinline__ int seq_of_row(int r) { return r >= SEQ ? r - SEQ : r + NMETA; }
__device__ __forceinline__ int prev_row(int r) { return r == SEQ ? -1 : (r == 0 ? T - 1 : r - 1); }
__device__ __forceinline__ int crow(int c, int p) { return c == 0 ? (p >= 112 ? SEQ + p - 112 : -1) : 128 * (c - 1) + p; }
namespace pg8 {
#define PG8_LAS __attribute__((address_space(3)))
typedef unsigned short bf16_t;
typedef short bf16x8 __attribute__((ext_vector_type(8)));
typedef float f32x4 __attribute__((ext_vector_type(4)));
typedef unsigned u32x4 __attribute__((ext_vector_type(4)));
constexpr int BM = 256, BK = 64, HALF = 128, HTB = HALF * BK * 2  , STAGE_BYTES = 8 * HTB, NXCD = 8, WGM = 8;

__host__ __device__ __forceinline__ int lds_byte(int r, int c) { const int st = (r >> 4) * 2 + (c >> 5), rr = r & 15, cc = c & 31, ob = rr * 64 + cc * 2; return st * 1024 + (ob ^ (((ob >> 9) & 1) << 5)); }
__host__ __device__ __forceinline__ void stage_rc(int b, int& R, int& C) { const int st = b / 1024, sb = b % 1024, swz = sb ^ (((sb >> 9) & 1) << 5); R = (st >> 1) * 16 + swz / 64; C = (st & 1) * 32 + (swz % 64) / 2; }
__host__ __device__ __forceinline__ int perm32(int rho) { const int n = rho >> 4, i = rho & 15; return 8 * (i >> 2) + 4 * n + (i & 3); }

struct Unit { int pm, pn, ah; };
struct Gemm { const bf16_t* A; const bf16_t* Bt; int M, N, K, lda, ldb, wv; };

struct StaticOrder {
    int nM, nN, nwg, G, c, lim, hmbase;
    __host__ __device__ void init(int M, int N, int G_, int c_) { nM = M / BM; nN = N / BM; nwg = nM * nN; G = G_; c = c_; lim = nwg; hmbase = -1; }
    __host__ __device__ bool next(int i, Unit& u) const {
        long L; u.ah = 0;
        if (hmbase >= 0) { if (i > 0) return false; L = hmbase + (c >> 1); u.ah = c & 1; if (L >= nwg) return false; }
        else { L = (long)i * G + c; if (L >= lim) return false; }
        int wgid = (int)L; { const int q = nwg / NXCD, r = nwg % NXCD, xcd = wgid % NXCD, off = wgid / NXCD; wgid = (xcd < r ? xcd * (q + 1) : r * (q + 1) + (xcd - r) * q) + off; }
        const int nig = WGM * nN, gid = wgid / nig, fm = gid * WGM, gsz = (nM - fm) < WGM ? (nM - fm) : WGM;
        u.pm = fm + ((wgid % nig) % gsz); u.pn = (wgid % nig) / gsz; return true;
    }
    __device__ __forceinline__ void a_ready(const Unit&) const {}
    __device__ __forceinline__ void done(const Unit&) const {}
};

__device__ __forceinline__ unsigned cvt_pk_bf16(float lo, float hi) { unsigned r; asm volatile("v_cvt_pk_bf16_f32 %0, %1, %2" : "=v"(r) : "v"(lo), "v"(hi)); return r; }

template <class Epi, class Sched, bool ALIGN_EPI = false, bool SP2 = false, bool HM = false>
__device__ __forceinline__ void gemm_phase(PG8_LAS unsigned char* lds, const Gemm g, const Sched& S, const Epi& E) {
    int tid = g.wv * 64 + lane_id(); asm volatile("" : "+v"(tid)); const int wid = g.wv, lane = tid & 63, wr = wid >> 2, wc = wid & 3, fr = lane & 15, fq = lane >> 4;
    const int K = g.K, nt = K / BK;
    unsigned voffA[2], voffB[2];
#pragma unroll
    for (int i = 0; i < 2; ++i) { int R, C; stage_rc(tid * 16 + i * 8192, R, C); const int Rb = Epi::PERM ? ((R & ~31) + perm32(R & 31)) : R;
        voffA[i] = (unsigned)(R * g.lda + C) * 2u; voffB[i] = (unsigned)(Rb * g.ldb + C) * 2u; }
    const size_t kstep = (size_t)(BK * 2);
    const size_t hA = (size_t)HALF * g.lda * 2, hB = (size_t)HALF * g.ldb * 2;
    const size_t tA = 2 * hA, tB = 2 * hB;
    const unsigned ldsw = (unsigned)wid * 1024u;
    const int aoff = lds_byte(wr * 64 + fr, fq * 8), boff = lds_byte(wc * 32 + fr, fq * 8);
#define PG8_SA(b, h) (((b) * 2 + (h)) * HTB)
#define PG8_SB(b, h) ((4 + (b) * 2 + (h)) * HTB)
#define PG8_STAGE(bufoff, gbase, voff) do { _Pragma("unroll") for (int _i = 0; _i < 2; ++_i) \
        __builtin_amdgcn_global_load_lds((const unsigned*)((const char*)(gbase) + (voff)[_i]), (PG8_LAS unsigned*)(lds + (bufoff) + ldsw + _i * 8192), 16, 0, 0); } while (0)
#define PG8_LDA(dst, b, h) do { _Pragma("unroll") for (int m = 0; m < 4; ++m) _Pragma("unroll") for (int k = 0; k < 2; ++k) dst[m][k] = *(const PG8_LAS bf16x8*)(lds + PG8_SA(b, h) + aoff + m * 2048 + k * 1024); } while (0)
#define PG8_LDB(dst, b, h) do { _Pragma("unroll") for (int n = 0; n < 2; ++n) _Pragma("unroll") for (int k = 0; k < 2; ++k) dst[n][k] = *(const PG8_LAS bf16x8*)(lds + PG8_SB(b, h) + boff + n * 2048 + k * 1024); } while (0)
#define PG8_MMA(ai, bj, At, Bt) do { __builtin_amdgcn_s_setprio(1); _Pragma("unroll") for (int m = 0; m < 4; ++m) _Pragma("unroll") for (int n = 0; n < 2; ++n) _Pragma("unroll") for (int k = 0; k < 2; ++k) \
        acc[ai][bj][m][n] = __builtin_amdgcn_mfma_f32_16x16x32_bf16(Bt[n][k], At[m][k], acc[ai][bj][m][n], 0, 0, 0); __builtin_amdgcn_s_setprio(0); } while (0)
#define PG8_WAIT_V(n) asm volatile("s_waitcnt vmcnt(" #n ")" ::: "memory")
#define PG8_WAIT_L(n) asm volatile("s_waitcnt lgkmcnt(" #n ")" ::: "memory")
#define PG8_BAR __builtin_amdgcn_s_barrier()
#define PG8_SCHED __builtin_amdgcn_sched_barrier(0)
    Unit cur, nxt; int ui = 0;
    if (!S.next(0, cur)) return;
    f32x4 acc[2][2][4][2];
#pragma unroll
    for (int a = 0; a < 2; ++a)
#pragma unroll
        for (int b = 0; b < 2; ++b)
#pragma unroll
            for (int m = 0; m < 4; ++m)
#pragma unroll
                for (int n = 0; n < 2; ++n) acc[a][b][m][n] = (f32x4){0.f, 0.f, 0.f, 0.f};
    bf16x8 At[4][2], B0[2][2], B1[2][2];
    const char* cA = (const char*)g.A + (size_t)cur.pm * tA + (size_t)cur.ah * hA; const char* cB = (const char*)g.Bt + (size_t)cur.pn * tB;
    S.a_ready(cur);
    if constexpr (SP2) {
        PG8_STAGE(PG8_SB(0, 0), cB, voffB); PG8_STAGE(PG8_SB(0, 1), cB + hB, voffB); PG8_STAGE(PG8_SA(0, 0), cA, voffA); PG8_STAGE(PG8_SA(0, 1), cA + hA, voffA);
        if (wr == 1) PG8_BAR;
        PG8_WAIT_V(2); PG8_BAR;
        PG8_STAGE(PG8_SB(1, 0), cB + kstep, voffB); PG8_STAGE(PG8_SA(1, 0), cA + kstep, voffA); PG8_STAGE(PG8_SB(1, 1), cB + hB + kstep, voffB);
        PG8_WAIT_V(6); PG8_BAR;
    } else {
        PG8_STAGE(PG8_SB(0, 0), cB, voffB); PG8_STAGE(PG8_SA(0, 0), cA, voffA); PG8_STAGE(PG8_SB(0, 1), cB + hB, voffB); PG8_STAGE(PG8_SA(0, 1), cA + hA, voffA);
        if (wr == 1) PG8_BAR;
        PG8_WAIT_V(4); PG8_BAR;
        PG8_STAGE(PG8_SB(1, 0), cB + kstep, voffB); PG8_STAGE(PG8_SA(1, 0), cA + kstep, voffA); PG8_STAGE(PG8_SB(1, 1), cB + hB + kstep, voffB);
        PG8_WAIT_V(6); PG8_BAR;
    }
    for (;;) {
        const bool has_next = S.next(ui + 1, nxt);
        const char* nA = has_next ? (const char*)g.A + (size_t)nxt.pm * tA + (size_t)nxt.ah * hA : cA; const char* nB = has_next ? (const char*)g.Bt + (size_t)nxt.pn * tB : cB;
        for (int t = 0; t < nt; t += 2) {
            const bool last = (t == nt - 2);
            const char* a1 = cA + (size_t)(t + 1) * kstep;
            const char* a2 = last ? nA : cA + (size_t)(t + 2) * kstep; const char* b2 = last ? nB : cB + (size_t)(t + 2) * kstep;
            const char* a3 = a2 + kstep; const char* b3 = b2 + kstep;
            if (last && has_next) S.a_ready(nxt);
            if constexpr (SP2) {
            PG8_LDB(B0, 0, 0); PG8_LDB(B1, 0, 1); PG8_SCHED; PG8_LDA(At, 0, 0); PG8_STAGE(PG8_SA(1, 1), a1 + hA, voffA);
            PG8_WAIT_V(8); PG8_WAIT_L(0); PG8_BAR; PG8_MMA(0, 0, At, B0); PG8_MMA(0, 1, At, B1); PG8_BAR; PG8_SCHED;
            if constexpr (!HM) PG8_LDA(At, 0, 1); PG8_STAGE(PG8_SB(0, 0), b2, voffB); PG8_STAGE(PG8_SB(0, 1), b2 + hB, voffB); PG8_STAGE(PG8_SA(0, 0), a2, voffA);
            PG8_WAIT_V(8); PG8_WAIT_L(0); PG8_BAR; if constexpr (!HM) { PG8_MMA(1, 0, At, B0); PG8_MMA(1, 1, At, B1); } PG8_BAR; PG8_SCHED;
            PG8_LDB(B0, 1, 0); PG8_LDB(B1, 1, 1); PG8_SCHED; PG8_LDA(At, 1, 0); PG8_STAGE(PG8_SA(0, 1), a2 + hA, voffA);
            PG8_WAIT_V(8); PG8_WAIT_L(0); PG8_BAR; PG8_MMA(0, 0, At, B0); PG8_MMA(0, 1, At, B1); PG8_BAR; PG8_SCHED;
            if constexpr (!HM) PG8_LDA(At, 1, 1); PG8_STAGE(PG8_SB(1, 0), b3, voffB); PG8_STAGE(PG8_SB(1, 1), b3 + hB, voffB); PG8_STAGE(PG8_SA(1, 0), a3, voffA);
            PG8_WAIT_V(8); PG8_WAIT_L(0); PG8_BAR; if constexpr (!HM) { PG8_MMA(1, 0, At, B0); PG8_MMA(1, 1, At, B1); } PG8_BAR; PG8_SCHED;
            } else {
            PG8_LDB(B0, 0, 0); PG8_SCHED; PG8_LDA(At, 0, 0); PG8_STAGE(PG8_SA(1, 1), a1 + hA, voffA);
            PG8_WAIT_L(8); PG8_BAR; PG8_WAIT_L(0); PG8_MMA(0, 0, At, B0); PG8_BAR; PG8_SCHED;
            PG8_LDB(B1, 0, 1); PG8_STAGE(PG8_SB(0, 0), b2, voffB);
            PG8_BAR; PG8_WAIT_L(0); PG8_MMA(0, 1, At, B1); PG8_BAR;
            PG8_LDA(At, 0, 1); PG8_STAGE(PG8_SA(0, 0), a2, voffA);
            PG8_BAR; PG8_WAIT_L(0); PG8_MMA(1, 0, At, B0); PG8_BAR; PG8_SCHED;
            PG8_STAGE(PG8_SB(0, 1), b2 + hB, voffB);
            PG8_WAIT_V(6); PG8_BAR; PG8_MMA(1, 1, At, B1); PG8_BAR;
            PG8_LDB(B0, 1, 0); PG8_SCHED; PG8_LDA(At, 1, 0); PG8_STAGE(PG8_SA(0, 1), a2 + hA, voffA);
            PG8_WAIT_L(8); PG8_BAR; PG8_WAIT_L(0); PG8_MMA(0, 0, At, B0); PG8_BAR; PG8_SCHED;
            PG8_LDB(B1, 1, 1); PG8_STAGE(PG8_SB(1, 0), b3, voffB);
            PG8_BAR; PG8_WAIT_L(0); PG8_MMA(0, 1, At, B1); PG8_BAR;
            PG8_LDA(At, 1, 1); PG8_STAGE(PG8_SA(1, 0), a3, voffA);
            PG8_BAR; PG8_WAIT_L(0); PG8_MMA(1, 0, At, B0); PG8_BAR; PG8_SCHED;
            PG8_STAGE(PG8_SB(1, 1), b3 + hB, voffB);
            PG8_WAIT_V(6); PG8_BAR; PG8_MMA(1, 1, At, B1); PG8_BAR;
            }
        }
        if constexpr (ALIGN_EPI) { if (wr == 0) PG8_BAR; }
        if constexpr (!Epi::AFTER_DRAIN) { E(acc, cur, wr, wc, fr, fq); S.done(cur); }
        if (!has_next) break;
#pragma unroll
        for (int a = 0; a < 2; ++a)
#pragma unroll
            for (int b = 0; b < 2; ++b)
#pragma unroll
                for (int m = 0; m < 4; ++m)
#pragma unroll
                    for (int n = 0; n < 2; ++n) acc[a][b][m][n] = (f32x4){0.f, 0.f, 0.f, 0.f};
        cur = nxt; cA = nA; cB = nB; ++ui;
        if constexpr (ALIGN_EPI) { if (wr == 1) PG8_BAR; }
    }
    PG8_WAIT_V(0);
    if constexpr (!ALIGN_EPI) { if (wr == 0) PG8_BAR; }
    PG8_BAR;
    if constexpr (Epi::AFTER_DRAIN) { E.fused(acc, cur, wr, wc, fr, fq, lds, wid, lane); S.done(cur); }
#undef PG8_SA
#undef PG8_SB
#undef PG8_STAGE
#undef PG8_LDA
#undef PG8_LDB
#undef PG8_MMA
#undef PG8_WAIT_V
#undef PG8_WAIT_L
#undef PG8_BAR
#undef PG8_SCHED
}

__device__ __forceinline__ float row_ss(const float* ss, int row, int fq) {
    const f32x4 a = *(const f32x4*)(ss + (size_t)row * 32 + 8 * fq), b = *(const f32x4*)(ss + (size_t)row * 32 + 8 * fq + 4);
    float s = ((a[0] + a[1]) + (a[2] + a[3])) + ((b[0] + b[1]) + (b[2] + b[3]));
    s += __shfl_xor(s, 16); s += __shfl_xor(s, 32); return s;
}
struct EpiScaleF32 {
    static constexpr bool PERM = false, AFTER_DRAIN = false;
    float* C; int ldc; const float* ss; float inv_d, eps;
    __device__ __forceinline__ void operator()(const f32x4 (&acc)[2][2][4][2], const Unit& u, int wr, int wc, int fr, int fq) const {
        const int row0 = u.pm * BM + wr * 64 + fr, col0 = u.pn * BM + wc * 32 + 4 * fq;
#pragma unroll
        for (int ai = 0; ai < 2; ++ai)
#pragma unroll
            for (int m = 0; m < 4; ++m) { const int row = row0 + ai * HALF + m * 16; float* rowp = C + (size_t)row * ldc + col0;
                const float rs = ss ? __builtin_amdgcn_rsqf(row_ss(ss, row, fq) * inv_d + eps) : 1.0f;
#pragma unroll
                for (int bj = 0; bj < 2; ++bj)
#pragma unroll
                    for (int n = 0; n < 2; ++n) *(f32x4*)(rowp + bj * HALF + n * 16) = acc[ai][bj][m][n] * rs; }
    }
};
struct EpiScaleBf16 {
    static constexpr bool PERM = true, AFTER_DRAIN = false;
    bf16_t* O; int ldo; const float* ss; float inv_d, eps;
    __device__ __forceinline__ void operator()(const f32x4 (&acc)[2][2][4][2], const Unit& u, int wr, int wc, int fr, int fq) const {
        const int row0 = u.pm * BM + wr * 64 + fr, col0 = u.pn * BM + wc * 32 + 8 * fq;
#pragma unroll
        for (int ai = 0; ai < 2; ++ai)
#pragma unroll
            for (int m = 0; m < 4; ++m) { const int row = row0 + ai * HALF + m * 16; const float rs = __builtin_amdgcn_rsqf(row_ss(ss, row, fq) * inv_d + eps);
#pragma unroll
                for (int bj = 0; bj < 2; ++bj) { const f32x4 v0 = acc[ai][bj][m][0] * rs, v1 = acc[ai][bj][m][1] * rs;
                    u32x4 w; w.x = cvt_pk_bf16(v0[0], v0[1]); w.y = cvt_pk_bf16(v0[2], v0[3]); w.z = cvt_pk_bf16(v1[0], v1[1]); w.w = cvt_pk_bf16(v1[2], v1[3]);
                    *(u32x4*)(O + (size_t)row * ldo + col0 + bj * HALF) = w; } }
    }
};
struct EpiSwiGLU {
    static constexpr bool PERM = true, AFTER_DRAIN = false;
    bf16_t* O; int ldo; const float* ss; float inv_d, eps; int nai;
    __device__ __forceinline__ void operator()(const f32x4 (&acc)[2][2][4][2], const Unit& u, int wr, int wc, int fr, int fq) const {
        const int row0 = u.pm * BM + u.ah * HALF + wr * 64 + fr, col0 = u.pn * HALF + wc * 32 + 8 * fq;
#pragma unroll
        for (int ai = 0; ai < 2; ++ai) { if (ai >= nai) break;
#pragma unroll
            for (int m = 0; m < 4; ++m) { const int row = row0 + ai * HALF + m * 16;
                const float rs = __builtin_amdgcn_rsqf(row_ss(ss, row, fq) * inv_d + eps);
                float o[8];
#pragma unroll
                for (int n = 0; n < 2; ++n)
#pragma unroll
                    for (int j = 0; j < 4; ++j) { const float gv = acc[ai][0][m][n][j] * rs, uv = acc[ai][1][m][n][j] * rs; o[n * 4 + j] = gv * uv * __builtin_amdgcn_rcpf(1.0f + __expf(-gv)); }
                u32x4 w; w.x = cvt_pk_bf16(o[0], o[1]); w.y = cvt_pk_bf16(o[2], o[3]); w.z = cvt_pk_bf16(o[4], o[5]); w.w = cvt_pk_bf16(o[6], o[7]);
                *(u32x4*)(O + (size_t)row * ldo + col0) = w; } }
    }
};
__device__ __forceinline__ float bflo(unsigned w) { return __builtin_bit_cast(float, w << 16); }
__device__ __forceinline__ float bfhi(unsigned w) { return __builtin_bit_cast(float, w & 0xffff0000u); }
struct EpiResidual {
    static constexpr bool PERM = true, AFTER_DRAIN = false;
    bf16_t* HL; bf16_t* HB; float* ss_out; float* out; int out_rows; float scale;
    __device__ __forceinline__ void operator()(const f32x4 (&acc)[2][2][4][2], const Unit& u, int wr, int wc, int fr, int fq) const {
        const int row0 = u.pm * BM + wr * 64 + fr, col0 = u.pn * BM + wc * 32 + 8 * fq;
#pragma unroll
        for (int ai = 0; ai < 2; ++ai)
#pragma unroll
            for (int m = 0; m < 4; ++m) { const int row = row0 + ai * HALF + m * 16; float sq = 0.f;
#pragma unroll
                for (int bj = 0; bj < 2; ++bj) { const size_t off = (size_t)row * 2048 + col0 + bj * HALF;
                    const u32x4 hi = *(const u32x4*)(HB + off), lo = *(const u32x4*)(HL + off);
                    f32x4 h0 = (f32x4){bflo(hi.x) + bflo(lo.x), bfhi(hi.x) + bfhi(lo.x), bflo(hi.y) + bflo(lo.y), bfhi(hi.y) + bfhi(lo.y)};
                    f32x4 h1 = (f32x4){bflo(hi.z) + bflo(lo.z), bfhi(hi.z) + bfhi(lo.z), bflo(hi.w) + bflo(lo.w), bfhi(hi.w) + bfhi(lo.w)};
                    h0 = h0 + acc[ai][bj][m][0] * scale; h1 = h1 + acc[ai][bj][m][1] * scale;
                    if (out && row < out_rows) { *(f32x4*)(out + off) = h0; *(f32x4*)(out + off + 4) = h1; }
                    u32x4 w; w.x = cvt_pk_bf16(h0[0], h0[1]); w.y = cvt_pk_bf16(h0[2], h0[3]); w.z = cvt_pk_bf16(h1[0], h1[1]); w.w = cvt_pk_bf16(h1[2], h1[3]);
                    u32x4 l2; l2.x = cvt_pk_bf16(h0[0] - bflo(w.x), h0[1] - bfhi(w.x)); l2.y = cvt_pk_bf16(h0[2] - bflo(w.y), h0[3] - bfhi(w.y)); l2.z = cvt_pk_bf16(h1[0] - bflo(w.z), h1[1] - bfhi(w.z)); l2.w = cvt_pk_bf16(h1[2] - bflo(w.w), h1[3] - bfhi(w.w));
                    *(u32x4*)(HB + off) = w; *(u32x4*)(HL + off) = l2;
                    sq += (h0[0] * h0[0] + h0[1] * h0[1]) + (h0[2] * h0[2] + h0[3] * h0[3]) + (h1[0] * h1[0] + h1[1] * h1[1]) + (h1[2] * h1[2] + h1[3] * h1[3]); }
                sq += __shfl_xor(sq, 16); sq += __shfl_xor(sq, 32);
                if (fq == 0 && ss_out) __hip_atomic_fetch_add(ss_out + (size_t)row * 32 + u.pn * 4 + wc, sq, __ATOMIC_RELAXED, __HIP_MEMORY_SCOPE_AGENT); }
    }
};
}
#define XB_TMO      128
#define XB_XCNT(j)  (256  + 64 * (j))
#define XB_XSUB(j)  (1280 + 64 * (j))
#define XB_XGEN(j)  (2304 + 64 * (j))
#define XB_TOP      3328
#define XB_TOPGEN   3392
#define XCD_BAR_WORDS 3456
#define XB_SPIN_CAP (1u << 18)

__device__ __forceinline__ unsigned xb_ld(unsigned* p)              { return __hip_atomic_load(p, __ATOMIC_RELAXED, __HIP_MEMORY_SCOPE_AGENT); }
__device__ __forceinline__ unsigned xb_add(unsigned* p, unsigned v) { return __hip_atomic_fetch_add(p, v, __ATOMIC_RELAXED, __HIP_MEMORY_SCOPE_AGENT); }
__device__ __forceinline__ unsigned xb_xcc_id() { return (unsigned)__builtin_amdgcn_s_getreg((3 << 11) | 20) & 0xFu; }
#define XB_SPIN(cond, bar) do { unsigned _sp = 0; while (cond) { __builtin_amdgcn_s_sleep(1); \
    if ((++_sp & 255u) == 0u) { if (xb_ld(&(bar)[XB_TMO])) break; if (_sp > XB_SPIN_CAP) { atomicAdd(&(bar)[XB_TMO], 1u); break; } } } } while (0)

struct XcdBarrier {
    unsigned* bar; unsigned x;
    volatile LAS unsigned* st;
};

__device__ __forceinline__ XcdBarrier xcd_barrier_post(unsigned* bar, volatile LAS unsigned* st, int wv) {
    XcdBarrier b; b.bar = bar; b.x = xb_xcc_id(); b.st = st;
    if ((wv == 0 && lane_id() == 0)) (void)xb_add(&bar[XB_XCNT(b.x)], 1u);
    return b;
}
__device__ __forceinline__ void xcd_barrier_complete(unsigned* bar, unsigned x, unsigned& nloc, unsigned& nx) {
    const unsigned G = gridDim.x * gridDim.y * gridDim.z;
    unsigned sum, cnt, mine, sp = 0u;
    for (;;) {
        sum = 0u; cnt = 0u; mine = 0u;
#pragma unroll
        for (unsigned j = 0; j < 16; ++j) { const unsigned c = xb_ld(&bar[XB_XCNT(j)]); sum += c; cnt += (c > 0u) ? 1u : 0u; mine = (j == x) ? c : mine; }
        if (sum == G) break;
        __builtin_amdgcn_s_sleep(1);
        if ((++sp & 255u) == 0u) { if (xb_ld(&bar[XB_TMO])) break; if (sp > XB_SPIN_CAP) { atomicAdd(&bar[XB_TMO], 1u); break; } }
    }
    nloc = mine > 0u ? mine : 1u; nx = cnt > 0u ? cnt : 1u;
}

__device__ __forceinline__ void xcd_barrier(const XcdBarrier& b, int wv) {
    asm volatile("s_waitcnt vmcnt(0)" ::: "memory");
    __syncthreads();
    if ((wv == 0 && lane_id() == 0)) {
        unsigned* bar = b.bar;
        __builtin_amdgcn_s_waitcnt(0);
        unsigned nloc = b.st[0], nx = b.st[1];
        if (nloc == 0u) { xcd_barrier_complete(bar, b.x, nloc, nx); b.st[0] = nloc; b.st[1] = nx; }
        const unsigned old = xb_add(&bar[XB_XSUB(b.x)], 1u);
        const unsigned gen = old / nloc;
        if (old + 1u == (gen + 1u) * nloc) {
            __builtin_amdgcn_fence(__ATOMIC_RELEASE, "agent");
            asm volatile("s_waitcnt vmcnt(0)" ::: "memory");
            const unsigned og = xb_add(&bar[XB_TOP], 1u);
            const unsigned tg = og / nx;
            if (og + 1u == (tg + 1u) * nx) xb_add(&bar[XB_TOPGEN], 1u);
            else XB_SPIN(xb_ld(&bar[XB_TOPGEN]) == tg, bar);
            __builtin_amdgcn_fence(__ATOMIC_ACQUIRE, "agent");
            xb_add(&bar[XB_XGEN(b.x)], 1u);
            asm volatile("s_waitcnt vmcnt(0)" ::: "memory");
        } else {
            XB_SPIN(xb_ld(&bar[XB_XGEN(b.x)]) == gen, bar);
            __builtin_amdgcn_fence(__ATOMIC_ACQUIRE, "agent");
            asm volatile("s_waitcnt vmcnt(0)" ::: "memory");
        }
    }
    __syncthreads();
}

struct P { const float* in[36]; float* out; unsigned char* ws; int ph_lo, ph_hi; };
enum { I_X = 0, I_META, I_F1N, I_F1G, I_F1U, I_F1D, I_MIXN, I_WIN, I_WOUT, I_QN, I_WQ, I_KVN, I_WKV, I_QKNQ, I_QKNK, I_CONVW, I_CONVB, I_DTB, I_ALOG, I_SSDD, I_SSDN, I_RETN,
       I_MU, I_W0, I_W2, I_A0, I_A2, I_G2, I_KK, I_KA, I_RK, I_LN, I_F2N, I_F2G, I_F2U, I_F2D };
#define CAS __attribute__((address_space(4)))
typedef const CAS P* KPtr;
struct Ctx { LAS unsigned char* lds; unsigned char* ws; KPtr kp; int tid, lane, wave, G, bid; };
__device__ __forceinline__ Ctx ctx_make(LAS unsigned char* lds, int wv) {
    Ctx F; KPtr kp = (KPtr)__builtin_amdgcn_kernarg_segment_ptr(); asm volatile("" : "+s"(kp)); int t = wv * 64 + lane_id(); asm volatile("" : "+v"(t));
    F.lds = lds; F.kp = kp; F.ws = kp->ws; F.tid = t; F.lane = t & 63; F.wave = __builtin_amdgcn_readfirstlane(t >> 6); F.G = gridDim.x; F.bid = blockIdx.x; return F;
}


__device__ __forceinline__ int queue_next(const Ctx& F, unsigned* ctr) {
    volatile LAS unsigned* slot = (volatile LAS unsigned*)(F.lds + LDSCTL_OFF + 64);
    __syncthreads();
    if (F.tid == 0) *slot = __hip_atomic_fetch_add(ctr, 1u, __ATOMIC_RELAXED, __HIP_MEMORY_SCOPE_AGENT);
    __syncthreads();
    return (int)*slot;
}
__device__ __forceinline__ f32x16 zero16() { f32x16 z;
#pragma unroll
    for (int i = 0; i < 16; ++i) z[i] = 0.f; return z; }
__device__ __forceinline__ void mma32(f32x16& acc, const LAS float* Ap, int sAi, int sAk, const LAS float* Bp, int sBk, int sBj, int K, int lane) {
    const int r = lane & 31, hh = lane >> 5;
    const LAS float* a = Ap + r * sAi + hh * sAk; const LAS float* b = Bp + hh * sBk + r * sBj;
#pragma unroll 4
    for (int k = 0; k < K; k += 2) acc = __builtin_amdgcn_mfma_f32_32x32x2f32(a[k * sAk], b[k * sBk], acc, 0, 0, 0);
}
__device__ __forceinline__ void mma32bf(f32x16& acc, const LAS float* Ap, int sAi, const LAS float* Bp, int sBj, int K, int lane) {
    const int r = lane & 31, hh = lane >> 5; const LAS float* a = Ap + r * sAi + 8 * hh; const LAS float* b = Bp + r * sBj + 8 * hh;
#pragma unroll 2
    for (int k = 0; k < K; k += 16) { const f32x4 a0 = *(const LAS f32x4*)(a + k), a1 = *(const LAS f32x4*)(a + k + 4), b0 = *(const LAS f32x4*)(b + k), b1 = *(const LAS f32x4*)(b + k + 4);
        v4u aw, bw; aw.x = cvtpk(a0[0], a0[1]); aw.y = cvtpk(a0[2], a0[3]); aw.z = cvtpk(a1[0], a1[1]); aw.w = cvtpk(a1[2], a1[3]); bw.x = cvtpk(b0[0], b0[1]); bw.y = cvtpk(b0[2], b0[3]); bw.z = cvtpk(b1[0], b1[1]); bw.w = cvtpk(b1[2], b1[3]);
        acc = __builtin_amdgcn_mfma_f32_32x32x16_bf16(__builtin_bit_cast(bf16x8, aw), __builtin_bit_cast(bf16x8, bw), acc, 0, 0, 0); }
}
__device__ __forceinline__ int rreg(int reg, int lane) { return (reg & 3) + 8 * (reg >> 2) + 4 * (lane >> 5); }

__device__ __forceinline__ void cvt_tile(const float* src, int srcN, const float* gain, int valid, bf16* dst, int ldd, LAS float* scr, int lane) {
    const int c4 = lane & 15, r0 = lane >> 4;
    f32x4 v[16];
#pragma unroll
    for (int i = 0; i < 16; ++i) v[i] = (4 * c4 < valid) ? *(const f32x4*)(src + (size_t)(r0 + 4 * i) * srcN + 4 * c4) : (f32x4){0.f, 0.f, 0.f, 0.f};
    float gk[16];
#pragma unroll
    for (int i = 0; i < 16; ++i) gk[i] = gain ? gain[r0 + 4 * i] : 1.0f;
#pragma unroll
    for (int i = 0; i < 16; ++i) { const int kk = r0 + 4 * i; LAS float* d = scr + kk * 65 + 4 * c4; d[0] = v[i][0] * gk[i]; d[1] = v[i][1] * gk[i]; d[2] = v[i][2] * gk[i]; d[3] = v[i][3] * gk[i]; }
    LDS_WAIT(); asm volatile("" ::: "memory");
    const int c8 = lane & 7;
#pragma unroll
    for (int j = 0; j < 8; ++j) { const int n = (lane >> 3) + 8 * j; const LAS float* s = scr + (8 * c8) * 65 + n;
        v4u o; o.x = pk2(s[0], s[65]); o.y = pk2(s[130], s[195]); o.z = pk2(s[260], s[325]); o.w = pk2(s[390], s[455]);
        *(v4u*)(dst + (size_t)n * ldd + 8 * c8) = o; }
    LDS_WAIT(); asm volatile("" ::: "memory");
}
constexpr int IT_GU = 2 * 32 * 176, IT_D = 2 * 88 * 32, IT_IN = 32 * 84, IT_OUT = 32 * 32, IT_MLA = 8 * 28, IT_ALL = IT_GU + IT_D + IT_IN + IT_OUT + IT_MLA;
__device__ __forceinline__ void convert_range(const Ctx& F, int L, int it0, int it1, int gw, int NGW) {
    LAS float* scr = (LAS float*)(F.lds + F.wave * 17408);
    const int lane = F.lane;
    bf16* WGU = (bf16*)(F.ws + O_WGU); bf16* WD = (bf16*)(F.ws + O_WD); bf16* WIN = (bf16*)(F.ws + O_WIN); bf16* WOUT = (bf16*)(F.ws + O_WOUT); bf16* WMLA = (bf16*)(F.ws + O_WMLA);
    const int l = L;
    for (int it = it0 + gw; it < it1; it += NGW) {
        int r = it;
        if (r < IT_GU) { const int which = r / 5632, f = 2 * l + which, q = r % 5632, kb = q / 176, nb = q % 176, n0 = 64 * nb, pn = n0 >> 8, within = n0 & 255, isup = within >= 128, f0 = 128 * pn + (within & 127);
            const float* src = (which ? (isup ? F.kp->in[I_F2U] : F.kp->in[I_F2G]) : (isup ? F.kp->in[I_F1U] : F.kp->in[I_F1G])) + (size_t)l * D * DFF + (size_t)(64 * kb) * DFF + f0;
            const float* gain = (which ? F.kp->in[I_F2N] : F.kp->in[I_F1N]) + l * D + 64 * kb;
            cvt_tile(src, DFF, gain, 64, WGU + (size_t)f * 11264 * 2048 + (size_t)n0 * 2048 + 64 * kb, 2048, scr, lane); continue; }
        r -= IT_GU;
        if (r < IT_D) { const int which = r / 2816, f = 2 * l + which, q = r % 2816, kb = q / 32, nb = q % 32;
            const float* src = (which ? F.kp->in[I_F2D] : F.kp->in[I_F1D]) + (size_t)l * DFF * D + (size_t)(64 * kb) * D + 64 * nb;
            cvt_tile(src, D, nullptr, 64, WD + (size_t)f * 2048 * 5632 + (size_t)(64 * nb) * 5632 + 64 * kb, 5632, scr, lane); continue; }
        r -= IT_D;
        if (r < IT_IN) { const int q = r, kb = q / 84, nb = q % 84, n0 = 64 * nb; int valid = NIN - n0; valid = valid < 0 ? 0 : (valid > 64 ? 64 : valid);
            const float* src = F.kp->in[I_WIN] + (size_t)l * D * NIN + (size_t)(64 * kb) * NIN + n0;
            cvt_tile(src, NIN, F.kp->in[I_MIXN] + l * D + 64 * kb, valid, WIN + (size_t)l * NINP * D + (size_t)n0 * D + 64 * kb, D, scr, lane); continue; }
        r -= IT_IN;
        if (r < IT_OUT) { const int q = r, kb = q / 32, nb = q % 32;
            const float* src = F.kp->in[I_WOUT] + (size_t)l * D * D + (size_t)(64 * kb) * D + 64 * nb;
            cvt_tile(src, D, nullptr, 64, WOUT + (size_t)l * D * D + (size_t)(64 * nb) * D + 64 * kb, D, scr, lane); continue; }
        r -= IT_OUT;
        { const int q = r, kb = q / 28, nb = q % 28, n0 = 64 * nb, k0 = 64 * kb;
            const float* src; int srcN, valid;
            if (n0 < 768) { valid = k0 < 384 ? 64 : 0; src = F.kp->in[I_WQ] + (size_t)l * 384 * 768 + (size_t)k0 * 768 + n0; srcN = 768; }
            else { valid = k0 >= 384 ? 64 : 0; src = F.kp->in[I_WKV] + (size_t)l * 128 * 1024 + (size_t)(k0 - 384) * 1024 + (n0 - 768); srcN = 1024; }
            cvt_tile(src, srcN, nullptr, valid, WMLA + (size_t)l * MLAN * 512 + (size_t)n0 * 512 + k0, 512, scr, lane); }
    }
}
__device__ __forceinline__ void convert_layer(const Ctx& F, int L, int gw, int NGW) { convert_range(F, L, 0, IT_ALL, gw, NGW); }
__device__ __forceinline__ void cv_tail0(const Ctx& F, int it0, int it1, int first_idle) {
    if (F.G != 256 || F.bid < first_idle) return;
    __syncthreads();
    convert_range(F, 0, it0, it1, (F.bid - first_idle) * NWAVES + F.wave, (F.G - first_idle) * NWAVES);
    __syncthreads();
}
__device__ __forceinline__ void p0_prologue(const Ctx& F, int cvt_only) {
    const int gw = F.bid * NWAVES + F.wave, NGW = F.G * NWAVES, lane = F.lane;
    if (F.G == 256) { convert_range(F, 0, 0, IT_GU / 2, gw, NGW); convert_range(F, 0, IT_GU, IT_ALL, gw, NGW); }
    else convert_layer(F, 0, gw, NGW);
    if (cvt_only) return;
    bf16* HL = (bf16*)(F.ws + O_H); bf16* HB = (bf16*)(F.ws + O_HB); float* SS = (float*)(F.ws + O_SS); bf16* Y = (bf16*)(F.ws + O_Y); f32x2* ROPE = (f32x2*)(F.ws + O_ROPE);
    for (int row = gw; row < MP; row += NGW) {
        const float* src = row < SEQ ? F.kp->in[I_X] + (size_t)row * D : F.kp->in[I_META] + (size_t)(row - SEQ) * D;
        float sq = 0.f;
        f32x4 xv[8];
#pragma unroll
        for (int j = 0; j < 8; ++j) { xv[j] = (f32x4){0.f, 0.f, 0.f, 0.f}; if (row < T) xv[j] = *(const f32x4*)(src + 256 * j + 4 * lane); }
#pragma unroll
        for (int j = 0; j < 8; ++j) { const f32x4 v = xv[j];
            v2u w; w.x = cvtpk(v[0], v[1]); w.y = cvtpk(v[2], v[3]); *(v2u*)(HB + (size_t)row * D + 256 * j + 4 * lane) = w;
            v2u lw; lw.x = cvtpk(v[0] - pg8::bflo(w.x), v[1] - pg8::bfhi(w.x)); lw.y = cvtpk(v[2] - pg8::bflo(w.y), v[3] - pg8::bfhi(w.y)); *(v2u*)(HL + (size_t)row * D + 256 * j + 4 * lane) = lw;
            sq += (v[0] * v[0] + v[1] * v[1]) + (v[2] * v[2] + v[3] * v[3]); }
        sq = wave_sum(sq); if (lane == 0) __hip_atomic_fetch_add(SS + (size_t)row * 32, sq, __ATOMIC_RELAXED, __HIP_MEMORY_SCOPE_AGENT);
#ifdef PROBE_ZERO_Y
        if (true) {
#else
        if (row >= T) {
#endif
#pragma unroll
            for (int j = 0; j < 4; ++j) *(v4u*)(Y + (size_t)row * D + 512 * j + 8 * lane) = (v4u){0u, 0u, 0u, 0u}; }
#ifdef PROBE_ZERO_Y
        if (row < T && lane < 32) { const float inv = powf(10000.0f, -(float)lane / 32.0f); const float ang = (float)seq_of_row(row) * inv; float sn, cs; sincosf(ang, &sn, &cs); ROPE[row * 32 + lane] = (f32x2){cs, sn}; }
#else
        else if (lane < 32) { const float inv = powf(10000.0f, -(float)lane / 32.0f); const float ang = (float)seq_of_row(row) * inv; float sn, cs; sincosf(ang, &sn, &cs); ROPE[row * 32 + lane] = (f32x2){cs, sn}; }
#endif
    }
}

__device__ __forceinline__ void m1_unit(const Ctx& F, int l, int r0, int r1, int grp) {
    const int lane = F.lane, tid = F.tid;
    const float* U = (const float*)(F.ws + O_U);
    if (r0 < r1) { bf16* AM = (bf16*)(F.ws + O_AMLA); const float* qn = F.kp->in[I_QN] + l * 384; const float* kvn = F.kp->in[I_KVN] + l * 128;
      const float* gp = lane < 48 ? qn + 8 * lane : kvn + 8 * (lane - 48); const f32x4 g0 = *(const f32x4*)gp, g1 = *(const f32x4*)(gp + 4);
      f32x4 a4[4], b4[4];
#pragma unroll
      for (int i = 0; i < 4; ++i) { const int row = r0 + F.wave + 8 * i; const float* ur = U + (size_t)(row < r1 ? row : r0) * NINP + 8 * lane; a4[i] = *(const f32x4*)ur; b4[i] = *(const f32x4*)(ur + 4); }
#pragma unroll
      for (int i = 0; i < 4; ++i) { const int row = r0 + F.wave + 8 * i; const f32x4 a = a4[i], b = b4[i];
        const float sq = (a[0] * a[0] + a[1] * a[1]) + (a[2] * a[2] + a[3] * a[3]) + (b[0] * b[0] + b[1] * b[1]) + (b[2] * b[2] + b[3] * b[3]);
        const float sq_q = wave_sum(lane < 48 ? sq : 0.f), sq_kv = wave_sum(lane >= 48 ? sq : 0.f);
        const float rs = lane < 48 ? 1.0f / sqrtf(sq_q * (1.0f / 384.0f) + EPS) : 1.0f / sqrtf(sq_kv * (1.0f / 128.0f) + EPS);
        v4u w; w.x = pk2(a[0] * rs * g0[0], a[1] * rs * g0[1]); w.y = pk2(a[2] * rs * g0[2], a[3] * rs * g0[3]); w.z = pk2(b[0] * rs * g1[0], b[1] * rs * g1[1]); w.w = pk2(b[2] * rs * g1[2], b[3] * rs * g1[3]);
        if (row < r1) *(v4u*)(AM + (size_t)row * 512 + 8 * lane) = w; } }
    if (r0 < r1) { float* RQK = (float*)(F.ws + O_RQK); const f32x2* ROPE = (const f32x2*)(F.ws + O_ROPE);
      f32x2 cs[4][4]; float x1[4][4], x2[4][4];
#pragma unroll
      for (int i = 0; i < 4; ++i) { const int row = r0 + F.wave + 8 * i, rc = row < r1 ? row : r0;
#pragma unroll
        for (int j = 0; j < 4; ++j) { const int idx = lane + 64 * j, qk = idx >> 7, hh = (idx >> 5) & 3, i5 = idx & 31; cs[i][j] = ROPE[rc * 32 + i5];
            x1[i][j] = U[(size_t)rc * NINP + U_RET + qk * 256 + hh * 64 + i5]; x2[i][j] = U[(size_t)rc * NINP + U_RET + qk * 256 + hh * 64 + 32 + i5]; } }
#pragma unroll
      for (int i = 0; i < 4; ++i) { const int row = r0 + F.wave + 8 * i; if (row < r1) {
#pragma unroll
        for (int j = 0; j < 4; ++j) { const int idx = lane + 64 * j, qk = idx >> 7, hh = (idx >> 5) & 3, i5 = idx & 31; const float sc = qk ? 0.125f : 1.0f;
            RQK[(size_t)row * 512 + qk * 256 + hh * 64 + i5] = (x1[i][j] * cs[i][j].x - x2[i][j] * cs[i][j].y) * sc; RQK[(size_t)row * 512 + qk * 256 + hh * 64 + 32 + i5] = (x1[i][j] * cs[i][j].y + x2[i][j] * cs[i][j].x) * sc; } } } }
    if (r0 < r1) { float* XBC = (float*)(F.ws + O_XBC); float* DT = (float*)(F.ws + O_DT); float* LA = (float*)(F.ws + O_LA);
      const float* cw = F.kp->in[I_CONVW] + l * 4096; const float* cb = F.kp->in[I_CONVB] + l * 1024;
      int rw[4], p1[4], p2[4], p3[4]; float dtr[4];
#pragma unroll
      for (int i = 0; i < 4; ++i) { const int row = r0 + F.wave + 8 * i; rw[i] = row < r1 ? row : r0; p1[i] = prev_row(rw[i]); p2[i] = p1[i] >= 0 ? prev_row(p1[i]) : -1; p3[i] = p2[i] >= 0 ? prev_row(p2[i]) : -1;
          dtr[i] = U[(size_t)rw[i] * NINP + U_SSD + 1536 + (lane & 7)]; }
#pragma unroll 1
      for (int j = 0; j < 4; ++j) { const int ch = 256 * j + 4 * lane; const size_t uo = U_SSD + 512 + ch; const f32x4 z4 = (f32x4){0.f, 0.f, 0.f, 0.f};
          const f32x4 wb = *(const f32x4*)(cb + ch), w0 = *(const f32x4*)(cw + ch), w1 = *(const f32x4*)(cw + 1024 + ch), w2 = *(const f32x4*)(cw + 2048 + ch), w3 = *(const f32x4*)(cw + 3072 + ch);
          f32x4 x0[4], x1[4], x2[4], x3[4];
#pragma unroll
          for (int i = 0; i < 4; ++i) { x3[i] = *(const f32x4*)(U + (size_t)rw[i] * NINP + uo); x2[i] = p1[i] >= 0 ? *(const f32x4*)(U + (size_t)p1[i] * NINP + uo) : z4;
              x1[i] = p2[i] >= 0 ? *(const f32x4*)(U + (size_t)p2[i] * NINP + uo) : z4; x0[i] = p3[i] >= 0 ? *(const f32x4*)(U + (size_t)p3[i] * NINP + uo) : z4; }
#pragma unroll
          for (int i = 0; i < 4; ++i) { f32x4 o = wb + w0 * x0[i] + w1 * x1[i] + w2 * x2[i] + w3 * x3[i];
              o[0] = siluf_(o[0]); o[1] = siluf_(o[1]); o[2] = siluf_(o[2]); o[3] = siluf_(o[3]);
              if (r0 + F.wave + 8 * i < r1) *(f32x4*)(XBC + (size_t)rw[i] * 1024 + ch) = o; } }
      { const float dtb = F.kp->in[I_DTB][l * 8 + (lane & 7)], nea = -__expf(F.kp->in[I_ALOG][l * 8 + (lane & 7)]);
        float dtv[4];
#pragma unroll
        for (int i = 0; i < 4; ++i) dtv[i] = softplusf_(dtr[i] + dtb);
        if (lane < 8) {
#pragma unroll
          for (int i = 0; i < 4; ++i) { DT[rw[i] * 8 + lane] = dtv[i]; LA[rw[i] * 8 + lane] = nea * dtv[i]; } } } }
    if (grp >= 0) { LAS float* xl = (LAS float*)F.lds; const int hd = F.wave, col = lane & 31;
      float* RW = (float*)(F.ws + O_RW); const size_t AS = (size_t)MP * 512; float* RBON = (float*)(F.ws + O_RBON);
      const float* MU = F.kp->in[I_MU] + l * 1664; const float* W2 = F.kp->in[I_W2] + l * 32 * 512; const float* A2 = F.kp->in[I_A2] + l * 32 * 512; const float* G2 = F.kp->in[I_G2] + l * 64 * 512;
      const int r0 = 32 * grp;
      __syncthreads();
      float sx[8], sp[8];
#pragma unroll
      for (int j = 0; j < 8; ++j) { const int idx = tid + 512 * j, tk = idx >> 7, cl = idx & 127, row = r0 + tk, rc = row < T ? row : 0, pr = prev_row(rc); const size_t uc = U_RWKV + 1536 + cl;
          sx[j] = U[(size_t)rc * NINP + uc]; sp[j] = U[(size_t)(pr >= 0 ? pr : 0) * NINP + uc]; }
      const float smu = MU[1536 + (tid & 127)];
#pragma unroll
      for (int j = 0; j < 8; ++j) { const int idx = tid + 512 * j, tk = idx >> 7, cl = idx & 127, row = r0 + tk; float xs = 0.f;
          if (row < T) { const float x = sx[j], xp = prev_row(row) >= 0 ? sp[j] : 0.f; xs = x + (xp - x) * smu;
              if (cl < 32) xs = 1.0f - 2.0f * __builtin_amdgcn_rcpf(1.0f + __expf(2.0f * xs)); else if (cl >= 64) xs = sigmoidf_(xs); }
          xl[tk * 132 + cl] = xs; }
      __syncthreads();
      float w0c[2], a0c[2], kkc[2], kac[2], rkc[2], muR[2], muK[2], muV[2];
#pragma unroll
      for (int ct = 0; ct < 2; ++ct) { const int ch = 64 * hd + 32 * ct + col; w0c[ct] = F.kp->in[I_W0][l * 512 + ch]; a0c[ct] = F.kp->in[I_A0][l * 512 + ch]; kkc[ct] = F.kp->in[I_KK][l * 512 + ch]; kac[ct] = F.kp->in[I_KA][l * 512 + ch]; rkc[ct] = F.kp->in[I_RK][l * 512 + ch];
          muR[ct] = MU[ch]; muK[ct] = MU[512 + ch]; muV[ct] = MU[1024 + ch]; }
      { constexpr int tb = 0;
          f32x16 aw[2], aa[2], ag[2];
#pragma unroll
          for (int ct = 0; ct < 2; ++ct) { aw[ct] = zero16(); aa[ct] = zero16(); ag[ct] = zero16(); }
          const LAS float* xa = xl + (32 * tb + col) * 132 + (lane >> 5); const int chb = 64 * hd + col, kh = lane >> 5;
#define M1_LORA(ACC, WM, XO, NB) do { _Pragma("unroll") for (int hb_ = 0; hb_ < (NB); ++hb_) { float bq_[16][2], xq_[16]; \
              _Pragma("unroll") for (int t_ = 0; t_ < 16; ++t_) { const float* wb_ = (WM) + 1024 * (16 * hb_ + t_); bq_[t_][0] = wb_[wvo]; bq_[t_][1] = wb_[wvo + 32]; xq_[t_] = xa[(XO) + 2 * (16 * hb_ + t_)]; } \
              _Pragma("unroll") for (int t_ = 0; t_ < 16; ++t_) { ACC[0] = __builtin_amdgcn_mfma_f32_32x32x2f32(xq_[t_], bq_[t_][0], ACC[0], 0, 0, 0); ACC[1] = __builtin_amdgcn_mfma_f32_32x32x2f32(xq_[t_], bq_[t_][1], ACC[1], 0, 0, 0); } } } while (0)
          const unsigned wvo = (unsigned)(kh * 512 + chb);
          M1_LORA(aw, W2, 0, 1); M1_LORA(aa, A2, 32, 1); M1_LORA(ag, G2, 64, 2);
#undef M1_LORA
#pragma unroll
          for (int rb = 0; rb < 16; rb += 4) {
              float uc[4][2][3], upv[4][2][3];
#pragma unroll
              for (int q = 0; q < 4; ++q) { const int row = r0 + 32 * tb + rreg(rb + q, lane), rc = row < T ? row : 0, pr = prev_row(rc);
#pragma unroll
                  for (int ct = 0; ct < 2; ++ct) { const float* ur = U + (size_t)rc * NINP + U_RWKV + chb + 32 * ct; const float* up = U + (size_t)(pr >= 0 ? pr : 0) * NINP + U_RWKV + chb + 32 * ct;
                      uc[q][ct][0] = ur[0]; uc[q][ct][1] = ur[512]; uc[q][ct][2] = ur[1024]; upv[q][ct][0] = pr >= 0 ? up[0] : 0.f; upv[q][ct][1] = pr >= 0 ? up[512] : 0.f; upv[q][ct][2] = pr >= 0 ? up[1024] : 0.f; } }
#pragma unroll
              for (int q = 0; q < 4; ++q) { const int reg = rb + q; const int row = r0 + 32 * tb + rreg(reg, lane); const bool ok = row < T;
                  float rr[2], k2[2], vv[2], kk[2], av[2], dec[2]; float nq = 0.f, bq = 0.f;
#pragma unroll
                  for (int ct = 0; ct < 2; ++ct) { float r = uc[q][ct][0], k = uc[q][ct][1], v = uc[q][ct][2];
                      r += (upv[q][ct][0] - r) * muR[ct]; k += (upv[q][ct][1] - k) * muK[ct]; v += (upv[q][ct][2] - v) * muV[ct];
                      float wr = w0c[ct] + aw[ct][reg]; wr = -softplusf_(-wr) - 0.5f; dec[ct] = __expf(-__expf(wr));
                      av[ct] = __builtin_amdgcn_rcpf(1.0f + __expf(-(a0c[ct] + aa[ct][reg])));
                      kk[ct] = k * kkc[ct]; k2[ct] = k * (1.0f + (av[ct] - 1.0f) * kac[ct]); rr[ct] = r; vv[ct] = v;
                      nq += kk[ct] * kk[ct]; bq += r * k2[ct] * rkc[ct]; }
                  nq = sum32(nq, lane); bq = sum32(bq, lane);
                  const float inrm = __builtin_amdgcn_rsqf(fmaxf(nq, 1e-24f));
                  if (ok) {
#pragma unroll
                      for (int ct = 0; ct < 2; ++ct) { const size_t o = (size_t)row * 512 + chb + 32 * ct; const float kn = kk[ct] * inrm;
                          RW[o] = rr[ct]; RW[AS + o] = dec[ct]; RW[2 * AS + o] = k2[ct]; RW[3 * AS + o] = vv[ct]; RW[4 * AS + o] = -kn; RW[5 * AS + o] = kn * av[ct]; RW[6 * AS + o] = ag[ct][reg]; }
                      if (col == 0) RBON[row * 8 + hd] = bq; } } }
      } }
}
__device__ __forceinline__ void m1_phase(const Ctx& F, int l, int qi = 1) {
    unsigned* ctr = (unsigned*)(F.ws + O_CTL) + CW_QUEUE + 64 * (4 * l + qi);
    constexpr int NG = (T + 31) / 32, NR = (T + 31) / 32;
    for (;;) { const int u = queue_next(F, ctr); if (u >= NG + NR) break;
        if (u < NG) m1_unit(F, l, 0, 0, u); else { const int r0 = 32 * (u - NG); m1_unit(F, l, r0, r0 + 32 < T ? r0 + 32 : T, -1); } }
}
constexpr int RWC = 64, NRC = (T + RWC - 1) / RWC;
__device__ __forceinline__ void rwkv_chunk_unit(const Ctx& F, int c, int h) {
    LAS float* BH = (LAS float*)F.lds; LAS float* KH = BH + 4160; LAS float* NX = KH + 4160; LAS float* RTT = NX + 4160;
    LAS float* AP = RTT + 4160; LAS float* BZ = AP + 4352; LAS float* Pm = BZ + 4160; LAS float* Qm = Pm + 4160; LAS float* Ge = Qm + 4160; LAS float* segt = Ge + 64;
    const float* RW = (const float*)(F.ws + O_RW); const size_t AS = (size_t)MP * 512; float* MATS = (float*)(F.ws + O_MATS) + (size_t)(c * 8 + h) * 16384;
    int tid = F.tid, w = F.wave; asm volatile("" : "+v"(tid), "+s"(w));
    const int lane = tid & 63, seg = tid >> 6, k = tid & 63;
    __syncthreads();
    { float p[8];
#pragma unroll
      for (int i = 0; i < 8; ++i) { const int s = RWC * c + 8 * seg + i; const float wv = s < T ? RW[AS + (size_t)row_of_seq(s) * 512 + 64 * h + k] : 1.0f; p[i] = wv; }
      float nkv[8], rv[8], bv[8], kkv[8];
#pragma unroll
      for (int i = 0; i < 8; ++i) { const int s = RWC * c + 8 * seg + i; nkv[i] = 0.f; rv[i] = 0.f; bv[i] = 0.f; kkv[i] = 0.f;
          if (s < T) { const size_t o = (size_t)row_of_seq(s) * 512 + 64 * h + k; rv[i] = RW[o]; kkv[i] = RW[2 * AS + o]; nkv[i] = RW[4 * AS + o]; bv[i] = RW[5 * AS + o]; } }
#pragma unroll
      for (int i = 1; i < 8; ++i) p[i] *= p[i - 1];
      segt[seg * 64 + k] = p[7];
      __syncthreads();
      float pre = 1.0f, tot = 1.0f;
#pragma unroll
      for (int q = 0; q < 8; ++q) { const float t = segt[q * 64 + k]; if (q < seg) pre *= t; tot *= t; }
      if (seg == 0) Ge[k] = tot;
#pragma unroll
      for (int i = 0; i < 8; ++i) { const int il = 8 * seg + i, s = RWC * c + il; const float G = pre * p[i], Gm1 = i ? pre * p[i - 1] : pre;
          const float nk = nkv[i], r = rv[i], b = bv[i], kk = kkv[i];
          const float ig = 1.0f / G;
          NX[k * 65 + il] = nk * Gm1; RTT[k * 65 + il] = r * G; BH[il * 65 + k] = b * ig; KH[il * 65 + k] = kk * ig; } }
    __syncthreads();
#define RW_PROD_TILE(PROD, TR, TC) do { const int prod_ = (PROD), tr_ = (TR), tc_ = (TC); f32x16 acc = zero16(); \
        if (tr_ <= tc_) mma32(acc, ((prod_ & 1) ? KH : BH) + 32 * tr_ * 65, 65, 1, ((prod_ < 2) ? NX : RTT) + 32 * tc_, 65, 1, 64, lane); \
        _Pragma("unroll") for (int r = 0; r < 16; ++r) { const int j = 32 * tr_ + rreg(r, lane), i = 32 * tc_ + (lane & 31); const float v = acc[r]; \
            if (prod_ == 0) AP[j * 68 + i] = j < i ? v : 0.f; else if (prod_ == 1) BZ[j * 65 + i] = j < i ? v : 0.f; else if (prod_ == 2) Pm[j * 65 + i] = j <= i ? v : 0.f; else Qm[j * 65 + i] = j <= i ? v : 0.f; } } while (0)
    RW_PROD_TILE(w >> 2, (w >> 1) & 1, w & 1);
    __syncthreads();
    if (w >= 6) { RW_PROD_TILE(3, w - 6, 0); RW_PROD_TILE(3, w - 6, 1); }
    else if (w >= 2) { RW_PROD_TILE(2, (w - 2) >> 1, (w - 2) & 1); }
    else { LAS float* Yr = (w == 0 ? NX : BZ) + lane * 65;
        for (int ib = 0; ib < 4; ++ib) { float a[16];
#pragma unroll
            for (int ii = 0; ii < 16; ++ii) a[ii] = Yr[16 * ib + ii];
#pragma unroll 4
            for (int j = 0; j < 16 * ib; ++j) { const float y = Yr[j]; const LAS float* ap = AP + j * 68 + 16 * ib;
                const f32x4 a0 = *(const LAS f32x4*)ap, a1 = *(const LAS f32x4*)(ap + 4), a2 = *(const LAS f32x4*)(ap + 8), a3 = *(const LAS f32x4*)(ap + 12);
#pragma unroll
                for (int q = 0; q < 4; ++q) { a[q] += y * a0[q]; a[4 + q] += y * a1[q]; a[8 + q] += y * a2[q]; a[12 + q] += y * a3[q]; } }
#pragma unroll
            for (int ii = 1; ii < 16; ++ii)
#pragma unroll
                for (int jj = 0; jj < ii; ++jj) a[ii] += a[jj] * AP[(16 * ib + jj) * 68 + 16 * ib + ii];
#pragma unroll
            for (int ii = 0; ii < 16; ++ii) Yr[16 * ib + ii] = a[ii]; } }
#undef RW_PROD_TILE
    __syncthreads();
    { const int rb = w >> 1;
#pragma unroll
      for (int t = 0; t < 2; ++t) { const int cb = 2 * (w & 1) + t; f32x16 acc = zero16();
          mma32(acc, (rb < 2 ? NX : BZ) + 32 * (rb & 1) * 65, 65, 1, (cb < 2 ? BH : Pm) + 32 * (cb & 1), 65, 1, 64, lane);
          float* dst = MATS + (rb < 2 ? (cb < 2 ? 0 : 8192) : (cb < 2 ? 4096 : 12288));
#pragma unroll
          for (int r = 0; r < 16; ++r) { const int row = 32 * (rb & 1) + rreg(r, lane), col = 32 * (cb & 1) + (lane & 31); float v = acc[r];
              if (rb < 2 && cb < 2) v = (v + (row == col ? 1.0f : 0.0f)) * Ge[col]; else if (rb < 2) v += RTT[row * 65 + col]; else if (cb < 2) v = (v + KH[row * 65 + col]) * Ge[col]; else v += Qm[row * 65 + col];
              dst[row * 64 + col] = v; } } }
}
template <int SV = 0>
__device__ __forceinline__ void rwkv_state_scan(const Ctx& F, int h, int rg) {
    LAS float* Sx = (LAS float*)F.lds; LAS float* tmp = Sx + 1056; LAS float* ring = tmp + 1024;
    const float* RW = (const float*)(F.ws + O_RW); const size_t AS = (size_t)MP * 512; const float* MATS = (const float*)(F.ws + O_MATS); float* SST8 = (float*)(F.ws + (SV ? O_QKV : O_SSTATE));
    const float* ZERO = (const float*)((const bf16*)(F.ws + O_H) + (size_t)8300 * D);
    const int tid = F.tid, lane = F.lane, w = F.wave, fr = lane & 15, kq = lane >> 4, role = w >> 2, cbk = w & 3;
#define RW_DMA(cn) do { const int cc_ = (cn) < NRC ? (cn) : NRC - 1; const float* mp_ = MATS + (size_t)(cc_ * 8 + h) * 16384; LAS float* sl_ = ring + ((cn) % 3) * 9216; \
        _Pragma("unroll") for (int q_ = 0; q_ < 2; ++q_) { const int ch_ = w + 8 * q_; \
            __builtin_amdgcn_global_load_lds((const unsigned*)(mp_ + ch_ * 256 + lane * 4), (LAS unsigned*)(sl_ + ch_ * 256), 16, 0, 0); \
            __builtin_amdgcn_global_load_lds((const unsigned*)(mp_ + 4096 + ch_ * 256 + lane * 4), (LAS unsigned*)(sl_ + 4096 + ch_ * 256), 16, 0, 0); \
            const int j_ = 4 * ch_ + kq, s_ = RWC * cc_ + j_; const float* vp_ = s_ < T ? RW + 3 * AS + (size_t)row_of_seq(s_) * 512 + 64 * h + 16 * rg + fr : ZERO + fr; \
            __builtin_amdgcn_global_load_lds((const unsigned*)vp_, (LAS unsigned*)(sl_ + 8192 + ch_ * 64), 4, 0, 0); } } while (0)
    __syncthreads();
    for (int i = tid; i < 1056; i += NTHR) Sx[i] = 0.f;
    RW_DMA(0); RW_DMA(1);
    asm volatile("s_waitcnt vmcnt(0)" ::: "memory");
    __syncthreads();
    for (int c = 0; c < NRC; ++c) {
        if (SV != 1) RW_DMA(c + 2);
        { const int idx = 2 * tid, v = idx >> 6, kk = idx & 63; const f32x2 sv = (f32x2){Sx[v * 66 + kk], Sx[v * 66 + kk + 1]}; *(f32x2*)(SST8 + ((size_t)(c * 8 + h) * 64 + 16 * rg + v) * 64 + kk) = sv; }
        const LAS float* sl = ring + (c % 3) * 9216;
        float av[16], bv[16]; f32x4 acc = (f32x4){0.f, 0.f, 0.f, 0.f}, acc2 = acc;
        if (role == 0) { const LAS float* mb = sl + 16 * cbk + fr;
#pragma unroll
            for (int t = 0; t < 16; ++t) { av[t] = Sx[fr * 66 + 4 * t + kq]; bv[t] = mb[(4 * t + kq) * 64]; }
        } else { const LAS float* wb = sl + 4096 + 16 * cbk + fr; const LAS float* vt = sl + 8192 + fr;
#pragma unroll
            for (int t = 0; t < 16; ++t) { av[t] = vt[(4 * t + kq) * 16]; bv[t] = wb[(4 * t + kq) * 64]; } }
#pragma unroll
        for (int t = 0; t < (SV == 2 ? 2 : 16); t += 2) { acc = __builtin_amdgcn_mfma_f32_16x16x4f32(av[t], bv[t], acc, 0, 0, 0); acc2 = __builtin_amdgcn_mfma_f32_16x16x4f32(av[t + 1], bv[t + 1], acc2, 0, 0, 0); }
        acc = acc + acc2;
        if (role != 0) *(LAS f32x4*)(tmp + (cbk * 64 + lane) * 4) = acc;
        LBAR();
        if (role == 0) { acc = acc + *(const LAS f32x4*)(tmp + (cbk * 64 + lane) * 4);
#pragma unroll
            for (int r = 0; r < 4; ++r) Sx[(4 * kq + r) * 66 + 16 * cbk + fr] = acc[r]; }
        if (SV != 1) asm volatile("s_waitcnt vmcnt(8)" ::: "memory");
        LBAR();
    }
    asm volatile("s_waitcnt vmcnt(0)" ::: "memory");
#undef RW_DMA
}
__device__ __forceinline__ void rwkv_out_unit(const Ctx& F, int l, int c, int h) {
    LAS float* S_ = (LAS float*)F.lds; LAS float* E_ = S_ + 4160; LAS float* VT_ = E_ + 4096; LAS float* F_ = VT_ + 4096; LAS float* O_ = F_ + 4096;
    const float* RW = (const float*)(F.ws + O_RW); const size_t AS = (size_t)MP * 512; const float* MATS = (const float*)(F.ws + O_MATS) + (size_t)(c * 8 + h) * 16384;
    const float* SST8 = (const float*)(F.ws + O_SSTATE) + (size_t)(c * 8 + h) * 4096; const float* RBON = (const float*)(F.ws + O_RBON); bf16* Y = (bf16*)(F.ws + O_Y);
    int tid = F.tid, w = F.wave; asm volatile("" : "+v"(tid), "+s"(w)); const int lane = tid & 63;
    const f32x4 z4 = (f32x4){0.f, 0.f, 0.f, 0.f};
    f32x4 sv[2], ev[2], fv[2], tv[2];
#pragma unroll
    for (int q = 0; q < 2; ++q) { const int idx = tid + 512 * q, r = idx >> 4, c4 = idx & 15, s = RWC * c + r;
        sv[q] = *(const f32x4*)(SST8 + r * 64 + 4 * c4); ev[q] = *(const f32x4*)(MATS + 8192 + 4 * idx); fv[q] = *(const f32x4*)(MATS + 12288 + 4 * idx);
        tv[q] = s < T ? *(const f32x4*)(RW + 3 * AS + (size_t)row_of_seq(s) * 512 + 64 * h + 4 * c4) : z4; }
    const int li = tid >> 3, part = tid & 7, ls = RWC * c + li, lrow = ls < T ? row_of_seq(ls) : 0; const size_t lo = (size_t)lrow * 512 + 64 * h + 8 * part;
    f32x4 v0 = z4, v1 = z4, g0 = z4, g1 = z4; float bon = 0.f;
    if (ls < T) { v0 = *(const f32x4*)(RW + 3 * AS + lo); v1 = *(const f32x4*)(RW + 3 * AS + lo + 4); g0 = *(const f32x4*)(RW + 6 * AS + lo); g1 = *(const f32x4*)(RW + 6 * AS + lo + 4); bon = RBON[lrow * 8 + h]; }
    const f32x4 ln0 = *(const f32x4*)(F.kp->in[I_LN] + l * 512 + 64 * h + 8 * part), ln1 = *(const f32x4*)(F.kp->in[I_LN] + l * 512 + 64 * h + 8 * part + 4);
    __syncthreads();
#pragma unroll
    for (int q = 0; q < 2; ++q) { const int idx = tid + 512 * q, r = idx >> 4, c4 = idx & 15;
        LAS float* d = S_ + r * 65 + 4 * c4; d[0] = sv[q][0]; d[1] = sv[q][1]; d[2] = sv[q][2]; d[3] = sv[q][3];
        *(LAS f32x4*)(E_ + 4 * idx) = ev[q]; *(LAS f32x4*)(F_ + 4 * idx) = fv[q]; *(LAS f32x4*)(VT_ + r * 64 + 4 * c4) = tv[q]; }
    LBAR();
    const int tr = (w >> 1) & 1, tc = w & 1; f32x16 acc = zero16();
    if (w < 4) mma32(acc, S_ + 32 * tr * 65, 65, 1, E_ + 32 * tc, 64, 1, 64, lane);
    else { mma32(acc, VT_ + 32 * tr, 1, 64, F_ + 32 * tc, 64, 1, 64, lane);
#pragma unroll
        for (int r = 0; r < 16; ++r) O_[(32 * tr + rreg(r, lane)) * 65 + 32 * tc + (lane & 31)] = acc[r]; }
    LBAR();
    if (w < 4) {
#pragma unroll
        for (int r = 0; r < 16; ++r) O_[(32 * tr + rreg(r, lane)) * 65 + 32 * tc + (lane & 31)] += acc[r]; }
    LBAR();
    { float x[8]; float sm = 0.f;
#pragma unroll
      for (int q = 0; q < 8; ++q) { x[q] = O_[(8 * part + q) * 65 + li]; sm += x[q]; }
      sm = sum8(sm);
      const float mu = sm * (1.0f / 64.0f); float vq = 0.f;
#pragma unroll
      for (int q = 0; q < 8; ++q) { const float d = x[q] - mu; vq += d * d; }
      vq = sum8(vq);
      const float rstd = 1.0f / sqrtf(vq * (1.0f / 64.0f) + 64e-5f);
      if (ls < T) {
          float ov[8];
#pragma unroll
          for (int q = 0; q < 4; ++q) { ov[q] = ((x[q] - mu) * rstd * ln0[q] + bon * v0[q]) * g0[q]; ov[4 + q] = ((x[4 + q] - mu) * rstd * ln1[q] + bon * v1[q]) * g1[q]; }
          v4u wv; wv.x = cvtpk(ov[0], ov[1]); wv.y = cvtpk(ov[2], ov[3]); wv.z = cvtpk(ov[4], ov[5]); wv.w = cvtpk(ov[6], ov[7]);
          *(v4u*)(Y + (size_t)lrow * D + 1536 + 64 * h + 8 * part) = wv; } }
}
__device__ __forceinline__ void ssd_states_unit(const Ctx& F, int c, int h) {
    LAS float* Bm = (LAS float*)F.lds; LAS float* XD = Bm + 16384; LAS float* csl = XD + 8192; LAS float* lal = csl + 128; LAS float* dtl = lal + 128;
    const float* XBC = (const float*)(F.ws + O_XBC); const float* DT = (const float*)(F.ws + O_DT); const float* LA = (const float*)(F.ws + O_LA);
    float* SST = (float*)(F.ws + O_SST); float* SDEC = (float*)(F.ws + O_SDEC);
    const int tid = F.tid, lane = F.lane, w = F.wave, g = h >> 2;
    __syncthreads();
    f32x4 bv[8], xv[4];
#pragma unroll
    for (int k = 0; k < 8; ++k) { const int idx = tid + 512 * k, j = idx >> 5, c4 = idx & 31, row = crow(c, j); bv[k] = row >= 0 ? *(const f32x4*)(XBC + (size_t)row * 1024 + 512 + 128 * g + 4 * c4) : (f32x4){0.f, 0.f, 0.f, 0.f}; }
#pragma unroll
    for (int k = 0; k < 4; ++k) { const int idx = tid + 512 * k, j = idx >> 4, c4 = idx & 15, row = crow(c, j); xv[k] = row >= 0 ? *(const f32x4*)(XBC + (size_t)row * 1024 + 64 * h + 4 * c4) : (f32x4){0.f, 0.f, 0.f, 0.f}; }
    if (tid < 128) { const int row = crow(c, tid); lal[tid] = row >= 0 ? LA[row * 8 + h] : 0.f; dtl[tid] = row >= 0 ? DT[row * 8 + h] : 0.f; }
    __syncthreads();
    if (tid < 64) { const float e0 = lal[2 * tid], e1 = lal[2 * tid + 1]; float s = e0 + e1;
#pragma unroll
        for (int o = 1; o < 64; o <<= 1) { const float t = __shfl_up(s, o); if (tid >= o) s += t; }
        csl[2 * tid + 1] = s; csl[2 * tid] = s - e1; }
    __syncthreads();
    const float cs_end = csl[127];
#pragma unroll
    for (int k = 0; k < 8; ++k) { const int idx = tid + 512 * k, j = idx >> 5, c4 = idx & 31; *(LAS f32x4*)(Bm + j * 128 + 4 * c4) = bv[k]; }
#pragma unroll
    for (int k = 0; k < 4; ++k) { const int idx = tid + 512 * k, j = idx >> 4, c4 = idx & 15; const f32x4 v = xv[k] * (dtl[j] * __expf(cs_end - csl[j])); *(LAS f32x4*)(XD + j * 64 + 4 * c4) = v; }
    __syncthreads();
    const int tr = w >> 2, tc = w & 3;
    f32x16 acc = zero16();
    mma32(acc, XD + 32 * tr, 1, 64, Bm + 32 * tc, 128, 1, 128, lane);
    float* dst = SST + ((size_t)(c * 8 + h) * 64 + 32 * tr) * 128 + 32 * tc + (lane & 31);
#pragma unroll
    for (int r = 0; r < 16; ++r) dst[(size_t)rreg(r, lane) * 128] = acc[r];
    if (tid == 0) SDEC[(c * 8 + h) * 32] = expf(cs_end);
}
__device__ __forceinline__ float ret_logg(int h) { return logf(1.0f - exp2f(-5.0f - (float)h)); }
__device__ __forceinline__ void ret_states_unit(const Ctx& F, int c, int h) {
    LAS float* V = (LAS float*)F.lds; LAS float* KD = V + 16384;
    const float* U = (const float*)(F.ws + O_U); const float* RQK = (const float*)(F.ws + O_RQK); float* RST = (float*)(F.ws + O_RST);
    const int tid = F.tid, lane = F.lane, w = F.wave; const float lg = ret_logg(h);
    __syncthreads();
    f32x4 vv[8], kv[4];
#pragma unroll
    for (int k = 0; k < 8; ++k) { const int idx = tid + 512 * k, j = idx >> 5, c4 = idx & 31, row = crow(c, j); vv[k] = row >= 0 ? *(const f32x4*)(U + (size_t)row * NINP + U_RET + 512 + 128 * h + 4 * c4) : (f32x4){0.f, 0.f, 0.f, 0.f}; }
#pragma unroll
    for (int k = 0; k < 4; ++k) { const int idx = tid + 512 * k, j = idx >> 4, c4 = idx & 15, row = crow(c, j); kv[k] = row >= 0 ? *(const f32x4*)(RQK + (size_t)row * 512 + 256 + 64 * h + 4 * c4) : (f32x4){0.f, 0.f, 0.f, 0.f}; }
#pragma unroll
    for (int k = 0; k < 8; ++k) { const int idx = tid + 512 * k, j = idx >> 5, c4 = idx & 31; *(LAS f32x4*)(V + j * 128 + 4 * c4) = vv[k]; }
#pragma unroll
    for (int k = 0; k < 4; ++k) { const int idx = tid + 512 * k, j = idx >> 4, c4 = idx & 15; *(LAS f32x4*)(KD + j * 64 + 4 * c4) = kv[k] * __expf((float)(127 - j) * lg); }
    __syncthreads();
    const int tr = w >> 1, tc = w & 1;
    f32x16 acc = zero16();
    mma32(acc, V + 32 * tr, 1, 128, KD + 32 * tc, 64, 1, 128, lane);
    float* dst = RST + ((size_t)(c * 4 + h) * 128 + 32 * tr) * 64 + 32 * tc + (lane & 31);
#pragma unroll
    for (int r = 0; r < 16; ++r) dst[(size_t)rreg(r, lane) * 64] = acc[r];
}

__device__ __forceinline__ void scan_job(float* base, size_t cstride, const float* dec, int decstride, float constdec) {
    float s = 0.f; float t[13], d[13];
#pragma unroll
    for (int i = 0; i < 13; ++i) { t[i] = base[(size_t)i * cstride]; d[i] = dec ? dec[i * decstride] : constdec; }
#pragma unroll
    for (int c0 = 0; c0 < NCH; c0 += 13) { float tn[13], dn[13];
        if (c0 + 13 < NCH) {
#pragma unroll
            for (int i = 0; i < 13; ++i) { tn[i] = base[(size_t)(c0 + 13 + i) * cstride]; dn[i] = dec ? dec[(c0 + 13 + i) * decstride] : constdec; } }
#pragma unroll
        for (int i = 0; i < 13; ++i) { base[(size_t)(c0 + i) * cstride] = s; s = d[i] * s + t[i]; }
#pragma unroll
        for (int i = 0; i < 13; ++i) { t[i] = tn[i]; d[i] = dn[i]; } }
}
__device__ __forceinline__ void rwkv_scan(const Ctx& F, int hb) {
    LAS float* st = (LAS float*)F.lds;
    float* RW = (float*)(F.ws + O_RW); const size_t AS = (size_t)MP * 512; float* OUT = RW + 7 * AS;
    const int tid = F.tid, lane = F.lane, rl = lane >> 3, ks = lane & 7, myrow = 8 * F.wave + rl;
    float S[8];
#pragma unroll
    for (int j = 0; j < 8; ++j) S[j] = 0.f;
    for (int s0 = 0; s0 < T; s0 += 32) {
        __syncthreads();
#pragma unroll
        for (int j = 0; j < 6; ++j) { const int idx = tid + 512 * j, stp = idx / 96, rem = idx % 96, arr = rem >> 4, c4 = rem & 15, s = s0 + stp;
            if (s < T) { const int row = row_of_seq(s); const int asel = arr == 0 ? 0 : (arr == 1 ? 1 : (arr == 2 ? 2 : (arr == 3 ? 4 : (arr == 4 ? 5 : 3))));
                *(LAS f32x4*)(st + stp * 384 + arr * 64 + 4 * c4) = *(const f32x4*)(RW + asel * AS + (size_t)row * 512 + 64 * hb + 4 * c4); } }
        __syncthreads();
        const int nst = (T - s0) < 32 ? (T - s0) : 32;
        for (int stp = 0; stp < nst; ++stp) { const LAS float* b = st + stp * 384 + 8 * ks;
            const f32x4 r0 = *(const LAS f32x4*)(b), r1 = *(const LAS f32x4*)(b + 4), w0 = *(const LAS f32x4*)(b + 64), w1 = *(const LAS f32x4*)(b + 68), k0 = *(const LAS f32x4*)(b + 128), k1 = *(const LAS f32x4*)(b + 132),
                        n0 = *(const LAS f32x4*)(b + 192), n1 = *(const LAS f32x4*)(b + 196), b0 = *(const LAS f32x4*)(b + 256), b1 = *(const LAS f32x4*)(b + 260);
            const float vv = st[stp * 384 + 320 + myrow];
            float sa = (S[0] * n0[0] + S[1] * n0[1]) + (S[2] * n0[2] + S[3] * n0[3]) + (S[4] * n1[0] + S[5] * n1[1]) + (S[6] * n1[2] + S[7] * n1[3]);
            sa += __shfl_xor(sa, 1); sa += __shfl_xor(sa, 2); sa += __shfl_xor(sa, 4);
            float o = 0.f;
#pragma unroll
            for (int j = 0; j < 4; ++j) { S[j] = S[j] * w0[j] + sa * b0[j] + vv * k0[j]; o += S[j] * r0[j]; S[4 + j] = S[4 + j] * w1[j] + sa * b1[j] + vv * k1[j]; o += S[4 + j] * r1[j]; }
            o += __shfl_xor(o, 1); o += __shfl_xor(o, 2); o += __shfl_xor(o, 4);
            if (ks == 0) OUT[(size_t)row_of_seq(s0 + stp) * 512 + 64 * hb + myrow] = o; }
    }
}
__device__ __forceinline__ void mla_prep2_unit(const Ctx& F, int l, int un) {
    const float* QKVb = (const float*)(F.ws + O_QKV); const float* U = (const float*)(F.ws + O_U);
    bf16* Q = (bf16*)(F.ws + O_Q); bf16* K = (bf16*)(F.ws + O_K); bf16* VT = (bf16*)(F.ws + O_VT);
    LAS bf16* Vl = (LAS bf16*)F.lds;
    const int lane = F.lane, tid = F.tid;
    const float* gq = F.kp->in[I_QKNQ] + l * 192; const float* gk = F.kp->in[I_QKNK] + l * 192;
    const float gq0 = gq[lane], gq1 = gq[64 + lane], gq2 = gq[128 + lane], gk0 = gk[lane], gk1 = gk[64 + lane], gk2 = gk[128 + lane];
    const float qs = 0.07216878364870322f * 1.4426950408889634f;
    __syncthreads();
#pragma unroll 1
    for (int ib = 0; ib < 8; ib += 4) {
        float xq[4][12], xk[4][8], xv[4][8], kpe[4]; f32x2 cs[4];
#pragma unroll
        for (int p = 0; p < 4; ++p) { const int s = 64 * un + 8 * F.wave + ib + p; const int row = s < T ? row_of_seq(s) : 0; const float* qk = QKVb + (size_t)row * MLAN;
            cs[p] = ((const f32x2*)(F.ws + O_ROPE))[row * 32 + (lane & 31)]; kpe[p] = U[(size_t)row * NINP + 512 + lane];
#pragma unroll
            for (int h = 0; h < 4; ++h) { xq[p][3 * h] = qk[192 * h + lane]; xq[p][3 * h + 1] = qk[192 * h + 64 + lane]; xq[p][3 * h + 2] = qk[192 * h + 128 + lane];
                xk[p][2 * h] = qk[768 + 256 * h + lane]; xk[p][2 * h + 1] = qk[768 + 256 * h + 64 + lane]; xv[p][2 * h] = qk[768 + 256 * h + 128 + lane]; xv[p][2 * h + 1] = qk[768 + 256 * h + 192 + lane]; } }
#pragma unroll
        for (int p = 0; p < 4; ++p) { const int sl = 8 * F.wave + ib + p, s = 64 * un + sl; const bool ok = s < T;
#pragma unroll
            for (int h = 0; h < 4; ++h) {
                { float x0 = xq[p][3 * h], x1 = xq[p][3 * h + 1], x2 = xq[p][3 * h + 2];
                  const float rs = 1.0f / sqrtf(wave_sum(x0 * x0 + x1 * x1 + x2 * x2) * (1.0f / 192.0f) + EPS);
                  x0 *= rs * gq0; x1 *= rs * gq1; x2 *= rs * gq2;
                  const float ot = xor32f(x2, lane); const float rr = lane < 32 ? x2 * cs[p].x - ot * cs[p].y : ot * cs[p].y + x2 * cs[p].x;
                  bf16* qd = Q + ((size_t)s * 4 + h) * 192; qd[lane] = (bf16)f2bf(x0 * qs); qd[64 + lane] = (bf16)f2bf(x1 * qs); qd[128 + lane] = (bf16)f2bf(rr * qs); }
                { float x0 = xk[p][2 * h], x1 = xk[p][2 * h + 1], x2 = kpe[p];
                  const float rs = 1.0f / sqrtf(wave_sum(x0 * x0 + x1 * x1 + x2 * x2) * (1.0f / 192.0f) + EPS);
                  x0 *= rs * gk0; x1 *= rs * gk1; x2 *= rs * gk2;
                  const float ot = xor32f(x2, lane); const float rr = lane < 32 ? x2 * cs[p].x - ot * cs[p].y : ot * cs[p].y + x2 * cs[p].x;
                  bf16* kd = K + ((size_t)s * 4 + h) * 192; kd[lane] = (bf16)f2bf(x0); kd[64 + lane] = (bf16)f2bf(x1); kd[128 + lane] = (bf16)f2bf(rr); }
                Vl[(h * 128 + lane) * 66 + sl] = ok ? (bf16)f2bf(xv[p][2 * h]) : (bf16)0; Vl[(h * 128 + 64 + lane) * 66 + sl] = ok ? (bf16)f2bf(xv[p][2 * h + 1]) : (bf16)0; } }
    }
    __syncthreads();
#pragma unroll
    for (int k = 0; k < 8; ++k) { const int idx = tid + 512 * k, r = idx >> 3, j = idx & 7; const LAS unsigned* src = (const LAS unsigned*)(Vl + r * 66 + 8 * j);
        v4u w; w.x = src[0]; w.y = src[1]; w.z = src[2]; w.w = src[3];
        *(v4u*)(VT + (size_t)r * TSEQ + 64 * un + 8 * j) = w; }
}
__device__ __forceinline__ void m3_phase(const Ctx& F, int l) {
    const int b2 = F.bid, NB = F.G;
    for (int job = b2; job < 192; job += NB) {
        if (job < 128) { if (!EN_SSD) continue; const int e = job * 512 + F.tid, h = e >> 13, rest = e & 8191; scan_job((float*)(F.ws + O_SST) + (size_t)h * 8192 + rest, (size_t)8 * 8192, (const float*)(F.ws + O_SDEC) + h * 32, 8 * 32, 0.f); }
        else { if (!EN_RET) continue; const int e = (job - 128) * 512 + F.tid, h = e >> 13, rest = e & 8191; scan_job((float*)(F.ws + O_RST) + (size_t)h * 8192 + rest, (size_t)4 * 8192, nullptr, 0, expf(128.0f * ret_logg(h))); }
    }
    if (EN_MLA) for (int un = NB - 1 - b2; un < (T + 63) / 64; un += NB) mla_prep2_unit(F, l, un);
}
template <int VAR = 0>
__device__ __forceinline__ void attn_unit(const Ctx& F, int hh, int qb, size_t yoff = O_Y) {
    LAS bf16* L0 = (LAS bf16*)F.lds;
    const bf16* Q = (const bf16*)(F.ws + O_Q); const bf16* K = (const bf16*)(F.ws + O_K); const bf16* VT = (const bf16*)(F.ws + O_VT); bf16* Y = (bf16*)(F.ws + yoff);
    int tid = F.tid, w = F.wave; asm volatile("" : "+v"(tid), "+s"(w));
    const int lane = tid & 63, h = lane >> 5, c = lane & 31, half = w >> 2, wq = w & 3;
    const int sq = 128 * qb + 32 * wq + c;
    bf16x8 qf[12];
#pragma unroll
    for (int ks = 0; ks < 12; ++ks) qf[ks] = *(const bf16x8*)(Q + ((size_t)sq * 4 + hh) * 192 + 16 * ks + 8 * h);
    f32x16 o[4];
#pragma unroll
    for (int t = 0; t < 4; ++t) o[t] = zero16();
    float m = -1e30f, lsum = 0.f;
    const int nst = qb + 1;
    v4u kr[6], vr[4];
    const unsigned kgo = (unsigned)(((tid >> 3) * 4 + hh) * 192 + 8 * (tid & 7)), klo = (unsigned)((tid >> 3) * 200 + 8 * (tid & 7));
    const unsigned vgo = (unsigned)((hh * 128 + (tid >> 2)) * TSEQ + 8 * (tid & 3)), vlo = (unsigned)(12800 + (tid >> 2) * 68 + 8 * (tid & 3));
#define AT_LOADK(st_) do { const bf16* kb_ = K + (size_t)(128 * (st_)) * 768; _Pragma("unroll") for (int j = 0; j < 6; ++j) kr[j] = *(const v4u*)(kb_ + kgo + (j / 3) * 49152 + 64 * (j % 3)); } while (0)
#define AT_LOADV(st_) do { const bf16* vb_ = VT + 128 * (st_); _Pragma("unroll") for (int j = 0; j < 4; ++j) vr[j] = *(const v4u*)(vb_ + vgo + (j >> 1) * 64 + 32 * (j & 1)); } while (0)
#define AT_STOREK() do { _Pragma("unroll") for (int j = 0; j < 6; ++j) *(LAS v4u*)(L0 + klo + (j / 3) * 22016 + 64 * (j % 3)) = kr[j]; } while (0)
#define AT_STOREV() do { _Pragma("unroll") for (int j = 0; j < 4; ++j) { LAS bf16* vd_ = L0 + vlo + (j >> 1) * 22016 + 32 * (j & 1); *(LAS v2u*)vd_ = (v2u){vr[j].x, vr[j].y}; *(LAS v2u*)(vd_ + 4) = (v2u){vr[j].z, vr[j].w}; } } while (0)
    __syncthreads();
    AT_LOADK(0); AT_LOADV(0); AT_STOREK(); AT_STOREV(); if (nst > 1) AT_LOADK(1);
    LBAR();
    const LAS bf16* Ks = L0 + half * 22016; const LAS bf16* Vs = Ks + 12800;
    const unsigned kaddr = (unsigned)(size_t)(Ks + c * 200 + 8 * h);
    for (int st = 0; st < nst; ++st) {
        const int kt = 2 * st + half;
        f32x16 sa[2]; sa[0] = zero16(); sa[1] = zero16();
        { bf16x8 fa0, fa1, fa2, fa3, fb0, fb1, fb2, fb3;
#define AT_KRD(dst_, i_) asm volatile("ds_read_b128 %0, %1 offset:%2" : "=v"(dst_) : "v"(kaddr), "n"(((i_) & 1) * 12800 + ((i_) >> 1) * 32) : "memory")
#define AT_MM(src_, i_) sa[(i_) & 1] = __builtin_amdgcn_mfma_f32_32x32x16_bf16(src_, qf[(i_) >> 1], sa[(i_) & 1], 0, 0, 0)
#define AT_W0(a_, b_, c_, d_) asm volatile("s_waitcnt lgkmcnt(0)" : "+v"(a_), "+v"(b_), "+v"(c_), "+v"(d_) :: "memory")
          AT_KRD(fa0, 0); AT_KRD(fa1, 1); AT_KRD(fa2, 2); AT_KRD(fa3, 3);
          AT_W0(fa0, fa1, fa2, fa3); AT_KRD(fb0, 4); AT_KRD(fb1, 5); AT_KRD(fb2, 6); AT_KRD(fb3, 7); AT_MM(fa0, 0); AT_MM(fa1, 1); AT_MM(fa2, 2); AT_MM(fa3, 3); __builtin_amdgcn_sched_barrier(0);
          AT_W0(fb0, fb1, fb2, fb3); AT_KRD(fa0, 8); AT_KRD(fa1, 9); AT_KRD(fa2, 10); AT_KRD(fa3, 11); AT_MM(fb0, 4); AT_MM(fb1, 5); AT_MM(fb2, 6); AT_MM(fb3, 7); __builtin_amdgcn_sched_barrier(0);
          AT_W0(fa0, fa1, fa2, fa3); AT_KRD(fb0, 12); AT_KRD(fb1, 13); AT_KRD(fb2, 14); AT_KRD(fb3, 15); AT_MM(fa0, 8); AT_MM(fa1, 9); AT_MM(fa2, 10); AT_MM(fa3, 11); __builtin_amdgcn_sched_barrier(0);
          AT_W0(fb0, fb1, fb2, fb3); AT_KRD(fa0, 16); AT_KRD(fa1, 17); AT_KRD(fa2, 18); AT_KRD(fa3, 19); AT_MM(fb0, 12); AT_MM(fb1, 13); AT_MM(fb2, 14); AT_MM(fb3, 15); __builtin_amdgcn_sched_barrier(0);
          AT_W0(fa0, fa1, fa2, fa3); AT_KRD(fb0, 20); AT_KRD(fb1, 21); AT_KRD(fb2, 22); AT_KRD(fb3, 23); AT_MM(fa0, 16); AT_MM(fa1, 17); AT_MM(fa2, 18); AT_MM(fa3, 19); __builtin_amdgcn_sched_barrier(0);
          AT_W0(fb0, fb1, fb2, fb3); AT_MM(fb0, 20); AT_MM(fb1, 21); AT_MM(fb2, 22); AT_MM(fb3, 23); __builtin_amdgcn_sched_barrier(0);
#undef AT_KRD
#undef AT_MM
#undef AT_W0
        }
        if (st == nst - 1) {
#pragma unroll
            for (int t2 = 0; t2 < 2; ++t2)
#pragma unroll
                for (int r = 0; r < 16; ++r) { const int key = 64 * kt + 32 * t2 + (r & 3) + 8 * (r >> 2) + 4 * h; if (key > sq) sa[t2][r] = -1e30f; } }
        float mx = -1e30f;
#pragma unroll
        for (int t2 = 0; t2 < 2; ++t2)
#pragma unroll
            for (int r = 0; r < 16; ++r) mx = fmaxf(mx, sa[t2][r]);
        mx = fmaxf(mx, __shfl_xor(mx, 32));
        if (__builtin_amdgcn_ballot_w64(mx > m) != 0ull) { const float mn = fmaxf(m, mx), alpha = __builtin_amdgcn_exp2f(m - mn); m = mn; lsum *= alpha;
#pragma unroll
            for (int t = 0; t < 4; ++t) o[t] = o[t] * alpha; }
        float rs = 0.f;
#pragma unroll
        for (int t2 = 0; t2 < 2; ++t2)
#pragma unroll
            for (int r = 0; r < 16; ++r) { const float pv = __builtin_amdgcn_exp2f(sa[t2][r] - m); sa[t2][r] = pv; rs += pv; }
        rs += __shfl_xor(rs, 32);
        lsum += rs;
        LBAR();
        if (st + 1 < nst) { AT_STOREK(); AT_LOADV(st + 1); }
#pragma unroll
        for (int t2 = 0; t2 < 2; ++t2)
#pragma unroll
            for (int s = 0; s < 2; ++s) { v4u pw; pw.x = cvtpk(sa[t2][8 * s], sa[t2][8 * s + 1]); pw.y = cvtpk(sa[t2][8 * s + 2], sa[t2][8 * s + 3]); pw.z = cvtpk(sa[t2][8 * s + 4], sa[t2][8 * s + 5]); pw.w = cvtpk(sa[t2][8 * s + 6], sa[t2][8 * s + 7]);
                const bf16x8 pf = __builtin_bit_cast(bf16x8, pw);
#pragma unroll
                for (int t = 0; t < 4; ++t) { const LAS bf16* vp = Vs + (32 * t + c) * 68 + 32 * t2 + 16 * s + 4 * h; const v2u lo = *(const LAS v2u*)vp, hi = *(const LAS v2u*)(vp + 8);
                    v4u vw; vw.x = lo.x; vw.y = lo.y; vw.z = hi.x; vw.w = hi.y;
                    o[t] = __builtin_amdgcn_mfma_f32_32x32x16_bf16(__builtin_bit_cast(bf16x8, vw), pf, o[t], 0, 0, 0); } }
        LBAR();
        if (st + 1 < nst) { AT_STOREV(); if (st + 2 < nst) AT_LOADK(st + 2); }
    }
#undef AT_LOADK
#undef AT_LOADV
#undef AT_STOREK
#undef AT_STOREV
    LAS float* MB = (LAS float*)F.lds + (wq * 64 + lane) * 67;
    if (half == 1) { MB[0] = m; MB[1] = lsum;
#pragma unroll
        for (int t = 0; t < 4; ++t)
#pragma unroll
            for (int r = 0; r < 16; ++r) MB[2 + 16 * t + r] = o[t][r]; }
    LBAR();
    if (half == 0) { const float m2 = MB[0], l2 = MB[1], mn = fmaxf(m, m2), a1 = __builtin_amdgcn_exp2f(m - mn), a2 = __builtin_amdgcn_exp2f(m2 - mn);
        const float inv = 1.0f / (lsum * a1 + l2 * a2);
        if (sq < T) { bf16* yr = Y + (size_t)row_of_seq(sq) * D + 128 * hh + 4 * h;
#pragma unroll
            for (int t = 0; t < 4; ++t)
#pragma unroll
                for (int rq = 0; rq < 4; ++rq) { float ov[4];
#pragma unroll
                    for (int i = 0; i < 4; ++i) ov[i] = (o[t][4 * rq + i] * a1 + MB[2 + 16 * t + 4 * rq + i] * a2) * inv;
                    v2u wv; wv.x = cvtpk(ov[0], ov[1]); wv.y = cvtpk(ov[2], ov[3]); *(v2u*)(yr + 32 * t + 8 * rq) = wv; } } }
}
__device__ __forceinline__ void ssd_out_unit(const Ctx& F, int l, int c, int h, int ih) {
    LAS float* CS_ = (LAS float*)F.lds; LAS float* BS_ = CS_ + 4352; LAS float* PS_ = BS_ + 8704; LAS float* SC_ = PS_ + 4352; LAS float* XD_ = SC_ + 8448; LAS float* csl = XD_ + 8448; LAS float* lal = csl + 128; LAS float* dtl = lal + 128;
    LAS float* Y_ = CS_;
    const float* XBC = (const float*)(F.ws + O_XBC); const float* DT = (const float*)(F.ws + O_DT); const float* LA = (const float*)(F.ws + O_LA); const float* U = (const float*)(F.ws + O_U);
    const float* SST = (const float*)(F.ws + O_SST); float* YZ = (float*)(F.ws + O_YZ);
    int tid = F.tid, w = F.wave; asm volatile("" : "+v"(tid), "+s"(w));
    const int lane = tid & 63, g = h >> 2;
    const f32x4 z4 = (f32x4){0.f, 0.f, 0.f, 0.f};
    float lav = 0.f, dtv = 0.f; const float Dh = F.kp->in[I_SSDD][l * 8 + h];
    if (tid < 128) { const int row = crow(c, tid); if (row >= 0) { lav = LA[row * 8 + h]; dtv = DT[row * 8 + h]; } }
    f32x4 xdv[4], csv[2][2], bsv[2][4], psv[2][2]; float xsv[8], zv[8];
#pragma unroll
    for (int k = 0; k < 4; ++k) { const int idx = tid + 512 * k, j = idx >> 4, c4 = idx & 15, row = crow(c, j); xdv[k] = row >= 0 ? *(const f32x4*)(XBC + (size_t)row * 1024 + 64 * h + 4 * c4) : z4; }
#pragma unroll
    for (int nh = 0; nh < 2; ++nh) {
#pragma unroll
        for (int k = 0; k < 2; ++k) { const int idx = tid + 512 * k, i = idx >> 4, c4 = idx & 15, row = crow(c, 64 * ih + i); csv[nh][k] = row >= 0 ? *(const f32x4*)(XBC + (size_t)row * 1024 + 768 + 128 * g + 64 * nh + 4 * c4) : z4; }
#pragma unroll
        for (int k = 0; k < 4; ++k) { const int idx = tid + 512 * k, j = idx >> 4, c4 = idx & 15, row = crow(c, j); bsv[nh][k] = row >= 0 ? *(const f32x4*)(XBC + (size_t)row * 1024 + 512 + 128 * g + 64 * nh + 4 * c4) : z4; }
#pragma unroll
        for (int k = 0; k < 2; ++k) { const int idx = tid + 512 * k, pp = idx >> 4, c4 = idx & 15; psv[nh][k] = *(const f32x4*)(SST + ((size_t)(c * 8 + h) * 64 + pp) * 128 + 64 * nh + 4 * c4); } }
#pragma unroll
    for (int k = 0; k < 8; ++k) { const int idx = tid + 512 * k, i = idx >> 6, pp = idx & 63, row = crow(c, 64 * ih + i); xsv[k] = 0.f; zv[k] = 0.f;
        if (row >= 0) { xsv[k] = XBC[(size_t)row * 1024 + 64 * h + pp]; zv[k] = U[(size_t)row * NINP + U_SSD + 64 * h + pp]; } }
    __syncthreads();
    if (tid < 128) { lal[tid] = lav; dtl[tid] = dtv; }
    LBAR();
    if (tid < 64) { const float e0 = lal[2 * tid], e1 = lal[2 * tid + 1]; float s = e0 + e1;
#pragma unroll
        for (int o = 1; o < 64; o <<= 1) { const float t = __shfl_up(s, o); if (tid >= o) s += t; }
        csl[2 * tid + 1] = s; csl[2 * tid] = s - e1; }
#pragma unroll
    for (int k = 0; k < 4; ++k) { const int idx = tid + 512 * k, j = idx >> 4, c4 = idx & 15; const f32x4 v = xdv[k] * dtl[j]; LAS float* d = XD_ + (4 * c4) * 132 + j; d[0] = v[0]; d[132] = v[1]; d[264] = v[2]; d[396] = v[3]; }
    f32x16 acc_s = zero16(), acc_y = zero16();
    const int tr = w >> 2, tc = w & 3, tr2 = (w >> 1) & 1, tc2 = w & 1;
#pragma unroll
    for (int nh = 0; nh < 2; ++nh) {
        if (nh) LBAR();
#pragma unroll
        for (int k = 0; k < 2; ++k) { const int idx = tid + 512 * k, i = idx >> 4, c4 = idx & 15; const f32x4 v = csv[nh][k]; *(LAS f32x4*)(CS_ + i * 68 + 4 * c4) = v; }
#pragma unroll
        for (int k = 0; k < 4; ++k) { const int idx = tid + 512 * k, j = idx >> 4, c4 = idx & 15; const f32x4 v = bsv[nh][k]; *(LAS f32x4*)(BS_ + j * 68 + 4 * c4) = v; }
#pragma unroll
        for (int k = 0; k < 2; ++k) { const int idx = tid + 512 * k, pp = idx >> 4, c4 = idx & 15; const f32x4 v = psv[nh][k]; *(LAS f32x4*)(PS_ + pp * 68 + 4 * c4) = v; }
        LBAR();
        mma32bf(acc_s, CS_ + 32 * tr * 68, 68, BS_ + 32 * tc * 68, 68, 64, lane);
        if (w < 4) mma32bf(acc_y, CS_ + 32 * tr2 * 68, 68, PS_ + 32 * tc2 * 68, 68, 64, lane);
    }
    if (w < 4) {
#pragma unroll
        for (int r = 0; r < 16; ++r) acc_y[r] *= __expf(csl[64 * ih + 32 * tr2 + rreg(r, lane)]); }
#pragma unroll
    for (int r = 0; r < 16; ++r) { const int i = 32 * tr + rreg(r, lane), j = 32 * tc + (lane & 31), il = 64 * ih + i;
        SC_[i * 132 + j] = j <= il ? acc_s[r] * __expf(csl[il] - csl[j]) : 0.f; }
    LBAR();
    if (w < 4) { mma32bf(acc_y, SC_ + 32 * tr2 * 132, 132, XD_ + 32 * tc2 * 132, 132, 128, lane);
#pragma unroll
        for (int r = 0; r < 16; ++r) Y_[(32 * tr2 + rreg(r, lane)) * 68 + 32 * tc2 + (lane & 31)] = acc_y[r]; }
    LBAR();
#pragma unroll
    for (int k = 0; k < 8; ++k) { const int idx = tid + 512 * k, i = idx >> 6, pp = idx & 63, row = crow(c, 64 * ih + i);
        YZ[(size_t)(row >= 0 ? row : T + 8) * 512 + 64 * h + pp] = (Y_[i * 68 + pp] + Dh * xsv[k]) * siluf_(zv[k]); }
}
__device__ __forceinline__ void ret_out_unit(const Ctx& F, int l, int c, int h, int ih) {
    LAS float* Q_ = (LAS float*)F.lds; LAS float* KM_ = Q_ + 4352; LAS float* SC_ = KM_ + 8704; LAS float* VH_ = SC_ + 8448; LAS float* SP_ = KM_; LAS float* Y_ = SC_;
    const float* U = (const float*)(F.ws + O_U); const float* RQK = (const float*)(F.ws + O_RQK); const float* RST = (const float*)(F.ws + O_RST); bf16* Y = (bf16*)(F.ws + O_Y);
    int tid = F.tid, w = F.wave; asm volatile("" : "+v"(tid), "+s"(w));
    const int lane = tid & 63; const float lg = ret_logg(h);
    const f32x4 z4 = (f32x4){0.f, 0.f, 0.f, 0.f};
    f32x4 qv[2], kv[4], spv[4], vv[2][4], gv[4];
#pragma unroll
    for (int k = 0; k < 2; ++k) { const int idx = tid + 512 * k, i = idx >> 4, c4 = idx & 15, row = crow(c, 64 * ih + i); qv[k] = row >= 0 ? *(const f32x4*)(RQK + (size_t)row * 512 + 64 * h + 4 * c4) : z4; }
#pragma unroll
    for (int k = 0; k < 4; ++k) { const int idx = tid + 512 * k, j = idx >> 4, c4 = idx & 15, row = crow(c, j); kv[k] = row >= 0 ? *(const f32x4*)(RQK + (size_t)row * 512 + 256 + 64 * h + 4 * c4) : z4; }
#pragma unroll
    for (int k = 0; k < 4; ++k) { const int idx = tid + 512 * k, vx = idx >> 4, c4 = idx & 15; spv[k] = *(const f32x4*)(RST + ((size_t)(c * 4 + h) * 128 + vx) * 64 + 4 * c4); }
#pragma unroll
    for (int jh = 0; jh < 2; ++jh)
#pragma unroll
        for (int k = 0; k < 4; ++k) { const int idx = tid + 512 * k, j = idx >> 5, c4 = idx & 31, row = crow(c, 64 * jh + j); vv[jh][k] = (jh <= ih && row >= 0) ? *(const f32x4*)(U + (size_t)row * NINP + U_RET + 512 + 128 * h + 4 * c4) : z4; }
    const int li = tid >> 3, part = tid & 7, lrow = crow(c, 64 * ih + li);
#pragma unroll
    for (int k = 0; k < 4; ++k) gv[k] = lrow >= 0 ? *(const f32x4*)(U + (size_t)lrow * NINP + U_RET + 1024 + 128 * h + 16 * part + 4 * k) : z4;
    __syncthreads();
#pragma unroll
    for (int k = 0; k < 2; ++k) { const int idx = tid + 512 * k, i = idx >> 4, c4 = idx & 15; const f32x4 v = qv[k]; *(LAS f32x4*)(Q_ + i * 68 + 4 * c4) = v; }
#pragma unroll
    for (int k = 0; k < 4; ++k) { const int idx = tid + 512 * k, j = idx >> 4, c4 = idx & 15; const f32x4 v = kv[k]; *(LAS f32x4*)(KM_ + j * 68 + 4 * c4) = v; }
    LBAR();
    const int tr = w >> 2, tc = w & 3;
    f32x16 acc_s = zero16();
    mma32bf(acc_s, Q_ + 32 * tr * 68, 68, KM_ + 32 * tc * 68, 68, 64, lane);
    LBAR();
#pragma unroll
    for (int k = 0; k < 4; ++k) { const int idx = tid + 512 * k, vx = idx >> 4, c4 = idx & 15; const f32x4 v = spv[k]; *(LAS f32x4*)(SP_ + vx * 68 + 4 * c4) = v; }
#pragma unroll
    for (int r = 0; r < 16; ++r) { const int i = 32 * tr + rreg(r, lane), j = 32 * tc + (lane & 31), il = 64 * ih + i;
        SC_[i * 132 + j] = j <= il ? acc_s[r] * __expf((float)(il - j) * lg) : 0.f; }
#pragma unroll
    for (int k = 0; k < 4; ++k) { const int idx = tid + 512 * k, j = idx >> 5, c4 = idx & 31; const f32x4 v = vv[0][k]; LAS float* d = VH_ + (4 * c4) * 68 + j; d[0] = v[0]; d[68] = v[1]; d[136] = v[2]; d[204] = v[3]; }
    LBAR();
    f32x16 acc_y = zero16();
    mma32bf(acc_y, Q_ + 32 * tr * 68, 68, SP_ + 32 * tc * 68, 68, 64, lane);
#pragma unroll
    for (int r = 0; r < 16; ++r) acc_y[r] *= __expf((float)(64 * ih + 32 * tr + rreg(r, lane) + 1) * lg);
    mma32bf(acc_y, SC_ + 32 * tr * 132, 132, VH_ + 32 * tc * 68, 68, 64, lane);
    if (ih) { LBAR();
#pragma unroll
        for (int k = 0; k < 4; ++k) { const int idx = tid + 512 * k, j = idx >> 5, c4 = idx & 31; const f32x4 v = vv[1][k]; LAS float* d = VH_ + (4 * c4) * 68 + j; d[0] = v[0]; d[68] = v[1]; d[136] = v[2]; d[204] = v[3]; }
        LBAR();
        mma32bf(acc_y, SC_ + 32 * tr * 132 + 64, 132, VH_ + 32 * tc * 68, 68, 64, lane); }
    LBAR();
#pragma unroll
    for (int r = 0; r < 16; ++r) Y_[(32 * tr + rreg(r, lane)) * 132 + 32 * tc + (lane & 31)] = acc_y[r];
    LBAR();
    { const LAS float* yr = Y_ + li * 132 + 16 * part;
      float s = 0.f;
#pragma unroll
      for (int k = 0; k < 16; ++k) s += yr[k];
      s = sum8(s);
      const float mu = s * (1.0f / 128.0f); float q = 0.f;
#pragma unroll
      for (int k = 0; k < 16; ++k) { const float d = yr[k] - mu; q += d * d; }
      q = sum8(q);
      const float rstd = 1.0f / sqrtf(q * (1.0f / 128.0f) + EPS);
      if (lrow >= 0) { const float* ng = F.kp->in[I_RETN] + l * 512 + 128 * h + 16 * part; float ov[16];
#pragma unroll
          for (int k = 0; k < 16; ++k) ov[k] = (yr[k] - mu) * rstd * ng[k] * siluf_(gv[k >> 2][k & 3]);
          bf16* yd = Y + (size_t)lrow * D + 1024 + 128 * h + 16 * part;
          v4u w0, w1; w0.x = cvtpk(ov[0], ov[1]); w0.y = cvtpk(ov[2], ov[3]); w0.z = cvtpk(ov[4], ov[5]); w0.w = cvtpk(ov[6], ov[7]); w1.x = cvtpk(ov[8], ov[9]); w1.y = cvtpk(ov[10], ov[11]); w1.z = cvtpk(ov[12], ov[13]); w1.w = cvtpk(ov[14], ov[15]);
          *(v4u*)yd = w0; *(v4u*)(yd + 8) = w1; } }
}
__device__ __forceinline__ void m4_phase(const Ctx& F, int l, int qi = 0, int only = -1) {
    unsigned* ctr = (unsigned*)(F.ws + O_CTL) + CW_QUEUE + 64 * (4 * l + qi);
    constexpr int N_AT = 4 * NCH, N_CV = 128, N_SO = NCH * 16, N_RO = NCH * 8, N_WO = NRC * 8, N_ALL = N_AT + N_CV + N_SO + N_RO + N_WO;
    int u = queue_next(F, ctr);
    while (u < N_AT) { if (only < 0) attn_unit<0>(F, u & 3, (NCH - 1) - (u >> 2)); else if (only == 0) attn_unit<DUP_VAR>(F, u & 3, (NCH - 1) - (u >> 2), O_QKV); u = queue_next(F, ctr); }
    while (u < N_AT + N_CV) { if (l + 1 < DEPTH && only < 0) { __syncthreads(); convert_layer(F, l + 1, (u - N_AT) * NWAVES + F.wave, N_CV * NWAVES); }
        u = queue_next(F, ctr); }
    while (u < N_AT + N_CV + N_SO + N_RO) { int v = u - N_AT - N_CV;
        if (v < N_RO) { const int c = v >> 3, h = (v >> 1) & 3, ih = v & 1; if (!(c == 0 && ih == 0) && (only < 0 || only == 2)) ret_out_unit(F, l, c, h, ih); }
        else { v -= N_RO; const int c = v >> 4, h = (v >> 1) & 7, ih = v & 1; if (!(c == 0 && ih == 0) && (only < 0 || only == 1)) ssd_out_unit(F, l, c, h, ih); }
        u = queue_next(F, ctr); }
    if (u < N_ALL && only < 0) {
        if (F.tid == 0) { unsigned* sflag = (unsigned*)(F.ws + O_CTL) + CW_QUEUE + 64 * (16 + l); const unsigned nscan = F.G >= 64 ? 32u : (unsigned)F.G; unsigned sp = 0;
            while (__hip_atomic_load(sflag, __ATOMIC_RELAXED, __HIP_MEMORY_SCOPE_AGENT) < nscan) { __builtin_amdgcn_s_sleep(8); if (++sp > (1u << 22)) break; }
            __builtin_amdgcn_fence(__ATOMIC_ACQUIRE, "agent"); asm volatile("s_waitcnt vmcnt(0)" ::: "memory"); }
        __syncthreads(); }
    while (u < N_ALL) { const int v = u - (N_AT + N_CV + N_SO + N_RO); if (only < 0 || only == 3) rwkv_out_unit(F, l, v >> 3, v & 7); u = queue_next(F, ctr); }
}
__device__ __forceinline__ void m5_phase(const Ctx& F, int l) {
#ifdef PROBE_DUP
    { const bf16* Y = (const bf16*)(F.ws + O_Y); const bf16* Y2 = (const bf16*)(F.ws + O_YZ); unsigned cnt = 0;
      for (int row = F.bid * NWAVES + F.wave; row < T; row += F.G * NWAVES) for (int j = 0; j < 8; ++j) cnt += Y[(size_t)row * D + 64 * j + F.lane] != Y2[(size_t)row * D + 64 * j + F.lane];
      if (cnt) atomicAdd((unsigned*)(F.ws + O_CTL) + 8, cnt); }
#endif
#ifdef PROBE_COPY_U
    { const float* U = (const float*)(F.ws + O_U); bf16* Y = (bf16*)(F.ws + O_Y);
      for (int row = F.bid * NWAVES + F.wave; row < T; row += F.G * NWAVES)
        for (int j = 0; j < 4; ++j) { const float* ur = U + (size_t)(PROBE_COPY_META ? SEQ + (row & 15) : row) * NINP + PROBE_COPY_U + 512 * j + 8 * F.lane; const f32x4 a = *(const f32x4*)ur, b = *(const f32x4*)(ur + 4);
          v4u w; w.x = pk2(a[0], a[1]); w.y = pk2(a[2], a[3]); w.z = pk2(b[0], b[1]); w.w = pk2(b[2], b[3]); *(v4u*)(Y + (size_t)row * D + 512 * j + 8 * F.lane) = w; } }
#endif
    if (!EN_SSD) return;
    const float* YZ = (const float*)(F.ws + O_YZ); bf16* Y = (bf16*)(F.ws + O_Y); const float* ng = F.kp->in[I_SSDN] + l * 512 + 8 * F.lane;
    const f32x4 g0 = *(const f32x4*)ng, g1 = *(const f32x4*)(ng + 4);
    const int gw = F.bid * NWAVES + F.wave, NGW = F.G * NWAVES;
    for (int rb = gw; rb < T; rb += 5 * NGW) { f32x4 av[5], bv[5];
#pragma unroll
        for (int i = 0; i < 5; ++i) { const int row = rb + i * NGW; const float* yr = YZ + (size_t)(row < T ? row : rb) * 512 + 8 * F.lane; av[i] = *(const f32x4*)yr; bv[i] = *(const f32x4*)(yr + 4); }
#pragma unroll
        for (int i = 0; i < 5; ++i) { const int row = rb + i * NGW; const f32x4 a = av[i], b = bv[i];
            const float sq = wave_sum((a[0] * a[0] + a[1] * a[1]) + (a[2] * a[2] + a[3] * a[3]) + (b[0] * b[0] + b[1] * b[1]) + (b[2] * b[2] + b[3] * b[3]));
            const float rs = __builtin_amdgcn_rsqf(sq * (1.0f / 512.0f) + EPS);
            v4u w; w.x = pk2(a[0] * rs * g0[0], a[1] * rs * g0[1]); w.y = pk2(a[2] * rs * g0[2], a[3] * rs * g0[3]); w.z = pk2(b[0] * rs * g1[0], b[1] * rs * g1[1]); w.w = pk2(b[2] * rs * g1[2], b[3] * rs * g1[3]);
            if (row < T) *(v4u*)(Y + (size_t)row * D + 512 + 8 * F.lane) = w; } }
}
template <int MODE  , int NT>
__device__ __forceinline__ void meta_gemm(const Ctx& F, const bf16* A16, int lda, const bf16* Bt, int ldb, int ntasks, int K, float* Cf, int ldc, const float* ss_in, float* ss_out, bf16* Ob, bf16* HL, float scale) {
    constexpr int NACC = MODE == 1 ? 2 * NT : NT;
    LAS float* red = (LAS float*)F.lds;
    int tid = F.tid, w = F.wave; asm volatile("" : "+v"(tid), "+s"(w));
    const int lane = tid & 63, g = lane >> 4, c = lane & 15, kper = K >> 3;
    for (int task = F.G - 1 - F.bid; task < ntasks; task += F.G) {
        const int n0 = MODE == 1 ? 256 * ((64 * task) >> 7) + ((64 * task) & 127) : 16 * NT * task;
        f32x4 acc[NACC];
#pragma unroll
        for (int q = 0; q < NACC; ++q) acc[q] = (f32x4){0.f, 0.f, 0.f, 0.f};
        const bf16* ap = A16 + (size_t)c * lda + w * kper + 8 * g; const bf16* bp = Bt + (size_t)(n0 + c) * ldb + w * kper + 8 * g;
        bf16x8 a_r[3], b_r[3][NACC]; const int klast = kper - 32;
#define MG_LOAD(s_, k_) do { const int kc_ = (k_) < klast ? (k_) : klast; a_r[s_] = *(const bf16x8*)(ap + kc_); \
            _Pragma("unroll") for (int t = 0; t < NT; ++t) { b_r[s_][t] = *(const bf16x8*)(bp + (size_t)(16 * t) * ldb + kc_); if (MODE == 1) b_r[s_][NT + t] = *(const bf16x8*)(bp + (size_t)(128 + 16 * t) * ldb + kc_); } } while (0)
#define MG_MMA(s_) do { _Pragma("unroll") for (int q = 0; q < NACC; ++q) acc[q] = __builtin_amdgcn_mfma_f32_16x16x32_bf16(b_r[s_][q], a_r[s_], acc[q], 0, 0, 0); } while (0)
        MG_LOAD(0, 0); MG_LOAD(1, 32); MG_LOAD(2, 64);
        for (int kk = 0; kk < kper; kk += 96) {
            MG_MMA(0); MG_LOAD(0, kk + 96);
            if (kk + 32 < kper) { MG_MMA(1); MG_LOAD(1, kk + 128); }
            if (kk + 64 < kper) { MG_MMA(2); MG_LOAD(2, kk + 160); } }
#undef MG_LOAD
#undef MG_MMA
        __syncthreads();
#pragma unroll
        for (int q = 0; q < NACC; ++q) *(LAS f32x4*)(red + ((w * NACC + q) * 64 + lane) * 4) = acc[q];
        __syncthreads();
        if (w == 0) { const int row = SEQ + c; float rs = 1.0f;
            if (ss_in) { float s = 0.f;
#pragma unroll
                for (int q = 0; q < 8; ++q) { const f32x4 x = *(const f32x4*)(ss_in + (size_t)row * 32 + 4 * q); s += (x[0] + x[1]) + (x[2] + x[3]); }
                rs = __builtin_amdgcn_rsqf(s * (1.0f / 2048.0f) + EPS); }
            float sq = 0.f;
#pragma unroll
            for (int t = 0; t < NT; ++t) { f32x4 v = (f32x4){0.f, 0.f, 0.f, 0.f}, v2 = v;
#pragma unroll
                for (int ww = 0; ww < 8; ++ww) { v = v + *(const LAS f32x4*)(red + ((ww * NACC + t) * 64 + lane) * 4); if (MODE == 1) v2 = v2 + *(const LAS f32x4*)(red + ((ww * NACC + NT + t) * 64 + lane) * 4); }
                if (MODE == 0) *(f32x4*)(Cf + (size_t)row * ldc + 16 * NT * task + 16 * t + 4 * g) = v * rs;
                if (MODE == 3) { v2u wv; wv.x = pk2(v[0] * rs, v[1] * rs); wv.y = pk2(v[2] * rs, v[3] * rs); *(v2u*)(Ob + (size_t)row * ldc + 16 * NT * task + 16 * t + 4 * g) = wv; }
                if (MODE == 1) { float o[4];
#pragma unroll
                    for (int i = 0; i < 4; ++i) { const float gv = v[i] * rs, uv = v2[i] * rs; o[i] = gv * uv * __builtin_amdgcn_rcpf(1.0f + __expf(-gv)); }
                    v2u wv; wv.x = pk2(o[0], o[1]); wv.y = pk2(o[2], o[3]); *(v2u*)(Ob + (size_t)row * DFF + 64 * task + 16 * t + 4 * g) = wv; }
                if (MODE == 2) { const size_t off = (size_t)row * D + 64 * task + 16 * t + 4 * g; const v2u hi = *(const v2u*)(Ob + off), lo = *(const v2u*)(HL + off);
                    f32x4 h4 = (f32x4){pg8::bflo(hi.x) + pg8::bflo(lo.x), pg8::bfhi(hi.x) + pg8::bfhi(lo.x), pg8::bflo(hi.y) + pg8::bflo(lo.y), pg8::bfhi(hi.y) + pg8::bfhi(lo.y)}; h4 = h4 + v * scale;
                    v2u wv; wv.x = cvtpk(h4[0], h4[1]); wv.y = cvtpk(h4[2], h4[3]); v2u lv; lv.x = cvtpk(h4[0] - pg8::bflo(wv.x), h4[1] - pg8::bfhi(wv.x)); lv.y = cvtpk(h4[2] - pg8::bflo(wv.y), h4[3] - pg8::bfhi(wv.y));
                    *(v2u*)(Ob + off) = wv; *(v2u*)(HL + off) = lv; sq += (h4[0] * h4[0] + h4[1] * h4[1]) + (h4[2] * h4[2] + h4[3] * h4[3]); } }
            if (MODE == 2 && ss_out) { sq += __shfl_xor(sq, 16); sq += __shfl_xor(sq, 32); if (g == 0) __hip_atomic_fetch_add(ss_out + (size_t)row * 32 + task, sq, __ATOMIC_RELAXED, __HIP_MEMORY_SCOPE_AGENT); } }
    }    __syncthreads();
}
__device__ __forceinline__ void gemm_swiglu(const Ctx& F, int hl, int ssidx) {
    const bf16* A = (const bf16*)(F.ws + O_HB); const bf16* Bt = (const bf16*)(F.ws + O_WGU) + (size_t)hl * 11264 * 2048; const float* ss = (const float*)(F.ws + O_SS) + (size_t)ssidx * MP * 32;
    { pg8::Gemm g{A, Bt, SEQ, 11264, 2048, 2048, 2048, F.wave}; pg8::StaticOrder S; S.init(SEQ, 11264, F.G, F.bid);
      const int full = (S.nwg / F.G) * F.G, rem = S.nwg - full;
      const bool split = false && (2 * rem == F.G);
      if (split) S.lim = full;
      pg8::EpiSwiGLU E{(bf16*)(F.ws + O_ACT), DFF, ss, 1.0f / 2048.0f, EPS, 2};
      pg8::gemm_phase<pg8::EpiSwiGLU, pg8::StaticOrder, true, true, false>(F.lds, g, S, E);
      if (split) { pg8::StaticOrder S2; S2.init(SEQ, 11264, F.G, F.bid); S2.hmbase = full;
          pg8::EpiSwiGLU E2{(bf16*)(F.ws + O_ACT), DFF, ss, 1.0f / 2048.0f, EPS, 1};
          pg8::gemm_phase<pg8::EpiSwiGLU, pg8::StaticOrder, true, true, true>(F.lds, g, S2, E2); } }
    meta_gemm<1, 4>(F, A + (size_t)SEQ * 2048, 2048, Bt, 2048, DFF / 64, 2048, nullptr, 0, ss, nullptr, (bf16*)(F.ws + O_ACT), nullptr, 0.f);
}
__device__ __forceinline__ void gemm_residual(const Ctx& F, const bf16* A, const bf16* Bt, int K, int ssidx, bool to_out, float scale) {
    float* sso = ssidx >= 0 ? (float*)(F.ws + O_SS) + (size_t)ssidx * MP * 32 : nullptr;
    { pg8::Gemm g{A, Bt, SEQ, 2048, K, K, K, F.wave}; pg8::StaticOrder S; S.init(SEQ, 2048, F.G, F.bid);
      pg8::EpiResidual E{(bf16*)(F.ws + O_H), (bf16*)(F.ws + O_HB), sso, to_out ? F.kp->out : nullptr, SEQ, scale};
      pg8::gemm_phase<pg8::EpiResidual, pg8::StaticOrder, true, true>(F.lds, g, S, E); }
    meta_gemm<2, 4>(F, A + (size_t)SEQ * K, K, Bt, K, 32, K, nullptr, 0, nullptr, sso, (bf16*)(F.ws + O_HB), (bf16*)(F.ws + O_H), scale);
}
__device__ __forceinline__ void gemm_residual_dummy(const Ctx& F, const bf16* A, const bf16* Bt, int K) {
    { pg8::Gemm g{A, Bt, SEQ, 2048, K, K, K, F.wave}; pg8::StaticOrder S; S.init(SEQ, 2048, F.G, F.bid);
      pg8::EpiResidual E{(bf16*)(F.ws + O_RW), (bf16*)(F.ws + O_RW + (size_t)72 * 1024 * 1024), nullptr, nullptr, SEQ, 0.5f};
      pg8::gemm_phase<pg8::EpiResidual, pg8::StaticOrder, true, true>(F.lds, g, S, E); }
}
__device__ __forceinline__ void gemm_scalef32(const Ctx& F, const bf16* A, const bf16* Bt, int N, int K, float* C, int ssidx) {
    const float* ss = ssidx >= 0 ? (const float*)(F.ws + O_SS) + (size_t)ssidx * MP * 32 : nullptr;
    { pg8::Gemm g{A, Bt, SEQ, N, K, K, K, F.wave}; pg8::StaticOrder S; S.init(SEQ, N, F.G, F.bid);
      pg8::EpiScaleF32 E{C, N, ss, 1.0f / 2048.0f, EPS};
      pg8::gemm_phase<pg8::EpiScaleF32, pg8::StaticOrder, true, true>(F.lds, g, S, E); }
    meta_gemm<0, 4>(F, A + (size_t)SEQ * K, K, Bt, K, N / 64, K, C, N, ss, nullptr, nullptr, nullptr, 0.f);
}
__global__ void __launch_bounds__(NTHR, 2) hybrid_fwd(P p) {
    extern __shared__ __attribute__((aligned(16))) unsigned char lds_raw[];
    LAS unsigned char* lds = (LAS unsigned char*)lds_raw;
    const int wv = __builtin_amdgcn_readfirstlane((int)threadIdx.x >> 6);
    for (int u = threadIdx.x; u < (LDS_BYTES - LDSCTL_OFF) / 4; u += NTHR) ((LAS unsigned*)(lds + LDSCTL_OFF))[u] = 0u;
    __syncthreads();
    XcdBarrier bar = xcd_barrier_post((unsigned*)(p.ws + O_CTL) + CW_BAR, (volatile LAS unsigned*)(lds + LDSCTL_OFF), wv);
    const int lo = p.ph_lo, hi = p.ph_hi;
#ifdef TIME_MASK
    if (blockIdx.x == TIME_BLK && threadIdx.x == 0) { volatile LAS unsigned long long* tp_ = (volatile LAS unsigned long long*)(lds + LDSCTL_OFF + 1024); tp_[0] = wall_clock64(); tp_[1] = 0ull; }
#endif
#define IN(k) (lo <= (k) && (k) < hi)
#ifdef TIME_MASK
#ifndef TIME_PRE
#define TIME_PRE 0
#endif
#ifndef TIME_BLK
#define TIME_BLK 0
#endif
#define TMARK(kind, post) do { if (blockIdx.x == TIME_BLK && threadIdx.x == 0) { const unsigned long long now_ = wall_clock64(); volatile LAS unsigned long long* tp_ = (volatile LAS unsigned long long*)(lds + LDSCTL_OFF + 1024); \
    if ((((post) ? TIME_MASK : TIME_PRE) >> (kind)) & 1) tp_[1] += now_ - tp_[0]; if (post) tp_[0] = now_; } } while (0)
#define SEAM(k, kind) do { TMARK(kind, 0); if (IN(k) && IN((k) + 1)) xcd_barrier(bar, wv); TMARK(kind, 1); } while (0)
#else
#define TMARK(kind, post) do { } while (0)
#define SEAM(k, kind) do { if (IN(k) && IN((k) + 1)) xcd_barrier(bar, wv); } while (0)
#endif
#ifndef NO_P0
    if (IN(0)) { const Ctx F = ctx_make(lds, wv); p0_prologue(F, 0); }
#ifdef DUP_CVT
    if (IN(0)) { const Ctx F = ctx_make(lds, wv); p0_prologue(F, 1); }
#endif
#endif
    SEAM(0, 0);
    for (int hl = 0; hl < 8; ++hl) {
        const int l = hl >> 1, second = hl & 1, base = 1 + 11 * l + (second ? 9 : 0);
        if (IN(base)) { const Ctx F = ctx_make(lds, wv); gemm_swiglu(F, hl, 3 * l + (second ? 2 : 0)); }
#ifdef DUP_GU
        if (IN(base)) { const Ctx F = ctx_make(lds, wv); gemm_swiglu(F, hl, 3 * l + (second ? 2 : 0)); }
#endif
        SEAM(base, 1);
        if (IN(base + 1)) { const Ctx F = ctx_make(lds, wv);
            gemm_residual(F, (const bf16*)(F.ws + O_ACT), (const bf16*)(F.ws + O_WD) + (size_t)hl * 2048 * 5632, 5632, second ? (l < 3 ? 3 * (l + 1) : -1) : 3 * l + 1, hl == 7, 0.5f); }
#ifdef DUP_DOWN
        if (IN(base + 1)) { const Ctx F = ctx_make(lds, wv); if (DUP_DOWN == 1) gemm_residual_dummy(F, (const bf16*)(F.ws + O_ACT), (const bf16*)(F.ws + O_WD) + (size_t)hl * 2048 * 5632, 5632); else gemm_residual_dummy(F, (const bf16*)(F.ws + O_Y), (const bf16*)(F.ws + O_WOUT) + (size_t)l * D * D, 2048); }
#endif
        if (hl < 7) SEAM(base + 1, 2);
        if (!second) {
            const int mb = base + 2;
            if (IN(mb)) { const Ctx F = ctx_make(lds, wv); gemm_scalef32(F, (const bf16*)(F.ws + O_HB), (const bf16*)(F.ws + O_WIN) + (size_t)l * NINP * D, NINP, 2048, (float*)(F.ws + O_U), 3 * l + 1); }
            if (IN(mb) && l == 0) { const Ctx F = ctx_make(lds, wv); cv_tail0(F, IT_GU / 2, IT_GU, (32 * 21) % F.G); }
#ifdef DUP_WIN
            if (IN(mb)) { const Ctx F = ctx_make(lds, wv); gemm_scalef32(F, (const bf16*)(F.ws + O_HB), (const bf16*)(F.ws + O_WIN) + (size_t)l * NINP * D, NINP, 2048, (float*)(F.ws + O_U), 3 * l + 1); }
#endif
            SEAM(mb, 3);
#ifndef NO_M1
            if (IN(mb + 1)) { const Ctx F = ctx_make(lds, wv); m1_phase(F, l); }
#ifdef DUP_M1
            if (IN(mb + 1)) { const Ctx F = ctx_make(lds, wv); m1_phase(F, l, 3); }
#endif
#endif
            SEAM(mb + 1, 4);
            if (IN(mb + 2)) {
                if (EN_MLA) { const Ctx F = ctx_make(lds, wv); gemm_scalef32(F, (const bf16*)(F.ws + O_AMLA), (const bf16*)(F.ws + O_WMLA) + (size_t)l * MLAN * 512, MLAN, 512, (float*)(F.ws + O_QKV), -1); }
#ifndef NO_M2
                { const Ctx F = ctx_make(lds, wv); unsigned* ctr = (unsigned*)(F.ws + O_CTL) + CW_QUEUE + 64 * (4 * l + 2);
                  for (;;) { int u = queue_next(F, ctr); if (u >= NRC * 8 + NCH * 8 + NCH * 4) break;
                      if (u < NRC * 8) { rwkv_chunk_unit(F, u >> 3, u & 7); continue; } u -= NRC * 8;
                      if (u < NCH * 8) { ssd_states_unit(F, u >> 3, u & 7); continue; } u -= NCH * 8;
                      ret_states_unit(F, u >> 2, u & 3); } }
#ifdef DUP_M2Q
                { const Ctx F = ctx_make(lds, wv); unsigned* ctr = (unsigned*)(F.ws + O_CTL) + CW_QUEUE + 64 * (4 * l + 3);
                  for (;;) { int u = queue_next(F, ctr); if (u >= NRC * 8 + NCH * 8 + NCH * 4) break;
                      if (u < NRC * 8) { rwkv_chunk_unit(F, u >> 3, u & 7); continue; } u -= NRC * 8;
                      if (u < NCH * 8) { ssd_states_unit(F, u >> 3, u & 7); continue; } u -= NCH * 8;
                      ret_states_unit(F, u >> 2, u & 3); } }
#endif
#endif
            }
            SEAM(mb + 2, 5);
#ifndef NO_M3
            if (IN(mb + 3)) { const Ctx F = ctx_make(lds, wv); m3_phase(F, l); }
#ifdef DUP_SCAN
            if (IN(mb + 3)) { const Ctx F = ctx_make(lds, wv); if (F.bid < 32) rwkv_state_scan<DUP_SCAN>(F, F.bid >> 2, F.bid & 3); }
#endif
#endif
            SEAM(mb + 3, 6);
#ifndef NO_M4
            if (IN(mb + 4)) { const Ctx F = ctx_make(lds, wv); const int nscan = F.G >= 64 ? 32 : F.G;
                if (F.bid < nscan) { for (int s = F.bid; s < 32; s += nscan) rwkv_state_scan<0>(F, s >> 2, s & 3);
                    asm volatile("s_waitcnt vmcnt(0)" ::: "memory"); __syncthreads();
                    if (F.tid == 0) { __builtin_amdgcn_fence(__ATOMIC_RELEASE, "agent"); asm volatile("s_waitcnt vmcnt(0)" ::: "memory"); __hip_atomic_fetch_add((unsigned*)(F.ws + O_CTL) + CW_QUEUE + 64 * (16 + l), 1u, __ATOMIC_RELAXED, __HIP_MEMORY_SCOPE_AGENT); } } }
            if (IN(mb + 4)) { const Ctx F = ctx_make(lds, wv); m4_phase(F, l); }
#ifdef DUP_M4
            if (IN(mb + 4)) { const Ctx F = ctx_make(lds, wv); m4_phase(F, l, 3, DUP_M4 - 1); }
#endif
#endif
            SEAM(mb + 4, 7);
#ifndef NO_M5
            if (IN(mb + 5)) { const Ctx F = ctx_make(lds, wv); m5_phase(F, l); }
#ifdef DUP_M5
            if (IN(mb + 5)) { const Ctx F = ctx_make(lds, wv); m5_phase(F, l); }
#endif
#endif
            SEAM(mb + 5, 8);
#ifdef DUP_BAR
            for (int q = 0; q < 8; ++q) xcd_barrier(bar, wv);
#endif
            if (IN(mb + 6)) { const Ctx F = ctx_make(lds, wv); gemm_residual(F, (const bf16*)(F.ws + O_Y), (const bf16*)(F.ws + O_WOUT) + (size_t)l * D * D, 2048, 3 * l + 2, false, 1.0f); }
            SEAM(mb + 6, 9);
        }
    }
#ifdef TIME_MASK
    TMARK(2, 0); TMARK(2, 1);
    if (blockIdx.x == TIME_BLK && threadIdx.x == 0) { volatile LAS unsigned long long* tp_ = (volatile LAS unsigned long long*)(lds + LDSCTL_OFF + 1024); const unsigned long long t0_ = tp_[0], d_ = tp_[1];
        while (wall_clock64() - t0_ < d_) __builtin_amdgcn_s_sleep(8); }
#endif
#ifdef PROBE_DUP
    xcd_barrier(bar, wv);
    { const Ctx F = ctx_make(lds, wv); const float v = (float)__hip_atomic_load((unsigned*)(F.ws + O_CTL) + 8, __ATOMIC_RELAXED, __HIP_MEMORY_SCOPE_AGENT); float* out = F.kp->out;
      for (size_t i = (size_t)F.bid * NTHR + F.tid; i < (size_t)SEQ * D; i += (size_t)F.G * NTHR) out[i] = v; }
#endif
#ifdef PROBE_ADD_META
    xcd_barrier(bar, wv);
    { const Ctx F = ctx_make(lds, wv); const float* H = (const float*)(F.ws + O_H); float* out = F.kp->out;
      for (int row = F.bid * NWAVES + F.wave; row < SEQ; row += F.G * NWAVES)
        for (int j = 0; j < 8; ++j) { const int c = 256 * j + 4 * F.lane; f32x4 v = *(f32x4*)(out + (size_t)row * D + c); v = v + *(const f32x4*)(H + (size_t)(SEQ + (row & 15)) * D + c); *(f32x4*)(out + (size_t)row * D + c) = v; } }
#endif
#undef IN
#undef SEAM
}

extern "C" void kernel_launch(void* const* d_in, const int* in_sizes, int n_in, void* d_out, int out_size, void* d_ws, size_t ws_size, hipStream_t stream) {
    static int grid = 0;
    if (grid == 0) {
        if (n_in != 36 || out_size != SEQ * D || ws_size < WS_END) { fprintf(stderr, "kernel_launch: expected 36 inputs, out %d, ws >= %zu; got n_in %d out %d ws %zu\n", SEQ * D, (size_t)WS_END, n_in, out_size, ws_size); grid = -1; return; }
        int dev = 0, cus = 0, per_cu = 0;
        if (hipGetDevice(&dev) != hipSuccess || hipDeviceGetAttribute(&cus, hipDeviceAttributeMultiprocessorCount, dev) != hipSuccess) { grid = -1; return; }
        if (hipFuncSetAttribute((const void*)hybrid_fwd, hipFuncAttributeMaxDynamicSharedMemorySize, LDS_BYTES) != hipSuccess) { fprintf(stderr, "kernel_launch: hipFuncSetAttribute failed\n"); grid = -1; return; }
        if (hipOccupancyMaxActiveBlocksPerMultiprocessor(&per_cu, (const void*)hybrid_fwd, NTHR, LDS_BYTES) != hipSuccess || per_cu < 1) fprintf(stderr, "kernel_launch: occupancy query reports %d\n", per_cu);
        (void)hipGetLastError();
        grid = cus;
    }
    if (grid < 0) return;
    if (hipMemsetAsync((char*)d_ws + O_CTL, 0, SZ_CTL, stream) != hipSuccess) { fprintf(stderr, "kernel_launch: memset failed\n"); return; }
    P a{};
    for (int i = 0; i < 36; ++i) a.in[i] = (const float*)d_in[i];
    a.out = (float*)d_out; a.ws = (unsigned char*)d_ws;
#if PER_PHASE_LAUNCH
    for (int ph = 0; ph < NPHASE; ++ph) { a.ph_lo = ph; a.ph_hi = ph + 1; hipLaunchKernelGGL(hybrid_fwd, dim3(grid), dim3(NTHR), LDS_BYTES, stream, a); }
#else
    a.ph_lo = 0; a.ph_hi = NPHASE;
    hipLaunchKernelGGL(hybrid_fwd, dim3(grid), dim3(NTHR), LDS_BYTES, stream, a);
#endif
    const hipError_t le = hipPeekAtLastError();
    if (le != hipSuccess) fprintf(stderr, "kernel_launch: launch failed: %s\n", hipGetErrorName(le));
}
```
